# Optimizing an MI355X kernel written in HIP

```python
import jax, jax.numpy as jnp
from jax import lax
import numpy as np

D_MODEL = 2048
BATCH = 4
SEQ = 4096
DEPTH = 1

GM_WIDTH = D_MODEL // 2
GM_GROUPS = 8
GM_CHUNK = 128
MLA_HEADS = 16
Q_LORA = D_MODEL // 4
KV_LORA = D_MODEL // 4
QK_NOPE = 128
QK_ROPE = 64
V_DIM = 128
QK_DIM = QK_NOPE + QK_ROPE
MLA_SCALE = QK_DIM ** -0.5
ROPE_THETA = 10000.0
Q_BLOCK = 128
MEM_LEN = 256
MEM_HEADS = 4
MEM_HEAD_DIM = D_MODEL // 8
MEM_WIDTH = MEM_HEADS * MEM_HEAD_DIM
MEM_SCALE = MEM_HEAD_DIM ** -0.5
N_BRANCH = 3
IN_COLS = 2 * GM_WIDTH + Q_LORA + KV_LORA + QK_ROPE + MEM_WIDTH
N_EXPERTS = 32
TOP_K = 4
D_FF = D_MODEL
SWIGLU_LIMIT = 7.0
SWIGLU_ALPHA = 1.702
ROW_BLOCK = 256
EPS = 1e-6

kernel_name = "hybrid_gmlp_mla_memory_moe_block"


def rms_norm(t, g):
    t32 = t.astype(jnp.float32)
    y = t32 * lax.rsqrt(jnp.mean(t32 * t32, axis=-1, keepdims=True) + EPS)
    return (y * g.astype(jnp.float32)).astype(t.dtype)


def layer_norm(t, g, b):
    t32 = t.astype(jnp.float32)
    mu = jnp.mean(t32, axis=-1, keepdims=True)
    c = t32 - mu
    y = c * lax.rsqrt(jnp.mean(c * c, axis=-1, keepdims=True) + EPS)
    return (y * g.astype(jnp.float32) + b.astype(jnp.float32)).astype(t.dtype)


def rope_tables(positions):
    inv = 1.0 / (ROPE_THETA ** (jnp.arange(0, QK_ROPE, 2, dtype=jnp.float32) / QK_ROPE))
    ang = positions.astype(jnp.float32)[..., None] * inv
    return jnp.cos(ang)[:, :, None, :], jnp.sin(ang)[:, :, None, :]


def apply_rope(t, cos, sin):
    half = t.shape[-1] // 2
    t32 = t.astype(jnp.float32)
    t1, t2 = t32[..., :half], t32[..., half:]
    return jnp.concatenate([t1 * cos - t2 * sin, t1 * sin + t2 * cos], axis=-1).astype(t.dtype)


def gmlp_branch(u, v, ln_g, ln_b, w_s, b_s):
    B, S, _ = v.shape
    v = layer_norm(v, ln_g, ln_b)
    cg = GM_WIDTH // GM_GROUPS
    vc = v.reshape(B, S // GM_CHUNK, GM_CHUNK, GM_GROUPS, cg)
    causal = jnp.tril(jnp.ones((GM_CHUNK, GM_CHUNK), dtype=bool))
    w = jnp.where(causal[None], w_s, jnp.zeros_like(w_s)).astype(v.dtype)
    mixed = jnp.einsum('gts,bnsgc->bntgc', w, vc) + b_s.T.astype(v.dtype)[:, :, None]
    return u * mixed.reshape(B, S, GM_WIDTH)


def causal_block_attention(q, k, v, scale):
    B, S, H, Dq = q.shape
    n_blocks = S // Q_BLOCK
    qb = q.reshape(B, n_blocks, Q_BLOCK, H, Dq).transpose(1, 0, 2, 3, 4)
    key_pos = jnp.arange(S)

    def attend(args):
        q_blk, i = args
        s = jnp.einsum('bqhd,bkhd->bhqk', q_blk, k).astype(jnp.float32) * scale
        q_pos = i * Q_BLOCK + jnp.arange(Q_BLOCK)
        mask = key_pos[None, :] <= q_pos[:, None]
        s = jnp.where(mask[None, None], s, -jnp.inf)
        p = jax.nn.softmax(s, axis=-1).astype(v.dtype)
        return jnp.einsum('bhqk,bkhd->bqhd', p, v)

    o = lax.map(attend, (qb, jnp.arange(n_blocks)))
    return o.transpose(1, 0, 2, 3, 4).reshape(B, S, H, v.shape[-1])


def mla_branch(c_q, c_kv, k_rope, cos, sin, cq_g, w_uq, ckv_g, w_ukv, qn_g, kn_g):
    B, S, _ = c_q.shape
    H = MLA_HEADS
    q = (rms_norm(c_q, cq_g) @ w_uq).reshape(B, S, H, QK_DIM)
    kv = (rms_norm(c_kv, ckv_g) @ w_ukv).reshape(B, S, H, QK_NOPE + V_DIM)
    k_nope, v = kv[..., :QK_NOPE], kv[..., QK_NOPE:]
    k = jnp.concatenate([k_nope, jnp.broadcast_to(k_rope[:, :, None, :], (B, S, H, QK_ROPE))], axis=-1)
    q = rms_norm(q, qn_g)
    k = rms_norm(k, kn_g)
    q = jnp.concatenate([q[..., :QK_NOPE], apply_rope(q[..., QK_NOPE:], cos, sin)], axis=-1)
    k = jnp.concatenate([k[..., :QK_NOPE], apply_rope(k[..., QK_NOPE:], cos, sin)], axis=-1)
    o = causal_block_attention(q, k, v, MLA_SCALE)
    return o.reshape(B, S, H * V_DIM)


def memory_branch(q_mem, mem, mem_g, w_k, w_v, qn_g, kn_g):
    B, S, _ = q_mem.shape
    M = mem.shape[1]
    m = rms_norm(mem, mem_g)
    q = rms_norm(q_mem.reshape(B, S, MEM_HEADS, MEM_HEAD_DIM), qn_g)
    k = rms_norm((m @ w_k).reshape(B, M, MEM_HEADS, MEM_HEAD_DIM), kn_g)
    v = (m @ w_v).reshape(B, M, MEM_HEADS, MEM_HEAD_DIM)
    s = jnp.einsum('bqhd,bkhd->bhqk', q, k).astype(jnp.float32) * MEM_SCALE
    p = jax.nn.softmax(s, axis=-1).astype(v.dtype)
    o = jnp.einsum('bhqk,bkhd->bqhd', p, v)
    return o.reshape(B, S, MEM_WIDTH)


def clamped_swiglu_expert(xb, w_gu, b_gu, w_down, b_down):
    gu = xb @ w_gu + b_gu
    gate, up = gu[..., :D_FF], gu[..., D_FF:]
    gate = jnp.minimum(gate, SWIGLU_LIMIT)
    up = jnp.clip(up, -SWIGLU_LIMIT, SWIGLU_LIMIT)
    glu = gate * jax.nn.sigmoid(gate * SWIGLU_ALPHA)
    return ((up + 1.0) * glu) @ w_down + b_down


def moe(h, router_w, router_b, w_gu, b_gu, w_down, b_down):
    T, D = h.shape
    logits = (h @ router_w + router_b).astype(jnp.float32)
    top_vals, top_idx = lax.top_k(logits, TOP_K)
    gates = jax.nn.softmax(top_vals, axis=-1).astype(h.dtype)
    flat_e = top_idx.reshape(-1).astype(jnp.int32)
    flat_tok = jnp.repeat(jnp.arange(T, dtype=jnp.int32), TOP_K)
    flat_g = gates.reshape(-1)
    order = jnp.argsort(flat_e)
    e_sorted = flat_e[order]
    counts = jnp.bincount(flat_e, length=N_EXPERTS).astype(jnp.int32)
    starts = jnp.cumsum(counts) - counts
    padded = ((counts + ROW_BLOCK - 1) // ROW_BLOCK) * ROW_BLOCK
    pad_ends = jnp.cumsum(padded)
    pad_starts = pad_ends - padded
    rank = jnp.arange(T * TOP_K, dtype=jnp.int32) - starts[e_sorted]
    dest = pad_starts[e_sorted] + rank
    n_rows = T * TOP_K + N_EXPERTS * ROW_BLOCK
    n_blocks = n_rows // ROW_BLOCK
    row_tok = jnp.full((n_rows,), T, dtype=jnp.int32).at[dest].set(flat_tok[order])
    row_gate = jnp.zeros((n_rows,), h.dtype).at[dest].set(flat_g[order])
    block_start = jnp.arange(n_blocks, dtype=jnp.int32) * ROW_BLOCK
    block_e = jnp.minimum(jnp.searchsorted(pad_ends, block_start, side='right'), N_EXPERTS - 1)
    h_pad = jnp.concatenate([h, jnp.zeros((1, D), h.dtype)], axis=0)

    def run_block(args):
        tok, e = args
        return clamped_swiglu_expert(h_pad[tok], w_gu[e], b_gu[e], w_down[e], b_down[e])

    ys = lax.map(run_block, (row_tok.reshape(n_blocks, ROW_BLOCK), block_e))
    ys = ys.reshape(n_rows, D) * row_gate[:, None]
    out = jnp.zeros((T + 1, D), ys.dtype).at[row_tok].add(ys)
    return out[:T]


def setup_inputs(seed: int = 0) -> dict:
    key = jax.random.key(seed)
    ks = iter(jax.random.split(key, 48))
    f32 = jnp.float32

    def nrm(shape, scale):
        return jax.random.normal(next(ks), shape, f32) * scale

    def gain(shape):
        return 1.0 + 0.1 * jax.random.normal(next(ks), shape, f32)

    L = DEPTH
    x = nrm((BATCH, SEQ, D_MODEL), 1.0)
    mem = nrm((BATCH, MEM_LEN, D_MODEL), 1.0)
    offs = jax.random.randint(next(ks), (BATCH, 1), 0, 1024, dtype=jnp.int32)
    positions = offs + jnp.arange(SEQ, dtype=jnp.int32)[None, :]
    return {
        "x": x,
        "mem": mem,
        "positions": positions,
        "ln1_g": gain((L, D_MODEL)),
        "w_in": nrm((L, D_MODEL, IN_COLS), D_MODEL ** -0.5),
        "w_gate": nrm((L, D_MODEL, N_BRANCH * D_MODEL), D_MODEL ** -0.5),
        "b_gate": nrm((L, N_BRANCH * D_MODEL), 0.1),
        "gmlp_ln_g": gain((L, GM_WIDTH)),
        "gmlp_ln_b": nrm((L, GM_WIDTH), 0.02),
        "gmlp_ws": nrm((L, GM_GROUPS, GM_CHUNK, GM_CHUNK), GM_CHUNK ** -0.5),
        "gmlp_bs": gain((L, GM_GROUPS, GM_CHUNK)),
        "w_pa": nrm((L, GM_WIDTH, D_MODEL), GM_WIDTH ** -0.5),
        "mla_cq_g": gain((L, Q_LORA)),
        "mla_w_uq": nrm((L, Q_LORA, MLA_HEADS * QK_DIM), Q_LORA ** -0.5),
        "mla_ckv_g": gain((L, KV_LORA)),
        "mla_w_ukv": nrm((L, KV_LORA, MLA_HEADS * (QK_NOPE + V_DIM)), KV_LORA ** -0.5),
        "mla_qn_g": gain((L, QK_DIM)),
        "mla_kn_g": gain((L, QK_DIM)),
        "w_pb": nrm((L, MLA_HEADS * V_DIM, D_MODEL), (MLA_HEADS * V_DIM) ** -0.5),
        "mem_ln_g": gain((L, D_MODEL)),
        "mem_w_k": nrm((L, D_MODEL, MEM_WIDTH), D_MODEL ** -0.5),
        "mem_w_v": nrm((L, D_MODEL, MEM_WIDTH), D_MODEL ** -0.5),
        "mem_qn_g": gain((L, MEM_HEAD_DIM)),
        "mem_kn_g": gain((L, MEM_HEAD_DIM)),
        "w_pc": nrm((L, MEM_WIDTH, D_MODEL), MEM_WIDTH ** -0.5),
        "w_o": nrm((L, D_MODEL, D_MODEL), D_MODEL ** -0.5),
        "ln2_g": gain((L, D_MODEL)),
        "router_w": nrm((L, D_MODEL, N_EXPERTS), D_MODEL ** -0.5),
        "router_b": nrm((L, N_EXPERTS), 0.01),
        "moe_w_gu": nrm((L, N_EXPERTS, D_MODEL, 2 * D_FF), D_MODEL ** -0.5),
        "moe_b_gu": nrm((L, N_EXPERTS, 2 * D_FF), 0.01),
        "moe_w_down": nrm((L, N_EXPERTS, D_FF, D_MODEL), D_FF ** -0.5),
        "moe_b_down": nrm((L, N_EXPERTS, D_MODEL), 0.01),
    }


def reference(x, mem, positions, ln1_g, w_in, w_gate, b_gate,
              gmlp_ln_g, gmlp_ln_b, gmlp_ws, gmlp_bs, w_pa,
              mla_cq_g, mla_w_uq, mla_ckv_g, mla_w_ukv, mla_qn_g, mla_kn_g, w_pb,
              mem_ln_g, mem_w_k, mem_w_v, mem_qn_g, mem_kn_g, w_pc,
              w_o, ln2_g, router_w, router_b, moe_w_gu, moe_b_gu, moe_w_down, moe_b_down):
    B, S, D = x.shape
    cos, sin = rope_tables(positions)
    splits = [GM_WIDTH, 2 * GM_WIDTH, 2 * GM_WIDTH + Q_LORA,
              2 * GM_WIDTH + Q_LORA + KV_LORA, 2 * GM_WIDTH + Q_LORA + KV_LORA + QK_ROPE]
    for l in range(DEPTH):
        h = rms_norm(x, ln1_g[l])
        proj = h @ w_in[l]
        u, v, c_q, c_kv, k_rope, q_mem = jnp.split(proj, splits, axis=-1)
        a = gmlp_branch(u, v, gmlp_ln_g[l], gmlp_ln_b[l], gmlp_ws[l], gmlp_bs[l])
        b = mla_branch(c_q, c_kv, k_rope, cos, sin, mla_cq_g[l], mla_w_uq[l],
                       mla_ckv_g[l], mla_w_ukv[l], mla_qn_g[l], mla_kn_g[l])
        c = memory_branch(q_mem, mem, mem_ln_g[l], mem_w_k[l], mem_w_v[l], mem_qn_g[l], mem_kn_g[l])
        g = jax.nn.sigmoid(h @ w_gate[l] + b_gate[l]).reshape(B, S, N_BRANCH, D)
        merged = (g[:, :, 0] * (a @ w_pa[l])
                  + g[:, :, 1] * (b @ w_pb[l])
                  + g[:, :, 2] * (c @ w_pc[l]))
        x = x + merged @ w_o[l]
        h2 = rms_norm(x, ln2_g[l]).reshape(B * S, D)
        y = moe(h2, router_w[l], router_b[l], moe_w_gu[l], moe_b_gu[l], moe_w_down[l], moe_b_down[l])
        x = x + y.reshape(B, S, D)
    return x
```

```cpp
#include <hip/hip_runtime.h>
#include <cstdio>
#include <cstdint>
#include <cmath>
constexpr int NWAVES = 8;
constexpr int T = 16384, D = 2048, NBATCH = 4, SEQ = 4096;
constexpr int P1N = 10496;
constexpr int P1_U = 0, P1_V = 1024, P1_CQ = 2048, P1_CKV = 2560, P1_QM = 3072, P1_KR = 4096, P1_G = 4352;
constexpr int P1_TILES = 41, MEMROWS = 1024;
constexpr int NH = 16, QKD = 192, NOPE = 128, ROPE = 64, VD = 128;
constexpr int NE = 32, DFF = 2048, MAXBLK = 288, MAXSLOT = MAXBLK * 256;
constexpr float EPS = 1e-6f;
constexpr float LOG2E = 1.4426950408889634f;
constexpr float MLA_QSCALE = 0.07216878364870322f * LOG2E;
constexpr float MEM_QSCALE = 0.0625f * LOG2E;

constexpr size_t MiB = 1u << 20;
constexpr size_t WS_CTL = 0, CTL_ZERO_BYTES = 1 * MiB;
constexpr size_t WS_W1T   = 1 * MiB;
constexpr size_t WS_WUQT  = WS_W1T + (size_t)(P1N + 2048) * 2048 * 2;
constexpr size_t WS_WUKVT = WS_WUQT + (size_t)3072 * 512 * 2;
constexpr size_t WS_WPAT  = WS_WUKVT + (size_t)4096 * 512 * 2;
constexpr size_t WS_WPBT  = WS_WPAT + (size_t)2048 * 1024 * 2;
constexpr size_t WS_WPCT  = WS_WPBT + (size_t)2048 * 2048 * 2;
constexpr size_t WS_WOT   = WS_WPCT + (size_t)2048 * 1024 * 2;
constexpr size_t WS_WGUT  = WS_WOT + (size_t)2048 * 2048 * 2;
constexpr size_t WS_WDT   = WS_WGUT + (size_t)NE * 4096 * 2048 * 2;
constexpr size_t WS_WSM   = WS_WDT + (size_t)NE * 2048 * 2048 * 2;
constexpr size_t WS_RWG   = WS_WSM + (size_t)8 * 128 * 128 * 2;
constexpr size_t WS_H     = WS_RWG + (size_t)2048 * 32 * 4;
constexpr size_t WS_P1    = WS_H + (size_t)(T + MEMROWS) * 2048 * 2;
constexpr size_t WS_MKV   = WS_P1 + (size_t)T * P1N * 2;
constexpr size_t WS_VSTAT = WS_MKV + (size_t)MEMROWS * 2048 * 2;
constexpr size_t WS_CQN   = WS_VSTAT + (size_t)T * 8;
constexpr size_t WS_CKVN  = WS_CQN + (size_t)T * 512 * 2;
constexpr size_t WS_QMN   = WS_CKVN + (size_t)T * 512 * 2;
constexpr size_t WS_KRR   = WS_QMN + (size_t)T * 1024 * 2;
constexpr size_t WS_KRSS  = WS_KRR + (size_t)T * 64 * 4;
constexpr size_t WS_ROPE  = WS_KRSS + (size_t)T * 4;
constexpr size_t WS_MKT   = WS_ROPE + (size_t)T * 64 * 4;
constexpr size_t WS_MVT   = WS_MKT + (size_t)MEMROWS * 1024 * 2;
constexpr size_t WS_QRAW  = WS_MVT + (size_t)MEMROWS * 1024 * 2;
constexpr size_t WS_KVRAW = WS_QRAW + (size_t)T * 3072 * 2;
constexpr size_t WS_QF    = WS_KVRAW + (size_t)T * 4096 * 2;
constexpr size_t WS_KFT   = WS_QF + (size_t)T * 3072 * 2;
constexpr size_t WS_VFT   = WS_KFT + (size_t)T * 3072 * 2;
constexpr size_t WS_AOUT  = WS_VFT + (size_t)T * 2048 * 2;
constexpr size_t WS_BATT  = WS_AOUT + (size_t)T * 1024 * 2;
constexpr size_t WS_CATT  = WS_BATT + (size_t)T * 2048 * 2;
constexpr size_t WS_MERGED= WS_CATT + (size_t)T * 1024 * 2;
constexpr size_t WS_X1    = WS_MERGED + (size_t)T * 2048 * 2;
constexpr size_t WS_TKE   = WS_X1 + (size_t)T * 2048 * 4;
constexpr size_t WS_TKR   = WS_TKE + (size_t)T * 16;
constexpr size_t WS_TKG   = WS_TKR + (size_t)T * 16;
constexpr size_t WS_HS    = WS_TKG + (size_t)T * 16;
constexpr size_t WS_ACT   = WS_HS + (size_t)MAXSLOT * 2048 * 2;
constexpr size_t WS_Y     = WS_ACT + (size_t)MAXSLOT * 2048 * 2;
constexpr size_t WS_END   = WS_Y + (size_t)MAXSLOT * 2048 * 2;
constexpr int CW_TMO = 0, CW_CODE = 1;
constexpr int CW_CNT = 64;
constexpr int CW_BAR = 4096;

constexpr int RING_OFF = 0, RING_BYTES = 133120;
constexpr int LDSCTL_OFF = RING_BYTES, MISC_OFF = LDSCTL_OFF + 320;
constexpr int LTAB_OFF = LDSCTL_OFF + 1024;
constexpr int LDS_BYTES = 147456;
namespace pg8 {
#define PG8_LAS __attribute__((address_space(3)))
typedef unsigned short bf16_t;
typedef short bf16x8 __attribute__((ext_vector_type(8)));
typedef float f32x4 __attribute__((ext_vector_type(4)));
typedef unsigned u32x4 __attribute__((ext_vector_type(4)));
constexpr int BM = 256, BK = 64, HALF = 128, HTB = HALF * BK * 2  , STAGE_BYTES = 8 * HTB, NXCD = 8, WGM = 8;

__host__ __device__ __forceinline__ int lds_byte(int r, int c) { const int st = (r >> 4) * 2 + (c >> 5), rr = r & 15, cc = c & 31, ob = rr * 64 + cc * 2; return st * 1024 + (ob ^ (((ob >> 9) & 1) << 5)); }
__host__ __device__ __forceinline__ void stage_rc(int b, int& R, int& C) { const int st = b / 1024, sb = b % 1024, swz = sb ^ (((sb >> 9) & 1) << 5); R = (st >> 1) * 16 + swz / 64; C = (st & 1) * 32 + (swz % 64) / 2; }
__host__ __device__ __forceinline__ int perm32(int rho) { const int n = rho >> 4, i = rho & 15; return 8 * (i >> 2) + 4 * n + (i & 3); }

struct Unit { int pm, pn; };
struct Gemm { const bf16_t* A; const bf16_t* Bt; int M, N, K, lda; };

struct StaticOrder {
    int nM, nN, nwg, G, c;
    __host__ __device__ void init(int M, int N, int G_, int c_) { nM = M / BM; nN = N / BM; nwg = nM * nN; G = G_; c = c_; }
    __host__ __device__ bool next(int i, Unit& u) const {
        const long L = (long)i * G + c; if (L >= nwg) return false;
        int wgid = (int)L; { const int q = nwg / NXCD, r = nwg % NXCD, xcd = wgid % NXCD, off = wgid / NXCD; wgid = (xcd < r ? xcd * (q + 1) : r * (q + 1) + (xcd - r) * q) + off; }
        const int nig = WGM * nN, gid = wgid / nig, fm = gid * WGM, gsz = (nM - fm) < WGM ? (nM - fm) : WGM;
        u.pm = fm + ((wgid % nig) % gsz); u.pn = (wgid % nig) / gsz; return true;
    }
    __device__ __forceinline__ void a_ready(const Unit&) const {}
    __device__ __forceinline__ void done(const Unit&) const {}
};

__device__ __forceinline__ unsigned cvt_pk_bf16(float lo, float hi) { unsigned r; asm volatile("v_cvt_pk_bf16_f32 %0, %1, %2" : "=v"(r) : "v"(lo), "v"(hi)); return r; }
typedef float f32x2 __attribute__((ext_vector_type(2)));
template <class Epi, class Sched, bool ALIGN_EPI = false, bool SP2 = false>
__device__ __forceinline__ void gemm_phase(PG8_LAS unsigned char* lds, const Gemm g, const Sched& S, const Epi& E) {
    int tid_ = threadIdx.x; asm volatile("" : "+v"(tid_));
    const int tid = tid_, wid = __builtin_amdgcn_readfirstlane(tid >> 6), lane = tid & 63, wr = wid >> 2, wc = wid & 3, fr = lane & 15, fq = lane >> 4;
    const int K = g.K, nt = K / BK;
    unsigned voffA[2], voffB[2];
#pragma unroll
    for (int i = 0; i < 2; ++i) { int R, C; stage_rc(tid * 16 + i * 8192, R, C); const int Rb = Epi::PERM ? ((R & ~31) + perm32(R & 31)) : R;
        voffA[i] = (unsigned)(R * g.lda + C) * 2u; voffB[i] = (unsigned)(Rb * K + C) * 2u; }
    const size_t kstep = (size_t)(BK * 2);
    const size_t hstepA = (size_t)HALF * g.lda * 2, hstepB = (size_t)HALF * K * 2;
    const size_t tstepA = 2 * hstepA, tstepB = 2 * hstepB;
    const unsigned ldsw = (unsigned)wid * 1024u;
    const int aoff = lds_byte(wr * 64 + fr, fq * 8), boff = lds_byte(wc * 32 + fr, fq * 8);
#define PG8_SA(b, h) (((b) * 2 + (h)) * HTB)
#define PG8_SB(b, h) ((4 + (b) * 2 + (h)) * HTB)
#define PG8_STAGE(bufoff, gbase, voff) do { _Pragma("unroll") for (int _i = 0; _i < 2; ++_i) \
        __builtin_amdgcn_global_load_lds((const unsigned*)((const char*)(gbase) + (voff)[_i]), (PG8_LAS unsigned*)(lds + (bufoff) + ldsw + _i * 8192), 16, 0, 0); } while (0)
#define PG8_LDA(dst, b, h) do { _Pragma("unroll") for (int m = 0; m < 4; ++m) _Pragma("unroll") for (int k = 0; k < 2; ++k) dst[m][k] = *(const PG8_LAS bf16x8*)(lds + PG8_SA(b, h) + aoff + m * 2048 + k * 1024); } while (0)
#define PG8_LDB(dst, b, h) do { _Pragma("unroll") for (int n = 0; n < 2; ++n) _Pragma("unroll") for (int k = 0; k < 2; ++k) dst[n][k] = *(const PG8_LAS bf16x8*)(lds + PG8_SB(b, h) + boff + n * 2048 + k * 1024); } while (0)
#define PG8_MMA(ai, bj, At, Bt) do { __builtin_amdgcn_s_setprio(1); _Pragma("unroll") for (int m = 0; m < 4; ++m) _Pragma("unroll") for (int n = 0; n < 2; ++n) _Pragma("unroll") for (int k = 0; k < 2; ++k) \
        acc[ai][bj][m][n] = __builtin_amdgcn_mfma_f32_16x16x32_bf16(Bt[n][k], At[m][k], acc[ai][bj][m][n], 0, 0, 0); __builtin_amdgcn_s_setprio(0); } while (0)
#define PG8_WAIT_V(n) asm volatile("s_waitcnt vmcnt(" #n ")" ::: "memory")
#define PG8_WAIT_L(n) asm volatile("s_waitcnt lgkmcnt(" #n ")" ::: "memory")
#define PG8_BAR __builtin_amdgcn_s_barrier()
#define PG8_SCHED __builtin_amdgcn_sched_barrier(0)
    Unit cur, nxt; int ui = 0;
    if (!S.next(0, cur)) return;
    f32x4 acc[2][2][4][2];
#pragma unroll
    for (int a = 0; a < 2; ++a)
#pragma unroll
        for (int b = 0; b < 2; ++b)
#pragma unroll
            for (int m = 0; m < 4; ++m)
#pragma unroll
                for (int n = 0; n < 2; ++n) acc[a][b][m][n] = (f32x4){0.f, 0.f, 0.f, 0.f};
    bf16x8 At[4][2], B0[2][2], B1[2][2];
    const char* cA = (const char*)g.A + (size_t)cur.pm * tstepA; const char* cB = (const char*)g.Bt + (size_t)cur.pn * tstepB;
    S.a_ready(cur);
    if constexpr (SP2) {
        PG8_STAGE(PG8_SB(0, 0), cB, voffB); PG8_STAGE(PG8_SB(0, 1), cB + hstepB, voffB); PG8_STAGE(PG8_SA(0, 0), cA, voffA); PG8_STAGE(PG8_SA(0, 1), cA + hstepA, voffA);
        if (wr == 1) PG8_BAR;
        PG8_WAIT_V(2); PG8_BAR;
        PG8_STAGE(PG8_SB(1, 0), cB + kstep, voffB); PG8_STAGE(PG8_SA(1, 0), cA + kstep, voffA); PG8_STAGE(PG8_SB(1, 1), cB + hstepB + kstep, voffB);
        PG8_WAIT_V(6); PG8_BAR;
    } else {
        PG8_STAGE(PG8_SB(0, 0), cB, voffB); PG8_STAGE(PG8_SA(0, 0), cA, voffA); PG8_STAGE(PG8_SB(0, 1), cB + hstepB, voffB); PG8_STAGE(PG8_SA(0, 1), cA + hstepA, voffA);
        if (wr == 1) PG8_BAR;
        PG8_WAIT_V(4); PG8_BAR;
        PG8_STAGE(PG8_SB(1, 0), cB + kstep, voffB); PG8_STAGE(PG8_SA(1, 0), cA + kstep, voffA); PG8_STAGE(PG8_SB(1, 1), cB + hstepB + kstep, voffB);
        PG8_WAIT_V(6); PG8_BAR;
    }
    for (;;) {
        const bool has_next = S.next(ui + 1, nxt);
        const char* nA = has_next ? (const char*)g.A + (size_t)nxt.pm * tstepA : cA; const char* nB = has_next ? (const char*)g.Bt + (size_t)nxt.pn * tstepB : cB;
        for (int t = 0; t < nt; t += 2) {
            const bool last = (t == nt - 2);
            const char* a1 = cA + (size_t)(t + 1) * kstep;
            const char* a2 = last ? nA : cA + (size_t)(t + 2) * kstep; const char* b2 = last ? nB : cB + (size_t)(t + 2) * kstep;
            const char* a3 = a2 + kstep; const char* b3 = b2 + kstep;
            if (last && has_next) S.a_ready(nxt);
            if constexpr (SP2) {
            PG8_LDB(B0, 0, 0); PG8_LDB(B1, 0, 1); PG8_SCHED; PG8_LDA(At, 0, 0); PG8_STAGE(PG8_SA(1, 1), a1 + hstepA, voffA);
            PG8_WAIT_V(8); PG8_WAIT_L(0); PG8_BAR; PG8_MMA(0, 0, At, B0); PG8_MMA(0, 1, At, B1); PG8_BAR; PG8_SCHED;
            PG8_LDA(At, 0, 1); PG8_STAGE(PG8_SB(0, 0), b2, voffB); PG8_STAGE(PG8_SB(0, 1), b2 + hstepB, voffB); PG8_STAGE(PG8_SA(0, 0), a2, voffA);
            PG8_WAIT_V(8); PG8_WAIT_L(0); PG8_BAR; PG8_MMA(1, 0, At, B0); PG8_MMA(1, 1, At, B1); PG8_BAR; PG8_SCHED;
            PG8_LDB(B0, 1, 0); PG8_LDB(B1, 1, 1); PG8_SCHED; PG8_LDA(At, 1, 0); PG8_STAGE(PG8_SA(0, 1), a2 + hstepA, voffA);
            PG8_WAIT_V(8); PG8_WAIT_L(0); PG8_BAR; PG8_MMA(0, 0, At, B0); PG8_MMA(0, 1, At, B1); PG8_BAR; PG8_SCHED;
            PG8_LDA(At, 1, 1); PG8_STAGE(PG8_SB(1, 0), b3, voffB); PG8_STAGE(PG8_SB(1, 1), b3 + hstepB, voffB); PG8_STAGE(PG8_SA(1, 0), a3, voffA);
            PG8_WAIT_V(8); PG8_WAIT_L(0); PG8_BAR; PG8_MMA(1, 0, At, B0); PG8_MMA(1, 1, At, B1); PG8_BAR; PG8_SCHED;
            } else {
            PG8_LDB(B0, 0, 0); PG8_SCHED; PG8_LDA(At, 0, 0); PG8_STAGE(PG8_SA(1, 1), a1 + hstepA, voffA);
            PG8_WAIT_L(8); PG8_BAR; PG8_WAIT_L(0); PG8_MMA(0, 0, At, B0); PG8_BAR; PG8_SCHED;
            PG8_LDB(B1, 0, 1); PG8_STAGE(PG8_SB(0, 0), b2, voffB);
            PG8_BAR; PG8_WAIT_L(0); PG8_MMA(0, 1, At, B1); PG8_BAR;
            PG8_LDA(At, 0, 1); PG8_STAGE(PG8_SA(0, 0), a2, voffA);
            PG8_BAR; PG8_WAIT_L(0); PG8_MMA(1, 0, At, B0); PG8_BAR; PG8_SCHED;
            PG8_STAGE(PG8_SB(0, 1), b2 + hstepB, voffB);
            PG8_WAIT_V(6); PG8_BAR; PG8_MMA(1, 1, At, B1); PG8_BAR;
            PG8_LDB(B0, 1, 0); PG8_SCHED; PG8_LDA(At, 1, 0); PG8_STAGE(PG8_SA(0, 1), a2 + hstepA, voffA);
            PG8_WAIT_L(8); PG8_BAR; PG8_WAIT_L(0); PG8_MMA(0, 0, At, B0); PG8_BAR; PG8_SCHED;
            PG8_LDB(B1, 1, 1); PG8_STAGE(PG8_SB(1, 0), b3, voffB);
            PG8_BAR; PG8_WAIT_L(0); PG8_MMA(0, 1, At, B1); PG8_BAR;
            PG8_LDA(At, 1, 1); PG8_STAGE(PG8_SA(1, 0), a3, voffA);
            PG8_BAR; PG8_WAIT_L(0); PG8_MMA(1, 0, At, B0); PG8_BAR; PG8_SCHED;
            PG8_STAGE(PG8_SB(1, 1), b3 + hstepB, voffB);
            PG8_WAIT_V(6); PG8_BAR; PG8_MMA(1, 1, At, B1); PG8_BAR;
            }
        }
        if constexpr (ALIGN_EPI) { if (wr == 0) PG8_BAR; }
        if constexpr (!Epi::AFTER_DRAIN) { E(acc, cur, wr, wc, fr, fq); S.done(cur); }
        if (!has_next) break;
#pragma unroll
        for (int a = 0; a < 2; ++a)
#pragma unroll
            for (int b = 0; b < 2; ++b)
#pragma unroll
                for (int m = 0; m < 4; ++m)
#pragma unroll
                    for (int n = 0; n < 2; ++n) acc[a][b][m][n] = (f32x4){0.f, 0.f, 0.f, 0.f};
        cur = nxt; cA = nA; cB = nB; ++ui;
        if constexpr (ALIGN_EPI) { if (wr == 1) PG8_BAR; }
    }
    PG8_WAIT_V(0);
    if constexpr (!ALIGN_EPI) { if (wr == 0) PG8_BAR; }
    PG8_BAR;
    if constexpr (Epi::AFTER_DRAIN) { E.fused(acc, cur, wr, wc, fr, fq, lds, wid, lane); S.done(cur); }
#undef PG8_SA
#undef PG8_SB
#undef PG8_STAGE
#undef PG8_LDA
#undef PG8_LDB
#undef PG8_MMA
#undef PG8_WAIT_V
#undef PG8_WAIT_L
#undef PG8_BAR
#undef PG8_SCHED
}
}
namespace pg8 {
__device__ __forceinline__ float sigm(float z) { return __builtin_amdgcn_rcpf(1.0f + __builtin_amdgcn_exp2f(-z * 1.4426950408889634f)); }
__device__ __forceinline__ u32x4 pack8(const f32x4 v0, const f32x4 v1) { u32x4 w; w.x = cvt_pk_bf16(v0[0], v0[1]); w.y = cvt_pk_bf16(v0[2], v0[3]); w.z = cvt_pk_bf16(v1[0], v1[1]); w.w = cvt_pk_bf16(v1[2], v1[3]); return w; }
__device__ __forceinline__ f32x4 bf_lo4(const u32x4 w) { f32x4 r; r[0] = __uint_as_float(w.x << 16); r[1] = __uint_as_float(w.x & 0xffff0000u); r[2] = __uint_as_float(w.y << 16); r[3] = __uint_as_float(w.y & 0xffff0000u); return r; }
__device__ __forceinline__ f32x4 bf_hi4(const u32x4 w) { f32x4 r; r[0] = __uint_as_float(w.z << 16); r[1] = __uint_as_float(w.z & 0xffff0000u); r[2] = __uint_as_float(w.w << 16); r[3] = __uint_as_float(w.w & 0xffff0000u); return r; }


struct EpiP1 {
    static constexpr bool PERM = true, AFTER_DRAIN = false;
    bf16_t* P1; bf16_t* MKV; const float* bgate;
    __device__ __forceinline__ void operator()(const f32x4 (&acc)[2][2][4][2], const Unit& u, int wr, int wc, int fr, int fq) const {
        const bool mem = u.pn >= 41, gate = (!mem) && u.pn >= 17;
        bf16_t* base = mem ? MKV + (size_t)((u.pm - 64) * BM + wr * 64 + fr) * 2048 + (u.pn - 41) * BM : P1 + (size_t)(u.pm * BM + wr * 64 + fr) * 10496 + u.pn * BM;
        const size_t ldc = mem ? 2048 : 10496;
        base += wc * 32 + 8 * fq;
        f32x4 bv[2][2];
#pragma unroll
        for (int bj = 0; bj < 2; ++bj)
#pragma unroll
            for (int n = 0; n < 2; ++n) bv[bj][n] = gate ? *(const f32x4*)(bgate + (u.pn - 17) * BM + wc * 32 + 8 * fq + bj * HALF + 4 * n) : (f32x4){0.f, 0.f, 0.f, 0.f};
#pragma unroll
        for (int ai = 0; ai < 2; ++ai)
#pragma unroll
            for (int m = 0; m < 4; ++m) { bf16_t* rowp = base + (size_t)(ai * HALF + m * 16) * ldc;
#pragma unroll
                for (int bj = 0; bj < 2; ++bj) { f32x4 v0 = acc[ai][bj][m][0] + bv[bj][0], v1 = acc[ai][bj][m][1] + bv[bj][1];
                    if (gate) {
#pragma unroll
                        for (int i = 0; i < 4; ++i) { v0[i] = sigm(v0[i]); v1[i] = sigm(v1[i]); } }
                    *(u32x4*)(rowp + bj * HALF) = pack8(v0, v1); } }
    }
};
struct EpiPlain {
    static constexpr bool PERM = true, AFTER_DRAIN = false;
    bf16_t* O; int ldc;
    __device__ __forceinline__ void operator()(const f32x4 (&acc)[2][2][4][2], const Unit& u, int wr, int wc, int fr, int fq) const {
        bf16_t* base = O + (size_t)(u.pm * BM + wr * 64 + fr) * ldc + u.pn * BM + wc * 32 + 8 * fq;
#pragma unroll
        for (int ai = 0; ai < 2; ++ai)
#pragma unroll
            for (int m = 0; m < 4; ++m) { bf16_t* rowp = base + (size_t)(ai * HALF + m * 16) * ldc;
#pragma unroll
                for (int bj = 0; bj < 2; ++bj) *(u32x4*)(rowp + bj * HALF) = pack8(acc[ai][bj][m][0], acc[ai][bj][m][1]); }
    }
};
template <bool FIRST> struct EpiGateAcc {
    static constexpr bool PERM = true, AFTER_DRAIN = false;
    const bf16_t* G; int gcol0; bf16_t* Mg;
    __device__ __forceinline__ void operator()(const f32x4 (&acc)[2][2][4][2], const Unit& u, int wr, int wc, int fr, int fq) const {
        const int row0 = u.pm * BM + wr * 64 + fr, col0 = u.pn * BM + wc * 32 + 8 * fq;
#pragma unroll
        for (int ai = 0; ai < 2; ++ai)
#pragma unroll
            for (int m = 0; m < 4; ++m) { const size_t r = (size_t)(row0 + ai * HALF + m * 16);
#pragma unroll
                for (int bj = 0; bj < 2; ++bj) {
                    const u32x4 gw = *(const u32x4*)(G + r * 10496 + gcol0 + col0 + bj * HALF);
                    f32x4 v0 = acc[ai][bj][m][0] * bf_lo4(gw), v1 = acc[ai][bj][m][1] * bf_hi4(gw);
                    bf16_t* mp = Mg + r * 2048 + col0 + bj * HALF;
                    if (!FIRST) { const u32x4 ow = *(const u32x4*)mp; v0 = v0 + bf_lo4(ow); v1 = v1 + bf_hi4(ow); }
                    *(u32x4*)mp = pack8(v0, v1); } }
    }
};
struct EpiX1 {
    static constexpr bool PERM = false, AFTER_DRAIN = false;
    const float* X; float* O;
    __device__ __forceinline__ void operator()(const f32x4 (&acc)[2][2][4][2], const Unit& u, int wr, int wc, int fr, int fq) const {
        const int row0 = u.pm * BM + wr * 64 + fr, col0 = u.pn * BM + wc * 32 + 4 * fq;
#pragma unroll
        for (int ai = 0; ai < 2; ++ai)
#pragma unroll
            for (int m = 0; m < 4; ++m) { const size_t off = (size_t)(row0 + ai * HALF + m * 16) * 2048 + col0;
#pragma unroll
                for (int bj = 0; bj < 2; ++bj)
#pragma unroll
                    for (int n = 0; n < 2; ++n) { const f32x4 xv = *(const f32x4*)(X + off + bj * HALF + n * 16); *(f32x4*)(O + off + bj * HALF + n * 16) = xv + acc[ai][bj][m][n]; } }
    }
};
struct EpiSwiGLU {
    static constexpr bool PERM = true, AFTER_DRAIN = false;
    const float* bgu; bf16_t* ACT;
    __device__ __forceinline__ void operator()(const f32x4 (&acc)[2][2][4][2], const Unit& u, int wr, int wc, int fr, int fq) const {
        const int e = u.pn >> 4, pnl = u.pn & 15, cl = pnl * HALF + wc * 32 + 8 * fq;
        const float* bp = bgu + (size_t)e * 4096 + cl;
        f32x4 bg[2], bu[2];
#pragma unroll
        for (int n = 0; n < 2; ++n) { bg[n] = *(const f32x4*)(bp + 4 * n); bu[n] = *(const f32x4*)(bp + 2048 + 4 * n); }
        bf16_t* base = ACT + (size_t)(u.pm * BM + wr * 64 + fr) * 2048 + cl;
#pragma unroll
        for (int ai = 0; ai < 2; ++ai)
#pragma unroll
            for (int m = 0; m < 4; ++m) { f32x4 o[2];
#pragma unroll
                for (int n = 0; n < 2; ++n) { const f32x4 g4 = acc[ai][0][m][n] + bg[n], u4 = acc[ai][1][m][n] + bu[n];
#pragma unroll
                    for (int i = 0; i < 4; ++i) { const float g = fminf(g4[i], 7.0f), up = fminf(fmaxf(u4[i], -7.0f), 7.0f); o[n][i] = (up + 1.0f) * g * sigm(1.702f * g); } }
                *(u32x4*)(base + (size_t)(ai * HALF + m * 16) * 2048) = pack8(o[0], o[1]); }
    }
};
struct EpiDown {
    static constexpr bool PERM = true, AFTER_DRAIN = false;
    const float* bd; bf16_t* Y;
    __device__ __forceinline__ void operator()(const f32x4 (&acc)[2][2][4][2], const Unit& u, int wr, int wc, int fr, int fq) const {
        const int e = u.pn >> 3, pnl = u.pn & 7, cl = pnl * BM + wc * 32 + 8 * fq;
        const float* bp = bd + (size_t)e * 2048 + cl;
        f32x4 bv[2][2];
#pragma unroll
        for (int bj = 0; bj < 2; ++bj)
#pragma unroll
            for (int n = 0; n < 2; ++n) bv[bj][n] = *(const f32x4*)(bp + bj * HALF + 4 * n);
        bf16_t* base = Y + (size_t)(u.pm * BM + wr * 64 + fr) * 2048 + cl;
#pragma unroll
        for (int ai = 0; ai < 2; ++ai)
#pragma unroll
            for (int m = 0; m < 4; ++m) { bf16_t* rowp = base + (size_t)(ai * HALF + m * 16) * 2048;
#pragma unroll
                for (int bj = 0; bj < 2; ++bj) *(u32x4*)(rowp + bj * HALF) = pack8(acc[ai][bj][m][0] + bv[bj][0], acc[ai][bj][m][1] + bv[bj][1]); }
    }
};

struct P1Order {
    StaticOrder base;
    __device__ void init(int G_, int c_) { base.init(16384, 41 * 256, G_, c_); }
    __device__ bool next(int i, Unit& u) const {
        const long L = (long)i * base.G + base.c;
        if (L < base.nwg) return base.next(i, u);
        const int j = (int)(L - base.nwg); if (j >= 32) return false;
        u.pm = 64 + (j & 3); u.pn = 41 + (j >> 2); return true;
    }
    __device__ __forceinline__ void a_ready(const Unit&) const {}
    __device__ __forceinline__ void done(const Unit&) const {}
};
struct MoeOrder {
    const PG8_LAS int* tab; int NT, x, j;
    __device__ bool next(int i, Unit& u) const {
        const int ntx = NT >> 3, Lx = i * 32 + j, rb = Lx / ntx, s = Lx - rb * ntx;
        if (rb >= tab[32]) return false;
        int e = 0;
        while (tab[e + 1] <= rb) ++e;
        u.pm = rb; u.pn = e * NT + x + 8 * s; return true;
    }
    __device__ __forceinline__ void a_ready(const Unit&) const {}
    __device__ __forceinline__ void done(const Unit&) const {}
};
}
#define GAS __attribute__((address_space(1)))
#define LAS __attribute__((address_space(3)))
typedef unsigned short bf16;
typedef unsigned v4u __attribute__((ext_vector_type(4)));
typedef float f32x4 __attribute__((ext_vector_type(4)));
typedef short bf16x8 __attribute__((ext_vector_type(8)));
typedef GAS unsigned gu32;
typedef GAS unsigned long long gu64;
#define RLX_AGENT __ATOMIC_RELAXED, __HIP_MEMORY_SCOPE_AGENT
#define LDS_WAIT() asm volatile("s_waitcnt lgkmcnt(0)" ::: "memory")
#define VM_WAIT() asm volatile("s_waitcnt vmcnt(0)" ::: "memory")
__device__ __forceinline__ unsigned long long rt() { return __builtin_amdgcn_s_memrealtime(); }
__device__ __forceinline__ unsigned f2bf(float f) { unsigned u = __builtin_bit_cast(unsigned, f); return (u + 0x7fffu + ((u >> 16) & 1u)) >> 16; }
__device__ __forceinline__ unsigned pk2(float lo, float hi) { return f2bf(lo) | (f2bf(hi) << 16); }
#define XB_TMO      128
#define XB_XCNT(j)  (256  + 64 * (j))
#define XB_XSUB(j)  (1280 + 64 * (j))
#define XB_XGEN(j)  (2304 + 64 * (j))
#define XB_TOP      3328
#define XB_TOPGEN   3392
#define XCD_BAR_WORDS 3456
#define XB_SPIN_CAP (1u << 18)

__device__ __forceinline__ unsigned xb_ld(unsigned* p)              { return __hip_atomic_load(p, __ATOMIC_RELAXED, __HIP_MEMORY_SCOPE_AGENT); }
__device__ __forceinline__ unsigned xb_add(unsigned* p, unsigned v) { return __hip_atomic_fetch_add(p, v, __ATOMIC_RELAXED, __HIP_MEMORY_SCOPE_AGENT); }
__device__ __forceinline__ unsigned xb_xcc_id() { return (unsigned)__builtin_amdgcn_s_getreg((3 << 11) | 20) & 0xFu; }
#define XB_SPIN(cond, bar) do { unsigned _sp = 0; while (cond) { __builtin_amdgcn_s_sleep(1); \
    if ((++_sp & 255u) == 0u) { if (xb_ld(&(bar)[XB_TMO])) break; if (_sp > XB_SPIN_CAP) { atomicAdd(&(bar)[XB_TMO], 1u); break; } } } } while (0)

struct XcdBarrier {
    unsigned* bar; unsigned x;
    volatile LAS unsigned* st;
};

__device__ __forceinline__ XcdBarrier xcd_barrier_post(unsigned* bar, volatile LAS unsigned* st) {
    XcdBarrier b; b.bar = bar; b.x = xb_xcc_id(); b.st = st;
    if (threadIdx.x == 0) (void)xb_add(&bar[XB_XCNT(b.x)], 1u);
    return b;
}
__device__ __forceinline__ void xcd_barrier_complete(unsigned* bar, unsigned x, unsigned& nloc, unsigned& nx) {
    const unsigned G = gridDim.x * gridDim.y * gridDim.z;
    unsigned sum, cnt, mine, sp = 0u;
    for (;;) {
        sum = 0u; cnt = 0u; mine = 0u;
#pragma unroll
        for (unsigned j = 0; j < 16; ++j) { const unsigned c = xb_ld(&bar[XB_XCNT(j)]); sum += c; cnt += (c > 0u) ? 1u : 0u; mine = (j == x) ? c : mine; }
        if (sum == G) break;
        __builtin_amdgcn_s_sleep(1);
        if ((++sp & 255u) == 0u) { if (xb_ld(&bar[XB_TMO])) break; if (sp > XB_SPIN_CAP) { atomicAdd(&bar[XB_TMO], 1u); break; } }
    }
    nloc = mine > 0u ? mine : 1u; nx = cnt > 0u ? cnt : 1u;
}

__device__ __forceinline__ void xcd_barrier(const XcdBarrier& b) {
    asm volatile("s_waitcnt vmcnt(0)" ::: "memory");
    __syncthreads();
    if (threadIdx.x == 0) {
        unsigned* bar = b.bar;
        __builtin_amdgcn_s_waitcnt(0);
        unsigned nloc = b.st[0], nx = b.st[1];
        if (nloc == 0u) { xcd_barrier_complete(bar, b.x, nloc, nx); b.st[0] = nloc; b.st[1] = nx; }
        const unsigned old = xb_add(&bar[XB_XSUB(b.x)], 1u);
        const unsigned gen = old / nloc;
        if (old + 1u == (gen + 1u) * nloc) {
            __builtin_amdgcn_fence(__ATOMIC_RELEASE, "agent");
            asm volatile("s_waitcnt vmcnt(0)" ::: "memory");
            const unsigned og = xb_add(&bar[XB_TOP], 1u);
            const unsigned tg = og / nx;
            if (og + 1u == (tg + 1u) * nx) xb_add(&bar[XB_TOPGEN], 1u);
            else XB_SPIN(xb_ld(&bar[XB_TOPGEN]) == tg, bar);
            __builtin_amdgcn_fence(__ATOMIC_ACQUIRE, "agent");
            xb_add(&bar[XB_XGEN(b.x)], 1u);
            asm volatile("s_waitcnt vmcnt(0)" ::: "memory");
        } else {
            XB_SPIN(xb_ld(&bar[XB_XGEN(b.x)]) == gen, bar);
            __builtin_amdgcn_fence(__ATOMIC_ACQUIRE, "agent");
            asm volatile("s_waitcnt vmcnt(0)" ::: "memory");
        }
    }
    __syncthreads();
}
typedef float f32x16 __attribute__((ext_vector_type(16)));
typedef float f32x2 __attribute__((ext_vector_type(2)));
typedef short s16x4 __attribute__((ext_vector_type(4)));
typedef unsigned u32x2 __attribute__((ext_vector_type(2)));
typedef short v4i16_t __attribute__((ext_vector_type(4)));
__device__ __forceinline__ unsigned cvtpk(float lo, float hi) { unsigned r; asm volatile("v_cvt_pk_bf16_f32 %0, %1, %2" : "=v"(r) : "v"(lo), "v"(hi)); return r; }
__device__ __forceinline__ float bflo(unsigned w) { return __uint_as_float(w << 16); }
__device__ __forceinline__ float bfhi(unsigned w) { return __uint_as_float(w & 0xffff0000u); }
__device__ __forceinline__ void unpack8(const v4u w, float (&f)[8]) { f[0] = bflo(w.x); f[1] = bfhi(w.x); f[2] = bflo(w.y); f[3] = bfhi(w.y); f[4] = bflo(w.z); f[5] = bfhi(w.z); f[6] = bflo(w.w); f[7] = bfhi(w.w); }
__device__ __forceinline__ v4u packf8(const float (&f)[8]) { v4u w; w.x = cvtpk(f[0], f[1]); w.y = cvtpk(f[2], f[3]); w.z = cvtpk(f[4], f[5]); w.w = cvtpk(f[6], f[7]); return w; }
__device__ __forceinline__ float wave_sum(float v) {
#pragma unroll
    for (int o = 1; o < 64; o <<= 1) v += __shfl_xor(v, o);
    return v;
}
__device__ __forceinline__ int crow(int r, int hi) { return (r & 3) + 8 * (r >> 2) + 4 * hi; }

__device__ __forceinline__ void transpose_item64(const float* W, size_t ldw, int k0, int n0, bf16* WT, size_t ldt, int r0, LAS float* scr, int lane) {
    const GAS float* src = (const GAS float*)W + (size_t)(k0 + (lane >> 4)) * ldw + n0 + (lane & 15) * 4;
    f32x4 v[16];
#pragma unroll
    for (int i = 0; i < 16; ++i) v[i] = *(const GAS f32x4*)(src + (size_t)(4 * i) * ldw);
#pragma unroll
    for (int i = 0; i < 16; ++i) { LAS float* s = scr + (4 * i + (lane >> 4)) * 65 + (lane & 15) * 4; s[0] = v[i].x; s[1] = v[i].y; s[2] = v[i].z; s[3] = v[i].w; }
    LDS_WAIT(); asm volatile("" ::: "memory");
    const int c = lane & 7;
#pragma unroll
    for (int j = 0; j < 8; ++j) { const int n = (lane >> 3) + 8 * j; const LAS float* s = scr + (8 * c) * 65 + n;
        v4u o; o.x = cvtpk(s[0 * 65], s[1 * 65]); o.y = cvtpk(s[2 * 65], s[3 * 65]); o.z = cvtpk(s[4 * 65], s[5 * 65]); o.w = cvtpk(s[6 * 65], s[7 * 65]);
        *(GAS v4u*)(WT + (size_t)(r0 + n) * ldt + k0 + 8 * c) = o; }
    LDS_WAIT(); asm volatile("" ::: "memory");
}
__device__ __forceinline__ void rms_row_to_bf16(const float* xrow, const float* gain, bf16* orow, int lane) {
    const GAS f32x4* xr = (const GAS f32x4*)xrow + lane; const GAS f32x4* gr = (const GAS f32x4*)gain + lane;
    f32x4 v[8]; float s = 0.f;
#pragma unroll
    for (int j = 0; j < 8; ++j) { v[j] = xr[64 * j]; s += (v[j].x * v[j].x + v[j].y * v[j].y) + (v[j].z * v[j].z + v[j].w * v[j].w); }
    const float rs = 1.0f / sqrtf(wave_sum(s) * (1.f / 2048.f) + EPS);
    GAS u32x2* o8 = (GAS u32x2*)orow + lane;
#pragma unroll
    for (int j = 0; j < 8; ++j) { const f32x4 g = gr[64 * j]; u32x2 w; w.x = cvtpk(v[j].x * rs * g.x, v[j].y * rs * g.y); w.y = cvtpk(v[j].z * rs * g.z, v[j].w * rs * g.w); o8[64 * j] = w; }
}
#define ATT_WAITV(n) asm volatile("s_waitcnt vmcnt(" #n ")" ::: "memory")
template <int DQK, int NSLOT, bool CAUSAL>
__device__ __forceinline__ void attn_unit(LAS unsigned char* lds, const bf16* Qw  , int qpitch, const bf16* Ktiles, const bf16* Vtiles,
                                          int ntiles, int qpos0  , bf16* Ow, int opitch, int wid, int lane) {
    constexpr int KS = DQK / 16, KTB = 64 * DQK * 2, VTB = 64 * 128 * 2, KP = KTB / 1024 / 8  , VP = 2, NP = KP + VP, PF = NSLOT - 1;
    static_assert(KTB % 8192 == 0, "K tile pieces must split evenly over 8 waves");
    const int r32 = lane & 31, hi = lane >> 5;
    bf16x8 qf[KS];
    { const GAS bf16x8* qp = (const GAS bf16x8*)((const GAS bf16*)Qw + (size_t)r32 * qpitch + hi * 8);
#pragma unroll
      for (int ks = 0; ks < KS; ++ks) qf[ks] = qp[2 * ks]; }
    asm volatile("s_waitcnt vmcnt(0)" ::: "memory");
#pragma unroll
    for (int ks = 0; ks < KS; ++ks) asm volatile("" : "+v"(qf[ks]));
    const GAS unsigned char* kg = (const GAS unsigned char*)Ktiles + (size_t)wid * 1024 + lane * 16;
    const GAS unsigned char* vg = (const GAS unsigned char*)Vtiles + (size_t)wid * 1024 + lane * 16;
    LAS unsigned char* kl = lds + wid * 1024; LAS unsigned char* vl = lds + NSLOT * KTB + wid * 1024;
#define ATT_ISSUE(t) do { const int sl_ = (t) % NSLOT; \
        _Pragma("unroll") for (int p_ = 0; p_ < KP; ++p_) __builtin_amdgcn_global_load_lds((const GAS unsigned*)(kg + (size_t)(t) * KTB + p_ * 8192), (LAS unsigned*)(kl + sl_ * KTB + p_ * 8192), 16, 0, 0); \
        _Pragma("unroll") for (int p_ = 0; p_ < VP; ++p_) __builtin_amdgcn_global_load_lds((const GAS unsigned*)(vg + (size_t)(t) * VTB + p_ * 8192), (LAS unsigned*)(vl + sl_ * VTB + p_ * 8192), 16, 0, 0); } while (0)
#pragma unroll
    for (int t = 0; t < PF; ++t) if (t < ntiles) ATT_ISSUE(t);
    f32x16 o[4];
#pragma unroll
    for (int d = 0; d < 4; ++d)
#pragma unroll
        for (int r = 0; r < 16; ++r) o[d][r] = 0.f;
    float mrun = -1e30f, lrun = 0.f;
    const int kbase = hi * 1024 + r32 * 16;
    const int g4 = lane >> 4, q4 = (lane >> 2) & 3, p4 = lane & 3;
    const int vbase = (4 * (g4 >> 1) + q4) * 64 + (16 * (g4 & 1) + 4 * p4) * 2;
    for (int j = 0; j < ntiles; ++j) {
        const int rem = ntiles - 1 - j;
        if (PF >= 2 && rem >= 1) { if (NP == 5) ATT_WAITV(5); else ATT_WAITV(6); } else ATT_WAITV(0);
        __builtin_amdgcn_s_barrier();
        asm volatile("" ::: "memory");
        if (j + PF < ntiles) ATT_ISSUE(j + PF);
        if (CAUSAL && 64 * j > qpos0 + 31) continue;
        const int sl = j % NSLOT;
        const LAS unsigned char* ks_ = lds + sl * KTB + kbase;
        const LAS unsigned char* vs_ = lds + NSLOT * KTB + sl * VTB + vbase;
        f32x16 p0, p1;
#pragma unroll
        for (int r = 0; r < 16; ++r) { p0[r] = 0.f; p1[r] = 0.f; }
#pragma unroll
        for (int ks = 0; ks < KS; ++ks) {
            const bf16x8 k0 = *(const LAS bf16x8*)(ks_ + ks * 2048), k1 = *(const LAS bf16x8*)(ks_ + ks * 2048 + 512);
            p0 = __builtin_amdgcn_mfma_f32_32x32x16_bf16(k0, qf[ks], p0, 0, 0, 0);
            p1 = __builtin_amdgcn_mfma_f32_32x32x16_bf16(k1, qf[ks], p1, 0, 0, 0);
        }
        if (CAUSAL && 64 * j + 63 > qpos0) {
            const int dq = qpos0 + r32 - 64 * j - 4 * hi;
#pragma unroll
            for (int r = 0; r < 16; ++r) { const int c = (r & 3) + 8 * (r >> 2); if (c > dq) p0[r] = -INFINITY; if (c + 32 > dq) p1[r] = -INFINITY; }
        }
        float mx = p0[0];
#pragma unroll
        for (int r = 1; r < 16; ++r) mx = fmaxf(mx, p0[r]);
#pragma unroll
        for (int r = 0; r < 16; ++r) mx = fmaxf(mx, p1[r]);
        mx = fmaxf(mx, __shfl_xor(mx, 32));
        const float mnew = fmaxf(mrun, mx);
        if (__any(mnew > mrun)) {
            const float alpha = __builtin_amdgcn_exp2f(mrun - mnew);
            lrun *= alpha;
#pragma unroll
            for (int d = 0; d < 4; ++d)
#pragma unroll
                for (int r = 0; r < 16; ++r) o[d][r] *= alpha;
            mrun = mnew;
        }
        float ps = 0.f;
#pragma unroll
        for (int r = 0; r < 16; ++r) { p0[r] = __builtin_amdgcn_exp2f(p0[r] - mrun); p1[r] = __builtin_amdgcn_exp2f(p1[r] - mrun); ps += p0[r] + p1[r]; }
        lrun += ps;
        bf16x8 pf[4];
        { v4u w;
          w.x = cvtpk(p0[0], p0[1]); w.y = cvtpk(p0[2], p0[3]); w.z = cvtpk(p0[4], p0[5]); w.w = cvtpk(p0[6], p0[7]); pf[0] = __builtin_bit_cast(bf16x8, w);
          w.x = cvtpk(p0[8], p0[9]); w.y = cvtpk(p0[10], p0[11]); w.z = cvtpk(p0[12], p0[13]); w.w = cvtpk(p0[14], p0[15]); pf[1] = __builtin_bit_cast(bf16x8, w);
          w.x = cvtpk(p1[0], p1[1]); w.y = cvtpk(p1[2], p1[3]); w.z = cvtpk(p1[4], p1[5]); w.w = cvtpk(p1[6], p1[7]); pf[2] = __builtin_bit_cast(bf16x8, w);
          w.x = cvtpk(p1[8], p1[9]); w.y = cvtpk(p1[10], p1[11]); w.z = cvtpk(p1[12], p1[13]); w.w = cvtpk(p1[14], p1[15]); pf[3] = __builtin_bit_cast(bf16x8, w); }
#pragma unroll
        for (int db = 0; db < 4; ++db)
#pragma unroll
            for (int s = 0; s < 4; ++s) {
                const s16x4 lo = __builtin_bit_cast(s16x4, __builtin_amdgcn_ds_read_tr16_b64_v4i16((LAS v4i16_t*)(vs_ + db * 4096 + s * 1024)));
                const s16x4 hh = __builtin_bit_cast(s16x4, __builtin_amdgcn_ds_read_tr16_b64_v4i16((LAS v4i16_t*)(vs_ + db * 4096 + s * 1024 + 512)));
                const bf16x8 vf = (bf16x8){lo[0], lo[1], lo[2], lo[3], hh[0], hh[1], hh[2], hh[3]};
                o[db] = __builtin_amdgcn_mfma_f32_32x32x16_bf16(vf, pf[s], o[db], 0, 0, 0);
            }
    }
    const float lt = lrun + __shfl_xor(lrun, 32);
    const float il = 1.0f / lt;
    GAS bf16* op = (GAS bf16*)Ow + (size_t)r32 * opitch + 4 * hi;
#pragma unroll
    for (int db = 0; db < 4; ++db)
#pragma unroll
        for (int rg = 0; rg < 4; ++rg) { u32x2 w; w.x = cvtpk(o[db][4 * rg] * il, o[db][4 * rg + 1] * il); w.y = cvtpk(o[db][4 * rg + 2] * il, o[db][4 * rg + 3] * il);
            *(GAS u32x2*)(op + 32 * db + 8 * rg) = w; }
    asm volatile("s_waitcnt vmcnt(0) lgkmcnt(0)" ::: "memory");
    __builtin_amdgcn_s_barrier();
    asm volatile("" ::: "memory");
#undef ATT_ISSUE
}
struct Frame {
    LAS unsigned char* lds;
    volatile LAS unsigned* MISC;
    gu32* ctl;
    int tid, lane, wave, vcu, G;
    unsigned char* ws;
};
#define WSP(T_, off) ((T_*)(F.ws + (off)))

__device__ __forceinline__ void p0_prologue(Frame& F, const float* const* in) {
    LAS float* scr = (LAS float*)(F.lds + RING_OFF + F.wave * 16640);
    const int gw = F.vcu * NWAVES + F.wave, NGW = F.G * NWAVES, lane = F.lane;
    constexpr int I0 = 32 * 65, I1 = 32 * 96, I2 = 32 * 16, I3 = 32 * 16, I4 = 8 * 48, I5 = 8 * 64, I6 = 16 * 32, I7 = 32 * 32, I8 = 16 * 32, I9 = 32 * 32, I10 = NE * 32 * 64, I11 = NE * 32 * 32;
    constexpr int NITEMS = I0 + I1 + I2 + I3 + I4 + I5 + I6 + I7 + I8 + I9 + I10 + I11;
    bf16* W1T = WSP(bf16, WS_W1T);
    for (int it = gw; it < NITEMS; it += NGW) {
        int r = it;
        if (r < I0) { const int kb = r / 65, cb = r % 65, c = 64 * cb; const int r0 = c < 3072 ? c : (c < 3136 ? 4096 + (c - 3072) : 3072 + (c - 3136));
            transpose_item64(in[4], 4160, 64 * kb, c, W1T, 2048, r0, scr, lane); continue; } r -= I0;
        if (r < I1) { const int kb = r / 96, cb = r % 96; transpose_item64(in[5], 6144, 64 * kb, 64 * cb, W1T, 2048, P1_G + 64 * cb, scr, lane); continue; } r -= I1;
        if (r < I2) { const int kb = r / 16, cb = r % 16; transpose_item64(in[20], 1024, 64 * kb, 64 * cb, W1T, 2048, P1N + 64 * cb, scr, lane); continue; } r -= I2;
        if (r < I3) { const int kb = r / 16, cb = r % 16; transpose_item64(in[21], 1024, 64 * kb, 64 * cb, W1T, 2048, P1N + 1024 + 64 * cb, scr, lane); continue; } r -= I3;
        if (r < I4) { const int kb = r / 48, cb = r % 48; transpose_item64(in[13], 3072, 64 * kb, 64 * cb, WSP(bf16, WS_WUQT), 512, 64 * cb, scr, lane); continue; } r -= I4;
        if (r < I5) { const int kb = r / 64, cb = r % 64; transpose_item64(in[15], 4096, 64 * kb, 64 * cb, WSP(bf16, WS_WUKVT), 512, 64 * cb, scr, lane); continue; } r -= I5;
        if (r < I6) { const int kb = r / 32, cb = r % 32; transpose_item64(in[11], 2048, 64 * kb, 64 * cb, WSP(bf16, WS_WPAT), 1024, 64 * cb, scr, lane); continue; } r -= I6;
        if (r < I7) { const int kb = r / 32, cb = r % 32; transpose_item64(in[18], 2048, 64 * kb, 64 * cb, WSP(bf16, WS_WPBT), 2048, 64 * cb, scr, lane); continue; } r -= I7;
        if (r < I8) { const int kb = r / 32, cb = r % 32; transpose_item64(in[24], 2048, 64 * kb, 64 * cb, WSP(bf16, WS_WPCT), 1024, 64 * cb, scr, lane); continue; } r -= I8;
        if (r < I9) { const int kb = r / 32, cb = r % 32; transpose_item64(in[25], 2048, 64 * kb, 64 * cb, WSP(bf16, WS_WOT), 2048, 64 * cb, scr, lane); continue; } r -= I9;
        if (r < I10) { const int e = r / 2048, q = r % 2048, kb = q / 64, cb = q % 64;
            const int r0 = cb < 32 ? 256 * (cb >> 1) + 64 * (cb & 1) : 256 * ((cb - 32) >> 1) + 128 + 64 * (cb & 1);
            transpose_item64(in[29] + (size_t)e * 2048 * 4096, 4096, 64 * kb, 64 * cb, WSP(bf16, WS_WGUT) + (size_t)e * 4096 * 2048, 2048, r0, scr, lane); continue; } r -= I10;
        { const int e = r / 1024, q = r % 1024, kb = q / 32, cb = q % 32;
            transpose_item64(in[31] + (size_t)e * 2048 * 2048, 2048, 64 * kb, 64 * cb, WSP(bf16, WS_WDT) + (size_t)e * 2048 * 2048, 2048, 64 * cb, scr, lane); }
    }
    const int gt = gw * 64 + lane, NGT = NGW * 64;
    for (int i = gt; i < 192 * 2048 / 8; i += NGT) *(GAS v4u*)(W1T + (size_t)4160 * 2048 + (size_t)i * 8) = (v4u){0u, 0u, 0u, 0u};
    { const float* wsrc = in[9]; bf16* wsm = WSP(bf16, WS_WSM);
      for (int i = gt; i < 8 * 128 * 128; i += NGT) { const int t = (i >> 7) & 127, s = i & 127; const float v = (s <= t) ? wsrc[i] : 0.f; wsm[i] = (bf16)(cvtpk(v, 0.f) & 0xffffu); } }
    { const float* rw = in[27]; const float* g2 = in[26]; float* rwg = WSP(float, WS_RWG);
      for (int i = gt; i < 2048 * 32; i += NGT) rwg[i] = rw[i] * g2[i >> 5]; }
    bf16* H = WSP(bf16, WS_H);
    for (int m = gw; m < T + MEMROWS; m += NGW) {
        if (m < T) rms_row_to_bf16(in[0] + (size_t)m * 2048, in[3], H + (size_t)m * 2048, lane);
        else rms_row_to_bf16(in[1] + (size_t)(m - T) * 2048, in[19], H + (size_t)m * 2048, lane);
    }
}

__device__ __forceinline__ float group16_sum(float v) { v += __shfl_xor(v, 1); v += __shfl_xor(v, 2); v += __shfl_xor(v, 4); v += __shfl_xor(v, 8); return v; }
__device__ __forceinline__ void p2_token(Frame& F, const float* const* in, int t) {
    const int l = F.lane;
    const GAS bf16* row = (const GAS bf16*)WSP(bf16, WS_P1) + (size_t)t * P1N;
    { float a[8], b[8]; unpack8(*(const GAS v4u*)(row + P1_V + 16 * l), a); unpack8(*(const GAS v4u*)(row + P1_V + 16 * l + 8), b);
      float s = 0.f;
#pragma unroll
      for (int i = 0; i < 8; ++i) s += a[i] + b[i];
      const float mean = wave_sum(s) * (1.f / 1024.f); float q = 0.f;
#pragma unroll
      for (int i = 0; i < 8; ++i) { const float d0 = a[i] - mean, d1 = b[i] - mean; q += d0 * d0 + d1 * d1; }
      const float rstd = 1.0f / sqrtf(wave_sum(q) * (1.f / 1024.f) + EPS);
      if (l == 0) { GAS float* vs = (GAS float*)WSP(float, WS_VSTAT) + (size_t)t * 2; vs[0] = mean; vs[1] = rstd; } }
#pragma unroll
    for (int w = 0; w < 2; ++w) {
        float a[8]; unpack8(*(const GAS v4u*)(row + (w ? P1_CKV : P1_CQ) + 8 * l), a);
        float s = 0.f;
#pragma unroll
        for (int i = 0; i < 8; ++i) s += a[i] * a[i];
        const float rs = 1.0f / sqrtf(wave_sum(s) * (1.f / 512.f) + EPS);
        const GAS float* g = (const GAS float*)(w ? in[14] : in[12]) + 8 * l;
        const f32x4 g0 = *(const GAS f32x4*)g, g1 = *(const GAS f32x4*)(g + 4);
        float o[8] = {a[0] * rs * g0.x, a[1] * rs * g0.y, a[2] * rs * g0.z, a[3] * rs * g0.w, a[4] * rs * g1.x, a[5] * rs * g1.y, a[6] * rs * g1.z, a[7] * rs * g1.w};
        *(GAS v4u*)((GAS bf16*)WSP(bf16, w ? WS_CKVN : WS_CQN) + (size_t)t * 512 + 8 * l) = packf8(o);
    }
    { float a[8], b[8]; unpack8(*(const GAS v4u*)(row + P1_QM + 16 * l), a); unpack8(*(const GAS v4u*)(row + P1_QM + 16 * l + 8), b);
      float s = 0.f;
#pragma unroll
      for (int i = 0; i < 8; ++i) s += a[i] * a[i] + b[i] * b[i];
      const float rs = MEM_QSCALE / sqrtf(group16_sum(s) * (1.f / 256.f) + EPS);
      const GAS float* g = (const GAS float*)in[22] + (l & 15) * 16;
      float ga[8], gb[8];
#pragma unroll
      for (int i = 0; i < 8; ++i) { ga[i] = g[i]; gb[i] = g[8 + i]; }
#pragma unroll
      for (int i = 0; i < 8; ++i) { a[i] *= rs * ga[i]; b[i] *= rs * gb[i]; }
      const int bb = t >> 12, tl = t & 4095, h = l >> 4;
      GAS bf16* dst = (GAS bf16*)WSP(bf16, WS_QMN) + ((size_t)((bb * 4 + h) * 4096 + tl)) * 256 + (l & 15) * 16;
      *(GAS v4u*)dst = packf8(a); *(GAS v4u*)(dst + 8) = packf8(b); }
    { float t1 = 0.f, t2 = 0.f;
      if (l < 32) { t1 = bflo((unsigned)row[P1_KR + l]); t2 = bflo((unsigned)row[P1_KR + 32 + l]); }
      const float ss = wave_sum(t1 * t1 + t2 * t2);
      if (l < 32) {
          const float pos = (float)((const GAS int*)in[2])[t];
          const float inv = 1.0f / powf(10000.0f, (float)(2 * l) / 64.0f);
          const float ang = pos * inv, c = cosf(ang), s = sinf(ang);
          GAS float* rp = (GAS float*)WSP(float, WS_ROPE) + (size_t)t * 64; rp[l] = c; rp[32 + l] = s;
          const GAS float* kg = (const GAS float*)in[17];
          const float a = t1 * kg[128 + l], b = t2 * kg[160 + l];
          GAS float* kr = (GAS float*)WSP(float, WS_KRR) + (size_t)t * 64; kr[l] = a * c - b * s; kr[32 + l] = a * s + b * c;
          if (l == 0) ((GAS float*)WSP(float, WS_KRSS))[t] = ss;
      } }
}
__device__ __forceinline__ void p2_memrow(Frame& F, const float* const* in, int m) {
    const int l = F.lane, bb = m >> 8, ml = m & 255, tile = ml >> 6, key = ml & 63, h = l >> 4, d0 = (l & 15) * 16;
    const GAS bf16* row = (const GAS bf16*)WSP(bf16, WS_MKV) + (size_t)m * 2048;
    { float a[8], b[8]; unpack8(*(const GAS v4u*)(row + 16 * l), a); unpack8(*(const GAS v4u*)(row + 16 * l + 8), b);
      float s = 0.f;
#pragma unroll
      for (int i = 0; i < 8; ++i) s += a[i] * a[i] + b[i] * b[i];
      const float rs = 1.0f / sqrtf(group16_sum(s) * (1.f / 256.f) + EPS);
      const GAS float* g = (const GAS float*)in[23] + d0;
#pragma unroll
      for (int i = 0; i < 8; ++i) { a[i] *= rs * g[i]; b[i] *= rs * g[8 + i]; }
      GAS bf16* base = (GAS bf16*)WSP(bf16, WS_MKT) + (size_t)((bb * 4 + h) * 4 + tile) * (32 * 64 * 8);
      const int c0 = d0 >> 3;
      *(GAS v4u*)(base + ((size_t)c0 * 64 + key) * 8) = packf8(a); *(GAS v4u*)(base + ((size_t)(c0 + 1) * 64 + key) * 8) = packf8(b); }
    { const v4u a = *(const GAS v4u*)(row + 1024 + 16 * l), b = *(const GAS v4u*)(row + 1024 + 16 * l + 8);
      const int half = d0 >> 7, cb = (d0 & 127) >> 5, off = d0 & 31;
      GAS bf16* base = (GAS bf16*)WSP(bf16, WS_MVT) + (size_t)(((bb * 4 + h) * 2 + half) * 4 + tile) * (4 * 64 * 32);
      GAS bf16* dst = base + ((size_t)cb * 64 + key) * 32 + off;
      *(GAS v4u*)dst = a; *(GAS v4u*)(dst + 8) = b; }
}

__device__ __forceinline__ void gmlp_unit(Frame& F, const float* const* in, int u) {
    const int ci = u >> 3, g = u & 7, tok0 = ci * 128, tid = F.tid, l = F.lane, r32 = l & 31, hi = l >> 5;
    LAS bf16* VT = (LAS bf16*)(F.lds + RING_OFF);
    const GAS bf16* P1 = (const GAS bf16*)WSP(bf16, WS_P1);
    { const int s = tid >> 2, qd = tid & 3;
      const GAS float* vs = (const GAS float*)WSP(float, WS_VSTAT) + (size_t)(tok0 + s) * 2; const float mean = vs[0], rstd = vs[1];
      const GAS bf16* src = P1 + (size_t)(tok0 + s) * P1N + P1_V + g * 128 + qd * 32;
      const GAS float* lg = (const GAS float*)in[7] + g * 128 + qd * 32; const GAS float* lb = (const GAS float*)in[8] + g * 128 + qd * 32;
#pragma unroll
      for (int i = 0; i < 4; ++i) { float a[8]; unpack8(*(const GAS v4u*)(src + 8 * i), a);
#pragma unroll
          for (int k = 0; k < 8; ++k) { const int c = qd * 32 + 8 * i + k; const float v = (a[k] - mean) * rstd * lg[8 * i + k] + lb[8 * i + k]; VT[c * 136 + s] = (bf16)(cvtpk(v, 0.f) & 0xffffu); } } }
    __syncthreads();
    const int w = F.wave, tb = w >> 1, cbp = (w & 1) * 2;
    f32x16 acc[2];
#pragma unroll
    for (int r = 0; r < 16; ++r) { acc[0][r] = 0.f; acc[1][r] = 0.f; }
    const GAS bf16* wsm = (const GAS bf16*)WSP(bf16, WS_WSM) + ((size_t)(g * 128 + 32 * tb + r32)) * 128 + 8 * hi;
    for (int ks = 0; ks < 2 * (tb + 1); ++ks) {
        const bf16x8 af = *(const GAS bf16x8*)(wsm + 16 * ks);
#pragma unroll
        for (int cc = 0; cc < 2; ++cc) { const bf16x8 bfr = *(const LAS bf16x8*)(VT + (32 * (cbp + cc) + r32) * 136 + 16 * ks + 8 * hi);
            acc[cc] = __builtin_amdgcn_mfma_f32_32x32x16_bf16(af, bfr, acc[cc], 0, 0, 0); }
    }
    const GAS float* bs = (const GAS float*)in[10] + g * 128;
    GAS bf16* AO = (GAS bf16*)WSP(bf16, WS_AOUT);
#pragma unroll
    for (int cc = 0; cc < 2; ++cc)
#pragma unroll
        for (int r = 0; r < 16; ++r) { const int t = 32 * tb + crow(r, hi), tok = tok0 + t, ch = g * 128 + 32 * (cbp + cc) + r32;
            const float uu = bflo((unsigned)P1[(size_t)tok * P1N + P1_U + ch]);
            AO[(size_t)tok * 1024 + ch] = (bf16)(cvtpk(uu * (acc[cc][r] + bs[t]), 0.f) & 0xffffu); }
    __syncthreads();
}

__device__ __forceinline__ void p4_token(Frame& F, const float* const* in, int t) {
    const int l = F.lane, bb = t >> 12, tl = t & 4095, tile = tl >> 6, key = tl & 63, h = l >> 2, sub = l & 3;
    const GAS float* rope = (const GAS float*)WSP(float, WS_ROPE) + (size_t)t * 64;
    { const GAS bf16* qr = (const GAS bf16*)WSP(bf16, WS_QRAW) + (size_t)t * 3072 + h * 192;
      float x[4][8], y[2][8];
#pragma unroll
      for (int i = 0; i < 4; ++i) unpack8(*(const GAS v4u*)(qr + sub * 32 + 8 * i), x[i]);
#pragma unroll
      for (int i = 0; i < 2; ++i) unpack8(*(const GAS v4u*)(qr + 128 + sub * 16 + 8 * i), y[i]);
      float s = 0.f;
#pragma unroll
      for (int i = 0; i < 4; ++i)
#pragma unroll
          for (int k = 0; k < 8; ++k) s += x[i][k] * x[i][k];
#pragma unroll
      for (int i = 0; i < 2; ++i)
#pragma unroll
          for (int k = 0; k < 8; ++k) s += y[i][k] * y[i][k];
      s += __shfl_xor(s, 1); s += __shfl_xor(s, 2);
      const float rs = 1.0f / sqrtf(s * (1.f / 192.f) + EPS);
      const GAS float* qg = (const GAS float*)in[16];
      GAS bf16* dst = (GAS bf16*)WSP(bf16, WS_QF) + ((size_t)((bb * 16 + h) * 4096 + tl)) * 192;
#pragma unroll
      for (int i = 0; i < 4; ++i) {
#pragma unroll
          for (int k = 0; k < 8; ++k) x[i][k] *= rs * qg[sub * 32 + 8 * i + k] * MLA_QSCALE;
          *(GAS v4u*)(dst + sub * 32 + 8 * i) = packf8(x[i]); }
#pragma unroll
      for (int i = 0; i < 2; ++i) { float o[8];
#pragma unroll
          for (int k = 0; k < 8; ++k) { const float mine = y[i][k] * rs * qg[128 + sub * 16 + 8 * i + k]; const float other = __shfl_xor(mine, 2);
              const int j = (sub & 1) * 16 + 8 * i + k; const float c = rope[j], sn = rope[32 + j];
              o[k] = (sub < 2 ? mine * c - other * sn : other * sn + mine * c) * MLA_QSCALE; }
          *(GAS v4u*)(dst + 128 + sub * 16 + 8 * i) = packf8(o); } }
    { const GAS bf16* kr = (const GAS bf16*)WSP(bf16, WS_KVRAW) + (size_t)t * 4096 + h * 256;
      float x[4][8];
#pragma unroll
      for (int i = 0; i < 4; ++i) unpack8(*(const GAS v4u*)(kr + sub * 32 + 8 * i), x[i]);
      float s = 0.f;
#pragma unroll
      for (int i = 0; i < 4; ++i)
#pragma unroll
          for (int k = 0; k < 8; ++k) s += x[i][k] * x[i][k];
      s += __shfl_xor(s, 1); s += __shfl_xor(s, 2);
      s += ((const GAS float*)WSP(float, WS_KRSS))[t];
      const float rs = 1.0f / sqrtf(s * (1.f / 192.f) + EPS);
      const GAS float* kg = (const GAS float*)in[17];
      GAS bf16* kbase = (GAS bf16*)WSP(bf16, WS_KFT) + (size_t)((bb * 16 + h) * 64 + tile) * (24 * 64 * 8);
#pragma unroll
      for (int i = 0; i < 4; ++i) {
#pragma unroll
          for (int k = 0; k < 8; ++k) x[i][k] *= rs * kg[sub * 32 + 8 * i + k];
          *(GAS v4u*)(kbase + ((size_t)(sub * 4 + i) * 64 + key) * 8) = packf8(x[i]); }
      const GAS float* krr = (const GAS float*)WSP(float, WS_KRR) + (size_t)t * 64 + sub * 16;
#pragma unroll
      for (int i = 0; i < 2; ++i) { float o[8];
#pragma unroll
          for (int k = 0; k < 8; ++k) o[k] = krr[8 * i + k] * rs;
          *(GAS v4u*)(kbase + ((size_t)(16 + 2 * sub + i) * 64 + key) * 8) = packf8(o); }
      GAS bf16* vdst = (GAS bf16*)WSP(bf16, WS_VFT) + (size_t)((bb * 16 + h) * 64 + tile) * (4 * 64 * 32) + ((size_t)sub * 64 + key) * 32;
#pragma unroll
      for (int i = 0; i < 4; ++i) *(GAS v4u*)(vdst + 8 * i) = *(const GAS v4u*)(kr + 128 + sub * 32 + 8 * i); }
}
__device__ __forceinline__ void p8_router(Frame& F, const float* const* in) {
    const int tid = F.tid, l = F.lane, r32 = l & 31, hi = l >> 5, w = F.wave, tk = w >> 2, kq = w & 3;
    LAS float* part = (LAS float*)(F.lds + RING_OFF);
    LAS float* ssp = part + 2 * 4 * 32 * 33;
    LAS int* lcnt = (LAS int*)(F.lds + LTAB_OFF) + 40;
    LAS int* gbase = lcnt + 32;
    const int tok0 = (blockIdx.x * 2 + tk) * 32;
    if (tid < 32) lcnt[tid] = 0;
    {   const GAS float* xr = (const GAS float*)WSP(float, WS_X1) + (size_t)(tok0 + r32) * 2048 + 4 * hi;
        const GAS float* rw = (const GAS float*)WSP(float, WS_RWG) + (size_t)(4 * hi) * 32 + r32;
        f32x16 acc;
#pragma unroll
        for (int r = 0; r < 16; ++r) acc[r] = 0.f;
        float ss = 0.f;
#pragma unroll 4
        for (int q = 64 * kq; q < 64 * kq + 64; ++q) {
            const f32x4 a = *(const GAS f32x4*)(xr + 8 * q);
            const GAS float* rq = rw + (size_t)(8 * q) * 32;
            const float b0 = rq[0], b1 = rq[32], b2 = rq[64], b3 = rq[96];
            acc = __builtin_amdgcn_mfma_f32_32x32x2f32(a.x, b0, acc, 0, 0, 0);
            acc = __builtin_amdgcn_mfma_f32_32x32x2f32(a.y, b1, acc, 0, 0, 0);
            acc = __builtin_amdgcn_mfma_f32_32x32x2f32(a.z, b2, acc, 0, 0, 0);
            acc = __builtin_amdgcn_mfma_f32_32x32x2f32(a.w, b3, acc, 0, 0, 0);
            ss += (a.x * a.x + a.y * a.y) + (a.z * a.z + a.w * a.w);
        }
        LAS float* pp = part + (size_t)((tk * 4 + kq) * 32) * 33;
#pragma unroll
        for (int r = 0; r < 16; ++r) pp[crow(r, hi) * 33 + r32] = acc[r];
        ssp[(tk * 4 + kq) * 64 + l] = ss;
    }
    __syncthreads();
    const bool sel = (kq == 0) && (l < 32);
    float v0 = -INFINITY, v1 = -INFINITY, v2 = -INFINITY, v3 = -INFINITY; int i0 = 0, i1 = 0, i2 = 0, i3 = 0; int lr0 = 0, lr1 = 0, lr2 = 0, lr3 = 0;
    if (sel) {
        float ss = 0.f;
#pragma unroll
        for (int k = 0; k < 4; ++k) ss += ssp[(tk * 4 + k) * 64 + l] + ssp[(tk * 4 + k) * 64 + 32 + l];
        const float rs = 1.0f / sqrtf(ss * (1.f / 2048.f) + EPS);
        const GAS float* rb = (const GAS float*)in[28];
        const LAS float* pp = part + (size_t)(tk * 4 * 32 + l) * 33;
#pragma unroll
        for (int e = 0; e < 32; ++e) {
            const float x = ((pp[e] + pp[32 * 33 + e]) + (pp[2 * 32 * 33 + e] + pp[3 * 32 * 33 + e])) * rs + rb[e];
            if (x > v3) {
                if (x > v0) { v3 = v2; i3 = i2; v2 = v1; i2 = i1; v1 = v0; i1 = i0; v0 = x; i0 = e; }
                else if (x > v1) { v3 = v2; i3 = i2; v2 = v1; i2 = i1; v1 = x; i1 = e; }
                else if (x > v2) { v3 = v2; i3 = i2; v2 = x; i2 = e; }
                else { v3 = x; i3 = e; }
            }
        }
        lr0 = __hip_atomic_fetch_add(&lcnt[i0], 1, __ATOMIC_RELAXED, __HIP_MEMORY_SCOPE_WORKGROUP); lr1 = __hip_atomic_fetch_add(&lcnt[i1], 1, __ATOMIC_RELAXED, __HIP_MEMORY_SCOPE_WORKGROUP); lr2 = __hip_atomic_fetch_add(&lcnt[i2], 1, __ATOMIC_RELAXED, __HIP_MEMORY_SCOPE_WORKGROUP); lr3 = __hip_atomic_fetch_add(&lcnt[i3], 1, __ATOMIC_RELAXED, __HIP_MEMORY_SCOPE_WORKGROUP);
    }
    __syncthreads();
    if (tid < 32) { const int c = lcnt[tid]; gbase[tid] = c ? (int)__hip_atomic_fetch_add((unsigned*)(F.ctl + CW_CNT + tid), (unsigned)c, __ATOMIC_RELAXED, __HIP_MEMORY_SCOPE_AGENT) : 0; }
    __syncthreads();
    if (sel) {
        const int t = tok0 + l;
        const float e1 = expf(v1 - v0), e2 = expf(v2 - v0), e3 = expf(v3 - v0), inv = 1.0f / (1.0f + e1 + e2 + e3);
        GAS int* te = (GAS int*)WSP(int, WS_TKE) + t * 4; GAS int* tr = (GAS int*)WSP(int, WS_TKR) + t * 4; GAS float* tg = (GAS float*)WSP(float, WS_TKG) + t * 4;
        te[0] = i0; te[1] = i1; te[2] = i2; te[3] = i3;
        tr[0] = gbase[i0] + lr0; tr[1] = gbase[i1] + lr1; tr[2] = gbase[i2] + lr2; tr[3] = gbase[i3] + lr3;
        tg[0] = inv; tg[1] = e1 * inv; tg[2] = e2 * inv; tg[3] = e3 * inv;
    }
    __syncthreads();
}
__device__ __forceinline__ void build_moe_tab(Frame& F) {
    LAS int* tab = (LAS int*)(F.lds + LTAB_OFF);
    if (F.tid == 0) { int s = 0; for (int e = 0; e < NE; ++e) { tab[e] = s; s += ((int)__hip_atomic_load(F.ctl + CW_CNT + e, RLX_AGENT) + 255) >> 8; } tab[NE] = s; }
    __syncthreads();
}
__device__ __forceinline__ void p9_scatter_token(Frame& F, const float* const* in, int t) {
    const int lane = F.lane; const LAS int* tab = (const LAS int*)(F.lds + LTAB_OFF);
    const GAS f32x4* xr = (const GAS f32x4*)(WSP(float, WS_X1) + (size_t)t * 2048) + lane; const GAS f32x4* gr = (const GAS f32x4*)in[26] + lane;
    f32x4 v[8]; float s = 0.f;
#pragma unroll
    for (int j = 0; j < 8; ++j) { v[j] = xr[64 * j]; s += (v[j].x * v[j].x + v[j].y * v[j].y) + (v[j].z * v[j].z + v[j].w * v[j].w); }
    const float rs = 1.0f / sqrtf(wave_sum(s) * (1.f / 2048.f) + EPS);
    u32x2 w[8];
#pragma unroll
    for (int j = 0; j < 8; ++j) { const f32x4 g = gr[64 * j]; w[j].x = cvtpk(v[j].x * rs * g.x, v[j].y * rs * g.y); w[j].y = cvtpk(v[j].z * rs * g.z, v[j].w * rs * g.w); }
    const GAS int* te = (const GAS int*)WSP(int, WS_TKE) + t * 4; const GAS int* tr = (const GAS int*)WSP(int, WS_TKR) + t * 4;
#pragma unroll
    for (int k = 0; k < 4; ++k) { const int e = te[k], rk = tr[k]; const size_t rowi = (size_t)tab[e] * 256 + rk;
        GAS u32x2* o8 = (GAS u32x2*)(WSP(bf16, WS_HS) + rowi * 2048) + lane;
#pragma unroll
        for (int j = 0; j < 8; ++j) o8[64 * j] = w[j]; }
}
__device__ __forceinline__ void p12_combine_token(Frame& F, float* out, int t) {
    const int lane = F.lane; const LAS int* tab = (const LAS int*)(F.lds + LTAB_OFF);
    const GAS f32x4* xr = (const GAS f32x4*)(WSP(float, WS_X1) + (size_t)t * 2048) + lane;
    f32x4 v[8];
#pragma unroll
    for (int j = 0; j < 8; ++j) v[j] = xr[64 * j];
    const GAS int* te = (const GAS int*)WSP(int, WS_TKE) + t * 4; const GAS int* tr = (const GAS int*)WSP(int, WS_TKR) + t * 4; const GAS float* tg = (const GAS float*)WSP(float, WS_TKG) + t * 4;
#pragma unroll
    for (int k = 0; k < 4; ++k) { const int e = te[k], rk = tr[k]; const float g = tg[k]; const size_t rowi = (size_t)tab[e] * 256 + rk;
        const GAS u32x2* y8 = (const GAS u32x2*)(WSP(bf16, WS_Y) + rowi * 2048) + lane;
#pragma unroll
        for (int j = 0; j < 8; ++j) { const u32x2 yw = y8[64 * j]; v[j].x += g * bflo(yw.x); v[j].y += g * bfhi(yw.x); v[j].z += g * bflo(yw.y); v[j].w += g * bfhi(yw.y); } }
    GAS f32x4* o = (GAS f32x4*)(out + (size_t)t * 2048) + lane;
#pragma unroll
    for (int j = 0; j < 8; ++j) o[64 * j] = v[j];
}

struct Args { const float* in[33]; float* out; unsigned char* ws; };
__global__ void __launch_bounds__(NWAVES * 64, 2) mk_fwd(Args args) {
    extern __shared__ __attribute__((aligned(16))) unsigned char lds[];
    Frame F;
    F.lds = (LAS unsigned char*)lds;
    F.MISC = (volatile LAS unsigned*)(F.lds + MISC_OFF);
    F.tid = threadIdx.x; F.lane = F.tid & 63; F.wave = __builtin_amdgcn_readfirstlane(F.tid >> 6);
    F.G = gridDim.x; { const int bx = blockIdx.x; F.vcu = (F.G % 8 == 0) ? (bx % 8) * (F.G / 8) + bx / 8 : bx; }
    F.ws = args.ws; F.ctl = (gu32*)(args.ws + WS_CTL);
    const float* const* in = args.in;
    for (int u = F.tid; u < (LDS_BYTES - LDSCTL_OFF) / 4; u += NWAVES * 64) ((LAS unsigned*)(F.lds + LDSCTL_OFF))[u] = 0u;
    __syncthreads();
    XcdBarrier bar = xcd_barrier_post((unsigned*)(F.ctl + CW_BAR), F.MISC + 8);
    const int gw = F.vcu * NWAVES + F.wave, NGW = F.G * NWAVES;
    typedef pg8::bf16_t pbf;

    p0_prologue(F, in);
    xcd_barrier(bar);

    {   pg8::Gemm g{WSP(pbf, WS_H), WSP(pbf, WS_W1T), T + MEMROWS, P1N + 2048, 2048, 2048};
        pg8::P1Order S; S.init(F.G, (int)blockIdx.x);
        pg8::EpiP1 E{WSP(pbf, WS_P1), WSP(pbf, WS_MKV), in[6]};
        pg8::gemm_phase<pg8::EpiP1, pg8::P1Order, true, true>(F.lds + RING_OFF, g, S, E);
    }
    xcd_barrier(bar);

    for (int t = gw; t < T; t += NGW) p2_token(F, in, t);
    for (int m = gw; m < MEMROWS; m += NGW) p2_memrow(F, in, m);
    xcd_barrier(bar);

    {   pg8::Gemm g{WSP(pbf, WS_CQN), WSP(pbf, WS_WUQT), T, 3072, 512, 512};
        pg8::StaticOrder S; S.init(T, 3072, F.G, (int)blockIdx.x);
        pg8::EpiPlain E{WSP(pbf, WS_QRAW), 3072};
        pg8::gemm_phase<pg8::EpiPlain, pg8::StaticOrder, true, true>(F.lds + RING_OFF, g, S, E);
    }
    {   pg8::Gemm g{WSP(pbf, WS_CKVN), WSP(pbf, WS_WUKVT), T, 4096, 512, 512};
        pg8::StaticOrder S; S.init(T, 4096, F.G, (int)blockIdx.x);
        pg8::EpiPlain E{WSP(pbf, WS_KVRAW), 4096};
        pg8::gemm_phase<pg8::EpiPlain, pg8::StaticOrder, true, true>(F.lds + RING_OFF, g, S, E);
    }
    __syncthreads();
    for (int u = F.vcu; u < 1024; u += F.G) gmlp_unit(F, in, u);
    for (int u = F.vcu; u < 512; u += F.G) {
        const int half = u & 1, qb = (u >> 1) & 15, bh = u >> 5;
        const bf16* Q = WSP(bf16, WS_QMN) + ((size_t)bh * 4096 + qb * 256 + 32 * F.wave) * 256;
        const bf16* Kt = WSP(bf16, WS_MKT) + (size_t)bh * 4 * (32 * 64 * 8);
        const bf16* Vt = WSP(bf16, WS_MVT) + (size_t)(bh * 2 + half) * 4 * (4 * 64 * 32);
        bf16* O = WSP(bf16, WS_CATT) + ((size_t)(bh >> 2) * 4096 + qb * 256 + 32 * F.wave) * 1024 + (bh & 3) * 256 + half * 128;
        attn_unit<256, 2, false>(F.lds + RING_OFF, Q, 256, Kt, Vt, 4, 0, O, 1024, F.wave, F.lane);
    }
    xcd_barrier(bar);

    for (int t = gw; t < T; t += NGW) p4_token(F, in, t);
    xcd_barrier(bar);

    {   const int bh = F.vcu >> 2, s = F.vcu & 3;
        for (int i = 0; i < 4; ++i) {
            const int qb = (i == 0) ? s : (i == 1) ? 7 - s : (i == 2) ? 8 + s : 15 - s;
            const bf16* Q = WSP(bf16, WS_QF) + ((size_t)bh * 4096 + qb * 256 + 32 * F.wave) * 192;
            const bf16* Kt = WSP(bf16, WS_KFT) + (size_t)bh * 64 * (24 * 64 * 8);
            const bf16* Vt = WSP(bf16, WS_VFT) + (size_t)bh * 64 * (4 * 64 * 32);
            bf16* O = WSP(bf16, WS_BATT) + ((size_t)(bh >> 4) * 4096 + qb * 256 + 32 * F.wave) * 2048 + (bh & 15) * 128;
            attn_unit<192, 3, true>(F.lds + RING_OFF, Q, 192, Kt, Vt, 4 * (qb + 1), qb * 256 + 32 * F.wave, O, 2048, F.wave, F.lane);
        }
    }
    xcd_barrier(bar);

    {   pg8::StaticOrder S; S.init(T, 2048, F.G, (int)blockIdx.x);
        {   pg8::Gemm g{WSP(pbf, WS_AOUT), WSP(pbf, WS_WPAT), T, 2048, 1024, 1024};
            pg8::EpiGateAcc<true> E{WSP(pbf, WS_P1), P1_G, WSP(pbf, WS_MERGED)};
            pg8::gemm_phase<pg8::EpiGateAcc<true>, pg8::StaticOrder, true, true>(F.lds + RING_OFF, g, S, E); }
        {   pg8::Gemm g{WSP(pbf, WS_BATT), WSP(pbf, WS_WPBT), T, 2048, 2048, 2048};
            pg8::EpiGateAcc<false> E{WSP(pbf, WS_P1), P1_G + 2048, WSP(pbf, WS_MERGED)};
            pg8::gemm_phase<pg8::EpiGateAcc<false>, pg8::StaticOrder, true, true>(F.lds + RING_OFF, g, S, E); }
        {   pg8::Gemm g{WSP(pbf, WS_CATT), WSP(pbf, WS_WPCT), T, 2048, 1024, 1024};
            pg8::EpiGateAcc<false> E{WSP(pbf, WS_P1), P1_G + 4096, WSP(pbf, WS_MERGED)};
            pg8::gemm_phase<pg8::EpiGateAcc<false>, pg8::StaticOrder, true, true>(F.lds + RING_OFF, g, S, E); }
    }
    xcd_barrier(bar);

    {   pg8::Gemm g{WSP(pbf, WS_MERGED), WSP(pbf, WS_WOT), T, 2048, 2048, 2048};
        pg8::StaticOrder S; S.init(T, 2048, F.G, (int)blockIdx.x);
        pg8::EpiX1 E{in[0], WSP(float, WS_X1)};
        pg8::gemm_phase<pg8::EpiX1, pg8::StaticOrder, true, true>(F.lds + RING_OFF, g, S, E);
    }
    xcd_barrier(bar);

    p8_router(F, in);
    xcd_barrier(bar);

    build_moe_tab(F);
    for (int t = gw; t < T; t += NGW) p9_scatter_token(F, in, t);
    xcd_barrier(bar);

    {   pg8::Gemm g{WSP(pbf, WS_HS), WSP(pbf, WS_WGUT), MAXSLOT, NE * 4096, 2048, 2048};
        pg8::MoeOrder S{(const LAS int*)(F.lds + LTAB_OFF), 16, (int)(blockIdx.x & 7), (int)(blockIdx.x >> 3)};
        pg8::EpiSwiGLU E{in[30], WSP(pbf, WS_ACT)};
        pg8::gemm_phase<pg8::EpiSwiGLU, pg8::MoeOrder, true, true>(F.lds + RING_OFF, g, S, E);
    }
    xcd_barrier(bar);

    {   pg8::Gemm g{WSP(pbf, WS_ACT), WSP(pbf, WS_WDT), MAXSLOT, NE * 2048, 2048, 2048};
        pg8::MoeOrder S{(const LAS int*)(F.lds + LTAB_OFF), 8, (int)(blockIdx.x & 7), (int)(blockIdx.x >> 3)};
        pg8::EpiDown E{in[32], WSP(pbf, WS_Y)};
        pg8::gemm_phase<pg8::EpiDown, pg8::MoeOrder, true, true>(F.lds + RING_OFF, g, S, E);
    }
    xcd_barrier(bar);

    for (int t = gw; t < T; t += NGW) p12_combine_token(F, args.out, t);
}

extern "C" void kernel_launch(void* const* d_in, const int* in_sizes, int n_in, void* d_out, int out_size, void* d_ws, size_t ws_size, hipStream_t stream) {
    static int grid = 0;
    if (grid == 0) {
        if (n_in != 33 || out_size != T * D || ws_size < WS_END) { fprintf(stderr, "kernel_launch: unexpected problem (n_in %d out %d ws %zu need %zu)\n", n_in, out_size, ws_size, (size_t)WS_END); grid = -1; return; }
        (void)in_sizes;
        if (hipFuncSetAttribute((const void*)mk_fwd, hipFuncAttributeMaxDynamicSharedMemorySize, LDS_BYTES) != hipSuccess) { fprintf(stderr, "kernel_launch: hipFuncSetAttribute failed\n"); grid = -1; return; }
        int per_cu = 0;
        if (hipOccupancyMaxActiveBlocksPerMultiprocessor(&per_cu, (const void*)mk_fwd, NWAVES * 64, LDS_BYTES) != hipSuccess || per_cu < 1) fprintf(stderr, "kernel_launch: occupancy query reports %d\n", per_cu);
        (void)hipGetLastError();
        grid = 256;
    }
    if (grid < 0) return;
    if (hipMemsetAsync((char*)d_ws + WS_CTL, 0, CTL_ZERO_BYTES, stream) != hipSuccess) { fprintf(stderr, "kernel_launch: memset failed\n"); return; }
    Args a{};
    for (int i = 0; i < 33; ++i) a.in[i] = (const float*)d_in[i];
    a.out = (float*)d_out; a.ws = (unsigned char*)d_ws;
    hipLaunchKernelGGL(mk_fwd, dim3(grid), dim3(NWAVES * 64), LDS_BYTES, stream, a);
}
```

```cpp
#include <hip/hip_runtime.h>
#include <cstdio>
#include <cstdint>
#include <cmath>
#ifndef REP_P0
#define REP_P0 1
#endif
#ifndef REP_P1
#define REP_P1 1
#endif
#ifndef REP_P3
#define REP_P3 1
#endif
#ifndef REP_P5
#define REP_P5 1
#endif
#ifndef REP_P6
#define REP_P6 1
#endif
#ifndef REP_P10
#define REP_P10 1
#endif
#ifndef REP_P11
#define REP_P11 1
#endif
#ifndef REP_CONV
#define REP_CONV 1
#endif
#ifndef ATTN_RB2
#define ATTN_RB2 1
#endif
#ifndef SPLIT_FREE
#define SPLIT_FREE 2
#endif
#ifndef CONV_ROWS
#define CONV_ROWS 256
#endif
#ifndef UV_F8
#define UV_F8 2
#endif
#ifndef ATTN_XCDMAP
#define ATTN_XCDMAP 0
#endif
#ifndef P10_PROBE
#define P10_PROBE 0
#endif
#ifndef KROT_MASK
#define KROT_MASK 0
#endif
#ifndef ROUTER_BF16X2
#define ROUTER_BF16X2 1
#endif
#ifndef CONV_OFFLOAD
#define CONV_OFFLOAD 1
#endif
#ifndef STAGE_IN_MMA
#define STAGE_IN_MMA 0
#endif
#ifndef ATT_SLEEP
#define ATT_SLEEP 0
#endif
#ifndef ATT_VPRE
#define ATT_VPRE 0
#endif
#ifndef KSEG_BATCH16
#define KSEG_BATCH16 0
#endif
#ifndef ATT_PAIR
#define ATT_PAIR 1
#endif
#ifndef PFETCH_MASK
#define PFETCH_MASK 0
#endif
#ifndef CONV_SLEEP
#define CONV_SLEEP 0
#endif
#ifndef ATT_REBAL
#define ATT_REBAL 0
#endif
#ifndef ATT_SPLITQK
#define ATT_SPLITQK 1
#endif
#ifndef ATT_DEFER
#define ATT_DEFER 0
#endif
#ifndef PRO_SPLIT
#define PRO_SPLIT 2
#endif
#ifndef ATT_PERMLANE
#define ATT_PERMLANE 1
#endif
#ifndef ATT_POLL_SLEEP
#define ATT_POLL_SLEEP 1
#endif
#ifndef ATT_SPREAD
#define ATT_SPREAD 0
#endif
#ifndef STAGE_AUX
#define STAGE_AUX 0
#endif
#ifndef MOE_MAP2
#define MOE_MAP2 0
#endif
#ifndef ATT_OWIDE
#define ATT_OWIDE 1
#endif
#ifndef XL_FAST
#define XL_FAST 1
#endif
#ifndef EPIX1_BATCH
#define EPIX1_BATCH 0
#endif
#ifndef SPLIT_PRIO
#define SPLIT_PRIO 0
#endif
#ifndef SPLIT_NOCONV
#define SPLIT_NOCONV 0
#endif
#ifndef CONV_QUOTA
#define CONV_QUOTA(it) (1 + ((it) & 1))
#endif
#ifndef ATTN_SPLIT
#define ATTN_SPLIT 1
#endif
#ifndef P7_ALIGN
#define P7_ALIGN true
#endif
#ifndef ATTN_F8
#define ATTN_F8 1
#endif
#ifndef GATE_BF16SPLIT
#define GATE_BF16SPLIT 0
#endif
#ifndef GATE_SKIP
#define GATE_SKIP 0
#endif
#ifndef GATE_F8
#define GATE_F8 1
#endif
#ifndef CONV_DMA
#define CONV_DMA 1
#endif
#ifndef PITCH_PAD
#define PITCH_PAD 0
#endif
#ifndef GEMM_ALIGN
#define GEMM_ALIGN true
#endif
#ifndef CONV_IN_P1
#define CONV_IN_P1 1
#endif
#ifndef REP_P7
#define REP_P7 1
#endif
#ifndef REP_P2
#define REP_P2 1
#endif
#ifndef REP_P4
#define REP_P4 1
#endif
#ifndef REP_P9
#define REP_P9 1
#endif
#ifndef REP_P12
#define REP_P12 1
#endif
constexpr int NWAVES = 8;
constexpr int T = 16384, D = 2048, NBATCH = 4, SEQ = 4096;
constexpr int HPITCH = 2048 + PITCH_PAD;
constexpr int P1N = 10496;
constexpr int P1_U = 0, P1_V = 1024, P1_CQ = 2048, P1_CKV = 2560, P1_QM = 3072, P1_KR = 4096, P1_G = 4352;
constexpr int P1_TILES = 41, MEMROWS = 1024;
constexpr int NH = 16, QKD = 192, NOPE = 128, ROPE = 64, VD = 128;
constexpr int NE = 32, DFF = 2048, MAXBLK = 288, MAXSLOT = MAXBLK * 256;
constexpr float EPS = 1e-6f;
constexpr float LOG2E = 1.4426950408889634f;
constexpr float MLA_QSCALE = 0.07216878364870322f * LOG2E;
constexpr float MEM_QSCALE = 0.0625f * LOG2E;
constexpr float MOE_WSCALE = 64.0f;
constexpr unsigned MOE_SW = 0x79797979u, MOE_SX = 0x7f7f7f7fu;
constexpr float UP_WSCALE = 16.0f;
constexpr unsigned UP_SW = 0x7b7b7b7bu;

constexpr size_t MiB = 1u << 20;
constexpr size_t WS_CTL = 0, CTL_ZERO_BYTES = 1 * MiB;
constexpr size_t WS_W1T   = 1 * MiB;
constexpr size_t WS_WUQT  = WS_W1T + (size_t)(P1N + 2048) * HPITCH * 2;
constexpr size_t WS_WUKVT = WS_WUQT + (size_t)4096 * 512 * 2;
constexpr size_t WS_WPT   = WS_WUKVT + (size_t)4096 * 512 * 2;
constexpr size_t WS_WOT   = WS_WPT + (size_t)2048 * 4096 * 2;
constexpr size_t WS_WGUT  = WS_WOT + (size_t)2048 * 2048 * 2;
constexpr size_t WS_WDT   = WS_WGUT + (size_t)NE * 4096 * 2048 * 2;
constexpr size_t WS_WSM   = WS_WDT + (size_t)NE * 2048 * 2048 * 2;
constexpr size_t WS_RWG   = WS_WSM + (size_t)8 * 128 * 128 * 2;
constexpr size_t WS_H     = WS_RWG + (size_t)2048 * 32 * 4;
constexpr size_t WS_P1    = WS_H + (size_t)(T + MEMROWS) * HPITCH * 2;
constexpr size_t WS_MKV   = WS_P1 + (size_t)T * P1N * 2;
constexpr size_t WS_VSTAT = WS_MKV + (size_t)MEMROWS * 2048 * 2;
constexpr size_t WS_CQN   = WS_VSTAT + (size_t)T * 8;
constexpr size_t WS_CKVN  = WS_CQN + (size_t)T * 512 * 2;
constexpr size_t WS_QMN   = WS_CKVN + (size_t)T * 512 * 2;
constexpr size_t WS_KRR   = WS_QMN + (size_t)T * 1024 * 2;
constexpr size_t WS_KRSS  = WS_KRR + (size_t)T * 64 * 4;
constexpr size_t WS_ROPE  = WS_KRSS + (size_t)T * 4;
constexpr size_t WS_MKT   = WS_ROPE + (size_t)T * 64 * 4;
constexpr size_t WS_MVT   = WS_MKT + (size_t)MEMROWS * 1024 * 2;
constexpr size_t WS_QRAW  = WS_MVT + (size_t)MEMROWS * 1024 * 2;
constexpr size_t WS_KVRAW = WS_QRAW + (size_t)T * 3072 * 2;
constexpr size_t WS_QF    = WS_KVRAW + (size_t)T * 4096 * 2;
constexpr size_t WS_KFT   = WS_QF + (size_t)T * 3072 * 2;
constexpr size_t WS_VFT   = WS_KFT + (size_t)T * 3072 * 2;
constexpr size_t WS_ABC   = WS_VFT + (size_t)T * 2048 * 2;
constexpr int ABC_LD = 2560, ABC_ROWB = 5120, ABC_BB = 2048, ABC_CB = 4096;
constexpr float ATT_OS = 32.0f; constexpr unsigned ATT_OSB = 0x7a7a7a7au;
constexpr size_t WS_MERGED= WS_ABC + (size_t)T * 4096 * 2;
constexpr size_t WS_X1    = WS_MERGED + (size_t)T * 2048 * 2;
constexpr size_t WS_TKE   = WS_X1 + (size_t)T * 2048 * 4;
constexpr size_t WS_TKR   = WS_TKE + (size_t)T * 16;
constexpr size_t WS_TKG   = WS_TKR + (size_t)T * 16;
constexpr size_t WS_HS    = WS_TKG + (size_t)T * 16;
constexpr size_t WS_ACT   = WS_HS + (size_t)MAXSLOT * 2048 * 2;
constexpr size_t WS_Y     = WS_ACT + (size_t)MAXSLOT * 2048 * 2;
constexpr size_t WS_H8    = WS_Y + (size_t)MAXSLOT * 2048 * 2;
constexpr size_t WS_WG8U  = WS_H8 + (size_t)(T + MEMROWS) * 2048;
constexpr size_t WS_WG8   = WS_WG8U + (size_t)8 * 256 * 2048;
constexpr size_t WS_END   = WS_WG8 + (size_t)41 * 256 * 2048;
constexpr int CW_TMO = 0, CW_CODE = 1;
constexpr int CW_CNT = 64;
constexpr int CW_BAR = 4096;

constexpr int RING_OFF = 0, RING_BYTES = ATT_PAIR ? 148480 : 133120;
constexpr int LDSCTL_OFF = RING_BYTES, MISC_OFF = LDSCTL_OFF + 320;
constexpr int LTAB_OFF = LDSCTL_OFF + 1024;
constexpr int LEPI_OFF = LDSCTL_OFF + 2048;
constexpr int LDS_BYTES = RING_BYTES + 14336;

#define XL_DPP(v, ctrl) __uint_as_float((unsigned)__builtin_amdgcn_update_dpp(0, (int)__float_as_uint(v), ctrl, 0xf, 0xf, true))
__device__ __forceinline__ float xl_sum16(float v) { v += XL_DPP(v, 0xB1); v += XL_DPP(v, 0x4E); v += XL_DPP(v, 0x141); v += XL_DPP(v, 0x140); return v; }
__device__ __forceinline__ float xl_swap16_sum(float v) { const auto r = __builtin_amdgcn_permlane16_swap(__float_as_uint(v), __float_as_uint(v), false, false); return __uint_as_float(r[0]) + __uint_as_float(r[1]); }
__device__ __forceinline__ float xl_swap32_sum(float v) { const auto r = __builtin_amdgcn_permlane32_swap(__float_as_uint(v), __float_as_uint(v), false, false); return __uint_as_float(r[0]) + __uint_as_float(r[1]); }
__device__ __forceinline__ float xl_swap32_max(float v) { const auto r = __builtin_amdgcn_permlane32_swap(__float_as_uint(v), __float_as_uint(v), false, false); return fmaxf(__uint_as_float(r[0]), __uint_as_float(r[1])); }
namespace pg8 {
#define PG8_LAS __attribute__((address_space(3)))
typedef unsigned short bf16_t;
typedef short bf16x8 __attribute__((ext_vector_type(8)));
typedef float f32x4 __attribute__((ext_vector_type(4)));
typedef unsigned u32x4 __attribute__((ext_vector_type(4)));
constexpr int BM = 256, BK = 64, HALF = 128, HTB = HALF * BK * 2  , STAGE_BYTES = 8 * HTB, NXCD = 8, WGM = 8;

__host__ __device__ __forceinline__ int lds_byte(int r, int c) { const int st = (r >> 4) * 2 + (c >> 5), rr = r & 15, cc = c & 31, ob = rr * 64 + cc * 2; return st * 1024 + (ob ^ (((ob >> 9) & 1) << 5)); }
__host__ __device__ __forceinline__ void stage_rc(int b, int& R, int& C) { const int st = b / 1024, sb = b % 1024, swz = sb ^ (((sb >> 9) & 1) << 5); R = (st >> 1) * 16 + swz / 64; C = (st & 1) * 32 + (swz % 64) / 2; }
__host__ __device__ __forceinline__ int perm32(int rho) { const int n = rho >> 4, i = rho & 15; return 8 * (i >> 2) + 4 * n + (i & 3); }

__device__ __forceinline__ int pg8_lane() { int l; asm volatile("v_mbcnt_lo_u32_b32 %0, -1, 0\n\tv_mbcnt_hi_u32_b32 %0, -1, %0" : "=v"(l)); return l; }
struct Unit { int pm, pn; int kr = 0; };
typedef int i32x4 __attribute__((ext_vector_type(4)));
typedef int i32x8 __attribute__((ext_vector_type(8)));
struct Gemm { const bf16_t* A; const bf16_t* Bt; int M, N, K, lda, ldb; unsigned sw = 0x7f7f7f7fu, sx = 0x7f7f7f7fu; };

struct StaticOrder {
    int nM, nN, nwg, G, c;
    __host__ __device__ void init(int M, int N, int G_, int c_) { nM = M / BM; nN = N / BM; nwg = nM * nN; G = G_; c = c_; }
    __host__ __device__ bool next(int i, Unit& u) const {
        const long L = (long)i * G + c; if (L >= nwg) return false;
        int wgid = (int)L; { const int q = nwg / NXCD, r = nwg % NXCD, xcd = wgid % NXCD, off = wgid / NXCD; wgid = (xcd < r ? xcd * (q + 1) : r * (q + 1) + (xcd - r) * q) + off; }
        const int nig = WGM * nN, gid = wgid / nig, fm = gid * WGM, gsz = (nM - fm) < WGM ? (nM - fm) : WGM;
        u.pm = fm + ((wgid % nig) % gsz); u.pn = (wgid % nig) / gsz; return true;
    }
    __device__ __forceinline__ void a_ready(const Unit&) const {}
    __device__ __forceinline__ void done(const Unit&) const {}
};

__device__ __forceinline__ unsigned cvt_pk_bf16(float lo, float hi) { unsigned r; asm volatile("v_cvt_pk_bf16_f32 %0, %1, %2" : "=v"(r) : "v"(lo), "v"(hi)); return r; }
typedef float f32x2 __attribute__((ext_vector_type(2)));

template <class E, class = void> struct probe_of { static constexpr int v = 0; };
template <class E> struct probe_of<E, decltype((void)E::PROBE)> { static constexpr int v = E::PROBE; };
template <class Epi, class Sched, bool ALIGN_EPI = false, bool SP2 = false, bool F8 = false, int MIXT = 0, bool KROT = false, bool PFETCH = false>
__device__ __forceinline__ void gemm_phase(PG8_LAS unsigned char* lds, const Gemm g, const Sched& S, const Epi& E, const int wave_) {
    int tid_ = wave_ * 64 + pg8_lane(); asm volatile("" : "+v"(tid_));
    const int tid = tid_, wid = __builtin_amdgcn_readfirstlane(tid >> 6), lane = tid & 63, wr = wid >> 2, wc = wid & 3, fr = lane & 15, fq = lane >> 4;
    const int K = g.K, nt = K / BK;
    unsigned voffA[2], voffB[2];
#pragma unroll
    for (int i = 0; i < 2; ++i) { int R, C; stage_rc(tid * 16 + i * 8192, R, C); const int Rb = Epi::PERM ? ((R & ~31) + perm32(R & 31)) : R;
        voffA[i] = (unsigned)(R * g.lda + C) * 2u; voffB[i] = (unsigned)(Rb * g.ldb + C) * 2u; }
    const size_t kstep = (size_t)(BK * 2);
    const size_t hstepA = (size_t)HALF * g.lda * 2, hstepB = (size_t)HALF * g.ldb * 2;
    const size_t tstepA = 2 * hstepA, tstepB = 2 * hstepB;
    const unsigned ldsw = (unsigned)wid * 1024u;
    unsigned pfoff = 0;
    if constexpr (PFETCH) { const int prow = wid * 32 + (lane & 31); pfoff = (lane < 32) ? (unsigned)(prow * g.lda) * 2u : (unsigned)(prow * g.ldb) * 2u; }
    PG8_LAS unsigned* const pfl = (PG8_LAS unsigned*)(lds + RING_BYTES + 8192 + wid * 256);
#define PG8_PF(baseA_, baseB_) do { if constexpr (PFETCH) { const char* pb_ = (lane < 32) ? (const char*)(baseA_) : (const char*)(baseB_); \
        __builtin_amdgcn_global_load_lds((const unsigned*)(pb_ + pfoff), pfl, 4, 0, 0); } } while (0)
#define PG8_WV1 do { if constexpr (PFETCH) PG8_WAIT_V(9); else PG8_WAIT_V(8); } while (0)
#define PG8_WV2 do { if constexpr (PFETCH) PG8_WAIT_V(10); else PG8_WAIT_V(8); } while (0)
    const int aoff = lds_byte(wr * 64 + fr, fq * 8), boff = lds_byte(wc * 32 + fr, fq * 8);
#define PG8_SA(b, h) (((b) * 2 + (h)) * HTB)
#define PG8_SB(b, h) ((4 + (b) * 2 + (h)) * HTB)
#define PG8_STAGE(bufoff, gbase, voff) do { if constexpr (probe_of<Epi>::v != 3) _Pragma("unroll") for (int _i = 0; _i < 2; ++_i) \
        __builtin_amdgcn_global_load_lds((const unsigned*)((const char*)(gbase) + (voff)[_i]), (PG8_LAS unsigned*)(lds + (bufoff) + ldsw + _i * 8192), 16, 0, STAGE_AUX); } while (0)
#define PG8_LDA(dst, b, h) do { if constexpr (probe_of<Epi>::v != 2) _Pragma("unroll") for (int m = 0; m < 4; ++m) _Pragma("unroll") for (int k = 0; k < 2; ++k) dst[m][k] = *(const PG8_LAS bf16x8*)(lds + PG8_SA(b, h) + aoff + m * 2048 + k * 1024); } while (0)
#define PG8_LDB(dst, b, h) do { if constexpr (probe_of<Epi>::v != 2) _Pragma("unroll") for (int n = 0; n < 2; ++n) _Pragma("unroll") for (int k = 0; k < 2; ++k) dst[n][k] = *(const PG8_LAS bf16x8*)(lds + PG8_SB(b, h) + boff + n * 2048 + k * 1024); } while (0)
#define PG8_MMA(ai, bj, At, Bt) do { __builtin_amdgcn_s_setprio(1); \
        if (F8 || (MIXT > 0 && f8now)) { _Pragma("unroll") for (int m = 0; m < 4; ++m) _Pragma("unroll") for (int n = 0; n < 2; ++n) { \
            const i32x8 a8_ = __builtin_shufflevector(__builtin_bit_cast(i32x4, At[m][0]), __builtin_bit_cast(i32x4, At[m][1]), 0, 1, 2, 3, 4, 5, 6, 7); \
            const i32x8 b8_ = __builtin_shufflevector(__builtin_bit_cast(i32x4, Bt[n][0]), __builtin_bit_cast(i32x4, Bt[n][1]), 0, 1, 2, 3, 4, 5, 6, 7); \
            if constexpr (probe_of<Epi>::v == 0 || probe_of<Epi>::v == 3) asm volatile("v_mfma_scale_f32_16x16x128_f8f6f4 %0, %1, %2, %0, %3, %4 op_sel_hi:[0,0,0]" : "+v"(acc[ai][bj][m][n]) : "v"(b8_), "v"(a8_), "v"(sw_), "v"(sx_)); \
            else asm volatile("" :: "v"(b8_), "v"(a8_)); } } \
        else { _Pragma("unroll") for (int m = 0; m < 4; ++m) _Pragma("unroll") for (int n = 0; n < 2; ++n) _Pragma("unroll") for (int k = 0; k < 2; ++k) \
            acc[ai][bj][m][n] = __builtin_amdgcn_mfma_f32_16x16x32_bf16(Bt[n][k], At[m][k], acc[ai][bj][m][n], 0, 0, 0); } \
        __builtin_amdgcn_s_setprio(0); } while (0)
#define PG8_STAGE1(bufoff, gbase, voff, i_) __builtin_amdgcn_global_load_lds((const unsigned*)((const char*)(gbase) + (voff)[i_]), (PG8_LAS unsigned*)(lds + (bufoff) + ldsw + (i_) * 8192), 16, 0, 0)
#define PG8_MMAS(ai, bj, At, Bt, M0, S0, M1, S1) do { __builtin_amdgcn_s_setprio(1); \
        if (F8 || (MIXT > 0 && f8now)) { _Pragma("unroll") for (int m = 0; m < 4; ++m) { _Pragma("unroll") for (int n = 0; n < 2; ++n) { \
            const i32x8 a8_ = __builtin_shufflevector(__builtin_bit_cast(i32x4, At[m][0]), __builtin_bit_cast(i32x4, At[m][1]), 0, 1, 2, 3, 4, 5, 6, 7); \
            const i32x8 b8_ = __builtin_shufflevector(__builtin_bit_cast(i32x4, Bt[n][0]), __builtin_bit_cast(i32x4, Bt[n][1]), 0, 1, 2, 3, 4, 5, 6, 7); \
            if constexpr (probe_of<Epi>::v == 0 || probe_of<Epi>::v == 3) asm volatile("v_mfma_scale_f32_16x16x128_f8f6f4 %0, %1, %2, %0, %3, %4 op_sel_hi:[0,0,0]" : "+v"(acc[ai][bj][m][n]) : "v"(b8_), "v"(a8_), "v"(sw_), "v"(sx_)); \
            else asm volatile("" :: "v"(b8_), "v"(a8_)); } \
            if (m == (M0)) { PG8_SCHED; S0; PG8_SCHED; } if (m == (M1)) { PG8_SCHED; S1; PG8_SCHED; } } } \
        else { _Pragma("unroll") for (int m = 0; m < 4; ++m) { _Pragma("unroll") for (int n = 0; n < 2; ++n) _Pragma("unroll") for (int k = 0; k < 2; ++k) \
            acc[ai][bj][m][n] = __builtin_amdgcn_mfma_f32_16x16x32_bf16(Bt[n][k], At[m][k], acc[ai][bj][m][n], 0, 0, 0); \
            if (m == (M0)) { PG8_SCHED; S0; PG8_SCHED; } if (m == (M1)) { PG8_SCHED; S1; PG8_SCHED; } } } \
        __builtin_amdgcn_s_setprio(0); } while (0)
#define PG8_WAIT_V(n) asm volatile("s_waitcnt vmcnt(" #n ")" ::: "memory")
#define PG8_WAIT_L(n) asm volatile("s_waitcnt lgkmcnt(" #n ")" ::: "memory")
#define PG8_BAR __builtin_amdgcn_s_barrier()
#define PG8_SCHED __builtin_amdgcn_sched_barrier(0)
    Unit cur, nxt; int ui = 0;
    if (!S.next(0, cur)) return;
    f32x4 acc[2][2][4][2];
#pragma unroll
    for (int a = 0; a < 2; ++a)
#pragma unroll
        for (int b = 0; b < 2; ++b)
#pragma unroll
            for (int m = 0; m < 4; ++m)
#pragma unroll
                for (int n = 0; n < 2; ++n) acc[a][b][m][n] = (f32x4){0.f, 0.f, 0.f, 0.f};
    bf16x8 At[4][2], B0[2][2], B1[2][2];
    if constexpr (probe_of<Epi>::v == 2) {
#pragma unroll
        for (int m = 0; m < 4; ++m)
#pragma unroll
            for (int k = 0; k < 2; ++k) At[m][k] = (bf16x8){0, 0, 0, 0, 0, 0, 0, 0};
#pragma unroll
        for (int n = 0; n < 2; ++n)
#pragma unroll
            for (int k = 0; k < 2; ++k) { B0[n][k] = (bf16x8){0, 0, 0, 0, 0, 0, 0, 0}; B1[n][k] = (bf16x8){0, 0, 0, 0, 0, 0, 0, 0}; }
    }
    const int sw_ = (int)g.sw, sx_ = (int)g.sx;
    const char* cA = (const char*)g.A + (size_t)cur.pm * tstepA; const char* cB = (const char*)g.Bt + (size_t)cur.pn * tstepB;
    const int krs = (KROT && MIXT == 0 && !Epi::KSEG && (nt & 15) == 0) ? (nt >> 3) : 0;
    int ckr = krs * (cur.kr & 7);
    const char* const pA = cA + (size_t)ckr * kstep; const char* const pB = cB + (size_t)ckr * kstep;
    S.a_ready(cur);
    if constexpr (SP2) {
        PG8_STAGE(PG8_SB(0, 0), pB, voffB); PG8_STAGE(PG8_SB(0, 1), pB + hstepB, voffB); PG8_STAGE(PG8_SA(0, 0), pA, voffA); PG8_STAGE(PG8_SA(0, 1), pA + hstepA, voffA);
        if (wr == 1) PG8_BAR;
        PG8_WAIT_V(2); PG8_BAR;
        PG8_STAGE(PG8_SB(1, 0), pB + kstep, voffB); PG8_STAGE(PG8_SA(1, 0), pA + kstep, voffA); PG8_STAGE(PG8_SB(1, 1), pB + hstepB + kstep, voffB);
        PG8_PF(pA + 2 * kstep, pB + 2 * kstep);
        if constexpr (PFETCH) PG8_WAIT_V(7); else PG8_WAIT_V(6);
        PG8_BAR;
    } else {
        PG8_STAGE(PG8_SB(0, 0), pB, voffB); PG8_STAGE(PG8_SA(0, 0), pA, voffA); PG8_STAGE(PG8_SB(0, 1), pB + hstepB, voffB); PG8_STAGE(PG8_SA(0, 1), pA + hstepA, voffA);
        if (wr == 1) PG8_BAR;
        PG8_WAIT_V(4); PG8_BAR;
        PG8_STAGE(PG8_SB(1, 0), pB + kstep, voffB); PG8_STAGE(PG8_SA(1, 0), pA + kstep, voffA); PG8_STAGE(PG8_SB(1, 1), pB + hstepB + kstep, voffB);
        PG8_WAIT_V(6); PG8_BAR;
    }
    for (;;) {
        const bool has_next = S.next(ui + 1, nxt);
        const char* nA = has_next ? (const char*)g.A + (size_t)nxt.pm * tstepA : cA; const char* nB = has_next ? (const char*)g.Bt + (size_t)nxt.pn * tstepB : cB;
        const int nkr = has_next ? krs * (nxt.kr & 7) : ckr;
        for (int t = 0; t < (MIXT > 0 ? MIXT : nt); t += 2) {
            constexpr bool f8now = false; (void)f8now;
            const bool last = (t == nt - 2);
            if constexpr (Epi::KSEG) { if (t == Epi::KSEG_T1 || t == Epi::KSEG_T2) { if constexpr (F8 || MIXT > 0) asm volatile("s_nop 15\n\ts_nop 15" ::: "memory"); E.kseg(acc, cur, t, wr, wc, fr, fq); } }
            int r0 = t + ckr; if (r0 >= nt) r0 -= nt; int r2 = r0 + 2; if (r2 >= nt) r2 -= nt;
            const char* a1 = cA + (size_t)(r0 + 1) * kstep;
            const char* a2 = last ? nA + (size_t)nkr * kstep : cA + (size_t)r2 * kstep; const char* b2 = last ? nB + (size_t)nkr * kstep : cB + (size_t)r2 * kstep;
            const char* a3 = a2 + kstep; const char* b3 = b2 + kstep;
            int r4 = t + 4, k4 = ckr; const char* pfa4 = cA; const char* pfb4 = cB;
            if (r4 >= nt) { r4 -= nt; k4 = nkr; pfa4 = nA; pfb4 = nB; }
            r4 += k4; if (r4 >= nt) r4 -= nt;
            pfa4 += (size_t)r4 * kstep; pfb4 += (size_t)r4 * kstep;
            if (last && has_next) S.a_ready(nxt);
            if constexpr (SP2) {
#if STAGE_IN_MMA
            PG8_LDB(B0, 0, 0); PG8_LDB(B1, 0, 1); PG8_SCHED; PG8_LDA(At, 0, 0);
            PG8_WAIT_V(6); PG8_WAIT_L(0); PG8_BAR;
            PG8_MMAS(0, 0, At, B0, 1, PG8_STAGE1(PG8_SA(1, 1), a1 + hstepA, voffA, 0), 9, (void)0); PG8_MMAS(0, 1, At, B1, 1, PG8_STAGE1(PG8_SA(1, 1), a1 + hstepA, voffA, 1), 9, (void)0); PG8_BAR; PG8_SCHED;
            PG8_LDA(At, 0, 1); PG8_STAGE(PG8_SB(0, 0), b2, voffB);
            PG8_WAIT_V(4); PG8_WAIT_L(0); PG8_BAR;
            PG8_MMAS(1, 0, At, B0, 0, PG8_STAGE1(PG8_SB(0, 1), b2 + hstepB, voffB, 0), 2, PG8_STAGE1(PG8_SB(0, 1), b2 + hstepB, voffB, 1));
            PG8_MMAS(1, 1, At, B1, 0, PG8_STAGE1(PG8_SA(0, 0), a2, voffA, 0), 2, PG8_STAGE1(PG8_SA(0, 0), a2, voffA, 1)); PG8_BAR; PG8_SCHED;
            PG8_LDB(B0, 1, 0); PG8_LDB(B1, 1, 1); PG8_SCHED; PG8_LDA(At, 1, 0);
            PG8_WAIT_V(6); PG8_WAIT_L(0); PG8_BAR;
            PG8_MMAS(0, 0, At, B0, 1, PG8_STAGE1(PG8_SA(0, 1), a2 + hstepA, voffA, 0), 9, (void)0); PG8_MMAS(0, 1, At, B1, 1, PG8_STAGE1(PG8_SA(0, 1), a2 + hstepA, voffA, 1), 9, (void)0); PG8_BAR; PG8_SCHED;
            PG8_LDA(At, 1, 1); PG8_STAGE(PG8_SB(1, 0), b3, voffB);
            PG8_WAIT_V(4); PG8_WAIT_L(0); PG8_BAR;
            PG8_MMAS(1, 0, At, B0, 0, PG8_STAGE1(PG8_SB(1, 1), b3 + hstepB, voffB, 0), 2, PG8_STAGE1(PG8_SB(1, 1), b3 + hstepB, voffB, 1));
            PG8_MMAS(1, 1, At, B1, 0, PG8_STAGE1(PG8_SA(1, 0), a3, voffA, 0), 2, PG8_STAGE1(PG8_SA(1, 0), a3, voffA, 1)); PG8_BAR; PG8_SCHED;
#else
            PG8_LDB(B0, 0, 0); PG8_LDB(B1, 0, 1); PG8_SCHED; PG8_LDA(At, 0, 0); PG8_STAGE(PG8_SA(1, 1), a1 + hstepA, voffA);
            PG8_WV1; PG8_WAIT_L(0); PG8_BAR; PG8_MMA(0, 0, At, B0); PG8_MMA(0, 1, At, B1); PG8_BAR; PG8_SCHED;
            PG8_LDA(At, 0, 1); PG8_STAGE(PG8_SB(0, 0), b2, voffB); PG8_STAGE(PG8_SB(0, 1), b2 + hstepB, voffB); PG8_STAGE(PG8_SA(0, 0), a2, voffA); PG8_PF(pfa4, pfb4);
            PG8_WV2; PG8_WAIT_L(0); PG8_BAR; PG8_MMA(1, 0, At, B0); PG8_MMA(1, 1, At, B1); PG8_BAR; PG8_SCHED;
            PG8_LDB(B0, 1, 0); PG8_LDB(B1, 1, 1); PG8_SCHED; PG8_LDA(At, 1, 0); PG8_STAGE(PG8_SA(0, 1), a2 + hstepA, voffA);
            PG8_WV1; PG8_WAIT_L(0); PG8_BAR; PG8_MMA(0, 0, At, B0); PG8_MMA(0, 1, At, B1); PG8_BAR; PG8_SCHED;
            PG8_LDA(At, 1, 1); PG8_STAGE(PG8_SB(1, 0), b3, voffB); PG8_STAGE(PG8_SB(1, 1), b3 + hstepB, voffB); PG8_STAGE(PG8_SA(1, 0), a3, voffA); PG8_PF(pfa4 + kstep, pfb4 + kstep);
            PG8_WV2; PG8_WAIT_L(0); PG8_BAR; PG8_MMA(1, 0, At, B0); PG8_MMA(1, 1, At, B1); PG8_BAR; PG8_SCHED;
#endif
            } else {
            PG8_LDB(B0, 0, 0); PG8_SCHED; PG8_LDA(At, 0, 0); PG8_STAGE(PG8_SA(1, 1), a1 + hstepA, voffA);
            PG8_WAIT_L(8); PG8_BAR; PG8_WAIT_L(0); PG8_MMA(0, 0, At, B0); PG8_BAR; PG8_SCHED;
            PG8_LDB(B1, 0, 1); PG8_STAGE(PG8_SB(0, 0), b2, voffB);
            PG8_BAR; PG8_WAIT_L(0); PG8_MMA(0, 1, At, B1); PG8_BAR;
            PG8_LDA(At, 0, 1); PG8_STAGE(PG8_SA(0, 0), a2, voffA);
            PG8_BAR; PG8_WAIT_L(0); PG8_MMA(1, 0, At, B0); PG8_BAR; PG8_SCHED;
            PG8_STAGE(PG8_SB(0, 1), b2 + hstepB, voffB);
            PG8_WAIT_V(6); PG8_BAR; PG8_MMA(1, 1, At, B1); PG8_BAR;
            PG8_LDB(B0, 1, 0); PG8_SCHED; PG8_LDA(At, 1, 0); PG8_STAGE(PG8_SA(0, 1), a2 + hstepA, voffA);
            PG8_WAIT_L(8); PG8_BAR; PG8_WAIT_L(0); PG8_MMA(0, 0, At, B0); PG8_BAR; PG8_SCHED;
            PG8_LDB(B1, 1, 1); PG8_STAGE(PG8_SB(1, 0), b3, voffB);
            PG8_BAR; PG8_WAIT_L(0); PG8_MMA(0, 1, At, B1); PG8_BAR;
            PG8_LDA(At, 1, 1); PG8_STAGE(PG8_SA(1, 0), a3, voffA);
            PG8_BAR; PG8_WAIT_L(0); PG8_MMA(1, 0, At, B0); PG8_BAR; PG8_SCHED;
            PG8_STAGE(PG8_SB(1, 1), b3 + hstepB, voffB);
            PG8_WAIT_V(6); PG8_BAR; PG8_MMA(1, 1, At, B1); PG8_BAR;
            }
                }
        if constexpr (MIXT > 0) for (int t = MIXT; t < nt; t += 2) {
            constexpr bool f8now = true; (void)f8now;
            const bool last = (t == nt - 2);
            if constexpr (Epi::KSEG) { if (t == Epi::KSEG_T1 || t == Epi::KSEG_T2) { if constexpr (F8 || MIXT > 0) asm volatile("s_nop 15\n\ts_nop 15" ::: "memory"); E.kseg(acc, cur, t, wr, wc, fr, fq); } }
            int r0 = t + ckr; if (r0 >= nt) r0 -= nt; int r2 = r0 + 2; if (r2 >= nt) r2 -= nt;
            const char* a1 = cA + (size_t)(r0 + 1) * kstep;
            const char* a2 = last ? nA + (size_t)nkr * kstep : cA + (size_t)r2 * kstep; const char* b2 = last ? nB + (size_t)nkr * kstep : cB + (size_t)r2 * kstep;
            const char* a3 = a2 + kstep; const char* b3 = b2 + kstep;
            int r4 = t + 4, k4 = ckr; const char* pfa4 = cA; const char* pfb4 = cB;
            if (r4 >= nt) { r4 -= nt; k4 = nkr; pfa4 = nA; pfb4 = nB; }
            r4 += k4; if (r4 >= nt) r4 -= nt;
            pfa4 += (size_t)r4 * kstep; pfb4 += (size_t)r4 * kstep;
            if (last && has_next) S.a_ready(nxt);
            if constexpr (SP2) {
#if STAGE_IN_MMA
            PG8_LDB(B0, 0, 0); PG8_LDB(B1, 0, 1); PG8_SCHED; PG8_LDA(At, 0, 0);
            PG8_WAIT_V(6); PG8_WAIT_L(0); PG8_BAR;
            PG8_MMAS(0, 0, At, B0, 1, PG8_STAGE1(PG8_SA(1, 1), a1 + hstepA, voffA, 0), 9, (void)0); PG8_MMAS(0, 1, At, B1, 1, PG8_STAGE1(PG8_SA(1, 1), a1 + hstepA, voffA, 1), 9, (void)0); PG8_BAR; PG8_SCHED;
            PG8_LDA(At, 0, 1); PG8_STAGE(PG8_SB(0, 0), b2, voffB);
            PG8_WAIT_V(4); PG8_WAIT_L(0); PG8_BAR;
            PG8_MMAS(1, 0, At, B0, 0, PG8_STAGE1(PG8_SB(0, 1), b2 + hstepB, voffB, 0), 2, PG8_STAGE1(PG8_SB(0, 1), b2 + hstepB, voffB, 1));
            PG8_MMAS(1, 1, At, B1, 0, PG8_STAGE1(PG8_SA(0, 0), a2, voffA, 0), 2, PG8_STAGE1(PG8_SA(0, 0), a2, voffA, 1)); PG8_BAR; PG8_SCHED;
            PG8_LDB(B0, 1, 0); PG8_LDB(B1, 1, 1); PG8_SCHED; PG8_LDA(At, 1, 0);
            PG8_WAIT_V(6); PG8_WAIT_L(0); PG8_BAR;
            PG8_MMAS(0, 0, At, B0, 1, PG8_STAGE1(PG8_SA(0, 1), a2 + hstepA, voffA, 0), 9, (void)0); PG8_MMAS(0, 1, At, B1, 1, PG8_STAGE1(PG8_SA(0, 1), a2 + hstepA, voffA, 1), 9, (void)0); PG8_BAR; PG8_SCHED;
            PG8_LDA(At, 1, 1); PG8_STAGE(PG8_SB(1, 0), b3, voffB);
            PG8_WAIT_V(4); PG8_WAIT_L(0); PG8_BAR;
            PG8_MMAS(1, 0, At, B0, 0, PG8_STAGE1(PG8_SB(1, 1), b3 + hstepB, voffB, 0), 2, PG8_STAGE1(PG8_SB(1, 1), b3 + hstepB, voffB, 1));
            PG8_MMAS(1, 1, At, B1, 0, PG8_STAGE1(PG8_SA(1, 0), a3, voffA, 0), 2, PG8_STAGE1(PG8_SA(1, 0), a3, voffA, 1)); PG8_BAR; PG8_SCHED;
#else
            PG8_LDB(B0, 0, 0); PG8_LDB(B1, 0, 1); PG8_SCHED; PG8_LDA(At, 0, 0); PG8_STAGE(PG8_SA(1, 1), a1 + hstepA, voffA);
            PG8_WV1; PG8_WAIT_L(0); PG8_BAR; PG8_MMA(0, 0, At, B0); PG8_MMA(0, 1, At, B1); PG8_BAR; PG8_SCHED;
            PG8_LDA(At, 0, 1); PG8_STAGE(PG8_SB(0, 0), b2, voffB); PG8_STAGE(PG8_SB(0, 1), b2 + hstepB, voffB); PG8_STAGE(PG8_SA(0, 0), a2, voffA); PG8_PF(pfa4, pfb4);
            PG8_WV2; PG8_WAIT_L(0); PG8_BAR; PG8_MMA(1, 0, At, B0); PG8_MMA(1, 1, At, B1); PG8_BAR; PG8_SCHED;
            PG8_LDB(B0, 1, 0); PG8_LDB(B1, 1, 1); PG8_SCHED; PG8_LDA(At, 1, 0); PG8_STAGE(PG8_SA(0, 1), a2 + hstepA, voffA);
            PG8_WV1; PG8_WAIT_L(0); PG8_BAR; PG8_MMA(0, 0, At, B0); PG8_MMA(0, 1, At, B1); PG8_BAR; PG8_SCHED;
            PG8_LDA(At, 1, 1); PG8_STAGE(PG8_SB(1, 0), b3, voffB); PG8_STAGE(PG8_SB(1, 1), b3 + hstepB, voffB); PG8_STAGE(PG8_SA(1, 0), a3, voffA); PG8_PF(pfa4 + kstep, pfb4 + kstep);
            PG8_WV2; PG8_WAIT_L(0); PG8_BAR; PG8_MMA(1, 0, At, B0); PG8_MMA(1, 1, At, B1); PG8_BAR; PG8_SCHED;
#endif
            } else {
            PG8_LDB(B0, 0, 0); PG8_SCHED; PG8_LDA(At, 0, 0); PG8_STAGE(PG8_SA(1, 1), a1 + hstepA, voffA);
            PG8_WAIT_L(8); PG8_BAR; PG8_WAIT_L(0); PG8_MMA(0, 0, At, B0); PG8_BAR; PG8_SCHED;
            PG8_LDB(B1, 0, 1); PG8_STAGE(PG8_SB(0, 0), b2, voffB);
            PG8_BAR; PG8_WAIT_L(0); PG8_MMA(0, 1, At, B1); PG8_BAR;
            PG8_LDA(At, 0, 1); PG8_STAGE(PG8_SA(0, 0), a2, voffA);
            PG8_BAR; PG8_WAIT_L(0); PG8_MMA(1, 0, At, B0); PG8_BAR; PG8_SCHED;
            PG8_STAGE(PG8_SB(0, 1), b2 + hstepB, voffB);
            PG8_WAIT_V(6); PG8_BAR; PG8_MMA(1, 1, At, B1); PG8_BAR;
            PG8_LDB(B0, 1, 0); PG8_SCHED; PG8_LDA(At, 1, 0); PG8_STAGE(PG8_SA(0, 1), a2 + hstepA, voffA);
            PG8_WAIT_L(8); PG8_BAR; PG8_WAIT_L(0); PG8_MMA(0, 0, At, B0); PG8_BAR; PG8_SCHED;
            PG8_LDB(B1, 1, 1); PG8_STAGE(PG8_SB(1, 0), b3, voffB);
            PG8_BAR; PG8_WAIT_L(0); PG8_MMA(0, 1, At, B1); PG8_BAR;
            PG8_LDA(At, 1, 1); PG8_STAGE(PG8_SA(1, 0), a3, voffA);
            PG8_BAR; PG8_WAIT_L(0); PG8_MMA(1, 0, At, B0); PG8_BAR; PG8_SCHED;
            PG8_STAGE(PG8_SB(1, 1), b3 + hstepB, voffB);
            PG8_WAIT_V(6); PG8_BAR; PG8_MMA(1, 1, At, B1); PG8_BAR;
            }
                }
        if constexpr (ALIGN_EPI) { if (wr == 0) PG8_BAR; }
        if constexpr (F8 || MIXT > 0) asm volatile("s_nop 15\n\ts_nop 15" ::: "memory");
        if constexpr (!Epi::AFTER_DRAIN) { E(acc, cur, wr, wc, fr, fq); S.done(cur); }
        if (!has_next) break;
#pragma unroll
        for (int a = 0; a < 2; ++a)
#pragma unroll
            for (int b = 0; b < 2; ++b)
#pragma unroll
                for (int m = 0; m < 4; ++m)
#pragma unroll
                    for (int n = 0; n < 2; ++n) acc[a][b][m][n] = (f32x4){0.f, 0.f, 0.f, 0.f};
        cur = nxt; cA = nA; cB = nB; ckr = nkr; ++ui;
        if constexpr (ALIGN_EPI) { if (wr == 1) PG8_BAR; }
    }
    PG8_WAIT_V(0);
    if constexpr (!ALIGN_EPI) { if (wr == 0) PG8_BAR; }
    PG8_BAR;
    if constexpr (Epi::AFTER_DRAIN) { E.fused(acc, cur, wr, wc, fr, fq, lds, wid, lane); S.done(cur); }
#undef PG8_SA
#undef PG8_SB
#undef PG8_STAGE
#undef PG8_PF
#undef PG8_WV1
#undef PG8_WV2
#undef PG8_LDA
#undef PG8_LDB
#undef PG8_MMA
#undef PG8_MMAS
#undef PG8_STAGE1
#undef PG8_WAIT_V
#undef PG8_WAIT_L
#undef PG8_BAR
#undef PG8_SCHED
}
}
namespace pg8 {
__device__ __forceinline__ float sigm(float z) { return __builtin_amdgcn_rcpf(1.0f + __builtin_amdgcn_exp2f(-z * 1.4426950408889634f)); }
typedef unsigned u32x2 __attribute__((ext_vector_type(2)));
__device__ __forceinline__ unsigned pk4f8(const f32x4 v) { int r = __builtin_amdgcn_cvt_pk_fp8_f32(v[0], v[1], 0, false); r = __builtin_amdgcn_cvt_pk_fp8_f32(v[2], v[3], r, true); return (unsigned)r; }
__device__ __forceinline__ u32x4 pack8(const f32x4 v0, const f32x4 v1) { u32x4 w; w.x = cvt_pk_bf16(v0[0], v0[1]); w.y = cvt_pk_bf16(v0[2], v0[3]); w.z = cvt_pk_bf16(v1[0], v1[1]); w.w = cvt_pk_bf16(v1[2], v1[3]); return w; }
__device__ __forceinline__ f32x4 bf_lo4(const u32x4 w) { f32x4 r; r[0] = __uint_as_float(w.x << 16); r[1] = __uint_as_float(w.x & 0xffff0000u); r[2] = __uint_as_float(w.y << 16); r[3] = __uint_as_float(w.y & 0xffff0000u); return r; }
__device__ __forceinline__ f32x4 bf_hi4(const u32x4 w) { f32x4 r; r[0] = __uint_as_float(w.z << 16); r[1] = __uint_as_float(w.z & 0xffff0000u); r[2] = __uint_as_float(w.w << 16); r[3] = __uint_as_float(w.w & 0xffff0000u); return r; }


struct EpiP1 {
    static constexpr bool PERM = true, AFTER_DRAIN = false, KSEG = false;
    bf16_t* P1; bf16_t* MKV; const float* bgate;
    __device__ __forceinline__ void operator()(const f32x4 (&acc)[2][2][4][2], const Unit& u, int wr, int wc, int fr, int fq) const {
        const bool mem = u.pn >= 41, gate = (!mem) && u.pn >= 17;
        bf16_t* base = mem ? MKV + (size_t)((u.pm - 64) * BM + wr * 64 + fr) * 2048 + (u.pn - 41) * BM : P1 + (size_t)(u.pm * BM + wr * 64 + fr) * 10496 + u.pn * BM;
        const size_t ldc = mem ? 2048 : 10496;
        base += wc * 32 + 8 * fq;
        f32x4 bv[2][2];
#pragma unroll
        for (int bj = 0; bj < 2; ++bj)
#pragma unroll
            for (int n = 0; n < 2; ++n) bv[bj][n] = gate ? *(const f32x4*)(bgate + (u.pn - 17) * BM + wc * 32 + 8 * fq + bj * HALF + 4 * n) : (f32x4){0.f, 0.f, 0.f, 0.f};
#pragma unroll
        for (int ai = 0; ai < 2; ++ai)
#pragma unroll
            for (int m = 0; m < 4; ++m) { bf16_t* rowp = base + (size_t)(ai * HALF + m * 16) * ldc;
#pragma unroll
                for (int bj = 0; bj < 2; ++bj) { f32x4 v0 = acc[ai][bj][m][0] + bv[bj][0], v1 = acc[ai][bj][m][1] + bv[bj][1];
                    if (gate) {
#pragma unroll
                        for (int i = 0; i < 4; ++i) { v0[i] = sigm(v0[i]); v1[i] = sigm(v1[i]); } }
                    *(u32x4*)(rowp + bj * HALF) = pack8(v0, v1); } }
    }
};
struct EpiGate {
    static constexpr bool PERM = true, AFTER_DRAIN = false, KSEG = false;
    bf16_t* P1; const float* bgate;
    __device__ __forceinline__ void operator()(const f32x4 (&acc)[2][2][4][2], const Unit& u, int wr, int wc, int fr, int fq) const {
        bf16_t* base = P1 + (size_t)(u.pm * BM + wr * 64 + fr) * 10496 + 4352 + u.pn * BM + wc * 32 + 8 * fq;
        f32x4 bv[2][2];
#pragma unroll
        for (int bj = 0; bj < 2; ++bj)
#pragma unroll
            for (int n = 0; n < 2; ++n) bv[bj][n] = *(const f32x4*)(bgate + u.pn * BM + wc * 32 + 8 * fq + bj * HALF + 4 * n);
#pragma unroll
        for (int ai = 0; ai < 2; ++ai)
#pragma unroll
            for (int m = 0; m < 4; ++m) { bf16_t* rowp = base + (size_t)(ai * HALF + m * 16) * 10496;
#pragma unroll
                for (int bj = 0; bj < 2; ++bj) { f32x4 v0 = acc[ai][bj][m][0] + bv[bj][0], v1 = acc[ai][bj][m][1] + bv[bj][1];
#pragma unroll
                    for (int i = 0; i < 4; ++i) { v0[i] = sigm(v0[i]); v1[i] = sigm(v1[i]); }
                    *(u32x4*)(rowp + bj * HALF) = pack8(v0, v1); } }
    }
};
struct EpiPlain {
    static constexpr bool PERM = true, AFTER_DRAIN = false, KSEG = false;
    bf16_t* O; int ldc;
    __device__ __forceinline__ void operator()(const f32x4 (&acc)[2][2][4][2], const Unit& u, int wr, int wc, int fr, int fq) const {
        bf16_t* base = O + (size_t)(u.pm * BM + wr * 64 + fr) * ldc + u.pn * BM + wc * 32 + 8 * fq;
#pragma unroll
        for (int ai = 0; ai < 2; ++ai)
#pragma unroll
            for (int m = 0; m < 4; ++m) { bf16_t* rowp = base + (size_t)(ai * HALF + m * 16) * ldc;
#pragma unroll
                for (int bj = 0; bj < 2; ++bj) *(u32x4*)(rowp + bj * HALF) = pack8(acc[ai][bj][m][0], acc[ai][bj][m][1]); }
    }
};
template <bool FIRST> struct EpiGateAcc {
    static constexpr bool PERM = true, AFTER_DRAIN = false, KSEG = false;
    const bf16_t* G; int gcol0; bf16_t* Mg;
    __device__ __forceinline__ void operator()(const f32x4 (&acc)[2][2][4][2], const Unit& u, int wr, int wc, int fr, int fq) const {
        const int row0 = u.pm * BM + wr * 64 + fr, col0 = u.pn * BM + wc * 32 + 8 * fq;
#pragma unroll
        for (int ai = 0; ai < 2; ++ai)
#pragma unroll
            for (int m = 0; m < 4; ++m) { const size_t r = (size_t)(row0 + ai * HALF + m * 16);
#pragma unroll
                for (int bj = 0; bj < 2; ++bj) {
                    const u32x4 gw = *(const u32x4*)(G + r * 10496 + gcol0 + col0 + bj * HALF);
                    f32x4 v0 = acc[ai][bj][m][0] * bf_lo4(gw), v1 = acc[ai][bj][m][1] * bf_hi4(gw);
                    bf16_t* mp = Mg + r * 2048 + col0 + bj * HALF;
                    if (!FIRST) { const u32x4 ow = *(const u32x4*)mp; v0 = v0 + bf_lo4(ow); v1 = v1 + bf_hi4(ow); }
                    *(u32x4*)mp = pack8(v0, v1); } }
    }
};
__device__ __forceinline__ float rowsq8(const f32x4 a, const f32x4 b) { return (a[0] * a[0] + a[1] * a[1]) + (a[2] * a[2] + a[3] * a[3]) + (b[0] * b[0] + b[1] * b[1]) + (b[2] * b[2] + b[3] * b[3]); }
struct EpiKV {
    static constexpr bool PERM = true, AFTER_DRAIN = false, KSEG = false;
    PG8_LAS float* P; const float* kn_g; const float* krss; const float* krr; bf16_t* KFT; bf16_t* VFT;
    __device__ __forceinline__ void operator()(const f32x4 (&acc)[2][2][4][2], const Unit& u, int wr, int wc, int fr, int fq) const {
        asm volatile("" : "+v"(fr), "+v"(fq));
        const int h = u.pn, b = u.pm >> 4, tq = (u.pm & 15) * 4;
#pragma unroll
        for (int ai = 0; ai < 2; ++ai)
#pragma unroll
            for (int m = 0; m < 4; ++m) { float s = rowsq8(acc[ai][0][m][0], acc[ai][0][m][1]); if (XL_FAST) s = xl_swap32_sum(xl_swap16_sum(s)); else { s += __shfl_xor(s, 16); s += __shfl_xor(s, 32); }
                if (fq == 0) P[(ai * HALF + wr * 64 + m * 16 + fr) * 4 + wc] = s; }
        asm volatile("s_waitcnt lgkmcnt(0)" ::: "memory"); __builtin_amdgcn_s_barrier(); asm volatile("" ::: "memory");
        const f32x4 g0 = *(const f32x4*)(kn_g + wc * 32 + 8 * fq), g1 = *(const f32x4*)(kn_g + wc * 32 + 8 * fq + 4);
#pragma unroll
        for (int ai = 0; ai < 2; ++ai)
#pragma unroll
            for (int m = 0; m < 4; ++m) { const int row = ai * HALF + wr * 64 + m * 16 + fr, key = m * 16 + fr; const size_t t = (size_t)u.pm * BM + row;
                const f32x4 p4 = *(const PG8_LAS f32x4*)(P + row * 4);
                const float rs = 1.0f / sqrtf(((p4[0] + p4[1]) + (p4[2] + p4[3]) + krss[t]) * (1.f / 192.f) + 1e-6f);
                const size_t tile = (size_t)(b * 16 + h) * 64 + tq + 2 * ai + wr;
                bf16_t* kb = KFT + tile * 12288 + key * 8;
                *(u32x4*)(kb + (4 * wc + fq) * 512) = pack8(acc[ai][0][m][0] * g0 * rs, acc[ai][0][m][1] * g1 * rs);
                *(u32x4*)(VFT + tile * 8192 + wc * 2048 + key * 32 + 8 * fq) = pack8(acc[ai][1][m][0], acc[ai][1][m][1]);
                if (fq < 2) { const int c = 2 * wc + fq; const f32x4 r0 = *(const f32x4*)(krr + t * 64 + 8 * c), r1 = *(const f32x4*)(krr + t * 64 + 8 * c + 4);
                    *(u32x4*)(kb + (16 + c) * 512) = pack8(r0 * rs, r1 * rs); }
                asm volatile("" ::: "memory"); }
    }
};
struct EpiQ {
    static constexpr bool PERM = true, AFTER_DRAIN = false, KSEG = false;
    PG8_LAS float* P; const float* qn_g; const float* rope; bf16_t* QF; float qscale;
    __device__ __forceinline__ void operator()(const f32x4 (&acc)[2][2][4][2], const Unit& u, int wr, int wc, int fr, int fq) const {
        asm volatile("" : "+v"(fr), "+v"(fq));
        const int h = u.pn, b = u.pm >> 4;
#pragma unroll
        for (int ai = 0; ai < 2; ++ai)
#pragma unroll
            for (int m = 0; m < 4; ++m) { float s = rowsq8(acc[ai][0][m][0], acc[ai][0][m][1]); if (wc < 2) s += rowsq8(acc[ai][1][m][0], acc[ai][1][m][1]);
                if (XL_FAST) s = xl_swap32_sum(xl_swap16_sum(s)); else { s += __shfl_xor(s, 16); s += __shfl_xor(s, 32); }
                if (fq == 0) P[(ai * HALF + wr * 64 + m * 16 + fr) * 4 + wc] = s; }
        asm volatile("s_waitcnt lgkmcnt(0)" ::: "memory"); __builtin_amdgcn_s_barrier(); asm volatile("" ::: "memory");
        const f32x4 g0 = *(const f32x4*)(qn_g + wc * 32 + 8 * fq) * qscale, g1 = *(const f32x4*)(qn_g + wc * 32 + 8 * fq + 4) * qscale;
        const int j = 4 * (4 * (wc & 1) + fq);
        const f32x4 gr1 = *(const f32x4*)(qn_g + 128 + j) * qscale, gr2 = *(const f32x4*)(qn_g + 160 + j) * qscale;
#pragma unroll
        for (int ai = 0; ai < 2; ++ai)
#pragma unroll
            for (int m = 0; m < 4; ++m) { const int row = ai * HALF + wr * 64 + m * 16 + fr; const size_t t = (size_t)u.pm * BM + row;
                const f32x4 p4 = *(const PG8_LAS f32x4*)(P + row * 4);
                const float rs = 1.0f / sqrtf(((p4[0] + p4[1]) + (p4[2] + p4[3])) * (1.f / 192.f) + 1e-6f);
                bf16_t* qb = QF + ((size_t)(b * 16 + h) * 4096 + (t & 4095)) * 192;
                *(u32x4*)(qb + wc * 32 + 8 * fq) = pack8(acc[ai][0][m][0] * g0 * rs, acc[ai][0][m][1] * g1 * rs);
                if (wc < 2) { const f32x4 c4 = *(const f32x4*)(rope + t * 64 + j), s4 = *(const f32x4*)(rope + t * 64 + 32 + j);
                    const f32x4 t1 = acc[ai][1][m][0] * gr1 * rs, t2 = acc[ai][1][m][1] * gr2 * rs;
                    const f32x4 o1 = t1 * c4 - t2 * s4, o2 = t1 * s4 + t2 * c4;
                    u32x2 w1; w1.x = cvt_pk_bf16(o1[0], o1[1]); w1.y = cvt_pk_bf16(o1[2], o1[3]); *(u32x2*)(qb + 128 + j) = w1;
                    u32x2 w2; w2.x = cvt_pk_bf16(o2[0], o2[1]); w2.y = cvt_pk_bf16(o2[2], o2[3]); *(u32x2*)(qb + 160 + j) = w2; }
                asm volatile("" ::: "memory"); }
    }
};
__device__ __forceinline__ unsigned pk4f8s(const f32x4 v, float s) { int r = __builtin_amdgcn_cvt_pk_fp8_f32(v[0] * s, v[1] * s, 0, false); r = __builtin_amdgcn_cvt_pk_fp8_f32(v[2] * s, v[3] * s, r, true); return (unsigned)r; }
struct EpiKV8 {
    static constexpr bool PERM = true, AFTER_DRAIN = false, KSEG = false;
    PG8_LAS float* P; const float* kn_g; const float* krss; const float* krr; unsigned char* K8; unsigned char* V8;
    __device__ __forceinline__ void operator()(const f32x4 (&acc)[2][2][4][2], const Unit& u, int wr, int wc, int fr, int fq) const {
        asm volatile("" : "+v"(fr), "+v"(fq));
        const int h = u.pn, b = u.pm >> 4, tq = (u.pm & 15) * 4;
#pragma unroll
        for (int ai = 0; ai < 2; ++ai)
#pragma unroll
            for (int m = 0; m < 4; ++m) { float s = rowsq8(acc[ai][0][m][0], acc[ai][0][m][1]); if (XL_FAST) s = xl_swap32_sum(xl_swap16_sum(s)); else { s += __shfl_xor(s, 16); s += __shfl_xor(s, 32); }
                if (fq == 0) P[(ai * HALF + wr * 64 + m * 16 + fr) * 4 + wc] = s; }
        asm volatile("s_waitcnt lgkmcnt(0)" ::: "memory"); __builtin_amdgcn_s_barrier(); asm volatile("" ::: "memory");
        const f32x4 g0 = *(const f32x4*)(kn_g + wc * 32 + 8 * fq), g1 = *(const f32x4*)(kn_g + wc * 32 + 8 * fq + 4);
#pragma unroll
        for (int ai = 0; ai < 2; ++ai)
#pragma unroll
            for (int m = 0; m < 4; ++m) { const int row = ai * HALF + wr * 64 + m * 16 + fr, key = m * 16 + fr; const size_t t = (size_t)u.pm * BM + row;
                const f32x4 p4 = *(const PG8_LAS f32x4*)(P + row * 4);
                const float rs = 1.0f / sqrtf(((p4[0] + p4[1]) + (p4[2] + p4[3]) + krss[t]) * (1.f / 192.f) + 1e-6f);
                const size_t tile = (size_t)(b * 16 + h) * 64 + tq + 2 * ai + wr;
                unsigned char* kb = K8 + tile * 12288 + key * 16;
                { u32x2 w; w.x = pk4f8s(acc[ai][0][m][0] * g0, rs); w.y = pk4f8s(acc[ai][0][m][1] * g1, rs); *(u32x2*)(kb + (2 * wc + (fq >> 1)) * 1024 + 8 * (fq & 1)) = w; }
                if (fq < 2) { const f32x4 r0 = *(const f32x4*)(krr + t * 64 + 16 * wc + 8 * fq), r1 = *(const f32x4*)(krr + t * 64 + 16 * wc + 8 * fq + 4);
                    u32x2 w; w.x = pk4f8s(r0, rs); w.y = pk4f8s(r1, rs); *(u32x2*)(kb + (8 + wc) * 1024 + 8 * fq) = w; }
                const int p = 32 * ((fr >> 2) & 1) + 16 * (m >> 1) + (fr & 3) + 4 * (2 * (m & 1) + (fr >> 3));
                unsigned char* vb = V8 + tile * 8192 + (p >> 4) * 2048 + (size_t)(wc * 32 + 8 * fq) * 16 + (p & 15);
                const unsigned w0 = pk4f8s(acc[ai][1][m][0], 1.0f), w1 = pk4f8s(acc[ai][1][m][1], 1.0f);
                vb[0] = (unsigned char)w0; vb[16] = (unsigned char)(w0 >> 8); vb[32] = (unsigned char)(w0 >> 16); vb[48] = (unsigned char)(w0 >> 24);
                vb[64] = (unsigned char)w1; vb[80] = (unsigned char)(w1 >> 8); vb[96] = (unsigned char)(w1 >> 16); vb[112] = (unsigned char)(w1 >> 24);
                asm volatile("" ::: "memory"); }
    }
};
struct EpiQ8 {
    static constexpr bool PERM = true, AFTER_DRAIN = false, KSEG = false;
    PG8_LAS float* P; const float* qn_g; const float* rope; unsigned char* Q8; float qscale;
    __device__ __forceinline__ void operator()(const f32x4 (&acc)[2][2][4][2], const Unit& u, int wr, int wc, int fr, int fq) const {
        asm volatile("" : "+v"(fr), "+v"(fq));
        const int h = u.pn, b = u.pm >> 4;
#pragma unroll
        for (int ai = 0; ai < 2; ++ai)
#pragma unroll
            for (int m = 0; m < 4; ++m) { float s = rowsq8(acc[ai][0][m][0], acc[ai][0][m][1]); if (wc < 2) s += rowsq8(acc[ai][1][m][0], acc[ai][1][m][1]);
                if (XL_FAST) s = xl_swap32_sum(xl_swap16_sum(s)); else { s += __shfl_xor(s, 16); s += __shfl_xor(s, 32); }
                if (fq == 0) P[(ai * HALF + wr * 64 + m * 16 + fr) * 4 + wc] = s; }
        asm volatile("s_waitcnt lgkmcnt(0)" ::: "memory"); __builtin_amdgcn_s_barrier(); asm volatile("" ::: "memory");
        const f32x4 g0 = *(const f32x4*)(qn_g + wc * 32 + 8 * fq) * qscale, g1 = *(const f32x4*)(qn_g + wc * 32 + 8 * fq + 4) * qscale;
        const int j = 4 * (4 * (wc & 1) + fq);
        const f32x4 gr1 = *(const f32x4*)(qn_g + 128 + j) * qscale, gr2 = *(const f32x4*)(qn_g + 160 + j) * qscale;
#pragma unroll
        for (int ai = 0; ai < 2; ++ai)
#pragma unroll
            for (int m = 0; m < 4; ++m) { const int row = ai * HALF + wr * 64 + m * 16 + fr; const size_t t = (size_t)u.pm * BM + row;
                const f32x4 p4 = *(const PG8_LAS f32x4*)(P + row * 4);
                const float rs = 1.0f / sqrtf(((p4[0] + p4[1]) + (p4[2] + p4[3])) * (1.f / 192.f) + 1e-6f);
                unsigned char* qb = Q8 + ((size_t)(b * 16 + h) * 4096 + (t & 4095)) * 192;
                { u32x2 w; w.x = pk4f8s(acc[ai][0][m][0] * g0, rs); w.y = pk4f8s(acc[ai][0][m][1] * g1, rs); *(u32x2*)(qb + wc * 32 + 8 * fq) = w; }
                if (wc < 2) { const f32x4 c4 = *(const f32x4*)(rope + t * 64 + j), s4 = *(const f32x4*)(rope + t * 64 + 32 + j);
                    const f32x4 t1 = acc[ai][1][m][0] * gr1 * rs, t2 = acc[ai][1][m][1] * gr2 * rs;
                    *(unsigned*)(qb + 128 + j) = pk4f8s(t1 * c4 - t2 * s4, 1.0f); *(unsigned*)(qb + 160 + j) = pk4f8s(t1 * s4 + t2 * c4, 1.0f); }
                asm volatile("" ::: "memory"); }
    }
};
template <int T1_, int T2_> struct EpiMergedT {
    static constexpr bool PERM = true, AFTER_DRAIN = false, KSEG = true; static constexpr int KSEG_T1 = T1_, KSEG_T2 = T2_;
    const bf16_t* G; bf16_t* Mg;
    __device__ __forceinline__ void kseg(f32x4 (&acc)[2][2][4][2], const Unit& u, int t, int wr, int wc, int fr, int fq) const {
        const bf16_t* gp = G + (size_t)(u.pm * BM + wr * 64 + fr) * 10496 + 4352 + (t == KSEG_T1 ? 0 : 2048) + u.pn * BM + wc * 32 + 8 * fq;
#if KSEG_BATCH16
#pragma unroll
        for (int ai = 0; ai < 2; ++ai) {
            u32x4 gn[4][2], gd[4][2];
#pragma unroll
            for (int m = 0; m < 4; ++m)
#pragma unroll
                for (int bj = 0; bj < 2; ++bj) { const bf16_t* p = gp + (size_t)(ai * HALF + m * 16) * 10496 + bj * HALF; gn[m][bj] = *(const u32x4*)p; gd[m][bj] = *(const u32x4*)(p + 2048); }
#pragma unroll
            for (int m = 0; m < 4; ++m)
#pragma unroll
                for (int bj = 0; bj < 2; ++bj) {
                    f32x4 r0 = bf_lo4(gd[m][bj]), r1 = bf_hi4(gd[m][bj]);
#pragma unroll
                    for (int i = 0; i < 4; ++i) { r0[i] = __builtin_amdgcn_rcpf(r0[i]); r1[i] = __builtin_amdgcn_rcpf(r1[i]); }
                    acc[ai][bj][m][0] = acc[ai][bj][m][0] * (bf_lo4(gn[m][bj]) * r0); acc[ai][bj][m][1] = acc[ai][bj][m][1] * (bf_hi4(gn[m][bj]) * r1); }
            asm volatile("" : "+v"(acc[ai][0][0][0]), "+v"(acc[ai][0][0][1]), "+v"(acc[ai][1][0][0]), "+v"(acc[ai][1][0][1]), "+v"(acc[ai][0][1][0]), "+v"(acc[ai][0][1][1]), "+v"(acc[ai][1][1][0]), "+v"(acc[ai][1][1][1]),
                         "+v"(acc[ai][0][2][0]), "+v"(acc[ai][0][2][1]), "+v"(acc[ai][1][2][0]), "+v"(acc[ai][1][2][1]), "+v"(acc[ai][0][3][0]), "+v"(acc[ai][0][3][1]), "+v"(acc[ai][1][3][0]), "+v"(acc[ai][1][3][1]) :: "memory");
        }
    }
#else
#pragma unroll
        for (int ai = 0; ai < 2; ++ai)
#pragma unroll
            for (int mp = 0; mp < 2; ++mp) {
                u32x4 gn[2][2], gd[2][2];
#pragma unroll
                for (int mm = 0; mm < 2; ++mm)
#pragma unroll
                    for (int bj = 0; bj < 2; ++bj) { const bf16_t* p = gp + (size_t)(ai * HALF + (2 * mp + mm) * 16) * 10496 + bj * HALF; gn[mm][bj] = *(const u32x4*)p; gd[mm][bj] = *(const u32x4*)(p + 2048); }
#pragma unroll
                for (int mm = 0; mm < 2; ++mm)
#pragma unroll
                    for (int bj = 0; bj < 2; ++bj) { const int m = 2 * mp + mm;
                        f32x4 r0 = bf_lo4(gd[mm][bj]), r1 = bf_hi4(gd[mm][bj]);
#pragma unroll
                        for (int i = 0; i < 4; ++i) { r0[i] = __builtin_amdgcn_rcpf(r0[i]); r1[i] = __builtin_amdgcn_rcpf(r1[i]); }
                        acc[ai][bj][m][0] = acc[ai][bj][m][0] * (bf_lo4(gn[mm][bj]) * r0); acc[ai][bj][m][1] = acc[ai][bj][m][1] * (bf_hi4(gn[mm][bj]) * r1); }
                asm volatile("" : "+v"(acc[ai][0][2 * mp][0]), "+v"(acc[ai][0][2 * mp][1]), "+v"(acc[ai][1][2 * mp][0]), "+v"(acc[ai][1][2 * mp][1]), "+v"(acc[ai][0][2 * mp + 1][0]), "+v"(acc[ai][0][2 * mp + 1][1]), "+v"(acc[ai][1][2 * mp + 1][0]), "+v"(acc[ai][1][2 * mp + 1][1]) :: "memory");
            }
    }
#endif
    __device__ __forceinline__ void operator()(const f32x4 (&acc)[2][2][4][2], const Unit& u, int wr, int wc, int fr, int fq) const {
        const int row0 = u.pm * BM + wr * 64 + fr, col0 = u.pn * BM + wc * 32 + 8 * fq;
#pragma unroll
        for (int ai = 0; ai < 2; ++ai)
#pragma unroll
            for (int m = 0; m < 4; ++m) { const size_t r = (size_t)(row0 + ai * HALF + m * 16);
#pragma unroll
                for (int bj = 0; bj < 2; ++bj) {
                    const u32x4 gw = *(const u32x4*)(G + r * 10496 + 4352 + 4096 + col0 + bj * HALF);
                    *(u32x4*)(Mg + r * 2048 + col0 + bj * HALF) = pack8(acc[ai][bj][m][0] * bf_lo4(gw), acc[ai][bj][m][1] * bf_hi4(gw)); } }
    }
};
struct EpiX1 {
    static constexpr bool PERM = true, AFTER_DRAIN = false, KSEG = false;
    const float* X; bf16_t* O;
    __device__ __forceinline__ void operator()(const f32x4 (&acc)[2][2][4][2], const Unit& u, int wr, int wc, int fr, int fq) const {
        const int row0 = u.pm * BM + wr * 64 + fr, col0 = u.pn * BM + wc * 32 + 8 * fq;
#if EPIX1_BATCH
#pragma unroll
        for (int ai = 0; ai < 2; ++ai) {
            f32x4 xv[4][2][2];
#pragma unroll
            for (int m = 0; m < 4; ++m) { const size_t off = (size_t)(row0 + ai * HALF + m * 16) * 2048 + col0;
#pragma unroll
                for (int bj = 0; bj < 2; ++bj) { xv[m][bj][0] = *(const f32x4*)(X + off + bj * HALF); xv[m][bj][1] = *(const f32x4*)(X + off + bj * HALF + 4); } }
#pragma unroll
            for (int m = 0; m < 4; ++m) { const size_t off = (size_t)(row0 + ai * HALF + m * 16) * 2048 + col0;
#pragma unroll
                for (int bj = 0; bj < 2; ++bj) *(u32x4*)(O + off + bj * HALF) = pack8(xv[m][bj][0] + acc[ai][bj][m][0], xv[m][bj][1] + acc[ai][bj][m][1]); }
            asm volatile("" ::: "memory");
        }
    }
};
#else
#pragma unroll
        for (int ai = 0; ai < 2; ++ai)
#pragma unroll
            for (int m = 0; m < 4; ++m) { const size_t off = (size_t)(row0 + ai * HALF + m * 16) * 2048 + col0;
#pragma unroll
                for (int bj = 0; bj < 2; ++bj) { const f32x4 x0 = *(const f32x4*)(X + off + bj * HALF), x1 = *(const f32x4*)(X + off + bj * HALF + 4);
                    *(u32x4*)(O + off + bj * HALF) = pack8(x0 + acc[ai][bj][m][0], x1 + acc[ai][bj][m][1]); } }
    }
};
#endif
struct EpiSwiGLU {
    static constexpr bool PERM = true, AFTER_DRAIN = false, KSEG = false;
    const float* bgu; unsigned char* ACT;
    __device__ __forceinline__ void operator()(const f32x4 (&acc)[2][2][4][2], const Unit& u, int wr, int wc, int fr, int fq) const {
        const int e = u.pn >> 4, pnl = u.pn & 15, cl = pnl * HALF + wc * 32 + 8 * fq;
        const float* bp = bgu + (size_t)e * 4096 + cl;
        f32x4 bg[2], bu[2];
#pragma unroll
        for (int n = 0; n < 2; ++n) { bg[n] = *(const f32x4*)(bp + 4 * n); bu[n] = *(const f32x4*)(bp + 2048 + 4 * n); }
        unsigned char* base = ACT + (size_t)(u.pm * BM + wr * 64 + fr) * 2048 + cl;
#pragma unroll
        for (int ai = 0; ai < 2; ++ai)
#pragma unroll
            for (int m = 0; m < 4; ++m) { f32x4 o[2];
#pragma unroll
                for (int n = 0; n < 2; ++n) { const f32x4 g4 = acc[ai][0][m][n] + bg[n], u4 = acc[ai][1][m][n] + bu[n];
#pragma unroll
                    for (int i = 0; i < 4; ++i) { const float g = fminf(g4[i], 7.0f), up = fminf(fmaxf(u4[i], -7.0f), 7.0f); o[n][i] = (up + 1.0f) * g * sigm(1.702f * g); } }
                u32x2 w8; w8.x = pk4f8(o[0]); w8.y = pk4f8(o[1]); *(u32x2*)(base + (size_t)(ai * HALF + m * 16) * 2048) = w8; }
    }
};
template <int P_> struct EpiSwiGLUProbe : EpiSwiGLU { static constexpr int PROBE = P_;
    __device__ __forceinline__ void operator()(const f32x4 (&)[2][2][4][2], const Unit&, int, int, int, int) const {} };

struct EpiDown {
    static constexpr bool PERM = true, AFTER_DRAIN = false, KSEG = false;
    const float* bd; unsigned char* Y;
    __device__ __forceinline__ void operator()(const f32x4 (&acc)[2][2][4][2], const Unit& u, int wr, int wc, int fr, int fq) const {
        const int e = u.pn >> 3, pnl = u.pn & 7, cl = pnl * BM + wc * 32 + 8 * fq;
        const float* bp = bd + (size_t)e * 2048 + cl;
        f32x4 bv[2][2];
#pragma unroll
        for (int bj = 0; bj < 2; ++bj)
#pragma unroll
            for (int n = 0; n < 2; ++n) bv[bj][n] = *(const f32x4*)(bp + bj * HALF + 4 * n);
        unsigned char* base = Y + (size_t)(u.pm * BM + wr * 64 + fr) * 2048 + cl;
#pragma unroll
        for (int ai = 0; ai < 2; ++ai)
#pragma unroll
            for (int m = 0; m < 4; ++m) { unsigned char* rowp = base + (size_t)(ai * HALF + m * 16) * 2048;
#pragma unroll
                for (int bj = 0; bj < 2; ++bj) { u32x2 w; w.x = pk4f8(acc[ai][bj][m][0] + bv[bj][0]); w.y = pk4f8(acc[ai][bj][m][1] + bv[bj][1]); *(u32x2*)(rowp + bj * HALF) = w; } }
    }
};

struct P1Order {
    StaticOrder base; int i_off, i_lim;
    __device__ void init(int G_, int c_, int i_off_, int i_lim_) { base.init(16384, (GATE_F8 ? (UV_F8 == 2 ? 4 : 8) : 41) * 256, G_, c_); i_off = i_off_; i_lim = i_lim_; }
    __device__ bool next(int i_, Unit& u) const {
        const int i = i_ + i_off; if (i >= i_lim) return false;
        const long L = (long)i * base.G + base.c;
        if (L < base.nwg) return base.next(i, u);
        const int j = (int)(L - base.nwg); if (GATE_F8 || j >= 32) return false;
        u.pm = 64 + (j & 3); u.pn = 41 + (j >> 2); return true;
    }
    __device__ __forceinline__ void a_ready(const Unit&) const {}
    __device__ __forceinline__ void done(const Unit&) const {}
};
struct GateOrder {
    StaticOrder base;
    __device__ void init(int G_, int c_) { base.init(16384, (UV_F8 == 1 ? 41 : UV_F8 == 2 ? 37 : 33) * 256, G_, c_); }
    __device__ bool next(int i, Unit& u) const {
        const long L = (long)i * base.G + base.c;
        if (L < base.nwg) { base.next(i, u); u.pn += (UV_F8 == 1 ? 0 : UV_F8 == 2 ? 4 : 8); return true; }
        const int j = (int)(L - base.nwg);
        if (j < 32) { u.pm = 64 + (j & 3); u.pn = 41 + (j >> 2); return true; }
        return false;
    }
    __device__ __forceinline__ void a_ready(const Unit&) const {}
    __device__ __forceinline__ void done(const Unit&) const {}
};
struct MoeOrder {
    const PG8_LAS int* tab; int NT, x, j;
    __device__ bool next(int i, Unit& u) const {
#if MOE_MAP2
        const int g = NT >> 2, Lx = i * 32 + j, rbi = Lx / g, s = Lx - rbi * g, rb = 2 * rbi + (x >> 2);
        if (rb >= __builtin_amdgcn_readfirstlane(tab[32])) return false;
        int e = 0;
        while (__builtin_amdgcn_readfirstlane(tab[e + 1]) <= rb) ++e;
        u.pm = rb; u.pn = e * NT + (x & 3) + 4 * s; u.kr = 0; return true;
#else
        const int ntx = NT >> 3, Lx = i * 32 + j, rb = Lx / ntx, s = Lx - rb * ntx;
        if (rb >= __builtin_amdgcn_readfirstlane(tab[32])) return false;
        int e = 0;
        while (__builtin_amdgcn_readfirstlane(tab[e + 1]) <= rb) ++e;
        u.pm = rb; u.pn = e * NT + x + 8 * s; u.kr = (rb + 4 * s) & 7; return true;
#endif
    }
    __device__ __forceinline__ void a_ready(const Unit&) const {}
    __device__ __forceinline__ void done(const Unit&) const {}
};
}
#define GAS __attribute__((address_space(1)))
#define LAS __attribute__((address_space(3)))
typedef unsigned short bf16;
typedef unsigned v4u __attribute__((ext_vector_type(4)));
typedef float f32x4 __attribute__((ext_vector_type(4)));
typedef short bf16x8 __attribute__((ext_vector_type(8)));
typedef GAS unsigned gu32;
typedef GAS unsigned long long gu64;
#define RLX_AGENT __ATOMIC_RELAXED, __HIP_MEMORY_SCOPE_AGENT
#define LDS_WAIT() asm volatile("s_waitcnt lgkmcnt(0)" ::: "memory")
#define VM_WAIT() asm volatile("s_waitcnt vmcnt(0)" ::: "memory")
__device__ __forceinline__ unsigned long long rt() { return __builtin_amdgcn_s_memrealtime(); }
__device__ __forceinline__ unsigned f2bf(float f) { unsigned u = __builtin_bit_cast(unsigned, f); return (u + 0x7fffu + ((u >> 16) & 1u)) >> 16; }
__device__ __forceinline__ unsigned pk2(float lo, float hi) { return f2bf(lo) | (f2bf(hi) << 16); }
#define XB_TMO      128
#define XB_XCNT(j)  (256  + 64 * (j))
#define XB_XSUB(j)  (1280 + 64 * (j))
#define XB_XGEN(j)  (2304 + 64 * (j))
#define XB_TOP      3328
#define XB_TOPGEN   3392
#define XCD_BAR_WORDS 3456
#define XB_SPIN_CAP (1u << 18)

__device__ __forceinline__ unsigned xb_ld(unsigned* p)              { return __hip_atomic_load(p, __ATOMIC_RELAXED, __HIP_MEMORY_SCOPE_AGENT); }
__device__ __forceinline__ unsigned xb_add(unsigned* p, unsigned v) { return __hip_atomic_fetch_add(p, v, __ATOMIC_RELAXED, __HIP_MEMORY_SCOPE_AGENT); }
__device__ __forceinline__ unsigned xb_xcc_id() { return (unsigned)__builtin_amdgcn_s_getreg((3 << 11) | 20) & 0xFu; }
#define XB_SPIN(cond, bar) do { unsigned _sp = 0; while (cond) { __builtin_amdgcn_s_sleep(1); \
    if ((++_sp & 255u) == 0u) { if (xb_ld(&(bar)[XB_TMO])) break; if (_sp > XB_SPIN_CAP) { atomicAdd(&(bar)[XB_TMO], 1u); break; } } } } while (0)

struct XcdBarrier {
    unsigned* bar; unsigned x;
    volatile LAS unsigned* st;
};

__device__ __forceinline__ XcdBarrier xcd_barrier_post(unsigned* bar, volatile LAS unsigned* st) {
    XcdBarrier b; b.bar = bar; b.x = xb_xcc_id(); b.st = st;
    if (threadIdx.x == 0) (void)xb_add(&bar[XB_XCNT(b.x)], 1u);
    return b;
}
__device__ __forceinline__ void xcd_barrier_complete(unsigned* bar, unsigned x, unsigned& nloc, unsigned& nx) {
    const unsigned G = gridDim.x * gridDim.y * gridDim.z;
    unsigned sum, cnt, mine, sp = 0u;
    for (;;) {
        sum = 0u; cnt = 0u; mine = 0u;
#pragma unroll
        for (unsigned j = 0; j < 16; ++j) { const unsigned c = xb_ld(&bar[XB_XCNT(j)]); sum += c; cnt += (c > 0u) ? 1u : 0u; mine = (j == x) ? c : mine; }
        if (sum == G) break;
        __builtin_amdgcn_s_sleep(1);
        if ((++sp & 255u) == 0u) { if (xb_ld(&bar[XB_TMO])) break; if (sp > XB_SPIN_CAP) { atomicAdd(&bar[XB_TMO], 1u); break; } }
    }
    nloc = mine > 0u ? mine : 1u; nx = cnt > 0u ? cnt : 1u;
}

__device__ __forceinline__ void xcd_barrier(const XcdBarrier& b) {
    asm volatile("s_waitcnt vmcnt(0)" ::: "memory");
    __syncthreads();
    if (threadIdx.x == 0) {
        unsigned* bar = b.bar;
        __builtin_amdgcn_s_waitcnt(0);
        unsigned nloc = b.st[0], nx = b.st[1];
        if (nloc == 0u) { xcd_barrier_complete(bar, b.x, nloc, nx); b.st[0] = nloc; b.st[1] = nx; }
        const unsigned old = xb_add(&bar[XB_XSUB(b.x)], 1u);
        const unsigned gen = old / nloc;
        if (old + 1u == (gen + 1u) * nloc) {
            __builtin_amdgcn_fence(__ATOMIC_RELEASE, "agent");
            asm volatile("s_waitcnt vmcnt(0)" ::: "memory");
            const unsigned og = xb_add(&bar[XB_TOP], 1u);
            const unsigned tg = og / nx;
            if (og + 1u == (tg + 1u) * nx) xb_add(&bar[XB_TOPGEN], 1u);
            else XB_SPIN(xb_ld(&bar[XB_TOPGEN]) == tg, bar);
            __builtin_amdgcn_fence(__ATOMIC_ACQUIRE, "agent");
            xb_add(&bar[XB_XGEN(b.x)], 1u);
            asm volatile("s_waitcnt vmcnt(0)" ::: "memory");
        } else {
            XB_SPIN(xb_ld(&bar[XB_XGEN(b.x)]) == gen, bar);
            __builtin_amdgcn_fence(__ATOMIC_ACQUIRE, "agent");
            asm volatile("s_waitcnt vmcnt(0)" ::: "memory");
        }
    }
    __syncthreads();
}
typedef float f32x16 __attribute__((ext_vector_type(16)));
typedef float f32x2 __attribute__((ext_vector_type(2)));
typedef short s16x4 __attribute__((ext_vector_type(4)));
typedef unsigned u32x2 __attribute__((ext_vector_type(2)));
typedef short v4i16_t __attribute__((ext_vector_type(4)));
__device__ __forceinline__ unsigned cvtpk(float lo, float hi) { unsigned r; asm volatile("v_cvt_pk_bf16_f32 %0, %1, %2" : "=v"(r) : "v"(lo), "v"(hi)); return r; }
__device__ __forceinline__ float bflo(unsigned w) { return __uint_as_float(w << 16); }
__device__ __forceinline__ float bfhi(unsigned w) { return __uint_as_float(w & 0xffff0000u); }
__device__ __forceinline__ void unpack8(const v4u w, float (&f)[8]) { f[0] = bflo(w.x); f[1] = bfhi(w.x); f[2] = bflo(w.y); f[3] = bfhi(w.y); f[4] = bflo(w.z); f[5] = bfhi(w.z); f[6] = bflo(w.w); f[7] = bfhi(w.w); }
__device__ __forceinline__ v4u packf8(const float (&f)[8]) { v4u w; w.x = cvtpk(f[0], f[1]); w.y = cvtpk(f[2], f[3]); w.z = cvtpk(f[4], f[5]); w.w = cvtpk(f[6], f[7]); return w; }
__device__ __forceinline__ float wave_sum(float v) {
#if XL_FAST
    return xl_swap32_sum(xl_swap16_sum(xl_sum16(v)));
#else
#pragma unroll
    for (int o = 1; o < 64; o <<= 1) v += __shfl_xor(v, o);
    return v;
#endif
}
__device__ __forceinline__ int crow(int r, int hi) { return (r & 3) + 8 * (r >> 2) + 4 * hi; }

template <bool ROPEP = false>
__device__ __forceinline__ void transpose_item64(const float* W, size_t ldw, int k0, int n0, bf16* WT, size_t ldt, int r0, LAS float* scr, int lane, int kdst = 0) {
    const GAS float* src = (const GAS float*)W + (size_t)(k0 + (lane >> 4)) * ldw + n0 + (lane & 15) * 4;
    f32x4 v[16];
#pragma unroll
    for (int i = 0; i < 16; ++i) v[i] = *(const GAS f32x4*)(src + (size_t)(4 * i) * ldw);
#pragma unroll
    for (int i = 0; i < 16; ++i) { LAS float* s = scr + (4 * i + (lane >> 4)) * 65 + (lane & 15) * 4; s[0] = v[i].x; s[1] = v[i].y; s[2] = v[i].z; s[3] = v[i].w; }
    LDS_WAIT(); asm volatile("" ::: "memory");
    const int c = lane & 7;
#pragma unroll
    for (int j = 0; j < 8; ++j) { const int n = (lane >> 3) + 8 * j; const LAS float* s = scr + (8 * c) * 65 + n;
        v4u o; o.x = cvtpk(s[0 * 65], s[1 * 65]); o.y = cvtpk(s[2 * 65], s[3 * 65]); o.z = cvtpk(s[4 * 65], s[5 * 65]); o.w = cvtpk(s[6 * 65], s[7 * 65]);
        const int nd = ROPEP ? (((n >> 4) & 1) * 32 + ((n >> 2) & 3) * 8 + (n >> 5) * 4 + (n & 3)) : n;
        *(GAS v4u*)(WT + (size_t)(r0 + nd) * ldt + kdst + k0 + 8 * c) = o; }
    LDS_WAIT(); asm volatile("" ::: "memory");
}
__device__ __forceinline__ unsigned pk4_fp8(float a, float b, float c, float d) { int r = __builtin_amdgcn_cvt_pk_fp8_f32(a, b, 0, false); r = __builtin_amdgcn_cvt_pk_fp8_f32(c, d, r, true); return (unsigned)r; }
template <bool ROPEP = false>
__device__ __forceinline__ void transpose_item64_f8(const float* W, size_t ldw, int k0, int n0, unsigned char* WT, size_t ldt, int r0, LAS float* scr, int lane, float scale) {
    const GAS float* src = (const GAS float*)W + (size_t)(k0 + (lane >> 4)) * ldw + n0 + (lane & 15) * 4;
    f32x4 v[16];
#pragma unroll
    for (int i = 0; i < 16; ++i) v[i] = *(const GAS f32x4*)(src + (size_t)(4 * i) * ldw);
#pragma unroll
    for (int i = 0; i < 16; ++i) { LAS float* s = scr + (4 * i + (lane >> 4)) * 65 + (lane & 15) * 4; s[0] = v[i].x; s[1] = v[i].y; s[2] = v[i].z; s[3] = v[i].w; }
    LDS_WAIT(); asm volatile("" ::: "memory");
    const int c = lane & 7;
#pragma unroll
    for (int j = 0; j < 8; ++j) { const int n = (lane >> 3) + 8 * j; const LAS float* s = scr + (8 * c) * 65 + n;
        u32x2 o; o.x = pk4_fp8(s[0 * 65] * scale, s[1 * 65] * scale, s[2 * 65] * scale, s[3 * 65] * scale); o.y = pk4_fp8(s[4 * 65] * scale, s[5 * 65] * scale, s[6 * 65] * scale, s[7 * 65] * scale);
        const int nd = ROPEP ? (((n >> 4) & 1) * 32 + ((n >> 2) & 3) * 8 + (n >> 5) * 4 + (n & 3)) : n;
        *(GAS u32x2*)(WT + (size_t)(r0 + nd) * ldt + k0 + 8 * c) = o; }
    LDS_WAIT(); asm volatile("" ::: "memory");
}
__device__ __forceinline__ void rms_row_to_bf16(const float* xrow, const float* gain, bf16* orow, int lane, unsigned char* orow8 = nullptr) {
    const GAS f32x4* xr = (const GAS f32x4*)xrow + lane; const GAS f32x4* gr = (const GAS f32x4*)gain + lane;
    f32x4 v[8]; float s = 0.f;
#pragma unroll
    for (int j = 0; j < 8; ++j) { v[j] = xr[64 * j]; s += (v[j].x * v[j].x + v[j].y * v[j].y) + (v[j].z * v[j].z + v[j].w * v[j].w); }
    const float rs = 1.0f / sqrtf(wave_sum(s) * (1.f / 2048.f) + EPS);
    GAS u32x2* o8 = (GAS u32x2*)orow + lane; GAS unsigned* o4 = (GAS unsigned*)orow8 + lane;
#pragma unroll
    for (int j = 0; j < 8; ++j) { const f32x4 g = gr[64 * j]; const float a0 = v[j].x * rs * g.x, a1 = v[j].y * rs * g.y, a2 = v[j].z * rs * g.z, a3 = v[j].w * rs * g.w;
        if (!(UV_F8 == 1 && GATE_F8)) { u32x2 w; w.x = cvtpk(a0, a1); w.y = cvtpk(a2, a3); o8[64 * j] = w; }
        if (orow8) o4[64 * j] = pk4_fp8(a0, a1, a2, a3); }
}
#define ATT_WAITV(n) asm volatile("s_waitcnt vmcnt(" #n ")" ::: "memory")
template <int DQK, int NSLOT, bool CAUSAL>
__device__ __forceinline__ void attn_unit(LAS unsigned char* lds, const bf16* Qw  , int qpitch, const bf16* Ktiles, const bf16* Vtiles,
                                          int ntiles, int qpos0  , unsigned char* Ow  , int opitch, int wid, int lane) {
    constexpr int KS = DQK / 16, KTB = 64 * DQK * 2, VTB = 64 * 128 * 2, KP = KTB / 1024 / 8  , VP = 2, NP = KP + VP, PF = NSLOT - 1;
    static_assert(KTB % 8192 == 0, "K tile pieces must split evenly over 8 waves");
    const int r32 = lane & 31, hi = lane >> 5;
    bf16x8 qf[KS];
    { const GAS bf16x8* qp = (const GAS bf16x8*)((const GAS bf16*)Qw + (size_t)r32 * qpitch + hi * 8);
#pragma unroll
      for (int ks = 0; ks < KS; ++ks) qf[ks] = qp[2 * ks]; }
    asm volatile("s_waitcnt vmcnt(0)" ::: "memory");
#pragma unroll
    for (int ks = 0; ks < KS; ++ks) asm volatile("" : "+v"(qf[ks]));
    const GAS unsigned char* kg = (const GAS unsigned char*)Ktiles + (size_t)wid * 1024;
    const GAS unsigned char* vg = (const GAS unsigned char*)Vtiles + (size_t)wid * 1024;
    const unsigned loff = (unsigned)lane * 16u;
    LAS unsigned char* kl = lds + wid * 1024; LAS unsigned char* vl = lds + NSLOT * KTB + wid * 1024;
#define ATT_ISSUE(t) do { const int sl_ = (t) % NSLOT; unsigned lo_ = loff; asm volatile("" : "+v"(lo_));   \
        _Pragma("unroll") for (int p_ = 0; p_ < KP; ++p_) __builtin_amdgcn_global_load_lds((const GAS unsigned*)(kg + ((size_t)(t) * KTB + p_ * 8192) + lo_), (LAS unsigned*)(kl + sl_ * KTB + p_ * 8192), 16, 0, 0); \
        _Pragma("unroll") for (int p_ = 0; p_ < VP; ++p_) __builtin_amdgcn_global_load_lds((const GAS unsigned*)(vg + ((size_t)(t) * VTB + p_ * 8192) + lo_), (LAS unsigned*)(vl + sl_ * VTB + p_ * 8192), 16, 0, 0); } while (0)
#pragma unroll
    for (int t = 0; t < PF; ++t) if (t < ntiles) ATT_ISSUE(t);
    f32x16 o[4];
#pragma unroll
    for (int d = 0; d < 4; ++d)
#pragma unroll
        for (int r = 0; r < 16; ++r) o[d][r] = 0.f;
    float mrun = -1e30f, lrun = 0.f;
    const int kbase = hi * 1024 + r32 * 16;
    const int g4 = lane >> 4, q4 = (lane >> 2) & 3, p4 = lane & 3;
    const int vbase = (4 * (g4 >> 1) + q4) * 64 + (16 * (g4 & 1) + 4 * p4) * 2;
    for (int j = 0; j < ntiles; ++j) {
        const int rem = ntiles - 1 - j;
        if (PF >= 2 && rem >= 1) { if (NP == 5) ATT_WAITV(5); else ATT_WAITV(6); } else ATT_WAITV(0);
        __builtin_amdgcn_s_barrier();
        asm volatile("" ::: "memory");
        if (j + PF < ntiles) ATT_ISSUE(j + PF);
        if (CAUSAL && 64 * j > qpos0 + 31) continue;
        const int sl = j % NSLOT;
        const LAS unsigned char* ks_ = lds + sl * KTB + kbase;
        const LAS unsigned char* vs_ = lds + NSLOT * KTB + sl * VTB + vbase;
        f32x16 p0, p1;
#pragma unroll
        for (int r = 0; r < 16; ++r) { p0[r] = 0.f; p1[r] = 0.f; }
        {   constexpr int NF = 2 * KS, KW = 8;
            bf16x8 kf[KW];
#pragma unroll
            for (int i = 0; i < KW; ++i) kf[i] = *(const LAS bf16x8*)(ks_ + (i >> 1) * 2048 + (i & 1) * 512);
            __builtin_amdgcn_sched_barrier(0);
#pragma unroll
            for (int i = 0; i < NF; ++i) {
                if (i & 1) p1 = __builtin_amdgcn_mfma_f32_32x32x16_bf16(kf[i % KW], qf[i >> 1], p1, 0, 0, 0);
                else       p0 = __builtin_amdgcn_mfma_f32_32x32x16_bf16(kf[i % KW], qf[i >> 1], p0, 0, 0, 0);
                if (i + KW < NF) kf[i % KW] = *(const LAS bf16x8*)(ks_ + ((i + KW) >> 1) * 2048 + ((i + KW) & 1) * 512);
                __builtin_amdgcn_sched_barrier(0);
            }
        }
        if (CAUSAL && 64 * j + 63 > qpos0) {
            const int dq = qpos0 + r32 - 64 * j - 4 * hi;
#pragma unroll
            for (int r = 0; r < 16; ++r) { const int c = (r & 3) + 8 * (r >> 2); if (c > dq) p0[r] = -INFINITY; if (c + 32 > dq) p1[r] = -INFINITY; }
        }
        float mx = p0[0];
#pragma unroll
        for (int r = 1; r < 16; ++r) mx = fmaxf(mx, p0[r]);
#pragma unroll
        for (int r = 0; r < 16; ++r) mx = fmaxf(mx, p1[r]);
        mx = XL_FAST ? xl_swap32_max(mx) : fmaxf(mx, __shfl_xor(mx, 32));
        const float mnew = fmaxf(mrun, mx);
        if (__any(mnew > mrun)) {
            const float alpha = __builtin_amdgcn_exp2f(mrun - mnew);
            lrun *= alpha;
#pragma unroll
            for (int d = 0; d < 4; ++d)
#pragma unroll
                for (int r = 0; r < 16; ++r) o[d][r] *= alpha;
            mrun = mnew;
        }
        float ps = 0.f;
#pragma unroll
        for (int r = 0; r < 16; ++r) { p0[r] = __builtin_amdgcn_exp2f(p0[r] - mrun); p1[r] = __builtin_amdgcn_exp2f(p1[r] - mrun); ps += p0[r] + p1[r]; }
        lrun += ps;
        bf16x8 pf[4];
        { v4u w;
          w.x = cvtpk(p0[0], p0[1]); w.y = cvtpk(p0[2], p0[3]); w.z = cvtpk(p0[4], p0[5]); w.w = cvtpk(p0[6], p0[7]); pf[0] = __builtin_bit_cast(bf16x8, w);
          w.x = cvtpk(p0[8], p0[9]); w.y = cvtpk(p0[10], p0[11]); w.z = cvtpk(p0[12], p0[13]); w.w = cvtpk(p0[14], p0[15]); pf[1] = __builtin_bit_cast(bf16x8, w);
          w.x = cvtpk(p1[0], p1[1]); w.y = cvtpk(p1[2], p1[3]); w.z = cvtpk(p1[4], p1[5]); w.w = cvtpk(p1[6], p1[7]); pf[2] = __builtin_bit_cast(bf16x8, w);
          w.x = cvtpk(p1[8], p1[9]); w.y = cvtpk(p1[10], p1[11]); w.z = cvtpk(p1[12], p1[13]); w.w = cvtpk(p1[14], p1[15]); pf[3] = __builtin_bit_cast(bf16x8, w); }
#define ATT_VLOAD(dst, s_) do { _Pragma("unroll") for (int db_ = 0; db_ < 4; ++db_) { \
            const s16x4 lo_ = __builtin_bit_cast(s16x4, __builtin_amdgcn_ds_read_tr16_b64_v4i16((LAS v4i16_t*)(vs_ + db_ * 4096 + (s_) * 1024))); \
            const s16x4 hh_ = __builtin_bit_cast(s16x4, __builtin_amdgcn_ds_read_tr16_b64_v4i16((LAS v4i16_t*)(vs_ + db_ * 4096 + (s_) * 1024 + 512))); \
            dst[db_] = (bf16x8){lo_[0], lo_[1], lo_[2], lo_[3], hh_[0], hh_[1], hh_[2], hh_[3]}; } } while (0)
        {   bf16x8 va[4], vb[4];
            ATT_VLOAD(va, 0);
            __builtin_amdgcn_sched_barrier(0);
            ATT_VLOAD(vb, 1);
#pragma unroll
            for (int db = 0; db < 4; ++db) o[db] = __builtin_amdgcn_mfma_f32_32x32x16_bf16(va[db], pf[0], o[db], 0, 0, 0);
            __builtin_amdgcn_sched_barrier(0);
            ATT_VLOAD(va, 2);
#pragma unroll
            for (int db = 0; db < 4; ++db) o[db] = __builtin_amdgcn_mfma_f32_32x32x16_bf16(vb[db], pf[1], o[db], 0, 0, 0);
            __builtin_amdgcn_sched_barrier(0);
            ATT_VLOAD(vb, 3);
#pragma unroll
            for (int db = 0; db < 4; ++db) o[db] = __builtin_amdgcn_mfma_f32_32x32x16_bf16(va[db], pf[2], o[db], 0, 0, 0);
            __builtin_amdgcn_sched_barrier(0);
#pragma unroll
            for (int db = 0; db < 4; ++db) o[db] = __builtin_amdgcn_mfma_f32_32x32x16_bf16(vb[db], pf[3], o[db], 0, 0, 0);
            __builtin_amdgcn_sched_barrier(0);
        }
#undef ATT_VLOAD
    }
    const float lt = XL_FAST ? xl_swap32_sum(lrun) : lrun + __shfl_xor(lrun, 32);
    const float il = ATT_OS / lt;
    GAS unsigned char* op = (GAS unsigned char*)Ow + (size_t)r32 * opitch + 4 * hi;
#pragma unroll
    for (int db = 0; db < 4; ++db)
#pragma unroll
        for (int rg = 0; rg < 4; ++rg) *(GAS unsigned*)(op + 32 * db + 8 * rg) = pk4_fp8(o[db][4 * rg] * il, o[db][4 * rg + 1] * il, o[db][4 * rg + 2] * il, o[db][4 * rg + 3] * il);
    asm volatile("s_waitcnt vmcnt(0) lgkmcnt(0)" ::: "memory");
    __builtin_amdgcn_s_barrier();
    asm volatile("" ::: "memory");
#undef ATT_ISSUE
}

typedef int i32x8a __attribute__((ext_vector_type(8)));
typedef int i32x4a __attribute__((ext_vector_type(4)));
__device__ __forceinline__ void att_bar4(LAS unsigned* ctr, unsigned& nbar, int lane) {
#if SPLIT_FREE
    nbar += 4;
    if (lane == 0) __hip_atomic_fetch_add(ctr, 1u, __ATOMIC_RELAXED, __HIP_MEMORY_SCOPE_WORKGROUP);
    for (;;) { const unsigned v = __builtin_amdgcn_readfirstlane(__hip_atomic_load(ctr, __ATOMIC_RELAXED, __HIP_MEMORY_SCOPE_WORKGROUP)); if (v >= nbar) break; if (ATT_POLL_SLEEP) __builtin_amdgcn_s_sleep(1); }
    asm volatile("" ::: "memory");
#else
    __builtin_amdgcn_s_barrier();
    asm volatile("" ::: "memory");
#endif
}
template <bool CAUSAL, int NWA = 8>
__device__ __forceinline__ void attn8_unit(LAS unsigned char* lds, const unsigned char* Qw  , const unsigned char* Ktiles, const unsigned char* Vtiles,
                                           int ntiles, int qpos0, unsigned char* Ow  , int opitch, int wid, int lane, LAS unsigned* bctr = nullptr, unsigned* nbar = nullptr) {
    constexpr int KTB = 12288, VTB = 8192, NSLOT = 3;
    const int r32 = lane & 31, hi = lane >> 5;
    i32x8a qf[3];
    { const GAS i32x4a* qp = (const GAS i32x4a*)((const GAS unsigned char*)Qw + (size_t)r32 * 192 + hi * 32);
#pragma unroll
      for (int s = 0; s < 3; ++s) { const i32x4a a = qp[4 * s], b = qp[4 * s + 1]; qf[s] = __builtin_shufflevector(a, b, 0, 1, 2, 3, 4, 5, 6, 7); } }
    asm volatile("s_waitcnt vmcnt(0)" ::: "memory");
#pragma unroll
    for (int s = 0; s < 3; ++s) asm volatile("" : "+v"(qf[s]));
    const GAS unsigned char* kg = (const GAS unsigned char*)Ktiles + (size_t)wid * 1024;
    const GAS unsigned char* vg = (const GAS unsigned char*)Vtiles + (size_t)wid * 1024;
    const unsigned loff = (unsigned)lane * 16u;
    LAS unsigned char* kl = lds + wid * 1024; LAS unsigned char* vl = lds + NSLOT * KTB + wid * 1024;
    const bool two = wid < 4;
#define A8_ISSUE(t) do { const int sl_ = (t) % NSLOT; unsigned lo_ = loff; asm volatile("" : "+v"(lo_)); \
        if (NWA == 8) { \
            __builtin_amdgcn_global_load_lds((const GAS unsigned*)(kg + (size_t)(t) * KTB + lo_), (LAS unsigned*)(kl + sl_ * KTB), 16, 0, 0); \
            if (two) __builtin_amdgcn_global_load_lds((const GAS unsigned*)(kg + ((size_t)(t) * KTB + 8192) + lo_), (LAS unsigned*)(kl + sl_ * KTB + 8192), 16, 0, 0); \
            __builtin_amdgcn_global_load_lds((const GAS unsigned*)(vg + (size_t)(t) * VTB + lo_), (LAS unsigned*)(vl + sl_ * VTB), 16, 0, 0); \
        } else {     \
            _Pragma("unroll") for (int p_ = 0; p_ < 3; ++p_) __builtin_amdgcn_global_load_lds((const GAS unsigned*)(kg + ((size_t)(t) * KTB + p_ * 4096) + lo_), (LAS unsigned*)(kl + sl_ * KTB + p_ * 4096), 16, 0, 0); \
            _Pragma("unroll") for (int p_ = 0; p_ < 2; ++p_) __builtin_amdgcn_global_load_lds((const GAS unsigned*)(vg + ((size_t)(t) * VTB + p_ * 4096) + lo_), (LAS unsigned*)(vl + sl_ * VTB + p_ * 4096), 16, 0, 0); \
        } } while (0)
    A8_ISSUE(0);
    if (ntiles > 1) A8_ISSUE(1);
    f32x16 o[4];
#pragma unroll
    for (int d = 0; d < 4; ++d)
#pragma unroll
        for (int r = 0; r < 16; ++r) o[d][r] = 0.f;
    float mrun = -1e30f, lrun = 0.f;
    const int kbase = (2 * hi) * 1024 + r32 * 16, vbase = (2 * hi) * 2048 + r32 * 16;
    const int SQ = 0x7b7b7b7b, SP = 0x79797979, S1 = 0x7f7f7f7f;
    for (int j = 0; j < ntiles; ++j) {
        if (ntiles - 1 - j >= 1) { if (NWA == 4) ATT_WAITV(5); else if (two) ATT_WAITV(3); else ATT_WAITV(2); } else ATT_WAITV(0);
        if (NWA == 4 && bctr) att_bar4(bctr, *nbar, lane); else { __builtin_amdgcn_s_barrier(); asm volatile("" ::: "memory"); }
        if (j + 2 < ntiles) A8_ISSUE(j + 2);
        if (CAUSAL && 64 * j > qpos0 + 31) continue;
        const int sl = j % NSLOT;
        const LAS unsigned char* ks_ = lds + sl * KTB + kbase;
        const LAS unsigned char* vs_ = lds + NSLOT * KTB + sl * VTB + vbase;
        i32x8a kf[3][2];
#pragma unroll
        for (int s = 0; s < 3; ++s)
#pragma unroll
            for (int kb = 0; kb < 2; ++kb) { const i32x4a a = *(const LAS i32x4a*)(ks_ + s * 4096 + kb * 512), b = *(const LAS i32x4a*)(ks_ + s * 4096 + kb * 512 + 1024);
                kf[s][kb] = __builtin_shufflevector(a, b, 0, 1, 2, 3, 4, 5, 6, 7); }
        f32x16 p0, p1;
#pragma unroll
        for (int r = 0; r < 16; ++r) { p0[r] = 0.f; p1[r] = 0.f; }
#pragma unroll
        for (int s = 0; s < 3; ++s) {
            p0 = __builtin_amdgcn_mfma_scale_f32_32x32x64_f8f6f4(kf[s][0], qf[s], p0, 0, 0, 0, S1, 0, SQ);
            p1 = __builtin_amdgcn_mfma_scale_f32_32x32x64_f8f6f4(kf[s][1], qf[s], p1, 0, 0, 0, S1, 0, SQ);
        }
        i32x8a vf[4];
#pragma unroll
        for (int db = 0; db < 4; ++db) { const i32x4a a = *(const LAS i32x4a*)(vs_ + db * 512), b = *(const LAS i32x4a*)(vs_ + db * 512 + 2048); vf[db] = __builtin_shufflevector(a, b, 0, 1, 2, 3, 4, 5, 6, 7); }
        __builtin_amdgcn_sched_barrier(0);
        if (CAUSAL && 64 * j + 63 > qpos0) {
            const int dq = qpos0 + r32 - 64 * j - 4 * hi;
#pragma unroll
            for (int r = 0; r < 16; ++r) { const int c = (r & 3) + 8 * (r >> 2); if (c > dq) p0[r] = -INFINITY; if (c + 32 > dq) p1[r] = -INFINITY; }
        }
        float mx = p0[0];
#pragma unroll
        for (int r = 1; r < 16; ++r) mx = fmaxf(mx, p0[r]);
#pragma unroll
        for (int r = 0; r < 16; ++r) mx = fmaxf(mx, p1[r]);
        mx = XL_FAST ? xl_swap32_max(mx) : fmaxf(mx, __shfl_xor(mx, 32));
        const float mnew = fmaxf(mrun, mx);
        if (__any(mx > mrun + 2.0f)) {
            const float alpha = __builtin_amdgcn_exp2f(mrun - mnew);
            lrun *= alpha;
#pragma unroll
            for (int d = 0; d < 4; ++d)
#pragma unroll
                for (int r = 0; r < 16; ++r) o[d][r] *= alpha;
            mrun = mnew;
        }
        float ps = 0.f; const float msh = mrun - 6.0f;
#pragma unroll
        for (int r = 0; r < 16; ++r) { p0[r] = __builtin_amdgcn_exp2f(p0[r] - msh); p1[r] = __builtin_amdgcn_exp2f(p1[r] - msh); ps += p0[r] + p1[r]; }
        lrun += ps;
        i32x8a pf;
        pf[0] = (int)pk4_fp8(p0[0], p0[1], p0[2], p0[3]); pf[1] = (int)pk4_fp8(p0[4], p0[5], p0[6], p0[7]); pf[2] = (int)pk4_fp8(p0[8], p0[9], p0[10], p0[11]); pf[3] = (int)pk4_fp8(p0[12], p0[13], p0[14], p0[15]);
        pf[4] = (int)pk4_fp8(p1[0], p1[1], p1[2], p1[3]); pf[5] = (int)pk4_fp8(p1[4], p1[5], p1[6], p1[7]); pf[6] = (int)pk4_fp8(p1[8], p1[9], p1[10], p1[11]); pf[7] = (int)pk4_fp8(p1[12], p1[13], p1[14], p1[15]);
#pragma unroll
        for (int db = 0; db < 4; ++db) o[db] = __builtin_amdgcn_mfma_scale_f32_32x32x64_f8f6f4(vf[db], pf, o[db], 0, 0, 0, S1, 0, SP);
    }
    const float lt = XL_FAST ? xl_swap32_sum(lrun) : lrun + __shfl_xor(lrun, 32);
    const float il = 64.0f * ATT_OS / lt;
    GAS unsigned char* op = (GAS unsigned char*)Ow + (size_t)r32 * opitch + 4 * hi;
#pragma unroll
    for (int db = 0; db < 4; ++db)
#pragma unroll
        for (int rg = 0; rg < 4; ++rg) *(GAS unsigned*)(op + 32 * db + 8 * rg) = pk4_fp8(o[db][4 * rg] * il, o[db][4 * rg + 1] * il, o[db][4 * rg + 2] * il, o[db][4 * rg + 3] * il);
    asm volatile("s_waitcnt vmcnt(0) lgkmcnt(0)" ::: "memory");
    if (NWA == 4 && bctr) att_bar4(bctr, *nbar, lane); else { __builtin_amdgcn_s_barrier(); asm volatile("" ::: "memory"); }
#undef A8_ISSUE
}

__device__ __forceinline__ float xhalf_max(float x) { const auto r = __builtin_amdgcn_permlane32_swap(__float_as_uint(x), __float_as_uint(x), false, false); return fmaxf(__uint_as_float(r[0]), __uint_as_float(r[1])); }
__device__ __forceinline__ float xhalf_sum(float x) { const auto r = __builtin_amdgcn_permlane32_swap(__float_as_uint(x), __float_as_uint(x), false, false); return __uint_as_float(r[0]) + __uint_as_float(r[1]); }
template <bool CAUSAL>
__device__ __forceinline__ void attn8_unit2(LAS unsigned char* lds, const unsigned char* Qw  , const unsigned char* Ktiles, const unsigned char* Vtiles,
                                            int ntiles, int qpos0  , unsigned char* Ow, int opitch, int wid, int lane, LAS unsigned* bctr, unsigned& nbar) {
    constexpr int KTB = 12288, VTB = 8192, NSLOT = ATT_PAIR ? 2 : 3, KSB = ATT_PAIR ? 2 * KTB : KTB, VSB = ATT_PAIR ? 2 * VTB : VTB;
    const int r32 = lane & 31, hi = lane >> 5;
    i32x8a qf[2][3];
#pragma unroll
    for (int bk = 0; bk < 2; ++bk) { const GAS i32x4a* qp = (const GAS i32x4a*)((const GAS unsigned char*)Qw + (size_t)(128 * bk + r32) * 192 + hi * 32);
#pragma unroll
      for (int s = 0; s < 3; ++s) { const i32x4a a = qp[4 * s], b = qp[4 * s + 1]; qf[bk][s] = __builtin_shufflevector(a, b, 0, 1, 2, 3, 4, 5, 6, 7); } }
    asm volatile("s_waitcnt vmcnt(0)" ::: "memory");
#pragma unroll
    for (int bk = 0; bk < 2; ++bk)
#pragma unroll
        for (int s = 0; s < 3; ++s) asm volatile("" : "+v"(qf[bk][s]));
    const GAS unsigned char* kg = (const GAS unsigned char*)Ktiles + (size_t)wid * 1024;
    const GAS unsigned char* vg = (const GAS unsigned char*)Vtiles + (size_t)wid * 1024;
    const unsigned loff = (unsigned)lane * 16u;
    LAS unsigned char* kl = lds + wid * 1024; LAS unsigned char* vl = lds + NSLOT * KSB + wid * 1024;
#define A2_ISSUE(t) do { const int sl_ = (t) % NSLOT; unsigned lo_ = loff; asm volatile("" : "+v"(lo_)); \
        _Pragma("unroll") for (int p_ = 0; p_ < KSB / 4096; ++p_) __builtin_amdgcn_global_load_lds((const GAS unsigned*)(kg + ((size_t)(t) * KSB + p_ * 4096) + lo_), (LAS unsigned*)(kl + sl_ * KSB + p_ * 4096), 16, 0, 0); \
        _Pragma("unroll") for (int p_ = 0; p_ < VSB / 4096; ++p_) __builtin_amdgcn_global_load_lds((const GAS unsigned*)(vg + ((size_t)(t) * VSB + p_ * 4096) + lo_), (LAS unsigned*)(vl + sl_ * VSB + p_ * 4096), 16, 0, 0); } while (0)
#define A2_PIECE(tp_, ix_) do { const int sl_ = (tp_) % NSLOT; unsigned lo_ = loff; asm volatile("" : "+v"(lo_)); \
        if ((ix_) < 6) __builtin_amdgcn_global_load_lds((const GAS unsigned*)(kg + ((size_t)(tp_) * KSB + (ix_) * 4096) + lo_), (LAS unsigned*)(kl + sl_ * KSB + (ix_) * 4096), 16, 0, 0); \
        else __builtin_amdgcn_global_load_lds((const GAS unsigned*)(vg + ((size_t)(tp_) * VSB + ((ix_) - 6) * 4096) + lo_), (LAS unsigned*)(vl + sl_ * VSB + ((ix_) - 6) * 4096), 16, 0, 0); } while (0)
#define A2_SPREAD(ix_) do { if (ATT_SPREAD && ATT_PAIR && bk == 1 && pend) { __builtin_amdgcn_sched_barrier(0); A2_PIECE((j >> 1) + 1, ix_); __builtin_amdgcn_sched_barrier(0); } } while (0)
    A2_ISSUE(0);
    if (!ATT_PAIR && ntiles > 1) A2_ISSUE(1);
    f32x16 o[2][4];
#pragma unroll
    for (int bk = 0; bk < 2; ++bk)
#pragma unroll
        for (int d = 0; d < 4; ++d)
#pragma unroll
            for (int r = 0; r < 16; ++r) o[bk][d][r] = 0.f;
    float mrun[2] = {-1e30f, -1e30f}, lrun[2] = {0.f, 0.f};
    const int kbase = (2 * hi) * 1024 + r32 * 16, vbase = (2 * hi) * 2048 + r32 * 16;
    const int SQ = 0x7b7b7b7b, SP = 0x79797979, S1 = 0x7f7f7f7f;
    for (int j = 0; j < ntiles; ++j) {
#if ATT_PAIR
        if ((j & 1) == 0) {
            ATT_WAITV(0);
            att_bar4(bctr, nbar, lane);
            if (!ATT_SPREAD && j + 2 < ntiles) A2_ISSUE((j >> 1) + 1);
        }
        const bool pend = ATT_SPREAD && (j & 1) == 0 && (j + 2 < ntiles); (void)pend;
        const int sl = (j >> 1) % NSLOT;
        unsigned ka_ = (unsigned)(sl * KSB + (j & 1) * KTB + kbase), va_ = (unsigned)(NSLOT * KSB + sl * VSB + (j & 1) * VTB + vbase);
#else
        if (ntiles - 1 - j >= 1) ATT_WAITV(5); else ATT_WAITV(0);
        att_bar4(bctr, nbar, lane);
        if (j + 2 < ntiles) A2_ISSUE(j + 2);
        const int sl = j % NSLOT;
        unsigned ka_ = (unsigned)(sl * KTB + kbase), va_ = (unsigned)(NSLOT * KTB + sl * VTB + vbase);
        const bool pend = false; (void)pend;
#endif
        asm volatile("" : "+v"(ka_), "+v"(va_));
        const LAS unsigned char* ks_ = lds + ka_;
        const LAS unsigned char* vs_ = lds + va_;
        i32x8a pf_prev; bool have_prev = false; (void)pf_prev;
#pragma unroll
        for (int bk = 0; bk < 2; ++bk) {
            const int qp0 = qpos0 + 128 * bk;
            if (CAUSAL && 64 * j > qp0 + 31) continue;
#if ATT_SPLITQK
            f32x16 p0, p1;
#pragma unroll
            for (int r = 0; r < 16; ++r) { p0[r] = 0.f; p1[r] = 0.f; }
#pragma unroll
            for (int s = 0; s < 3; ++s) {
                const i32x4a a0 = *(const LAS i32x4a*)(ks_ + s * 4096), b0 = *(const LAS i32x4a*)(ks_ + s * 4096 + 1024);
                const i32x8a k0 = __builtin_shufflevector(a0, b0, 0, 1, 2, 3, 4, 5, 6, 7);
                p0 = __builtin_amdgcn_mfma_scale_f32_32x32x64_f8f6f4(k0, qf[bk][s], p0, 0, 0, 0, S1, 0, SQ);
            }
            __builtin_amdgcn_sched_barrier(0);
#pragma unroll
            for (int s = 0; s < 3; ++s) {
                const i32x4a a1 = *(const LAS i32x4a*)(ks_ + s * 4096 + 512), b1 = *(const LAS i32x4a*)(ks_ + s * 4096 + 512 + 1024);
                const i32x8a k1 = __builtin_shufflevector(a1, b1, 0, 1, 2, 3, 4, 5, 6, 7);
                p1 = __builtin_amdgcn_mfma_scale_f32_32x32x64_f8f6f4(k1, qf[bk][s], p1, 0, 0, 0, S1, 0, SQ);
            }
            __builtin_amdgcn_sched_barrier(0);
            const bool diag = CAUSAL && 64 * j + 63 > qp0;
            const int dq = qp0 + r32 - 64 * j - 4 * hi;
            if (diag) {
#pragma unroll
                for (int r = 0; r < 16; ++r) { const int c = (r & 3) + 8 * (r >> 2); if (c > dq) p0[r] = -INFINITY; }
            }
            float mx = p0[0];
#pragma unroll
            for (int r = 1; r < 16; ++r) mx = fmaxf(mx, p0[r]);
            mx = ATT_PERMLANE ? xhalf_max(mx) : fmaxf(mx, __shfl_xor(mx, 32));
            if (__any(mx > mrun[bk] + 2.0f)) {
                const float mnew = fmaxf(mrun[bk], mx), alpha = __builtin_amdgcn_exp2f(mrun[bk] - mnew);
                lrun[bk] *= alpha;
#pragma unroll
                for (int d = 0; d < 4; ++d)
#pragma unroll
                    for (int r = 0; r < 16; ++r) o[bk][d][r] *= alpha;
                mrun[bk] = mnew;
            }
            float msh = mrun[bk] - 6.0f, ps = 0.f;
#pragma unroll
            for (int r = 0; r < 16; ++r) { p0[r] = __builtin_amdgcn_exp2f(p0[r] - msh); ps += p0[r]; }
            __builtin_amdgcn_sched_barrier(0);
            if (diag) {
#pragma unroll
                for (int r = 0; r < 16; ++r) { const int c = (r & 3) + 8 * (r >> 2); if (c + 32 > dq) p1[r] = -INFINITY; }
            }
            mx = p1[0];
#pragma unroll
            for (int r = 1; r < 16; ++r) mx = fmaxf(mx, p1[r]);
            mx = ATT_PERMLANE ? xhalf_max(mx) : fmaxf(mx, __shfl_xor(mx, 32));
            if (__any(mx > mrun[bk] + 2.0f)) {
                const float mnew = fmaxf(mrun[bk], mx), alpha = __builtin_amdgcn_exp2f(mrun[bk] - mnew);
                lrun[bk] *= alpha; ps *= alpha;
#pragma unroll
                for (int r = 0; r < 16; ++r) p0[r] *= alpha;
#pragma unroll
                for (int d = 0; d < 4; ++d)
#pragma unroll
                    for (int r = 0; r < 16; ++r) o[bk][d][r] *= alpha;
                mrun[bk] = mnew; msh = mnew - 6.0f;
            }
#pragma unroll
            for (int r = 0; r < 16; ++r) { p1[r] = __builtin_amdgcn_exp2f(p1[r] - msh); ps += p1[r]; }
            lrun[bk] += ps;
            i32x8a pf;
            pf[0] = (int)pk4_fp8(p0[0], p0[1], p0[2], p0[3]); pf[1] = (int)pk4_fp8(p0[4], p0[5], p0[6], p0[7]); pf[2] = (int)pk4_fp8(p0[8], p0[9], p0[10], p0[11]); pf[3] = (int)pk4_fp8(p0[12], p0[13], p0[14], p0[15]);
            pf[4] = (int)pk4_fp8(p1[0], p1[1], p1[2], p1[3]); pf[5] = (int)pk4_fp8(p1[4], p1[5], p1[6], p1[7]); pf[6] = (int)pk4_fp8(p1[8], p1[9], p1[10], p1[11]); pf[7] = (int)pk4_fp8(p1[12], p1[13], p1[14], p1[15]);
            asm volatile("" : "+v"(pf));
#pragma unroll
            for (int db = 0; db < 4; ++db) { const i32x4a a = *(const LAS i32x4a*)(vs_ + db * 512), b = *(const LAS i32x4a*)(vs_ + db * 512 + 2048);
                const i32x8a vfd = __builtin_shufflevector(a, b, 0, 1, 2, 3, 4, 5, 6, 7);
                asm volatile("v_mfma_scale_f32_32x32x64_f8f6f4 %0, %1, %2, %0, %3, %4 op_sel_hi:[0,0,0]" : "+v"(o[bk][db]) : "v"(vfd), "v"(pf), "v"(S1), "v"(SP));
                A2_SPREAD(6 + db); }
            if (ATT_SPREAD && ATT_PAIR && bk == 1 && pend) { A2_PIECE((j >> 1) + 1, 0); A2_PIECE((j >> 1) + 1, 1); A2_PIECE((j >> 1) + 1, 2); A2_PIECE((j >> 1) + 1, 3); A2_PIECE((j >> 1) + 1, 4); A2_PIECE((j >> 1) + 1, 5); }
#else
            f32x16 p0, p1;
#pragma unroll
            for (int r = 0; r < 16; ++r) { p0[r] = 0.f; p1[r] = 0.f; }
#pragma unroll
            for (int s = 0; s < 3; ++s) {
                const i32x4a a0 = *(const LAS i32x4a*)(ks_ + s * 4096), b0 = *(const LAS i32x4a*)(ks_ + s * 4096 + 1024);
                const i32x4a a1 = *(const LAS i32x4a*)(ks_ + s * 4096 + 512), b1 = *(const LAS i32x4a*)(ks_ + s * 4096 + 512 + 1024);
                const i32x8a k0 = __builtin_shufflevector(a0, b0, 0, 1, 2, 3, 4, 5, 6, 7), k1 = __builtin_shufflevector(a1, b1, 0, 1, 2, 3, 4, 5, 6, 7);
                p0 = __builtin_amdgcn_mfma_scale_f32_32x32x64_f8f6f4(k0, qf[bk][s], p0, 0, 0, 0, S1, 0, SQ);
                p1 = __builtin_amdgcn_mfma_scale_f32_32x32x64_f8f6f4(k1, qf[bk][s], p1, 0, 0, 0, S1, 0, SQ);
            }
#if ATT_DEFER
            if (bk == 1 && have_prev) {
                __builtin_amdgcn_sched_barrier(0);
#pragma unroll
                for (int db = 0; db < 4; ++db) { const i32x4a a = *(const LAS i32x4a*)(vs_ + db * 512), b = *(const LAS i32x4a*)(vs_ + db * 512 + 2048);
                    const i32x8a vfd = __builtin_shufflevector(a, b, 0, 1, 2, 3, 4, 5, 6, 7);
                    asm volatile("v_mfma_scale_f32_32x32x64_f8f6f4 %0, %1, %2, %0, %3, %4 op_sel_hi:[0,0,0]" : "+v"(o[0][db]) : "v"(vfd), "v"(pf_prev), "v"(S1), "v"(SP));
                    __builtin_amdgcn_sched_barrier(0); }
            }
#endif
            if (CAUSAL && 64 * j + 63 > qp0) {
                const int dq = qp0 + r32 - 64 * j - 4 * hi;
#pragma unroll
                for (int r = 0; r < 16; ++r) { const int c = (r & 3) + 8 * (r >> 2); if (c > dq) p0[r] = -INFINITY; if (c + 32 > dq) p1[r] = -INFINITY; }
            }
            float mx = p0[0];
#pragma unroll
            for (int r = 1; r < 16; ++r) mx = fmaxf(mx, p0[r]);
#pragma unroll
            for (int r = 0; r < 16; ++r) mx = fmaxf(mx, p1[r]);
            mx = ATT_PERMLANE ? xhalf_max(mx) : fmaxf(mx, __shfl_xor(mx, 32));
            const float mnew = fmaxf(mrun[bk], mx);
            if (__any(mx > mrun[bk] + 2.0f)) {
                const float alpha = __builtin_amdgcn_exp2f(mrun[bk] - mnew);
                lrun[bk] *= alpha;
#pragma unroll
                for (int d = 0; d < 4; ++d)
#pragma unroll
                    for (int r = 0; r < 16; ++r) o[bk][d][r] *= alpha;
                mrun[bk] = mnew;
            }
#if ATT_VPRE
            float ps = 0.f; const float msh = mrun[bk] - 6.0f;
            i32x8a pf;
#pragma unroll
            for (int r = 0; r < 16; ++r) { p0[r] = __builtin_amdgcn_exp2f(p0[r] - msh); ps += p0[r]; }
            pf[0] = (int)pk4_fp8(p0[0], p0[1], p0[2], p0[3]); pf[1] = (int)pk4_fp8(p0[4], p0[5], p0[6], p0[7]); pf[2] = (int)pk4_fp8(p0[8], p0[9], p0[10], p0[11]); pf[3] = (int)pk4_fp8(p0[12], p0[13], p0[14], p0[15]);
            asm volatile("" : "+v"(pf[0]), "+v"(pf[1]), "+v"(pf[2]), "+v"(pf[3]));
            i32x8a vf0, vf1, vf2, vf3;
            { const i32x4a a = *(const LAS i32x4a*)(vs_ + 0 * 512), b = *(const LAS i32x4a*)(vs_ + 0 * 512 + 2048); vf0 = __builtin_shufflevector(a, b, 0, 1, 2, 3, 4, 5, 6, 7); }
            { const i32x4a a = *(const LAS i32x4a*)(vs_ + 1 * 512), b = *(const LAS i32x4a*)(vs_ + 1 * 512 + 2048); vf1 = __builtin_shufflevector(a, b, 0, 1, 2, 3, 4, 5, 6, 7); }
            asm volatile("" ::: "memory");
#pragma unroll
            for (int r = 0; r < 16; ++r) { p1[r] = __builtin_amdgcn_exp2f(p1[r] - msh); ps += p1[r]; }
            lrun[bk] += ps;
            pf[4] = (int)pk4_fp8(p1[0], p1[1], p1[2], p1[3]); pf[5] = (int)pk4_fp8(p1[4], p1[5], p1[6], p1[7]); pf[6] = (int)pk4_fp8(p1[8], p1[9], p1[10], p1[11]); pf[7] = (int)pk4_fp8(p1[12], p1[13], p1[14], p1[15]);
            asm volatile("" : "+v"(pf));
            { const i32x4a a = *(const LAS i32x4a*)(vs_ + 2 * 512), b = *(const LAS i32x4a*)(vs_ + 2 * 512 + 2048); vf2 = __builtin_shufflevector(a, b, 0, 1, 2, 3, 4, 5, 6, 7); }
            { const i32x4a a = *(const LAS i32x4a*)(vs_ + 3 * 512), b = *(const LAS i32x4a*)(vs_ + 3 * 512 + 2048); vf3 = __builtin_shufflevector(a, b, 0, 1, 2, 3, 4, 5, 6, 7); }
            asm volatile("v_mfma_scale_f32_32x32x64_f8f6f4 %0, %1, %2, %0, %3, %4 op_sel_hi:[0,0,0]" : "+v"(o[bk][0]) : "v"(vf0), "v"(pf), "v"(S1), "v"(SP));
            asm volatile("v_mfma_scale_f32_32x32x64_f8f6f4 %0, %1, %2, %0, %3, %4 op_sel_hi:[0,0,0]" : "+v"(o[bk][1]) : "v"(vf1), "v"(pf), "v"(S1), "v"(SP));
            asm volatile("v_mfma_scale_f32_32x32x64_f8f6f4 %0, %1, %2, %0, %3, %4 op_sel_hi:[0,0,0]" : "+v"(o[bk][2]) : "v"(vf2), "v"(pf), "v"(S1), "v"(SP));
            asm volatile("v_mfma_scale_f32_32x32x64_f8f6f4 %0, %1, %2, %0, %3, %4 op_sel_hi:[0,0,0]" : "+v"(o[bk][3]) : "v"(vf3), "v"(pf), "v"(S1), "v"(SP));
#else
            float ps = 0.f; const float msh = mrun[bk] - 6.0f;
#pragma unroll
            for (int r = 0; r < 16; ++r) { p0[r] = __builtin_amdgcn_exp2f(p0[r] - msh); p1[r] = __builtin_amdgcn_exp2f(p1[r] - msh); ps += p0[r] + p1[r]; }
            lrun[bk] += ps;
            i32x8a pf;
            pf[0] = (int)pk4_fp8(p0[0], p0[1], p0[2], p0[3]); pf[1] = (int)pk4_fp8(p0[4], p0[5], p0[6], p0[7]); pf[2] = (int)pk4_fp8(p0[8], p0[9], p0[10], p0[11]); pf[3] = (int)pk4_fp8(p0[12], p0[13], p0[14], p0[15]);
            pf[4] = (int)pk4_fp8(p1[0], p1[1], p1[2], p1[3]); pf[5] = (int)pk4_fp8(p1[4], p1[5], p1[6], p1[7]); pf[6] = (int)pk4_fp8(p1[8], p1[9], p1[10], p1[11]); pf[7] = (int)pk4_fp8(p1[12], p1[13], p1[14], p1[15]);
            asm volatile("" : "+v"(pf));
#if ATT_DEFER
            if (bk == 0) { pf_prev = pf; have_prev = true; } else
#endif
            {
#pragma unroll
            for (int db = 0; db < 4; ++db) { const i32x4a a = *(const LAS i32x4a*)(vs_ + db * 512), b = *(const LAS i32x4a*)(vs_ + db * 512 + 2048);
                const i32x8a vfd = __builtin_shufflevector(a, b, 0, 1, 2, 3, 4, 5, 6, 7);
                asm volatile("v_mfma_scale_f32_32x32x64_f8f6f4 %0, %1, %2, %0, %3, %4 op_sel_hi:[0,0,0]" : "+v"(o[bk][db]) : "v"(vfd), "v"(pf), "v"(S1), "v"(SP)); }
            }
#endif
#endif
        }
    }
    asm volatile("s_nop 15\n s_nop 15" ::: "memory");
#pragma unroll
    for (int bk = 0; bk < 2; ++bk) {
        const float lt = ATT_PERMLANE ? xhalf_sum(lrun[bk]) : lrun[bk] + __shfl_xor(lrun[bk], 32);
        const float il = 64.0f * ATT_OS / lt;
#if ATT_OWIDE
        unsigned ooff_ = (unsigned)(r32 * opitch + 16 * hi); asm volatile("" : "+v"(ooff_));
        GAS unsigned char* op = (GAS unsigned char*)Ow + (size_t)(128 * bk) * opitch + ooff_;
#pragma unroll
        for (int db = 0; db < 4; ++db) {
            unsigned w[4];
#pragma unroll
            for (int rg = 0; rg < 4; ++rg) w[rg] = pk4_fp8(o[bk][db][4 * rg] * il, o[bk][db][4 * rg + 1] * il, o[bk][db][4 * rg + 2] * il, o[bk][db][4 * rg + 3] * il);
            const auto s02 = __builtin_amdgcn_permlane32_swap(w[0], w[2], false, false);
            const auto s13 = __builtin_amdgcn_permlane32_swap(w[1], w[3], false, false);
            v4u ov; ov.x = s02[0]; ov.y = s02[1]; ov.z = s13[0]; ov.w = s13[1];
            *(GAS v4u*)(op + 32 * db) = ov;
            __builtin_amdgcn_sched_barrier(0);
        }
    }
#else
        GAS unsigned char* op = (GAS unsigned char*)Ow + (size_t)(128 * bk + r32) * opitch + 4 * hi;
#pragma unroll
        for (int db = 0; db < 4; ++db)
#pragma unroll
            for (int rg = 0; rg < 4; ++rg) *(GAS unsigned*)(op + 32 * db + 8 * rg) = pk4_fp8(o[bk][db][4 * rg] * il, o[bk][db][4 * rg + 1] * il, o[bk][db][4 * rg + 2] * il, o[bk][db][4 * rg + 3] * il);
    }
#endif
    asm volatile("s_waitcnt vmcnt(0) lgkmcnt(0)" ::: "memory");
    att_bar4(bctr, nbar, lane);
#undef A2_ISSUE
#undef A2_PIECE
#undef A2_SPREAD
}
struct Frame {
    LAS unsigned char* lds;
    volatile LAS unsigned* MISC;
    gu32* ctl;
    int tid, lane, wave, vcu, G;
    unsigned char* ws;
};
#define WSP(T_, off) ((T_*)(F.ws + (off)))

template <int PART>
__device__ __forceinline__ void p0_prologue(Frame& F, const float* const* in, const int rank = 0, const int nrank = 0) {
    LAS float* scr = (LAS float*)(F.lds + RING_OFF + F.wave * 16640);
    const int gw = (PART == 1 ? rank : F.vcu) * NWAVES + F.wave, NGW = (PART == 1 ? nrank : F.G) * NWAVES, lane = F.lane;
    constexpr int I0 = 32 * 65, I1 = 32 * 96, I2 = 32 * 16, I3 = 32 * 16, I4 = 8 * 48, I5 = 8 * 64, I6 = 16 * 32, I7 = 32 * 32, I8 = 16 * 32, I9 = 32 * 32;
    constexpr int NITEMS = I0 + I1 + I2 + I3 + I4 + I5 + I6 + I7 + I8 + I9;
    bf16* W1T = WSP(bf16, WS_W1T);
    constexpr int NIT_A = I0 + I1 + I2 + I3;
    constexpr int NIT_B = (PRO_SPLIT == 2) ? NIT_A + I4 + I5 : NITEMS;
    const int it_lo = (PART == 1) ? NIT_A : 0, it_hi = (PART == 1) ? NIT_B : NITEMS;
    for (int it = it_lo + gw; it < it_hi; it += NGW) {
        if (PART == 0 && PRO_SPLIT && it >= NIT_A && it < NIT_B) continue;
        int r = it;
        if (r < I0) { const int kb = r / 65, cb = r % 65, c = 64 * cb;
            const int r0 = c < 3072 ? c : (c < 3136 ? 4096 + (c - 3072) : 3072 + (c - 3136));
            if (GATE_F8 && (UV_F8 == 1 || r0 >= (UV_F8 == 2 ? 1024 : 2048))) transpose_item64_f8(in[4], 4160, 64 * kb, c, WSP(unsigned char, WS_WG8U), 2048, r0, scr, lane, MOE_WSCALE);
            else transpose_item64(in[4], 4160, 64 * kb, c, W1T, HPITCH, r0, scr, lane);
            continue; } r -= I0;
        if (r < I1) { const int kb = r / 96, cb = r % 96;
            if (GATE_F8) transpose_item64_f8(in[5], 6144, 64 * kb, 64 * cb, WSP(unsigned char, WS_WG8), 2048, 9 * 256 + 64 * cb, scr, lane, MOE_WSCALE);
            else transpose_item64(in[5], 6144, 64 * kb, 64 * cb, W1T, HPITCH, P1_G + 64 * cb, scr, lane);
            continue; } r -= I1;
        if (r < I2) { const int kb = r / 16, cb = r % 16;
            if (GATE_F8) transpose_item64_f8(in[20], 1024, 64 * kb, 64 * cb, WSP(unsigned char, WS_WG8), 2048, 33 * 256 + 64 * cb, scr, lane, MOE_WSCALE);
            else transpose_item64(in[20], 1024, 64 * kb, 64 * cb, W1T, HPITCH, P1N + 64 * cb, scr, lane);
            continue; } r -= I2;
        if (r < I3) { const int kb = r / 16, cb = r % 16;
            if (GATE_F8) transpose_item64_f8(in[21], 1024, 64 * kb, 64 * cb, WSP(unsigned char, WS_WG8), 2048, 33 * 256 + 1024 + 64 * cb, scr, lane, MOE_WSCALE);
            else transpose_item64(in[21], 1024, 64 * kb, 64 * cb, W1T, HPITCH, P1N + 1024 + 64 * cb, scr, lane);
            continue; } r -= I3;
        if (r < I4) { const int kb = r / 48, cb = r % 48, hh = cb / 3, part = cb % 3;
            if (part < 2) transpose_item64_f8(in[13], 3072, 64 * kb, 64 * cb, WSP(unsigned char, WS_WUQT), 512, 256 * hh + 64 * part, scr, lane, UP_WSCALE);
            else transpose_item64_f8<true>(in[13], 3072, 64 * kb, 64 * cb, WSP(unsigned char, WS_WUQT), 512, 256 * hh + 128, scr, lane, UP_WSCALE);
            continue; } r -= I4;
        if (r < I5) { const int kb = r / 64, cb = r % 64; transpose_item64_f8(in[15], 4096, 64 * kb, 64 * cb, WSP(unsigned char, WS_WUKVT), 512, 64 * cb, scr, lane, UP_WSCALE); continue; } r -= I5;
        if (r < I6) { const int kb = r / 32, cb = r % 32; transpose_item64(in[11], 2048, 64 * kb, 64 * cb, WSP(bf16, WS_WPT), ABC_LD, 64 * cb, scr, lane, 0); continue; } r -= I6;
        if (r < I7) { const int kb = r / 32, cb = r % 32; transpose_item64_f8(in[18], 2048, 64 * kb, 64 * cb, WSP(unsigned char, WS_WPT) + ABC_BB, ABC_ROWB, 64 * cb, scr, lane, MOE_WSCALE); continue; } r -= I7;
        if (r < I8) { const int kb = r / 32, cb = r % 32; transpose_item64_f8(in[24], 2048, 64 * kb, 64 * cb, WSP(unsigned char, WS_WPT) + ABC_CB, ABC_ROWB, 64 * cb, scr, lane, MOE_WSCALE); continue; } r -= I8;
        { const int kb = r / 32, cb = r % 32; transpose_item64(in[25], 2048, 64 * kb, 64 * cb, WSP(bf16, WS_WOT), 2048, 64 * cb, scr, lane); }
    }
    if (PART == 1) return;
    const int gt = gw * 64 + lane, NGT = NGW * 64;
    for (int i = gt; i < 192 * 2048 / 8; i += NGT) { const int rr = i / 256, cc = i % 256; *(GAS v4u*)(W1T + (size_t)(4160 + rr) * HPITCH + (size_t)cc * 8) = (v4u){0u, 0u, 0u, 0u}; }
    if (GATE_F8) for (int i = gt; i < 192 * 2048 / 16; i += NGT) *(GAS v4u*)(WSP(unsigned char, WS_WG8) + (size_t)(2048 + 64) * 2048 + (size_t)i * 16) = (v4u){0u, 0u, 0u, 0u};
    for (int i = gt; i < 16 * 64 * 512 / 16; i += NGT) { const int hh = i / (64 * 512 / 16), q = i % (64 * 512 / 16); *(GAS v4u*)(WSP(unsigned char, WS_WUQT) + (size_t)(256 * hh + 192) * 512 + (size_t)q * 16) = (v4u){0u, 0u, 0u, 0u}; }
    { const float* wsrc = in[9]; bf16* wsm = WSP(bf16, WS_WSM);
      for (int i = gt; i < 8 * 128 * 128; i += NGT) { const int t = (i >> 7) & 127, s = i & 127; const float v = (s <= t) ? wsrc[i] : 0.f; wsm[i] = (bf16)(cvtpk(v, 0.f) & 0xffffu); } }
    { const float* rw = in[27]; const float* g2 = in[26]; float* rwg = WSP(float, WS_RWG);
#if ROUTER_BF16X2
      { bf16* wh = (bf16*)rwg; bf16* wl = wh + 32 * 2048;
        for (int i = gt; i < 2048 * 32; i += NGT) { const int k = i >> 5, ex = i & 31; const float w = rw[i] * g2[k];
            const unsigned h = cvtpk(w, 0.f) & 0xffffu; const float r = w - __uint_as_float(h << 16);
            wh[ex * 2048 + k] = (bf16)h; wl[ex * 2048 + k] = (bf16)(cvtpk(r, 0.f) & 0xffffu); } }
      (void)rwg; }
#else
      for (int i = gt; i < 2048 * 32; i += NGT) rwg[i] = rw[i] * g2[i >> 5]; }
#endif
    bf16* H = WSP(bf16, WS_H);
    for (int m = gw; m < T + MEMROWS; m += NGW) {
        if (m < T) rms_row_to_bf16(in[0] + (size_t)m * 2048, in[3], H + (size_t)m * HPITCH, lane, WSP(unsigned char, WS_H8) + (size_t)m * 2048);
        else rms_row_to_bf16(in[1] + (size_t)(m - T) * 2048, in[19], H + (size_t)m * HPITCH, lane, WSP(unsigned char, WS_H8) + (size_t)m * 2048);
    }
}

struct MoeItem { const float* src; size_t ldw; unsigned char* dst; int r0; int k0; };
__device__ __forceinline__ MoeItem moe_item(Frame& F, const float* const* in, int it) {
    constexpr int I10 = NE * 32 * 64;
    MoeItem m;
    if (it < I10) { const int e = it / 2048, q = it % 2048, kb = q / 64, cb = q % 64;
        m.r0 = cb < 32 ? 256 * (cb >> 1) + 64 * (cb & 1) : 256 * ((cb - 32) >> 1) + 128 + 64 * (cb & 1);
        m.src = in[29] + (size_t)e * 2048 * 4096 + (size_t)(64 * kb) * 4096 + 64 * cb; m.ldw = 4096; m.dst = WSP(unsigned char, WS_WGUT) + (size_t)e * 4096 * 2048; m.k0 = 64 * kb; }
    else { const int r = it - I10, e = r / 1024, q = r % 1024, kb = q / 32, cb = q % 32;
        m.r0 = 64 * cb; m.src = in[31] + (size_t)e * 2048 * 2048 + (size_t)(64 * kb) * 2048 + 64 * cb; m.ldw = 2048; m.dst = WSP(unsigned char, WS_WDT) + (size_t)e * 2048 * 2048; m.k0 = 64 * kb; }
    return m;
}
#define MOE_LOADS(v_, m_) do { const GAS float* src_ = (const GAS float*)(m_).src + (size_t)(4 * (lane >> 4)) * (m_).ldw + (lane & 15) * 4; \
        _Pragma("unroll") for (int j_ = 0; j_ < 4; ++j_) _Pragma("unroll") for (int r_ = 0; r_ < 4; ++r_) v_[4 * j_ + r_] = __builtin_nontemporal_load((const GAS f32x4*)(src_ + (size_t)(16 * j_ + r_) * (m_).ldw)); } while (0)
#define MOE_TOLDS(v_) do { LAS unsigned* s_ = scr + (4 * (lane & 15)) * 17 + (lane >> 4); \
        _Pragma("unroll") for (int j_ = 0; j_ < 4; ++j_) { \
            s_[0 * 17 + 4 * j_] = pk4_fp8(v_[4 * j_][0] * MOE_WSCALE, v_[4 * j_ + 1][0] * MOE_WSCALE, v_[4 * j_ + 2][0] * MOE_WSCALE, v_[4 * j_ + 3][0] * MOE_WSCALE); \
            s_[1 * 17 + 4 * j_] = pk4_fp8(v_[4 * j_][1] * MOE_WSCALE, v_[4 * j_ + 1][1] * MOE_WSCALE, v_[4 * j_ + 2][1] * MOE_WSCALE, v_[4 * j_ + 3][1] * MOE_WSCALE); \
            s_[2 * 17 + 4 * j_] = pk4_fp8(v_[4 * j_][2] * MOE_WSCALE, v_[4 * j_ + 1][2] * MOE_WSCALE, v_[4 * j_ + 2][2] * MOE_WSCALE, v_[4 * j_ + 3][2] * MOE_WSCALE); \
            s_[3 * 17 + 4 * j_] = pk4_fp8(v_[4 * j_][3] * MOE_WSCALE, v_[4 * j_ + 1][3] * MOE_WSCALE, v_[4 * j_ + 2][3] * MOE_WSCALE, v_[4 * j_ + 3][3] * MOE_WSCALE); } } while (0)
#define MOE_EMIT(m_) do { LDS_WAIT(); asm volatile("" ::: "memory"); \
        _Pragma("unroll") for (int jj_ = 0; jj_ < 4; ++jj_) { const int n_ = (lane >> 2) + 16 * jj_; const LAS unsigned* s_ = scr + n_ * 17 + 4 * (lane & 3); \
            v4u o_; o_.x = s_[0]; o_.y = s_[1]; o_.z = s_[2]; o_.w = s_[3]; \
            __builtin_nontemporal_store(o_, (GAS v4u*)((m_).dst + (size_t)((m_).r0 + n_) * 2048 + (m_).k0 + 16 * (lane & 3))); } \
        LDS_WAIT(); asm volatile("" ::: "memory"); } while (0)
template <int MODE>
__device__ __forceinline__ void moe_convert_share(Frame& F, const float* const* in) {
    LAS unsigned* scr = (LAS unsigned*)(F.lds + RING_OFF + F.wave * 4608);
    constexpr int NIT = NE * 32 * 64 + NE * 32 * 32;
    const int per = (NIT + F.G - 1) / F.G, lo = F.vcu * per, hi = (lo + per < NIT) ? lo + per : NIT, lane = F.lane;
    int it = lo + F.wave;
    f32x4 va[16], vb[16];
    MoeItem ma = moe_item(F, in, it < hi ? it : lo), mb = moe_item(F, in, it + NWAVES < hi ? it + NWAVES : lo);
    if (it < hi) MOE_LOADS(va, ma);
    if (it + NWAVES < hi) MOE_LOADS(vb, mb);
    for (; it < hi; it += 2 * NWAVES) {
        if (MODE == 0) MOE_TOLDS(va); else { _Pragma("unroll") for (int i_ = 0; i_ < 16; ++i_) asm volatile("" :: "v"(va[i_])); }
        const MoeItem na = moe_item(F, in, it + 2 * NWAVES < hi ? it + 2 * NWAVES : lo);
        if (it + 2 * NWAVES < hi) MOE_LOADS(va, na);
        if (MODE == 0) MOE_EMIT(ma);
        if (it + NWAVES < hi) {
            if (MODE == 0) MOE_TOLDS(vb); else { _Pragma("unroll") for (int i_ = 0; i_ < 16; ++i_) asm volatile("" :: "v"(vb[i_])); }
            const MoeItem nb = moe_item(F, in, it + 3 * NWAVES < hi ? it + 3 * NWAVES : lo);
            if (it + 3 * NWAVES < hi) MOE_LOADS(vb, nb);
            if (MODE == 0) MOE_EMIT(mb);
            mb = nb;
        }
        ma = na;
    }
    __syncthreads();
}
#define MOE_LOADS_ASM(v_, m_) do { const GAS float* src_ = (const GAS float*)(m_).src + (size_t)(4 * (lane >> 4)) * (m_).ldw + (lane & 15) * 4; \
        _Pragma("unroll") for (int j_ = 0; j_ < 4; ++j_) _Pragma("unroll") for (int r_ = 0; r_ < 4; ++r_) { const GAS float* p_ = src_ + (size_t)(16 * j_ + r_) * (m_).ldw; \
            asm volatile("global_load_dwordx4 %0, %1, off nt" : "=v"(v_[4 * j_ + r_]) : "v"(p_) : "memory"); } } while (0)
#define MOE_WAIT_ASM(v_, n_) asm volatile("s_waitcnt vmcnt(" #n_ ")" : "+v"(v_[0]), "+v"(v_[1]), "+v"(v_[2]), "+v"(v_[3]), "+v"(v_[4]), "+v"(v_[5]), "+v"(v_[6]), "+v"(v_[7]), \
        "+v"(v_[8]), "+v"(v_[9]), "+v"(v_[10]), "+v"(v_[11]), "+v"(v_[12]), "+v"(v_[13]), "+v"(v_[14]), "+v"(v_[15]) :: "memory")
__device__ __forceinline__ MoeItem moe_super(Frame& F, const float* const* in, int s) {
    constexpr int S10 = NE * 16 * 64;
    MoeItem m;
    if (s < S10) { const int e = s / 1024, q = s % 1024, kb = q / 64, cb = q % 64;
        m.r0 = cb < 32 ? 256 * (cb >> 1) + 64 * (cb & 1) : 256 * ((cb - 32) >> 1) + 128 + 64 * (cb & 1);
        m.src = in[29] + (size_t)e * 2048 * 4096 + (size_t)(128 * kb) * 4096 + 64 * cb; m.ldw = 4096; m.dst = WSP(unsigned char, WS_WGUT) + (size_t)e * 4096 * 2048; m.k0 = 128 * kb; }
    else { const int r = s - S10, e = r / 512, q = r % 512, kb = q / 32, cb = q % 32;
        m.r0 = 64 * cb; m.src = in[31] + (size_t)e * 2048 * 2048 + (size_t)(128 * kb) * 2048 + 64 * cb; m.ldw = 2048; m.dst = WSP(unsigned char, WS_WDT) + (size_t)e * 2048 * 2048; m.k0 = 128 * kb; }
    return m;
}
#define MOE_TOLDS33(v_, h_) do { LAS unsigned* s_ = scr + (4 * (lane & 15)) * 33 + (lane >> 4) + 16 * (h_); \
        _Pragma("unroll") for (int j_ = 0; j_ < 4; ++j_) { \
            s_[0 * 33 + 4 * j_] = pk4_fp8(v_[4 * j_][0] * MOE_WSCALE, v_[4 * j_ + 1][0] * MOE_WSCALE, v_[4 * j_ + 2][0] * MOE_WSCALE, v_[4 * j_ + 3][0] * MOE_WSCALE); \
            s_[1 * 33 + 4 * j_] = pk4_fp8(v_[4 * j_][1] * MOE_WSCALE, v_[4 * j_ + 1][1] * MOE_WSCALE, v_[4 * j_ + 2][1] * MOE_WSCALE, v_[4 * j_ + 3][1] * MOE_WSCALE); \
            s_[2 * 33 + 4 * j_] = pk4_fp8(v_[4 * j_][2] * MOE_WSCALE, v_[4 * j_ + 1][2] * MOE_WSCALE, v_[4 * j_ + 2][2] * MOE_WSCALE, v_[4 * j_ + 3][2] * MOE_WSCALE); \
            s_[3 * 33 + 4 * j_] = pk4_fp8(v_[4 * j_][3] * MOE_WSCALE, v_[4 * j_ + 1][3] * MOE_WSCALE, v_[4 * j_ + 2][3] * MOE_WSCALE, v_[4 * j_ + 3][3] * MOE_WSCALE); } } while (0)
#define MOE_EMIT33(m_) do { LDS_WAIT(); asm volatile("" ::: "memory"); \
        _Pragma("unroll") for (int jj_ = 0; jj_ < 8; ++jj_) { const int n_ = (lane >> 3) + 8 * jj_; const LAS unsigned* s_ = scr + n_ * 33 + 4 * (lane & 7); \
            v4u o_; o_.x = s_[0]; o_.y = s_[1]; o_.z = s_[2]; o_.w = s_[3]; \
            __builtin_nontemporal_store(o_, (GAS v4u*)((m_).dst + (size_t)((m_).r0 + n_) * 2048 + (m_).k0 + 16 * (lane & 7))); } \
        LDS_WAIT(); asm volatile("" ::: "memory"); } while (0)
template <int NW>
__device__ __forceinline__ void moe_convert_share_w(Frame& F, const float* const* in, const int cw, LAS unsigned* scr, const int lane) {
    constexpr int NSUP = NE * 16 * 64 + NE * 16 * 32, PER = NSUP / 256;
    static_assert(PER % NW == 0, "equal shares");
    const int lo = F.vcu * PER, hi = lo + PER;
    int it = lo + cw;
    f32x4 va[16], vb[16];
    MoeItem m = moe_super(F, in, it), mh = m;
    mh.src += (size_t)64 * m.ldw;
    MOE_LOADS_ASM(va, m);
    MOE_LOADS_ASM(vb, mh);
    bool first = true;
    for (; it < hi; it += NW) {
        MoeItem n = moe_super(F, in, it + NW < hi ? it + NW : lo), nh = n;
        nh.src += (size_t)64 * n.ldw;
        MOE_WAIT_ASM(va, 16);
        MOE_TOLDS33(va, 0);
        MOE_LOADS_ASM(va, n);
        MOE_WAIT_ASM(vb, 16);
        MOE_TOLDS33(vb, 1);
        MOE_LOADS_ASM(vb, nh);
        MOE_EMIT33(m);
        m = n; first = false;
    }
    MOE_WAIT_ASM(va, 0); MOE_WAIT_ASM(vb, 0);
}
#undef MOE_TOLDS33
#undef MOE_EMIT33
__device__ __forceinline__ MoeItem moe_super256(Frame& F, const float* const* in, int s) {
    constexpr int S10 = NE * 8 * 64;
    MoeItem m;
    if (s < S10) { const int e = s / 512, q = s % 512, kb = q / 64, cb = q % 64;
        m.r0 = cb < 32 ? 256 * (cb >> 1) + 64 * (cb & 1) : 256 * ((cb - 32) >> 1) + 128 + 64 * (cb & 1);
        m.src = in[29] + (size_t)e * 2048 * 4096 + (size_t)(256 * kb) * 4096 + 64 * cb; m.ldw = 4096; m.dst = WSP(unsigned char, WS_WGUT) + (size_t)e * 4096 * 2048; m.k0 = 256 * kb; }
    else { const int r = s - S10, e = r / 256, q = r % 256, kb = q / 32, cb = q % 32;
        m.r0 = 64 * cb; m.src = in[31] + (size_t)e * 2048 * 2048 + (size_t)(256 * kb) * 2048 + 64 * cb; m.ldw = 2048; m.dst = WSP(unsigned char, WS_WDT) + (size_t)e * 2048 * 2048; m.k0 = 256 * kb; }
    return m;
}
#define MOE_TOLDS65(v_, h_) do { LAS unsigned* s_ = scr + (4 * (lane & 15)) * 65 + (lane >> 4) + 16 * (h_); \
        _Pragma("unroll") for (int j_ = 0; j_ < 4; ++j_) { \
            s_[0 * 65 + 4 * j_] = pk4_fp8(v_[4 * j_][0] * MOE_WSCALE, v_[4 * j_ + 1][0] * MOE_WSCALE, v_[4 * j_ + 2][0] * MOE_WSCALE, v_[4 * j_ + 3][0] * MOE_WSCALE); \
            s_[1 * 65 + 4 * j_] = pk4_fp8(v_[4 * j_][1] * MOE_WSCALE, v_[4 * j_ + 1][1] * MOE_WSCALE, v_[4 * j_ + 2][1] * MOE_WSCALE, v_[4 * j_ + 3][1] * MOE_WSCALE); \
            s_[2 * 65 + 4 * j_] = pk4_fp8(v_[4 * j_][2] * MOE_WSCALE, v_[4 * j_ + 1][2] * MOE_WSCALE, v_[4 * j_ + 2][2] * MOE_WSCALE, v_[4 * j_ + 3][2] * MOE_WSCALE); \
            s_[3 * 65 + 4 * j_] = pk4_fp8(v_[4 * j_][3] * MOE_WSCALE, v_[4 * j_ + 1][3] * MOE_WSCALE, v_[4 * j_ + 2][3] * MOE_WSCALE, v_[4 * j_ + 3][3] * MOE_WSCALE); } } while (0)
#define MOE_EMIT65(m_) do { LDS_WAIT(); asm volatile("" ::: "memory"); \
        _Pragma("unroll") for (int jj_ = 0; jj_ < 16; ++jj_) { const int n_ = (lane >> 4) + 4 * jj_; const LAS unsigned* s_ = scr + n_ * 65 + 4 * (lane & 15); \
            v4u o_; o_.x = s_[0]; o_.y = s_[1]; o_.z = s_[2]; o_.w = s_[3]; \
            __builtin_nontemporal_store(o_, (GAS v4u*)((m_).dst + (size_t)((m_).r0 + n_) * 2048 + (m_).k0 + 16 * (lane & 15))); } \
        LDS_WAIT(); asm volatile("" ::: "memory"); } while (0)
#define MOE_Q(m_, q_) MoeItem{(m_).src + (size_t)(64 * (q_)) * (m_).ldw, (m_).ldw, (m_).dst, (m_).r0, (m_).k0}
template <int NW>
__device__ __forceinline__ void moe_convert_range256(Frame& F, const float* const* in, const int cw, LAS unsigned* scr, const int lane, const int lo, const int hi) {
    int it = lo + cw;
    f32x4 va[16], vb[16];
    MoeItem m = moe_super256(F, in, it);
    { const MoeItem q0 = MOE_Q(m, 0), q1 = MOE_Q(m, 1); MOE_LOADS_ASM(va, q0); MOE_LOADS_ASM(vb, q1); }
    bool first = true;
    for (; it < hi; it += NW) {
        const MoeItem n = moe_super256(F, in, it + NW < hi ? it + NW : lo);
        const MoeItem q2 = MOE_Q(m, 2), q3 = MOE_Q(m, 3), n0 = MOE_Q(n, 0), n1 = MOE_Q(n, 1);
        MOE_WAIT_ASM(va, 16);
        MOE_TOLDS65(va, 0); MOE_LOADS_ASM(va, q2);
        MOE_WAIT_ASM(vb, 16);
        MOE_TOLDS65(vb, 1); MOE_LOADS_ASM(vb, q3);
        MOE_WAIT_ASM(va, 16);
        MOE_TOLDS65(va, 2); MOE_LOADS_ASM(va, n0);
        MOE_WAIT_ASM(vb, 16);
        MOE_TOLDS65(vb, 3); MOE_LOADS_ASM(vb, n1);
        MOE_EMIT65(m);
        if (CONV_SLEEP > 0) __builtin_amdgcn_s_sleep(CONV_SLEEP);
        m = n; first = false;
    }
    MOE_WAIT_ASM(va, 0); MOE_WAIT_ASM(vb, 0);
}
constexpr int CONV_NSUP = NE * 8 * 64 + NE * 8 * 32, CONV_OFF_CUS = (CONV_OFFLOAD == 2) ? 160 : 128, CONV_OFF = CONV_OFFLOAD ? 8 * CONV_OFF_CUS : 0, CONV_PER5 = (CONV_NSUP - CONV_OFF) / 256;
static_assert((CONV_NSUP - CONV_OFF) % 256 == 0, "equal shares per workgroup");
template <int NW>
__device__ __forceinline__ void moe_convert_share_w256(Frame& F, const float* const* in, const int cw, LAS unsigned* scr, const int lane) {
    moe_convert_range256<NW>(F, in, cw, scr, lane, F.vcu * CONV_PER5, F.vcu * CONV_PER5 + CONV_PER5);
}
#undef MOE_TOLDS65
#undef MOE_EMIT65
#undef MOE_Q
#undef MOE_LOADS_ASM
#undef MOE_WAIT_ASM
#undef MOE_LOADS
#undef MOE_TOLDS
#undef MOE_EMIT

__device__ __forceinline__ void moe_convert_share_dma(Frame& F, const float* const* in) {
    LAS unsigned char* wbase = F.lds + RING_OFF + F.wave * 16640;
    LAS unsigned* tile2 = (LAS unsigned*)(wbase + 12288);
    constexpr int NIT = NE * 32 * 64 + NE * 32 * 32;
    const int per = (NIT + F.G - 1) / F.G, lo = F.vcu * per, hi = (lo + per < NIT) ? lo + per : NIT, lane = F.lane;
    const int nitems = (hi - lo - F.wave + NWAVES - 1) / NWAVES;
    if (nitems > 0) {
        const int nchunks = nitems * 4;
        const int ng = lane & 15, kr = lane >> 4;
#define CDMA_ISSUE(c_) do { const MoeItem m_ = moe_item(F, in, lo + F.wave + NWAVES * ((c_) >> 2)); const int kc_ = (c_) & 3; \
            const GAS unsigned char* g_ = (const GAS unsigned char*)m_.src + ((size_t)(16 * kc_ + kr) * m_.ldw + (size_t)ng * 4) * 4; LAS unsigned char* l_ = wbase + ((c_) % 3) * 4096; \
            _Pragma("unroll") for (int q_ = 0; q_ < 4; ++q_) __builtin_amdgcn_global_load_lds((const GAS unsigned*)(g_ + (size_t)(4 * q_) * m_.ldw * 4), (LAS unsigned*)(l_ + q_ * 1024), 16, 0, 2); } while (0)
        CDMA_ISSUE(0);
        if (nchunks > 1) CDMA_ISSUE(1);
        for (int c = 0; c < nchunks; ++c) {
            if (c + 2 < nchunks) { CDMA_ISSUE(c + 2); asm volatile("s_waitcnt vmcnt(8)" ::: "memory"); }
            else if (c + 1 < nchunks) asm volatile("s_waitcnt vmcnt(4)" ::: "memory");
            else asm volatile("s_waitcnt vmcnt(0)" ::: "memory");
            const LAS unsigned char* cb = wbase + (c % 3) * 4096 + (4 * kr) * 256 + ng * 16;
            const f32x4 r0 = *(const LAS f32x4*)(cb), r1 = *(const LAS f32x4*)(cb + 256), r2 = *(const LAS f32x4*)(cb + 512), r3 = *(const LAS f32x4*)(cb + 768);
            LAS unsigned* t2 = tile2 + (4 * ng) * 17 + 4 * (c & 3) + kr;
            t2[0 * 17] = pk4_fp8(r0[0] * MOE_WSCALE, r1[0] * MOE_WSCALE, r2[0] * MOE_WSCALE, r3[0] * MOE_WSCALE);
            t2[1 * 17] = pk4_fp8(r0[1] * MOE_WSCALE, r1[1] * MOE_WSCALE, r2[1] * MOE_WSCALE, r3[1] * MOE_WSCALE);
            t2[2 * 17] = pk4_fp8(r0[2] * MOE_WSCALE, r1[2] * MOE_WSCALE, r2[2] * MOE_WSCALE, r3[2] * MOE_WSCALE);
            t2[3 * 17] = pk4_fp8(r0[3] * MOE_WSCALE, r1[3] * MOE_WSCALE, r2[3] * MOE_WSCALE, r3[3] * MOE_WSCALE);
            LDS_WAIT(); asm volatile("" ::: "memory");
            if ((c & 3) == 3) {
                const MoeItem m = moe_item(F, in, lo + F.wave + NWAVES * (c >> 2));
#pragma unroll
                for (int jj = 0; jj < 4; ++jj) { const int n = (lane >> 2) + 16 * jj; const LAS unsigned* s = tile2 + n * 17 + 4 * (lane & 3);
                    v4u o; o.x = s[0]; o.y = s[1]; o.z = s[2]; o.w = s[3];
                    __builtin_nontemporal_store(o, (GAS v4u*)(m.dst + (size_t)(m.r0 + n) * 2048 + m.k0 + 16 * (lane & 3))); }
                LDS_WAIT(); asm volatile("" ::: "memory");
            }
        }
#undef CDMA_ISSUE
    }
    asm volatile("s_waitcnt vmcnt(0)" ::: "memory");
    __syncthreads();
}

struct MoeItem256 { const float* src; size_t ldw; unsigned char* dst; int rowbase; int rowmode; int k0; };
__device__ __forceinline__ MoeItem256 moe_item256(Frame& F, const float* const* in, int it) {
    constexpr int I10 = NE * 32 * 64;
    MoeItem256 m;
    if (it < I10) { const int e = it / 2048, q = it % 2048, kb = q / 16, cb = q % 16; const bool gate = cb < 8; const int grp0 = gate ? 2 * cb : 2 * (cb - 8);
        m.src = in[29] + (size_t)e * 2048 * 4096 + (size_t)(16 * kb) * 4096 + 256 * cb; m.ldw = 4096; m.dst = WSP(unsigned char, WS_WGUT) + (size_t)e * 4096 * 2048;
        m.rowbase = 256 * grp0 + (gate ? 0 : 128); m.rowmode = 1; m.k0 = 16 * kb; }
    else { const int r = it - I10, e = r / 1024, q = r % 1024, kb = q / 8, cb = q % 8;
        m.src = in[31] + (size_t)e * 2048 * 2048 + (size_t)(16 * kb) * 2048 + 256 * cb; m.ldw = 2048; m.dst = WSP(unsigned char, WS_WDT) + (size_t)e * 2048 * 2048;
        m.rowbase = 256 * cb; m.rowmode = 0; m.k0 = 16 * kb; }
    return m;
}
__device__ __forceinline__ void moe_convert_share_dma256(Frame& F, const float* const* in) {
    LAS unsigned char* wbase = F.lds + RING_OFF + F.wave * 16640;
    LAS unsigned* tile2 = (LAS unsigned*)(wbase + 12288);
    constexpr int NIT = NE * 32 * 64 + NE * 32 * 32;
    const int per = (NIT + F.G - 1) / F.G, lo = F.vcu * per, hi = (lo + per < NIT) ? lo + per : NIT, lane = F.lane;
    const int nitems = (hi - lo - F.wave + NWAVES - 1) / NWAVES;
    if (nitems > 0) {
        const int nchunks = nitems * 4;
#define C256_ISSUE(c_) do { const MoeItem256 m_ = moe_item256(F, in, lo + F.wave + NWAVES * ((c_) >> 2)); const int kc_ = (c_) & 3; \
            const GAS unsigned char* g_ = (const GAS unsigned char*)m_.src + ((size_t)(4 * kc_) * m_.ldw + (size_t)lane * 4) * 4; LAS unsigned char* l_ = wbase + ((c_) % 3) * 4096; \
            _Pragma("unroll") for (int r_ = 0; r_ < 4; ++r_) __builtin_amdgcn_global_load_lds((const GAS unsigned*)(g_ + (size_t)r_ * m_.ldw * 4), (LAS unsigned*)(l_ + r_ * 1024), 16, 0, 2); } while (0)
        C256_ISSUE(0);
        if (nchunks > 1) C256_ISSUE(1);
        for (int c = 0; c < nchunks; ++c) {
            if (c + 2 < nchunks) { C256_ISSUE(c + 2); asm volatile("s_waitcnt vmcnt(8)" ::: "memory"); }
            else if (c + 1 < nchunks) asm volatile("s_waitcnt vmcnt(4)" ::: "memory");
            else asm volatile("s_waitcnt vmcnt(0)" ::: "memory");
            const LAS float* cb = (const LAS float*)(wbase + (c % 3) * 4096) + lane;
            LAS unsigned* t2 = tile2 + (c & 3) * 256 + lane;
#pragma unroll
            for (int cc = 0; cc < 4; ++cc) t2[64 * cc] = pk4_fp8(cb[64 * cc] * MOE_WSCALE, cb[256 + 64 * cc] * MOE_WSCALE, cb[512 + 64 * cc] * MOE_WSCALE, cb[768 + 64 * cc] * MOE_WSCALE);
            LDS_WAIT(); asm volatile("" ::: "memory");
            if ((c & 3) == 3) {
                const MoeItem256 m = moe_item256(F, in, lo + F.wave + NWAVES * (c >> 2));
#pragma unroll
                for (int cc = 0; cc < 4; ++cc) { const LAS unsigned* s = tile2 + lane + 64 * cc;
                    v4u o; o.x = s[0]; o.y = s[256]; o.z = s[512]; o.w = s[768];
                    const int row = m.rowbase + (m.rowmode ? 256 * (cc >> 1) + lane + 64 * (cc & 1) : lane + 64 * cc);
                    __builtin_nontemporal_store(o, (GAS v4u*)(m.dst + (size_t)row * 2048 + m.k0)); }
                LDS_WAIT(); asm volatile("" ::: "memory");
            }
        }
#undef C256_ISSUE
    }
    asm volatile("s_waitcnt vmcnt(0)" ::: "memory");
    __syncthreads();
}

struct ConvState { int lo, nchunks, c, cw; };
template <int NCW>
__device__ __forceinline__ void conv_steps(Frame& F, const float* const* in, ConvState& S, LAS unsigned char* wbase, int nsteps, int lane) {
    LAS unsigned* tile2 = (LAS unsigned*)(wbase + 12288);
    const int ng = lane & 15, kr = lane >> 4;
#define CS_ISSUE(c_) do { const MoeItem m_ = moe_item(F, in, S.lo + S.cw + NCW * ((c_) >> 2)); const int kc_ = (c_) & 3; \
        const GAS unsigned char* g_ = (const GAS unsigned char*)m_.src + ((size_t)(16 * kc_ + kr) * m_.ldw + (size_t)ng * 4) * 4; LAS unsigned char* l_ = wbase + ((c_) % 3) * 4096; \
        _Pragma("unroll") for (int q_ = 0; q_ < 4; ++q_) __builtin_amdgcn_global_load_lds((const GAS unsigned*)(g_ + (size_t)(4 * q_) * m_.ldw * 4), (LAS unsigned*)(l_ + q_ * 1024), 16, 0, 2); } while (0)
    if (S.c < 0) { S.c = 0; if (S.nchunks > 0) CS_ISSUE(0); if (S.nchunks > 1) CS_ISSUE(1); }
    for (int st = 0; st < nsteps && S.c < S.nchunks; ++st) {
        const int c = S.c;
        if (c + 2 < S.nchunks) { CS_ISSUE(c + 2); asm volatile("s_waitcnt vmcnt(8)" ::: "memory"); }
        else if (c + 1 < S.nchunks) asm volatile("s_waitcnt vmcnt(4)" ::: "memory");
        else asm volatile("s_waitcnt vmcnt(0)" ::: "memory");
        const LAS unsigned char* cb = wbase + (c % 3) * 4096 + (4 * kr) * 256 + ng * 16;
        const f32x4 r0 = *(const LAS f32x4*)(cb), r1 = *(const LAS f32x4*)(cb + 256), r2 = *(const LAS f32x4*)(cb + 512), r3 = *(const LAS f32x4*)(cb + 768);
        LAS unsigned* t2 = tile2 + (4 * ng) * 17 + 4 * (c & 3) + kr;
        t2[0 * 17] = pk4_fp8(r0[0] * MOE_WSCALE, r1[0] * MOE_WSCALE, r2[0] * MOE_WSCALE, r3[0] * MOE_WSCALE);
        t2[1 * 17] = pk4_fp8(r0[1] * MOE_WSCALE, r1[1] * MOE_WSCALE, r2[1] * MOE_WSCALE, r3[1] * MOE_WSCALE);
        t2[2 * 17] = pk4_fp8(r0[2] * MOE_WSCALE, r1[2] * MOE_WSCALE, r2[2] * MOE_WSCALE, r3[2] * MOE_WSCALE);
        t2[3 * 17] = pk4_fp8(r0[3] * MOE_WSCALE, r1[3] * MOE_WSCALE, r2[3] * MOE_WSCALE, r3[3] * MOE_WSCALE);
        LDS_WAIT(); asm volatile("" ::: "memory");
        if ((c & 3) == 3) {
            const MoeItem m = moe_item(F, in, S.lo + S.cw + NCW * (c >> 2));
#pragma unroll
            for (int jj = 0; jj < 4; ++jj) { const int n = (lane >> 2) + 16 * jj; const LAS unsigned* s = tile2 + n * 17 + 4 * (lane & 3);
                v4u o; o.x = s[0]; o.y = s[1]; o.z = s[2]; o.w = s[3];
                __builtin_nontemporal_store(o, (GAS v4u*)(m.dst + (size_t)(m.r0 + n) * 2048 + m.k0 + 16 * (lane & 3))); }
            LDS_WAIT(); asm volatile("" ::: "memory");
        }
        S.c = c + 1;
    }
#undef CS_ISSUE
}

__device__ __forceinline__ float group16_sum(float v) { if (XL_FAST) return xl_sum16(v); v += __shfl_xor(v, 1); v += __shfl_xor(v, 2); v += __shfl_xor(v, 4); v += __shfl_xor(v, 8); return v; }
__device__ __forceinline__ void p2_token(Frame& F, const float* const* in, int t) {
    const int l = F.lane;
    const GAS bf16* row = (const GAS bf16*)WSP(bf16, WS_P1) + (size_t)t * P1N;
    { float a[8], b[8]; unpack8(*(const GAS v4u*)(row + P1_V + 16 * l), a); unpack8(*(const GAS v4u*)(row + P1_V + 16 * l + 8), b);
      float s = 0.f;
#pragma unroll
      for (int i = 0; i < 8; ++i) s += a[i] + b[i];
      const float mean = wave_sum(s) * (1.f / 1024.f); float q = 0.f;
#pragma unroll
      for (int i = 0; i < 8; ++i) { const float d0 = a[i] - mean, d1 = b[i] - mean; q += d0 * d0 + d1 * d1; }
      const float rstd = 1.0f / sqrtf(wave_sum(q) * (1.f / 1024.f) + EPS);
      if (l == 0) { GAS float* vs = (GAS float*)WSP(float, WS_VSTAT) + (size_t)t * 2; vs[0] = mean; vs[1] = rstd; } }
#pragma unroll
    for (int w = 0; w < 2; ++w) {
        float a[8]; unpack8(*(const GAS v4u*)(row + (w ? P1_CKV : P1_CQ) + 8 * l), a);
        float s = 0.f;
#pragma unroll
        for (int i = 0; i < 8; ++i) s += a[i] * a[i];
        const float rs = 1.0f / sqrtf(wave_sum(s) * (1.f / 512.f) + EPS);
        const GAS float* g = (const GAS float*)(w ? in[14] : in[12]) + 8 * l;
        const f32x4 g0 = *(const GAS f32x4*)g, g1 = *(const GAS f32x4*)(g + 4);
        float o[8] = {a[0] * rs * g0.x, a[1] * rs * g0.y, a[2] * rs * g0.z, a[3] * rs * g0.w, a[4] * rs * g1.x, a[5] * rs * g1.y, a[6] * rs * g1.z, a[7] * rs * g1.w};
        u32x2 w8; w8.x = pk4_fp8(o[0], o[1], o[2], o[3]); w8.y = pk4_fp8(o[4], o[5], o[6], o[7]);
        *(GAS u32x2*)((GAS unsigned char*)WSP(unsigned char, w ? WS_CKVN : WS_CQN) + (size_t)t * 512 + 8 * l) = w8;
    }
    { float a[8], b[8]; unpack8(*(const GAS v4u*)(row + P1_QM + 16 * l), a); unpack8(*(const GAS v4u*)(row + P1_QM + 16 * l + 8), b);
      float s = 0.f;
#pragma unroll
      for (int i = 0; i < 8; ++i) s += a[i] * a[i] + b[i] * b[i];
      const float rs = MEM_QSCALE / sqrtf(group16_sum(s) * (1.f / 256.f) + EPS);
      const GAS float* g = (const GAS float*)in[22] + (l & 15) * 16;
      float ga[8], gb[8];
#pragma unroll
      for (int i = 0; i < 8; ++i) { ga[i] = g[i]; gb[i] = g[8 + i]; }
#pragma unroll
      for (int i = 0; i < 8; ++i) { a[i] *= rs * ga[i]; b[i] *= rs * gb[i]; }
      const int bb = t >> 12, tl = t & 4095, h = l >> 4;
      GAS bf16* dst = (GAS bf16*)WSP(bf16, WS_QMN) + ((size_t)((bb * 4 + h) * 4096 + tl)) * 256 + (l & 15) * 16;
      *(GAS v4u*)dst = packf8(a); *(GAS v4u*)(dst + 8) = packf8(b); }
    { float t1 = 0.f, t2 = 0.f;
      if (l < 32) { t1 = bflo((unsigned)row[P1_KR + l]); t2 = bflo((unsigned)row[P1_KR + 32 + l]); }
      const float ss = wave_sum(t1 * t1 + t2 * t2);
      if (l < 32) {
          const float pos = (float)((const GAS int*)in[2])[t];
          const float inv = 1.0f / powf(10000.0f, (float)(2 * l) / 64.0f);
          const float ang = pos * inv, c = cosf(ang), s = sinf(ang);
          GAS float* rp = (GAS float*)WSP(float, WS_ROPE) + (size_t)t * 64; rp[l] = c; rp[32 + l] = s;
          const GAS float* kg = (const GAS float*)in[17];
          const float a = t1 * kg[128 + l], b = t2 * kg[160 + l];
          GAS float* kr = (GAS float*)WSP(float, WS_KRR) + (size_t)t * 64; kr[l] = a * c - b * s; kr[32 + l] = a * s + b * c;
          if (l == 0) ((GAS float*)WSP(float, WS_KRSS))[t] = ss;
      } }
}
__device__ __forceinline__ void p2_memrow(Frame& F, const float* const* in, int m) {
    const int l = F.lane, bb = m >> 8, ml = m & 255, tile = ml >> 6, key = ml & 63, h = l >> 4, d0 = (l & 15) * 16;
    const GAS bf16* row = (const GAS bf16*)WSP(bf16, WS_MKV) + (size_t)m * 2048;
    { float a[8], b[8]; unpack8(*(const GAS v4u*)(row + 16 * l), a); unpack8(*(const GAS v4u*)(row + 16 * l + 8), b);
      float s = 0.f;
#pragma unroll
      for (int i = 0; i < 8; ++i) s += a[i] * a[i] + b[i] * b[i];
      const float rs = 1.0f / sqrtf(group16_sum(s) * (1.f / 256.f) + EPS);
      const GAS float* g = (const GAS float*)in[23] + d0;
#pragma unroll
      for (int i = 0; i < 8; ++i) { a[i] *= rs * g[i]; b[i] *= rs * g[8 + i]; }
      GAS bf16* base = (GAS bf16*)WSP(bf16, WS_MKT) + (size_t)((bb * 4 + h) * 4 + tile) * (32 * 64 * 8);
      const int c0 = d0 >> 3;
      *(GAS v4u*)(base + ((size_t)c0 * 64 + key) * 8) = packf8(a); *(GAS v4u*)(base + ((size_t)(c0 + 1) * 64 + key) * 8) = packf8(b); }
    { const v4u a = *(const GAS v4u*)(row + 1024 + 16 * l), b = *(const GAS v4u*)(row + 1024 + 16 * l + 8);
      const int half = d0 >> 7, cb = (d0 & 127) >> 5, off = d0 & 31;
      GAS bf16* base = (GAS bf16*)WSP(bf16, WS_MVT) + (size_t)(((bb * 4 + h) * 2 + half) * 4 + tile) * (4 * 64 * 32);
      GAS bf16* dst = base + ((size_t)cb * 64 + key) * 32 + off;
      *(GAS v4u*)dst = a; *(GAS v4u*)(dst + 8) = b; }
}

__device__ __forceinline__ void gmlp_unit(Frame& F, const float* const* in, int u) {
    const int ci = u >> 3, g = u & 7, tok0 = ci * 128, tid = F.tid, l = F.lane, r32 = l & 31, hi = l >> 5;
    LAS bf16* VT = (LAS bf16*)(F.lds + RING_OFF);
    const GAS bf16* P1 = (const GAS bf16*)WSP(bf16, WS_P1);
    { const int s = tid >> 2, qd = tid & 3;
      const GAS float* vs = (const GAS float*)WSP(float, WS_VSTAT) + (size_t)(tok0 + s) * 2; const float mean = vs[0], rstd = vs[1];
      const GAS bf16* src = P1 + (size_t)(tok0 + s) * P1N + P1_V + g * 128 + qd * 32;
      const GAS float* lg = (const GAS float*)in[7] + g * 128 + qd * 32; const GAS float* lb = (const GAS float*)in[8] + g * 128 + qd * 32;
#pragma unroll
      for (int i = 0; i < 4; ++i) { float a[8]; unpack8(*(const GAS v4u*)(src + 8 * i), a);
#pragma unroll
          for (int k = 0; k < 8; ++k) { const int c = qd * 32 + 8 * i + k; const float v = (a[k] - mean) * rstd * lg[8 * i + k] + lb[8 * i + k]; VT[c * 136 + s] = (bf16)(cvtpk(v, 0.f) & 0xffffu); } } }
    __syncthreads();
    const int w = F.wave, tb = w >> 1, cbp = (w & 1) * 2;
    f32x16 acc[2];
#pragma unroll
    for (int r = 0; r < 16; ++r) { acc[0][r] = 0.f; acc[1][r] = 0.f; }
    const GAS bf16* wsm = (const GAS bf16*)WSP(bf16, WS_WSM) + ((size_t)(g * 128 + 32 * tb + r32)) * 128 + 8 * hi;
    for (int ks = 0; ks < 2 * (tb + 1); ++ks) {
        const bf16x8 af = *(const GAS bf16x8*)(wsm + 16 * ks);
#pragma unroll
        for (int cc = 0; cc < 2; ++cc) { const bf16x8 bfr = *(const LAS bf16x8*)(VT + (32 * (cbp + cc) + r32) * 136 + 16 * ks + 8 * hi);
            acc[cc] = __builtin_amdgcn_mfma_f32_32x32x16_bf16(af, bfr, acc[cc], 0, 0, 0); }
    }
    const GAS float* bs = (const GAS float*)in[10] + g * 128;
    GAS bf16* AO = (GAS bf16*)WSP(bf16, WS_ABC);
#pragma unroll
    for (int cc = 0; cc < 2; ++cc)
#pragma unroll
        for (int r = 0; r < 16; ++r) { const int t = 32 * tb + crow(r, hi), tok = tok0 + t, ch = g * 128 + 32 * (cbp + cc) + r32;
            const float uu = bflo((unsigned)P1[(size_t)tok * P1N + P1_U + ch]);
            AO[(size_t)tok * ABC_LD + ch] = (bf16)(cvtpk(uu * (acc[cc][r] + bs[t]), 0.f) & 0xffffu); }
    __syncthreads();
}

__device__ __forceinline__ void p4_token(Frame& F, const float* const* in, int t) {
    const int l = F.lane, bb = t >> 12, tl = t & 4095, tile = tl >> 6, key = tl & 63, h = l >> 2, sub = l & 3;
    const GAS float* rope = (const GAS float*)WSP(float, WS_ROPE) + (size_t)t * 64;
    { const GAS bf16* qr = (const GAS bf16*)WSP(bf16, WS_QRAW) + (size_t)t * 3072 + h * 192;
      float x[4][8], y[2][8];
#pragma unroll
      for (int i = 0; i < 4; ++i) unpack8(*(const GAS v4u*)(qr + sub * 32 + 8 * i), x[i]);
#pragma unroll
      for (int i = 0; i < 2; ++i) unpack8(*(const GAS v4u*)(qr + 128 + sub * 16 + 8 * i), y[i]);
      float s = 0.f;
#pragma unroll
      for (int i = 0; i < 4; ++i)
#pragma unroll
          for (int k = 0; k < 8; ++k) s += x[i][k] * x[i][k];
#pragma unroll
      for (int i = 0; i < 2; ++i)
#pragma unroll
          for (int k = 0; k < 8; ++k) s += y[i][k] * y[i][k];
      s += __shfl_xor(s, 1); s += __shfl_xor(s, 2);
      const float rs = 1.0f / sqrtf(s * (1.f / 192.f) + EPS);
      const GAS float* qg = (const GAS float*)in[16];
      GAS bf16* dst = (GAS bf16*)WSP(bf16, WS_QF) + ((size_t)((bb * 16 + h) * 4096 + tl)) * 192;
#pragma unroll
      for (int i = 0; i < 4; ++i) {
#pragma unroll
          for (int k = 0; k < 8; ++k) x[i][k] *= rs * qg[sub * 32 + 8 * i + k] * MLA_QSCALE;
          *(GAS v4u*)(dst + sub * 32 + 8 * i) = packf8(x[i]); }
#pragma unroll
      for (int i = 0; i < 2; ++i) { float o[8];
#pragma unroll
          for (int k = 0; k < 8; ++k) { const float mine = y[i][k] * rs * qg[128 + sub * 16 + 8 * i + k]; const float other = __shfl_xor(mine, 2);
              const int j = (sub & 1) * 16 + 8 * i + k; const float c = rope[j], sn = rope[32 + j];
              o[k] = (sub < 2 ? mine * c - other * sn : other * sn + mine * c) * MLA_QSCALE; }
          *(GAS v4u*)(dst + 128 + sub * 16 + 8 * i) = packf8(o); } }
    { const GAS bf16* kr = (const GAS bf16*)WSP(bf16, WS_KVRAW) + (size_t)t * 4096 + h * 256;
      float x[4][8];
#pragma unroll
      for (int i = 0; i < 4; ++i) unpack8(*(const GAS v4u*)(kr + sub * 32 + 8 * i), x[i]);
      float s = 0.f;
#pragma unroll
      for (int i = 0; i < 4; ++i)
#pragma unroll
          for (int k = 0; k < 8; ++k) s += x[i][k] * x[i][k];
      s += __shfl_xor(s, 1); s += __shfl_xor(s, 2);
      s += ((const GAS float*)WSP(float, WS_KRSS))[t];
      const float rs = 1.0f / sqrtf(s * (1.f / 192.f) + EPS);
      const GAS float* kg = (const GAS float*)in[17];
      GAS bf16* kbase = (GAS bf16*)WSP(bf16, WS_KFT) + (size_t)((bb * 16 + h) * 64 + tile) * (24 * 64 * 8);
#pragma unroll
      for (int i = 0; i < 4; ++i) {
#pragma unroll
          for (int k = 0; k < 8; ++k) x[i][k] *= rs * kg[sub * 32 + 8 * i + k];
          *(GAS v4u*)(kbase + ((size_t)(sub * 4 + i) * 64 + key) * 8) = packf8(x[i]); }
      const GAS float* krr = (const GAS float*)WSP(float, WS_KRR) + (size_t)t * 64 + sub * 16;
#pragma unroll
      for (int i = 0; i < 2; ++i) { float o[8];
#pragma unroll
          for (int k = 0; k < 8; ++k) o[k] = krr[8 * i + k] * rs;
          *(GAS v4u*)(kbase + ((size_t)(16 + 2 * sub + i) * 64 + key) * 8) = packf8(o); }
      GAS bf16* vdst = (GAS bf16*)WSP(bf16, WS_VFT) + (size_t)((bb * 16 + h) * 64 + tile) * (4 * 64 * 32) + ((size_t)sub * 64 + key) * 32;
#pragma unroll
      for (int i = 0; i < 4; ++i) *(GAS v4u*)(vdst + 8 * i) = *(const GAS v4u*)(kr + 128 + sub * 32 + 8 * i); }
}
__device__ __forceinline__ void p8_router(Frame& F, const float* const* in) {
    const int tid = F.tid, l = F.lane, r32 = l & 31, hi = l >> 5, w = F.wave, tk = w >> 2, kq = w & 3;
    LAS float* part = (LAS float*)(F.lds + RING_OFF);
    LAS float* ssp = part + 2 * 4 * 32 * 33;
    LAS int* lcnt = (LAS int*)(F.lds + LTAB_OFF) + 40;
    LAS int* gbase = lcnt + 32;
    const int tok0 = (blockIdx.x * 2 + tk) * 32;
    if (tid < 32) lcnt[tid] = 0;
#if ROUTER_BF16X2
    {   const GAS bf16* xr = (const GAS bf16*)WSP(bf16, WS_X1) + (size_t)(tok0 + r32) * 2048 + 8 * hi;
        const GAS bf16* wh = (const GAS bf16*)WSP(bf16, WS_RWG) + (size_t)r32 * 2048 + 8 * hi;
        f32x16 acc;
#pragma unroll
        for (int r = 0; r < 16; ++r) acc[r] = 0.f;
        float ss = 0.f;
#pragma unroll 4
        for (int it = 32 * kq; it < 32 * kq + 32; ++it) {
            const v4u aw = *(const GAS v4u*)(xr + 16 * it);
            const bf16x8 a = __builtin_bit_cast(bf16x8, aw);
            const bf16x8 bh = *(const GAS bf16x8*)(wh + 16 * it), bl = *(const GAS bf16x8*)(wh + 32 * 2048 + 16 * it);
            acc = __builtin_amdgcn_mfma_f32_32x32x16_bf16(a, bh, acc, 0, 0, 0);
            acc = __builtin_amdgcn_mfma_f32_32x32x16_bf16(a, bl, acc, 0, 0, 0);
            float fa[8]; unpack8(aw, fa);
            ss += ((fa[0] * fa[0] + fa[1] * fa[1]) + (fa[2] * fa[2] + fa[3] * fa[3])) + ((fa[4] * fa[4] + fa[5] * fa[5]) + (fa[6] * fa[6] + fa[7] * fa[7]));
        }
#else
    {   const GAS bf16* xr = (const GAS bf16*)WSP(bf16, WS_X1) + (size_t)(tok0 + r32) * 2048 + 4 * hi;
        const GAS float* rw = (const GAS float*)WSP(float, WS_RWG) + (size_t)(4 * hi) * 32 + r32;
        f32x16 acc;
#pragma unroll
        for (int r = 0; r < 16; ++r) acc[r] = 0.f;
        float ss = 0.f;
#pragma unroll 4
        for (int q = 64 * kq; q < 64 * kq + 64; ++q) {
            const u32x2 aw = *(const GAS u32x2*)(xr + 8 * q); f32x4 a; a.x = bflo(aw.x); a.y = bfhi(aw.x); a.z = bflo(aw.y); a.w = bfhi(aw.y);
            const GAS float* rq = rw + (size_t)(8 * q) * 32;
            const float b0 = rq[0], b1 = rq[32], b2 = rq[64], b3 = rq[96];
            acc = __builtin_amdgcn_mfma_f32_32x32x2f32(a.x, b0, acc, 0, 0, 0);
            acc = __builtin_amdgcn_mfma_f32_32x32x2f32(a.y, b1, acc, 0, 0, 0);
            acc = __builtin_amdgcn_mfma_f32_32x32x2f32(a.z, b2, acc, 0, 0, 0);
            acc = __builtin_amdgcn_mfma_f32_32x32x2f32(a.w, b3, acc, 0, 0, 0);
            ss += (a.x * a.x + a.y * a.y) + (a.z * a.z + a.w * a.w);
        }
#endif
        LAS float* pp = part + (size_t)((tk * 4 + kq) * 32) * 33;
#pragma unroll
        for (int r = 0; r < 16; ++r) pp[crow(r, hi) * 33 + r32] = acc[r];
        ssp[(tk * 4 + kq) * 64 + l] = ss;
    }
    __syncthreads();
    const bool sel = (kq == 0) && (l < 32);
    float v0 = -INFINITY, v1 = -INFINITY, v2 = -INFINITY, v3 = -INFINITY; int i0 = 0, i1 = 0, i2 = 0, i3 = 0; int lr0 = 0, lr1 = 0, lr2 = 0, lr3 = 0;
    if (sel) {
        float ss = 0.f;
#pragma unroll
        for (int k = 0; k < 4; ++k) ss += ssp[(tk * 4 + k) * 64 + l] + ssp[(tk * 4 + k) * 64 + 32 + l];
        const float rs = 1.0f / sqrtf(ss * (1.f / 2048.f) + EPS);
        const GAS float* rb = (const GAS float*)in[28];
        const LAS float* pp = part + (size_t)(tk * 4 * 32 + l) * 33;
#pragma unroll
        for (int e = 0; e < 32; ++e) {
            const float x = ((pp[e] + pp[32 * 33 + e]) + (pp[2 * 32 * 33 + e] + pp[3 * 32 * 33 + e])) * rs + rb[e];
            if (x > v3) {
                if (x > v0) { v3 = v2; i3 = i2; v2 = v1; i2 = i1; v1 = v0; i1 = i0; v0 = x; i0 = e; }
                else if (x > v1) { v3 = v2; i3 = i2; v2 = v1; i2 = i1; v1 = x; i1 = e; }
                else if (x > v2) { v3 = v2; i3 = i2; v2 = x; i2 = e; }
                else { v3 = x; i3 = e; }
            }
        }
        lr0 = __hip_atomic_fetch_add(&lcnt[i0], 1, __ATOMIC_RELAXED, __HIP_MEMORY_SCOPE_WORKGROUP); lr1 = __hip_atomic_fetch_add(&lcnt[i1], 1, __ATOMIC_RELAXED, __HIP_MEMORY_SCOPE_WORKGROUP); lr2 = __hip_atomic_fetch_add(&lcnt[i2], 1, __ATOMIC_RELAXED, __HIP_MEMORY_SCOPE_WORKGROUP); lr3 = __hip_atomic_fetch_add(&lcnt[i3], 1, __ATOMIC_RELAXED, __HIP_MEMORY_SCOPE_WORKGROUP);
    }
    __syncthreads();
    if (tid < 32) { const int c = lcnt[tid]; gbase[tid] = c ? (int)__hip_atomic_fetch_add((unsigned*)(F.ctl + CW_CNT + tid), (unsigned)c, __ATOMIC_RELAXED, __HIP_MEMORY_SCOPE_AGENT) : 0; }
    __syncthreads();
    if (sel) {
        const int t = tok0 + l;
        const float e1 = expf(v1 - v0), e2 = expf(v2 - v0), e3 = expf(v3 - v0), inv = 1.0f / (1.0f + e1 + e2 + e3);
        GAS int* te = (GAS int*)WSP(int, WS_TKE) + t * 4; GAS int* tr = (GAS int*)WSP(int, WS_TKR) + t * 4; GAS float* tg = (GAS float*)WSP(float, WS_TKG) + t * 4;
        te[0] = i0; te[1] = i1; te[2] = i2; te[3] = i3;
        tr[0] = gbase[i0] + lr0; tr[1] = gbase[i1] + lr1; tr[2] = gbase[i2] + lr2; tr[3] = gbase[i3] + lr3;
        tg[0] = inv; tg[1] = e1 * inv; tg[2] = e2 * inv; tg[3] = e3 * inv;
    }
    __syncthreads();
}
__device__ __forceinline__ void build_moe_tab(Frame& F) {
    LAS int* tab = (LAS int*)(F.lds + LTAB_OFF);
    if (F.tid == 0) { int s = 0; for (int e = 0; e < NE; ++e) { tab[e] = s; s += ((int)__hip_atomic_load(F.ctl + CW_CNT + e, RLX_AGENT) + 255) >> 8; } tab[NE] = s; }
    __syncthreads();
}
__device__ __forceinline__ void p9_scatter_token(Frame& F, const float* const* in, int t) {
    const int lane = F.lane; const LAS int* tab = (const LAS int*)(F.lds + LTAB_OFF);
    const GAS u32x2* xr = (const GAS u32x2*)(WSP(bf16, WS_X1) + (size_t)t * 2048) + lane; const GAS f32x4* gr = (const GAS f32x4*)in[26] + lane;
    f32x4 v[8]; float s = 0.f;
#pragma unroll
    for (int j = 0; j < 8; ++j) { const u32x2 xw = xr[64 * j]; v[j].x = bflo(xw.x); v[j].y = bfhi(xw.x); v[j].z = bflo(xw.y); v[j].w = bfhi(xw.y); s += (v[j].x * v[j].x + v[j].y * v[j].y) + (v[j].z * v[j].z + v[j].w * v[j].w); }
    const float rs = 1.0f / sqrtf(wave_sum(s) * (1.f / 2048.f) + EPS);
    unsigned w[8];
#pragma unroll
    for (int j = 0; j < 8; ++j) { const f32x4 g = gr[64 * j]; w[j] = pk4_fp8(v[j].x * rs * g.x, v[j].y * rs * g.y, v[j].z * rs * g.z, v[j].w * rs * g.w); }
    const GAS int* te = (const GAS int*)WSP(int, WS_TKE) + t * 4; const GAS int* tr = (const GAS int*)WSP(int, WS_TKR) + t * 4;
#pragma unroll
    for (int k = 0; k < 4; ++k) { const int e = te[k], rk = tr[k]; const size_t rowi = (size_t)tab[e] * 256 + rk;
        GAS unsigned* o4 = (GAS unsigned*)(WSP(unsigned char, WS_HS) + rowi * 2048) + lane;
#pragma unroll
        for (int j = 0; j < 8; ++j) o4[64 * j] = w[j]; }
}
__device__ __forceinline__ void p12_combine_token(Frame& F, float* out, int t) {
    const int lane = F.lane; const LAS int* tab = (const LAS int*)(F.lds + LTAB_OFF);
    const GAS u32x2* xr = (const GAS u32x2*)(WSP(bf16, WS_X1) + (size_t)t * 2048) + lane;
    f32x4 v[8];
#pragma unroll
    for (int j = 0; j < 8; ++j) { const u32x2 xw = xr[64 * j]; v[j].x = bflo(xw.x); v[j].y = bfhi(xw.x); v[j].z = bflo(xw.y); v[j].w = bfhi(xw.y); }
    const GAS int* te = (const GAS int*)WSP(int, WS_TKE) + t * 4; const GAS int* tr = (const GAS int*)WSP(int, WS_TKR) + t * 4; const GAS float* tg = (const GAS float*)WSP(float, WS_TKG) + t * 4;
#pragma unroll
    for (int k = 0; k < 4; ++k) { const int e = te[k], rk = tr[k]; const float g = tg[k]; const size_t rowi = (size_t)tab[e] * 256 + rk;
        const GAS unsigned* y4 = (const GAS unsigned*)(WSP(unsigned char, WS_Y) + rowi * 2048) + lane;
#pragma unroll
        for (int j = 0; j < 8; ++j) { const int yw = (int)y4[64 * j]; const f32x2 lo = __builtin_amdgcn_cvt_pk_f32_fp8(yw, false), hh = __builtin_amdgcn_cvt_pk_f32_fp8(yw, true);
            v[j].x += g * lo[0]; v[j].y += g * lo[1]; v[j].z += g * hh[0]; v[j].w += g * hh[1]; } }
    GAS f32x4* o = (GAS f32x4*)(out + (size_t)t * 2048) + lane;
#pragma unroll
    for (int j = 0; j < 8; ++j) o[64 * j] = v[j];
}

struct Args { const float* in[33]; float* out; unsigned char* ws; };
__global__ void __launch_bounds__(NWAVES * 64, 2) mk_fwd(Args args) {
    extern __shared__ __attribute__((aligned(16))) unsigned char lds[];
    Frame F;
    F.lds = (LAS unsigned char*)lds;
    F.MISC = (volatile LAS unsigned*)(F.lds + MISC_OFF);
    F.tid = threadIdx.x; F.lane = F.tid & 63; F.wave = __builtin_amdgcn_readfirstlane(F.tid >> 6);
    F.G = gridDim.x; { const int bx = blockIdx.x; F.vcu = (F.G % 8 == 0) ? (bx % 8) * (F.G / 8) + bx / 8 : bx; }
    F.ws = args.ws; F.ctl = (gu32*)(args.ws + WS_CTL);
    const float* const* in = args.in;
    for (int u = F.tid; u < (LDS_BYTES - LDSCTL_OFF) / 4; u += NWAVES * 64) ((LAS unsigned*)(F.lds + LDSCTL_OFF))[u] = 0u;
    __syncthreads();
#define PHASE_SEAM() do { xcd_barrier(bar); int l_ = pg8::pg8_lane(); asm volatile("" : "+v"(l_)); F.lane = l_; F.tid = F.wave * 64 + l_; } while (0)
    XcdBarrier bar = xcd_barrier_post((unsigned*)(F.ctl + CW_BAR), F.MISC + 8);
    const int gw = F.vcu * NWAVES + F.wave, NGW = F.G * NWAVES;
    typedef pg8::bf16_t pbf;

    for (int rep = 0; rep < REP_P0; ++rep) p0_prologue<0>(F, in);
    PHASE_SEAM();

    for (int rep = 0; rep < REP_P1; ++rep)
    {   pg8::Gemm g{WSP(pbf, WS_H), WSP(pbf, WS_W1T), T + MEMROWS, P1N + 2048, 2048, HPITCH, HPITCH};
        pg8::EpiP1 E{WSP(pbf, WS_P1), WSP(pbf, WS_MKV), in[6]};
        const int slot = (CONV_IN_P1 && (!ATTN_SPLIT || SPLIT_NOCONV) && rep == 0) ? (F.vcu % (GATE_F8 ? 5 : 10)) : 0;
        if (!(UV_F8 == 1 && GATE_F8))
        {   pg8::P1Order S; S.init(F.G, (int)blockIdx.x, 0, slot);
            pg8::gemm_phase<pg8::EpiP1, pg8::P1Order, GEMM_ALIGN, true>(F.lds + RING_OFF, g, S, E, F.wave); }
        if (CONV_IN_P1 && (!ATTN_SPLIT || SPLIT_NOCONV) && rep == 0) { __syncthreads(); if (CONV_DMA == 2) moe_convert_share_dma256(F, in); else if (CONV_DMA) moe_convert_share_dma(F, in); else moe_convert_share<0>(F, in); if (REP_CONV > 1) moe_convert_share<1>(F, in); }
        if (!(UV_F8 == 1 && GATE_F8))
        {   pg8::P1Order S; S.init(F.G, (int)blockIdx.x, slot, 1 << 20);
            pg8::gemm_phase<pg8::EpiP1, pg8::P1Order, GEMM_ALIGN, true>(F.lds + RING_OFF, g, S, E, F.wave); }
        if (GATE_F8) {
            pg8::Gemm g8{WSP(pbf, WS_H8), WSP(pbf, WS_WG8) - (size_t)8 * 256 * 1024, T + MEMROWS, 41 * 256, 1024, 1024, 1024, MOE_SW, MOE_SX};
            pg8::GateOrder SG; SG.init(F.G, (int)blockIdx.x);
            pg8::gemm_phase<pg8::EpiP1, pg8::GateOrder, GEMM_ALIGN, true, true, 0, (KROT_MASK & 4) != 0>(F.lds + RING_OFF, g8, SG, E, F.wave); }
        if (GATE_F8 && PRO_SPLIT == 1 && UV_F8 == 2 && rep == 0 && blockIdx.x >= 96) p0_prologue<1>(F, in, (int)blockIdx.x - 96, 160);
        if (GATE_F8 && PRO_SPLIT == 2 && UV_F8 == 2 && rep == 0 && blockIdx.x >= 224) p0_prologue<1>(F, in, (int)blockIdx.x - 224, 32);
        if (GATE_F8 && CONV_OFFLOAD && UV_F8 == 2 && rep == 0 && blockIdx.x >= 96 && blockIdx.x < 96 + CONV_OFF_CUS) {
            const int k0 = (CONV_NSUP - CONV_OFF) + 8 * ((int)blockIdx.x - 96);
            moe_convert_range256<8>(F, in, F.wave, (LAS unsigned*)(F.lds + RING_OFF + F.wave * 16640), F.lane, k0, k0 + 8); }
    }
    PHASE_SEAM();

    for (int rep = 0; rep < REP_P2; ++rep)
    for (int t = gw; t < T; t += NGW) p2_token(F, in, t);
    for (int m = gw; m < MEMROWS; m += NGW) p2_memrow(F, in, m);
    PHASE_SEAM();

    for (int rep = 0; rep < REP_P3; ++rep) {
    {   pg8::Gemm g{WSP(pbf, WS_CQN), WSP(pbf, WS_WUQT), T, 4096, 256, 256, 256, UP_SW, MOE_SX};
        pg8::StaticOrder S; S.init(T, 4096, F.G, (int)blockIdx.x);
#if ATTN_F8
        pg8::EpiQ8 E{(LAS float*)(F.lds + LEPI_OFF), in[16], WSP(float, WS_ROPE), WSP(unsigned char, WS_QF), MLA_QSCALE * 16.0f};
        pg8::gemm_phase<pg8::EpiQ8, pg8::StaticOrder, true, true, true>(F.lds + RING_OFF, g, S, E, F.wave);
#else
        pg8::EpiQ E{(LAS float*)(F.lds + LEPI_OFF), in[16], WSP(float, WS_ROPE), WSP(pbf, WS_QF), MLA_QSCALE};
        pg8::gemm_phase<pg8::EpiQ, pg8::StaticOrder, true, true, true>(F.lds + RING_OFF, g, S, E, F.wave);
#endif
    }
    {   pg8::Gemm g{WSP(pbf, WS_CKVN), WSP(pbf, WS_WUKVT), T, 4096, 256, 256, 256, UP_SW, MOE_SX};
        pg8::StaticOrder S; S.init(T, 4096, F.G, (int)blockIdx.x);
#if ATTN_F8
        pg8::EpiKV8 E{(LAS float*)(F.lds + LEPI_OFF), in[17], WSP(float, WS_KRSS), WSP(float, WS_KRR), WSP(unsigned char, WS_KFT), WSP(unsigned char, WS_VFT)};
        pg8::gemm_phase<pg8::EpiKV8, pg8::StaticOrder, true, true, true>(F.lds + RING_OFF, g, S, E, F.wave);
#else
        pg8::EpiKV E{(LAS float*)(F.lds + LEPI_OFF), in[17], WSP(float, WS_KRSS), WSP(float, WS_KRR), WSP(pbf, WS_KFT), WSP(pbf, WS_VFT)};
        pg8::gemm_phase<pg8::EpiKV, pg8::StaticOrder, true, true, true>(F.lds + RING_OFF, g, S, E, F.wave);
#endif
    }
    __syncthreads();
    for (int u = F.vcu; u < 1024; u += F.G) gmlp_unit(F, in, u);
    for (int u = F.vcu; u < 512; u += F.G) {
        const int half = u & 1, qb = (u >> 1) & 15, bh = u >> 5;
        const bf16* Q = WSP(bf16, WS_QMN) + ((size_t)bh * 4096 + qb * 256 + 32 * F.wave) * 256;
        const bf16* Kt = WSP(bf16, WS_MKT) + (size_t)bh * 4 * (32 * 64 * 8);
        const bf16* Vt = WSP(bf16, WS_MVT) + (size_t)(bh * 2 + half) * 4 * (4 * 64 * 32);
        unsigned char* O = WSP(unsigned char, WS_ABC) + ((size_t)(bh >> 2) * 4096 + qb * 256 + 32 * F.wave) * ABC_ROWB + ABC_CB + (bh & 3) * 256 + half * 128;
        attn_unit<256, 2, false>(F.lds + RING_OFF, Q, 256, Kt, Vt, 4, 0, O, ABC_ROWB, F.wave, F.lane);
    }
    }
    PHASE_SEAM();

#if ATTN_SPLIT
    {   const int s = F.vcu & 3;
#if !(ATTN_XCDMAP && ATTN_RB2)
        const int bh = F.vcu >> 2;
#endif
        constexpr int NIT = NE * 32 * 64 + NE * 32 * 32;
        ConvState cs; cs.lo = F.vcu * (NIT / 256); cs.cw = F.wave - 4; cs.c = -1;
        { const int nitems = (NIT / 256 - cs.cw + 3) / 4; cs.nchunks = (F.wave >= 4 && !SPLIT_NOCONV) ? nitems * 4 : 0; }
        LAS unsigned char* cbase = F.lds + RING_OFF + (ATT_PAIR && ATTN_RB2 ? 81920 : 61440) + (F.wave - 4) * 16640;
#if ATTN_RB2
#if ATTN_XCDMAP
#define P5_UNIT(i_) const int s16 = F.vcu & 15, s8 = (s16 + 8) & 15, qb = ((i_) == 0) ? s16 : ((i_) == 1) ? 15 - s16 : ((i_) == 2) ? s8 : 15 - s8, nt = 4 * (qb + 1), \
        bh = 8 * (F.vcu >> 5) + 2 * (i_) + ((F.vcu >> 4) & 1)
#else
#define P5_UNIT(i_) const int qb = ((i_) == 0) ? s : ((i_) == 1) ? 7 - s : ((i_) == 2) ? 8 + s : 15 - s, nt = 4 * (qb + 1)
#endif
#if ATT_REBAL
        LAS unsigned* bctr = (LAS unsigned*)(F.lds + MISC_OFF + 64);
        if (F.tid == 0) { bctr[0] = 0u; bctr[1] = 0u; }
        __syncthreads();
        const unsigned char* Kt = WSP(unsigned char, WS_KFT) + (size_t)bh * 64 * 12288;
        const unsigned char* Vt = WSP(unsigned char, WS_VFT) + (size_t)bh * 64 * 8192;
        if (F.wave < 4) {
            unsigned nbar = 0;
            const int nu = (s == 0) ? 2 : 3;
            for (int i = 0; i < nu; ++i) {
                const int qb = (s == 0) ? (i == 0 ? 15 : 13) : (s == 1) ? (i == 0 ? 14 : i == 1 ? 8 : 5) : (s == 2) ? (i == 0 ? 12 : i == 1 ? 9 : 6) : (i == 0 ? 11 : i == 1 ? 10 : 7);
                const unsigned char* Q = WSP(unsigned char, WS_QF) + ((size_t)bh * 4096 + qb * 256 + 32 * F.wave) * 192;
                unsigned char* O = WSP(unsigned char, WS_ABC) + ((size_t)(bh >> 4) * 4096 + qb * 256 + 32 * F.wave) * ABC_ROWB + ABC_BB + (bh & 15) * 128;
                attn8_unit2<true>(F.lds + RING_OFF, Q, Kt, Vt, 4 * (qb + 1), qb * 256 + 32 * F.wave, O, ABC_ROWB, F.wave, F.lane, bctr, nbar); }
        } else {
            moe_convert_share_w256<4>(F, in, F.wave - 4, (LAS unsigned*)cbase, F.lane);
            asm volatile("s_waitcnt vmcnt(0) lgkmcnt(0)" ::: "memory");
            unsigned nbar2 = 0; const int cw = F.wave - 4;
            att_bar4(bctr + 1, nbar2, F.lane);
            const int nu = (s == 3) ? 4 : 2;
            for (int i = 0; i < nu; ++i) {
                const int qh = (s == 0) ? (i == 0 ? 9 : 3) : (s == 1) ? (i == 0 ? 8 : 4) : (s == 2) ? (i == 0 ? 7 : 5) : (i == 0 ? 6 : i == 1 ? 2 : i == 2 ? 1 : 0);
                const unsigned char* Q = WSP(unsigned char, WS_QF) + ((size_t)bh * 4096 + qh * 128 + 32 * cw) * 192;
                unsigned char* O = WSP(unsigned char, WS_ABC) + ((size_t)(bh >> 4) * 4096 + qh * 128 + 32 * cw) * ABC_ROWB + ABC_BB + (bh & 15) * 128;
                attn8_unit<true, 4>(F.lds + RING_OFF + 61440, Q, Kt, Vt, 2 * (qh + 1), qh * 128 + 32 * cw, O, ABC_ROWB, cw, F.lane, bctr + 1, &nbar2); }
        }
#else
        LAS unsigned* bctr = (LAS unsigned*)(F.lds + MISC_OFF + 64);
        if (F.tid == 0) *bctr = 0u;
        __syncthreads();
        if (F.wave < 4) {
            unsigned nbar = 0;
            for (int rep = 0; rep < REP_P5; ++rep)
            for (int i = 0; i < 4; ++i) { P5_UNIT(i);
                const unsigned char* Q = WSP(unsigned char, WS_QF) + ((size_t)bh * 4096 + qb * 256 + 32 * F.wave) * 192;
                const unsigned char* Kt = WSP(unsigned char, WS_KFT) + (size_t)bh * 64 * 12288;
                const unsigned char* Vt = WSP(unsigned char, WS_VFT) + (size_t)bh * 64 * 8192;
                unsigned char* O = WSP(unsigned char, WS_ABC) + ((size_t)(bh >> 4) * 4096 + qb * 256 + 32 * F.wave) * ABC_ROWB + ABC_BB + (bh & 15) * 128;
                attn8_unit2<true>(F.lds + RING_OFF, Q, Kt, Vt, nt, qb * 256 + 32 * F.wave, O, ABC_ROWB, F.wave, F.lane, bctr, nbar); }
        } else {
#if !SPLIT_FREE
            int it = 0;
            for (int i = 0; i < 4; ++i) { P5_UNIT(i);
                for (int j = 0; j < nt; ++j, ++it) { conv_steps<4>(F, in, cs, cbase, 3, F.lane); __builtin_amdgcn_s_barrier(); asm volatile("" ::: "memory"); }
                __builtin_amdgcn_s_barrier(); asm volatile("" ::: "memory"); }
#endif
#if SPLIT_FREE == 2
            for (int rep = 0; rep < REP_CONV; ++rep) { if (CONV_ROWS == 256) moe_convert_share_w256<4>(F, in, F.wave - 4, (LAS unsigned*)cbase, F.lane); else moe_convert_share_w<4>(F, in, F.wave - 4, (LAS unsigned*)cbase, F.lane); }
            asm volatile("s_waitcnt vmcnt(0)" ::: "memory");
#else
            for (int rep = 0; rep < REP_CONV; ++rep) { cs.c = -1; conv_steps<4>(F, in, cs, cbase, 1 << 20, F.lane); asm volatile("s_waitcnt vmcnt(0)" ::: "memory"); }
#endif
        }
#endif
#undef P5_UNIT
#else
#define P5_UNIT(i_) const int qb = (((i_) >> 1) == 0) ? s : (((i_) >> 1) == 1) ? 7 - s : (((i_) >> 1) == 2) ? 8 + s : 15 - s, qh = 2 * qb + ((i_) & 1), nt = 2 * (qh + 1)
        if (F.wave < 4) {
            __builtin_amdgcn_s_setprio(SPLIT_PRIO);
            for (int i = 0; i < 8; ++i) { P5_UNIT(i);
                const unsigned char* Q = WSP(unsigned char, WS_QF) + ((size_t)bh * 4096 + qh * 128 + 32 * F.wave) * 192;
                const unsigned char* Kt = WSP(unsigned char, WS_KFT) + (size_t)bh * 64 * 12288;
                const unsigned char* Vt = WSP(unsigned char, WS_VFT) + (size_t)bh * 64 * 8192;
                unsigned char* O = WSP(unsigned char, WS_ABC) + ((size_t)(bh >> 4) * 4096 + qh * 128 + 32 * F.wave) * ABC_ROWB + ABC_BB + (bh & 15) * 128;
                attn8_unit<true, 4>(F.lds + RING_OFF, Q, Kt, Vt, nt, qh * 128 + 32 * F.wave, O, ABC_ROWB, F.wave, F.lane); }
            __builtin_amdgcn_s_setprio(0);
        } else {
            int it = 0;
            for (int i = 0; i < 8; ++i) { P5_UNIT(i);
                for (int j = 0; j < nt; ++j, ++it) { conv_steps<4>(F, in, cs, cbase, CONV_QUOTA(it), F.lane); __builtin_amdgcn_s_barrier(); asm volatile("" ::: "memory"); }
                __builtin_amdgcn_s_barrier(); asm volatile("" ::: "memory"); }
            conv_steps<4>(F, in, cs, cbase, 1 << 20, F.lane); asm volatile("s_waitcnt vmcnt(0)" ::: "memory");
        }
#undef P5_UNIT
#endif
        __syncthreads();
    }
    PHASE_SEAM();

#else
    for (int rep = 0; rep < REP_P5; ++rep)
    {   const int bh = F.vcu >> 2, s = F.vcu & 3;
        for (int i = 0; i < 4; ++i) {
            if (!CONV_IN_P1 && rep == 0 && i == ((F.vcu >> 2) & 3)) { moe_convert_share<0>(F, in); if (REP_CONV > 1) moe_convert_share<1>(F, in); }
            const int qb = (i == 0) ? s : (i == 1) ? 7 - s : (i == 2) ? 8 + s : 15 - s;
#if ATTN_F8
            const unsigned char* Q = WSP(unsigned char, WS_QF) + ((size_t)bh * 4096 + qb * 256 + 32 * F.wave) * 192;
            const unsigned char* Kt = WSP(unsigned char, WS_KFT) + (size_t)bh * 64 * 12288;
            const unsigned char* Vt = WSP(unsigned char, WS_VFT) + (size_t)bh * 64 * 8192;
            unsigned char* O = WSP(unsigned char, WS_ABC) + ((size_t)(bh >> 4) * 4096 + qb * 256 + 32 * F.wave) * ABC_ROWB + ABC_BB + (bh & 15) * 128;
            attn8_unit<true>(F.lds + RING_OFF, Q, Kt, Vt, 4 * (qb + 1), qb * 256 + 32 * F.wave, O, ABC_ROWB, F.wave, F.lane);
#else
            const bf16* Q = WSP(bf16, WS_QF) + ((size_t)bh * 4096 + qb * 256 + 32 * F.wave) * 192;
            const bf16* Kt = WSP(bf16, WS_KFT) + (size_t)bh * 64 * (24 * 64 * 8);
            const bf16* Vt = WSP(bf16, WS_VFT) + (size_t)bh * 64 * (4 * 64 * 32);
            unsigned char* O = WSP(unsigned char, WS_ABC) + ((size_t)(bh >> 4) * 4096 + qb * 256 + 32 * F.wave) * ABC_ROWB + ABC_BB + (bh & 15) * 128;
            attn_unit<192, 3, true>(F.lds + RING_OFF, Q, 192, Kt, Vt, 4 * (qb + 1), qb * 256 + 32 * F.wave, O, ABC_ROWB, F.wave, F.lane);
#endif
        }
    }
    PHASE_SEAM();

#endif
    for (int rep = 0; rep < REP_P6; ++rep)
    {   pg8::Gemm g{WSP(pbf, WS_ABC), WSP(pbf, WS_WPT), T, 2048, ABC_LD, ABC_LD, ABC_LD, MOE_SW, ATT_OSB};
        pg8::StaticOrder S; S.init(T, 2048, F.G, (int)blockIdx.x);
        pg8::EpiMergedT<16, 32> E{WSP(pbf, WS_P1), WSP(pbf, WS_MERGED)};
        pg8::gemm_phase<pg8::EpiMergedT<16, 32>, pg8::StaticOrder, GEMM_ALIGN, true, false, 16>(F.lds + RING_OFF, g, S, E, F.wave);
    }
    PHASE_SEAM();

    for (int rep = 0; rep < REP_P7; ++rep)
    {   pg8::Gemm g{WSP(pbf, WS_MERGED), WSP(pbf, WS_WOT), T, 2048, 2048, 2048, 2048};
        pg8::StaticOrder S; S.init(T, 2048, F.G, (int)blockIdx.x);
        pg8::EpiX1 E{in[0], WSP(pbf, WS_X1)};
        pg8::gemm_phase<pg8::EpiX1, pg8::StaticOrder, P7_ALIGN, true>(F.lds + RING_OFF, g, S, E, F.wave);
    }
    PHASE_SEAM();

    p8_router(F, in);
    PHASE_SEAM();

    build_moe_tab(F);
    for (int rep = 0; rep < REP_P9; ++rep)
    for (int t = gw; t < T; t += NGW) p9_scatter_token(F, in, t);
    PHASE_SEAM();

    for (int rep = 0; rep < REP_P10; ++rep)
    {   pg8::Gemm g{WSP(pbf, WS_HS), WSP(pbf, WS_WGUT), MAXSLOT, NE * 4096, 1024, 1024, 1024, MOE_SW, MOE_SX};
        pg8::MoeOrder S{(const LAS int*)(F.lds + LTAB_OFF), 16, (int)(blockIdx.x & 7), (int)(blockIdx.x >> 3)};
        pg8::EpiSwiGLU E{in[30], WSP(unsigned char, WS_ACT)};
#if P10_PROBE
        if (rep > 0) { pg8::EpiSwiGLUProbe<P10_PROBE> EP; EP.bgu = E.bgu; EP.ACT = E.ACT;
            pg8::gemm_phase<pg8::EpiSwiGLUProbe<P10_PROBE>, pg8::MoeOrder, GEMM_ALIGN, true, true>(F.lds + RING_OFF, g, S, EP, F.wave); }
        else
#endif
        pg8::gemm_phase<pg8::EpiSwiGLU, pg8::MoeOrder, GEMM_ALIGN, true, true, 0, (KROT_MASK & 1) != 0, (PFETCH_MASK & 1) != 0>(F.lds + RING_OFF, g, S, E, F.wave);
    }
    PHASE_SEAM();

    for (int rep = 0; rep < REP_P11; ++rep)
    {   pg8::Gemm g{WSP(pbf, WS_ACT), WSP(pbf, WS_WDT), MAXSLOT, NE * 2048, 1024, 1024, 1024, MOE_SW, MOE_SX};
        pg8::MoeOrder S{(const LAS int*)(F.lds + LTAB_OFF), 8, (int)(blockIdx.x & 7), (int)(blockIdx.x >> 3)};
        pg8::EpiDown E{in[32], WSP(unsigned char, WS_Y)};
        pg8::gemm_phase<pg8::EpiDown, pg8::MoeOrder, GEMM_ALIGN, true, true, 0, (KROT_MASK & 2) != 0>(F.lds + RING_OFF, g, S, E, F.wave);
    }
    PHASE_SEAM();

    for (int rep = 0; rep < REP_P12; ++rep)
    for (int t = gw; t < T; t += NGW) p12_combine_token(F, args.out, t);
}

extern "C" void kernel_launch(void* const* d_in, const int* in_sizes, int n_in, void* d_out, int out_size, void* d_ws, size_t ws_size, hipStream_t stream) {
    static int grid = 0;
    if (grid == 0) {
        if (n_in != 33 || out_size != T * D || ws_size < WS_END) { fprintf(stderr, "kernel_launch: unexpected problem (n_in %d out %d ws %zu need %zu)\n", n_in, out_size, ws_size, (size_t)WS_END); grid = -1; return; }
        (void)in_sizes;
        if (hipFuncSetAttribute((const void*)mk_fwd, hipFuncAttributeMaxDynamicSharedMemorySize, LDS_BYTES) != hipSuccess) { fprintf(stderr, "kernel_launch: hipFuncSetAttribute failed\n"); grid = -1; return; }
        int per_cu = 0;
        if (hipOccupancyMaxActiveBlocksPerMultiprocessor(&per_cu, (const void*)mk_fwd, NWAVES * 64, LDS_BYTES) != hipSuccess || per_cu < 1) fprintf(stderr, "kernel_launch: occupancy query reports %d\n", per_cu);
        (void)hipGetLastError();
        grid = 256;
    }
    if (grid < 0) return;
    if (hipMemsetAsync((char*)d_ws + WS_CTL, 0, CTL_ZERO_BYTES, stream) != hipSuccess) { fprintf(stderr, "kernel_launch: memset failed\n"); return; }
    Args a{};
    for (int i = 0; i < 33; ++i) a.in[i] = (const float*)d_in[i];
    a.out = (float*)d_out; a.ws = (unsigned char*)d_ws;
    hipLaunchKernelGGL(mk_fwd, dim3(grid), dim3(NWAVES * 64), LDS_BYTES, stream, a);
}
```

```cpp
#include <hip/hip_runtime.h>
#include <cstdio>
#include <cstdint>
#include <cmath>
#ifndef REP_P0
#define REP_P0 1
#endif
#ifndef REP_P1
#define REP_P1 1
#endif
#ifndef REP_P3
#define REP_P3 1
#endif
#ifndef REP_P5
#define REP_P5 1
#endif
#ifndef REP_P6
#define REP_P6 1
#endif
#ifndef REP_P10
#define REP_P10 1
#endif
#ifndef REP_P11
#define REP_P11 1
#endif
#ifndef REP_CONV
#define REP_CONV 1
#endif
#ifndef ATTN_RB2
#define ATTN_RB2 1
#endif
#ifndef SPLIT_FREE
#define SPLIT_FREE 2
#endif
#ifndef CONV_ROWS
#define CONV_ROWS 256
#endif
#ifndef UV_F8
#define UV_F8 2
#endif
#ifndef ATTN_XCDMAP
#define ATTN_XCDMAP 0
#endif
#ifndef P10_PROBE
#define P10_PROBE 0
#endif
#ifndef KROT_MASK
#define KROT_MASK 0
#endif
#ifndef ROUTER_BF16X2
#define ROUTER_BF16X2 1
#endif
#ifndef CONV_OFFLOAD
#define CONV_OFFLOAD 1
#endif
#ifndef STAGE_IN_MMA
#define STAGE_IN_MMA 0
#endif
#ifndef ATT_SLEEP
#define ATT_SLEEP 0
#endif
#ifndef ATT_VPRE
#define ATT_VPRE 0
#endif
#ifndef KSEG_BATCH16
#define KSEG_BATCH16 0
#endif
#ifndef ATT_PAIR
#define ATT_PAIR 1
#endif
#ifndef PFETCH_MASK
#define PFETCH_MASK 0
#endif
#ifndef CONV_SLEEP
#define CONV_SLEEP 0
#endif
#ifndef ATT_REBAL
#define ATT_REBAL 0
#endif
#ifndef ATT_SPLITQK
#define ATT_SPLITQK 1
#endif
#ifndef ATT_DEFER
#define ATT_DEFER 0
#endif
#ifndef PRO_SPLIT
#define PRO_SPLIT 0
#endif
#ifndef ATT_PERMLANE
#define ATT_PERMLANE 1
#endif
#ifndef ATT_POLL_SLEEP
#define ATT_POLL_SLEEP 1
#endif
#ifndef ATT_SPREAD
#define ATT_SPREAD 0
#endif
#ifndef STAGE_AUX
#define STAGE_AUX 0
#endif
#ifndef MOE_MAP2
#define MOE_MAP2 0
#endif
#ifndef ATT_OWIDE
#define ATT_OWIDE 1
#endif
#ifndef XL_FAST
#define XL_FAST 1
#endif
#ifndef EPIX1_BATCH
#define EPIX1_BATCH 0
#endif
#ifndef SPLIT_PRIO
#define SPLIT_PRIO 0
#endif
#ifndef SPLIT_NOCONV
#define SPLIT_NOCONV 0
#endif
#ifndef CONV_QUOTA
#define CONV_QUOTA(it) (1 + ((it) & 1))
#endif
#ifndef ATTN_SPLIT
#define ATTN_SPLIT 1
#endif
#ifndef P7_ALIGN
#define P7_ALIGN true
#endif
#ifndef ATTN_F8
#define ATTN_F8 1
#endif
#ifndef GATE_BF16SPLIT
#define GATE_BF16SPLIT 0
#endif
#ifndef GATE_SKIP
#define GATE_SKIP 0
#endif
#ifndef GATE_F8
#define GATE_F8 1
#endif
#ifndef CONV_DMA
#define CONV_DMA 1
#endif
#ifndef PITCH_PAD
#define PITCH_PAD 0
#endif
#ifndef GEMM_ALIGN
#define GEMM_ALIGN true
#endif
#ifndef CONV_IN_P1
#define CONV_IN_P1 1
#endif
#ifndef REP_P7
#define REP_P7 1
#endif
#ifndef REP_P2
#define REP_P2 1
#endif
#ifndef REP_P4
#define REP_P4 1
#endif
#ifndef REP_P9
#define REP_P9 1
#endif
#ifndef REP_P12
#define REP_P12 1
#endif
constexpr int NWAVES = 8;
constexpr int T = 16384, D = 2048, NBATCH = 4, SEQ = 4096;
constexpr int HPITCH = 2048 + PITCH_PAD;
constexpr int P1N = 10496;
constexpr int P1_U = 0, P1_V = 1024, P1_CQ = 2048, P1_CKV = 2560, P1_QM = 3072, P1_KR = 4096, P1_G = 4352;
constexpr int P1_TILES = 41, MEMROWS = 1024;
constexpr int NH = 16, QKD = 192, NOPE = 128, ROPE = 64, VD = 128;
constexpr int NE = 32, DFF = 2048, MAXBLK = 288, MAXSLOT = MAXBLK * 256;
constexpr float EPS = 1e-6f;
constexpr float LOG2E = 1.4426950408889634f;
constexpr float MLA_QSCALE = 0.07216878364870322f * LOG2E;
constexpr float MEM_QSCALE = 0.0625f * LOG2E;
constexpr float MOE_WSCALE = 64.0f;
constexpr unsigned MOE_SW = 0x79797979u, MOE_SX = 0x7f7f7f7fu;
constexpr float UP_WSCALE = 16.0f;
constexpr unsigned UP_SW = 0x7b7b7b7bu;

constexpr size_t MiB = 1u << 20;
constexpr size_t WS_CTL = 0, CTL_ZERO_BYTES = 1 * MiB;
constexpr size_t WS_W1T   = 1 * MiB;
constexpr size_t WS_WUQT  = WS_W1T + (size_t)(P1N + 2048) * HPITCH * 2;
constexpr size_t WS_WUKVT = WS_WUQT + (size_t)4096 * 512 * 2;
constexpr size_t WS_WPT   = WS_WUKVT + (size_t)4096 * 512 * 2;
constexpr size_t WS_WOT   = WS_WPT + (size_t)2048 * 4096 * 2;
constexpr size_t WS_WGUT  = WS_WOT + (size_t)2048 * 2048 * 2;
constexpr size_t WS_WDT   = WS_WGUT + (size_t)NE * 4096 * 2048 * 2;
constexpr size_t WS_WSM   = WS_WDT + (size_t)NE * 2048 * 2048 * 2;
constexpr size_t WS_RWG   = WS_WSM + (size_t)8 * 128 * 128 * 2;
constexpr size_t WS_H     = WS_RWG + (size_t)2048 * 32 * 4;
constexpr size_t WS_P1    = WS_H + (size_t)(T + MEMROWS) * HPITCH * 2;
constexpr size_t WS_MKV   = WS_P1 + (size_t)T * P1N * 2;
constexpr size_t WS_VSTAT = WS_MKV + (size_t)MEMROWS * 2048 * 2;
constexpr size_t WS_CQN   = WS_VSTAT + (size_t)T * 8;
constexpr size_t WS_CKVN  = WS_CQN + (size_t)T * 512 * 2;
constexpr size_t WS_QMN   = WS_CKVN + (size_t)T * 512 * 2;
constexpr size_t WS_KRR   = WS_QMN + (size_t)T * 1024 * 2;
constexpr size_t WS_KRSS  = WS_KRR + (size_t)T * 64 * 4;
constexpr size_t WS_ROPE  = WS_KRSS + (size_t)T * 4;
constexpr size_t WS_MKT   = WS_ROPE + (size_t)T * 64 * 4;
constexpr size_t WS_MVT   = WS_MKT + (size_t)MEMROWS * 1024 * 2;
constexpr size_t WS_QRAW  = WS_MVT + (size_t)MEMROWS * 1024 * 2;
constexpr size_t WS_KVRAW = WS_QRAW + (size_t)T * 3072 * 2;
constexpr size_t WS_QF    = WS_KVRAW + (size_t)T * 4096 * 2;
constexpr size_t WS_KFT   = WS_QF + (size_t)T * 3072 * 2;
constexpr size_t WS_VFT   = WS_KFT + (size_t)T * 3072 * 2;
constexpr size_t WS_ABC   = WS_VFT + (size_t)T * 2048 * 2;
constexpr int ABC_LD = 2560, ABC_ROWB = 5120, ABC_BB = 2048, ABC_CB = 4096;
constexpr float ATT_OS = 32.0f; constexpr unsigned ATT_OSB = 0x7a7a7a7au;
constexpr size_t WS_MERGED= WS_ABC + (size_t)T * 4096 * 2;
constexpr size_t WS_X1    = WS_MERGED + (size_t)T * 2048 * 2;
constexpr size_t WS_TKE   = WS_X1 + (size_t)T * 2048 * 4;
constexpr size_t WS_TKR   = WS_TKE + (size_t)T * 16;
constexpr size_t WS_TKG   = WS_TKR + (size_t)T * 16;
constexpr size_t WS_HS    = WS_TKG + (size_t)T * 16;
constexpr size_t WS_ACT   = WS_HS + (size_t)MAXSLOT * 2048 * 2;
constexpr size_t WS_Y     = WS_ACT + (size_t)MAXSLOT * 2048 * 2;
constexpr size_t WS_H8    = WS_Y + (size_t)MAXSLOT * 2048 * 2;
constexpr size_t WS_WG8U  = WS_H8 + (size_t)(T + MEMROWS) * 2048;
constexpr size_t WS_WG8   = WS_WG8U + (size_t)8 * 256 * 2048;
constexpr size_t WS_END   = WS_WG8 + (size_t)41 * 256 * 2048;
constexpr int CW_TMO = 0, CW_CODE = 1;
constexpr int CW_CNT = 64;
constexpr int CW_BAR = 4096;

constexpr int RING_OFF = 0, RING_BYTES = ATT_PAIR ? 148480 : 133120;
constexpr int LDSCTL_OFF = RING_BYTES, MISC_OFF = LDSCTL_OFF + 320;
constexpr int LTAB_OFF = LDSCTL_OFF + 1024;
constexpr int LEPI_OFF = LDSCTL_OFF + 2048;
constexpr int LDS_BYTES = RING_BYTES + 14336;

#define XL_DPP(v, ctrl) __uint_as_float((unsigned)__builtin_amdgcn_update_dpp(0, (int)__float_as_uint(v), ctrl, 0xf, 0xf, true))
__device__ __forceinline__ float xl_sum16(float v) { v += XL_DPP(v, 0xB1); v += XL_DPP(v, 0x4E); v += XL_DPP(v, 0x141); v += XL_DPP(v, 0x140); return v; }
__device__ __forceinline__ float xl_swap16_sum(float v) { const auto r = __builtin_amdgcn_permlane16_swap(__float_as_uint(v), __float_as_uint(v), false, false); return __uint_as_float(r[0]) + __uint_as_float(r[1]); }
__device__ __forceinline__ float xl_swap32_sum(float v) { const auto r = __builtin_amdgcn_permlane32_swap(__float_as_uint(v), __float_as_uint(v), false, false); return __uint_as_float(r[0]) + __uint_as_float(r[1]); }
__device__ __forceinline__ float xl_swap32_max(float v) { const auto r = __builtin_amdgcn_permlane32_swap(__float_as_uint(v), __float_as_uint(v), false, false); return fmaxf(__uint_as_float(r[0]), __uint_as_float(r[1])); }

#ifndef RSQ_FAST
#define RSQ_FAST 1
#endif
#if RSQ_FAST
#define FAST_RSQ(x) __builtin_amdgcn_rsqf(x)
#else
#define FAST_RSQ(x) (1.0f / sqrtf(x))
#endif
namespace pg8 {
#define PG8_LAS __attribute__((address_space(3)))
typedef unsigned short bf16_t;
typedef short bf16x8 __attribute__((ext_vector_type(8)));
typedef float f32x4 __attribute__((ext_vector_type(4)));
typedef unsigned u32x4 __attribute__((ext_vector_type(4)));
constexpr int BM = 256, BK = 64, HALF = 128, HTB = HALF * BK * 2  , STAGE_BYTES = 8 * HTB, NXCD = 8, WGM = 8;

__host__ __device__ __forceinline__ int lds_byte(int r, int c) { const int st = (r >> 4) * 2 + (c >> 5), rr = r & 15, cc = c & 31, ob = rr * 64 + cc * 2; return st * 1024 + (ob ^ (((ob >> 9) & 1) << 5)); }
__host__ __device__ __forceinline__ void stage_rc(int b, int& R, int& C) { const int st = b / 1024, sb = b % 1024, swz = sb ^ (((sb >> 9) & 1) << 5); R = (st >> 1) * 16 + swz / 64; C = (st & 1) * 32 + (swz % 64) / 2; }
__host__ __device__ __forceinline__ int perm32(int rho) { const int n = rho >> 4, i = rho & 15; return 8 * (i >> 2) + 4 * n + (i & 3); }

__device__ __forceinline__ int pg8_lane() { int l; asm volatile("v_mbcnt_lo_u32_b32 %0, -1, 0\n\tv_mbcnt_hi_u32_b32 %0, -1, %0" : "=v"(l)); return l; }
struct Unit { int pm, pn; int kr = 0; };
typedef int i32x4 __attribute__((ext_vector_type(4)));
typedef int i32x8 __attribute__((ext_vector_type(8)));
struct Gemm { const bf16_t* A; const bf16_t* Bt; int M, N, K, lda, ldb; unsigned sw = 0x7f7f7f7fu, sx = 0x7f7f7f7fu; };

struct StaticOrder {
    int nM, nN, nwg, G, c;
    __host__ __device__ void init(int M, int N, int G_, int c_) { nM = M / BM; nN = N / BM; nwg = nM * nN; G = G_; c = c_; }
    __host__ __device__ bool next(int i, Unit& u) const {
        const long L = (long)i * G + c; if (L >= nwg) return false;
        int wgid = (int)L; { const int q = nwg / NXCD, r = nwg % NXCD, xcd = wgid % NXCD, off = wgid / NXCD; wgid = (xcd < r ? xcd * (q + 1) : r * (q + 1) + (xcd - r) * q) + off; }
        const int nig = WGM * nN, gid = wgid / nig, fm = gid * WGM, gsz = (nM - fm) < WGM ? (nM - fm) : WGM;
        u.pm = fm + ((wgid % nig) % gsz); u.pn = (wgid % nig) / gsz; return true;
    }
    __device__ __forceinline__ void a_ready(const Unit&) const {}
    __device__ __forceinline__ void done(const Unit&) const {}
};

__device__ __forceinline__ unsigned cvt_pk_bf16(float lo, float hi) { unsigned r; asm volatile("v_cvt_pk_bf16_f32 %0, %1, %2" : "=v"(r) : "v"(lo), "v"(hi)); return r; }
typedef float f32x2 __attribute__((ext_vector_type(2)));

template <class E, class = void> struct probe_of { static constexpr int v = 0; };
template <class E> struct probe_of<E, decltype((void)E::PROBE)> { static constexpr int v = E::PROBE; };
template <class Epi, class Sched, bool ALIGN_EPI = false, bool SP2 = false, bool F8 = false, int MIXT = 0, bool KROT = false, bool PFETCH = false>
__device__ __forceinline__ void gemm_phase(PG8_LAS unsigned char* lds, const Gemm g, const Sched& S, const Epi& E, const int wave_) {
    int tid_ = wave_ * 64 + pg8_lane(); asm volatile("" : "+v"(tid_));
    const int tid = tid_, wid = __builtin_amdgcn_readfirstlane(tid >> 6), lane = tid & 63, wr = wid >> 2, wc = wid & 3, fr = lane & 15, fq = lane >> 4;
    const int K = g.K, nt = K / BK;
    unsigned voffA[2], voffB[2];
#pragma unroll
    for (int i = 0; i < 2; ++i) { int R, C; stage_rc(tid * 16 + i * 8192, R, C); const int Rb = Epi::PERM ? ((R & ~31) + perm32(R & 31)) : R;
        voffA[i] = (unsigned)(R * g.lda + C) * 2u; voffB[i] = (unsigned)(Rb * g.ldb + C) * 2u; }
    const size_t kstep = (size_t)(BK * 2);
    const size_t hstepA = (size_t)HALF * g.lda * 2, hstepB = (size_t)HALF * g.ldb * 2;
    const size_t tstepA = 2 * hstepA, tstepB = 2 * hstepB;
    const unsigned ldsw = (unsigned)wid * 1024u;
    unsigned pfoff = 0;
    if constexpr (PFETCH) { const int prow = wid * 32 + (lane & 31); pfoff = (lane < 32) ? (unsigned)(prow * g.lda) * 2u : (unsigned)(prow * g.ldb) * 2u; }
    PG8_LAS unsigned* const pfl = (PG8_LAS unsigned*)(lds + RING_BYTES + 8192 + wid * 256);
#define PG8_PF(baseA_, baseB_) do { if constexpr (PFETCH) { const char* pb_ = (lane < 32) ? (const char*)(baseA_) : (const char*)(baseB_); \
        __builtin_amdgcn_global_load_lds((const unsigned*)(pb_ + pfoff), pfl, 4, 0, 0); } } while (0)
#define PG8_WV1 do { if constexpr (PFETCH) PG8_WAIT_V(9); else PG8_WAIT_V(8); } while (0)
#define PG8_WV2 do { if constexpr (PFETCH) PG8_WAIT_V(10); else PG8_WAIT_V(8); } while (0)
    const int aoff = lds_byte(wr * 64 + fr, fq * 8), boff = lds_byte(wc * 32 + fr, fq * 8);
#define PG8_SA(b, h) (((b) * 2 + (h)) * HTB)
#define PG8_SB(b, h) ((4 + (b) * 2 + (h)) * HTB)
#define PG8_STAGE(bufoff, gbase, voff) do { if constexpr (probe_of<Epi>::v != 3) _Pragma("unroll") for (int _i = 0; _i < 2; ++_i) \
        __builtin_amdgcn_global_load_lds((const unsigned*)((const char*)(gbase) + (voff)[_i]), (PG8_LAS unsigned*)(lds + (bufoff) + ldsw + _i * 8192), 16, 0, STAGE_AUX); } while (0)
#define PG8_LDA(dst, b, h) do { if constexpr (probe_of<Epi>::v != 2) _Pragma("unroll") for (int m = 0; m < 4; ++m) _Pragma("unroll") for (int k = 0; k < 2; ++k) dst[m][k] = *(const PG8_LAS bf16x8*)(lds + PG8_SA(b, h) + aoff + m * 2048 + k * 1024); } while (0)
#define PG8_LDB(dst, b, h) do { if constexpr (probe_of<Epi>::v != 2) _Pragma("unroll") for (int n = 0; n < 2; ++n) _Pragma("unroll") for (int k = 0; k < 2; ++k) dst[n][k] = *(const PG8_LAS bf16x8*)(lds + PG8_SB(b, h) + boff + n * 2048 + k * 1024); } while (0)
#define PG8_MMA(ai, bj, At, Bt) do { __builtin_amdgcn_s_setprio(1); \
        if (F8 || (MIXT > 0 && f8now)) { _Pragma("unroll") for (int m = 0; m < 4; ++m) _Pragma("unroll") for (int n = 0; n < 2; ++n) { \
            const i32x8 a8_ = __builtin_shufflevector(__builtin_bit_cast(i32x4, At[m][0]), __builtin_bit_cast(i32x4, At[m][1]), 0, 1, 2, 3, 4, 5, 6, 7); \
            const i32x8 b8_ = __builtin_shufflevector(__builtin_bit_cast(i32x4, Bt[n][0]), __builtin_bit_cast(i32x4, Bt[n][1]), 0, 1, 2, 3, 4, 5, 6, 7); \
            if constexpr (probe_of<Epi>::v == 0 || probe_of<Epi>::v == 3) asm volatile("v_mfma_scale_f32_16x16x128_f8f6f4 %0, %1, %2, %0, %3, %4 op_sel_hi:[0,0,0]" : "+v"(acc[ai][bj][m][n]) : "v"(b8_), "v"(a8_), "v"(sw_), "v"(sx_)); \
            else asm volatile("" :: "v"(b8_), "v"(a8_)); } } \
        else { _Pragma("unroll") for (int m = 0; m < 4; ++m) _Pragma("unroll") for (int n = 0; n < 2; ++n) _Pragma("unroll") for (int k = 0; k < 2; ++k) \
            acc[ai][bj][m][n] = __builtin_amdgcn_mfma_f32_16x16x32_bf16(Bt[n][k], At[m][k], acc[ai][bj][m][n], 0, 0, 0); } \
        __builtin_amdgcn_s_setprio(0); } while (0)
#define PG8_STAGE1(bufoff, gbase, voff, i_) __builtin_amdgcn_global_load_lds((const unsigned*)((const char*)(gbase) + (voff)[i_]), (PG8_LAS unsigned*)(lds + (bufoff) + ldsw + (i_) * 8192), 16, 0, 0)
#define PG8_MMAS(ai, bj, At, Bt, M0, S0, M1, S1) do { __builtin_amdgcn_s_setprio(1); \
        if (F8 || (MIXT > 0 && f8now)) { _Pragma("unroll") for (int m = 0; m < 4; ++m) { _Pragma("unroll") for (int n = 0; n < 2; ++n) { \
            const i32x8 a8_ = __builtin_shufflevector(__builtin_bit_cast(i32x4, At[m][0]), __builtin_bit_cast(i32x4, At[m][1]), 0, 1, 2, 3, 4, 5, 6, 7); \
            const i32x8 b8_ = __builtin_shufflevector(__builtin_bit_cast(i32x4, Bt[n][0]), __builtin_bit_cast(i32x4, Bt[n][1]), 0, 1, 2, 3, 4, 5, 6, 7); \
            if constexpr (probe_of<Epi>::v == 0 || probe_of<Epi>::v == 3) asm volatile("v_mfma_scale_f32_16x16x128_f8f6f4 %0, %1, %2, %0, %3, %4 op_sel_hi:[0,0,0]" : "+v"(acc[ai][bj][m][n]) : "v"(b8_), "v"(a8_), "v"(sw_), "v"(sx_)); \
            else asm volatile("" :: "v"(b8_), "v"(a8_)); } \
            if (m == (M0)) { PG8_SCHED; S0; PG8_SCHED; } if (m == (M1)) { PG8_SCHED; S1; PG8_SCHED; } } } \
        else { _Pragma("unroll") for (int m = 0; m < 4; ++m) { _Pragma("unroll") for (int n = 0; n < 2; ++n) _Pragma("unroll") for (int k = 0; k < 2; ++k) \
            acc[ai][bj][m][n] = __builtin_amdgcn_mfma_f32_16x16x32_bf16(Bt[n][k], At[m][k], acc[ai][bj][m][n], 0, 0, 0); \
            if (m == (M0)) { PG8_SCHED; S0; PG8_SCHED; } if (m == (M1)) { PG8_SCHED; S1; PG8_SCHED; } } } \
        __builtin_amdgcn_s_setprio(0); } while (0)
#define PG8_WAIT_V(n) asm volatile("s_waitcnt vmcnt(" #n ")" ::: "memory")
#define PG8_WAIT_L(n) asm volatile("s_waitcnt lgkmcnt(" #n ")" ::: "memory")
#define PG8_BAR __builtin_amdgcn_s_barrier()
#define PG8_SCHED __builtin_amdgcn_sched_barrier(0)
    Unit cur, nxt; int ui = 0;
    if (!S.next(0, cur)) return;
    f32x4 acc[2][2][4][2];
#pragma unroll
    for (int a = 0; a < 2; ++a)
#pragma unroll
        for (int b = 0; b < 2; ++b)
#pragma unroll
            for (int m = 0; m < 4; ++m)
#pragma unroll
                for (int n = 0; n < 2; ++n) acc[a][b][m][n] = (f32x4){0.f, 0.f, 0.f, 0.f};
    bf16x8 At[4][2], B0[2][2], B1[2][2];
    if constexpr (probe_of<Epi>::v == 2) {
#pragma unroll
        for (int m = 0; m < 4; ++m)
#pragma unroll
            for (int k = 0; k < 2; ++k) At[m][k] = (bf16x8){0, 0, 0, 0, 0, 0, 0, 0};
#pragma unroll
        for (int n = 0; n < 2; ++n)
#pragma unroll
            for (int k = 0; k < 2; ++k) { B0[n][k] = (bf16x8){0, 0, 0, 0, 0, 0, 0, 0}; B1[n][k] = (bf16x8){0, 0, 0, 0, 0, 0, 0, 0}; }
    }
    const int sw_ = (int)g.sw, sx_ = (int)g.sx;
    const char* cA = (const char*)g.A + (size_t)cur.pm * tstepA; const char* cB = (const char*)g.Bt + (size_t)cur.pn * tstepB;
    const int krs = (KROT && MIXT == 0 && !Epi::KSEG && (nt & 15) == 0) ? (nt >> 3) : 0;
    int ckr = krs * (cur.kr & 7);
    const char* const pA = cA + (size_t)ckr * kstep; const char* const pB = cB + (size_t)ckr * kstep;
    S.a_ready(cur);
    if constexpr (SP2) {
        PG8_STAGE(PG8_SB(0, 0), pB, voffB); PG8_STAGE(PG8_SB(0, 1), pB + hstepB, voffB); PG8_STAGE(PG8_SA(0, 0), pA, voffA); PG8_STAGE(PG8_SA(0, 1), pA + hstepA, voffA);
        if (wr == 1) PG8_BAR;
        PG8_WAIT_V(2); PG8_BAR;
        PG8_STAGE(PG8_SB(1, 0), pB + kstep, voffB); PG8_STAGE(PG8_SA(1, 0), pA + kstep, voffA); PG8_STAGE(PG8_SB(1, 1), pB + hstepB + kstep, voffB);
        PG8_PF(pA + 2 * kstep, pB + 2 * kstep);
        if constexpr (PFETCH) PG8_WAIT_V(7); else PG8_WAIT_V(6);
        PG8_BAR;
    } else {
        PG8_STAGE(PG8_SB(0, 0), pB, voffB); PG8_STAGE(PG8_SA(0, 0), pA, voffA); PG8_STAGE(PG8_SB(0, 1), pB + hstepB, voffB); PG8_STAGE(PG8_SA(0, 1), pA + hstepA, voffA);
        if (wr == 1) PG8_BAR;
        PG8_WAIT_V(4); PG8_BAR;
        PG8_STAGE(PG8_SB(1, 0), pB + kstep, voffB); PG8_STAGE(PG8_SA(1, 0), pA + kstep, voffA); PG8_STAGE(PG8_SB(1, 1), pB + hstepB + kstep, voffB);
        PG8_WAIT_V(6); PG8_BAR;
    }
    for (;;) {
        const bool has_next = S.next(ui + 1, nxt);
        const char* nA = has_next ? (const char*)g.A + (size_t)nxt.pm * tstepA : cA; const char* nB = has_next ? (const char*)g.Bt + (size_t)nxt.pn * tstepB : cB;
        const int nkr = has_next ? krs * (nxt.kr & 7) : ckr;
        for (int t = 0; t < (MIXT > 0 ? MIXT : nt); t += 2) {
            constexpr bool f8now = false; (void)f8now;
            const bool last = (t == nt - 2);
            if constexpr (Epi::KSEG) { if (t == Epi::KSEG_T1 || t == Epi::KSEG_T2) { if constexpr (F8 || MIXT > 0) asm volatile("s_nop 15\n\ts_nop 15" ::: "memory"); E.kseg(acc, cur, t, wr, wc, fr, fq); } }
            int r0 = t + ckr; if (r0 >= nt) r0 -= nt; int r2 = r0 + 2; if (r2 >= nt) r2 -= nt;
            const char* a1 = cA + (size_t)(r0 + 1) * kstep;
            const char* a2 = last ? nA + (size_t)nkr * kstep : cA + (size_t)r2 * kstep; const char* b2 = last ? nB + (size_t)nkr * kstep : cB + (size_t)r2 * kstep;
            const char* a3 = a2 + kstep; const char* b3 = b2 + kstep;
            int r4 = t + 4, k4 = ckr; const char* pfa4 = cA; const char* pfb4 = cB;
            if (r4 >= nt) { r4 -= nt; k4 = nkr; pfa4 = nA; pfb4 = nB; }
            r4 += k4; if (r4 >= nt) r4 -= nt;
            pfa4 += (size_t)r4 * kstep; pfb4 += (size_t)r4 * kstep;
            if (last && has_next) S.a_ready(nxt);
            if constexpr (SP2) {
#if STAGE_IN_MMA
            PG8_LDB(B0, 0, 0); PG8_LDB(B1, 0, 1); PG8_SCHED; PG8_LDA(At, 0, 0);
            PG8_WAIT_V(6); PG8_WAIT_L(0); PG8_BAR;
            PG8_MMAS(0, 0, At, B0, 1, PG8_STAGE1(PG8_SA(1, 1), a1 + hstepA, voffA, 0), 9, (void)0); PG8_MMAS(0, 1, At, B1, 1, PG8_STAGE1(PG8_SA(1, 1), a1 + hstepA, voffA, 1), 9, (void)0); PG8_BAR; PG8_SCHED;
            PG8_LDA(At, 0, 1); PG8_STAGE(PG8_SB(0, 0), b2, voffB);
            PG8_WAIT_V(4); PG8_WAIT_L(0); PG8_BAR;
            PG8_MMAS(1, 0, At, B0, 0, PG8_STAGE1(PG8_SB(0, 1), b2 + hstepB, voffB, 0), 2, PG8_STAGE1(PG8_SB(0, 1), b2 + hstepB, voffB, 1));
            PG8_MMAS(1, 1, At, B1, 0, PG8_STAGE1(PG8_SA(0, 0), a2, voffA, 0), 2, PG8_STAGE1(PG8_SA(0, 0), a2, voffA, 1)); PG8_BAR; PG8_SCHED;
            PG8_LDB(B0, 1, 0); PG8_LDB(B1, 1, 1); PG8_SCHED; PG8_LDA(At, 1, 0);
            PG8_WAIT_V(6); PG8_WAIT_L(0); PG8_BAR;
            PG8_MMAS(0, 0, At, B0, 1, PG8_STAGE1(PG8_SA(0, 1), a2 + hstepA, voffA, 0), 9, (void)0); PG8_MMAS(0, 1, At, B1, 1, PG8_STAGE1(PG8_SA(0, 1), a2 + hstepA, voffA, 1), 9, (void)0); PG8_BAR; PG8_SCHED;
            PG8_LDA(At, 1, 1); PG8_STAGE(PG8_SB(1, 0), b3, voffB);
            PG8_WAIT_V(4); PG8_WAIT_L(0); PG8_BAR;
            PG8_MMAS(1, 0, At, B0, 0, PG8_STAGE1(PG8_SB(1, 1), b3 + hstepB, voffB, 0), 2, PG8_STAGE1(PG8_SB(1, 1), b3 + hstepB, voffB, 1));
            PG8_MMAS(1, 1, At, B1, 0, PG8_STAGE1(PG8_SA(1, 0), a3, voffA, 0), 2, PG8_STAGE1(PG8_SA(1, 0), a3, voffA, 1)); PG8_BAR; PG8_SCHED;
#else
            PG8_LDB(B0, 0, 0); PG8_LDB(B1, 0, 1); PG8_SCHED; PG8_LDA(At, 0, 0); PG8_STAGE(PG8_SA(1, 1), a1 + hstepA, voffA);
            PG8_WV1; PG8_WAIT_L(0); PG8_BAR; PG8_MMA(0, 0, At, B0); PG8_MMA(0, 1, At, B1); PG8_BAR; PG8_SCHED;
            PG8_LDA(At, 0, 1); PG8_STAGE(PG8_SB(0, 0), b2, voffB); PG8_STAGE(PG8_SB(0, 1), b2 + hstepB, voffB); PG8_STAGE(PG8_SA(0, 0), a2, voffA); PG8_PF(pfa4, pfb4);
            PG8_WV2; PG8_WAIT_L(0); PG8_BAR; PG8_MMA(1, 0, At, B0); PG8_MMA(1, 1, At, B1); PG8_BAR; PG8_SCHED;
            PG8_LDB(B0, 1, 0); PG8_LDB(B1, 1, 1); PG8_SCHED; PG8_LDA(At, 1, 0); PG8_STAGE(PG8_SA(0, 1), a2 + hstepA, voffA);
            PG8_WV1; PG8_WAIT_L(0); PG8_BAR; PG8_MMA(0, 0, At, B0); PG8_MMA(0, 1, At, B1); PG8_BAR; PG8_SCHED;
            PG8_LDA(At, 1, 1); PG8_STAGE(PG8_SB(1, 0), b3, voffB); PG8_STAGE(PG8_SB(1, 1), b3 + hstepB, voffB); PG8_STAGE(PG8_SA(1, 0), a3, voffA); PG8_PF(pfa4 + kstep, pfb4 + kstep);
            PG8_WV2; PG8_WAIT_L(0); PG8_BAR; PG8_MMA(1, 0, At, B0); PG8_MMA(1, 1, At, B1); PG8_BAR; PG8_SCHED;
#endif
            } else {
            PG8_LDB(B0, 0, 0); PG8_SCHED; PG8_LDA(At, 0, 0); PG8_STAGE(PG8_SA(1, 1), a1 + hstepA, voffA);
            PG8_WAIT_L(8); PG8_BAR; PG8_WAIT_L(0); PG8_MMA(0, 0, At, B0); PG8_BAR; PG8_SCHED;
            PG8_LDB(B1, 0, 1); PG8_STAGE(PG8_SB(0, 0), b2, voffB);
            PG8_BAR; PG8_WAIT_L(0); PG8_MMA(0, 1, At, B1); PG8_BAR;
            PG8_LDA(At, 0, 1); PG8_STAGE(PG8_SA(0, 0), a2, voffA);
            PG8_BAR; PG8_WAIT_L(0); PG8_MMA(1, 0, At, B0); PG8_BAR; PG8_SCHED;
            PG8_STAGE(PG8_SB(0, 1), b2 + hstepB, voffB);
            PG8_WAIT_V(6); PG8_BAR; PG8_MMA(1, 1, At, B1); PG8_BAR;
            PG8_LDB(B0, 1, 0); PG8_SCHED; PG8_LDA(At, 1, 0); PG8_STAGE(PG8_SA(0, 1), a2 + hstepA, voffA);
            PG8_WAIT_L(8); PG8_BAR; PG8_WAIT_L(0); PG8_MMA(0, 0, At, B0); PG8_BAR; PG8_SCHED;
            PG8_LDB(B1, 1, 1); PG8_STAGE(PG8_SB(1, 0), b3, voffB);
            PG8_BAR; PG8_WAIT_L(0); PG8_MMA(0, 1, At, B1); PG8_BAR;
            PG8_LDA(At, 1, 1); PG8_STAGE(PG8_SA(1, 0), a3, voffA);
            PG8_BAR; PG8_WAIT_L(0); PG8_MMA(1, 0, At, B0); PG8_BAR; PG8_SCHED;
            PG8_STAGE(PG8_SB(1, 1), b3 + hstepB, voffB);
            PG8_WAIT_V(6); PG8_BAR; PG8_MMA(1, 1, At, B1); PG8_BAR;
            }
                }
        if constexpr (MIXT > 0) for (int t = MIXT; t < nt; t += 2) {
            constexpr bool f8now = true; (void)f8now;
            const bool last = (t == nt - 2);
            if constexpr (Epi::KSEG) { if (t == Epi::KSEG_T1 || t == Epi::KSEG_T2) { if constexpr (F8 || MIXT > 0) asm volatile("s_nop 15\n\ts_nop 15" ::: "memory"); E.kseg(acc, cur, t, wr, wc, fr, fq); } }
            int r0 = t + ckr; if (r0 >= nt) r0 -= nt; int r2 = r0 + 2; if (r2 >= nt) r2 -= nt;
            const char* a1 = cA + (size_t)(r0 + 1) * kstep;
            const char* a2 = last ? nA + (size_t)nkr * kstep : cA + (size_t)r2 * kstep; const char* b2 = last ? nB + (size_t)nkr * kstep : cB + (size_t)r2 * kstep;
            const char* a3 = a2 + kstep; const char* b3 = b2 + kstep;
            int r4 = t + 4, k4 = ckr; const char* pfa4 = cA; const char* pfb4 = cB;
            if (r4 >= nt) { r4 -= nt; k4 = nkr; pfa4 = nA; pfb4 = nB; }
            r4 += k4; if (r4 >= nt) r4 -= nt;
            pfa4 += (size_t)r4 * kstep; pfb4 += (size_t)r4 * kstep;
            if (last && has_next) S.a_ready(nxt);
            if constexpr (SP2) {
#if STAGE_IN_MMA
            PG8_LDB(B0, 0, 0); PG8_LDB(B1, 0, 1); PG8_SCHED; PG8_LDA(At, 0, 0);
            PG8_WAIT_V(6); PG8_WAIT_L(0); PG8_BAR;
            PG8_MMAS(0, 0, At, B0, 1, PG8_STAGE1(PG8_SA(1, 1), a1 + hstepA, voffA, 0), 9, (void)0); PG8_MMAS(0, 1, At, B1, 1, PG8_STAGE1(PG8_SA(1, 1), a1 + hstepA, voffA, 1), 9, (void)0); PG8_BAR; PG8_SCHED;
            PG8_LDA(At, 0, 1); PG8_STAGE(PG8_SB(0, 0), b2, voffB);
            PG8_WAIT_V(4); PG8_WAIT_L(0); PG8_BAR;
            PG8_MMAS(1, 0, At, B0, 0, PG8_STAGE1(PG8_SB(0, 1), b2 + hstepB, voffB, 0), 2, PG8_STAGE1(PG8_SB(0, 1), b2 + hstepB, voffB, 1));
            PG8_MMAS(1, 1, At, B1, 0, PG8_STAGE1(PG8_SA(0, 0), a2, voffA, 0), 2, PG8_STAGE1(PG8_SA(0, 0), a2, voffA, 1)); PG8_BAR; PG8_SCHED;
            PG8_LDB(B0, 1, 0); PG8_LDB(B1, 1, 1); PG8_SCHED; PG8_LDA(At, 1, 0);
            PG8_WAIT_V(6); PG8_WAIT_L(0); PG8_BAR;
            PG8_MMAS(0, 0, At, B0, 1, PG8_STAGE1(PG8_SA(0, 1), a2 + hstepA, voffA, 0), 9, (void)0); PG8_MMAS(0, 1, At, B1, 1, PG8_STAGE1(PG8_SA(0, 1), a2 + hstepA, voffA, 1), 9, (void)0); PG8_BAR; PG8_SCHED;
            PG8_LDA(At, 1, 1); PG8_STAGE(PG8_SB(1, 0), b3, voffB);
            PG8_WAIT_V(4); PG8_WAIT_L(0); PG8_BAR;
            PG8_MMAS(1, 0, At, B0, 0, PG8_STAGE1(PG8_SB(1, 1), b3 + hstepB, voffB, 0), 2, PG8_STAGE1(PG8_SB(1, 1), b3 + hstepB, voffB, 1));
            PG8_MMAS(1, 1, At, B1, 0, PG8_STAGE1(PG8_SA(1, 0), a3, voffA, 0), 2, PG8_STAGE1(PG8_SA(1, 0), a3, voffA, 1)); PG8_BAR; PG8_SCHED;
#else
            PG8_LDB(B0, 0, 0); PG8_LDB(B1, 0, 1); PG8_SCHED; PG8_LDA(At, 0, 0); PG8_STAGE(PG8_SA(1, 1), a1 + hstepA, voffA);
            PG8_WV1; PG8_WAIT_L(0); PG8_BAR; PG8_MMA(0, 0, At, B0); PG8_MMA(0, 1, At, B1); PG8_BAR; PG8_SCHED;
            PG8_LDA(At, 0, 1); PG8_STAGE(PG8_SB(0, 0), b2, voffB); PG8_STAGE(PG8_SB(0, 1), b2 + hstepB, voffB); PG8_STAGE(PG8_SA(0, 0), a2, voffA); PG8_PF(pfa4, pfb4);
            PG8_WV2; PG8_WAIT_L(0); PG8_BAR; PG8_MMA(1, 0, At, B0); PG8_MMA(1, 1, At, B1); PG8_BAR; PG8_SCHED;
            PG8_LDB(B0, 1, 0); PG8_LDB(B1, 1, 1); PG8_SCHED; PG8_LDA(At, 1, 0); PG8_STAGE(PG8_SA(0, 1), a2 + hstepA, voffA);
            PG8_WV1; PG8_WAIT_L(0); PG8_BAR; PG8_MMA(0, 0, At, B0); PG8_MMA(0, 1, At, B1); PG8_BAR; PG8_SCHED;
            PG8_LDA(At, 1, 1); PG8_STAGE(PG8_SB(1, 0), b3, voffB); PG8_STAGE(PG8_SB(1, 1), b3 + hstepB, voffB); PG8_STAGE(PG8_SA(1, 0), a3, voffA); PG8_PF(pfa4 + kstep, pfb4 + kstep);
            PG8_WV2; PG8_WAIT_L(0); PG8_BAR; PG8_MMA(1, 0, At, B0); PG8_MMA(1, 1, At, B1); PG8_BAR; PG8_SCHED;
#endif
            } else {
            PG8_LDB(B0, 0, 0); PG8_SCHED; PG8_LDA(At, 0, 0); PG8_STAGE(PG8_SA(1, 1), a1 + hstepA, voffA);
            PG8_WAIT_L(8); PG8_BAR; PG8_WAIT_L(0); PG8_MMA(0, 0, At, B0); PG8_BAR; PG8_SCHED;
            PG8_LDB(B1, 0, 1); PG8_STAGE(PG8_SB(0, 0), b2, voffB);
            PG8_BAR; PG8_WAIT_L(0); PG8_MMA(0, 1, At, B1); PG8_BAR;
            PG8_LDA(At, 0, 1); PG8_STAGE(PG8_SA(0, 0), a2, voffA);
            PG8_BAR; PG8_WAIT_L(0); PG8_MMA(1, 0, At, B0); PG8_BAR; PG8_SCHED;
            PG8_STAGE(PG8_SB(0, 1), b2 + hstepB, voffB);
            PG8_WAIT_V(6); PG8_BAR; PG8_MMA(1, 1, At, B1); PG8_BAR;
            PG8_LDB(B0, 1, 0); PG8_SCHED; PG8_LDA(At, 1, 0); PG8_STAGE(PG8_SA(0, 1), a2 + hstepA, voffA);
            PG8_WAIT_L(8); PG8_BAR; PG8_WAIT_L(0); PG8_MMA(0, 0, At, B0); PG8_BAR; PG8_SCHED;
            PG8_LDB(B1, 1, 1); PG8_STAGE(PG8_SB(1, 0), b3, voffB);
            PG8_BAR; PG8_WAIT_L(0); PG8_MMA(0, 1, At, B1); PG8_BAR;
            PG8_LDA(At, 1, 1); PG8_STAGE(PG8_SA(1, 0), a3, voffA);
            PG8_BAR; PG8_WAIT_L(0); PG8_MMA(1, 0, At, B0); PG8_BAR; PG8_SCHED;
            PG8_STAGE(PG8_SB(1, 1), b3 + hstepB, voffB);
            PG8_WAIT_V(6); PG8_BAR; PG8_MMA(1, 1, At, B1); PG8_BAR;
            }
                }
        if constexpr (ALIGN_EPI) { if (wr == 0) PG8_BAR; }
        if constexpr (F8 || MIXT > 0) asm volatile("s_nop 15\n\ts_nop 15" ::: "memory");
        if constexpr (!Epi::AFTER_DRAIN) { E(acc, cur, wr, wc, fr, fq); S.done(cur); }
        if (!has_next) break;
#pragma unroll
        for (int a = 0; a < 2; ++a)
#pragma unroll
            for (int b = 0; b < 2; ++b)
#pragma unroll
                for (int m = 0; m < 4; ++m)
#pragma unroll
                    for (int n = 0; n < 2; ++n) acc[a][b][m][n] = (f32x4){0.f, 0.f, 0.f, 0.f};
        cur = nxt; cA = nA; cB = nB; ckr = nkr; ++ui;
        if constexpr (ALIGN_EPI) { if (wr == 1) PG8_BAR; }
    }
    PG8_WAIT_V(0);
    if constexpr (!ALIGN_EPI) { if (wr == 0) PG8_BAR; }
    PG8_BAR;
    if constexpr (Epi::AFTER_DRAIN) { E.fused(acc, cur, wr, wc, fr, fq, lds, wid, lane); S.done(cur); }
#undef PG8_SA
#undef PG8_SB
#undef PG8_STAGE
#undef PG8_PF
#undef PG8_WV1
#undef PG8_WV2
#undef PG8_LDA
#undef PG8_LDB
#undef PG8_MMA
#undef PG8_MMAS
#undef PG8_STAGE1
#undef PG8_WAIT_V
#undef PG8_WAIT_L
#undef PG8_BAR
#undef PG8_SCHED
}
}
namespace pg8 {
__device__ __forceinline__ float sigm(float z) { return __builtin_amdgcn_rcpf(1.0f + __builtin_amdgcn_exp2f(-z * 1.4426950408889634f)); }
typedef unsigned u32x2 __attribute__((ext_vector_type(2)));
__device__ __forceinline__ unsigned pk4f8(const f32x4 v) { int r = __builtin_amdgcn_cvt_pk_fp8_f32(v[0], v[1], 0, false); r = __builtin_amdgcn_cvt_pk_fp8_f32(v[2], v[3], r, true); return (unsigned)r; }
__device__ __forceinline__ u32x4 pack8(const f32x4 v0, const f32x4 v1) { u32x4 w; w.x = cvt_pk_bf16(v0[0], v0[1]); w.y = cvt_pk_bf16(v0[2], v0[3]); w.z = cvt_pk_bf16(v1[0], v1[1]); w.w = cvt_pk_bf16(v1[2], v1[3]); return w; }
__device__ __forceinline__ f32x4 bf_lo4(const u32x4 w) { f32x4 r; r[0] = __uint_as_float(w.x << 16); r[1] = __uint_as_float(w.x & 0xffff0000u); r[2] = __uint_as_float(w.y << 16); r[3] = __uint_as_float(w.y & 0xffff0000u); return r; }
__device__ __forceinline__ f32x4 bf_hi4(const u32x4 w) { f32x4 r; r[0] = __uint_as_float(w.z << 16); r[1] = __uint_as_float(w.z & 0xffff0000u); r[2] = __uint_as_float(w.w << 16); r[3] = __uint_as_float(w.w & 0xffff0000u); return r; }


struct EpiP1 {
    static constexpr bool PERM = true, AFTER_DRAIN = false, KSEG = false;
    bf16_t* P1; bf16_t* MKV; const float* bgate;
    __device__ __forceinline__ void operator()(const f32x4 (&acc)[2][2][4][2], const Unit& u, int wr, int wc, int fr, int fq) const {
        const bool mem = u.pn >= 41, gate = (!mem) && u.pn >= 17;
        bf16_t* base = mem ? MKV + (size_t)((u.pm - 64) * BM + wr * 64 + fr) * 2048 + (u.pn - 41) * BM : P1 + (size_t)(u.pm * BM + wr * 64 + fr) * 10496 + u.pn * BM;
        const size_t ldc = mem ? 2048 : 10496;
        base += wc * 32 + 8 * fq;
        f32x4 bv[2][2];
#pragma unroll
        for (int bj = 0; bj < 2; ++bj)
#pragma unroll
            for (int n = 0; n < 2; ++n) bv[bj][n] = gate ? *(const f32x4*)(bgate + (u.pn - 17) * BM + wc * 32 + 8 * fq + bj * HALF + 4 * n) : (f32x4){0.f, 0.f, 0.f, 0.f};
#pragma unroll
        for (int ai = 0; ai < 2; ++ai)
#pragma unroll
            for (int m = 0; m < 4; ++m) { bf16_t* rowp = base + (size_t)(ai * HALF + m * 16) * ldc;
#pragma unroll
                for (int bj = 0; bj < 2; ++bj) { f32x4 v0 = acc[ai][bj][m][0] + bv[bj][0], v1 = acc[ai][bj][m][1] + bv[bj][1];
                    if (gate) {
#pragma unroll
                        for (int i = 0; i < 4; ++i) { v0[i] = sigm(v0[i]); v1[i] = sigm(v1[i]); } }
                    *(u32x4*)(rowp + bj * HALF) = pack8(v0, v1); } }
    }
};
struct EpiGate {
    static constexpr bool PERM = true, AFTER_DRAIN = false, KSEG = false;
    bf16_t* P1; const float* bgate;
    __device__ __forceinline__ void operator()(const f32x4 (&acc)[2][2][4][2], const Unit& u, int wr, int wc, int fr, int fq) const {
        bf16_t* base = P1 + (size_t)(u.pm * BM + wr * 64 + fr) * 10496 + 4352 + u.pn * BM + wc * 32 + 8 * fq;
        f32x4 bv[2][2];
#pragma unroll
        for (int bj = 0; bj < 2; ++bj)
#pragma unroll
            for (int n = 0; n < 2; ++n) bv[bj][n] = *(const f32x4*)(bgate + u.pn * BM + wc * 32 + 8 * fq + bj * HALF + 4 * n);
#pragma unroll
        for (int ai = 0; ai < 2; ++ai)
#pragma unroll
            for (int m = 0; m < 4; ++m) { bf16_t* rowp = base + (size_t)(ai * HALF + m * 16) * 10496;
#pragma unroll
                for (int bj = 0; bj < 2; ++bj) { f32x4 v0 = acc[ai][bj][m][0] + bv[bj][0], v1 = acc[ai][bj][m][1] + bv[bj][1];
#pragma unroll
                    for (int i = 0; i < 4; ++i) { v0[i] = sigm(v0[i]); v1[i] = sigm(v1[i]); }
                    *(u32x4*)(rowp + bj * HALF) = pack8(v0, v1); } }
    }
};
struct EpiPlain {
    static constexpr bool PERM = true, AFTER_DRAIN = false, KSEG = false;
    bf16_t* O; int ldc;
    __device__ __forceinline__ void operator()(const f32x4 (&acc)[2][2][4][2], const Unit& u, int wr, int wc, int fr, int fq) const {
        bf16_t* base = O + (size_t)(u.pm * BM + wr * 64 + fr) * ldc + u.pn * BM + wc * 32 + 8 * fq;
#pragma unroll
        for (int ai = 0; ai < 2; ++ai)
#pragma unroll
            for (int m = 0; m < 4; ++m) { bf16_t* rowp = base + (size_t)(ai * HALF + m * 16) * ldc;
#pragma unroll
                for (int bj = 0; bj < 2; ++bj) *(u32x4*)(rowp + bj * HALF) = pack8(acc[ai][bj][m][0], acc[ai][bj][m][1]); }
    }
};
template <bool FIRST> struct EpiGateAcc {
    static constexpr bool PERM = true, AFTER_DRAIN = false, KSEG = false;
    const bf16_t* G; int gcol0; bf16_t* Mg;
    __device__ __forceinline__ void operator()(const f32x4 (&acc)[2][2][4][2], const Unit& u, int wr, int wc, int fr, int fq) const {
        const int row0 = u.pm * BM + wr * 64 + fr, col0 = u.pn * BM + wc * 32 + 8 * fq;
#pragma unroll
        for (int ai = 0; ai < 2; ++ai)
#pragma unroll
            for (int m = 0; m < 4; ++m) { const size_t r = (size_t)(row0 + ai * HALF + m * 16);
#pragma unroll
                for (int bj = 0; bj < 2; ++bj) {
                    const u32x4 gw = *(const u32x4*)(G + r * 10496 + gcol0 + col0 + bj * HALF);
                    f32x4 v0 = acc[ai][bj][m][0] * bf_lo4(gw), v1 = acc[ai][bj][m][1] * bf_hi4(gw);
                    bf16_t* mp = Mg + r * 2048 + col0 + bj * HALF;
                    if (!FIRST) { const u32x4 ow = *(const u32x4*)mp; v0 = v0 + bf_lo4(ow); v1 = v1 + bf_hi4(ow); }
                    *(u32x4*)mp = pack8(v0, v1); } }
    }
};
__device__ __forceinline__ float rowsq8(const f32x4 a, const f32x4 b) { return (a[0] * a[0] + a[1] * a[1]) + (a[2] * a[2] + a[3] * a[3]) + (b[0] * b[0] + b[1] * b[1]) + (b[2] * b[2] + b[3] * b[3]); }
struct EpiKV {
    static constexpr bool PERM = true, AFTER_DRAIN = false, KSEG = false;
    PG8_LAS float* P; const float* kn_g; const float* krss; const float* krr; bf16_t* KFT; bf16_t* VFT;
    __device__ __forceinline__ void operator()(const f32x4 (&acc)[2][2][4][2], const Unit& u, int wr, int wc, int fr, int fq) const {
        asm volatile("" : "+v"(fr), "+v"(fq));
        const int h = u.pn, b = u.pm >> 4, tq = (u.pm & 15) * 4;
#pragma unroll
        for (int ai = 0; ai < 2; ++ai)
#pragma unroll
            for (int m = 0; m < 4; ++m) { float s = rowsq8(acc[ai][0][m][0], acc[ai][0][m][1]); if (XL_FAST) s = xl_swap32_sum(xl_swap16_sum(s)); else { s += __shfl_xor(s, 16); s += __shfl_xor(s, 32); }
                if (fq == 0) P[(ai * HALF + wr * 64 + m * 16 + fr) * 4 + wc] = s; }
        asm volatile("s_waitcnt lgkmcnt(0)" ::: "memory"); __builtin_amdgcn_s_barrier(); asm volatile("" ::: "memory");
        const f32x4 g0 = *(const f32x4*)(kn_g + wc * 32 + 8 * fq), g1 = *(const f32x4*)(kn_g + wc * 32 + 8 * fq + 4);
#pragma unroll
        for (int ai = 0; ai < 2; ++ai)
#pragma unroll
            for (int m = 0; m < 4; ++m) { const int row = ai * HALF + wr * 64 + m * 16 + fr, key = m * 16 + fr; const size_t t = (size_t)u.pm * BM + row;
                const f32x4 p4 = *(const PG8_LAS f32x4*)(P + row * 4);
                const float rs = 1.0f * FAST_RSQ(((p4[0] + p4[1]) + (p4[2] + p4[3]) + krss[t]) * (1.f / 192.f) + 1e-6f);
                const size_t tile = (size_t)(b * 16 + h) * 64 + tq + 2 * ai + wr;
                bf16_t* kb = KFT + tile * 12288 + key * 8;
                *(u32x4*)(kb + (4 * wc + fq) * 512) = pack8(acc[ai][0][m][0] * g0 * rs, acc[ai][0][m][1] * g1 * rs);
                *(u32x4*)(VFT + tile * 8192 + wc * 2048 + key * 32 + 8 * fq) = pack8(acc[ai][1][m][0], acc[ai][1][m][1]);
                if (fq < 2) { const int c = 2 * wc + fq; const f32x4 r0 = *(const f32x4*)(krr + t * 64 + 8 * c), r1 = *(const f32x4*)(krr + t * 64 + 8 * c + 4);
                    *(u32x4*)(kb + (16 + c) * 512) = pack8(r0 * rs, r1 * rs); }
                asm volatile("" ::: "memory"); }
    }
};
struct EpiQ {
    static constexpr bool PERM = true, AFTER_DRAIN = false, KSEG = false;
    PG8_LAS float* P; const float* qn_g; const float* rope; bf16_t* QF; float qscale;
    __device__ __forceinline__ void operator()(const f32x4 (&acc)[2][2][4][2], const Unit& u, int wr, int wc, int fr, int fq) const {
        asm volatile("" : "+v"(fr), "+v"(fq));
        const int h = u.pn, b = u.pm >> 4;
#pragma unroll
        for (int ai = 0; ai < 2; ++ai)
#pragma unroll
            for (int m = 0; m < 4; ++m) { float s = rowsq8(acc[ai][0][m][0], acc[ai][0][m][1]); if (wc < 2) s += rowsq8(acc[ai][1][m][0], acc[ai][1][m][1]);
                if (XL_FAST) s = xl_swap32_sum(xl_swap16_sum(s)); else { s += __shfl_xor(s, 16); s += __shfl_xor(s, 32); }
                if (fq == 0) P[(ai * HALF + wr * 64 + m * 16 + fr) * 4 + wc] = s; }
        asm volatile("s_waitcnt lgkmcnt(0)" ::: "memory"); __builtin_amdgcn_s_barrier(); asm volatile("" ::: "memory");
        const f32x4 g0 = *(const f32x4*)(qn_g + wc * 32 + 8 * fq) * qscale, g1 = *(const f32x4*)(qn_g + wc * 32 + 8 * fq + 4) * qscale;
        const int j = 4 * (4 * (wc & 1) + fq);
        const f32x4 gr1 = *(const f32x4*)(qn_g + 128 + j) * qscale, gr2 = *(const f32x4*)(qn_g + 160 + j) * qscale;
#pragma unroll
        for (int ai = 0; ai < 2; ++ai)
#pragma unroll
            for (int m = 0; m < 4; ++m) { const int row = ai * HALF + wr * 64 + m * 16 + fr; const size_t t = (size_t)u.pm * BM + row;
                const f32x4 p4 = *(const PG8_LAS f32x4*)(P + row * 4);
                const float rs = 1.0f * FAST_RSQ(((p4[0] + p4[1]) + (p4[2] + p4[3])) * (1.f / 192.f) + 1e-6f);
                bf16_t* qb = QF + ((size_t)(b * 16 + h) * 4096 + (t & 4095)) * 192;
                *(u32x4*)(qb + wc * 32 + 8 * fq) = pack8(acc[ai][0][m][0] * g0 * rs, acc[ai][0][m][1] * g1 * rs);
                if (wc < 2) { const f32x4 c4 = *(const f32x4*)(rope + t * 64 + j), s4 = *(const f32x4*)(rope + t * 64 + 32 + j);
                    const f32x4 t1 = acc[ai][1][m][0] * gr1 * rs, t2 = acc[ai][1][m][1] * gr2 * rs;
                    const f32x4 o1 = t1 * c4 - t2 * s4, o2 = t1 * s4 + t2 * c4;
                    u32x2 w1; w1.x = cvt_pk_bf16(o1[0], o1[1]); w1.y = cvt_pk_bf16(o1[2], o1[3]); *(u32x2*)(qb + 128 + j) = w1;
                    u32x2 w2; w2.x = cvt_pk_bf16(o2[0], o2[1]); w2.y = cvt_pk_bf16(o2[2], o2[3]); *(u32x2*)(qb + 160 + j) = w2; }
                asm volatile("" ::: "memory"); }
    }
};
__device__ __forceinline__ unsigned pk4f8s(const f32x4 v, float s) { int r = __builtin_amdgcn_cvt_pk_fp8_f32(v[0] * s, v[1] * s, 0, false); r = __builtin_amdgcn_cvt_pk_fp8_f32(v[2] * s, v[3] * s, r, true); return (unsigned)r; }
struct EpiKV8 {
    static constexpr bool PERM = true, AFTER_DRAIN = false, KSEG = false;
    PG8_LAS float* P; const float* kn_g; const float* krss; const float* krr; unsigned char* K8; unsigned char* V8;
    __device__ __forceinline__ void operator()(const f32x4 (&acc)[2][2][4][2], const Unit& u, int wr, int wc, int fr, int fq) const {
        asm volatile("" : "+v"(fr), "+v"(fq));
        const int h = u.pn, b = u.pm >> 4, tq = (u.pm & 15) * 4;
#pragma unroll
        for (int ai = 0; ai < 2; ++ai)
#pragma unroll
            for (int m = 0; m < 4; ++m) { float s = rowsq8(acc[ai][0][m][0], acc[ai][0][m][1]); if (XL_FAST) s = xl_swap32_sum(xl_swap16_sum(s)); else { s += __shfl_xor(s, 16); s += __shfl_xor(s, 32); }
                if (fq == 0) P[(ai * HALF + wr * 64 + m * 16 + fr) * 4 + wc] = s; }
        asm volatile("s_waitcnt lgkmcnt(0)" ::: "memory"); __builtin_amdgcn_s_barrier(); asm volatile("" ::: "memory");
        const f32x4 g0 = *(const f32x4*)(kn_g + wc * 32 + 8 * fq), g1 = *(const f32x4*)(kn_g + wc * 32 + 8 * fq + 4);
#pragma unroll
        for (int ai = 0; ai < 2; ++ai)
#pragma unroll
            for (int m = 0; m < 4; ++m) { const int row = ai * HALF + wr * 64 + m * 16 + fr, key = m * 16 + fr; const size_t t = (size_t)u.pm * BM + row;
                const f32x4 p4 = *(const PG8_LAS f32x4*)(P + row * 4);
                const float rs = 1.0f * FAST_RSQ(((p4[0] + p4[1]) + (p4[2] + p4[3]) + krss[t]) * (1.f / 192.f) + 1e-6f);
                const size_t tile = (size_t)(b * 16 + h) * 64 + tq + 2 * ai + wr;
                unsigned char* kb = K8 + tile * 12288 + key * 16;
                { u32x2 w; w.x = pk4f8s(acc[ai][0][m][0] * g0, rs); w.y = pk4f8s(acc[ai][0][m][1] * g1, rs); *(u32x2*)(kb + (2 * wc + (fq >> 1)) * 1024 + 8 * (fq & 1)) = w; }
                if (fq < 2) { const f32x4 r0 = *(const f32x4*)(krr + t * 64 + 16 * wc + 8 * fq), r1 = *(const f32x4*)(krr + t * 64 + 16 * wc + 8 * fq + 4);
                    u32x2 w; w.x = pk4f8s(r0, rs); w.y = pk4f8s(r1, rs); *(u32x2*)(kb + (8 + wc) * 1024 + 8 * fq) = w; }
                const int p = 32 * ((fr >> 2) & 1) + 16 * (m >> 1) + (fr & 3) + 4 * (2 * (m & 1) + (fr >> 3));
                unsigned char* vb = V8 + tile * 8192 + (p >> 4) * 2048 + (size_t)(wc * 32 + 8 * fq) * 16 + (p & 15);
                const unsigned w0 = pk4f8s(acc[ai][1][m][0], 1.0f), w1 = pk4f8s(acc[ai][1][m][1], 1.0f);
                vb[0] = (unsigned char)w0; vb[16] = (unsigned char)(w0 >> 8); vb[32] = (unsigned char)(w0 >> 16); vb[48] = (unsigned char)(w0 >> 24);
                vb[64] = (unsigned char)w1; vb[80] = (unsigned char)(w1 >> 8); vb[96] = (unsigned char)(w1 >> 16); vb[112] = (unsigned char)(w1 >> 24);
                asm volatile("" ::: "memory"); }
    }
};
struct EpiQ8 {
    static constexpr bool PERM = true, AFTER_DRAIN = false, KSEG = false;
    PG8_LAS float* P; const float* qn_g; const float* rope; unsigned char* Q8; float qscale;
    __device__ __forceinline__ void operator()(const f32x4 (&acc)[2][2][4][2], const Unit& u, int wr, int wc, int fr, int fq) const {
        asm volatile("" : "+v"(fr), "+v"(fq));
        const int h = u.pn, b = u.pm >> 4;
#pragma unroll
        for (int ai = 0; ai < 2; ++ai)
#pragma unroll
            for (int m = 0; m < 4; ++m) { float s = rowsq8(acc[ai][0][m][0], acc[ai][0][m][1]); if (wc < 2) s += rowsq8(acc[ai][1][m][0], acc[ai][1][m][1]);
                if (XL_FAST) s = xl_swap32_sum(xl_swap16_sum(s)); else { s += __shfl_xor(s, 16); s += __shfl_xor(s, 32); }
                if (fq == 0) P[(ai * HALF + wr * 64 + m * 16 + fr) * 4 + wc] = s; }
        asm volatile("s_waitcnt lgkmcnt(0)" ::: "memory"); __builtin_amdgcn_s_barrier(); asm volatile("" ::: "memory");
        const f32x4 g0 = *(const f32x4*)(qn_g + wc * 32 + 8 * fq) * qscale, g1 = *(const f32x4*)(qn_g + wc * 32 + 8 * fq + 4) * qscale;
        const int j = 4 * (4 * (wc & 1) + fq);
        const f32x4 gr1 = *(const f32x4*)(qn_g + 128 + j) * qscale, gr2 = *(const f32x4*)(qn_g + 160 + j) * qscale;
#pragma unroll
        for (int ai = 0; ai < 2; ++ai)
#pragma unroll
            for (int m = 0; m < 4; ++m) { const int row = ai * HALF + wr * 64 + m * 16 + fr; const size_t t = (size_t)u.pm * BM + row;
                const f32x4 p4 = *(const PG8_LAS f32x4*)(P + row * 4);
                const float rs = 1.0f * FAST_RSQ(((p4[0] + p4[1]) + (p4[2] + p4[3])) * (1.f / 192.f) + 1e-6f);
                unsigned char* qb = Q8 + ((size_t)(b * 16 + h) * 4096 + (t & 4095)) * 192;
                { u32x2 w; w.x = pk4f8s(acc[ai][0][m][0] * g0, rs); w.y = pk4f8s(acc[ai][0][m][1] * g1, rs); *(u32x2*)(qb + wc * 32 + 8 * fq) = w; }
                if (wc < 2) { const f32x4 c4 = *(const f32x4*)(rope + t * 64 + j), s4 = *(const f32x4*)(rope + t * 64 + 32 + j);
                    const f32x4 t1 = acc[ai][1][m][0] * gr1 * rs, t2 = acc[ai][1][m][1] * gr2 * rs;
                    *(unsigned*)(qb + 128 + j) = pk4f8s(t1 * c4 - t2 * s4, 1.0f); *(unsigned*)(qb + 160 + j) = pk4f8s(t1 * s4 + t2 * c4, 1.0f); }
                asm volatile("" ::: "memory"); }
    }
};
template <int T1_, int T2_> struct EpiMergedT {
    static constexpr bool PERM = true, AFTER_DRAIN = false, KSEG = true; static constexpr int KSEG_T1 = T1_, KSEG_T2 = T2_;
    const bf16_t* G; bf16_t* Mg;
    __device__ __forceinline__ void kseg(f32x4 (&acc)[2][2][4][2], const Unit& u, int t, int wr, int wc, int fr, int fq) const {
        const bf16_t* gp = G + (size_t)(u.pm * BM + wr * 64 + fr) * 10496 + 4352 + (t == KSEG_T1 ? 0 : 2048) + u.pn * BM + wc * 32 + 8 * fq;
#if KSEG_BATCH16
#pragma unroll
        for (int ai = 0; ai < 2; ++ai) {
            u32x4 gn[4][2], gd[4][2];
#pragma unroll
            for (int m = 0; m < 4; ++m)
#pragma unroll
                for (int bj = 0; bj < 2; ++bj) { const bf16_t* p = gp + (size_t)(ai * HALF + m * 16) * 10496 + bj * HALF; gn[m][bj] = *(const u32x4*)p; gd[m][bj] = *(const u32x4*)(p + 2048); }
#pragma unroll
            for (int m = 0; m < 4; ++m)
#pragma unroll
                for (int bj = 0; bj < 2; ++bj) {
                    f32x4 r0 = bf_lo4(gd[m][bj]), r1 = bf_hi4(gd[m][bj]);
#pragma unroll
                    for (int i = 0; i < 4; ++i) { r0[i] = __builtin_amdgcn_rcpf(r0[i]); r1[i] = __builtin_amdgcn_rcpf(r1[i]); }
                    acc[ai][bj][m][0] = acc[ai][bj][m][0] * (bf_lo4(gn[m][bj]) * r0); acc[ai][bj][m][1] = acc[ai][bj][m][1] * (bf_hi4(gn[m][bj]) * r1); }
            asm volatile("" : "+v"(acc[ai][0][0][0]), "+v"(acc[ai][0][0][1]), "+v"(acc[ai][1][0][0]), "+v"(acc[ai][1][0][1]), "+v"(acc[ai][0][1][0]), "+v"(acc[ai][0][1][1]), "+v"(acc[ai][1][1][0]), "+v"(acc[ai][1][1][1]),
                         "+v"(acc[ai][0][2][0]), "+v"(acc[ai][0][2][1]), "+v"(acc[ai][1][2][0]), "+v"(acc[ai][1][2][1]), "+v"(acc[ai][0][3][0]), "+v"(acc[ai][0][3][1]), "+v"(acc[ai][1][3][0]), "+v"(acc[ai][1][3][1]) :: "memory");
        }
    }
#else
#pragma unroll
        for (int ai = 0; ai < 2; ++ai)
#pragma unroll
            for (int mp = 0; mp < 2; ++mp) {
                u32x4 gn[2][2], gd[2][2];
#pragma unroll
                for (int mm = 0; mm < 2; ++mm)
#pragma unroll
                    for (int bj = 0; bj < 2; ++bj) { const bf16_t* p = gp + (size_t)(ai * HALF + (2 * mp + mm) * 16) * 10496 + bj * HALF; gn[mm][bj] = *(const u32x4*)p; gd[mm][bj] = *(const u32x4*)(p + 2048); }
#pragma unroll
                for (int mm = 0; mm < 2; ++mm)
#pragma unroll
                    for (int bj = 0; bj < 2; ++bj) { const int m = 2 * mp + mm;
                        f32x4 r0 = bf_lo4(gd[mm][bj]), r1 = bf_hi4(gd[mm][bj]);
#pragma unroll
                        for (int i = 0; i < 4; ++i) { r0[i] = __builtin_amdgcn_rcpf(r0[i]); r1[i] = __builtin_amdgcn_rcpf(r1[i]); }
                        acc[ai][bj][m][0] = acc[ai][bj][m][0] * (bf_lo4(gn[mm][bj]) * r0); acc[ai][bj][m][1] = acc[ai][bj][m][1] * (bf_hi4(gn[mm][bj]) * r1); }
                asm volatile("" : "+v"(acc[ai][0][2 * mp][0]), "+v"(acc[ai][0][2 * mp][1]), "+v"(acc[ai][1][2 * mp][0]), "+v"(acc[ai][1][2 * mp][1]), "+v"(acc[ai][0][2 * mp + 1][0]), "+v"(acc[ai][0][2 * mp + 1][1]), "+v"(acc[ai][1][2 * mp + 1][0]), "+v"(acc[ai][1][2 * mp + 1][1]) :: "memory");
            }
    }
#endif
    __device__ __forceinline__ void operator()(const f32x4 (&acc)[2][2][4][2], const Unit& u, int wr, int wc, int fr, int fq) const {
        const int row0 = u.pm * BM + wr * 64 + fr, col0 = u.pn * BM + wc * 32 + 8 * fq;
#pragma unroll
        for (int ai = 0; ai < 2; ++ai)
#pragma unroll
            for (int m = 0; m < 4; ++m) { const size_t r = (size_t)(row0 + ai * HALF + m * 16);
#pragma unroll
                for (int bj = 0; bj < 2; ++bj) {
                    const u32x4 gw = *(const u32x4*)(G + r * 10496 + 4352 + 4096 + col0 + bj * HALF);
                    *(u32x4*)(Mg + r * 2048 + col0 + bj * HALF) = pack8(acc[ai][bj][m][0] * bf_lo4(gw), acc[ai][bj][m][1] * bf_hi4(gw)); } }
    }
};
struct EpiX1 {
    static constexpr bool PERM = true, AFTER_DRAIN = false, KSEG = false;
    const float* X; bf16_t* O;
    __device__ __forceinline__ void operator()(const f32x4 (&acc)[2][2][4][2], const Unit& u, int wr, int wc, int fr, int fq) const {
        const int row0 = u.pm * BM + wr * 64 + fr, col0 = u.pn * BM + wc * 32 + 8 * fq;
#if EPIX1_BATCH
#pragma unroll
        for (int ai = 0; ai < 2; ++ai) {
            f32x4 xv[4][2][2];
#pragma unroll
            for (int m = 0; m < 4; ++m) { const size_t off = (size_t)(row0 + ai * HALF + m * 16) * 2048 + col0;
#pragma unroll
                for (int bj = 0; bj < 2; ++bj) { xv[m][bj][0] = *(const f32x4*)(X + off + bj * HALF); xv[m][bj][1] = *(const f32x4*)(X + off + bj * HALF + 4); } }
#pragma unroll
            for (int m = 0; m < 4; ++m) { const size_t off = (size_t)(row0 + ai * HALF + m * 16) * 2048 + col0;
#pragma unroll
                for (int bj = 0; bj < 2; ++bj) *(u32x4*)(O + off + bj * HALF) = pack8(xv[m][bj][0] + acc[ai][bj][m][0], xv[m][bj][1] + acc[ai][bj][m][1]); }
            asm volatile("" ::: "memory");
        }
    }
};
#else
#pragma unroll
        for (int ai = 0; ai < 2; ++ai)
#pragma unroll
            for (int m = 0; m < 4; ++m) { const size_t off = (size_t)(row0 + ai * HALF + m * 16) * 2048 + col0;
#pragma unroll
                for (int bj = 0; bj < 2; ++bj) { const f32x4 x0 = *(const f32x4*)(X + off + bj * HALF), x1 = *(const f32x4*)(X + off + bj * HALF + 4);
                    *(u32x4*)(O + off + bj * HALF) = pack8(x0 + acc[ai][bj][m][0], x1 + acc[ai][bj][m][1]); } }
    }
};
#endif
struct EpiSwiGLU {
    static constexpr bool PERM = true, AFTER_DRAIN = false, KSEG = false;
    const float* bgu; unsigned char* ACT;
    __device__ __forceinline__ void operator()(const f32x4 (&acc)[2][2][4][2], const Unit& u, int wr, int wc, int fr, int fq) const {
        const int e = u.pn >> 4, pnl = u.pn & 15, cl = pnl * HALF + wc * 32 + 8 * fq;
        const float* bp = bgu + (size_t)e * 4096 + cl;
        f32x4 bg[2], bu[2];
#pragma unroll
        for (int n = 0; n < 2; ++n) { bg[n] = *(const f32x4*)(bp + 4 * n); bu[n] = *(const f32x4*)(bp + 2048 + 4 * n); }
        unsigned char* base = ACT + (size_t)(u.pm * BM + wr * 64 + fr) * 2048 + cl;
#pragma unroll
        for (int ai = 0; ai < 2; ++ai)
#pragma unroll
            for (int m = 0; m < 4; ++m) { f32x4 o[2];
#pragma unroll
                for (int n = 0; n < 2; ++n) { const f32x4 g4 = acc[ai][0][m][n] + bg[n], u4 = acc[ai][1][m][n] + bu[n];
#pragma unroll
                    for (int i = 0; i < 4; ++i) { const float g = fminf(g4[i], 7.0f), up = fminf(fmaxf(u4[i], -7.0f), 7.0f); o[n][i] = (up + 1.0f) * g * sigm(1.702f * g); } }
                u32x2 w8; w8.x = pk4f8(o[0]); w8.y = pk4f8(o[1]); *(u32x2*)(base + (size_t)(ai * HALF + m * 16) * 2048) = w8; }
    }
};
template <int P_> struct EpiSwiGLUProbe : EpiSwiGLU { static constexpr int PROBE = P_;
    __device__ __forceinline__ void operator()(const f32x4 (&)[2][2][4][2], const Unit&, int, int, int, int) const {} };

struct EpiDown {
    static constexpr bool PERM = true, AFTER_DRAIN = false, KSEG = false;
    const float* bd; unsigned char* Y;
    __device__ __forceinline__ void operator()(const f32x4 (&acc)[2][2][4][2], const Unit& u, int wr, int wc, int fr, int fq) const {
        const int e = u.pn >> 3, pnl = u.pn & 7, cl = pnl * BM + wc * 32 + 8 * fq;
        const float* bp = bd + (size_t)e * 2048 + cl;
        f32x4 bv[2][2];
#pragma unroll
        for (int bj = 0; bj < 2; ++bj)
#pragma unroll
            for (int n = 0; n < 2; ++n) bv[bj][n] = *(const f32x4*)(bp + bj * HALF + 4 * n);
        unsigned char* base = Y + (size_t)(u.pm * BM + wr * 64 + fr) * 2048 + cl;
#pragma unroll
        for (int ai = 0; ai < 2; ++ai)
#pragma unroll
            for (int m = 0; m < 4; ++m) { unsigned char* rowp = base + (size_t)(ai * HALF + m * 16) * 2048;
#pragma unroll
                for (int bj = 0; bj < 2; ++bj) { u32x2 w; w.x = pk4f8(acc[ai][bj][m][0] + bv[bj][0]); w.y = pk4f8(acc[ai][bj][m][1] + bv[bj][1]); *(u32x2*)(rowp + bj * HALF) = w; } }
    }
};

struct P1Order {
    StaticOrder base; int i_off, i_lim;
    __device__ void init(int G_, int c_, int i_off_, int i_lim_) { base.init(16384, (GATE_F8 ? (UV_F8 == 2 ? 4 : 8) : 41) * 256, G_, c_); i_off = i_off_; i_lim = i_lim_; }
    __device__ bool next(int i_, Unit& u) const {
        const int i = i_ + i_off; if (i >= i_lim) return false;
        const long L = (long)i * base.G + base.c;
        if (L < base.nwg) return base.next(i, u);
        const int j = (int)(L - base.nwg); if (GATE_F8 || j >= 32) return false;
        u.pm = 64 + (j & 3); u.pn = 41 + (j >> 2); return true;
    }
    __device__ __forceinline__ void a_ready(const Unit&) const {}
    __device__ __forceinline__ void done(const Unit&) const {}
};
struct GateOrder {
    StaticOrder base;
    __device__ void init(int G_, int c_) { base.init(16384, (UV_F8 == 1 ? 41 : UV_F8 == 2 ? 37 : 33) * 256, G_, c_); }
    __device__ bool next(int i, Unit& u) const {
        const long L = (long)i * base.G + base.c;
        if (L < base.nwg) { base.next(i, u); u.pn += (UV_F8 == 1 ? 0 : UV_F8 == 2 ? 4 : 8); return true; }
        const int j = (int)(L - base.nwg);
        if (j < 32) { u.pm = 64 + (j & 3); u.pn = 41 + (j >> 2); return true; }
        return false;
    }
    __device__ __forceinline__ void a_ready(const Unit&) const {}
    __device__ __forceinline__ void done(const Unit&) const {}
};
struct MoeOrder {
    const PG8_LAS int* tab; int NT, x, j;
    __device__ bool next(int i, Unit& u) const {
#if MOE_MAP2
        const int g = NT >> 2, Lx = i * 32 + j, rbi = Lx / g, s = Lx - rbi * g, rb = 2 * rbi + (x >> 2);
        if (rb >= __builtin_amdgcn_readfirstlane(tab[32])) return false;
        int e = 0;
        while (__builtin_amdgcn_readfirstlane(tab[e + 1]) <= rb) ++e;
        u.pm = rb; u.pn = e * NT + (x & 3) + 4 * s; u.kr = 0; return true;
#else
        const int ntx = NT >> 3, Lx = i * 32 + j, rb = Lx / ntx, s = Lx - rb * ntx;
        if (rb >= __builtin_amdgcn_readfirstlane(tab[32])) return false;
        int e = 0;
        while (__builtin_amdgcn_readfirstlane(tab[e + 1]) <= rb) ++e;
        u.pm = rb; u.pn = e * NT + x + 8 * s; u.kr = (rb + 4 * s) & 7; return true;
#endif
    }
    __device__ __forceinline__ void a_ready(const Unit&) const {}
    __device__ __forceinline__ void done(const Unit&) const {}
};
}
#define GAS __attribute__((address_space(1)))
#define LAS __attribute__((address_space(3)))
typedef unsigned short bf16;
typedef unsigned v4u __attribute__((ext_vector_type(4)));
typedef float f32x4 __attribute__((ext_vector_type(4)));
typedef short bf16x8 __attribute__((ext_vector_type(8)));
typedef GAS unsigned gu32;
typedef GAS unsigned long long gu64;
#define RLX_AGENT __ATOMIC_RELAXED, __HIP_MEMORY_SCOPE_AGENT
#define LDS_WAIT() asm volatile("s_waitcnt lgkmcnt(0)" ::: "memory")
#define VM_WAIT() asm volatile("s_waitcnt vmcnt(0)" ::: "memory")
__device__ __forceinline__ unsigned long long rt() { return __builtin_amdgcn_s_memrealtime(); }
__device__ __forceinline__ unsigned f2bf(float f) { unsigned u = __builtin_bit_cast(unsigned, f); return (u + 0x7fffu + ((u >> 16) & 1u)) >> 16; }
__device__ __forceinline__ unsigned pk2(float lo, float hi) { return f2bf(lo) | (f2bf(hi) << 16); }
#define XB_TMO      128
#define XB_XCNT(j)  (256  + 64 * (j))
#define XB_XSUB(j)  (1280 + 64 * (j))
#define XB_XGEN(j)  (2304 + 64 * (j))
#define XB_TOP      3328
#define XB_TOPGEN   3392
#define XCD_BAR_WORDS 3456
#define XB_SPIN_CAP (1u << 18)

__device__ __forceinline__ unsigned xb_ld(unsigned* p)              { return __hip_atomic_load(p, __ATOMIC_RELAXED, __HIP_MEMORY_SCOPE_AGENT); }
__device__ __forceinline__ unsigned xb_add(unsigned* p, unsigned v) { return __hip_atomic_fetch_add(p, v, __ATOMIC_RELAXED, __HIP_MEMORY_SCOPE_AGENT); }
__device__ __forceinline__ unsigned xb_xcc_id() { return (unsigned)__builtin_amdgcn_s_getreg((3 << 11) | 20) & 0xFu; }
#define XB_SPIN(cond, bar) do { unsigned _sp = 0; while (cond) { __builtin_amdgcn_s_sleep(1); \
    if ((++_sp & 255u) == 0u) { if (xb_ld(&(bar)[XB_TMO])) break; if (_sp > XB_SPIN_CAP) { atomicAdd(&(bar)[XB_TMO], 1u); break; } } } } while (0)

struct XcdBarrier {
    unsigned* bar; unsigned x;
    volatile LAS unsigned* st;
};

__device__ __forceinline__ XcdBarrier xcd_barrier_post(unsigned* bar, volatile LAS unsigned* st) {
    XcdBarrier b; b.bar = bar; b.x = xb_xcc_id(); b.st = st;
    if (threadIdx.x == 0) (void)xb_add(&bar[XB_XCNT(b.x)], 1u);
    return b;
}
__device__ __forceinline__ void xcd_barrier_complete(unsigned* bar, unsigned x, unsigned& nloc, unsigned& nx) {
    const unsigned G = gridDim.x * gridDim.y * gridDim.z;
    unsigned sum, cnt, mine, sp = 0u;
    for (;;) {
        sum = 0u; cnt = 0u; mine = 0u;
#pragma unroll
        for (unsigned j = 0; j < 16; ++j) { const unsigned c = xb_ld(&bar[XB_XCNT(j)]); sum += c; cnt += (c > 0u) ? 1u : 0u; mine = (j == x) ? c : mine; }
        if (sum == G) break;
        __builtin_amdgcn_s_sleep(1);
        if ((++sp & 255u) == 0u) { if (xb_ld(&bar[XB_TMO])) break; if (sp > XB_SPIN_CAP) { atomicAdd(&bar[XB_TMO], 1u); break; } }
    }
    nloc = mine > 0u ? mine : 1u; nx = cnt > 0u ? cnt : 1u;
}

__device__ __forceinline__ void xcd_barrier(const XcdBarrier& b) {
    asm volatile("s_waitcnt vmcnt(0)" ::: "memory");
    __syncthreads();
    if (threadIdx.x == 0) {
        unsigned* bar = b.bar;
        __builtin_amdgcn_s_waitcnt(0);
        unsigned nloc = b.st[0], nx = b.st[1];
        if (nloc == 0u) { xcd_barrier_complete(bar, b.x, nloc, nx); b.st[0] = nloc; b.st[1] = nx; }
        const unsigned old = xb_add(&bar[XB_XSUB(b.x)], 1u);
        const unsigned gen = old / nloc;
        if (old + 1u == (gen + 1u) * nloc) {
            __builtin_amdgcn_fence(__ATOMIC_RELEASE, "agent");
            asm volatile("s_waitcnt vmcnt(0)" ::: "memory");
            const unsigned og = xb_add(&bar[XB_TOP], 1u);
            const unsigned tg = og / nx;
            if (og + 1u == (tg + 1u) * nx) xb_add(&bar[XB_TOPGEN], 1u);
            else XB_SPIN(xb_ld(&bar[XB_TOPGEN]) == tg, bar);
            __builtin_amdgcn_fence(__ATOMIC_ACQUIRE, "agent");
            xb_add(&bar[XB_XGEN(b.x)], 1u);
            asm volatile("s_waitcnt vmcnt(0)" ::: "memory");
        } else {
            XB_SPIN(xb_ld(&bar[XB_XGEN(b.x)]) == gen, bar);
            __builtin_amdgcn_fence(__ATOMIC_ACQUIRE, "agent");
            asm volatile("s_waitcnt vmcnt(0)" ::: "memory");
        }
    }
    __syncthreads();
}
typedef float f32x16 __attribute__((ext_vector_type(16)));
typedef float f32x2 __attribute__((ext_vector_type(2)));
typedef short s16x4 __attribute__((ext_vector_type(4)));
typedef unsigned u32x2 __attribute__((ext_vector_type(2)));
typedef short v4i16_t __attribute__((ext_vector_type(4)));
__device__ __forceinline__ unsigned cvtpk(float lo, float hi) { unsigned r; asm volatile("v_cvt_pk_bf16_f32 %0, %1, %2" : "=v"(r) : "v"(lo), "v"(hi)); return r; }
__device__ __forceinline__ float bflo(unsigned w) { return __uint_as_float(w << 16); }
__device__ __forceinline__ float bfhi(unsigned w) { return __uint_as_float(w & 0xffff0000u); }
__device__ __forceinline__ void unpack8(const v4u w, float (&f)[8]) { f[0] = bflo(w.x); f[1] = bfhi(w.x); f[2] = bflo(w.y); f[3] = bfhi(w.y); f[4] = bflo(w.z); f[5] = bfhi(w.z); f[6] = bflo(w.w); f[7] = bfhi(w.w); }
__device__ __forceinline__ v4u packf8(const float (&f)[8]) { v4u w; w.x = cvtpk(f[0], f[1]); w.y = cvtpk(f[2], f[3]); w.z = cvtpk(f[4], f[5]); w.w = cvtpk(f[6], f[7]); return w; }
__device__ __forceinline__ float wave_sum(float v) {
#if XL_FAST
    return xl_swap32_sum(xl_swap16_sum(xl_sum16(v)));
#else
#pragma unroll
    for (int o = 1; o < 64; o <<= 1) v += __shfl_xor(v, o);
    return v;
#endif
}
__device__ __forceinline__ int crow(int r, int hi) { return (r & 3) + 8 * (r >> 2) + 4 * hi; }

template <bool ROPEP = false>
__device__ __forceinline__ void transpose_item64(const float* W, size_t ldw, int k0, int n0, bf16* WT, size_t ldt, int r0, LAS float* scr, int lane, int kdst = 0) {
    const GAS float* src = (const GAS float*)W + (size_t)(k0 + (lane >> 4)) * ldw + n0 + (lane & 15) * 4;
    f32x4 v[16];
#pragma unroll
    for (int i = 0; i < 16; ++i) v[i] = *(const GAS f32x4*)(src + (size_t)(4 * i) * ldw);
#pragma unroll
    for (int i = 0; i < 16; ++i) { LAS float* s = scr + (4 * i + (lane >> 4)) * 65 + (lane & 15) * 4; s[0] = v[i].x; s[1] = v[i].y; s[2] = v[i].z; s[3] = v[i].w; }
    LDS_WAIT(); asm volatile("" ::: "memory");
    const int c = lane & 7;
#pragma unroll
    for (int j = 0; j < 8; ++j) { const int n = (lane >> 3) + 8 * j; const LAS float* s = scr + (8 * c) * 65 + n;
        v4u o; o.x = cvtpk(s[0 * 65], s[1 * 65]); o.y = cvtpk(s[2 * 65], s[3 * 65]); o.z = cvtpk(s[4 * 65], s[5 * 65]); o.w = cvtpk(s[6 * 65], s[7 * 65]);
        const int nd = ROPEP ? (((n >> 4) & 1) * 32 + ((n >> 2) & 3) * 8 + (n >> 5) * 4 + (n & 3)) : n;
        *(GAS v4u*)(WT + (size_t)(r0 + nd) * ldt + kdst + k0 + 8 * c) = o; }
    LDS_WAIT(); asm volatile("" ::: "memory");
}
__device__ __forceinline__ unsigned pk4_fp8(float a, float b, float c, float d) { int r = __builtin_amdgcn_cvt_pk_fp8_f32(a, b, 0, false); r = __builtin_amdgcn_cvt_pk_fp8_f32(c, d, r, true); return (unsigned)r; }
template <bool ROPEP = false>
__device__ __forceinline__ void transpose_item64_f8(const float* W, size_t ldw, int k0, int n0, unsigned char* WT, size_t ldt, int r0, LAS float* scr, int lane, float scale) {
    const GAS float* src = (const GAS float*)W + (size_t)(k0 + (lane >> 4)) * ldw + n0 + (lane & 15) * 4;
    f32x4 v[16];
#pragma unroll
    for (int i = 0; i < 16; ++i) v[i] = *(const GAS f32x4*)(src + (size_t)(4 * i) * ldw);
#pragma unroll
    for (int i = 0; i < 16; ++i) { LAS float* s = scr + (4 * i + (lane >> 4)) * 65 + (lane & 15) * 4; s[0] = v[i].x; s[1] = v[i].y; s[2] = v[i].z; s[3] = v[i].w; }
    LDS_WAIT(); asm volatile("" ::: "memory");
    const int c = lane & 7;
#pragma unroll
    for (int j = 0; j < 8; ++j) { const int n = (lane >> 3) + 8 * j; const LAS float* s = scr + (8 * c) * 65 + n;
        u32x2 o; o.x = pk4_fp8(s[0 * 65] * scale, s[1 * 65] * scale, s[2 * 65] * scale, s[3 * 65] * scale); o.y = pk4_fp8(s[4 * 65] * scale, s[5 * 65] * scale, s[6 * 65] * scale, s[7 * 65] * scale);
        const int nd = ROPEP ? (((n >> 4) & 1) * 32 + ((n >> 2) & 3) * 8 + (n >> 5) * 4 + (n & 3)) : n;
        *(GAS u32x2*)(WT + (size_t)(r0 + nd) * ldt + k0 + 8 * c) = o; }
    LDS_WAIT(); asm volatile("" ::: "memory");
}
__device__ __forceinline__ void rms_row_to_bf16(const float* xrow, const float* gain, bf16* orow, int lane, unsigned char* orow8 = nullptr) {
    const GAS f32x4* xr = (const GAS f32x4*)xrow + lane; const GAS f32x4* gr = (const GAS f32x4*)gain + lane;
    f32x4 v[8]; float s = 0.f;
#pragma unroll
    for (int j = 0; j < 8; ++j) { v[j] = xr[64 * j]; s += (v[j].x * v[j].x + v[j].y * v[j].y) + (v[j].z * v[j].z + v[j].w * v[j].w); }
    const float rs = 1.0f * FAST_RSQ(wave_sum(s) * (1.f / 2048.f) + EPS);
    GAS u32x2* o8 = (GAS u32x2*)orow + lane; GAS unsigned* o4 = (GAS unsigned*)orow8 + lane;
#pragma unroll
    for (int j = 0; j < 8; ++j) { const f32x4 g = gr[64 * j]; const float a0 = v[j].x * rs * g.x, a1 = v[j].y * rs * g.y, a2 = v[j].z * rs * g.z, a3 = v[j].w * rs * g.w;
        if (!(UV_F8 == 1 && GATE_F8)) { u32x2 w; w.x = cvtpk(a0, a1); w.y = cvtpk(a2, a3); o8[64 * j] = w; }
        if (orow8) o4[64 * j] = pk4_fp8(a0, a1, a2, a3); }
}
#define ATT_WAITV(n) asm volatile("s_waitcnt vmcnt(" #n ")" ::: "memory")
template <int DQK, int NSLOT, bool CAUSAL>
__device__ __forceinline__ void attn_unit(LAS unsigned char* lds, const bf16* Qw  , int qpitch, const bf16* Ktiles, const bf16* Vtiles,
                                          int ntiles, int qpos0  , unsigned char* Ow  , int opitch, int wid, int lane) {
    constexpr int KS = DQK / 16, KTB = 64 * DQK * 2, VTB = 64 * 128 * 2, KP = KTB / 1024 / 8  , VP = 2, NP = KP + VP, PF = NSLOT - 1;
    static_assert(KTB % 8192 == 0, "K tile pieces must split evenly over 8 waves");
    const int r32 = lane & 31, hi = lane >> 5;
    bf16x8 qf[KS];
    { const GAS bf16x8* qp = (const GAS bf16x8*)((const GAS bf16*)Qw + (size_t)r32 * qpitch + hi * 8);
#pragma unroll
      for (int ks = 0; ks < KS; ++ks) qf[ks] = qp[2 * ks]; }
    asm volatile("s_waitcnt vmcnt(0)" ::: "memory");
#pragma unroll
    for (int ks = 0; ks < KS; ++ks) asm volatile("" : "+v"(qf[ks]));
    const GAS unsigned char* kg = (const GAS unsigned char*)Ktiles + (size_t)wid * 1024;
    const GAS unsigned char* vg = (const GAS unsigned char*)Vtiles + (size_t)wid * 1024;
    const unsigned loff = (unsigned)lane * 16u;
    LAS unsigned char* kl = lds + wid * 1024; LAS unsigned char* vl = lds + NSLOT * KTB + wid * 1024;
#define ATT_ISSUE(t) do { const int sl_ = (t) % NSLOT; unsigned lo_ = loff; asm volatile("" : "+v"(lo_));   \
        _Pragma("unroll") for (int p_ = 0; p_ < KP; ++p_) __builtin_amdgcn_global_load_lds((const GAS unsigned*)(kg + ((size_t)(t) * KTB + p_ * 8192) + lo_), (LAS unsigned*)(kl + sl_ * KTB + p_ * 8192), 16, 0, 0); \
        _Pragma("unroll") for (int p_ = 0; p_ < VP; ++p_) __builtin_amdgcn_global_load_lds((const GAS unsigned*)(vg + ((size_t)(t) * VTB + p_ * 8192) + lo_), (LAS unsigned*)(vl + sl_ * VTB + p_ * 8192), 16, 0, 0); } while (0)
#pragma unroll
    for (int t = 0; t < PF; ++t) if (t < ntiles) ATT_ISSUE(t);
    f32x16 o[4];
#pragma unroll
    for (int d = 0; d < 4; ++d)
#pragma unroll
        for (int r = 0; r < 16; ++r) o[d][r] = 0.f;
    float mrun = -1e30f, lrun = 0.f;
    const int kbase = hi * 1024 + r32 * 16;
    const int g4 = lane >> 4, q4 = (lane >> 2) & 3, p4 = lane & 3;
    const int vbase = (4 * (g4 >> 1) + q4) * 64 + (16 * (g4 & 1) + 4 * p4) * 2;
    for (int j = 0; j < ntiles; ++j) {
        const int rem = ntiles - 1 - j;
        if (PF >= 2 && rem >= 1) { if (NP == 5) ATT_WAITV(5); else ATT_WAITV(6); } else ATT_WAITV(0);
        __builtin_amdgcn_s_barrier();
        asm volatile("" ::: "memory");
        if (j + PF < ntiles) ATT_ISSUE(j + PF);
        if (CAUSAL && 64 * j > qpos0 + 31) continue;
        const int sl = j % NSLOT;
        const LAS unsigned char* ks_ = lds + sl * KTB + kbase;
        const LAS unsigned char* vs_ = lds + NSLOT * KTB + sl * VTB + vbase;
        f32x16 p0, p1;
#pragma unroll
        for (int r = 0; r < 16; ++r) { p0[r] = 0.f; p1[r] = 0.f; }
        {   constexpr int NF = 2 * KS, KW = 8;
            bf16x8 kf[KW];
#pragma unroll
            for (int i = 0; i < KW; ++i) kf[i] = *(const LAS bf16x8*)(ks_ + (i >> 1) * 2048 + (i & 1) * 512);
            __builtin_amdgcn_sched_barrier(0);
#pragma unroll
            for (int i = 0; i < NF; ++i) {
                if (i & 1) p1 = __builtin_amdgcn_mfma_f32_32x32x16_bf16(kf[i % KW], qf[i >> 1], p1, 0, 0, 0);
                else       p0 = __builtin_amdgcn_mfma_f32_32x32x16_bf16(kf[i % KW], qf[i >> 1], p0, 0, 0, 0);
                if (i + KW < NF) kf[i % KW] = *(const LAS bf16x8*)(ks_ + ((i + KW) >> 1) * 2048 + ((i + KW) & 1) * 512);
                __builtin_amdgcn_sched_barrier(0);
            }
        }
        if (CAUSAL && 64 * j + 63 > qpos0) {
            const int dq = qpos0 + r32 - 64 * j - 4 * hi;
#pragma unroll
            for (int r = 0; r < 16; ++r) { const int c = (r & 3) + 8 * (r >> 2); if (c > dq) p0[r] = -INFINITY; if (c + 32 > dq) p1[r] = -INFINITY; }
        }
        float mx = p0[0];
#pragma unroll
        for (int r = 1; r < 16; ++r) mx = fmaxf(mx, p0[r]);
#pragma unroll
        for (int r = 0; r < 16; ++r) mx = fmaxf(mx, p1[r]);
        mx = XL_FAST ? xl_swap32_max(mx) : fmaxf(mx, __shfl_xor(mx, 32));
        const float mnew = fmaxf(mrun, mx);
        if (__any(mnew > mrun)) {
            const float alpha = __builtin_amdgcn_exp2f(mrun - mnew);
            lrun *= alpha;
#pragma unroll
            for (int d = 0; d < 4; ++d)
#pragma unroll
                for (int r = 0; r < 16; ++r) o[d][r] *= alpha;
            mrun = mnew;
        }
        float ps = 0.f;
#pragma unroll
        for (int r = 0; r < 16; ++r) { p0[r] = __builtin_amdgcn_exp2f(p0[r] - mrun); p1[r] = __builtin_amdgcn_exp2f(p1[r] - mrun); ps += p0[r] + p1[r]; }
        lrun += ps;
        bf16x8 pf[4];
        { v4u w;
          w.x = cvtpk(p0[0], p0[1]); w.y = cvtpk(p0[2], p0[3]); w.z = cvtpk(p0[4], p0[5]); w.w = cvtpk(p0[6], p0[7]); pf[0] = __builtin_bit_cast(bf16x8, w);
          w.x = cvtpk(p0[8], p0[9]); w.y = cvtpk(p0[10], p0[11]); w.z = cvtpk(p0[12], p0[13]); w.w = cvtpk(p0[14], p0[15]); pf[1] = __builtin_bit_cast(bf16x8, w);
          w.x = cvtpk(p1[0], p1[1]); w.y = cvtpk(p1[2], p1[3]); w.z = cvtpk(p1[4], p1[5]); w.w = cvtpk(p1[6], p1[7]); pf[2] = __builtin_bit_cast(bf16x8, w);
          w.x = cvtpk(p1[8], p1[9]); w.y = cvtpk(p1[10], p1[11]); w.z = cvtpk(p1[12], p1[13]); w.w = cvtpk(p1[14], p1[15]); pf[3] = __builtin_bit_cast(bf16x8, w); }
#define ATT_VLOAD(dst, s_) do { _Pragma("unroll") for (int db_ = 0; db_ < 4; ++db_) { \
            const s16x4 lo_ = __builtin_bit_cast(s16x4, __builtin_amdgcn_ds_read_tr16_b64_v4i16((LAS v4i16_t*)(vs_ + db_ * 4096 + (s_) * 1024))); \
            const s16x4 hh_ = __builtin_bit_cast(s16x4, __builtin_amdgcn_ds_read_tr16_b64_v4i16((LAS v4i16_t*)(vs_ + db_ * 4096 + (s_) * 1024 + 512))); \
            dst[db_] = (bf16x8){lo_[0], lo_[1], lo_[2], lo_[3], hh_[0], hh_[1], hh_[2], hh_[3]}; } } while (0)
        {   bf16x8 va[4], vb[4];
            ATT_VLOAD(va, 0);
            __builtin_amdgcn_sched_barrier(0);
            ATT_VLOAD(vb, 1);
#pragma unroll
            for (int db = 0; db < 4; ++db) o[db] = __builtin_amdgcn_mfma_f32_32x32x16_bf16(va[db], pf[0], o[db], 0, 0, 0);
            __builtin_amdgcn_sched_barrier(0);
            ATT_VLOAD(va, 2);
#pragma unroll
            for (int db = 0; db < 4; ++db) o[db] = __builtin_amdgcn_mfma_f32_32x32x16_bf16(vb[db], pf[1], o[db], 0, 0, 0);
            __builtin_amdgcn_sched_barrier(0);
            ATT_VLOAD(vb, 3);
#pragma unroll
            for (int db = 0; db < 4; ++db) o[db] = __builtin_amdgcn_mfma_f32_32x32x16_bf16(va[db], pf[2], o[db], 0, 0, 0);
            __builtin_amdgcn_sched_barrier(0);
#pragma unroll
            for (int db = 0; db < 4; ++db) o[db] = __builtin_amdgcn_mfma_f32_32x32x16_bf16(vb[db], pf[3], o[db], 0, 0, 0);
            __builtin_amdgcn_sched_barrier(0);
        }
#undef ATT_VLOAD
    }
    const float lt = XL_FAST ? xl_swap32_sum(lrun) : lrun + __shfl_xor(lrun, 32);
    const float il = ATT_OS / lt;
    GAS unsigned char* op = (GAS unsigned char*)Ow + (size_t)r32 * opitch + 4 * hi;
#pragma unroll
    for (int db = 0; db < 4; ++db)
#pragma unroll
        for (int rg = 0; rg < 4; ++rg) *(GAS unsigned*)(op + 32 * db + 8 * rg) = pk4_fp8(o[db][4 * rg] * il, o[db][4 * rg + 1] * il, o[db][4 * rg + 2] * il, o[db][4 * rg + 3] * il);
    asm volatile("s_waitcnt vmcnt(0) lgkmcnt(0)" ::: "memory");
    __builtin_amdgcn_s_barrier();
    asm volatile("" ::: "memory");
#undef ATT_ISSUE
}

typedef int i32x8a __attribute__((ext_vector_type(8)));
typedef int i32x4a __attribute__((ext_vector_type(4)));
__device__ __forceinline__ void att_bar4(LAS unsigned* ctr, unsigned& nbar, int lane) {
#if SPLIT_FREE
    nbar += 4;
    if (lane == 0) __hip_atomic_fetch_add(ctr, 1u, __ATOMIC_RELAXED, __HIP_MEMORY_SCOPE_WORKGROUP);
    for (;;) { const unsigned v = __builtin_amdgcn_readfirstlane(__hip_atomic_load(ctr, __ATOMIC_RELAXED, __HIP_MEMORY_SCOPE_WORKGROUP)); if (v >= nbar) break; if (ATT_POLL_SLEEP) __builtin_amdgcn_s_sleep(1); }
    asm volatile("" ::: "memory");
#else
    __builtin_amdgcn_s_barrier();
    asm volatile("" ::: "memory");
#endif
}
template <bool CAUSAL, int NWA = 8>
__device__ __forceinline__ void attn8_unit(LAS unsigned char* lds, const unsigned char* Qw  , const unsigned char* Ktiles, const unsigned char* Vtiles,
                                           int ntiles, int qpos0, unsigned char* Ow  , int opitch, int wid, int lane, LAS unsigned* bctr = nullptr, unsigned* nbar = nullptr) {
    constexpr int KTB = 12288, VTB = 8192, NSLOT = 3;
    const int r32 = lane & 31, hi = lane >> 5;
    i32x8a qf[3];
    { const GAS i32x4a* qp = (const GAS i32x4a*)((const GAS unsigned char*)Qw + (size_t)r32 * 192 + hi * 32);
#pragma unroll
      for (int s = 0; s < 3; ++s) { const i32x4a a = qp[4 * s], b = qp[4 * s + 1]; qf[s] = __builtin_shufflevector(a, b, 0, 1, 2, 3, 4, 5, 6, 7); } }
    asm volatile("s_waitcnt vmcnt(0)" ::: "memory");
#pragma unroll
    for (int s = 0; s < 3; ++s) asm volatile("" : "+v"(qf[s]));
    const GAS unsigned char* kg = (const GAS unsigned char*)Ktiles + (size_t)wid * 1024;
    const GAS unsigned char* vg = (const GAS unsigned char*)Vtiles + (size_t)wid * 1024;
    const unsigned loff = (unsigned)lane * 16u;
    LAS unsigned char* kl = lds + wid * 1024; LAS unsigned char* vl = lds + NSLOT * KTB + wid * 1024;
    const bool two = wid < 4;
#define A8_ISSUE(t) do { const int sl_ = (t) % NSLOT; unsigned lo_ = loff; asm volatile("" : "+v"(lo_)); \
        if (NWA == 8) { \
            __builtin_amdgcn_global_load_lds((const GAS unsigned*)(kg + (size_t)(t) * KTB + lo_), (LAS unsigned*)(kl + sl_ * KTB), 16, 0, 0); \
            if (two) __builtin_amdgcn_global_load_lds((const GAS unsigned*)(kg + ((size_t)(t) * KTB + 8192) + lo_), (LAS unsigned*)(kl + sl_ * KTB + 8192), 16, 0, 0); \
            __builtin_amdgcn_global_load_lds((const GAS unsigned*)(vg + (size_t)(t) * VTB + lo_), (LAS unsigned*)(vl + sl_ * VTB), 16, 0, 0); \
        } else {     \
            _Pragma("unroll") for (int p_ = 0; p_ < 3; ++p_) __builtin_amdgcn_global_load_lds((const GAS unsigned*)(kg + ((size_t)(t) * KTB + p_ * 4096) + lo_), (LAS unsigned*)(kl + sl_ * KTB + p_ * 4096), 16, 0, 0); \
            _Pragma("unroll") for (int p_ = 0; p_ < 2; ++p_) __builtin_amdgcn_global_load_lds((const GAS unsigned*)(vg + ((size_t)(t) * VTB + p_ * 4096) + lo_), (LAS unsigned*)(vl + sl_ * VTB + p_ * 4096), 16, 0, 0); \
        } } while (0)
    A8_ISSUE(0);
    if (ntiles > 1) A8_ISSUE(1);
    f32x16 o[4];
#pragma unroll
    for (int d = 0; d < 4; ++d)
#pragma unroll
        for (int r = 0; r < 16; ++r) o[d][r] = 0.f;
    float mrun = -1e30f, lrun = 0.f;
    const int kbase = (2 * hi) * 1024 + r32 * 16, vbase = (2 * hi) * 2048 + r32 * 16;
    const int SQ = 0x7b7b7b7b, SP = 0x79797979, S1 = 0x7f7f7f7f;
    for (int j = 0; j < ntiles; ++j) {
        if (ntiles - 1 - j >= 1) { if (NWA == 4) ATT_WAITV(5); else if (two) ATT_WAITV(3); else ATT_WAITV(2); } else ATT_WAITV(0);
        if (NWA == 4 && bctr) att_bar4(bctr, *nbar, lane); else { __builtin_amdgcn_s_barrier(); asm volatile("" ::: "memory"); }
        if (j + 2 < ntiles) A8_ISSUE(j + 2);
        if (CAUSAL && 64 * j > qpos0 + 31) continue;
        const int sl = j % NSLOT;
        const LAS unsigned char* ks_ = lds + sl * KTB + kbase;
        const LAS unsigned char* vs_ = lds + NSLOT * KTB + sl * VTB + vbase;
        i32x8a kf[3][2];
#pragma unroll
        for (int s = 0; s < 3; ++s)
#pragma unroll
            for (int kb = 0; kb < 2; ++kb) { const i32x4a a = *(const LAS i32x4a*)(ks_ + s * 4096 + kb * 512), b = *(const LAS i32x4a*)(ks_ + s * 4096 + kb * 512 + 1024);
                kf[s][kb] = __builtin_shufflevector(a, b, 0, 1, 2, 3, 4, 5, 6, 7); }
        f32x16 p0, p1;
#pragma unroll
        for (int r = 0; r < 16; ++r) { p0[r] = 0.f; p1[r] = 0.f; }
#pragma unroll
        for (int s = 0; s < 3; ++s) {
            p0 = __builtin_amdgcn_mfma_scale_f32_32x32x64_f8f6f4(kf[s][0], qf[s], p0, 0, 0, 0, S1, 0, SQ);
            p1 = __builtin_amdgcn_mfma_scale_f32_32x32x64_f8f6f4(kf[s][1], qf[s], p1, 0, 0, 0, S1, 0, SQ);
        }
        i32x8a vf[4];
#pragma unroll
        for (int db = 0; db < 4; ++db) { const i32x4a a = *(const LAS i32x4a*)(vs_ + db * 512), b = *(const LAS i32x4a*)(vs_ + db * 512 + 2048); vf[db] = __builtin_shufflevector(a, b, 0, 1, 2, 3, 4, 5, 6, 7); }
        __builtin_amdgcn_sched_barrier(0);
        if (CAUSAL && 64 * j + 63 > qpos0) {
            const int dq = qpos0 + r32 - 64 * j - 4 * hi;
#pragma unroll
            for (int r = 0; r < 16; ++r) { const int c = (r & 3) + 8 * (r >> 2); if (c > dq) p0[r] = -INFINITY; if (c + 32 > dq) p1[r] = -INFINITY; }
        }
        float mx = p0[0];
#pragma unroll
        for (int r = 1; r < 16; ++r) mx = fmaxf(mx, p0[r]);
#pragma unroll
        for (int r = 0; r < 16; ++r) mx = fmaxf(mx, p1[r]);
        mx = XL_FAST ? xl_swap32_max(mx) : fmaxf(mx, __shfl_xor(mx, 32));
        const float mnew = fmaxf(mrun, mx);
        if (__any(mx > mrun + 2.0f)) {
            const float alpha = __builtin_amdgcn_exp2f(mrun - mnew);
            lrun *= alpha;
#pragma unroll
            for (int d = 0; d < 4; ++d)
#pragma unroll
                for (int r = 0; r < 16; ++r) o[d][r] *= alpha;
            mrun = mnew;
        }
        float ps = 0.f; const float msh = mrun - 6.0f;
#pragma unroll
        for (int r = 0; r < 16; ++r) { p0[r] = __builtin_amdgcn_exp2f(p0[r] - msh); p1[r] = __builtin_amdgcn_exp2f(p1[r] - msh); ps += p0[r] + p1[r]; }
        lrun += ps;
        i32x8a pf;
        pf[0] = (int)pk4_fp8(p0[0], p0[1], p0[2], p0[3]); pf[1] = (int)pk4_fp8(p0[4], p0[5], p0[6], p0[7]); pf[2] = (int)pk4_fp8(p0[8], p0[9], p0[10], p0[11]); pf[3] = (int)pk4_fp8(p0[12], p0[13], p0[14], p0[15]);
        pf[4] = (int)pk4_fp8(p1[0], p1[1], p1[2], p1[3]); pf[5] = (int)pk4_fp8(p1[4], p1[5], p1[6], p1[7]); pf[6] = (int)pk4_fp8(p1[8], p1[9], p1[10], p1[11]); pf[7] = (int)pk4_fp8(p1[12], p1[13], p1[14], p1[15]);
#pragma unroll
        for (int db = 0; db < 4; ++db) o[db] = __builtin_amdgcn_mfma_scale_f32_32x32x64_f8f6f4(vf[db], pf, o[db], 0, 0, 0, S1, 0, SP);
    }
    const float lt = XL_FAST ? xl_swap32_sum(lrun) : lrun + __shfl_xor(lrun, 32);
    const float il = 64.0f * ATT_OS / lt;
    GAS unsigned char* op = (GAS unsigned char*)Ow + (size_t)r32 * opitch + 4 * hi;
#pragma unroll
    for (int db = 0; db < 4; ++db)
#pragma unroll
        for (int rg = 0; rg < 4; ++rg) *(GAS unsigned*)(op + 32 * db + 8 * rg) = pk4_fp8(o[db][4 * rg] * il, o[db][4 * rg + 1] * il, o[db][4 * rg + 2] * il, o[db][4 * rg + 3] * il);
    asm volatile("s_waitcnt vmcnt(0) lgkmcnt(0)" ::: "memory");
    if (NWA == 4 && bctr) att_bar4(bctr, *nbar, lane); else { __builtin_amdgcn_s_barrier(); asm volatile("" ::: "memory"); }
#undef A8_ISSUE
}

__device__ __forceinline__ float xhalf_max(float x) { const auto r = __builtin_amdgcn_permlane32_swap(__float_as_uint(x), __float_as_uint(x), false, false); return fmaxf(__uint_as_float(r[0]), __uint_as_float(r[1])); }
__device__ __forceinline__ float xhalf_sum(float x) { const auto r = __builtin_amdgcn_permlane32_swap(__float_as_uint(x), __float_as_uint(x), false, false); return __uint_as_float(r[0]) + __uint_as_float(r[1]); }
template <bool CAUSAL>
__device__ __forceinline__ void attn8_unit2(LAS unsigned char* lds, const unsigned char* Qw  , const unsigned char* Ktiles, const unsigned char* Vtiles,
                                            int ntiles, int qpos0  , unsigned char* Ow, int opitch, int wid, int lane, LAS unsigned* bctr, unsigned& nbar) {
    constexpr int KTB = 12288, VTB = 8192, NSLOT = ATT_PAIR ? 2 : 3, KSB = ATT_PAIR ? 2 * KTB : KTB, VSB = ATT_PAIR ? 2 * VTB : VTB;
    const int r32 = lane & 31, hi = lane >> 5;
    i32x8a qf[2][3];
#pragma unroll
    for (int bk = 0; bk < 2; ++bk) { const GAS i32x4a* qp = (const GAS i32x4a*)((const GAS unsigned char*)Qw + (size_t)(128 * bk + r32) * 192 + hi * 32);
#pragma unroll
      for (int s = 0; s < 3; ++s) { const i32x4a a = qp[4 * s], b = qp[4 * s + 1]; qf[bk][s] = __builtin_shufflevector(a, b, 0, 1, 2, 3, 4, 5, 6, 7); } }
    asm volatile("s_waitcnt vmcnt(0)" ::: "memory");
#pragma unroll
    for (int bk = 0; bk < 2; ++bk)
#pragma unroll
        for (int s = 0; s < 3; ++s) asm volatile("" : "+v"(qf[bk][s]));
    const GAS unsigned char* kg = (const GAS unsigned char*)Ktiles + (size_t)wid * 1024;
    const GAS unsigned char* vg = (const GAS unsigned char*)Vtiles + (size_t)wid * 1024;
    const unsigned loff = (unsigned)lane * 16u;
    LAS unsigned char* kl = lds + wid * 1024; LAS unsigned char* vl = lds + NSLOT * KSB + wid * 1024;
#define A2_ISSUE(t) do { const int sl_ = (t) % NSLOT; unsigned lo_ = loff; asm volatile("" : "+v"(lo_)); \
        _Pragma("unroll") for (int p_ = 0; p_ < KSB / 4096; ++p_) __builtin_amdgcn_global_load_lds((const GAS unsigned*)(kg + ((size_t)(t) * KSB + p_ * 4096) + lo_), (LAS unsigned*)(kl + sl_ * KSB + p_ * 4096), 16, 0, 0); \
        _Pragma("unroll") for (int p_ = 0; p_ < VSB / 4096; ++p_) __builtin_amdgcn_global_load_lds((const GAS unsigned*)(vg + ((size_t)(t) * VSB + p_ * 4096) + lo_), (LAS unsigned*)(vl + sl_ * VSB + p_ * 4096), 16, 0, 0); } while (0)
#define A2_PIECE(tp_, ix_) do { const int sl_ = (tp_) % NSLOT; unsigned lo_ = loff; asm volatile("" : "+v"(lo_)); \
        if ((ix_) < 6) __builtin_amdgcn_global_load_lds((const GAS unsigned*)(kg + ((size_t)(tp_) * KSB + (ix_) * 4096) + lo_), (LAS unsigned*)(kl + sl_ * KSB + (ix_) * 4096), 16, 0, 0); \
        else __builtin_amdgcn_global_load_lds((const GAS unsigned*)(vg + ((size_t)(tp_) * VSB + ((ix_) - 6) * 4096) + lo_), (LAS unsigned*)(vl + sl_ * VSB + ((ix_) - 6) * 4096), 16, 0, 0); } while (0)
#define A2_SPREAD(ix_) do { if (ATT_SPREAD && ATT_PAIR && bk == 1 && pend) { __builtin_amdgcn_sched_barrier(0); A2_PIECE((j >> 1) + 1, ix_); __builtin_amdgcn_sched_barrier(0); } } while (0)
    A2_ISSUE(0);
    if (!ATT_PAIR && ntiles > 1) A2_ISSUE(1);
    f32x16 o[2][4];
#pragma unroll
    for (int bk = 0; bk < 2; ++bk)
#pragma unroll
        for (int d = 0; d < 4; ++d)
#pragma unroll
            for (int r = 0; r < 16; ++r) o[bk][d][r] = 0.f;
    float mrun[2] = {-1e30f, -1e30f}, lrun[2] = {0.f, 0.f};
    const int kbase = (2 * hi) * 1024 + r32 * 16, vbase = (2 * hi) * 2048 + r32 * 16;
    const int SQ = 0x7b7b7b7b, SP = 0x79797979, S1 = 0x7f7f7f7f;
    for (int j = 0; j < ntiles; ++j) {
#if ATT_PAIR
        if ((j & 1) == 0) {
            ATT_WAITV(0);
            att_bar4(bctr, nbar, lane);
            if (!ATT_SPREAD && j + 2 < ntiles) A2_ISSUE((j >> 1) + 1);
        }
        const bool pend = ATT_SPREAD && (j & 1) == 0 && (j + 2 < ntiles); (void)pend;
        const int sl = (j >> 1) % NSLOT;
        unsigned ka_ = (unsigned)(sl * KSB + (j & 1) * KTB + kbase), va_ = (unsigned)(NSLOT * KSB + sl * VSB + (j & 1) * VTB + vbase);
#else
        if (ntiles - 1 - j >= 1) ATT_WAITV(5); else ATT_WAITV(0);
        att_bar4(bctr, nbar, lane);
        if (j + 2 < ntiles) A2_ISSUE(j + 2);
        const int sl = j % NSLOT;
        unsigned ka_ = (unsigned)(sl * KTB + kbase), va_ = (unsigned)(NSLOT * KTB + sl * VTB + vbase);
        const bool pend = false; (void)pend;
#endif
        asm volatile("" : "+v"(ka_), "+v"(va_));
        const LAS unsigned char* ks_ = lds + ka_;
        const LAS unsigned char* vs_ = lds + va_;
        i32x8a pf_prev; bool have_prev = false; (void)pf_prev;
#pragma unroll
        for (int bk = 0; bk < 2; ++bk) {
            const int qp0 = qpos0 + 128 * bk;
            if (CAUSAL && 64 * j > qp0 + 31) continue;
#if ATT_SPLITQK
            f32x16 p0, p1;
#pragma unroll
            for (int r = 0; r < 16; ++r) { p0[r] = 0.f; p1[r] = 0.f; }
#pragma unroll
            for (int s = 0; s < 3; ++s) {
                const i32x4a a0 = *(const LAS i32x4a*)(ks_ + s * 4096), b0 = *(const LAS i32x4a*)(ks_ + s * 4096 + 1024);
                const i32x8a k0 = __builtin_shufflevector(a0, b0, 0, 1, 2, 3, 4, 5, 6, 7);
                p0 = __builtin_amdgcn_mfma_scale_f32_32x32x64_f8f6f4(k0, qf[bk][s], p0, 0, 0, 0, S1, 0, SQ);
            }
            __builtin_amdgcn_sched_barrier(0);
#pragma unroll
            for (int s = 0; s < 3; ++s) {
                const i32x4a a1 = *(const LAS i32x4a*)(ks_ + s * 4096 + 512), b1 = *(const LAS i32x4a*)(ks_ + s * 4096 + 512 + 1024);
                const i32x8a k1 = __builtin_shufflevector(a1, b1, 0, 1, 2, 3, 4, 5, 6, 7);
                p1 = __builtin_amdgcn_mfma_scale_f32_32x32x64_f8f6f4(k1, qf[bk][s], p1, 0, 0, 0, S1, 0, SQ);
            }
            __builtin_amdgcn_sched_barrier(0);
            const bool diag = CAUSAL && 64 * j + 63 > qp0;
            const int dq = qp0 + r32 - 64 * j - 4 * hi;
            if (diag) {
#pragma unroll
                for (int r = 0; r < 16; ++r) { const int c = (r & 3) + 8 * (r >> 2); if (c > dq) p0[r] = -INFINITY; }
            }
            float mx = p0[0];
#pragma unroll
            for (int r = 1; r < 16; ++r) mx = fmaxf(mx, p0[r]);
            mx = ATT_PERMLANE ? xhalf_max(mx) : fmaxf(mx, __shfl_xor(mx, 32));
            if (__any(mx > mrun[bk] + 2.0f)) {
                const float mnew = fmaxf(mrun[bk], mx), alpha = __builtin_amdgcn_exp2f(mrun[bk] - mnew);
                lrun[bk] *= alpha;
#pragma unroll
                for (int d = 0; d < 4; ++d)
#pragma unroll
                    for (int r = 0; r < 16; ++r) o[bk][d][r] *= alpha;
                mrun[bk] = mnew;
            }
            float msh = mrun[bk] - 6.0f, ps = 0.f;
#pragma unroll
            for (int r = 0; r < 16; ++r) { p0[r] = __builtin_amdgcn_exp2f(p0[r] - msh); ps += p0[r]; }
            __builtin_amdgcn_sched_barrier(0);
            if (diag) {
#pragma unroll
                for (int r = 0; r < 16; ++r) { const int c = (r & 3) + 8 * (r >> 2); if (c + 32 > dq) p1[r] = -INFINITY; }
            }
            mx = p1[0];
#pragma unroll
            for (int r = 1; r < 16; ++r) mx = fmaxf(mx, p1[r]);
            mx = ATT_PERMLANE ? xhalf_max(mx) : fmaxf(mx, __shfl_xor(mx, 32));
            if (__any(mx > mrun[bk] + 2.0f)) {
                const float mnew = fmaxf(mrun[bk], mx), alpha = __builtin_amdgcn_exp2f(mrun[bk] - mnew);
                lrun[bk] *= alpha; ps *= alpha;
#pragma unroll
                for (int r = 0; r < 16; ++r) p0[r] *= alpha;
#pragma unroll
                for (int d = 0; d < 4; ++d)
#pragma unroll
                    for (int r = 0; r < 16; ++r) o[bk][d][r] *= alpha;
                mrun[bk] = mnew; msh = mnew - 6.0f;
            }
#pragma unroll
            for (int r = 0; r < 16; ++r) { p1[r] = __builtin_amdgcn_exp2f(p1[r] - msh); ps += p1[r]; }
            lrun[bk] += ps;
            i32x8a pf;
            pf[0] = (int)pk4_fp8(p0[0], p0[1], p0[2], p0[3]); pf[1] = (int)pk4_fp8(p0[4], p0[5], p0[6], p0[7]); pf[2] = (int)pk4_fp8(p0[8], p0[9], p0[10], p0[11]); pf[3] = (int)pk4_fp8(p0[12], p0[13], p0[14], p0[15]);
            pf[4] = (int)pk4_fp8(p1[0], p1[1], p1[2], p1[3]); pf[5] = (int)pk4_fp8(p1[4], p1[5], p1[6], p1[7]); pf[6] = (int)pk4_fp8(p1[8], p1[9], p1[10], p1[11]); pf[7] = (int)pk4_fp8(p1[12], p1[13], p1[14], p1[15]);
            asm volatile("" : "+v"(pf));
#pragma unroll
            for (int db = 0; db < 4; ++db) { const i32x4a a = *(const LAS i32x4a*)(vs_ + db * 512), b = *(const LAS i32x4a*)(vs_ + db * 512 + 2048);
                const i32x8a vfd = __builtin_shufflevector(a, b, 0, 1, 2, 3, 4, 5, 6, 7);
                asm volatile("v_mfma_scale_f32_32x32x64_f8f6f4 %0, %1, %2, %0, %3, %4 op_sel_hi:[0,0,0]" : "+v"(o[bk][db]) : "v"(vfd), "v"(pf), "v"(S1), "v"(SP));
                A2_SPREAD(6 + db); }
            if (ATT_SPREAD && ATT_PAIR && bk == 1 && pend) { A2_PIECE((j >> 1) + 1, 0); A2_PIECE((j >> 1) + 1, 1); A2_PIECE((j >> 1) + 1, 2); A2_PIECE((j >> 1) + 1, 3); A2_PIECE((j >> 1) + 1, 4); A2_PIECE((j >> 1) + 1, 5); }
#else
            f32x16 p0, p1;
#pragma unroll
            for (int r = 0; r < 16; ++r) { p0[r] = 0.f; p1[r] = 0.f; }
#pragma unroll
            for (int s = 0; s < 3; ++s) {
                const i32x4a a0 = *(const LAS i32x4a*)(ks_ + s * 4096), b0 = *(const LAS i32x4a*)(ks_ + s * 4096 + 1024);
                const i32x4a a1 = *(const LAS i32x4a*)(ks_ + s * 4096 + 512), b1 = *(const LAS i32x4a*)(ks_ + s * 4096 + 512 + 1024);
                const i32x8a k0 = __builtin_shufflevector(a0, b0, 0, 1, 2, 3, 4, 5, 6, 7), k1 = __builtin_shufflevector(a1, b1, 0, 1, 2, 3, 4, 5, 6, 7);
                p0 = __builtin_amdgcn_mfma_scale_f32_32x32x64_f8f6f4(k0, qf[bk][s], p0, 0, 0, 0, S1, 0, SQ);
                p1 = __builtin_amdgcn_mfma_scale_f32_32x32x64_f8f6f4(k1, qf[bk][s], p1, 0, 0, 0, S1, 0, SQ);
            }
#if ATT_DEFER
            if (bk == 1 && have_prev) {
                __builtin_amdgcn_sched_barrier(0);
#pragma unroll
                for (int db = 0; db < 4; ++db) { const i32x4a a = *(const LAS i32x4a*)(vs_ + db * 512), b = *(const LAS i32x4a*)(vs_ + db * 512 + 2048);
                    const i32x8a vfd = __builtin_shufflevector(a, b, 0, 1, 2, 3, 4, 5, 6, 7);
                    asm volatile("v_mfma_scale_f32_32x32x64_f8f6f4 %0, %1, %2, %0, %3, %4 op_sel_hi:[0,0,0]" : "+v"(o[0][db]) : "v"(vfd), "v"(pf_prev), "v"(S1), "v"(SP));
                    __builtin_amdgcn_sched_barrier(0); }
            }
#endif
            if (CAUSAL && 64 * j + 63 > qp0) {
                const int dq = qp0 + r32 - 64 * j - 4 * hi;
#pragma unroll
                for (int r = 0; r < 16; ++r) { const int c = (r & 3) + 8 * (r >> 2); if (c > dq) p0[r] = -INFINITY; if (c + 32 > dq) p1[r] = -INFINITY; }
            }
            float mx = p0[0];
#pragma unroll
            for (int r = 1; r < 16; ++r) mx = fmaxf(mx, p0[r]);
#pragma unroll
            for (int r = 0; r < 16; ++r) mx = fmaxf(mx, p1[r]);
            mx = ATT_PERMLANE ? xhalf_max(mx) : fmaxf(mx, __shfl_xor(mx, 32));
            const float mnew = fmaxf(mrun[bk], mx);
            if (__any(mx > mrun[bk] + 2.0f)) {
                const float alpha = __builtin_amdgcn_exp2f(mrun[bk] - mnew);
                lrun[bk] *= alpha;
#pragma unroll
                for (int d = 0; d < 4; ++d)
#pragma unroll
                    for (int r = 0; r < 16; ++r) o[bk][d][r] *= alpha;
                mrun[bk] = mnew;
            }
#if ATT_VPRE
            float ps = 0.f; const float msh = mrun[bk] - 6.0f;
            i32x8a pf;
#pragma unroll
            for (int r = 0; r < 16; ++r) { p0[r] = __builtin_amdgcn_exp2f(p0[r] - msh); ps += p0[r]; }
            pf[0] = (int)pk4_fp8(p0[0], p0[1], p0[2], p0[3]); pf[1] = (int)pk4_fp8(p0[4], p0[5], p0[6], p0[7]); pf[2] = (int)pk4_fp8(p0[8], p0[9], p0[10], p0[11]); pf[3] = (int)pk4_fp8(p0[12], p0[13], p0[14], p0[15]);
            asm volatile("" : "+v"(pf[0]), "+v"(pf[1]), "+v"(pf[2]), "+v"(pf[3]));
            i32x8a vf0, vf1, vf2, vf3;
            { const i32x4a a = *(const LAS i32x4a*)(vs_ + 0 * 512), b = *(const LAS i32x4a*)(vs_ + 0 * 512 + 2048); vf0 = __builtin_shufflevector(a, b, 0, 1, 2, 3, 4, 5, 6, 7); }
            { const i32x4a a = *(const LAS i32x4a*)(vs_ + 1 * 512), b = *(const LAS i32x4a*)(vs_ + 1 * 512 + 2048); vf1 = __builtin_shufflevector(a, b, 0, 1, 2, 3, 4, 5, 6, 7); }
            asm volatile("" ::: "memory");
#pragma unroll
            for (int r = 0; r < 16; ++r) { p1[r] = __builtin_amdgcn_exp2f(p1[r] - msh); ps += p1[r]; }
            lrun[bk] += ps;
            pf[4] = (int)pk4_fp8(p1[0], p1[1], p1[2], p1[3]); pf[5] = (int)pk4_fp8(p1[4], p1[5], p1[6], p1[7]); pf[6] = (int)pk4_fp8(p1[8], p1[9], p1[10], p1[11]); pf[7] = (int)pk4_fp8(p1[12], p1[13], p1[14], p1[15]);
            asm volatile("" : "+v"(pf));
            { const i32x4a a = *(const LAS i32x4a*)(vs_ + 2 * 512), b = *(const LAS i32x4a*)(vs_ + 2 * 512 + 2048); vf2 = __builtin_shufflevector(a, b, 0, 1, 2, 3, 4, 5, 6, 7); }
            { const i32x4a a = *(const LAS i32x4a*)(vs_ + 3 * 512), b = *(const LAS i32x4a*)(vs_ + 3 * 512 + 2048); vf3 = __builtin_shufflevector(a, b, 0, 1, 2, 3, 4, 5, 6, 7); }
            asm volatile("v_mfma_scale_f32_32x32x64_f8f6f4 %0, %1, %2, %0, %3, %4 op_sel_hi:[0,0,0]" : "+v"(o[bk][0]) : "v"(vf0), "v"(pf), "v"(S1), "v"(SP));
            asm volatile("v_mfma_scale_f32_32x32x64_f8f6f4 %0, %1, %2, %0, %3, %4 op_sel_hi:[0,0,0]" : "+v"(o[bk][1]) : "v"(vf1), "v"(pf), "v"(S1), "v"(SP));
            asm volatile("v_mfma_scale_f32_32x32x64_f8f6f4 %0, %1, %2, %0, %3, %4 op_sel_hi:[0,0,0]" : "+v"(o[bk][2]) : "v"(vf2), "v"(pf), "v"(S1), "v"(SP));
            asm volatile("v_mfma_scale_f32_32x32x64_f8f6f4 %0, %1, %2, %0, %3, %4 op_sel_hi:[0,0,0]" : "+v"(o[bk][3]) : "v"(vf3), "v"(pf), "v"(S1), "v"(SP));
#else
            float ps = 0.f; const float msh = mrun[bk] - 6.0f;
#pragma unroll
            for (int r = 0; r < 16; ++r) { p0[r] = __builtin_amdgcn_exp2f(p0[r] - msh); p1[r] = __builtin_amdgcn_exp2f(p1[r] - msh); ps += p0[r] + p1[r]; }
            lrun[bk] += ps;
            i32x8a pf;
            pf[0] = (int)pk4_fp8(p0[0], p0[1], p0[2], p0[3]); pf[1] = (int)pk4_fp8(p0[4], p0[5], p0[6], p0[7]); pf[2] = (int)pk4_fp8(p0[8], p0[9], p0[10], p0[11]); pf[3] = (int)pk4_fp8(p0[12], p0[13], p0[14], p0[15]);
            pf[4] = (int)pk4_fp8(p1[0], p1[1], p1[2], p1[3]); pf[5] = (int)pk4_fp8(p1[4], p1[5], p1[6], p1[7]); pf[6] = (int)pk4_fp8(p1[8], p1[9], p1[10], p1[11]); pf[7] = (int)pk4_fp8(p1[12], p1[13], p1[14], p1[15]);
            asm volatile("" : "+v"(pf));
#if ATT_DEFER
            if (bk == 0) { pf_prev = pf; have_prev = true; } else
#endif
            {
#pragma unroll
            for (int db = 0; db < 4; ++db) { const i32x4a a = *(const LAS i32x4a*)(vs_ + db * 512), b = *(const LAS i32x4a*)(vs_ + db * 512 + 2048);
                const i32x8a vfd = __builtin_shufflevector(a, b, 0, 1, 2, 3, 4, 5, 6, 7);
                asm volatile("v_mfma_scale_f32_32x32x64_f8f6f4 %0, %1, %2, %0, %3, %4 op_sel_hi:[0,0,0]" : "+v"(o[bk][db]) : "v"(vfd), "v"(pf), "v"(S1), "v"(SP)); }
            }
#endif
#endif
        }
    }
    asm volatile("s_nop 15\n s_nop 15" ::: "memory");
#pragma unroll
    for (int bk = 0; bk < 2; ++bk) {
        const float lt = ATT_PERMLANE ? xhalf_sum(lrun[bk]) : lrun[bk] + __shfl_xor(lrun[bk], 32);
        const float il = 64.0f * ATT_OS / lt;
#if ATT_OWIDE
        unsigned ooff_ = (unsigned)(r32 * opitch + 16 * hi); asm volatile("" : "+v"(ooff_));
        GAS unsigned char* op = (GAS unsigned char*)Ow + (size_t)(128 * bk) * opitch + ooff_;
#pragma unroll
        for (int db = 0; db < 4; ++db) {
            unsigned w[4];
#pragma unroll
            for (int rg = 0; rg < 4; ++rg) w[rg] = pk4_fp8(o[bk][db][4 * rg] * il, o[bk][db][4 * rg + 1] * il, o[bk][db][4 * rg + 2] * il, o[bk][db][4 * rg + 3] * il);
            const auto s02 = __builtin_amdgcn_permlane32_swap(w[0], w[2], false, false);
            const auto s13 = __builtin_amdgcn_permlane32_swap(w[1], w[3], false, false);
            v4u ov; ov.x = s02[0]; ov.y = s02[1]; ov.z = s13[0]; ov.w = s13[1];
            *(GAS v4u*)(op + 32 * db) = ov;
            __builtin_amdgcn_sched_barrier(0);
        }
    }
#else
        GAS unsigned char* op = (GAS unsigned char*)Ow + (size_t)(128 * bk + r32) * opitch + 4 * hi;
#pragma unroll
        for (int db = 0; db < 4; ++db)
#pragma unroll
            for (int rg = 0; rg < 4; ++rg) *(GAS unsigned*)(op + 32 * db + 8 * rg) = pk4_fp8(o[bk][db][4 * rg] * il, o[bk][db][4 * rg + 1] * il, o[bk][db][4 * rg + 2] * il, o[bk][db][4 * rg + 3] * il);
    }
#endif
    asm volatile("s_waitcnt vmcnt(0) lgkmcnt(0)" ::: "memory");
    att_bar4(bctr, nbar, lane);
#undef A2_ISSUE
#undef A2_PIECE
#undef A2_SPREAD
}
struct Frame {
    LAS unsigned char* lds;
    volatile LAS unsigned* MISC;
    gu32* ctl;
    int tid, lane, wave, vcu, G;
    unsigned char* ws;
};
#define WSP(T_, off) ((T_*)(F.ws + (off)))

template <int PART>
__device__ __forceinline__ void p0_prologue(Frame& F, const float* const* in, const int rank = 0, const int nrank = 0) {
    LAS float* scr = (LAS float*)(F.lds + RING_OFF + F.wave * 16640);
    const int gw = (PART == 1 ? rank : F.vcu) * NWAVES + F.wave, NGW = (PART == 1 ? nrank : F.G) * NWAVES, lane = F.lane;
    constexpr int I0 = 32 * 65, I1 = 32 * 96, I2 = 32 * 16, I3 = 32 * 16, I4 = 8 * 48, I5 = 8 * 64, I6 = 16 * 32, I7 = 32 * 32, I8 = 16 * 32, I9 = 32 * 32;
    constexpr int NITEMS = I0 + I1 + I2 + I3 + I4 + I5 + I6 + I7 + I8 + I9;
    bf16* W1T = WSP(bf16, WS_W1T);
    constexpr int NIT_A = I0 + I1 + I2 + I3;
    constexpr int NIT_B = (PRO_SPLIT == 2) ? NIT_A + I4 + I5 : NITEMS;
    const int it_lo = (PART == 1) ? NIT_A : 0, it_hi = (PART == 1) ? NIT_B : NITEMS;
    for (int it = it_lo + gw; it < it_hi; it += NGW) {
        if (PART == 0 && PRO_SPLIT && it >= NIT_A && it < NIT_B) continue;
        int r = it;
        if (r < I0) { const int kb = r / 65, cb = r % 65, c = 64 * cb;
            const int r0 = c < 3072 ? c : (c < 3136 ? 4096 + (c - 3072) : 3072 + (c - 3136));
            if (GATE_F8 && (UV_F8 == 1 || r0 >= (UV_F8 == 2 ? 1024 : 2048))) transpose_item64_f8(in[4], 4160, 64 * kb, c, WSP(unsigned char, WS_WG8U), 2048, r0, scr, lane, MOE_WSCALE);
            else transpose_item64(in[4], 4160, 64 * kb, c, W1T, HPITCH, r0, scr, lane);
            continue; } r -= I0;
        if (r < I1) { const int kb = r / 96, cb = r % 96;
            if (GATE_F8) transpose_item64_f8(in[5], 6144, 64 * kb, 64 * cb, WSP(unsigned char, WS_WG8), 2048, 9 * 256 + 64 * cb, scr, lane, MOE_WSCALE);
            else transpose_item64(in[5], 6144, 64 * kb, 64 * cb, W1T, HPITCH, P1_G + 64 * cb, scr, lane);
            continue; } r -= I1;
        if (r < I2) { const int kb = r / 16, cb = r % 16;
            if (GATE_F8) transpose_item64_f8(in[20], 1024, 64 * kb, 64 * cb, WSP(unsigned char, WS_WG8), 2048, 33 * 256 + 64 * cb, scr, lane, MOE_WSCALE);
            else transpose_item64(in[20], 1024, 64 * kb, 64 * cb, W1T, HPITCH, P1N + 64 * cb, scr, lane);
            continue; } r -= I2;
        if (r < I3) { const int kb = r / 16, cb = r % 16;
            if (GATE_F8) transpose_item64_f8(in[21], 1024, 64 * kb, 64 * cb, WSP(unsigned char, WS_WG8), 2048, 33 * 256 + 1024 + 64 * cb, scr, lane, MOE_WSCALE);
            else transpose_item64(in[21], 1024, 64 * kb, 64 * cb, W1T, HPITCH, P1N + 1024 + 64 * cb, scr, lane);
            continue; } r -= I3;
        if (r < I4) { const int kb = r / 48, cb = r % 48, hh = cb / 3, part = cb % 3;
            if (part < 2) transpose_item64_f8(in[13], 3072, 64 * kb, 64 * cb, WSP(unsigned char, WS_WUQT), 512, 256 * hh + 64 * part, scr, lane, UP_WSCALE);
            else transpose_item64_f8<true>(in[13], 3072, 64 * kb, 64 * cb, WSP(unsigned char, WS_WUQT), 512, 256 * hh + 128, scr, lane, UP_WSCALE);
            continue; } r -= I4;
        if (r < I5) { const int kb = r / 64, cb = r % 64; transpose_item64_f8(in[15], 4096, 64 * kb, 64 * cb, WSP(unsigned char, WS_WUKVT), 512, 64 * cb, scr, lane, UP_WSCALE); continue; } r -= I5;
        if (r < I6) { const int kb = r / 32, cb = r % 32; transpose_item64(in[11], 2048, 64 * kb, 64 * cb, WSP(bf16, WS_WPT), ABC_LD, 64 * cb, scr, lane, 0); continue; } r -= I6;
        if (r < I7) { const int kb = r / 32, cb = r % 32; transpose_item64_f8(in[18], 2048, 64 * kb, 64 * cb, WSP(unsigned char, WS_WPT) + ABC_BB, ABC_ROWB, 64 * cb, scr, lane, MOE_WSCALE); continue; } r -= I7;
        if (r < I8) { const int kb = r / 32, cb = r % 32; transpose_item64_f8(in[24], 2048, 64 * kb, 64 * cb, WSP(unsigned char, WS_WPT) + ABC_CB, ABC_ROWB, 64 * cb, scr, lane, MOE_WSCALE); continue; } r -= I8;
        { const int kb = r / 32, cb = r % 32; transpose_item64(in[25], 2048, 64 * kb, 64 * cb, WSP(bf16, WS_WOT), 2048, 64 * cb, scr, lane); }
    }
    if (PART == 1) return;
    const int gt = gw * 64 + lane, NGT = NGW * 64;
    for (int i = gt; i < 192 * 2048 / 8; i += NGT) { const int rr = i / 256, cc = i % 256; *(GAS v4u*)(W1T + (size_t)(4160 + rr) * HPITCH + (size_t)cc * 8) = (v4u){0u, 0u, 0u, 0u}; }
    if (GATE_F8) for (int i = gt; i < 192 * 2048 / 16; i += NGT) *(GAS v4u*)(WSP(unsigned char, WS_WG8) + (size_t)(2048 + 64) * 2048 + (size_t)i * 16) = (v4u){0u, 0u, 0u, 0u};
    for (int i = gt; i < 16 * 64 * 512 / 16; i += NGT) { const int hh = i / (64 * 512 / 16), q = i % (64 * 512 / 16); *(GAS v4u*)(WSP(unsigned char, WS_WUQT) + (size_t)(256 * hh + 192) * 512 + (size_t)q * 16) = (v4u){0u, 0u, 0u, 0u}; }
    { const float* wsrc = in[9]; bf16* wsm = WSP(bf16, WS_WSM);
      for (int i = gt; i < 8 * 128 * 128; i += NGT) { const int t = (i >> 7) & 127, s = i & 127; const float v = (s <= t) ? wsrc[i] : 0.f; wsm[i] = (bf16)(cvtpk(v, 0.f) & 0xffffu); } }
    { const float* rw = in[27]; const float* g2 = in[26]; float* rwg = WSP(float, WS_RWG);
#if ROUTER_BF16X2
      { bf16* wh = (bf16*)rwg; bf16* wl = wh + 32 * 2048;
        for (int i = gt; i < 2048 * 32; i += NGT) { const int k = i >> 5, ex = i & 31; const float w = rw[i] * g2[k];
            const unsigned h = cvtpk(w, 0.f) & 0xffffu; const float r = w - __uint_as_float(h << 16);
            wh[ex * 2048 + k] = (bf16)h; wl[ex * 2048 + k] = (bf16)(cvtpk(r, 0.f) & 0xffffu); } }
      (void)rwg; }
#else
      for (int i = gt; i < 2048 * 32; i += NGT) rwg[i] = rw[i] * g2[i >> 5]; }
#endif
    bf16* H = WSP(bf16, WS_H);
    for (int m = gw; m < T + MEMROWS; m += NGW) {
        if (m < T) rms_row_to_bf16(in[0] + (size_t)m * 2048, in[3], H + (size_t)m * HPITCH, lane, WSP(unsigned char, WS_H8) + (size_t)m * 2048);
        else rms_row_to_bf16(in[1] + (size_t)(m - T) * 2048, in[19], H + (size_t)m * HPITCH, lane, WSP(unsigned char, WS_H8) + (size_t)m * 2048);
    }
}

struct MoeItem { const float* src; size_t ldw; unsigned char* dst; int r0; int k0; };
__device__ __forceinline__ MoeItem moe_item(Frame& F, const float* const* in, int it) {
    constexpr int I10 = NE * 32 * 64;
    MoeItem m;
    if (it < I10) { const int e = it / 2048, q = it % 2048, kb = q / 64, cb = q % 64;
        m.r0 = cb < 32 ? 256 * (cb >> 1) + 64 * (cb & 1) : 256 * ((cb - 32) >> 1) + 128 + 64 * (cb & 1);
        m.src = in[29] + (size_t)e * 2048 * 4096 + (size_t)(64 * kb) * 4096 + 64 * cb; m.ldw = 4096; m.dst = WSP(unsigned char, WS_WGUT) + (size_t)e * 4096 * 2048; m.k0 = 64 * kb; }
    else { const int r = it - I10, e = r / 1024, q = r % 1024, kb = q / 32, cb = q % 32;
        m.r0 = 64 * cb; m.src = in[31] + (size_t)e * 2048 * 2048 + (size_t)(64 * kb) * 2048 + 64 * cb; m.ldw = 2048; m.dst = WSP(unsigned char, WS_WDT) + (size_t)e * 2048 * 2048; m.k0 = 64 * kb; }
    return m;
}
#define MOE_LOADS(v_, m_) do { const GAS float* src_ = (const GAS float*)(m_).src + (size_t)(4 * (lane >> 4)) * (m_).ldw + (lane & 15) * 4; \
        _Pragma("unroll") for (int j_ = 0; j_ < 4; ++j_) _Pragma("unroll") for (int r_ = 0; r_ < 4; ++r_) v_[4 * j_ + r_] = __builtin_nontemporal_load((const GAS f32x4*)(src_ + (size_t)(16 * j_ + r_) * (m_).ldw)); } while (0)
#define MOE_TOLDS(v_) do { LAS unsigned* s_ = scr + (4 * (lane & 15)) * 17 + (lane >> 4); \
        _Pragma("unroll") for (int j_ = 0; j_ < 4; ++j_) { \
            s_[0 * 17 + 4 * j_] = pk4_fp8(v_[4 * j_][0] * MOE_WSCALE, v_[4 * j_ + 1][0] * MOE_WSCALE, v_[4 * j_ + 2][0] * MOE_WSCALE, v_[4 * j_ + 3][0] * MOE_WSCALE); \
            s_[1 * 17 + 4 * j_] = pk4_fp8(v_[4 * j_][1] * MOE_WSCALE, v_[4 * j_ + 1][1] * MOE_WSCALE, v_[4 * j_ + 2][1] * MOE_WSCALE, v_[4 * j_ + 3][1] * MOE_WSCALE); \
            s_[2 * 17 + 4 * j_] = pk4_fp8(v_[4 * j_][2] * MOE_WSCALE, v_[4 * j_ + 1][2] * MOE_WSCALE, v_[4 * j_ + 2][2] * MOE_WSCALE, v_[4 * j_ + 3][2] * MOE_WSCALE); \
            s_[3 * 17 + 4 * j_] = pk4_fp8(v_[4 * j_][3] * MOE_WSCALE, v_[4 * j_ + 1][3] * MOE_WSCALE, v_[4 * j_ + 2][3] * MOE_WSCALE, v_[4 * j_ + 3][3] * MOE_WSCALE); } } while (0)
#define MOE_EMIT(m_) do { LDS_WAIT(); asm volatile("" ::: "memory"); \
        _Pragma("unroll") for (int jj_ = 0; jj_ < 4; ++jj_) { const int n_ = (lane >> 2) + 16 * jj_; const LAS unsigned* s_ = scr + n_ * 17 + 4 * (lane & 3); \
            v4u o_; o_.x = s_[0]; o_.y = s_[1]; o_.z = s_[2]; o_.w = s_[3]; \
            __builtin_nontemporal_store(o_, (GAS v4u*)((m_).dst + (size_t)((m_).r0 + n_) * 2048 + (m_).k0 + 16 * (lane & 3))); } \
        LDS_WAIT(); asm volatile("" ::: "memory"); } while (0)
template <int MODE>
__device__ __forceinline__ void moe_convert_share(Frame& F, const float* const* in) {
    LAS unsigned* scr = (LAS unsigned*)(F.lds + RING_OFF + F.wave * 4608);
    constexpr int NIT = NE * 32 * 64 + NE * 32 * 32;
    const int per = (NIT + F.G - 1) / F.G, lo = F.vcu * per, hi = (lo + per < NIT) ? lo + per : NIT, lane = F.lane;
    int it = lo + F.wave;
    f32x4 va[16], vb[16];
    MoeItem ma = moe_item(F, in, it < hi ? it : lo), mb = moe_item(F, in, it + NWAVES < hi ? it + NWAVES : lo);
    if (it < hi) MOE_LOADS(va, ma);
    if (it + NWAVES < hi) MOE_LOADS(vb, mb);
    for (; it < hi; it += 2 * NWAVES) {
        if (MODE == 0) MOE_TOLDS(va); else { _Pragma("unroll") for (int i_ = 0; i_ < 16; ++i_) asm volatile("" :: "v"(va[i_])); }
        const MoeItem na = moe_item(F, in, it + 2 * NWAVES < hi ? it + 2 * NWAVES : lo);
        if (it + 2 * NWAVES < hi) MOE_LOADS(va, na);
        if (MODE == 0) MOE_EMIT(ma);
        if (it + NWAVES < hi) {
            if (MODE == 0) MOE_TOLDS(vb); else { _Pragma("unroll") for (int i_ = 0; i_ < 16; ++i_) asm volatile("" :: "v"(vb[i_])); }
            const MoeItem nb = moe_item(F, in, it + 3 * NWAVES < hi ? it + 3 * NWAVES : lo);
            if (it + 3 * NWAVES < hi) MOE_LOADS(vb, nb);
            if (MODE == 0) MOE_EMIT(mb);
            mb = nb;
        }
        ma = na;
    }
    __syncthreads();
}
#define MOE_LOADS_ASM(v_, m_) do { const GAS float* src_ = (const GAS float*)(m_).src + (size_t)(4 * (lane >> 4)) * (m_).ldw + (lane & 15) * 4; \
        _Pragma("unroll") for (int j_ = 0; j_ < 4; ++j_) _Pragma("unroll") for (int r_ = 0; r_ < 4; ++r_) { const GAS float* p_ = src_ + (size_t)(16 * j_ + r_) * (m_).ldw; \
            asm volatile("global_load_dwordx4 %0, %1, off nt" : "=v"(v_[4 * j_ + r_]) : "v"(p_) : "memory"); } } while (0)
#define MOE_WAIT_ASM(v_, n_) asm volatile("s_waitcnt vmcnt(" #n_ ")" : "+v"(v_[0]), "+v"(v_[1]), "+v"(v_[2]), "+v"(v_[3]), "+v"(v_[4]), "+v"(v_[5]), "+v"(v_[6]), "+v"(v_[7]), \
        "+v"(v_[8]), "+v"(v_[9]), "+v"(v_[10]), "+v"(v_[11]), "+v"(v_[12]), "+v"(v_[13]), "+v"(v_[14]), "+v"(v_[15]) :: "memory")
__device__ __forceinline__ MoeItem moe_super(Frame& F, const float* const* in, int s) {
    constexpr int S10 = NE * 16 * 64;
    MoeItem m;
    if (s < S10) { const int e = s / 1024, q = s % 1024, kb = q / 64, cb = q % 64;
        m.r0 = cb < 32 ? 256 * (cb >> 1) + 64 * (cb & 1) : 256 * ((cb - 32) >> 1) + 128 + 64 * (cb & 1);
        m.src = in[29] + (size_t)e * 2048 * 4096 + (size_t)(128 * kb) * 4096 + 64 * cb; m.ldw = 4096; m.dst = WSP(unsigned char, WS_WGUT) + (size_t)e * 4096 * 2048; m.k0 = 128 * kb; }
    else { const int r = s - S10, e = r / 512, q = r % 512, kb = q / 32, cb = q % 32;
        m.r0 = 64 * cb; m.src = in[31] + (size_t)e * 2048 * 2048 + (size_t)(128 * kb) * 2048 + 64 * cb; m.ldw = 2048; m.dst = WSP(unsigned char, WS_WDT) + (size_t)e * 2048 * 2048; m.k0 = 128 * kb; }
    return m;
}
#define MOE_TOLDS33(v_, h_) do { LAS unsigned* s_ = scr + (4 * (lane & 15)) * 33 + (lane >> 4) + 16 * (h_); \
        _Pragma("unroll") for (int j_ = 0; j_ < 4; ++j_) { \
            s_[0 * 33 + 4 * j_] = pk4_fp8(v_[4 * j_][0] * MOE_WSCALE, v_[4 * j_ + 1][0] * MOE_WSCALE, v_[4 * j_ + 2][0] * MOE_WSCALE, v_[4 * j_ + 3][0] * MOE_WSCALE); \
            s_[1 * 33 + 4 * j_] = pk4_fp8(v_[4 * j_][1] * MOE_WSCALE, v_[4 * j_ + 1][1] * MOE_WSCALE, v_[4 * j_ + 2][1] * MOE_WSCALE, v_[4 * j_ + 3][1] * MOE_WSCALE); \
            s_[2 * 33 + 4 * j_] = pk4_fp8(v_[4 * j_][2] * MOE_WSCALE, v_[4 * j_ + 1][2] * MOE_WSCALE, v_[4 * j_ + 2][2] * MOE_WSCALE, v_[4 * j_ + 3][2] * MOE_WSCALE); \
            s_[3 * 33 + 4 * j_] = pk4_fp8(v_[4 * j_][3] * MOE_WSCALE, v_[4 * j_ + 1][3] * MOE_WSCALE, v_[4 * j_ + 2][3] * MOE_WSCALE, v_[4 * j_ + 3][3] * MOE_WSCALE); } } while (0)
#define MOE_EMIT33(m_) do { LDS_WAIT(); asm volatile("" ::: "memory"); \
        _Pragma("unroll") for (int jj_ = 0; jj_ < 8; ++jj_) { const int n_ = (lane >> 3) + 8 * jj_; const LAS unsigned* s_ = scr + n_ * 33 + 4 * (lane & 7); \
            v4u o_; o_.x = s_[0]; o_.y = s_[1]; o_.z = s_[2]; o_.w = s_[3]; \
            __builtin_nontemporal_store(o_, (GAS v4u*)((m_).dst + (size_t)((m_).r0 + n_) * 2048 + (m_).k0 + 16 * (lane & 7))); } \
        LDS_WAIT(); asm volatile("" ::: "memory"); } while (0)
template <int NW>
__device__ __forceinline__ void moe_convert_share_w(Frame& F, const float* const* in, const int cw, LAS unsigned* scr, const int lane) {
    constexpr int NSUP = NE * 16 * 64 + NE * 16 * 32, PER = NSUP / 256;
    static_assert(PER % NW == 0, "equal shares");
    const int lo = F.vcu * PER, hi = lo + PER;
    int it = lo + cw;
    f32x4 va[16], vb[16];
    MoeItem m = moe_super(F, in, it), mh = m;
    mh.src += (size_t)64 * m.ldw;
    MOE_LOADS_ASM(va, m);
    MOE_LOADS_ASM(vb, mh);
    bool first = true;
    for (; it < hi; it += NW) {
        MoeItem n = moe_super(F, in, it + NW < hi ? it + NW : lo), nh = n;
        nh.src += (size_t)64 * n.ldw;
        MOE_WAIT_ASM(va, 16);
        MOE_TOLDS33(va, 0);
        MOE_LOADS_ASM(va, n);
        MOE_WAIT_ASM(vb, 16);
        MOE_TOLDS33(vb, 1);
        MOE_LOADS_ASM(vb, nh);
        MOE_EMIT33(m);
        m = n; first = false;
    }
    MOE_WAIT_ASM(va, 0); MOE_WAIT_ASM(vb, 0);
}
#undef MOE_TOLDS33
#undef MOE_EMIT33
__device__ __forceinline__ MoeItem moe_super256(Frame& F, const float* const* in, int s) {
    constexpr int S10 = NE * 8 * 64;
    MoeItem m;
    if (s < S10) { const int e = s / 512, q = s % 512, kb = q / 64, cb = q % 64;
        m.r0 = cb < 32 ? 256 * (cb >> 1) + 64 * (cb & 1) : 256 * ((cb - 32) >> 1) + 128 + 64 * (cb & 1);
        m.src = in[29] + (size_t)e * 2048 * 4096 + (size_t)(256 * kb) * 4096 + 64 * cb; m.ldw = 4096; m.dst = WSP(unsigned char, WS_WGUT) + (size_t)e * 4096 * 2048; m.k0 = 256 * kb; }
    else { const int r = s - S10, e = r / 256, q = r % 256, kb = q / 32, cb = q % 32;
        m.r0 = 64 * cb; m.src = in[31] + (size_t)e * 2048 * 2048 + (size_t)(256 * kb) * 2048 + 64 * cb; m.ldw = 2048; m.dst = WSP(unsigned char, WS_WDT) + (size_t)e * 2048 * 2048; m.k0 = 256 * kb; }
    return m;
}
#define MOE_TOLDS65(v_, h_) do { LAS unsigned* s_ = scr + (4 * (lane & 15)) * 65 + (lane >> 4) + 16 * (h_); \
        _Pragma("unroll") for (int j_ = 0; j_ < 4; ++j_) { \
            s_[0 * 65 + 4 * j_] = pk4_fp8(v_[4 * j_][0] * MOE_WSCALE, v_[4 * j_ + 1][0] * MOE_WSCALE, v_[4 * j_ + 2][0] * MOE_WSCALE, v_[4 * j_ + 3][0] * MOE_WSCALE); \
            s_[1 * 65 + 4 * j_] = pk4_fp8(v_[4 * j_][1] * MOE_WSCALE, v_[4 * j_ + 1][1] * MOE_WSCALE, v_[4 * j_ + 2][1] * MOE_WSCALE, v_[4 * j_ + 3][1] * MOE_WSCALE); \
            s_[2 * 65 + 4 * j_] = pk4_fp8(v_[4 * j_][2] * MOE_WSCALE, v_[4 * j_ + 1][2] * MOE_WSCALE, v_[4 * j_ + 2][2] * MOE_WSCALE, v_[4 * j_ + 3][2] * MOE_WSCALE); \
            s_[3 * 65 + 4 * j_] = pk4_fp8(v_[4 * j_][3] * MOE_WSCALE, v_[4 * j_ + 1][3] * MOE_WSCALE, v_[4 * j_ + 2][3] * MOE_WSCALE, v_[4 * j_ + 3][3] * MOE_WSCALE); } } while (0)
#define MOE_EMIT65(m_) do { LDS_WAIT(); asm volatile("" ::: "memory"); \
        _Pragma("unroll") for (int jj_ = 0; jj_ < 16; ++jj_) { const int n_ = (lane >> 4) + 4 * jj_; const LAS unsigned* s_ = scr + n_ * 65 + 4 * (lane & 15); \
            v4u o_; o_.x = s_[0]; o_.y = s_[1]; o_.z = s_[2]; o_.w = s_[3]; \
            __builtin_nontemporal_store(o_, (GAS v4u*)((m_).dst + (size_t)((m_).r0 + n_) * 2048 + (m_).k0 + 16 * (lane & 15))); } \
        LDS_WAIT(); asm volatile("" ::: "memory"); } while (0)
#define MOE_Q(m_, q_) MoeItem{(m_).src + (size_t)(64 * (q_)) * (m_).ldw, (m_).ldw, (m_).dst, (m_).r0, (m_).k0}
template <int NW>
__device__ __forceinline__ void moe_convert_range256(Frame& F, const float* const* in, const int cw, LAS unsigned* scr, const int lane, const int lo, const int hi) {
    int it = lo + cw;
    f32x4 va[16], vb[16];
    MoeItem m = moe_super256(F, in, it);
    { const MoeItem q0 = MOE_Q(m, 0), q1 = MOE_Q(m, 1); MOE_LOADS_ASM(va, q0); MOE_LOADS_ASM(vb, q1); }
    bool first = true;
    for (; it < hi; it += NW) {
        const MoeItem n = moe_super256(F, in, it + NW < hi ? it + NW : lo);
        const MoeItem q2 = MOE_Q(m, 2), q3 = MOE_Q(m, 3), n0 = MOE_Q(n, 0), n1 = MOE_Q(n, 1);
        MOE_WAIT_ASM(va, 16);
        MOE_TOLDS65(va, 0); MOE_LOADS_ASM(va, q2);
        MOE_WAIT_ASM(vb, 16);
        MOE_TOLDS65(vb, 1); MOE_LOADS_ASM(vb, q3);
        MOE_WAIT_ASM(va, 16);
        MOE_TOLDS65(va, 2); MOE_LOADS_ASM(va, n0);
        MOE_WAIT_ASM(vb, 16);
        MOE_TOLDS65(vb, 3); MOE_LOADS_ASM(vb, n1);
        MOE_EMIT65(m);
        if (CONV_SLEEP > 0) __builtin_amdgcn_s_sleep(CONV_SLEEP);
        m = n; first = false;
    }
    MOE_WAIT_ASM(va, 0); MOE_WAIT_ASM(vb, 0);
}
constexpr int CONV_NSUP = NE * 8 * 64 + NE * 8 * 32, CONV_OFF_CUS = (CONV_OFFLOAD == 2) ? 160 : 128, CONV_OFF = CONV_OFFLOAD ? 8 * CONV_OFF_CUS : 0, CONV_PER5 = (CONV_NSUP - CONV_OFF) / 256;
static_assert((CONV_NSUP - CONV_OFF) % 256 == 0, "equal shares per workgroup");
template <int NW>
__device__ __forceinline__ void moe_convert_share_w256(Frame& F, const float* const* in, const int cw, LAS unsigned* scr, const int lane) {
    moe_convert_range256<NW>(F, in, cw, scr, lane, F.vcu * CONV_PER5, F.vcu * CONV_PER5 + CONV_PER5);
}
#undef MOE_TOLDS65
#undef MOE_EMIT65
#undef MOE_Q
#undef MOE_LOADS_ASM
#undef MOE_WAIT_ASM
#undef MOE_LOADS
#undef MOE_TOLDS
#undef MOE_EMIT

__device__ __forceinline__ void moe_convert_share_dma(Frame& F, const float* const* in) {
    LAS unsigned char* wbase = F.lds + RING_OFF + F.wave * 16640;
    LAS unsigned* tile2 = (LAS unsigned*)(wbase + 12288);
    constexpr int NIT = NE * 32 * 64 + NE * 32 * 32;
    const int per = (NIT + F.G - 1) / F.G, lo = F.vcu * per, hi = (lo + per < NIT) ? lo + per : NIT, lane = F.lane;
    const int nitems = (hi - lo - F.wave + NWAVES - 1) / NWAVES;
    if (nitems > 0) {
        const int nchunks = nitems * 4;
        const int ng = lane & 15, kr = lane >> 4;
#define CDMA_ISSUE(c_) do { const MoeItem m_ = moe_item(F, in, lo + F.wave + NWAVES * ((c_) >> 2)); const int kc_ = (c_) & 3; \
            const GAS unsigned char* g_ = (const GAS unsigned char*)m_.src + ((size_t)(16 * kc_ + kr) * m_.ldw + (size_t)ng * 4) * 4; LAS unsigned char* l_ = wbase + ((c_) % 3) * 4096; \
            _Pragma("unroll") for (int q_ = 0; q_ < 4; ++q_) __builtin_amdgcn_global_load_lds((const GAS unsigned*)(g_ + (size_t)(4 * q_) * m_.ldw * 4), (LAS unsigned*)(l_ + q_ * 1024), 16, 0, 2); } while (0)
        CDMA_ISSUE(0);
        if (nchunks > 1) CDMA_ISSUE(1);
        for (int c = 0; c < nchunks; ++c) {
            if (c + 2 < nchunks) { CDMA_ISSUE(c + 2); asm volatile("s_waitcnt vmcnt(8)" ::: "memory"); }
            else if (c + 1 < nchunks) asm volatile("s_waitcnt vmcnt(4)" ::: "memory");
            else asm volatile("s_waitcnt vmcnt(0)" ::: "memory");
            const LAS unsigned char* cb = wbase + (c % 3) * 4096 + (4 * kr) * 256 + ng * 16;
            const f32x4 r0 = *(const LAS f32x4*)(cb), r1 = *(const LAS f32x4*)(cb + 256), r2 = *(const LAS f32x4*)(cb + 512), r3 = *(const LAS f32x4*)(cb + 768);
            LAS unsigned* t2 = tile2 + (4 * ng) * 17 + 4 * (c & 3) + kr;
            t2[0 * 17] = pk4_fp8(r0[0] * MOE_WSCALE, r1[0] * MOE_WSCALE, r2[0] * MOE_WSCALE, r3[0] * MOE_WSCALE);
            t2[1 * 17] = pk4_fp8(r0[1] * MOE_WSCALE, r1[1] * MOE_WSCALE, r2[1] * MOE_WSCALE, r3[1] * MOE_WSCALE);
            t2[2 * 17] = pk4_fp8(r0[2] * MOE_WSCALE, r1[2] * MOE_WSCALE, r2[2] * MOE_WSCALE, r3[2] * MOE_WSCALE);
            t2[3 * 17] = pk4_fp8(r0[3] * MOE_WSCALE, r1[3] * MOE_WSCALE, r2[3] * MOE_WSCALE, r3[3] * MOE_WSCALE);
            LDS_WAIT(); asm volatile("" ::: "memory");
            if ((c & 3) == 3) {
                const MoeItem m = moe_item(F, in, lo + F.wave + NWAVES * (c >> 2));
#pragma unroll
                for (int jj = 0; jj < 4; ++jj) { const int n = (lane >> 2) + 16 * jj; const LAS unsigned* s = tile2 + n * 17 + 4 * (lane & 3);
                    v4u o; o.x = s[0]; o.y = s[1]; o.z = s[2]; o.w = s[3];
                    __builtin_nontemporal_store(o, (GAS v4u*)(m.dst + (size_t)(m.r0 + n) * 2048 + m.k0 + 16 * (lane & 3))); }
                LDS_WAIT(); asm volatile("" ::: "memory");
            }
        }
#undef CDMA_ISSUE
    }
    asm volatile("s_waitcnt vmcnt(0)" ::: "memory");
    __syncthreads();
}

struct MoeItem256 { const float* src; size_t ldw; unsigned char* dst; int rowbase; int rowmode; int k0; };
__device__ __forceinline__ MoeItem256 moe_item256(Frame& F, const float* const* in, int it) {
    constexpr int I10 = NE * 32 * 64;
    MoeItem256 m;
    if (it < I10) { const int e = it / 2048, q = it % 2048, kb = q / 16, cb = q % 16; const bool gate = cb < 8; const int grp0 = gate ? 2 * cb : 2 * (cb - 8);
        m.src = in[29] + (size_t)e * 2048 * 4096 + (size_t)(16 * kb) * 4096 + 256 * cb; m.ldw = 4096; m.dst = WSP(unsigned char, WS_WGUT) + (size_t)e * 4096 * 2048;
        m.rowbase = 256 * grp0 + (gate ? 0 : 128); m.rowmode = 1; m.k0 = 16 * kb; }
    else { const int r = it - I10, e = r / 1024, q = r % 1024, kb = q / 8, cb = q % 8;
        m.src = in[31] + (size_t)e * 2048 * 2048 + (size_t)(16 * kb) * 2048 + 256 * cb; m.ldw = 2048; m.dst = WSP(unsigned char, WS_WDT) + (size_t)e * 2048 * 2048;
        m.rowbase = 256 * cb; m.rowmode = 0; m.k0 = 16 * kb; }
    return m;
}
__device__ __forceinline__ void moe_convert_share_dma256(Frame& F, const float* const* in) {
    LAS unsigned char* wbase = F.lds + RING_OFF + F.wave * 16640;
    LAS unsigned* tile2 = (LAS unsigned*)(wbase + 12288);
    constexpr int NIT = NE * 32 * 64 + NE * 32 * 32;
    const int per = (NIT + F.G - 1) / F.G, lo = F.vcu * per, hi = (lo + per < NIT) ? lo + per : NIT, lane = F.lane;
    const int nitems = (hi - lo - F.wave + NWAVES - 1) / NWAVES;
    if (nitems > 0) {
        const int nchunks = nitems * 4;
#define C256_ISSUE(c_) do { const MoeItem256 m_ = moe_item256(F, in, lo + F.wave + NWAVES * ((c_) >> 2)); const int kc_ = (c_) & 3; \
            const GAS unsigned char* g_ = (const GAS unsigned char*)m_.src + ((size_t)(4 * kc_) * m_.ldw + (size_t)lane * 4) * 4; LAS unsigned char* l_ = wbase + ((c_) % 3) * 4096; \
            _Pragma("unroll") for (int r_ = 0; r_ < 4; ++r_) __builtin_amdgcn_global_load_lds((const GAS unsigned*)(g_ + (size_t)r_ * m_.ldw * 4), (LAS unsigned*)(l_ + r_ * 1024), 16, 0, 2); } while (0)
        C256_ISSUE(0);
        if (nchunks > 1) C256_ISSUE(1);
        for (int c = 0; c < nchunks; ++c) {
            if (c + 2 < nchunks) { C256_ISSUE(c + 2); asm volatile("s_waitcnt vmcnt(8)" ::: "memory"); }
            else if (c + 1 < nchunks) asm volatile("s_waitcnt vmcnt(4)" ::: "memory");
            else asm volatile("s_waitcnt vmcnt(0)" ::: "memory");
            const LAS float* cb = (const LAS float*)(wbase + (c % 3) * 4096) + lane;
            LAS unsigned* t2 = tile2 + (c & 3) * 256 + lane;
#pragma unroll
            for (int cc = 0; cc < 4; ++cc) t2[64 * cc] = pk4_fp8(cb[64 * cc] * MOE_WSCALE, cb[256 + 64 * cc] * MOE_WSCALE, cb[512 + 64 * cc] * MOE_WSCALE, cb[768 + 64 * cc] * MOE_WSCALE);
            LDS_WAIT(); asm volatile("" ::: "memory");
            if ((c & 3) == 3) {
                const MoeItem256 m = moe_item256(F, in, lo + F.wave + NWAVES * (c >> 2));
#pragma unroll
                for (int cc = 0; cc < 4; ++cc) { const LAS unsigned* s = tile2 + lane + 64 * cc;
                    v4u o; o.x = s[0]; o.y = s[256]; o.z = s[512]; o.w = s[768];
                    const int row = m.rowbase + (m.rowmode ? 256 * (cc >> 1) + lane + 64 * (cc & 1) : lane + 64 * cc);
                    __builtin_nontemporal_store(o, (GAS v4u*)(m.dst + (size_t)row * 2048 + m.k0)); }
                LDS_WAIT(); asm volatile("" ::: "memory");
            }
        }
#undef C256_ISSUE
    }
    asm volatile("s_waitcnt vmcnt(0)" ::: "memory");
    __syncthreads();
}

struct ConvState { int lo, nchunks, c, cw; };
template <int NCW>
__device__ __forceinline__ void conv_steps(Frame& F, const float* const* in, ConvState& S, LAS unsigned char* wbase, int nsteps, int lane) {
    LAS unsigned* tile2 = (LAS unsigned*)(wbase + 12288);
    const int ng = lane & 15, kr = lane >> 4;
#define CS_ISSUE(c_) do { const MoeItem m_ = moe_item(F, in, S.lo + S.cw + NCW * ((c_) >> 2)); const int kc_ = (c_) & 3; \
        const GAS unsigned char* g_ = (const GAS unsigned char*)m_.src + ((size_t)(16 * kc_ + kr) * m_.ldw + (size_t)ng * 4) * 4; LAS unsigned char* l_ = wbase + ((c_) % 3) * 4096; \
        _Pragma("unroll") for (int q_ = 0; q_ < 4; ++q_) __builtin_amdgcn_global_load_lds((const GAS unsigned*)(g_ + (size_t)(4 * q_) * m_.ldw * 4), (LAS unsigned*)(l_ + q_ * 1024), 16, 0, 2); } while (0)
    if (S.c < 0) { S.c = 0; if (S.nchunks > 0) CS_ISSUE(0); if (S.nchunks > 1) CS_ISSUE(1); }
    for (int st = 0; st < nsteps && S.c < S.nchunks; ++st) {
        const int c = S.c;
        if (c + 2 < S.nchunks) { CS_ISSUE(c + 2); asm volatile("s_waitcnt vmcnt(8)" ::: "memory"); }
        else if (c + 1 < S.nchunks) asm volatile("s_waitcnt vmcnt(4)" ::: "memory");
        else asm volatile("s_waitcnt vmcnt(0)" ::: "memory");
        const LAS unsigned char* cb = wbase + (c % 3) * 4096 + (4 * kr) * 256 + ng * 16;
        const f32x4 r0 = *(const LAS f32x4*)(cb), r1 = *(const LAS f32x4*)(cb + 256), r2 = *(const LAS f32x4*)(cb + 512), r3 = *(const LAS f32x4*)(cb + 768);
        LAS unsigned* t2 = tile2 + (4 * ng) * 17 + 4 * (c & 3) + kr;
        t2[0 * 17] = pk4_fp8(r0[0] * MOE_WSCALE, r1[0] * MOE_WSCALE, r2[0] * MOE_WSCALE, r3[0] * MOE_WSCALE);
        t2[1 * 17] = pk4_fp8(r0[1] * MOE_WSCALE, r1[1] * MOE_WSCALE, r2[1] * MOE_WSCALE, r3[1] * MOE_WSCALE);
        t2[2 * 17] = pk4_fp8(r0[2] * MOE_WSCALE, r1[2] * MOE_WSCALE, r2[2] * MOE_WSCALE, r3[2] * MOE_WSCALE);
        t2[3 * 17] = pk4_fp8(r0[3] * MOE_WSCALE, r1[3] * MOE_WSCALE, r2[3] * MOE_WSCALE, r3[3] * MOE_WSCALE);
        LDS_WAIT(); asm volatile("" ::: "memory");
        if ((c & 3) == 3) {
            const MoeItem m = moe_item(F, in, S.lo + S.cw + NCW * (c >> 2));
#pragma unroll
            for (int jj = 0; jj < 4; ++jj) { const int n = (lane >> 2) + 16 * jj; const LAS unsigned* s = tile2 + n * 17 + 4 * (lane & 3);
                v4u o; o.x = s[0]; o.y = s[1]; o.z = s[2]; o.w = s[3];
                __builtin_nontemporal_store(o, (GAS v4u*)(m.dst + (size_t)(m.r0 + n) * 2048 + m.k0 + 16 * (lane & 3))); }
            LDS_WAIT(); asm volatile("" ::: "memory");
        }
        S.c = c + 1;
    }
#undef CS_ISSUE
}

__device__ __forceinline__ float group16_sum(float v) { if (XL_FAST) return xl_sum16(v); v += __shfl_xor(v, 1); v += __shfl_xor(v, 2); v += __shfl_xor(v, 4); v += __shfl_xor(v, 8); return v; }
__device__ __forceinline__ void p2_token(Frame& F, const float* const* in, int t) {
    const int l = F.lane;
    const GAS bf16* row = (const GAS bf16*)WSP(bf16, WS_P1) + (size_t)t * P1N;
    { float a[8], b[8]; unpack8(*(const GAS v4u*)(row + P1_V + 16 * l), a); unpack8(*(const GAS v4u*)(row + P1_V + 16 * l + 8), b);
      float s = 0.f;
#pragma unroll
      for (int i = 0; i < 8; ++i) s += a[i] + b[i];
      const float mean = wave_sum(s) * (1.f / 1024.f); float q = 0.f;
#pragma unroll
      for (int i = 0; i < 8; ++i) { const float d0 = a[i] - mean, d1 = b[i] - mean; q += d0 * d0 + d1 * d1; }
      const float rstd = 1.0f * FAST_RSQ(wave_sum(q) * (1.f / 1024.f) + EPS);
      if (l == 0) { GAS float* vs = (GAS float*)WSP(float, WS_VSTAT) + (size_t)t * 2; vs[0] = mean; vs[1] = rstd; } }
#pragma unroll
    for (int w = 0; w < 2; ++w) {
        float a[8]; unpack8(*(const GAS v4u*)(row + (w ? P1_CKV : P1_CQ) + 8 * l), a);
        float s = 0.f;
#pragma unroll
        for (int i = 0; i < 8; ++i) s += a[i] * a[i];
        const float rs = 1.0f * FAST_RSQ(wave_sum(s) * (1.f / 512.f) + EPS);
        const GAS float* g = (const GAS float*)(w ? in[14] : in[12]) + 8 * l;
        const f32x4 g0 = *(const GAS f32x4*)g, g1 = *(const GAS f32x4*)(g + 4);
        float o[8] = {a[0] * rs * g0.x, a[1] * rs * g0.y, a[2] * rs * g0.z, a[3] * rs * g0.w, a[4] * rs * g1.x, a[5] * rs * g1.y, a[6] * rs * g1.z, a[7] * rs * g1.w};
        u32x2 w8; w8.x = pk4_fp8(o[0], o[1], o[2], o[3]); w8.y = pk4_fp8(o[4], o[5], o[6], o[7]);
        *(GAS u32x2*)((GAS unsigned char*)WSP(unsigned char, w ? WS_CKVN : WS_CQN) + (size_t)t * 512 + 8 * l) = w8;
    }
    { float a[8], b[8]; unpack8(*(const GAS v4u*)(row + P1_QM + 16 * l), a); unpack8(*(const GAS v4u*)(row + P1_QM + 16 * l + 8), b);
      float s = 0.f;
#pragma unroll
      for (int i = 0; i < 8; ++i) s += a[i] * a[i] + b[i] * b[i];
      const float rs = MEM_QSCALE * FAST_RSQ(group16_sum(s) * (1.f / 256.f) + EPS);
      const GAS float* g = (const GAS float*)in[22] + (l & 15) * 16;
      float ga[8], gb[8];
#pragma unroll
      for (int i = 0; i < 8; ++i) { ga[i] = g[i]; gb[i] = g[8 + i]; }
#pragma unroll
      for (int i = 0; i < 8; ++i) { a[i] *= rs * ga[i]; b[i] *= rs * gb[i]; }
      const int bb = t >> 12, tl = t & 4095, h = l >> 4;
      GAS bf16* dst = (GAS bf16*)WSP(bf16, WS_QMN) + ((size_t)((bb * 4 + h) * 4096 + tl)) * 256 + (l & 15) * 16;
      *(GAS v4u*)dst = packf8(a); *(GAS v4u*)(dst + 8) = packf8(b); }
    { float t1 = 0.f, t2 = 0.f;
      if (l < 32) { t1 = bflo((unsigned)row[P1_KR + l]); t2 = bflo((unsigned)row[P1_KR + 32 + l]); }
      const float ss = wave_sum(t1 * t1 + t2 * t2);
      if (l < 32) {
          const float pos = (float)((const GAS int*)in[2])[t];
          const float inv = 1.0f / powf(10000.0f, (float)(2 * l) / 64.0f);
          const float ang = pos * inv, c = cosf(ang), s = sinf(ang);
          GAS float* rp = (GAS float*)WSP(float, WS_ROPE) + (size_t)t * 64; rp[l] = c; rp[32 + l] = s;
          const GAS float* kg = (const GAS float*)in[17];
          const float a = t1 * kg[128 + l], b = t2 * kg[160 + l];
          GAS float* kr = (GAS float*)WSP(float, WS_KRR) + (size_t)t * 64; kr[l] = a * c - b * s; kr[32 + l] = a * s + b * c;
          if (l == 0) ((GAS float*)WSP(float, WS_KRSS))[t] = ss;
      } }
}
__device__ __forceinline__ void p2_memrow(Frame& F, const float* const* in, int m) {
    const int l = F.lane, bb = m >> 8, ml = m & 255, tile = ml >> 6, key = ml & 63, h = l >> 4, d0 = (l & 15) * 16;
    const GAS bf16* row = (const GAS bf16*)WSP(bf16, WS_MKV) + (size_t)m * 2048;
    { float a[8], b[8]; unpack8(*(const GAS v4u*)(row + 16 * l), a); unpack8(*(const GAS v4u*)(row + 16 * l + 8), b);
      float s = 0.f;
#pragma unroll
      for (int i = 0; i < 8; ++i) s += a[i] * a[i] + b[i] * b[i];
      const float rs = 1.0f * FAST_RSQ(group16_sum(s) * (1.f / 256.f) + EPS);
      const GAS float* g = (const GAS float*)in[23] + d0;
#pragma unroll
      for (int i = 0; i < 8; ++i) { a[i] *= rs * g[i]; b[i] *= rs * g[8 + i]; }
      GAS bf16* base = (GAS bf16*)WSP(bf16, WS_MKT) + (size_t)((bb * 4 + h) * 4 + tile) * (32 * 64 * 8);
      const int c0 = d0 >> 3;
      *(GAS v4u*)(base + ((size_t)c0 * 64 + key) * 8) = packf8(a); *(GAS v4u*)(base + ((size_t)(c0 + 1) * 64 + key) * 8) = packf8(b); }
    { const v4u a = *(const GAS v4u*)(row + 1024 + 16 * l), b = *(const GAS v4u*)(row + 1024 + 16 * l + 8);
      const int half = d0 >> 7, cb = (d0 & 127) >> 5, off = d0 & 31;
      GAS bf16* base = (GAS bf16*)WSP(bf16, WS_MVT) + (size_t)(((bb * 4 + h) * 2 + half) * 4 + tile) * (4 * 64 * 32);
      GAS bf16* dst = base + ((size_t)cb * 64 + key) * 32 + off;
      *(GAS v4u*)dst = a; *(GAS v4u*)(dst + 8) = b; }
}

__device__ __forceinline__ void gmlp_unit(Frame& F, const float* const* in, int u) {
    const int ci = u >> 3, g = u & 7, tok0 = ci * 128, tid = F.tid, l = F.lane, r32 = l & 31, hi = l >> 5;
    LAS bf16* VT = (LAS bf16*)(F.lds + RING_OFF);
    const GAS bf16* P1 = (const GAS bf16*)WSP(bf16, WS_P1);
    { const int s = tid >> 2, qd = tid & 3;
      const GAS float* vs = (const GAS float*)WSP(float, WS_VSTAT) + (size_t)(tok0 + s) * 2; const float mean = vs[0], rstd = vs[1];
      const GAS bf16* src = P1 + (size_t)(tok0 + s) * P1N + P1_V + g * 128 + qd * 32;
      const GAS float* lg = (const GAS float*)in[7] + g * 128 + qd * 32; const GAS float* lb = (const GAS float*)in[8] + g * 128 + qd * 32;
#pragma unroll
      for (int i = 0; i < 4; ++i) { float a[8]; unpack8(*(const GAS v4u*)(src + 8 * i), a);
#pragma unroll
          for (int k = 0; k < 8; ++k) { const int c = qd * 32 + 8 * i + k; const float v = (a[k] - mean) * rstd * lg[8 * i + k] + lb[8 * i + k]; VT[c * 136 + s] = (bf16)(cvtpk(v, 0.f) & 0xffffu); } } }
    __syncthreads();
    const int w = F.wave, tb = w >> 1, cbp = (w & 1) * 2;
    f32x16 acc[2];
#pragma unroll
    for (int r = 0; r < 16; ++r) { acc[0][r] = 0.f; acc[1][r] = 0.f; }
    const GAS bf16* wsm = (const GAS bf16*)WSP(bf16, WS_WSM) + ((size_t)(g * 128 + 32 * tb + r32)) * 128 + 8 * hi;
    for (int ks = 0; ks < 2 * (tb + 1); ++ks) {
        const bf16x8 af = *(const GAS bf16x8*)(wsm + 16 * ks);
#pragma unroll
        for (int cc = 0; cc < 2; ++cc) { const bf16x8 bfr = *(const LAS bf16x8*)(VT + (32 * (cbp + cc) + r32) * 136 + 16 * ks + 8 * hi);
            acc[cc] = __builtin_amdgcn_mfma_f32_32x32x16_bf16(af, bfr, acc[cc], 0, 0, 0); }
    }
    const GAS float* bs = (const GAS float*)in[10] + g * 128;
    GAS bf16* AO = (GAS bf16*)WSP(bf16, WS_ABC);
#pragma unroll
    for (int cc = 0; cc < 2; ++cc)
#pragma unroll
        for (int r = 0; r < 16; ++r) { const int t = 32 * tb + crow(r, hi), tok = tok0 + t, ch = g * 128 + 32 * (cbp + cc) + r32;
            const float uu = bflo((unsigned)P1[(size_t)tok * P1N + P1_U + ch]);
            AO[(size_t)tok * ABC_LD + ch] = (bf16)(cvtpk(uu * (acc[cc][r] + bs[t]), 0.f) & 0xffffu); }
    __syncthreads();
}

__device__ __forceinline__ void p4_token(Frame& F, const float* const* in, int t) {
    const int l = F.lane, bb = t >> 12, tl = t & 4095, tile = tl >> 6, key = tl & 63, h = l >> 2, sub = l & 3;
    const GAS float* rope = (const GAS float*)WSP(float, WS_ROPE) + (size_t)t * 64;
    { const GAS bf16* qr = (const GAS bf16*)WSP(bf16, WS_QRAW) + (size_t)t * 3072 + h * 192;
      float x[4][8], y[2][8];
#pragma unroll
      for (int i = 0; i < 4; ++i) unpack8(*(const GAS v4u*)(qr + sub * 32 + 8 * i), x[i]);
#pragma unroll
      for (int i = 0; i < 2; ++i) unpack8(*(const GAS v4u*)(qr + 128 + sub * 16 + 8 * i), y[i]);
      float s = 0.f;
#pragma unroll
      for (int i = 0; i < 4; ++i)
#pragma unroll
          for (int k = 0; k < 8; ++k) s += x[i][k] * x[i][k];
#pragma unroll
      for (int i = 0; i < 2; ++i)
#pragma unroll
          for (int k = 0; k < 8; ++k) s += y[i][k] * y[i][k];
      s += __shfl_xor(s, 1); s += __shfl_xor(s, 2);
      const float rs = 1.0f * FAST_RSQ(s * (1.f / 192.f) + EPS);
      const GAS float* qg = (const GAS float*)in[16];
      GAS bf16* dst = (GAS bf16*)WSP(bf16, WS_QF) + ((size_t)((bb * 16 + h) * 4096 + tl)) * 192;
#pragma unroll
      for (int i = 0; i < 4; ++i) {
#pragma unroll
          for (int k = 0; k < 8; ++k) x[i][k] *= rs * qg[sub * 32 + 8 * i + k] * MLA_QSCALE;
          *(GAS v4u*)(dst + sub * 32 + 8 * i) = packf8(x[i]); }
#pragma unroll
      for (int i = 0; i < 2; ++i) { float o[8];
#pragma unroll
          for (int k = 0; k < 8; ++k) { const float mine = y[i][k] * rs * qg[128 + sub * 16 + 8 * i + k]; const float other = __shfl_xor(mine, 2);
              const int j = (sub & 1) * 16 + 8 * i + k; const float c = rope[j], sn = rope[32 + j];
              o[k] = (sub < 2 ? mine * c - other * sn : other * sn + mine * c) * MLA_QSCALE; }
          *(GAS v4u*)(dst + 128 + sub * 16 + 8 * i) = packf8(o); } }
    { const GAS bf16* kr = (const GAS bf16*)WSP(bf16, WS_KVRAW) + (size_t)t * 4096 + h * 256;
      float x[4][8];
#pragma unroll
      for (int i = 0; i < 4; ++i) unpack8(*(const GAS v4u*)(kr + sub * 32 + 8 * i), x[i]);
      float s = 0.f;
#pragma unroll
      for (int i = 0; i < 4; ++i)
#pragma unroll
          for (int k = 0; k < 8; ++k) s += x[i][k] * x[i][k];
      s += __shfl_xor(s, 1); s += __shfl_xor(s, 2);
      s += ((const GAS float*)WSP(float, WS_KRSS))[t];
      const float rs = 1.0f * FAST_RSQ(s * (1.f / 192.f) + EPS);
      const GAS float* kg = (const GAS float*)in[17];
      GAS bf16* kbase = (GAS bf16*)WSP(bf16, WS_KFT) + (size_t)((bb * 16 + h) * 64 + tile) * (24 * 64 * 8);
#pragma unroll
      for (int i = 0; i < 4; ++i) {
#pragma unroll
          for (int k = 0; k < 8; ++k) x[i][k] *= rs * kg[sub * 32 + 8 * i + k];
          *(GAS v4u*)(kbase + ((size_t)(sub * 4 + i) * 64 + key) * 8) = packf8(x[i]); }
      const GAS float* krr = (const GAS float*)WSP(float, WS_KRR) + (size_t)t * 64 + sub * 16;
#pragma unroll
      for (int i = 0; i < 2; ++i) { float o[8];
#pragma unroll
          for (int k = 0; k < 8; ++k) o[k] = krr[8 * i + k] * rs;
          *(GAS v4u*)(kbase + ((size_t)(16 + 2 * sub + i) * 64 + key) * 8) = packf8(o); }
      GAS bf16* vdst = (GAS bf16*)WSP(bf16, WS_VFT) + (size_t)((bb * 16 + h) * 64 + tile) * (4 * 64 * 32) + ((size_t)sub * 64 + key) * 32;
#pragma unroll
      for (int i = 0; i < 4; ++i) *(GAS v4u*)(vdst + 8 * i) = *(const GAS v4u*)(kr + 128 + sub * 32 + 8 * i); }
}
__device__ __forceinline__ void p8_router(Frame& F, const float* const* in) {
    const int tid = F.tid, l = F.lane, r32 = l & 31, hi = l >> 5, w = F.wave, tk = w >> 2, kq = w & 3;
    LAS float* part = (LAS float*)(F.lds + RING_OFF);
    LAS float* ssp = part + 2 * 4 * 32 * 33;
    LAS int* lcnt = (LAS int*)(F.lds + LTAB_OFF) + 40;
    LAS int* gbase = lcnt + 32;
    const int tok0 = (blockIdx.x * 2 + tk) * 32;
    if (tid < 32) lcnt[tid] = 0;
#if ROUTER_BF16X2
    {   const GAS bf16* xr = (const GAS bf16*)WSP(bf16, WS_X1) + (size_t)(tok0 + r32) * 2048 + 8 * hi;
        const GAS bf16* wh = (const GAS bf16*)WSP(bf16, WS_RWG) + (size_t)r32 * 2048 + 8 * hi;
        f32x16 acc;
#pragma unroll
        for (int r = 0; r < 16; ++r) acc[r] = 0.f;
        float ss = 0.f;
#pragma unroll 4
        for (int it = 32 * kq; it < 32 * kq + 32; ++it) {
            const v4u aw = *(const GAS v4u*)(xr + 16 * it);
            const bf16x8 a = __builtin_bit_cast(bf16x8, aw);
            const bf16x8 bh = *(const GAS bf16x8*)(wh + 16 * it), bl = *(const GAS bf16x8*)(wh + 32 * 2048 + 16 * it);
            acc = __builtin_amdgcn_mfma_f32_32x32x16_bf16(a, bh, acc, 0, 0, 0);
            acc = __builtin_amdgcn_mfma_f32_32x32x16_bf16(a, bl, acc, 0, 0, 0);
            float fa[8]; unpack8(aw, fa);
            ss += ((fa[0] * fa[0] + fa[1] * fa[1]) + (fa[2] * fa[2] + fa[3] * fa[3])) + ((fa[4] * fa[4] + fa[5] * fa[5]) + (fa[6] * fa[6] + fa[7] * fa[7]));
        }
#else
    {   const GAS bf16* xr = (const GAS bf16*)WSP(bf16, WS_X1) + (size_t)(tok0 + r32) * 2048 + 4 * hi;
        const GAS float* rw = (const GAS float*)WSP(float, WS_RWG) + (size_t)(4 * hi) * 32 + r32;
        f32x16 acc;
#pragma unroll
        for (int r = 0; r < 16; ++r) acc[r] = 0.f;
        float ss = 0.f;
#pragma unroll 4
        for (int q = 64 * kq; q < 64 * kq + 64; ++q) {
            const u32x2 aw = *(const GAS u32x2*)(xr + 8 * q); f32x4 a; a.x = bflo(aw.x); a.y = bfhi(aw.x); a.z = bflo(aw.y); a.w = bfhi(aw.y);
            const GAS float* rq = rw + (size_t)(8 * q) * 32;
            const float b0 = rq[0], b1 = rq[32], b2 = rq[64], b3 = rq[96];
            acc = __builtin_amdgcn_mfma_f32_32x32x2f32(a.x, b0, acc, 0, 0, 0);
            acc = __builtin_amdgcn_mfma_f32_32x32x2f32(a.y, b1, acc, 0, 0, 0);
            acc = __builtin_amdgcn_mfma_f32_32x32x2f32(a.z, b2, acc, 0, 0, 0);
            acc = __builtin_amdgcn_mfma_f32_32x32x2f32(a.w, b3, acc, 0, 0, 0);
            ss += (a.x * a.x + a.y * a.y) + (a.z * a.z + a.w * a.w);
        }
#endif
        LAS float* pp = part + (size_t)((tk * 4 + kq) * 32) * 33;
#pragma unroll
        for (int r = 0; r < 16; ++r) pp[crow(r, hi) * 33 + r32] = acc[r];
        ssp[(tk * 4 + kq) * 64 + l] = ss;
    }
    __syncthreads();
    const bool sel = (kq == 0) && (l < 32);
    float v0 = -INFINITY, v1 = -INFINITY, v2 = -INFINITY, v3 = -INFINITY; int i0 = 0, i1 = 0, i2 = 0, i3 = 0; int lr0 = 0, lr1 = 0, lr2 = 0, lr3 = 0;
    if (sel) {
        float ss = 0.f;
#pragma unroll
        for (int k = 0; k < 4; ++k) ss += ssp[(tk * 4 + k) * 64 + l] + ssp[(tk * 4 + k) * 64 + 32 + l];
        const float rs = 1.0f * FAST_RSQ(ss * (1.f / 2048.f) + EPS);
        const GAS float* rb = (const GAS float*)in[28];
        const LAS float* pp = part + (size_t)(tk * 4 * 32 + l) * 33;
#pragma unroll
        for (int e = 0; e < 32; ++e) {
            const float x = ((pp[e] + pp[32 * 33 + e]) + (pp[2 * 32 * 33 + e] + pp[3 * 32 * 33 + e])) * rs + rb[e];
            if (x > v3) {
                if (x > v0) { v3 = v2; i3 = i2; v2 = v1; i2 = i1; v1 = v0; i1 = i0; v0 = x; i0 = e; }
                else if (x > v1) { v3 = v2; i3 = i2; v2 = v1; i2 = i1; v1 = x; i1 = e; }
                else if (x > v2) { v3 = v2; i3 = i2; v2 = x; i2 = e; }
                else { v3 = x; i3 = e; }
            }
        }
        lr0 = __hip_atomic_fetch_add(&lcnt[i0], 1, __ATOMIC_RELAXED, __HIP_MEMORY_SCOPE_WORKGROUP); lr1 = __hip_atomic_fetch_add(&lcnt[i1], 1, __ATOMIC_RELAXED, __HIP_MEMORY_SCOPE_WORKGROUP); lr2 = __hip_atomic_fetch_add(&lcnt[i2], 1, __ATOMIC_RELAXED, __HIP_MEMORY_SCOPE_WORKGROUP); lr3 = __hip_atomic_fetch_add(&lcnt[i3], 1, __ATOMIC_RELAXED, __HIP_MEMORY_SCOPE_WORKGROUP);
    }
    __syncthreads();
    if (tid < 32) { const int c = lcnt[tid]; gbase[tid] = c ? (int)__hip_atomic_fetch_add((unsigned*)(F.ctl + CW_CNT + tid), (unsigned)c, __ATOMIC_RELAXED, __HIP_MEMORY_SCOPE_AGENT) : 0; }
    __syncthreads();
    if (sel) {
        const int t = tok0 + l;
        const float e1 = expf(v1 - v0), e2 = expf(v2 - v0), e3 = expf(v3 - v0), inv = 1.0f / (1.0f + e1 + e2 + e3);
        GAS int* te = (GAS int*)WSP(int, WS_TKE) + t * 4; GAS int* tr = (GAS int*)WSP(int, WS_TKR) + t * 4; GAS float* tg = (GAS float*)WSP(float, WS_TKG) + t * 4;
        te[0] = i0; te[1] = i1; te[2] = i2; te[3] = i3;
        tr[0] = gbase[i0] + lr0; tr[1] = gbase[i1] + lr1; tr[2] = gbase[i2] + lr2; tr[3] = gbase[i3] + lr3;
        tg[0] = inv; tg[1] = e1 * inv; tg[2] = e2 * inv; tg[3] = e3 * inv;
    }
    __syncthreads();
}
__device__ __forceinline__ void build_moe_tab(Frame& F) {
    LAS int* tab = (LAS int*)(F.lds + LTAB_OFF);
    if (F.tid == 0) { int s = 0; for (int e = 0; e < NE; ++e) { tab[e] = s; s += ((int)__hip_atomic_load(F.ctl + CW_CNT + e, RLX_AGENT) + 255) >> 8; } tab[NE] = s; }
    __syncthreads();
}
__device__ __forceinline__ void p9_scatter_token(Frame& F, const float* const* in, int t) {
    const int lane = F.lane; const LAS int* tab = (const LAS int*)(F.lds + LTAB_OFF);
    const GAS u32x2* xr = (const GAS u32x2*)(WSP(bf16, WS_X1) + (size_t)t * 2048) + lane; const GAS f32x4* gr = (const GAS f32x4*)in[26] + lane;
    f32x4 v[8]; float s = 0.f;
#pragma unroll
    for (int j = 0; j < 8; ++j) { const u32x2 xw = xr[64 * j]; v[j].x = bflo(xw.x); v[j].y = bfhi(xw.x); v[j].z = bflo(xw.y); v[j].w = bfhi(xw.y); s += (v[j].x * v[j].x + v[j].y * v[j].y) + (v[j].z * v[j].z + v[j].w * v[j].w); }
    const float rs = 1.0f * FAST_RSQ(wave_sum(s) * (1.f / 2048.f) + EPS);
    unsigned w[8];
#pragma unroll
    for (int j = 0; j < 8; ++j) { const f32x4 g = gr[64 * j]; w[j] = pk4_fp8(v[j].x * rs * g.x, v[j].y * rs * g.y, v[j].z * rs * g.z, v[j].w * rs * g.w); }
    const GAS int* te = (const GAS int*)WSP(int, WS_TKE) + t * 4; const GAS int* tr = (const GAS int*)WSP(int, WS_TKR) + t * 4;
#pragma unroll
    for (int k = 0; k < 4; ++k) { const int e = te[k], rk = tr[k]; const size_t rowi = (size_t)tab[e] * 256 + rk;
        GAS unsigned* o4 = (GAS unsigned*)(WSP(unsigned char, WS_HS) + rowi * 2048) + lane;
#pragma unroll
        for (int j = 0; j < 8; ++j) o4[64 * j] = w[j]; }
}
__device__ __forceinline__ void p12_combine_token(Frame& F, float* out, int t) {
    const int lane = F.lane; const LAS int* tab = (const LAS int*)(F.lds + LTAB_OFF);
    const GAS u32x2* xr = (const GAS u32x2*)(WSP(bf16, WS_X1) + (size_t)t * 2048) + lane;
    f32x4 v[8];
#pragma unroll
    for (int j = 0; j < 8; ++j) { const u32x2 xw = xr[64 * j]; v[j].x = bflo(xw.x); v[j].y = bfhi(xw.x); v[j].z = bflo(xw.y); v[j].w = bfhi(xw.y); }
    const GAS int* te = (const GAS int*)WSP(int, WS_TKE) + t * 4; const GAS int* tr = (const GAS int*)WSP(int, WS_TKR) + t * 4; const GAS float* tg = (const GAS float*)WSP(float, WS_TKG) + t * 4;
#pragma unroll
    for (int k = 0; k < 4; ++k) { const int e = te[k], rk = tr[k]; const float g = tg[k]; const size_t rowi = (size_t)tab[e] * 256 + rk;
        const GAS unsigned* y4 = (const GAS unsigned*)(WSP(unsigned char, WS_Y) + rowi * 2048) + lane;
#pragma unroll
        for (int j = 0; j < 8; ++j) { const int yw = (int)y4[64 * j]; const f32x2 lo = __builtin_amdgcn_cvt_pk_f32_fp8(yw, false), hh = __builtin_amdgcn_cvt_pk_f32_fp8(yw, true);
            v[j].x += g * lo[0]; v[j].y += g * lo[1]; v[j].z += g * hh[0]; v[j].w += g * hh[1]; } }
    GAS f32x4* o = (GAS f32x4*)(out + (size_t)t * 2048) + lane;
#pragma unroll
    for (int j = 0; j < 8; ++j) o[64 * j] = v[j];
}

struct Args { const float* in[33]; float* out; unsigned char* ws; };
__global__ void __launch_bounds__(NWAVES * 64, 2) mk_fwd(Args args) {
    extern __shared__ __attribute__((aligned(16))) unsigned char lds[];
    Frame F;
    F.lds = (LAS unsigned char*)lds;
    F.MISC = (volatile LAS unsigned*)(F.lds + MISC_OFF);
    F.tid = threadIdx.x; F.lane = F.tid & 63; F.wave = __builtin_amdgcn_readfirstlane(F.tid >> 6);
    F.G = gridDim.x; { const int bx = blockIdx.x; F.vcu = (F.G % 8 == 0) ? (bx % 8) * (F.G / 8) + bx / 8 : bx; }
    F.ws = args.ws; F.ctl = (gu32*)(args.ws + WS_CTL);
    const float* const* in = args.in;
    for (int u = F.tid; u < (LDS_BYTES - LDSCTL_OFF) / 4; u += NWAVES * 64) ((LAS unsigned*)(F.lds + LDSCTL_OFF))[u] = 0u;
    __syncthreads();
#define PHASE_SEAM() do { xcd_barrier(bar); int l_ = pg8::pg8_lane(); asm volatile("" : "+v"(l_)); F.lane = l_; F.tid = F.wave * 64 + l_; } while (0)
    XcdBarrier bar = xcd_barrier_post((unsigned*)(F.ctl + CW_BAR), F.MISC + 8);
    const int gw = F.vcu * NWAVES + F.wave, NGW = F.G * NWAVES;
    typedef pg8::bf16_t pbf;

    for (int rep = 0; rep < REP_P0; ++rep) p0_prologue<0>(F, in);
    PHASE_SEAM();

    for (int rep = 0; rep < REP_P1; ++rep)
    {   pg8::Gemm g{WSP(pbf, WS_H), WSP(pbf, WS_W1T), T + MEMROWS, P1N + 2048, 2048, HPITCH, HPITCH};
        pg8::EpiP1 E{WSP(pbf, WS_P1), WSP(pbf, WS_MKV), in[6]};
        const int slot = (CONV_IN_P1 && (!ATTN_SPLIT || SPLIT_NOCONV) && rep == 0) ? (F.vcu % (GATE_F8 ? 5 : 10)) : 0;
        if (!(UV_F8 == 1 && GATE_F8))
        {   pg8::P1Order S; S.init(F.G, (int)blockIdx.x, 0, slot);
            pg8::gemm_phase<pg8::EpiP1, pg8::P1Order, GEMM_ALIGN, true>(F.lds + RING_OFF, g, S, E, F.wave); }
        if (CONV_IN_P1 && (!ATTN_SPLIT || SPLIT_NOCONV) && rep == 0) { __syncthreads(); if (CONV_DMA == 2) moe_convert_share_dma256(F, in); else if (CONV_DMA) moe_convert_share_dma(F, in); else moe_convert_share<0>(F, in); if (REP_CONV > 1) moe_convert_share<1>(F, in); }
        if (!(UV_F8 == 1 && GATE_F8))
        {   pg8::P1Order S; S.init(F.G, (int)blockIdx.x, slot, 1 << 20);
            pg8::gemm_phase<pg8::EpiP1, pg8::P1Order, GEMM_ALIGN, true>(F.lds + RING_OFF, g, S, E, F.wave); }
        if (GATE_F8) {
            pg8::Gemm g8{WSP(pbf, WS_H8), WSP(pbf, WS_WG8) - (size_t)8 * 256 * 1024, T + MEMROWS, 41 * 256, 1024, 1024, 1024, MOE_SW, MOE_SX};
            pg8::GateOrder SG; SG.init(F.G, (int)blockIdx.x);
            pg8::gemm_phase<pg8::EpiP1, pg8::GateOrder, GEMM_ALIGN, true, true, 0, (KROT_MASK & 4) != 0>(F.lds + RING_OFF, g8, SG, E, F.wave); }
        if (GATE_F8 && PRO_SPLIT == 1 && UV_F8 == 2 && rep == 0 && blockIdx.x >= 96) p0_prologue<1>(F, in, (int)blockIdx.x - 96, 160);
        if (GATE_F8 && PRO_SPLIT == 2 && UV_F8 == 2 && rep == 0 && blockIdx.x >= 224) p0_prologue<1>(F, in, (int)blockIdx.x - 224, 32);
        if (GATE_F8 && CONV_OFFLOAD && UV_F8 == 2 && rep == 0 && blockIdx.x >= 96 && blockIdx.x < 96 + CONV_OFF_CUS) {
            const int k0 = (CONV_NSUP - CONV_OFF) + 8 * ((int)blockIdx.x - 96);
            moe_convert_range256<8>(F, in, F.wave, (LAS unsigned*)(F.lds + RING_OFF + F.wave * 16640), F.lane, k0, k0 + 8); }
    }
    PHASE_SEAM();

    for (int rep = 0; rep < REP_P2; ++rep)
    for (int t = gw; t < T; t += NGW) p2_token(F, in, t);
    for (int m = gw; m < MEMROWS; m += NGW) p2_memrow(F, in, m);
    PHASE_SEAM();

    for (int rep = 0; rep < REP_P3; ++rep) {
    {   pg8::Gemm g{WSP(pbf, WS_CQN), WSP(pbf, WS_WUQT), T, 4096, 256, 256, 256, UP_SW, MOE_SX};
        pg8::StaticOrder S; S.init(T, 4096, F.G, (int)blockIdx.x);
#if ATTN_F8
        pg8::EpiQ8 E{(LAS float*)(F.lds + LEPI_OFF), in[16], WSP(float, WS_ROPE), WSP(unsigned char, WS_QF), MLA_QSCALE * 16.0f};
        pg8::gemm_phase<pg8::EpiQ8, pg8::StaticOrder, true, true, true>(F.lds + RING_OFF, g, S, E, F.wave);
#else
        pg8::EpiQ E{(LAS float*)(F.lds + LEPI_OFF), in[16], WSP(float, WS_ROPE), WSP(pbf, WS_QF), MLA_QSCALE};
        pg8::gemm_phase<pg8::EpiQ, pg8::StaticOrder, true, true, true>(F.lds + RING_OFF, g, S, E, F.wave);
#endif
    }
    {   pg8::Gemm g{WSP(pbf, WS_CKVN), WSP(pbf, WS_WUKVT), T, 4096, 256, 256, 256, UP_SW, MOE_SX};
        pg8::StaticOrder S; S.init(T, 4096, F.G, (int)blockIdx.x);
#if ATTN_F8
        pg8::EpiKV8 E{(LAS float*)(F.lds + LEPI_OFF), in[17], WSP(float, WS_KRSS), WSP(float, WS_KRR), WSP(unsigned char, WS_KFT), WSP(unsigned char, WS_VFT)};
        pg8::gemm_phase<pg8::EpiKV8, pg8::StaticOrder, true, true, true>(F.lds + RING_OFF, g, S, E, F.wave);
#else
        pg8::EpiKV E{(LAS float*)(F.lds + LEPI_OFF), in[17], WSP(float, WS_KRSS), WSP(float, WS_KRR), WSP(pbf, WS_KFT), WSP(pbf, WS_VFT)};
        pg8::gemm_phase<pg8::EpiKV, pg8::StaticOrder, true, true, true>(F.lds + RING_OFF, g, S, E, F.wave);
#endif
    }
    __syncthreads();
    for (int u = F.vcu; u < 1024; u += F.G) gmlp_unit(F, in, u);
    for (int u = F.vcu; u < 512; u += F.G) {
        const int half = u & 1, qb = (u >> 1) & 15, bh = u >> 5;
        const bf16* Q = WSP(bf16, WS_QMN) + ((size_t)bh * 4096 + qb * 256 + 32 * F.wave) * 256;
        const bf16* Kt = WSP(bf16, WS_MKT) + (size_t)bh * 4 * (32 * 64 * 8);
        const bf16* Vt = WSP(bf16, WS_MVT) + (size_t)(bh * 2 + half) * 4 * (4 * 64 * 32);
        unsigned char* O = WSP(unsigned char, WS_ABC) + ((size_t)(bh >> 2) * 4096 + qb * 256 + 32 * F.wave) * ABC_ROWB + ABC_CB + (bh & 3) * 256 + half * 128;
        attn_unit<256, 2, false>(F.lds + RING_OFF, Q, 256, Kt, Vt, 4, 0, O, ABC_ROWB, F.wave, F.lane);
    }
    }
    PHASE_SEAM();

#if ATTN_SPLIT
    {   const int s = F.vcu & 3;
#if !(ATTN_XCDMAP && ATTN_RB2)
        const int bh = F.vcu >> 2;
#endif
        constexpr int NIT = NE * 32 * 64 + NE * 32 * 32;
        ConvState cs; cs.lo = F.vcu * (NIT / 256); cs.cw = F.wave - 4; cs.c = -1;
        { const int nitems = (NIT / 256 - cs.cw + 3) / 4; cs.nchunks = (F.wave >= 4 && !SPLIT_NOCONV) ? nitems * 4 : 0; }
        LAS unsigned char* cbase = F.lds + RING_OFF + (ATT_PAIR && ATTN_RB2 ? 81920 : 61440) + (F.wave - 4) * 16640;
#if ATTN_RB2
#if ATTN_XCDMAP
#define P5_UNIT(i_) const int s16 = F.vcu & 15, s8 = (s16 + 8) & 15, qb = ((i_) == 0) ? s16 : ((i_) == 1) ? 15 - s16 : ((i_) == 2) ? s8 : 15 - s8, nt = 4 * (qb + 1), \
        bh = 8 * (F.vcu >> 5) + 2 * (i_) + ((F.vcu >> 4) & 1)
#else
#define P5_UNIT(i_) const int qb = ((i_) == 0) ? s : ((i_) == 1) ? 7 - s : ((i_) == 2) ? 8 + s : 15 - s, nt = 4 * (qb + 1)
#endif
#if ATT_REBAL
        LAS unsigned* bctr = (LAS unsigned*)(F.lds + MISC_OFF + 64);
        if (F.tid == 0) { bctr[0] = 0u; bctr[1] = 0u; }
        __syncthreads();
        const unsigned char* Kt = WSP(unsigned char, WS_KFT) + (size_t)bh * 64 * 12288;
        const unsigned char* Vt = WSP(unsigned char, WS_VFT) + (size_t)bh * 64 * 8192;
        if (F.wave < 4) {
            unsigned nbar = 0;
            const int nu = (s == 0) ? 2 : 3;
            for (int i = 0; i < nu; ++i) {
                const int qb = (s == 0) ? (i == 0 ? 15 : 13) : (s == 1) ? (i == 0 ? 14 : i == 1 ? 8 : 5) : (s == 2) ? (i == 0 ? 12 : i == 1 ? 9 : 6) : (i == 0 ? 11 : i == 1 ? 10 : 7);
                const unsigned char* Q = WSP(unsigned char, WS_QF) + ((size_t)bh * 4096 + qb * 256 + 32 * F.wave) * 192;
                unsigned char* O = WSP(unsigned char, WS_ABC) + ((size_t)(bh >> 4) * 4096 + qb * 256 + 32 * F.wave) * ABC_ROWB + ABC_BB + (bh & 15) * 128;
                attn8_unit2<true>(F.lds + RING_OFF, Q, Kt, Vt, 4 * (qb + 1), qb * 256 + 32 * F.wave, O, ABC_ROWB, F.wave, F.lane, bctr, nbar); }
        } else {
            moe_convert_share_w256<4>(F, in, F.wave - 4, (LAS unsigned*)cbase, F.lane);
            asm volatile("s_waitcnt vmcnt(0) lgkmcnt(0)" ::: "memory");
            unsigned nbar2 = 0; const int cw = F.wave - 4;
            att_bar4(bctr + 1, nbar2, F.lane);
            const int nu = (s == 3) ? 4 : 2;
            for (int i = 0; i < nu; ++i) {
                const int qh = (s == 0) ? (i == 0 ? 9 : 3) : (s == 1) ? (i == 0 ? 8 : 4) : (s == 2) ? (i == 0 ? 7 : 5) : (i == 0 ? 6 : i == 1 ? 2 : i == 2 ? 1 : 0);
                const unsigned char* Q = WSP(unsigned char, WS_QF) + ((size_t)bh * 4096 + qh * 128 + 32 * cw) * 192;
                unsigned char* O = WSP(unsigned char, WS_ABC) + ((size_t)(bh >> 4) * 4096 + qh * 128 + 32 * cw) * ABC_ROWB + ABC_BB + (bh & 15) * 128;
                attn8_unit<true, 4>(F.lds + RING_OFF + 61440, Q, Kt, Vt, 2 * (qh + 1), qh * 128 + 32 * cw, O, ABC_ROWB, cw, F.lane, bctr + 1, &nbar2); }
        }
#else
        LAS unsigned* bctr = (LAS unsigned*)(F.lds + MISC_OFF + 64);
        if (F.tid == 0) *bctr = 0u;
        __syncthreads();
        if (F.wave < 4) {
            unsigned nbar = 0;
            for (int rep = 0; rep < REP_P5; ++rep)
            for (int i = 0; i < 4; ++i) { P5_UNIT(i);
                const unsigned char* Q = WSP(unsigned char, WS_QF) + ((size_t)bh * 4096 + qb * 256 + 32 * F.wave) * 192;
                const unsigned char* Kt = WSP(unsigned char, WS_KFT) + (size_t)bh * 64 * 12288;
                const unsigned char* Vt = WSP(unsigned char, WS_VFT) + (size_t)bh * 64 * 8192;
                unsigned char* O = WSP(unsigned char, WS_ABC) + ((size_t)(bh >> 4) * 4096 + qb * 256 + 32 * F.wave) * ABC_ROWB + ABC_BB + (bh & 15) * 128;
                attn8_unit2<true>(F.lds + RING_OFF, Q, Kt, Vt, nt, qb * 256 + 32 * F.wave, O, ABC_ROWB, F.wave, F.lane, bctr, nbar); }
        } else {
#if !SPLIT_FREE
            int it = 0;
            for (int i = 0; i < 4; ++i) { P5_UNIT(i);
                for (int j = 0; j < nt; ++j, ++it) { conv_steps<4>(F, in, cs, cbase, 3, F.lane); __builtin_amdgcn_s_barrier(); asm volatile("" ::: "memory"); }
                __builtin_amdgcn_s_barrier(); asm volatile("" ::: "memory"); }
#endif
#if SPLIT_FREE == 2
            for (int rep = 0; rep < REP_CONV; ++rep) { if (CONV_ROWS == 256) moe_convert_share_w256<4>(F, in, F.wave - 4, (LAS unsigned*)cbase, F.lane); else moe_convert_share_w<4>(F, in, F.wave - 4, (LAS unsigned*)cbase, F.lane); }
            asm volatile("s_waitcnt vmcnt(0)" ::: "memory");
#else
            for (int rep = 0; rep < REP_CONV; ++rep) { cs.c = -1; conv_steps<4>(F, in, cs, cbase, 1 << 20, F.lane); asm volatile("s_waitcnt vmcnt(0)" ::: "memory"); }
#endif
        }
#endif
#undef P5_UNIT
#else
#define P5_UNIT(i_) const int qb = (((i_) >> 1) == 0) ? s : (((i_) >> 1) == 1) ? 7 - s : (((i_) >> 1) == 2) ? 8 + s : 15 - s, qh = 2 * qb + ((i_) & 1), nt = 2 * (qh + 1)
        if (F.wave < 4) {
            __builtin_amdgcn_s_setprio(SPLIT_PRIO);
            for (int i = 0; i < 8; ++i) { P5_UNIT(i);
                const unsigned char* Q = WSP(unsigned char, WS_QF) + ((size_t)bh * 4096 + qh * 128 + 32 * F.wave) * 192;
                const unsigned char* Kt = WSP(unsigned char, WS_KFT) + (size_t)bh * 64 * 12288;
                const unsigned char* Vt = WSP(unsigned char, WS_VFT) + (size_t)bh * 64 * 8192;
                unsigned char* O = WSP(unsigned char, WS_ABC) + ((size_t)(bh >> 4) * 4096 + qh * 128 + 32 * F.wave) * ABC_ROWB + ABC_BB + (bh & 15) * 128;
                attn8_unit<true, 4>(F.lds + RING_OFF, Q, Kt, Vt, nt, qh * 128 + 32 * F.wave, O, ABC_ROWB, F.wave, F.lane); }
            __builtin_amdgcn_s_setprio(0);
        } else {
            int it = 0;
            for (int i = 0; i < 8; ++i) { P5_UNIT(i);
                for (int j = 0; j < nt; ++j, ++it) { conv_steps<4>(F, in, cs, cbase, CONV_QUOTA(it), F.lane); __builtin_amdgcn_s_barrier(); asm volatile("" ::: "memory"); }
                __builtin_amdgcn_s_barrier(); asm volatile("" ::: "memory"); }
            conv_steps<4>(F, in, cs, cbase, 1 << 20, F.lane); asm volatile("s_waitcnt vmcnt(0)" ::: "memory");
        }
#undef P5_UNIT
#endif
        __syncthreads();
    }
    PHASE_SEAM();

#else
    for (int rep = 0; rep < REP_P5; ++rep)
    {   const int bh = F.vcu >> 2, s = F.vcu & 3;
        for (int i = 0; i < 4; ++i) {
            if (!CONV_IN_P1 && rep == 0 && i == ((F.vcu >> 2) & 3)) { moe_convert_share<0>(F, in); if (REP_CONV > 1) moe_convert_share<1>(F, in); }
            const int qb = (i == 0) ? s : (i == 1) ? 7 - s : (i == 2) ? 8 + s : 15 - s;
#if ATTN_F8
            const unsigned char* Q = WSP(unsigned char, WS_QF) + ((size_t)bh * 4096 + qb * 256 + 32 * F.wave) * 192;
            const unsigned char* Kt = WSP(unsigned char, WS_KFT) + (size_t)bh * 64 * 12288;
            const unsigned char* Vt = WSP(unsigned char, WS_VFT) + (size_t)bh * 64 * 8192;
            unsigned char* O = WSP(unsigned char, WS_ABC) + ((size_t)(bh >> 4) * 4096 + qb * 256 + 32 * F.wave) * ABC_ROWB + ABC_BB + (bh & 15) * 128;
            attn8_unit<true>(F.lds + RING_OFF, Q, Kt, Vt, 4 * (qb + 1), qb * 256 + 32 * F.wave, O, ABC_ROWB, F.wave, F.lane);
#else
            const bf16* Q = WSP(bf16, WS_QF) + ((size_t)bh * 4096 + qb * 256 + 32 * F.wave) * 192;
            const bf16* Kt = WSP(bf16, WS_KFT) + (size_t)bh * 64 * (24 * 64 * 8);
            const bf16* Vt = WSP(bf16, WS_VFT) + (size_t)bh * 64 * (4 * 64 * 32);
            unsigned char* O = WSP(unsigned char, WS_ABC) + ((size_t)(bh >> 4) * 4096 + qb * 256 + 32 * F.wave) * ABC_ROWB + ABC_BB + (bh & 15) * 128;
            attn_unit<192, 3, true>(F.lds + RING_OFF, Q, 192, Kt, Vt, 4 * (qb + 1), qb * 256 + 32 * F.wave, O, ABC_ROWB, F.wave, F.lane);
#endif
        }
    }
    PHASE_SEAM();

#endif
    for (int rep = 0; rep < REP_P6; ++rep)
    {   pg8::Gemm g{WSP(pbf, WS_ABC), WSP(pbf, WS_WPT), T, 2048, ABC_LD, ABC_LD, ABC_LD, MOE_SW, ATT_OSB};
        pg8::StaticOrder S; S.init(T, 2048, F.G, (int)blockIdx.x);
        pg8::EpiMergedT<16, 32> E{WSP(pbf, WS_P1), WSP(pbf, WS_MERGED)};
        pg8::gemm_phase<pg8::EpiMergedT<16, 32>, pg8::StaticOrder, GEMM_ALIGN, true, false, 16>(F.lds + RING_OFF, g, S, E, F.wave);
    }
    PHASE_SEAM();

    for (int rep = 0; rep < REP_P7; ++rep)
    {   pg8::Gemm g{WSP(pbf, WS_MERGED), WSP(pbf, WS_WOT), T, 2048, 2048, 2048, 2048};
        pg8::StaticOrder S; S.init(T, 2048, F.G, (int)blockIdx.x);
        pg8::EpiX1 E{in[0], WSP(pbf, WS_X1)};
        pg8::gemm_phase<pg8::EpiX1, pg8::StaticOrder, P7_ALIGN, true>(F.lds + RING_OFF, g, S, E, F.wave);
    }
    PHASE_SEAM();

    p8_router(F, in);
    PHASE_SEAM();

    build_moe_tab(F);
    for (int rep = 0; rep < REP_P9; ++rep)
    for (int t = gw; t < T; t += NGW) p9_scatter_token(F, in, t);
    PHASE_SEAM();

    for (int rep = 0; rep < REP_P10; ++rep)
    {   pg8::Gemm g{WSP(pbf, WS_HS), WSP(pbf, WS_WGUT), MAXSLOT, NE * 4096, 1024, 1024, 1024, MOE_SW, MOE_SX};
        pg8::MoeOrder S{(const LAS int*)(F.lds + LTAB_OFF), 16, (int)(blockIdx.x & 7), (int)(blockIdx.x >> 3)};
        pg8::EpiSwiGLU E{in[30], WSP(unsigned char, WS_ACT)};
#if P10_PROBE
        if (rep > 0) { pg8::EpiSwiGLUProbe<P10_PROBE> EP; EP.bgu = E.bgu; EP.ACT = E.ACT;
            pg8::gemm_phase<pg8::EpiSwiGLUProbe<P10_PROBE>, pg8::MoeOrder, GEMM_ALIGN, true, true>(F.lds + RING_OFF, g, S, EP, F.wave); }
        else
#endif
        pg8::gemm_phase<pg8::EpiSwiGLU, pg8::MoeOrder, GEMM_ALIGN, true, true, 0, (KROT_MASK & 1) != 0, (PFETCH_MASK & 1) != 0>(F.lds + RING_OFF, g, S, E, F.wave);
    }
    PHASE_SEAM();

    for (int rep = 0; rep < REP_P11; ++rep)
    {   pg8::Gemm g{WSP(pbf, WS_ACT), WSP(pbf, WS_WDT), MAXSLOT, NE * 2048, 1024, 1024, 1024, MOE_SW, MOE_SX};
        pg8::MoeOrder S{(const LAS int*)(F.lds + LTAB_OFF), 8, (int)(blockIdx.x & 7), (int)(blockIdx.x >> 3)};
        pg8::EpiDown E{in[32], WSP(unsigned char, WS_Y)};
        pg8::gemm_phase<pg8::EpiDown, pg8::MoeOrder, GEMM_ALIGN, true, true, 0, (KROT_MASK & 2) != 0>(F.lds + RING_OFF, g, S, E, F.wave);
    }
    PHASE_SEAM();

    for (int rep = 0; rep < REP_P12; ++rep)
    for (int t = gw; t < T; t += NGW) p12_combine_token(F, args.out, t);
}

extern "C" void kernel_launch(void* const* d_in, const int* in_sizes, int n_in, void* d_out, int out_size, void* d_ws, size_t ws_size, hipStream_t stream) {
    static int grid = 0;
    if (grid == 0) {
        if (n_in != 33 || out_size != T * D || ws_size < WS_END) { fprintf(stderr, "kernel_launch: unexpected problem (n_in %d out %d ws %zu need %zu)\n", n_in, out_size, ws_size, (size_t)WS_END); grid = -1; return; }
        (void)in_sizes;
        if (hipFuncSetAttribute((const void*)mk_fwd, hipFuncAttributeMaxDynamicSharedMemorySize, LDS_BYTES) != hipSuccess) { fprintf(stderr, "kernel_launch: hipFuncSetAttribute failed\n"); grid = -1; return; }
        int per_cu = 0;
        if (hipOccupancyMaxActiveBlocksPerMultiprocessor(&per_cu, (const void*)mk_fwd, NWAVES * 64, LDS_BYTES) != hipSuccess || per_cu < 1) fprintf(stderr, "kernel_launch: occupancy query reports %d\n", per_cu);
        (void)hipGetLastError();
        grid = 256;
    }
    if (grid < 0) return;
    if (hipMemsetAsync((char*)d_ws + WS_CTL, 0, CTL_ZERO_BYTES, stream) != hipSuccess) { fprintf(stderr, "kernel_launch: memset failed\n"); return; }
    Args a{};
    for (int i = 0; i < 33; ++i) a.in[i] = (const float*)d_in[i];
    a.out = (float*)d_out; a.ws = (unsigned char*)d_ws;
    hipLaunchKernelGGL(mk_fwd, dim3(grid), dim3(NWAVES * 64), LDS_BYTES, stream, a);
}
```

```cpp
#include <hip/hip_runtime.h>
#include <cstdio>
#include <cstdint>
#include <cmath>
#ifndef REP_P0
#define REP_P0 1
#endif
#ifndef REP_P1
#define REP_P1 1
#endif
#ifndef REP_P3
#define REP_P3 1
#endif
#ifndef REP_P5
#define REP_P5 1
#endif
#ifndef REP_P6
#define REP_P6 1
#endif
#ifndef REP_P10
#define REP_P10 1
#endif
#ifndef REP_P11
#define REP_P11 1
#endif
#ifndef REP_CONV
#define REP_CONV 1
#endif
#ifndef ATTN_RB2
#define ATTN_RB2 1
#endif
#ifndef SPLIT_FREE
#define SPLIT_FREE 2
#endif
#ifndef CONV_ROWS
#define CONV_ROWS 256
#endif
#ifndef UV_F8
#define UV_F8 2
#endif
#ifndef ATTN_XCDMAP
#define ATTN_XCDMAP 0
#endif
#ifndef P10_PROBE
#define P10_PROBE 0
#endif
#ifndef KROT_MASK
#define KROT_MASK 0
#endif
#ifndef ROUTER_BF16X2
#define ROUTER_BF16X2 1
#endif
#ifndef CONV_OFFLOAD
#define CONV_OFFLOAD 1
#endif
#ifndef STAGE_IN_MMA
#define STAGE_IN_MMA 0
#endif
#ifndef ATT_SLEEP
#define ATT_SLEEP 0
#endif
#ifndef ATT_VPRE
#define ATT_VPRE 0
#endif
#ifndef KSEG_BATCH16
#define KSEG_BATCH16 0
#endif
#ifndef ATT_PAIR
#define ATT_PAIR 1
#endif
#ifndef PFETCH_MASK
#define PFETCH_MASK 0
#endif
#ifndef CONV_SLEEP
#define CONV_SLEEP 0
#endif
#ifndef ATT_REBAL
#define ATT_REBAL 0
#endif
#ifndef ATT_SPLITQK
#define ATT_SPLITQK 1
#endif
#ifndef ATT_DEFER
#define ATT_DEFER 0
#endif
#ifndef PRO_SPLIT
#define PRO_SPLIT 0
#endif
#ifndef ATT_PERMLANE
#define ATT_PERMLANE 1
#endif
#ifndef ATT_POLL_SLEEP
#define ATT_POLL_SLEEP 1
#endif
#ifndef ATT_SPREAD
#define ATT_SPREAD 0
#endif
#ifndef STAGE_AUX
#define STAGE_AUX 0
#endif
#ifndef MOE_MAP2
#define MOE_MAP2 0
#endif
#ifndef ATT_OWIDE
#define ATT_OWIDE 1
#endif
#ifndef XL_FAST
#define XL_FAST 1
#endif
#ifndef EPIX1_BATCH
#define EPIX1_BATCH 0
#endif
#ifndef CNT_SPREAD
#define CNT_SPREAD 1
#endif
#ifndef SPLIT_PRIO
#define SPLIT_PRIO 0
#endif
#ifndef SPLIT_NOCONV
#define SPLIT_NOCONV 0
#endif
#ifndef CONV_QUOTA
#define CONV_QUOTA(it) (1 + ((it) & 1))
#endif
#ifndef ATTN_SPLIT
#define ATTN_SPLIT 1
#endif
#ifndef P7_ALIGN
#define P7_ALIGN true
#endif
#ifndef ATTN_F8
#define ATTN_F8 1
#endif
#ifndef GATE_BF16SPLIT
#define GATE_BF16SPLIT 0
#endif
#ifndef GATE_SKIP
#define GATE_SKIP 0
#endif
#ifndef GATE_F8
#define GATE_F8 1
#endif
#ifndef CONV_DMA
#define CONV_DMA 1
#endif
#ifndef PITCH_PAD
#define PITCH_PAD 0
#endif
#ifndef GEMM_ALIGN
#define GEMM_ALIGN true
#endif
#ifndef CONV_IN_P1
#define CONV_IN_P1 1
#endif
#ifndef REP_P7
#define REP_P7 1
#endif
#ifndef REP_P2
#define REP_P2 1
#endif
#ifndef REP_P4
#define REP_P4 1
#endif
#ifndef REP_P9
#define REP_P9 1
#endif
#ifndef REP_P12
#define REP_P12 1
#endif
constexpr int NWAVES = 8;
constexpr int T = 16384, D = 2048, NBATCH = 4, SEQ = 4096;
constexpr int HPITCH = 2048 + PITCH_PAD;
constexpr int P1N = 10496;
constexpr int P1_U = 0, P1_V = 1024, P1_CQ = 2048, P1_CKV = 2560, P1_QM = 3072, P1_KR = 4096, P1_G = 4352;
constexpr int P1_TILES = 41, MEMROWS = 1024;
constexpr int NH = 16, QKD = 192, NOPE = 128, ROPE = 64, VD = 128;
constexpr int NE = 32, DFF = 2048, MAXBLK = 288, MAXSLOT = MAXBLK * 256;
constexpr float EPS = 1e-6f;
constexpr float LOG2E = 1.4426950408889634f;
constexpr float MLA_QSCALE = 0.07216878364870322f * LOG2E;
constexpr float MEM_QSCALE = 0.0625f * LOG2E;
constexpr float MOE_WSCALE = 64.0f;
constexpr unsigned MOE_SW = 0x79797979u, MOE_SX = 0x7f7f7f7fu;
constexpr float UP_WSCALE = 16.0f;
constexpr unsigned UP_SW = 0x7b7b7b7bu;

constexpr size_t MiB = 1u << 20;
constexpr size_t WS_CTL = 0, CTL_ZERO_BYTES = 1 * MiB;
constexpr size_t WS_W1T   = 1 * MiB;
constexpr size_t WS_WUQT  = WS_W1T + (size_t)(P1N + 2048) * HPITCH * 2;
constexpr size_t WS_WUKVT = WS_WUQT + (size_t)4096 * 512 * 2;
constexpr size_t WS_WPT   = WS_WUKVT + (size_t)4096 * 512 * 2;
constexpr size_t WS_WOT   = WS_WPT + (size_t)2048 * 4096 * 2;
constexpr size_t WS_WGUT  = WS_WOT + (size_t)2048 * 2048 * 2;
constexpr size_t WS_WDT   = WS_WGUT + (size_t)NE * 4096 * 2048 * 2;
constexpr size_t WS_WSM   = WS_WDT + (size_t)NE * 2048 * 2048 * 2;
constexpr size_t WS_RWG   = WS_WSM + (size_t)8 * 128 * 128 * 2;
constexpr size_t WS_H     = WS_RWG + (size_t)2048 * 32 * 4;
constexpr size_t WS_P1    = WS_H + (size_t)(T + MEMROWS) * HPITCH * 2;
constexpr size_t WS_MKV   = WS_P1 + (size_t)T * P1N * 2;
constexpr size_t WS_VSTAT = WS_MKV + (size_t)MEMROWS * 2048 * 2;
constexpr size_t WS_CQN   = WS_VSTAT + (size_t)T * 8;
constexpr size_t WS_CKVN  = WS_CQN + (size_t)T * 512 * 2;
constexpr size_t WS_QMN   = WS_CKVN + (size_t)T * 512 * 2;
constexpr size_t WS_KRR   = WS_QMN + (size_t)T * 1024 * 2;
constexpr size_t WS_KRSS  = WS_KRR + (size_t)T * 64 * 4;
constexpr size_t WS_ROPE  = WS_KRSS + (size_t)T * 4;
constexpr size_t WS_MKT   = WS_ROPE + (size_t)T * 64 * 4;
constexpr size_t WS_MVT   = WS_MKT + (size_t)MEMROWS * 1024 * 2;
constexpr size_t WS_QRAW  = WS_MVT + (size_t)MEMROWS * 1024 * 2;
constexpr size_t WS_KVRAW = WS_QRAW + (size_t)T * 3072 * 2;
constexpr size_t WS_QF    = WS_KVRAW + (size_t)T * 4096 * 2;
constexpr size_t WS_KFT   = WS_QF + (size_t)T * 3072 * 2;
constexpr size_t WS_VFT   = WS_KFT + (size_t)T * 3072 * 2;
constexpr size_t WS_ABC   = WS_VFT + (size_t)T * 2048 * 2;
constexpr int ABC_LD = 2560, ABC_ROWB = 5120, ABC_BB = 2048, ABC_CB = 4096;
constexpr float ATT_OS = 32.0f; constexpr unsigned ATT_OSB = 0x7a7a7a7au;
constexpr size_t WS_MERGED= WS_ABC + (size_t)T * 4096 * 2;
constexpr size_t WS_X1    = WS_MERGED + (size_t)T * 2048 * 2;
constexpr size_t WS_TKE   = WS_X1 + (size_t)T * 2048 * 4;
constexpr size_t WS_TKR   = WS_TKE + (size_t)T * 16;
constexpr size_t WS_TKG   = WS_TKR + (size_t)T * 16;
constexpr size_t WS_HS    = WS_TKG + (size_t)T * 16;
constexpr size_t WS_ACT   = WS_HS + (size_t)MAXSLOT * 2048 * 2;
constexpr size_t WS_Y     = WS_ACT + (size_t)MAXSLOT * 2048 * 2;
constexpr size_t WS_H8    = WS_Y + (size_t)MAXSLOT * 2048 * 2;
constexpr size_t WS_WG8U  = WS_H8 + (size_t)(T + MEMROWS) * 2048;
constexpr size_t WS_WG8   = WS_WG8U + (size_t)8 * 256 * 2048;
constexpr size_t WS_END   = WS_WG8 + (size_t)41 * 256 * 2048;
constexpr int CW_TMO = 0, CW_CODE = 1;
constexpr int CW_CNT = 64, CNT_STRIDE = CNT_SPREAD ? 32 : 1;
constexpr int CW_CNT_OLD_ = 64;
constexpr int CW_BAR = 4096;

constexpr int RING_OFF = 0, RING_BYTES = ATT_PAIR ? 148480 : 133120;
constexpr int LDSCTL_OFF = RING_BYTES, MISC_OFF = LDSCTL_OFF + 320;
constexpr int LTAB_OFF = LDSCTL_OFF + 1024;
constexpr int LEPI_OFF = LDSCTL_OFF + 2048;
constexpr int LDS_BYTES = RING_BYTES + 14336;

#define XL_DPP(v, ctrl) __uint_as_float((unsigned)__builtin_amdgcn_update_dpp(0, (int)__float_as_uint(v), ctrl, 0xf, 0xf, true))
__device__ __forceinline__ float xl_sum16(float v) { v += XL_DPP(v, 0xB1); v += XL_DPP(v, 0x4E); v += XL_DPP(v, 0x141); v += XL_DPP(v, 0x140); return v; }
__device__ __forceinline__ float xl_swap16_sum(float v) { const auto r = __builtin_amdgcn_permlane16_swap(__float_as_uint(v), __float_as_uint(v), false, false); return __uint_as_float(r[0]) + __uint_as_float(r[1]); }
__device__ __forceinline__ float xl_swap32_sum(float v) { const auto r = __builtin_amdgcn_permlane32_swap(__float_as_uint(v), __float_as_uint(v), false, false); return __uint_as_float(r[0]) + __uint_as_float(r[1]); }
__device__ __forceinline__ float xl_swap32_max(float v) { const auto r = __builtin_amdgcn_permlane32_swap(__float_as_uint(v), __float_as_uint(v), false, false); return fmaxf(__uint_as_float(r[0]), __uint_as_float(r[1])); }

#ifndef RSQ_FAST
#define RSQ_FAST 1
#endif
#if RSQ_FAST
#define FAST_RSQ(x) __builtin_amdgcn_rsqf(x)
#else
#define FAST_RSQ(x) (1.0f / sqrtf(x))
#endif
namespace pg8 {
#define PG8_LAS __attribute__((address_space(3)))
typedef unsigned short bf16_t;
typedef short bf16x8 __attribute__((ext_vector_type(8)));
typedef float f32x4 __attribute__((ext_vector_type(4)));
typedef unsigned u32x4 __attribute__((ext_vector_type(4)));
constexpr int BM = 256, BK = 64, HALF = 128, HTB = HALF * BK * 2  , STAGE_BYTES = 8 * HTB, NXCD = 8, WGM = 8;

__host__ __device__ __forceinline__ int lds_byte(int r, int c) { const int st = (r >> 4) * 2 + (c >> 5), rr = r & 15, cc = c & 31, ob = rr * 64 + cc * 2; return st * 1024 + (ob ^ (((ob >> 9) & 1) << 5)); }
__host__ __device__ __forceinline__ void stage_rc(int b, int& R, int& C) { const int st = b / 1024, sb = b % 1024, swz = sb ^ (((sb >> 9) & 1) << 5); R = (st >> 1) * 16 + swz / 64; C = (st & 1) * 32 + (swz % 64) / 2; }
__host__ __device__ __forceinline__ int perm32(int rho) { const int n = rho >> 4, i = rho & 15; return 8 * (i >> 2) + 4 * n + (i & 3); }

__device__ __forceinline__ int pg8_lane() { int l; asm volatile("v_mbcnt_lo_u32_b32 %0, -1, 0\n\tv_mbcnt_hi_u32_b32 %0, -1, %0" : "=v"(l)); return l; }
struct Unit { int pm, pn; int kr = 0; };
typedef int i32x4 __attribute__((ext_vector_type(4)));
typedef int i32x8 __attribute__((ext_vector_type(8)));
struct Gemm { const bf16_t* A; const bf16_t* Bt; int M, N, K, lda, ldb; unsigned sw = 0x7f7f7f7fu, sx = 0x7f7f7f7fu; };

struct StaticOrder {
    int nM, nN, nwg, G, c;
    __host__ __device__ void init(int M, int N, int G_, int c_) { nM = M / BM; nN = N / BM; nwg = nM * nN; G = G_; c = c_; }
    __host__ __device__ bool next(int i, Unit& u) const {
        const long L = (long)i * G + c; if (L >= nwg) return false;
        int wgid = (int)L; { const int q = nwg / NXCD, r = nwg % NXCD, xcd = wgid % NXCD, off = wgid / NXCD; wgid = (xcd < r ? xcd * (q + 1) : r * (q + 1) + (xcd - r) * q) + off; }
        const int nig = WGM * nN, gid = wgid / nig, fm = gid * WGM, gsz = (nM - fm) < WGM ? (nM - fm) : WGM;
        u.pm = fm + ((wgid % nig) % gsz); u.pn = (wgid % nig) / gsz; return true;
    }
    __device__ __forceinline__ void a_ready(const Unit&) const {}
    __device__ __forceinline__ void done(const Unit&) const {}
};

__device__ __forceinline__ unsigned cvt_pk_bf16(float lo, float hi) { unsigned r; asm volatile("v_cvt_pk_bf16_f32 %0, %1, %2" : "=v"(r) : "v"(lo), "v"(hi)); return r; }
typedef float f32x2 __attribute__((ext_vector_type(2)));

template <class E, class = void> struct probe_of { static constexpr int v = 0; };
template <class E> struct probe_of<E, decltype((void)E::PROBE)> { static constexpr int v = E::PROBE; };
template <class Epi, class Sched, bool ALIGN_EPI = false, bool SP2 = false, bool F8 = false, int MIXT = 0, bool KROT = false, bool PFETCH = false>
__device__ __forceinline__ void gemm_phase(PG8_LAS unsigned char* lds, const Gemm g, const Sched& S, const Epi& E, const int wave_) {
    int tid_ = wave_ * 64 + pg8_lane(); asm volatile("" : "+v"(tid_));
    const int tid = tid_, wid = __builtin_amdgcn_readfirstlane(tid >> 6), lane = tid & 63, wr = wid >> 2, wc = wid & 3, fr = lane & 15, fq = lane >> 4;
    const int K = g.K, nt = K / BK;
    unsigned voffA[2], voffB[2];
#pragma unroll
    for (int i = 0; i < 2; ++i) { int R, C; stage_rc(tid * 16 + i * 8192, R, C); const int Rb = Epi::PERM ? ((R & ~31) + perm32(R & 31)) : R;
        voffA[i] = (unsigned)(R * g.lda + C) * 2u; voffB[i] = (unsigned)(Rb * g.ldb + C) * 2u; }
    const size_t kstep = (size_t)(BK * 2);
    const size_t hstepA = (size_t)HALF * g.lda * 2, hstepB = (size_t)HALF * g.ldb * 2;
    const size_t tstepA = 2 * hstepA, tstepB = 2 * hstepB;
    const unsigned ldsw = (unsigned)wid * 1024u;
    unsigned pfoff = 0;
    if constexpr (PFETCH) { const int prow = wid * 32 + (lane & 31); pfoff = (lane < 32) ? (unsigned)(prow * g.lda) * 2u : (unsigned)(prow * g.ldb) * 2u; }
    PG8_LAS unsigned* const pfl = (PG8_LAS unsigned*)(lds + RING_BYTES + 8192 + wid * 256);
#define PG8_PF(baseA_, baseB_) do { if constexpr (PFETCH) { const char* pb_ = (lane < 32) ? (const char*)(baseA_) : (const char*)(baseB_); \
        __builtin_amdgcn_global_load_lds((const unsigned*)(pb_ + pfoff), pfl, 4, 0, 0); } } while (0)
#define PG8_WV1 do { if constexpr (PFETCH) PG8_WAIT_V(9); else PG8_WAIT_V(8); } while (0)
#define PG8_WV2 do { if constexpr (PFETCH) PG8_WAIT_V(10); else PG8_WAIT_V(8); } while (0)
    const int aoff = lds_byte(wr * 64 + fr, fq * 8), boff = lds_byte(wc * 32 + fr, fq * 8);
#define PG8_SA(b, h) (((b) * 2 + (h)) * HTB)
#define PG8_SB(b, h) ((4 + (b) * 2 + (h)) * HTB)
#define PG8_STAGE(bufoff, gbase, voff) do { if constexpr (probe_of<Epi>::v != 3) _Pragma("unroll") for (int _i = 0; _i < 2; ++_i) \
        __builtin_amdgcn_global_load_lds((const unsigned*)((const char*)(gbase) + (voff)[_i]), (PG8_LAS unsigned*)(lds + (bufoff) + ldsw + _i * 8192), 16, 0, STAGE_AUX); } while (0)
#define PG8_LDA(dst, b, h) do { if constexpr (probe_of<Epi>::v != 2) _Pragma("unroll") for (int m = 0; m < 4; ++m) _Pragma("unroll") for (int k = 0; k < 2; ++k) dst[m][k] = *(const PG8_LAS bf16x8*)(lds + PG8_SA(b, h) + aoff + m * 2048 + k * 1024); } while (0)
#define PG8_LDB(dst, b, h) do { if constexpr (probe_of<Epi>::v != 2) _Pragma("unroll") for (int n = 0; n < 2; ++n) _Pragma("unroll") for (int k = 0; k < 2; ++k) dst[n][k] = *(const PG8_LAS bf16x8*)(lds + PG8_SB(b, h) + boff + n * 2048 + k * 1024); } while (0)
#define PG8_MMA(ai, bj, At, Bt) do { __builtin_amdgcn_s_setprio(1); \
        if (F8 || (MIXT > 0 && f8now)) { _Pragma("unroll") for (int m = 0; m < 4; ++m) _Pragma("unroll") for (int n = 0; n < 2; ++n) { \
            const i32x8 a8_ = __builtin_shufflevector(__builtin_bit_cast(i32x4, At[m][0]), __builtin_bit_cast(i32x4, At[m][1]), 0, 1, 2, 3, 4, 5, 6, 7); \
            const i32x8 b8_ = __builtin_shufflevector(__builtin_bit_cast(i32x4, Bt[n][0]), __builtin_bit_cast(i32x4, Bt[n][1]), 0, 1, 2, 3, 4, 5, 6, 7); \
            if constexpr (probe_of<Epi>::v == 0 || probe_of<Epi>::v == 3) asm volatile("v_mfma_scale_f32_16x16x128_f8f6f4 %0, %1, %2, %0, %3, %4 op_sel_hi:[0,0,0]" : "+v"(acc[ai][bj][m][n]) : "v"(b8_), "v"(a8_), "v"(sw_), "v"(sx_)); \
            else asm volatile("" :: "v"(b8_), "v"(a8_)); } } \
        else { _Pragma("unroll") for (int m = 0; m < 4; ++m) _Pragma("unroll") for (int n = 0; n < 2; ++n) _Pragma("unroll") for (int k = 0; k < 2; ++k) \
            acc[ai][bj][m][n] = __builtin_amdgcn_mfma_f32_16x16x32_bf16(Bt[n][k], At[m][k], acc[ai][bj][m][n], 0, 0, 0); } \
        __builtin_amdgcn_s_setprio(0); } while (0)
#define PG8_STAGE1(bufoff, gbase, voff, i_) __builtin_amdgcn_global_load_lds((const unsigned*)((const char*)(gbase) + (voff)[i_]), (PG8_LAS unsigned*)(lds + (bufoff) + ldsw + (i_) * 8192), 16, 0, 0)
#define PG8_MMAS(ai, bj, At, Bt, M0, S0, M1, S1) do { __builtin_amdgcn_s_setprio(1); \
        if (F8 || (MIXT > 0 && f8now)) { _Pragma("unroll") for (int m = 0; m < 4; ++m) { _Pragma("unroll") for (int n = 0; n < 2; ++n) { \
            const i32x8 a8_ = __builtin_shufflevector(__builtin_bit_cast(i32x4, At[m][0]), __builtin_bit_cast(i32x4, At[m][1]), 0, 1, 2, 3, 4, 5, 6, 7); \
            const i32x8 b8_ = __builtin_shufflevector(__builtin_bit_cast(i32x4, Bt[n][0]), __builtin_bit_cast(i32x4, Bt[n][1]), 0, 1, 2, 3, 4, 5, 6, 7); \
            if constexpr (probe_of<Epi>::v == 0 || probe_of<Epi>::v == 3) asm volatile("v_mfma_scale_f32_16x16x128_f8f6f4 %0, %1, %2, %0, %3, %4 op_sel_hi:[0,0,0]" : "+v"(acc[ai][bj][m][n]) : "v"(b8_), "v"(a8_), "v"(sw_), "v"(sx_)); \
            else asm volatile("" :: "v"(b8_), "v"(a8_)); } \
            if (m == (M0)) { PG8_SCHED; S0; PG8_SCHED; } if (m == (M1)) { PG8_SCHED; S1; PG8_SCHED; } } } \
        else { _Pragma("unroll") for (int m = 0; m < 4; ++m) { _Pragma("unroll") for (int n = 0; n < 2; ++n) _Pragma("unroll") for (int k = 0; k < 2; ++k) \
            acc[ai][bj][m][n] = __builtin_amdgcn_mfma_f32_16x16x32_bf16(Bt[n][k], At[m][k], acc[ai][bj][m][n], 0, 0, 0); \
            if (m == (M0)) { PG8_SCHED; S0; PG8_SCHED; } if (m == (M1)) { PG8_SCHED; S1; PG8_SCHED; } } } \
        __builtin_amdgcn_s_setprio(0); } while (0)
#define PG8_WAIT_V(n) asm volatile("s_waitcnt vmcnt(" #n ")" ::: "memory")
#define PG8_WAIT_L(n) asm volatile("s_waitcnt lgkmcnt(" #n ")" ::: "memory")
#define PG8_BAR __builtin_amdgcn_s_barrier()
#define PG8_SCHED __builtin_amdgcn_sched_barrier(0)
    Unit cur, nxt; int ui = 0;
    if (!S.next(0, cur)) return;
    f32x4 acc[2][2][4][2];
#pragma unroll
    for (int a = 0; a < 2; ++a)
#pragma unroll
        for (int b = 0; b < 2; ++b)
#pragma unroll
            for (int m = 0; m < 4; ++m)
#pragma unroll
                for (int n = 0; n < 2; ++n) acc[a][b][m][n] = (f32x4){0.f, 0.f, 0.f, 0.f};
    bf16x8 At[4][2], B0[2][2], B1[2][2];
    if constexpr (probe_of<Epi>::v == 2) {
#pragma unroll
        for (int m = 0; m < 4; ++m)
#pragma unroll
            for (int k = 0; k < 2; ++k) At[m][k] = (bf16x8){0, 0, 0, 0, 0, 0, 0, 0};
#pragma unroll
        for (int n = 0; n < 2; ++n)
#pragma unroll
            for (int k = 0; k < 2; ++k) { B0[n][k] = (bf16x8){0, 0, 0, 0, 0, 0, 0, 0}; B1[n][k] = (bf16x8){0, 0, 0, 0, 0, 0, 0, 0}; }
    }
    const int sw_ = (int)g.sw, sx_ = (int)g.sx;
    const char* cA = (const char*)g.A + (size_t)cur.pm * tstepA; const char* cB = (const char*)g.Bt + (size_t)cur.pn * tstepB;
    const int krs = (KROT && MIXT == 0 && !Epi::KSEG && (nt & 15) == 0) ? (nt >> 3) : 0;
    int ckr = krs * (cur.kr & 7);
    const char* const pA = cA + (size_t)ckr * kstep; const char* const pB = cB + (size_t)ckr * kstep;
    S.a_ready(cur);
    if constexpr (SP2) {
        PG8_STAGE(PG8_SB(0, 0), pB, voffB); PG8_STAGE(PG8_SB(0, 1), pB + hstepB, voffB); PG8_STAGE(PG8_SA(0, 0), pA, voffA); PG8_STAGE(PG8_SA(0, 1), pA + hstepA, voffA);
        if (wr == 1) PG8_BAR;
        PG8_WAIT_V(2); PG8_BAR;
        PG8_STAGE(PG8_SB(1, 0), pB + kstep, voffB); PG8_STAGE(PG8_SA(1, 0), pA + kstep, voffA); PG8_STAGE(PG8_SB(1, 1), pB + hstepB + kstep, voffB);
        PG8_PF(pA + 2 * kstep, pB + 2 * kstep);
        if constexpr (PFETCH) PG8_WAIT_V(7); else PG8_WAIT_V(6);
        PG8_BAR;
    } else {
        PG8_STAGE(PG8_SB(0, 0), pB, voffB); PG8_STAGE(PG8_SA(0, 0), pA, voffA); PG8_STAGE(PG8_SB(0, 1), pB + hstepB, voffB); PG8_STAGE(PG8_SA(0, 1), pA + hstepA, voffA);
        if (wr == 1) PG8_BAR;
        PG8_WAIT_V(4); PG8_BAR;
        PG8_STAGE(PG8_SB(1, 0), pB + kstep, voffB); PG8_STAGE(PG8_SA(1, 0), pA + kstep, voffA); PG8_STAGE(PG8_SB(1, 1), pB + hstepB + kstep, voffB);
        PG8_WAIT_V(6); PG8_BAR;
    }
    for (;;) {
        const bool has_next = S.next(ui + 1, nxt);
        const char* nA = has_next ? (const char*)g.A + (size_t)nxt.pm * tstepA : cA; const char* nB = has_next ? (const char*)g.Bt + (size_t)nxt.pn * tstepB : cB;
        const int nkr = has_next ? krs * (nxt.kr & 7) : ckr;
        for (int t = 0; t < (MIXT > 0 ? MIXT : nt); t += 2) {
            constexpr bool f8now = false; (void)f8now;
            const bool last = (t == nt - 2);
            if constexpr (Epi::KSEG) { if (t == Epi::KSEG_T1 || t == Epi::KSEG_T2) { if constexpr (F8 || MIXT > 0) asm volatile("s_nop 15\n\ts_nop 15" ::: "memory"); E.kseg(acc, cur, t, wr, wc, fr, fq); } }
            int r0 = t + ckr; if (r0 >= nt) r0 -= nt; int r2 = r0 + 2; if (r2 >= nt) r2 -= nt;
            const char* a1 = cA + (size_t)(r0 + 1) * kstep;
            const char* a2 = last ? nA + (size_t)nkr * kstep : cA + (size_t)r2 * kstep; const char* b2 = last ? nB + (size_t)nkr * kstep : cB + (size_t)r2 * kstep;
            const char* a3 = a2 + kstep; const char* b3 = b2 + kstep;
            int r4 = t + 4, k4 = ckr; const char* pfa4 = cA; const char* pfb4 = cB;
            if (r4 >= nt) { r4 -= nt; k4 = nkr; pfa4 = nA; pfb4 = nB; }
            r4 += k4; if (r4 >= nt) r4 -= nt;
            pfa4 += (size_t)r4 * kstep; pfb4 += (size_t)r4 * kstep;
            if (last && has_next) S.a_ready(nxt);
            if constexpr (SP2) {
#if STAGE_IN_MMA
            PG8_LDB(B0, 0, 0); PG8_LDB(B1, 0, 1); PG8_SCHED; PG8_LDA(At, 0, 0);
            PG8_WAIT_V(6); PG8_WAIT_L(0); PG8_BAR;
            PG8_MMAS(0, 0, At, B0, 1, PG8_STAGE1(PG8_SA(1, 1), a1 + hstepA, voffA, 0), 9, (void)0); PG8_MMAS(0, 1, At, B1, 1, PG8_STAGE1(PG8_SA(1, 1), a1 + hstepA, voffA, 1), 9, (void)0); PG8_BAR; PG8_SCHED;
            PG8_LDA(At, 0, 1); PG8_STAGE(PG8_SB(0, 0), b2, voffB);
            PG8_WAIT_V(4); PG8_WAIT_L(0); PG8_BAR;
            PG8_MMAS(1, 0, At, B0, 0, PG8_STAGE1(PG8_SB(0, 1), b2 + hstepB, voffB, 0), 2, PG8_STAGE1(PG8_SB(0, 1), b2 + hstepB, voffB, 1));
            PG8_MMAS(1, 1, At, B1, 0, PG8_STAGE1(PG8_SA(0, 0), a2, voffA, 0), 2, PG8_STAGE1(PG8_SA(0, 0), a2, voffA, 1)); PG8_BAR; PG8_SCHED;
            PG8_LDB(B0, 1, 0); PG8_LDB(B1, 1, 1); PG8_SCHED; PG8_LDA(At, 1, 0);
            PG8_WAIT_V(6); PG8_WAIT_L(0); PG8_BAR;
            PG8_MMAS(0, 0, At, B0, 1, PG8_STAGE1(PG8_SA(0, 1), a2 + hstepA, voffA, 0), 9, (void)0); PG8_MMAS(0, 1, At, B1, 1, PG8_STAGE1(PG8_SA(0, 1), a2 + hstepA, voffA, 1), 9, (void)0); PG8_BAR; PG8_SCHED;
            PG8_LDA(At, 1, 1); PG8_STAGE(PG8_SB(1, 0), b3, voffB);
            PG8_WAIT_V(4); PG8_WAIT_L(0); PG8_BAR;
            PG8_MMAS(1, 0, At, B0, 0, PG8_STAGE1(PG8_SB(1, 1), b3 + hstepB, voffB, 0), 2, PG8_STAGE1(PG8_SB(1, 1), b3 + hstepB, voffB, 1));
            PG8_MMAS(1, 1, At, B1, 0, PG8_STAGE1(PG8_SA(1, 0), a3, voffA, 0), 2, PG8_STAGE1(PG8_SA(1, 0), a3, voffA, 1)); PG8_BAR; PG8_SCHED;
#else
            PG8_LDB(B0, 0, 0); PG8_LDB(B1, 0, 1); PG8_SCHED; PG8_LDA(At, 0, 0); PG8_STAGE(PG8_SA(1, 1), a1 + hstepA, voffA);
            PG8_WV1; PG8_WAIT_L(0); PG8_BAR; PG8_MMA(0, 0, At, B0); PG8_MMA(0, 1, At, B1); PG8_BAR; PG8_SCHED;
            PG8_LDA(At, 0, 1); PG8_STAGE(PG8_SB(0, 0), b2, voffB); PG8_STAGE(PG8_SB(0, 1), b2 + hstepB, voffB); PG8_STAGE(PG8_SA(0, 0), a2, voffA); PG8_PF(pfa4, pfb4);
            PG8_WV2; PG8_WAIT_L(0); PG8_BAR; PG8_MMA(1, 0, At, B0); PG8_MMA(1, 1, At, B1); PG8_BAR; PG8_SCHED;
            PG8_LDB(B0, 1, 0); PG8_LDB(B1, 1, 1); PG8_SCHED; PG8_LDA(At, 1, 0); PG8_STAGE(PG8_SA(0, 1), a2 + hstepA, voffA);
            PG8_WV1; PG8_WAIT_L(0); PG8_BAR; PG8_MMA(0, 0, At, B0); PG8_MMA(0, 1, At, B1); PG8_BAR; PG8_SCHED;
            PG8_LDA(At, 1, 1); PG8_STAGE(PG8_SB(1, 0), b3, voffB); PG8_STAGE(PG8_SB(1, 1), b3 + hstepB, voffB); PG8_STAGE(PG8_SA(1, 0), a3, voffA); PG8_PF(pfa4 + kstep, pfb4 + kstep);
            PG8_WV2; PG8_WAIT_L(0); PG8_BAR; PG8_MMA(1, 0, At, B0); PG8_MMA(1, 1, At, B1); PG8_BAR; PG8_SCHED;
#endif
            } else {
            PG8_LDB(B0, 0, 0); PG8_SCHED; PG8_LDA(At, 0, 0); PG8_STAGE(PG8_SA(1, 1), a1 + hstepA, voffA);
            PG8_WAIT_L(8); PG8_BAR; PG8_WAIT_L(0); PG8_MMA(0, 0, At, B0); PG8_BAR; PG8_SCHED;
            PG8_LDB(B1, 0, 1); PG8_STAGE(PG8_SB(0, 0), b2, voffB);
            PG8_BAR; PG8_WAIT_L(0); PG8_MMA(0, 1, At, B1); PG8_BAR;
            PG8_LDA(At, 0, 1); PG8_STAGE(PG8_SA(0, 0), a2, voffA);
            PG8_BAR; PG8_WAIT_L(0); PG8_MMA(1, 0, At, B0); PG8_BAR; PG8_SCHED;
            PG8_STAGE(PG8_SB(0, 1), b2 + hstepB, voffB);
            PG8_WAIT_V(6); PG8_BAR; PG8_MMA(1, 1, At, B1); PG8_BAR;
            PG8_LDB(B0, 1, 0); PG8_SCHED; PG8_LDA(At, 1, 0); PG8_STAGE(PG8_SA(0, 1), a2 + hstepA, voffA);
            PG8_WAIT_L(8); PG8_BAR; PG8_WAIT_L(0); PG8_MMA(0, 0, At, B0); PG8_BAR; PG8_SCHED;
            PG8_LDB(B1, 1, 1); PG8_STAGE(PG8_SB(1, 0), b3, voffB);
            PG8_BAR; PG8_WAIT_L(0); PG8_MMA(0, 1, At, B1); PG8_BAR;
            PG8_LDA(At, 1, 1); PG8_STAGE(PG8_SA(1, 0), a3, voffA);
            PG8_BAR; PG8_WAIT_L(0); PG8_MMA(1, 0, At, B0); PG8_BAR; PG8_SCHED;
            PG8_STAGE(PG8_SB(1, 1), b3 + hstepB, voffB);
            PG8_WAIT_V(6); PG8_BAR; PG8_MMA(1, 1, At, B1); PG8_BAR;
            }
                }
        if constexpr (MIXT > 0) for (int t = MIXT; t < nt; t += 2) {
            constexpr bool f8now = true; (void)f8now;
            const bool last = (t == nt - 2);
            if constexpr (Epi::KSEG) { if (t == Epi::KSEG_T1 || t == Epi::KSEG_T2) { if constexpr (F8 || MIXT > 0) asm volatile("s_nop 15\n\ts_nop 15" ::: "memory"); E.kseg(acc, cur, t, wr, wc, fr, fq); } }
            int r0 = t + ckr; if (r0 >= nt) r0 -= nt; int r2 = r0 + 2; if (r2 >= nt) r2 -= nt;
            const char* a1 = cA + (size_t)(r0 + 1) * kstep;
            const char* a2 = last ? nA + (size_t)nkr * kstep : cA + (size_t)r2 * kstep; const char* b2 = last ? nB + (size_t)nkr * kstep : cB + (size_t)r2 * kstep;
            const char* a3 = a2 + kstep; const char* b3 = b2 + kstep;
            int r4 = t + 4, k4 = ckr; const char* pfa4 = cA; const char* pfb4 = cB;
            if (r4 >= nt) { r4 -= nt; k4 = nkr; pfa4 = nA; pfb4 = nB; }
            r4 += k4; if (r4 >= nt) r4 -= nt;
            pfa4 += (size_t)r4 * kstep; pfb4 += (size_t)r4 * kstep;
            if (last && has_next) S.a_ready(nxt);
            if constexpr (SP2) {
#if STAGE_IN_MMA
            PG8_LDB(B0, 0, 0); PG8_LDB(B1, 0, 1); PG8_SCHED; PG8_LDA(At, 0, 0);
            PG8_WAIT_V(6); PG8_WAIT_L(0); PG8_BAR;
            PG8_MMAS(0, 0, At, B0, 1, PG8_STAGE1(PG8_SA(1, 1), a1 + hstepA, voffA, 0), 9, (void)0); PG8_MMAS(0, 1, At, B1, 1, PG8_STAGE1(PG8_SA(1, 1), a1 + hstepA, voffA, 1), 9, (void)0); PG8_BAR; PG8_SCHED;
            PG8_LDA(At, 0, 1); PG8_STAGE(PG8_SB(0, 0), b2, voffB);
            PG8_WAIT_V(4); PG8_WAIT_L(0); PG8_BAR;
            PG8_MMAS(1, 0, At, B0, 0, PG8_STAGE1(PG8_SB(0, 1), b2 + hstepB, voffB, 0), 2, PG8_STAGE1(PG8_SB(0, 1), b2 + hstepB, voffB, 1));
            PG8_MMAS(1, 1, At, B1, 0, PG8_STAGE1(PG8_SA(0, 0), a2, voffA, 0), 2, PG8_STAGE1(PG8_SA(0, 0), a2, voffA, 1)); PG8_BAR; PG8_SCHED;
            PG8_LDB(B0, 1, 0); PG8_LDB(B1, 1, 1); PG8_SCHED; PG8_LDA(At, 1, 0);
            PG8_WAIT_V(6); PG8_WAIT_L(0); PG8_BAR;
            PG8_MMAS(0, 0, At, B0, 1, PG8_STAGE1(PG8_SA(0, 1), a2 + hstepA, voffA, 0), 9, (void)0); PG8_MMAS(0, 1, At, B1, 1, PG8_STAGE1(PG8_SA(0, 1), a2 + hstepA, voffA, 1), 9, (void)0); PG8_BAR; PG8_SCHED;
            PG8_LDA(At, 1, 1); PG8_STAGE(PG8_SB(1, 0), b3, voffB);
            PG8_WAIT_V(4); PG8_WAIT_L(0); PG8_BAR;
            PG8_MMAS(1, 0, At, B0, 0, PG8_STAGE1(PG8_SB(1, 1), b3 + hstepB, voffB, 0), 2, PG8_STAGE1(PG8_SB(1, 1), b3 + hstepB, voffB, 1));
            PG8_MMAS(1, 1, At, B1, 0, PG8_STAGE1(PG8_SA(1, 0), a3, voffA, 0), 2, PG8_STAGE1(PG8_SA(1, 0), a3, voffA, 1)); PG8_BAR; PG8_SCHED;
#else
            PG8_LDB(B0, 0, 0); PG8_LDB(B1, 0, 1); PG8_SCHED; PG8_LDA(At, 0, 0); PG8_STAGE(PG8_SA(1, 1), a1 + hstepA, voffA);
            PG8_WV1; PG8_WAIT_L(0); PG8_BAR; PG8_MMA(0, 0, At, B0); PG8_MMA(0, 1, At, B1); PG8_BAR; PG8_SCHED;
            PG8_LDA(At, 0, 1); PG8_STAGE(PG8_SB(0, 0), b2, voffB); PG8_STAGE(PG8_SB(0, 1), b2 + hstepB, voffB); PG8_STAGE(PG8_SA(0, 0), a2, voffA); PG8_PF(pfa4, pfb4);
            PG8_WV2; PG8_WAIT_L(0); PG8_BAR; PG8_MMA(1, 0, At, B0); PG8_MMA(1, 1, At, B1); PG8_BAR; PG8_SCHED;
            PG8_LDB(B0, 1, 0); PG8_LDB(B1, 1, 1); PG8_SCHED; PG8_LDA(At, 1, 0); PG8_STAGE(PG8_SA(0, 1), a2 + hstepA, voffA);
            PG8_WV1; PG8_WAIT_L(0); PG8_BAR; PG8_MMA(0, 0, At, B0); PG8_MMA(0, 1, At, B1); PG8_BAR; PG8_SCHED;
            PG8_LDA(At, 1, 1); PG8_STAGE(PG8_SB(1, 0), b3, voffB); PG8_STAGE(PG8_SB(1, 1), b3 + hstepB, voffB); PG8_STAGE(PG8_SA(1, 0), a3, voffA); PG8_PF(pfa4 + kstep, pfb4 + kstep);
            PG8_WV2; PG8_WAIT_L(0); PG8_BAR; PG8_MMA(1, 0, At, B0); PG8_MMA(1, 1, At, B1); PG8_BAR; PG8_SCHED;
#endif
            } else {
            PG8_LDB(B0, 0, 0); PG8_SCHED; PG8_LDA(At, 0, 0); PG8_STAGE(PG8_SA(1, 1), a1 + hstepA, voffA);
            PG8_WAIT_L(8); PG8_BAR; PG8_WAIT_L(0); PG8_MMA(0, 0, At, B0); PG8_BAR; PG8_SCHED;
            PG8_LDB(B1, 0, 1); PG8_STAGE(PG8_SB(0, 0), b2, voffB);
            PG8_BAR; PG8_WAIT_L(0); PG8_MMA(0, 1, At, B1); PG8_BAR;
            PG8_LDA(At, 0, 1); PG8_STAGE(PG8_SA(0, 0), a2, voffA);
            PG8_BAR; PG8_WAIT_L(0); PG8_MMA(1, 0, At, B0); PG8_BAR; PG8_SCHED;
            PG8_STAGE(PG8_SB(0, 1), b2 + hstepB, voffB);
            PG8_WAIT_V(6); PG8_BAR; PG8_MMA(1, 1, At, B1); PG8_BAR;
            PG8_LDB(B0, 1, 0); PG8_SCHED; PG8_LDA(At, 1, 0); PG8_STAGE(PG8_SA(0, 1), a2 + hstepA, voffA);
            PG8_WAIT_L(8); PG8_BAR; PG8_WAIT_L(0); PG8_MMA(0, 0, At, B0); PG8_BAR; PG8_SCHED;
            PG8_LDB(B1, 1, 1); PG8_STAGE(PG8_SB(1, 0), b3, voffB);
            PG8_BAR; PG8_WAIT_L(0); PG8_MMA(0, 1, At, B1); PG8_BAR;
            PG8_LDA(At, 1, 1); PG8_STAGE(PG8_SA(1, 0), a3, voffA);
            PG8_BAR; PG8_WAIT_L(0); PG8_MMA(1, 0, At, B0); PG8_BAR; PG8_SCHED;
            PG8_STAGE(PG8_SB(1, 1), b3 + hstepB, voffB);
            PG8_WAIT_V(6); PG8_BAR; PG8_MMA(1, 1, At, B1); PG8_BAR;
            }
                }
        if constexpr (ALIGN_EPI) { if (wr == 0) PG8_BAR; }
        if constexpr (F8 || MIXT > 0) asm volatile("s_nop 15\n\ts_nop 15" ::: "memory");
        if constexpr (!Epi::AFTER_DRAIN) { E(acc, cur, wr, wc, fr, fq); S.done(cur); }
        if (!has_next) break;
#pragma unroll
        for (int a = 0; a < 2; ++a)
#pragma unroll
            for (int b = 0; b < 2; ++b)
#pragma unroll
                for (int m = 0; m < 4; ++m)
#pragma unroll
                    for (int n = 0; n < 2; ++n) acc[a][b][m][n] = (f32x4){0.f, 0.f, 0.f, 0.f};
        cur = nxt; cA = nA; cB = nB; ckr = nkr; ++ui;
        if constexpr (ALIGN_EPI) { if (wr == 1) PG8_BAR; }
    }
    PG8_WAIT_V(0);
    if constexpr (!ALIGN_EPI) { if (wr == 0) PG8_BAR; }
    PG8_BAR;
    if constexpr (Epi::AFTER_DRAIN) { E.fused(acc, cur, wr, wc, fr, fq, lds, wid, lane); S.done(cur); }
#undef PG8_SA
#undef PG8_SB
#undef PG8_STAGE
#undef PG8_PF
#undef PG8_WV1
#undef PG8_WV2
#undef PG8_LDA
#undef PG8_LDB
#undef PG8_MMA
#undef PG8_MMAS
#undef PG8_STAGE1
#undef PG8_WAIT_V
#undef PG8_WAIT_L
#undef PG8_BAR
#undef PG8_SCHED
}
}
namespace pg8 {
__device__ __forceinline__ float sigm(float z) { return __builtin_amdgcn_rcpf(1.0f + __builtin_amdgcn_exp2f(-z * 1.4426950408889634f)); }
typedef unsigned u32x2 __attribute__((ext_vector_type(2)));
__device__ __forceinline__ unsigned pk4f8(const f32x4 v) { int r = __builtin_amdgcn_cvt_pk_fp8_f32(v[0], v[1], 0, false); r = __builtin_amdgcn_cvt_pk_fp8_f32(v[2], v[3], r, true); return (unsigned)r; }
__device__ __forceinline__ u32x4 pack8(const f32x4 v0, const f32x4 v1) { u32x4 w; w.x = cvt_pk_bf16(v0[0], v0[1]); w.y = cvt_pk_bf16(v0[2], v0[3]); w.z = cvt_pk_bf16(v1[0], v1[1]); w.w = cvt_pk_bf16(v1[2], v1[3]); return w; }
__device__ __forceinline__ f32x4 bf_lo4(const u32x4 w) { f32x4 r; r[0] = __uint_as_float(w.x << 16); r[1] = __uint_as_float(w.x & 0xffff0000u); r[2] = __uint_as_float(w.y << 16); r[3] = __uint_as_float(w.y & 0xffff0000u); return r; }
__device__ __forceinline__ f32x4 bf_hi4(const u32x4 w) { f32x4 r; r[0] = __uint_as_float(w.z << 16); r[1] = __uint_as_float(w.z & 0xffff0000u); r[2] = __uint_as_float(w.w << 16); r[3] = __uint_as_float(w.w & 0xffff0000u); return r; }


struct EpiP1 {
    static constexpr bool PERM = true, AFTER_DRAIN = false, KSEG = false;
    bf16_t* P1; bf16_t* MKV; const float* bgate;
    __device__ __forceinline__ void operator()(const f32x4 (&acc)[2][2][4][2], const Unit& u, int wr, int wc, int fr, int fq) const {
        const bool mem = u.pn >= 41, gate = (!mem) && u.pn >= 17;
        bf16_t* base = mem ? MKV + (size_t)((u.pm - 64) * BM + wr * 64 + fr) * 2048 + (u.pn - 41) * BM : P1 + (size_t)(u.pm * BM + wr * 64 + fr) * 10496 + u.pn * BM;
        const size_t ldc = mem ? 2048 : 10496;
        base += wc * 32 + 8 * fq;
        f32x4 bv[2][2];
#pragma unroll
        for (int bj = 0; bj < 2; ++bj)
#pragma unroll
            for (int n = 0; n < 2; ++n) bv[bj][n] = gate ? *(const f32x4*)(bgate + (u.pn - 17) * BM + wc * 32 + 8 * fq + bj * HALF + 4 * n) : (f32x4){0.f, 0.f, 0.f, 0.f};
#pragma unroll
        for (int ai = 0; ai < 2; ++ai)
#pragma unroll
            for (int m = 0; m < 4; ++m) { bf16_t* rowp = base + (size_t)(ai * HALF + m * 16) * ldc;
#pragma unroll
                for (int bj = 0; bj < 2; ++bj) { f32x4 v0 = acc[ai][bj][m][0] + bv[bj][0], v1 = acc[ai][bj][m][1] + bv[bj][1];
                    if (gate) {
#pragma unroll
                        for (int i = 0; i < 4; ++i) { v0[i] = sigm(v0[i]); v1[i] = sigm(v1[i]); } }
                    *(u32x4*)(rowp + bj * HALF) = pack8(v0, v1); } }
    }
};
struct EpiGate {
    static constexpr bool PERM = true, AFTER_DRAIN = false, KSEG = false;
    bf16_t* P1; const float* bgate;
    __device__ __forceinline__ void operator()(const f32x4 (&acc)[2][2][4][2], const Unit& u, int wr, int wc, int fr, int fq) const {
        bf16_t* base = P1 + (size_t)(u.pm * BM + wr * 64 + fr) * 10496 + 4352 + u.pn * BM + wc * 32 + 8 * fq;
        f32x4 bv[2][2];
#pragma unroll
        for (int bj = 0; bj < 2; ++bj)
#pragma unroll
            for (int n = 0; n < 2; ++n) bv[bj][n] = *(const f32x4*)(bgate + u.pn * BM + wc * 32 + 8 * fq + bj * HALF + 4 * n);
#pragma unroll
        for (int ai = 0; ai < 2; ++ai)
#pragma unroll
            for (int m = 0; m < 4; ++m) { bf16_t* rowp = base + (size_t)(ai * HALF + m * 16) * 10496;
#pragma unroll
                for (int bj = 0; bj < 2; ++bj) { f32x4 v0 = acc[ai][bj][m][0] + bv[bj][0], v1 = acc[ai][bj][m][1] + bv[bj][1];
#pragma unroll
                    for (int i = 0; i < 4; ++i) { v0[i] = sigm(v0[i]); v1[i] = sigm(v1[i]); }
                    *(u32x4*)(rowp + bj * HALF) = pack8(v0, v1); } }
    }
};
struct EpiPlain {
    static constexpr bool PERM = true, AFTER_DRAIN = false, KSEG = false;
    bf16_t* O; int ldc;
    __device__ __forceinline__ void operator()(const f32x4 (&acc)[2][2][4][2], const Unit& u, int wr, int wc, int fr, int fq) const {
        bf16_t* base = O + (size_t)(u.pm * BM + wr * 64 + fr) * ldc + u.pn * BM + wc * 32 + 8 * fq;
#pragma unroll
        for (int ai = 0; ai < 2; ++ai)
#pragma unroll
            for (int m = 0; m < 4; ++m) { bf16_t* rowp = base + (size_t)(ai * HALF + m * 16) * ldc;
#pragma unroll
                for (int bj = 0; bj < 2; ++bj) *(u32x4*)(rowp + bj * HALF) = pack8(acc[ai][bj][m][0], acc[ai][bj][m][1]); }
    }
};
template <bool FIRST> struct EpiGateAcc {
    static constexpr bool PERM = true, AFTER_DRAIN = false, KSEG = false;
    const bf16_t* G; int gcol0; bf16_t* Mg;
    __device__ __forceinline__ void operator()(const f32x4 (&acc)[2][2][4][2], const Unit& u, int wr, int wc, int fr, int fq) const {
        const int row0 = u.pm * BM + wr * 64 + fr, col0 = u.pn * BM + wc * 32 + 8 * fq;
#pragma unroll
        for (int ai = 0; ai < 2; ++ai)
#pragma unroll
            for (int m = 0; m < 4; ++m) { const size_t r = (size_t)(row0 + ai * HALF + m * 16);
#pragma unroll
                for (int bj = 0; bj < 2; ++bj) {
                    const u32x4 gw = *(const u32x4*)(G + r * 10496 + gcol0 + col0 + bj * HALF);
                    f32x4 v0 = acc[ai][bj][m][0] * bf_lo4(gw), v1 = acc[ai][bj][m][1] * bf_hi4(gw);
                    bf16_t* mp = Mg + r * 2048 + col0 + bj * HALF;
                    if (!FIRST) { const u32x4 ow = *(const u32x4*)mp; v0 = v0 + bf_lo4(ow); v1 = v1 + bf_hi4(ow); }
                    *(u32x4*)mp = pack8(v0, v1); } }
    }
};
__device__ __forceinline__ float rowsq8(const f32x4 a, const f32x4 b) { return (a[0] * a[0] + a[1] * a[1]) + (a[2] * a[2] + a[3] * a[3]) + (b[0] * b[0] + b[1] * b[1]) + (b[2] * b[2] + b[3] * b[3]); }
struct EpiKV {
    static constexpr bool PERM = true, AFTER_DRAIN = false, KSEG = false;
    PG8_LAS float* P; const float* kn_g; const float* krss; const float* krr; bf16_t* KFT; bf16_t* VFT;
    __device__ __forceinline__ void operator()(const f32x4 (&acc)[2][2][4][2], const Unit& u, int wr, int wc, int fr, int fq) const {
        asm volatile("" : "+v"(fr), "+v"(fq));
        const int h = u.pn, b = u.pm >> 4, tq = (u.pm & 15) * 4;
#pragma unroll
        for (int ai = 0; ai < 2; ++ai)
#pragma unroll
            for (int m = 0; m < 4; ++m) { float s = rowsq8(acc[ai][0][m][0], acc[ai][0][m][1]); if (XL_FAST) s = xl_swap32_sum(xl_swap16_sum(s)); else { s += __shfl_xor(s, 16); s += __shfl_xor(s, 32); }
                if (fq == 0) P[(ai * HALF + wr * 64 + m * 16 + fr) * 4 + wc] = s; }
        asm volatile("s_waitcnt lgkmcnt(0)" ::: "memory"); __builtin_amdgcn_s_barrier(); asm volatile("" ::: "memory");
        const f32x4 g0 = *(const f32x4*)(kn_g + wc * 32 + 8 * fq), g1 = *(const f32x4*)(kn_g + wc * 32 + 8 * fq + 4);
#pragma unroll
        for (int ai = 0; ai < 2; ++ai)
#pragma unroll
            for (int m = 0; m < 4; ++m) { const int row = ai * HALF + wr * 64 + m * 16 + fr, key = m * 16 + fr; const size_t t = (size_t)u.pm * BM + row;
                const f32x4 p4 = *(const PG8_LAS f32x4*)(P + row * 4);
                const float rs = 1.0f * FAST_RSQ(((p4[0] + p4[1]) + (p4[2] + p4[3]) + krss[t]) * (1.f / 192.f) + 1e-6f);
                const size_t tile = (size_t)(b * 16 + h) * 64 + tq + 2 * ai + wr;
                bf16_t* kb = KFT + tile * 12288 + key * 8;
                *(u32x4*)(kb + (4 * wc + fq) * 512) = pack8(acc[ai][0][m][0] * g0 * rs, acc[ai][0][m][1] * g1 * rs);
                *(u32x4*)(VFT + tile * 8192 + wc * 2048 + key * 32 + 8 * fq) = pack8(acc[ai][1][m][0], acc[ai][1][m][1]);
                if (fq < 2) { const int c = 2 * wc + fq; const f32x4 r0 = *(const f32x4*)(krr + t * 64 + 8 * c), r1 = *(const f32x4*)(krr + t * 64 + 8 * c + 4);
                    *(u32x4*)(kb + (16 + c) * 512) = pack8(r0 * rs, r1 * rs); }
                asm volatile("" ::: "memory"); }
    }
};
struct EpiQ {
    static constexpr bool PERM = true, AFTER_DRAIN = false, KSEG = false;
    PG8_LAS float* P; const float* qn_g; const float* rope; bf16_t* QF; float qscale;
    __device__ __forceinline__ void operator()(const f32x4 (&acc)[2][2][4][2], const Unit& u, int wr, int wc, int fr, int fq) const {
        asm volatile("" : "+v"(fr), "+v"(fq));
        const int h = u.pn, b = u.pm >> 4;
#pragma unroll
        for (int ai = 0; ai < 2; ++ai)
#pragma unroll
            for (int m = 0; m < 4; ++m) { float s = rowsq8(acc[ai][0][m][0], acc[ai][0][m][1]); if (wc < 2) s += rowsq8(acc[ai][1][m][0], acc[ai][1][m][1]);
                if (XL_FAST) s = xl_swap32_sum(xl_swap16_sum(s)); else { s += __shfl_xor(s, 16); s += __shfl_xor(s, 32); }
                if (fq == 0) P[(ai * HALF + wr * 64 + m * 16 + fr) * 4 + wc] = s; }
        asm volatile("s_waitcnt lgkmcnt(0)" ::: "memory"); __builtin_amdgcn_s_barrier(); asm volatile("" ::: "memory");
        const f32x4 g0 = *(const f32x4*)(qn_g + wc * 32 + 8 * fq) * qscale, g1 = *(const f32x4*)(qn_g + wc * 32 + 8 * fq + 4) * qscale;
        const int j = 4 * (4 * (wc & 1) + fq);
        const f32x4 gr1 = *(const f32x4*)(qn_g + 128 + j) * qscale, gr2 = *(const f32x4*)(qn_g + 160 + j) * qscale;
#pragma unroll
        for (int ai = 0; ai < 2; ++ai)
#pragma unroll
            for (int m = 0; m < 4; ++m) { const int row = ai * HALF + wr * 64 + m * 16 + fr; const size_t t = (size_t)u.pm * BM + row;
                const f32x4 p4 = *(const PG8_LAS f32x4*)(P + row * 4);
                const float rs = 1.0f * FAST_RSQ(((p4[0] + p4[1]) + (p4[2] + p4[3])) * (1.f / 192.f) + 1e-6f);
                bf16_t* qb = QF + ((size_t)(b * 16 + h) * 4096 + (t & 4095)) * 192;
                *(u32x4*)(qb + wc * 32 + 8 * fq) = pack8(acc[ai][0][m][0] * g0 * rs, acc[ai][0][m][1] * g1 * rs);
                if (wc < 2) { const f32x4 c4 = *(const f32x4*)(rope + t * 64 + j), s4 = *(const f32x4*)(rope + t * 64 + 32 + j);
                    const f32x4 t1 = acc[ai][1][m][0] * gr1 * rs, t2 = acc[ai][1][m][1] * gr2 * rs;
                    const f32x4 o1 = t1 * c4 - t2 * s4, o2 = t1 * s4 + t2 * c4;
                    u32x2 w1; w1.x = cvt_pk_bf16(o1[0], o1[1]); w1.y = cvt_pk_bf16(o1[2], o1[3]); *(u32x2*)(qb + 128 + j) = w1;
                    u32x2 w2; w2.x = cvt_pk_bf16(o2[0], o2[1]); w2.y = cvt_pk_bf16(o2[2], o2[3]); *(u32x2*)(qb + 160 + j) = w2; }
                asm volatile("" ::: "memory"); }
    }
};
__device__ __forceinline__ unsigned pk4f8s(const f32x4 v, float s) { int r = __builtin_amdgcn_cvt_pk_fp8_f32(v[0] * s, v[1] * s, 0, false); r = __builtin_amdgcn_cvt_pk_fp8_f32(v[2] * s, v[3] * s, r, true); return (unsigned)r; }
struct EpiKV8 {
    static constexpr bool PERM = true, AFTER_DRAIN = false, KSEG = false;
    PG8_LAS float* P; const float* kn_g; const float* krss; const float* krr; unsigned char* K8; unsigned char* V8;
    __device__ __forceinline__ void operator()(const f32x4 (&acc)[2][2][4][2], const Unit& u, int wr, int wc, int fr, int fq) const {
        asm volatile("" : "+v"(fr), "+v"(fq));
        const int h = u.pn, b = u.pm >> 4, tq = (u.pm & 15) * 4;
#pragma unroll
        for (int ai = 0; ai < 2; ++ai)
#pragma unroll
            for (int m = 0; m < 4; ++m) { float s = rowsq8(acc[ai][0][m][0], acc[ai][0][m][1]); if (XL_FAST) s = xl_swap32_sum(xl_swap16_sum(s)); else { s += __shfl_xor(s, 16); s += __shfl_xor(s, 32); }
                if (fq == 0) P[(ai * HALF + wr * 64 + m * 16 + fr) * 4 + wc] = s; }
        asm volatile("s_waitcnt lgkmcnt(0)" ::: "memory"); __builtin_amdgcn_s_barrier(); asm volatile("" ::: "memory");
        const f32x4 g0 = *(const f32x4*)(kn_g + wc * 32 + 8 * fq), g1 = *(const f32x4*)(kn_g + wc * 32 + 8 * fq + 4);
#pragma unroll
        for (int ai = 0; ai < 2; ++ai)
#pragma unroll
            for (int m = 0; m < 4; ++m) { const int row = ai * HALF + wr * 64 + m * 16 + fr, key = m * 16 + fr; const size_t t = (size_t)u.pm * BM + row;
                const f32x4 p4 = *(const PG8_LAS f32x4*)(P + row * 4);
                const float rs = 1.0f * FAST_RSQ(((p4[0] + p4[1]) + (p4[2] + p4[3]) + krss[t]) * (1.f / 192.f) + 1e-6f);
                const size_t tile = (size_t)(b * 16 + h) * 64 + tq + 2 * ai + wr;
                unsigned char* kb = K8 + tile * 12288 + key * 16;
                { u32x2 w; w.x = pk4f8s(acc[ai][0][m][0] * g0, rs); w.y = pk4f8s(acc[ai][0][m][1] * g1, rs); *(u32x2*)(kb + (2 * wc + (fq >> 1)) * 1024 + 8 * (fq & 1)) = w; }
                if (fq < 2) { const f32x4 r0 = *(const f32x4*)(krr + t * 64 + 16 * wc + 8 * fq), r1 = *(const f32x4*)(krr + t * 64 + 16 * wc + 8 * fq + 4);
                    u32x2 w; w.x = pk4f8s(r0, rs); w.y = pk4f8s(r1, rs); *(u32x2*)(kb + (8 + wc) * 1024 + 8 * fq) = w; }
                const int p = 32 * ((fr >> 2) & 1) + 16 * (m >> 1) + (fr & 3) + 4 * (2 * (m & 1) + (fr >> 3));
                unsigned char* vb = V8 + tile * 8192 + (p >> 4) * 2048 + (size_t)(wc * 32 + 8 * fq) * 16 + (p & 15);
                const unsigned w0 = pk4f8s(acc[ai][1][m][0], 1.0f), w1 = pk4f8s(acc[ai][1][m][1], 1.0f);
                vb[0] = (unsigned char)w0; vb[16] = (unsigned char)(w0 >> 8); vb[32] = (unsigned char)(w0 >> 16); vb[48] = (unsigned char)(w0 >> 24);
                vb[64] = (unsigned char)w1; vb[80] = (unsigned char)(w1 >> 8); vb[96] = (unsigned char)(w1 >> 16); vb[112] = (unsigned char)(w1 >> 24);
                asm volatile("" ::: "memory"); }
    }
};
struct EpiQ8 {
    static constexpr bool PERM = true, AFTER_DRAIN = false, KSEG = false;
    PG8_LAS float* P; const float* qn_g; const float* rope; unsigned char* Q8; float qscale;
    __device__ __forceinline__ void operator()(const f32x4 (&acc)[2][2][4][2], const Unit& u, int wr, int wc, int fr, int fq) const {
        asm volatile("" : "+v"(fr), "+v"(fq));
        const int h = u.pn, b = u.pm >> 4;
#pragma unroll
        for (int ai = 0; ai < 2; ++ai)
#pragma unroll
            for (int m = 0; m < 4; ++m) { float s = rowsq8(acc[ai][0][m][0], acc[ai][0][m][1]); if (wc < 2) s += rowsq8(acc[ai][1][m][0], acc[ai][1][m][1]);
                if (XL_FAST) s = xl_swap32_sum(xl_swap16_sum(s)); else { s += __shfl_xor(s, 16); s += __shfl_xor(s, 32); }
                if (fq == 0) P[(ai * HALF + wr * 64 + m * 16 + fr) * 4 + wc] = s; }
        asm volatile("s_waitcnt lgkmcnt(0)" ::: "memory"); __builtin_amdgcn_s_barrier(); asm volatile("" ::: "memory");
        const f32x4 g0 = *(const f32x4*)(qn_g + wc * 32 + 8 * fq) * qscale, g1 = *(const f32x4*)(qn_g + wc * 32 + 8 * fq + 4) * qscale;
        const int j = 4 * (4 * (wc & 1) + fq);
        const f32x4 gr1 = *(const f32x4*)(qn_g + 128 + j) * qscale, gr2 = *(const f32x4*)(qn_g + 160 + j) * qscale;
#pragma unroll
        for (int ai = 0; ai < 2; ++ai)
#pragma unroll
            for (int m = 0; m < 4; ++m) { const int row = ai * HALF + wr * 64 + m * 16 + fr; const size_t t = (size_t)u.pm * BM + row;
                const f32x4 p4 = *(const PG8_LAS f32x4*)(P + row * 4);
                const float rs = 1.0f * FAST_RSQ(((p4[0] + p4[1]) + (p4[2] + p4[3])) * (1.f / 192.f) + 1e-6f);
                unsigned char* qb = Q8 + ((size_t)(b * 16 + h) * 4096 + (t & 4095)) * 192;
                { u32x2 w; w.x = pk4f8s(acc[ai][0][m][0] * g0, rs); w.y = pk4f8s(acc[ai][0][m][1] * g1, rs); *(u32x2*)(qb + wc * 32 + 8 * fq) = w; }
                if (wc < 2) { const f32x4 c4 = *(const f32x4*)(rope + t * 64 + j), s4 = *(const f32x4*)(rope + t * 64 + 32 + j);
                    const f32x4 t1 = acc[ai][1][m][0] * gr1 * rs, t2 = acc[ai][1][m][1] * gr2 * rs;
                    *(unsigned*)(qb + 128 + j) = pk4f8s(t1 * c4 - t2 * s4, 1.0f); *(unsigned*)(qb + 160 + j) = pk4f8s(t1 * s4 + t2 * c4, 1.0f); }
                asm volatile("" ::: "memory"); }
    }
};
template <int T1_, int T2_> struct EpiMergedT {
    static constexpr bool PERM = true, AFTER_DRAIN = false, KSEG = true; static constexpr int KSEG_T1 = T1_, KSEG_T2 = T2_;
    const bf16_t* G; bf16_t* Mg;
    __device__ __forceinline__ void kseg(f32x4 (&acc)[2][2][4][2], const Unit& u, int t, int wr, int wc, int fr, int fq) const {
        const bf16_t* gp = G + (size_t)(u.pm * BM + wr * 64 + fr) * 10496 + 4352 + (t == KSEG_T1 ? 0 : 2048) + u.pn * BM + wc * 32 + 8 * fq;
#if KSEG_BATCH16
#pragma unroll
        for (int ai = 0; ai < 2; ++ai) {
            u32x4 gn[4][2], gd[4][2];
#pragma unroll
            for (int m = 0; m < 4; ++m)
#pragma unroll
                for (int bj = 0; bj < 2; ++bj) { const bf16_t* p = gp + (size_t)(ai * HALF + m * 16) * 10496 + bj * HALF; gn[m][bj] = *(const u32x4*)p; gd[m][bj] = *(const u32x4*)(p + 2048); }
#pragma unroll
            for (int m = 0; m < 4; ++m)
#pragma unroll
                for (int bj = 0; bj < 2; ++bj) {
                    f32x4 r0 = bf_lo4(gd[m][bj]), r1 = bf_hi4(gd[m][bj]);
#pragma unroll
                    for (int i = 0; i < 4; ++i) { r0[i] = __builtin_amdgcn_rcpf(r0[i]); r1[i] = __builtin_amdgcn_rcpf(r1[i]); }
                    acc[ai][bj][m][0] = acc[ai][bj][m][0] * (bf_lo4(gn[m][bj]) * r0); acc[ai][bj][m][1] = acc[ai][bj][m][1] * (bf_hi4(gn[m][bj]) * r1); }
            asm volatile("" : "+v"(acc[ai][0][0][0]), "+v"(acc[ai][0][0][1]), "+v"(acc[ai][1][0][0]), "+v"(acc[ai][1][0][1]), "+v"(acc[ai][0][1][0]), "+v"(acc[ai][0][1][1]), "+v"(acc[ai][1][1][0]), "+v"(acc[ai][1][1][1]),
                         "+v"(acc[ai][0][2][0]), "+v"(acc[ai][0][2][1]), "+v"(acc[ai][1][2][0]), "+v"(acc[ai][1][2][1]), "+v"(acc[ai][0][3][0]), "+v"(acc[ai][0][3][1]), "+v"(acc[ai][1][3][0]), "+v"(acc[ai][1][3][1]) :: "memory");
        }
    }
#else
#pragma unroll
        for (int ai = 0; ai < 2; ++ai)
#pragma unroll
            for (int mp = 0; mp < 2; ++mp) {
                u32x4 gn[2][2], gd[2][2];
#pragma unroll
                for (int mm = 0; mm < 2; ++mm)
#pragma unroll
                    for (int bj = 0; bj < 2; ++bj) { const bf16_t* p = gp + (size_t)(ai * HALF + (2 * mp + mm) * 16) * 10496 + bj * HALF; gn[mm][bj] = *(const u32x4*)p; gd[mm][bj] = *(const u32x4*)(p + 2048); }
#pragma unroll
                for (int mm = 0; mm < 2; ++mm)
#pragma unroll
                    for (int bj = 0; bj < 2; ++bj) { const int m = 2 * mp + mm;
                        f32x4 r0 = bf_lo4(gd[mm][bj]), r1 = bf_hi4(gd[mm][bj]);
#pragma unroll
                        for (int i = 0; i < 4; ++i) { r0[i] = __builtin_amdgcn_rcpf(r0[i]); r1[i] = __builtin_amdgcn_rcpf(r1[i]); }
                        acc[ai][bj][m][0] = acc[ai][bj][m][0] * (bf_lo4(gn[mm][bj]) * r0); acc[ai][bj][m][1] = acc[ai][bj][m][1] * (bf_hi4(gn[mm][bj]) * r1); }
                asm volatile("" : "+v"(acc[ai][0][2 * mp][0]), "+v"(acc[ai][0][2 * mp][1]), "+v"(acc[ai][1][2 * mp][0]), "+v"(acc[ai][1][2 * mp][1]), "+v"(acc[ai][0][2 * mp + 1][0]), "+v"(acc[ai][0][2 * mp + 1][1]), "+v"(acc[ai][1][2 * mp + 1][0]), "+v"(acc[ai][1][2 * mp + 1][1]) :: "memory");
            }
    }
#endif
    __device__ __forceinline__ void operator()(const f32x4 (&acc)[2][2][4][2], const Unit& u, int wr, int wc, int fr, int fq) const {
        const int row0 = u.pm * BM + wr * 64 + fr, col0 = u.pn * BM + wc * 32 + 8 * fq;
#pragma unroll
        for (int ai = 0; ai < 2; ++ai)
#pragma unroll
            for (int m = 0; m < 4; ++m) { const size_t r = (size_t)(row0 + ai * HALF + m * 16);
#pragma unroll
                for (int bj = 0; bj < 2; ++bj) {
                    const u32x4 gw = *(const u32x4*)(G + r * 10496 + 4352 + 4096 + col0 + bj * HALF);
                    *(u32x4*)(Mg + r * 2048 + col0 + bj * HALF) = pack8(acc[ai][bj][m][0] * bf_lo4(gw), acc[ai][bj][m][1] * bf_hi4(gw)); } }
    }
};
struct EpiX1 {
    static constexpr bool PERM = true, AFTER_DRAIN = false, KSEG = false;
    const float* X; bf16_t* O;
    __device__ __forceinline__ void operator()(const f32x4 (&acc)[2][2][4][2], const Unit& u, int wr, int wc, int fr, int fq) const {
        const int row0 = u.pm * BM + wr * 64 + fr, col0 = u.pn * BM + wc * 32 + 8 * fq;
#if EPIX1_BATCH
#pragma unroll
        for (int ai = 0; ai < 2; ++ai) {
            f32x4 xv[4][2][2];
#pragma unroll
            for (int m = 0; m < 4; ++m) { const size_t off = (size_t)(row0 + ai * HALF + m * 16) * 2048 + col0;
#pragma unroll
                for (int bj = 0; bj < 2; ++bj) { xv[m][bj][0] = *(const f32x4*)(X + off + bj * HALF); xv[m][bj][1] = *(const f32x4*)(X + off + bj * HALF + 4); } }
#pragma unroll
            for (int m = 0; m < 4; ++m) { const size_t off = (size_t)(row0 + ai * HALF + m * 16) * 2048 + col0;
#pragma unroll
                for (int bj = 0; bj < 2; ++bj) *(u32x4*)(O + off + bj * HALF) = pack8(xv[m][bj][0] + acc[ai][bj][m][0], xv[m][bj][1] + acc[ai][bj][m][1]); }
            asm volatile("" ::: "memory");
        }
    }
};
#else
#pragma unroll
        for (int ai = 0; ai < 2; ++ai)
#pragma unroll
            for (int m = 0; m < 4; ++m) { const size_t off = (size_t)(row0 + ai * HALF + m * 16) * 2048 + col0;
#pragma unroll
                for (int bj = 0; bj < 2; ++bj) { const f32x4 x0 = *(const f32x4*)(X + off + bj * HALF), x1 = *(const f32x4*)(X + off + bj * HALF + 4);
                    *(u32x4*)(O + off + bj * HALF) = pack8(x0 + acc[ai][bj][m][0], x1 + acc[ai][bj][m][1]); } }
    }
};
#endif
struct EpiSwiGLU {
    static constexpr bool PERM = true, AFTER_DRAIN = false, KSEG = false;
    const float* bgu; unsigned char* ACT;
    __device__ __forceinline__ void operator()(const f32x4 (&acc)[2][2][4][2], const Unit& u, int wr, int wc, int fr, int fq) const {
        const int e = u.pn >> 4, pnl = u.pn & 15, cl = pnl * HALF + wc * 32 + 8 * fq;
        const float* bp = bgu + (size_t)e * 4096 + cl;
        f32x4 bg[2], bu[2];
#pragma unroll
        for (int n = 0; n < 2; ++n) { bg[n] = *(const f32x4*)(bp + 4 * n); bu[n] = *(const f32x4*)(bp + 2048 + 4 * n); }
        unsigned char* base = ACT + (size_t)(u.pm * BM + wr * 64 + fr) * 2048 + cl;
#pragma unroll
        for (int ai = 0; ai < 2; ++ai)
#pragma unroll
            for (int m = 0; m < 4; ++m) { f32x4 o[2];
#pragma unroll
                for (int n = 0; n < 2; ++n) { const f32x4 g4 = acc[ai][0][m][n] + bg[n], u4 = acc[ai][1][m][n] + bu[n];
#pragma unroll
                    for (int i = 0; i < 4; ++i) { const float g = fminf(g4[i], 7.0f), up = fminf(fmaxf(u4[i], -7.0f), 7.0f); o[n][i] = (up + 1.0f) * g * sigm(1.702f * g); } }
                u32x2 w8; w8.x = pk4f8(o[0]); w8.y = pk4f8(o[1]); *(u32x2*)(base + (size_t)(ai * HALF + m * 16) * 2048) = w8; }
    }
};
template <int P_> struct EpiSwiGLUProbe : EpiSwiGLU { static constexpr int PROBE = P_;
    __device__ __forceinline__ void operator()(const f32x4 (&)[2][2][4][2], const Unit&, int, int, int, int) const {} };

struct EpiDown {
    static constexpr bool PERM = true, AFTER_DRAIN = false, KSEG = false;
    const float* bd; unsigned char* Y;
    __device__ __forceinline__ void operator()(const f32x4 (&acc)[2][2][4][2], const Unit& u, int wr, int wc, int fr, int fq) const {
        const int e = u.pn >> 3, pnl = u.pn & 7, cl = pnl * BM + wc * 32 + 8 * fq;
        const float* bp = bd + (size_t)e * 2048 + cl;
        f32x4 bv[2][2];
#pragma unroll
        for (int bj = 0; bj < 2; ++bj)
#pragma unroll
            for (int n = 0; n < 2; ++n) bv[bj][n] = *(const f32x4*)(bp + bj * HALF + 4 * n);
        unsigned char* base = Y + (size_t)(u.pm * BM + wr * 64 + fr) * 2048 + cl;
#pragma unroll
        for (int ai = 0; ai < 2; ++ai)
#pragma unroll
            for (int m = 0; m < 4; ++m) { unsigned char* rowp = base + (size_t)(ai * HALF + m * 16) * 2048;
#pragma unroll
                for (int bj = 0; bj < 2; ++bj) { u32x2 w; w.x = pk4f8(acc[ai][bj][m][0] + bv[bj][0]); w.y = pk4f8(acc[ai][bj][m][1] + bv[bj][1]); *(u32x2*)(rowp + bj * HALF) = w; } }
    }
};

struct P1Order {
    StaticOrder base; int i_off, i_lim;
    __device__ void init(int G_, int c_, int i_off_, int i_lim_) { base.init(16384, (GATE_F8 ? (UV_F8 == 2 ? 4 : 8) : 41) * 256, G_, c_); i_off = i_off_; i_lim = i_lim_; }
    __device__ bool next(int i_, Unit& u) const {
        const int i = i_ + i_off; if (i >= i_lim) return false;
        const long L = (long)i * base.G + base.c;
        if (L < base.nwg) return base.next(i, u);
        const int j = (int)(L - base.nwg); if (GATE_F8 || j >= 32) return false;
        u.pm = 64 + (j & 3); u.pn = 41 + (j >> 2); return true;
    }
    __device__ __forceinline__ void a_ready(const Unit&) const {}
    __device__ __forceinline__ void done(const Unit&) const {}
};
struct GateOrder {
    StaticOrder base;
    __device__ void init(int G_, int c_) { base.init(16384, (UV_F8 == 1 ? 41 : UV_F8 == 2 ? 37 : 33) * 256, G_, c_); }
    __device__ bool next(int i, Unit& u) const {
        const long L = (long)i * base.G + base.c;
        if (L < base.nwg) { base.next(i, u); u.pn += (UV_F8 == 1 ? 0 : UV_F8 == 2 ? 4 : 8); return true; }
        const int j = (int)(L - base.nwg);
        if (j < 32) { u.pm = 64 + (j & 3); u.pn = 41 + (j >> 2); return true; }
        return false;
    }
    __device__ __forceinline__ void a_ready(const Unit&) const {}
    __device__ __forceinline__ void done(const Unit&) const {}
};
struct MoeOrder {
    const PG8_LAS int* tab; int NT, x, j;
    __device__ bool next(int i, Unit& u) const {
#if MOE_MAP2
        const int g = NT >> 2, Lx = i * 32 + j, rbi = Lx / g, s = Lx - rbi * g, rb = 2 * rbi + (x >> 2);
        if (rb >= __builtin_amdgcn_readfirstlane(tab[32])) return false;
        int e = 0;
        while (__builtin_amdgcn_readfirstlane(tab[e + 1]) <= rb) ++e;
        u.pm = rb; u.pn = e * NT + (x & 3) + 4 * s; u.kr = 0; return true;
#else
        const int ntx = NT >> 3, Lx = i * 32 + j, rb = Lx / ntx, s = Lx - rb * ntx;
        if (rb >= __builtin_amdgcn_readfirstlane(tab[32])) return false;
        int e = 0;
        while (__builtin_amdgcn_readfirstlane(tab[e + 1]) <= rb) ++e;
        u.pm = rb; u.pn = e * NT + x + 8 * s; u.kr = (rb + 4 * s) & 7; return true;
#endif
    }
    __device__ __forceinline__ void a_ready(const Unit&) const {}
    __device__ __forceinline__ void done(const Unit&) const {}
};
}
#define GAS __attribute__((address_space(1)))
#define LAS __attribute__((address_space(3)))
typedef unsigned short bf16;
typedef unsigned v4u __attribute__((ext_vector_type(4)));
typedef float f32x4 __attribute__((ext_vector_type(4)));
typedef short bf16x8 __attribute__((ext_vector_type(8)));
typedef GAS unsigned gu32;
typedef GAS unsigned long long gu64;
#define RLX_AGENT __ATOMIC_RELAXED, __HIP_MEMORY_SCOPE_AGENT
#define LDS_WAIT() asm volatile("s_waitcnt lgkmcnt(0)" ::: "memory")
#define VM_WAIT() asm volatile("s_waitcnt vmcnt(0)" ::: "memory")
__device__ __forceinline__ unsigned long long rt() { return __builtin_amdgcn_s_memrealtime(); }
__device__ __forceinline__ unsigned f2bf(float f) { unsigned u = __builtin_bit_cast(unsigned, f); return (u + 0x7fffu + ((u >> 16) & 1u)) >> 16; }
__device__ __forceinline__ unsigned pk2(float lo, float hi) { return f2bf(lo) | (f2bf(hi) << 16); }
#define XB_TMO      128
#define XB_XCNT(j)  (256  + 64 * (j))
#define XB_XSUB(j)  (1280 + 64 * (j))
#define XB_XGEN(j)  (2304 + 64 * (j))
#define XB_TOP      3328
#define XB_TOPGEN   3392
#define XCD_BAR_WORDS 3456
#define XB_SPIN_CAP (1u << 18)

__device__ __forceinline__ unsigned xb_ld(unsigned* p)              { return __hip_atomic_load(p, __ATOMIC_RELAXED, __HIP_MEMORY_SCOPE_AGENT); }
__device__ __forceinline__ unsigned xb_add(unsigned* p, unsigned v) { return __hip_atomic_fetch_add(p, v, __ATOMIC_RELAXED, __HIP_MEMORY_SCOPE_AGENT); }
__device__ __forceinline__ unsigned xb_xcc_id() { return (unsigned)__builtin_amdgcn_s_getreg((3 << 11) | 20) & 0xFu; }
#define XB_SPIN(cond, bar) do { unsigned _sp = 0; while (cond) { __builtin_amdgcn_s_sleep(1); \
    if ((++_sp & 255u) == 0u) { if (xb_ld(&(bar)[XB_TMO])) break; if (_sp > XB_SPIN_CAP) { atomicAdd(&(bar)[XB_TMO], 1u); break; } } } } while (0)

struct XcdBarrier {
    unsigned* bar; unsigned x;
    volatile LAS unsigned* st;
};

__device__ __forceinline__ XcdBarrier xcd_barrier_post(unsigned* bar, volatile LAS unsigned* st) {
    XcdBarrier b; b.bar = bar; b.x = xb_xcc_id(); b.st = st;
    if (threadIdx.x == 0) (void)xb_add(&bar[XB_XCNT(b.x)], 1u);
    return b;
}
__device__ __forceinline__ void xcd_barrier_complete(unsigned* bar, unsigned x, unsigned& nloc, unsigned& nx) {
    const unsigned G = gridDim.x * gridDim.y * gridDim.z;
    unsigned sum, cnt, mine, sp = 0u;
    for (;;) {
        sum = 0u; cnt = 0u; mine = 0u;
#pragma unroll
        for (unsigned j = 0; j < 16; ++j) { const unsigned c = xb_ld(&bar[XB_XCNT(j)]); sum += c; cnt += (c > 0u) ? 1u : 0u; mine = (j == x) ? c : mine; }
        if (sum == G) break;
        __builtin_amdgcn_s_sleep(1);
        if ((++sp & 255u) == 0u) { if (xb_ld(&bar[XB_TMO])) break; if (sp > XB_SPIN_CAP) { atomicAdd(&bar[XB_TMO], 1u); break; } }
    }
    nloc = mine > 0u ? mine : 1u; nx = cnt > 0u ? cnt : 1u;
}

__device__ __forceinline__ void xcd_barrier(const XcdBarrier& b) {
    asm volatile("s_waitcnt vmcnt(0)" ::: "memory");
    __syncthreads();
    if (threadIdx.x == 0) {
        unsigned* bar = b.bar;
        __builtin_amdgcn_s_waitcnt(0);
        unsigned nloc = b.st[0], nx = b.st[1];
        if (nloc == 0u) { xcd_barrier_complete(bar, b.x, nloc, nx); b.st[0] = nloc; b.st[1] = nx; }
        const unsigned old = xb_add(&bar[XB_XSUB(b.x)], 1u);
        const unsigned gen = old / nloc;
        if (old + 1u == (gen + 1u) * nloc) {
            __builtin_amdgcn_fence(__ATOMIC_RELEASE, "agent");
            asm volatile("s_waitcnt vmcnt(0)" ::: "memory");
            const unsigned og = xb_add(&bar[XB_TOP], 1u);
            const unsigned tg = og / nx;
            if (og + 1u == (tg + 1u) * nx) xb_add(&bar[XB_TOPGEN], 1u);
            else XB_SPIN(xb_ld(&bar[XB_TOPGEN]) == tg, bar);
            __builtin_amdgcn_fence(__ATOMIC_ACQUIRE, "agent");
            xb_add(&bar[XB_XGEN(b.x)], 1u);
            asm volatile("s_waitcnt vmcnt(0)" ::: "memory");
        } else {
            XB_SPIN(xb_ld(&bar[XB_XGEN(b.x)]) == gen, bar);
            __builtin_amdgcn_fence(__ATOMIC_ACQUIRE, "agent");
            asm volatile("s_waitcnt vmcnt(0)" ::: "memory");
        }
    }
    __syncthreads();
}
typedef float f32x16 __attribute__((ext_vector_type(16)));
typedef float f32x2 __attribute__((ext_vector_type(2)));
typedef short s16x4 __attribute__((ext_vector_type(4)));
typedef unsigned u32x2 __attribute__((ext_vector_type(2)));
typedef short v4i16_t __attribute__((ext_vector_type(4)));
__device__ __forceinline__ unsigned cvtpk(float lo, float hi) { unsigned r; asm volatile("v_cvt_pk_bf16_f32 %0, %1, %2" : "=v"(r) : "v"(lo), "v"(hi)); return r; }
__device__ __forceinline__ float bflo(unsigned w) { return __uint_as_float(w << 16); }
__device__ __forceinline__ float bfhi(unsigned w) { return __uint_as_float(w & 0xffff0000u); }
__device__ __forceinline__ void unpack8(const v4u w, float (&f)[8]) { f[0] = bflo(w.x); f[1] = bfhi(w.x); f[2] = bflo(w.y); f[3] = bfhi(w.y); f[4] = bflo(w.z); f[5] = bfhi(w.z); f[6] = bflo(w.w); f[7] = bfhi(w.w); }
__device__ __forceinline__ v4u packf8(const float (&f)[8]) { v4u w; w.x = cvtpk(f[0], f[1]); w.y = cvtpk(f[2], f[3]); w.z = cvtpk(f[4], f[5]); w.w = cvtpk(f[6], f[7]); return w; }
__device__ __forceinline__ float wave_sum(float v) {
#if XL_FAST
    return xl_swap32_sum(xl_swap16_sum(xl_sum16(v)));
#else
#pragma unroll
    for (int o = 1; o < 64; o <<= 1) v += __shfl_xor(v, o);
    return v;
#endif
}
__device__ __forceinline__ int crow(int r, int hi) { return (r & 3) + 8 * (r >> 2) + 4 * hi; }

template <bool ROPEP = false>
__device__ __forceinline__ void transpose_item64(const float* W, size_t ldw, int k0, int n0, bf16* WT, size_t ldt, int r0, LAS float* scr, int lane, int kdst = 0) {
    const GAS float* src = (const GAS float*)W + (size_t)(k0 + (lane >> 4)) * ldw + n0 + (lane & 15) * 4;
    f32x4 v[16];
#pragma unroll
    for (int i = 0; i < 16; ++i) v[i] = *(const GAS f32x4*)(src + (size_t)(4 * i) * ldw);
#pragma unroll
    for (int i = 0; i < 16; ++i) { LAS float* s = scr + (4 * i + (lane >> 4)) * 65 + (lane & 15) * 4; s[0] = v[i].x; s[1] = v[i].y; s[2] = v[i].z; s[3] = v[i].w; }
    LDS_WAIT(); asm volatile("" ::: "memory");
    const int c = lane & 7;
#pragma unroll
    for (int j = 0; j < 8; ++j) { const int n = (lane >> 3) + 8 * j; const LAS float* s = scr + (8 * c) * 65 + n;
        v4u o; o.x = cvtpk(s[0 * 65], s[1 * 65]); o.y = cvtpk(s[2 * 65], s[3 * 65]); o.z = cvtpk(s[4 * 65], s[5 * 65]); o.w = cvtpk(s[6 * 65], s[7 * 65]);
        const int nd = ROPEP ? (((n >> 4) & 1) * 32 + ((n >> 2) & 3) * 8 + (n >> 5) * 4 + (n & 3)) : n;
        *(GAS v4u*)(WT + (size_t)(r0 + nd) * ldt + kdst + k0 + 8 * c) = o; }
    LDS_WAIT(); asm volatile("" ::: "memory");
}
__device__ __forceinline__ unsigned pk4_fp8(float a, float b, float c, float d) { int r = __builtin_amdgcn_cvt_pk_fp8_f32(a, b, 0, false); r = __builtin_amdgcn_cvt_pk_fp8_f32(c, d, r, true); return (unsigned)r; }
template <bool ROPEP = false>
__device__ __forceinline__ void transpose_item64_f8(const float* W, size_t ldw, int k0, int n0, unsigned char* WT, size_t ldt, int r0, LAS float* scr, int lane, float scale) {
    const GAS float* src = (const GAS float*)W + (size_t)(k0 + (lane >> 4)) * ldw + n0 + (lane & 15) * 4;
    f32x4 v[16];
#pragma unroll
    for (int i = 0; i < 16; ++i) v[i] = *(const GAS f32x4*)(src + (size_t)(4 * i) * ldw);
#pragma unroll
    for (int i = 0; i < 16; ++i) { LAS float* s = scr + (4 * i + (lane >> 4)) * 65 + (lane & 15) * 4; s[0] = v[i].x; s[1] = v[i].y; s[2] = v[i].z; s[3] = v[i].w; }
    LDS_WAIT(); asm volatile("" ::: "memory");
    const int c = lane & 7;
#pragma unroll
    for (int j = 0; j < 8; ++j) { const int n = (lane >> 3) + 8 * j; const LAS float* s = scr + (8 * c) * 65 + n;
        u32x2 o; o.x = pk4_fp8(s[0 * 65] * scale, s[1 * 65] * scale, s[2 * 65] * scale, s[3 * 65] * scale); o.y = pk4_fp8(s[4 * 65] * scale, s[5 * 65] * scale, s[6 * 65] * scale, s[7 * 65] * scale);
        const int nd = ROPEP ? (((n >> 4) & 1) * 32 + ((n >> 2) & 3) * 8 + (n >> 5) * 4 + (n & 3)) : n;
        *(GAS u32x2*)(WT + (size_t)(r0 + nd) * ldt + k0 + 8 * c) = o; }
    LDS_WAIT(); asm volatile("" ::: "memory");
}
__device__ __forceinline__ void rms_row_to_bf16(const float* xrow, const float* gain, bf16* orow, int lane, unsigned char* orow8 = nullptr) {
    const GAS f32x4* xr = (const GAS f32x4*)xrow + lane; const GAS f32x4* gr = (const GAS f32x4*)gain + lane;
    f32x4 v[8]; float s = 0.f;
#pragma unroll
    for (int j = 0; j < 8; ++j) { v[j] = xr[64 * j]; s += (v[j].x * v[j].x + v[j].y * v[j].y) + (v[j].z * v[j].z + v[j].w * v[j].w); }
    const float rs = 1.0f * FAST_RSQ(wave_sum(s) * (1.f / 2048.f) + EPS);
    GAS u32x2* o8 = (GAS u32x2*)orow + lane; GAS unsigned* o4 = (GAS unsigned*)orow8 + lane;
#pragma unroll
    for (int j = 0; j < 8; ++j) { const f32x4 g = gr[64 * j]; const float a0 = v[j].x * rs * g.x, a1 = v[j].y * rs * g.y, a2 = v[j].z * rs * g.z, a3 = v[j].w * rs * g.w;
        if (!(UV_F8 == 1 && GATE_F8)) { u32x2 w; w.x = cvtpk(a0, a1); w.y = cvtpk(a2, a3); o8[64 * j] = w; }
        if (orow8) o4[64 * j] = pk4_fp8(a0, a1, a2, a3); }
}
#define ATT_WAITV(n) asm volatile("s_waitcnt vmcnt(" #n ")" ::: "memory")
template <int DQK, int NSLOT, bool CAUSAL>
__device__ __forceinline__ void attn_unit(LAS unsigned char* lds, const bf16* Qw  , int qpitch, const bf16* Ktiles, const bf16* Vtiles,
                                          int ntiles, int qpos0  , unsigned char* Ow  , int opitch, int wid, int lane) {
    constexpr int KS = DQK / 16, KTB = 64 * DQK * 2, VTB = 64 * 128 * 2, KP = KTB / 1024 / 8  , VP = 2, NP = KP + VP, PF = NSLOT - 1;
    static_assert(KTB % 8192 == 0, "K tile pieces must split evenly over 8 waves");
    const int r32 = lane & 31, hi = lane >> 5;
    bf16x8 qf[KS];
    { const GAS bf16x8* qp = (const GAS bf16x8*)((const GAS bf16*)Qw + (size_t)r32 * qpitch + hi * 8);
#pragma unroll
      for (int ks = 0; ks < KS; ++ks) qf[ks] = qp[2 * ks]; }
    asm volatile("s_waitcnt vmcnt(0)" ::: "memory");
#pragma unroll
    for (int ks = 0; ks < KS; ++ks) asm volatile("" : "+v"(qf[ks]));
    const GAS unsigned char* kg = (const GAS unsigned char*)Ktiles + (size_t)wid * 1024;
    const GAS unsigned char* vg = (const GAS unsigned char*)Vtiles + (size_t)wid * 1024;
    const unsigned loff = (unsigned)lane * 16u;
    LAS unsigned char* kl = lds + wid * 1024; LAS unsigned char* vl = lds + NSLOT * KTB + wid * 1024;
#define ATT_ISSUE(t) do { const int sl_ = (t) % NSLOT; unsigned lo_ = loff; asm volatile("" : "+v"(lo_));   \
        _Pragma("unroll") for (int p_ = 0; p_ < KP; ++p_) __builtin_amdgcn_global_load_lds((const GAS unsigned*)(kg + ((size_t)(t) * KTB + p_ * 8192) + lo_), (LAS unsigned*)(kl + sl_ * KTB + p_ * 8192), 16, 0, 0); \
        _Pragma("unroll") for (int p_ = 0; p_ < VP; ++p_) __builtin_amdgcn_global_load_lds((const GAS unsigned*)(vg + ((size_t)(t) * VTB + p_ * 8192) + lo_), (LAS unsigned*)(vl + sl_ * VTB + p_ * 8192), 16, 0, 0); } while (0)
#pragma unroll
    for (int t = 0; t < PF; ++t) if (t < ntiles) ATT_ISSUE(t);
    f32x16 o[4];
#pragma unroll
    for (int d = 0; d < 4; ++d)
#pragma unroll
        for (int r = 0; r < 16; ++r) o[d][r] = 0.f;
    float mrun = -1e30f, lrun = 0.f;
    const int kbase = hi * 1024 + r32 * 16;
    const int g4 = lane >> 4, q4 = (lane >> 2) & 3, p4 = lane & 3;
    const int vbase = (4 * (g4 >> 1) + q4) * 64 + (16 * (g4 & 1) + 4 * p4) * 2;
    for (int j = 0; j < ntiles; ++j) {
        const int rem = ntiles - 1 - j;
        if (PF >= 2 && rem >= 1) { if (NP == 5) ATT_WAITV(5); else ATT_WAITV(6); } else ATT_WAITV(0);
        __builtin_amdgcn_s_barrier();
        asm volatile("" ::: "memory");
        if (j + PF < ntiles) ATT_ISSUE(j + PF);
        if (CAUSAL && 64 * j > qpos0 + 31) continue;
        const int sl = j % NSLOT;
        const LAS unsigned char* ks_ = lds + sl * KTB + kbase;
        const LAS unsigned char* vs_ = lds + NSLOT * KTB + sl * VTB + vbase;
        f32x16 p0, p1;
#pragma unroll
        for (int r = 0; r < 16; ++r) { p0[r] = 0.f; p1[r] = 0.f; }
        {   constexpr int NF = 2 * KS, KW = 8;
            bf16x8 kf[KW];
#pragma unroll
            for (int i = 0; i < KW; ++i) kf[i] = *(const LAS bf16x8*)(ks_ + (i >> 1) * 2048 + (i & 1) * 512);
            __builtin_amdgcn_sched_barrier(0);
#pragma unroll
            for (int i = 0; i < NF; ++i) {
                if (i & 1) p1 = __builtin_amdgcn_mfma_f32_32x32x16_bf16(kf[i % KW], qf[i >> 1], p1, 0, 0, 0);
                else       p0 = __builtin_amdgcn_mfma_f32_32x32x16_bf16(kf[i % KW], qf[i >> 1], p0, 0, 0, 0);
                if (i + KW < NF) kf[i % KW] = *(const LAS bf16x8*)(ks_ + ((i + KW) >> 1) * 2048 + ((i + KW) & 1) * 512);
                __builtin_amdgcn_sched_barrier(0);
            }
        }
        if (CAUSAL && 64 * j + 63 > qpos0) {
            const int dq = qpos0 + r32 - 64 * j - 4 * hi;
#pragma unroll
            for (int r = 0; r < 16; ++r) { const int c = (r & 3) + 8 * (r >> 2); if (c > dq) p0[r] = -INFINITY; if (c + 32 > dq) p1[r] = -INFINITY; }
        }
        float mx = p0[0];
#pragma unroll
        for (int r = 1; r < 16; ++r) mx = fmaxf(mx, p0[r]);
#pragma unroll
        for (int r = 0; r < 16; ++r) mx = fmaxf(mx, p1[r]);
        mx = XL_FAST ? xl_swap32_max(mx) : fmaxf(mx, __shfl_xor(mx, 32));
        const float mnew = fmaxf(mrun, mx);
        if (__any(mnew > mrun)) {
            const float alpha = __builtin_amdgcn_exp2f(mrun - mnew);
            lrun *= alpha;
#pragma unroll
            for (int d = 0; d < 4; ++d)
#pragma unroll
                for (int r = 0; r < 16; ++r) o[d][r] *= alpha;
            mrun = mnew;
        }
        float ps = 0.f;
#pragma unroll
        for (int r = 0; r < 16; ++r) { p0[r] = __builtin_amdgcn_exp2f(p0[r] - mrun); p1[r] = __builtin_amdgcn_exp2f(p1[r] - mrun); ps += p0[r] + p1[r]; }
        lrun += ps;
        bf16x8 pf[4];
        { v4u w;
          w.x = cvtpk(p0[0], p0[1]); w.y = cvtpk(p0[2], p0[3]); w.z = cvtpk(p0[4], p0[5]); w.w = cvtpk(p0[6], p0[7]); pf[0] = __builtin_bit_cast(bf16x8, w);
          w.x = cvtpk(p0[8], p0[9]); w.y = cvtpk(p0[10], p0[11]); w.z = cvtpk(p0[12], p0[13]); w.w = cvtpk(p0[14], p0[15]); pf[1] = __builtin_bit_cast(bf16x8, w);
          w.x = cvtpk(p1[0], p1[1]); w.y = cvtpk(p1[2], p1[3]); w.z = cvtpk(p1[4], p1[5]); w.w = cvtpk(p1[6], p1[7]); pf[2] = __builtin_bit_cast(bf16x8, w);
          w.x = cvtpk(p1[8], p1[9]); w.y = cvtpk(p1[10], p1[11]); w.z = cvtpk(p1[12], p1[13]); w.w = cvtpk(p1[14], p1[15]); pf[3] = __builtin_bit_cast(bf16x8, w); }
#define ATT_VLOAD(dst, s_) do { _Pragma("unroll") for (int db_ = 0; db_ < 4; ++db_) { \
            const s16x4 lo_ = __builtin_bit_cast(s16x4, __builtin_amdgcn_ds_read_tr16_b64_v4i16((LAS v4i16_t*)(vs_ + db_ * 4096 + (s_) * 1024))); \
            const s16x4 hh_ = __builtin_bit_cast(s16x4, __builtin_amdgcn_ds_read_tr16_b64_v4i16((LAS v4i16_t*)(vs_ + db_ * 4096 + (s_) * 1024 + 512))); \
            dst[db_] = (bf16x8){lo_[0], lo_[1], lo_[2], lo_[3], hh_[0], hh_[1], hh_[2], hh_[3]}; } } while (0)
        {   bf16x8 va[4], vb[4];
            ATT_VLOAD(va, 0);
            __builtin_amdgcn_sched_barrier(0);
            ATT_VLOAD(vb, 1);
#pragma unroll
            for (int db = 0; db < 4; ++db) o[db] = __builtin_amdgcn_mfma_f32_32x32x16_bf16(va[db], pf[0], o[db], 0, 0, 0);
            __builtin_amdgcn_sched_barrier(0);
            ATT_VLOAD(va, 2);
#pragma unroll
            for (int db = 0; db < 4; ++db) o[db] = __builtin_amdgcn_mfma_f32_32x32x16_bf16(vb[db], pf[1], o[db], 0, 0, 0);
            __builtin_amdgcn_sched_barrier(0);
            ATT_VLOAD(vb, 3);
#pragma unroll
            for (int db = 0; db < 4; ++db) o[db] = __builtin_amdgcn_mfma_f32_32x32x16_bf16(va[db], pf[2], o[db], 0, 0, 0);
            __builtin_amdgcn_sched_barrier(0);
#pragma unroll
            for (int db = 0; db < 4; ++db) o[db] = __builtin_amdgcn_mfma_f32_32x32x16_bf16(vb[db], pf[3], o[db], 0, 0, 0);
            __builtin_amdgcn_sched_barrier(0);
        }
#undef ATT_VLOAD
    }
    const float lt = XL_FAST ? xl_swap32_sum(lrun) : lrun + __shfl_xor(lrun, 32);
    const float il = ATT_OS / lt;
    GAS unsigned char* op = (GAS unsigned char*)Ow + (size_t)r32 * opitch + 4 * hi;
#pragma unroll
    for (int db = 0; db < 4; ++db)
#pragma unroll
        for (int rg = 0; rg < 4; ++rg) *(GAS unsigned*)(op + 32 * db + 8 * rg) = pk4_fp8(o[db][4 * rg] * il, o[db][4 * rg + 1] * il, o[db][4 * rg + 2] * il, o[db][4 * rg + 3] * il);
    asm volatile("s_waitcnt vmcnt(0) lgkmcnt(0)" ::: "memory");
    __builtin_amdgcn_s_barrier();
    asm volatile("" ::: "memory");
#undef ATT_ISSUE
}

typedef int i32x8a __attribute__((ext_vector_type(8)));
typedef int i32x4a __attribute__((ext_vector_type(4)));
__device__ __forceinline__ void att_bar4(LAS unsigned* ctr, unsigned& nbar, int lane) {
#if SPLIT_FREE
    nbar += 4;
    if (lane == 0) __hip_atomic_fetch_add(ctr, 1u, __ATOMIC_RELAXED, __HIP_MEMORY_SCOPE_WORKGROUP);
    for (;;) { const unsigned v = __builtin_amdgcn_readfirstlane(__hip_atomic_load(ctr, __ATOMIC_RELAXED, __HIP_MEMORY_SCOPE_WORKGROUP)); if (v >= nbar) break; if (ATT_POLL_SLEEP) __builtin_amdgcn_s_sleep(1); }
    asm volatile("" ::: "memory");
#else
    __builtin_amdgcn_s_barrier();
    asm volatile("" ::: "memory");
#endif
}
template <bool CAUSAL, int NWA = 8>
__device__ __forceinline__ void attn8_unit(LAS unsigned char* lds, const unsigned char* Qw  , const unsigned char* Ktiles, const unsigned char* Vtiles,
                                           int ntiles, int qpos0, unsigned char* Ow  , int opitch, int wid, int lane, LAS unsigned* bctr = nullptr, unsigned* nbar = nullptr) {
    constexpr int KTB = 12288, VTB = 8192, NSLOT = 3;
    const int r32 = lane & 31, hi = lane >> 5;
    i32x8a qf[3];
    { const GAS i32x4a* qp = (const GAS i32x4a*)((const GAS unsigned char*)Qw + (size_t)r32 * 192 + hi * 32);
#pragma unroll
      for (int s = 0; s < 3; ++s) { const i32x4a a = qp[4 * s], b = qp[4 * s + 1]; qf[s] = __builtin_shufflevector(a, b, 0, 1, 2, 3, 4, 5, 6, 7); } }
    asm volatile("s_waitcnt vmcnt(0)" ::: "memory");
#pragma unroll
    for (int s = 0; s < 3; ++s) asm volatile("" : "+v"(qf[s]));
    const GAS unsigned char* kg = (const GAS unsigned char*)Ktiles + (size_t)wid * 1024;
    const GAS unsigned char* vg = (const GAS unsigned char*)Vtiles + (size_t)wid * 1024;
    const unsigned loff = (unsigned)lane * 16u;
    LAS unsigned char* kl = lds + wid * 1024; LAS unsigned char* vl = lds + NSLOT * KTB + wid * 1024;
    const bool two = wid < 4;
#define A8_ISSUE(t) do { const int sl_ = (t) % NSLOT; unsigned lo_ = loff; asm volatile("" : "+v"(lo_)); \
        if (NWA == 8) { \
            __builtin_amdgcn_global_load_lds((const GAS unsigned*)(kg + (size_t)(t) * KTB + lo_), (LAS unsigned*)(kl + sl_ * KTB), 16, 0, 0); \
            if (two) __builtin_amdgcn_global_load_lds((const GAS unsigned*)(kg + ((size_t)(t) * KTB + 8192) + lo_), (LAS unsigned*)(kl + sl_ * KTB + 8192), 16, 0, 0); \
            __builtin_amdgcn_global_load_lds((const GAS unsigned*)(vg + (size_t)(t) * VTB + lo_), (LAS unsigned*)(vl + sl_ * VTB), 16, 0, 0); \
        } else {     \
            _Pragma("unroll") for (int p_ = 0; p_ < 3; ++p_) __builtin_amdgcn_global_load_lds((const GAS unsigned*)(kg + ((size_t)(t) * KTB + p_ * 4096) + lo_), (LAS unsigned*)(kl + sl_ * KTB + p_ * 4096), 16, 0, 0); \
            _Pragma("unroll") for (int p_ = 0; p_ < 2; ++p_) __builtin_amdgcn_global_load_lds((const GAS unsigned*)(vg + ((size_t)(t) * VTB + p_ * 4096) + lo_), (LAS unsigned*)(vl + sl_ * VTB + p_ * 4096), 16, 0, 0); \
        } } while (0)
    A8_ISSUE(0);
    if (ntiles > 1) A8_ISSUE(1);
    f32x16 o[4];
#pragma unroll
    for (int d = 0; d < 4; ++d)
#pragma unroll
        for (int r = 0; r < 16; ++r) o[d][r] = 0.f;
    float mrun = -1e30f, lrun = 0.f;
    const int kbase = (2 * hi) * 1024 + r32 * 16, vbase = (2 * hi) * 2048 + r32 * 16;
    const int SQ = 0x7b7b7b7b, SP = 0x79797979, S1 = 0x7f7f7f7f;
    for (int j = 0; j < ntiles; ++j) {
        if (ntiles - 1 - j >= 1) { if (NWA == 4) ATT_WAITV(5); else if (two) ATT_WAITV(3); else ATT_WAITV(2); } else ATT_WAITV(0);
        if (NWA == 4 && bctr) att_bar4(bctr, *nbar, lane); else { __builtin_amdgcn_s_barrier(); asm volatile("" ::: "memory"); }
        if (j + 2 < ntiles) A8_ISSUE(j + 2);
        if (CAUSAL && 64 * j > qpos0 + 31) continue;
        const int sl = j % NSLOT;
        const LAS unsigned char* ks_ = lds + sl * KTB + kbase;
        const LAS unsigned char* vs_ = lds + NSLOT * KTB + sl * VTB + vbase;
        i32x8a kf[3][2];
#pragma unroll
        for (int s = 0; s < 3; ++s)
#pragma unroll
            for (int kb = 0; kb < 2; ++kb) { const i32x4a a = *(const LAS i32x4a*)(ks_ + s * 4096 + kb * 512), b = *(const LAS i32x4a*)(ks_ + s * 4096 + kb * 512 + 1024);
                kf[s][kb] = __builtin_shufflevector(a, b, 0, 1, 2, 3, 4, 5, 6, 7); }
        f32x16 p0, p1;
#pragma unroll
        for (int r = 0; r < 16; ++r) { p0[r] = 0.f; p1[r] = 0.f; }
#pragma unroll
        for (int s = 0; s < 3; ++s) {
            p0 = __builtin_amdgcn_mfma_scale_f32_32x32x64_f8f6f4(kf[s][0], qf[s], p0, 0, 0, 0, S1, 0, SQ);
            p1 = __builtin_amdgcn_mfma_scale_f32_32x32x64_f8f6f4(kf[s][1], qf[s], p1, 0, 0, 0, S1, 0, SQ);
        }
        i32x8a vf[4];
#pragma unroll
        for (int db = 0; db < 4; ++db) { const i32x4a a = *(const LAS i32x4a*)(vs_ + db * 512), b = *(const LAS i32x4a*)(vs_ + db * 512 + 2048); vf[db] = __builtin_shufflevector(a, b, 0, 1, 2, 3, 4, 5, 6, 7); }
        __builtin_amdgcn_sched_barrier(0);
        if (CAUSAL && 64 * j + 63 > qpos0) {
            const int dq = qpos0 + r32 - 64 * j - 4 * hi;
#pragma unroll
            for (int r = 0; r < 16; ++r) { const int c = (r & 3) + 8 * (r >> 2); if (c > dq) p0[r] = -INFINITY; if (c + 32 > dq) p1[r] = -INFINITY; }
        }
        float mx = p0[0];
#pragma unroll
        for (int r = 1; r < 16; ++r) mx = fmaxf(mx, p0[r]);
#pragma unroll
        for (int r = 0; r < 16; ++r) mx = fmaxf(mx, p1[r]);
        mx = XL_FAST ? xl_swap32_max(mx) : fmaxf(mx, __shfl_xor(mx, 32));
        const float mnew = fmaxf(mrun, mx);
        if (__any(mx > mrun + 2.0f)) {
            const float alpha = __builtin_amdgcn_exp2f(mrun - mnew);
            lrun *= alpha;
#pragma unroll
            for (int d = 0; d < 4; ++d)
#pragma unroll
                for (int r = 0; r < 16; ++r) o[d][r] *= alpha;
            mrun = mnew;
        }
        float ps = 0.f; const float msh = mrun - 6.0f;
#pragma unroll
        for (int r = 0; r < 16; ++r) { p0[r] = __builtin_amdgcn_exp2f(p0[r] - msh); p1[r] = __builtin_amdgcn_exp2f(p1[r] - msh); ps += p0[r] + p1[r]; }
        lrun += ps;
        i32x8a pf;
        pf[0] = (int)pk4_fp8(p0[0], p0[1], p0[2], p0[3]); pf[1] = (int)pk4_fp8(p0[4], p0[5], p0[6], p0[7]); pf[2] = (int)pk4_fp8(p0[8], p0[9], p0[10], p0[11]); pf[3] = (int)pk4_fp8(p0[12], p0[13], p0[14], p0[15]);
        pf[4] = (int)pk4_fp8(p1[0], p1[1], p1[2], p1[3]); pf[5] = (int)pk4_fp8(p1[4], p1[5], p1[6], p1[7]); pf[6] = (int)pk4_fp8(p1[8], p1[9], p1[10], p1[11]); pf[7] = (int)pk4_fp8(p1[12], p1[13], p1[14], p1[15]);
#pragma unroll
        for (int db = 0; db < 4; ++db) o[db] = __builtin_amdgcn_mfma_scale_f32_32x32x64_f8f6f4(vf[db], pf, o[db], 0, 0, 0, S1, 0, SP);
    }
    const float lt = XL_FAST ? xl_swap32_sum(lrun) : lrun + __shfl_xor(lrun, 32);
    const float il = 64.0f * ATT_OS / lt;
    GAS unsigned char* op = (GAS unsigned char*)Ow + (size_t)r32 * opitch + 4 * hi;
#pragma unroll
    for (int db = 0; db < 4; ++db)
#pragma unroll
        for (int rg = 0; rg < 4; ++rg) *(GAS unsigned*)(op + 32 * db + 8 * rg) = pk4_fp8(o[db][4 * rg] * il, o[db][4 * rg + 1] * il, o[db][4 * rg + 2] * il, o[db][4 * rg + 3] * il);
    asm volatile("s_waitcnt vmcnt(0) lgkmcnt(0)" ::: "memory");
    if (NWA == 4 && bctr) att_bar4(bctr, *nbar, lane); else { __builtin_amdgcn_s_barrier(); asm volatile("" ::: "memory"); }
#undef A8_ISSUE
}

__device__ __forceinline__ float xhalf_max(float x) { const auto r = __builtin_amdgcn_permlane32_swap(__float_as_uint(x), __float_as_uint(x), false, false); return fmaxf(__uint_as_float(r[0]), __uint_as_float(r[1])); }
__device__ __forceinline__ float xhalf_sum(float x) { const auto r = __builtin_amdgcn_permlane32_swap(__float_as_uint(x), __float_as_uint(x), false, false); return __uint_as_float(r[0]) + __uint_as_float(r[1]); }
template <bool CAUSAL>
__device__ __forceinline__ void attn8_unit2(LAS unsigned char* lds, const unsigned char* Qw  , const unsigned char* Ktiles, const unsigned char* Vtiles,
                                            int ntiles, int qpos0  , unsigned char* Ow, int opitch, int wid, int lane, LAS unsigned* bctr, unsigned& nbar) {
    constexpr int KTB = 12288, VTB = 8192, NSLOT = ATT_PAIR ? 2 : 3, KSB = ATT_PAIR ? 2 * KTB : KTB, VSB = ATT_PAIR ? 2 * VTB : VTB;
    const int r32 = lane & 31, hi = lane >> 5;
    i32x8a qf[2][3];
#pragma unroll
    for (int bk = 0; bk < 2; ++bk) { const GAS i32x4a* qp = (const GAS i32x4a*)((const GAS unsigned char*)Qw + (size_t)(128 * bk + r32) * 192 + hi * 32);
#pragma unroll
      for (int s = 0; s < 3; ++s) { const i32x4a a = qp[4 * s], b = qp[4 * s + 1]; qf[bk][s] = __builtin_shufflevector(a, b, 0, 1, 2, 3, 4, 5, 6, 7); } }
    asm volatile("s_waitcnt vmcnt(0)" ::: "memory");
#pragma unroll
    for (int bk = 0; bk < 2; ++bk)
#pragma unroll
        for (int s = 0; s < 3; ++s) asm volatile("" : "+v"(qf[bk][s]));
    const GAS unsigned char* kg = (const GAS unsigned char*)Ktiles + (size_t)wid * 1024;
    const GAS unsigned char* vg = (const GAS unsigned char*)Vtiles + (size_t)wid * 1024;
    const unsigned loff = (unsigned)lane * 16u;
    LAS unsigned char* kl = lds + wid * 1024; LAS unsigned char* vl = lds + NSLOT * KSB + wid * 1024;
#define A2_ISSUE(t) do { const int sl_ = (t) % NSLOT; unsigned lo_ = loff; asm volatile("" : "+v"(lo_)); \
        _Pragma("unroll") for (int p_ = 0; p_ < KSB / 4096; ++p_) __builtin_amdgcn_global_load_lds((const GAS unsigned*)(kg + ((size_t)(t) * KSB + p_ * 4096) + lo_), (LAS unsigned*)(kl + sl_ * KSB + p_ * 4096), 16, 0, 0); \
        _Pragma("unroll") for (int p_ = 0; p_ < VSB / 4096; ++p_) __builtin_amdgcn_global_load_lds((const GAS unsigned*)(vg + ((size_t)(t) * VSB + p_ * 4096) + lo_), (LAS unsigned*)(vl + sl_ * VSB + p_ * 4096), 16, 0, 0); } while (0)
#define A2_PIECE(tp_, ix_) do { const int sl_ = (tp_) % NSLOT; unsigned lo_ = loff; asm volatile("" : "+v"(lo_)); \
        if ((ix_) < 6) __builtin_amdgcn_global_load_lds((const GAS unsigned*)(kg + ((size_t)(tp_) * KSB + (ix_) * 4096) + lo_), (LAS unsigned*)(kl + sl_ * KSB + (ix_) * 4096), 16, 0, 0); \
        else __builtin_amdgcn_global_load_lds((const GAS unsigned*)(vg + ((size_t)(tp_) * VSB + ((ix_) - 6) * 4096) + lo_), (LAS unsigned*)(vl + sl_ * VSB + ((ix_) - 6) * 4096), 16, 0, 0); } while (0)
#define A2_SPREAD(ix_) do { if (ATT_SPREAD && ATT_PAIR && bk == 1 && pend) { __builtin_amdgcn_sched_barrier(0); A2_PIECE((j >> 1) + 1, ix_); __builtin_amdgcn_sched_barrier(0); } } while (0)
    A2_ISSUE(0);
    if (!ATT_PAIR && ntiles > 1) A2_ISSUE(1);
    f32x16 o[2][4];
#pragma unroll
    for (int bk = 0; bk < 2; ++bk)
#pragma unroll
        for (int d = 0; d < 4; ++d)
#pragma unroll
            for (int r = 0; r < 16; ++r) o[bk][d][r] = 0.f;
    float mrun[2] = {-1e30f, -1e30f}, lrun[2] = {0.f, 0.f};
    const int kbase = (2 * hi) * 1024 + r32 * 16, vbase = (2 * hi) * 2048 + r32 * 16;
    const int SQ = 0x7b7b7b7b, SP = 0x79797979, S1 = 0x7f7f7f7f;
    for (int j = 0; j < ntiles; ++j) {
#if ATT_PAIR
        if ((j & 1) == 0) {
            ATT_WAITV(0);
            att_bar4(bctr, nbar, lane);
            if (!ATT_SPREAD && j + 2 < ntiles) A2_ISSUE((j >> 1) + 1);
        }
        const bool pend = ATT_SPREAD && (j & 1) == 0 && (j + 2 < ntiles); (void)pend;
        const int sl = (j >> 1) % NSLOT;
        unsigned ka_ = (unsigned)(sl * KSB + (j & 1) * KTB + kbase), va_ = (unsigned)(NSLOT * KSB + sl * VSB + (j & 1) * VTB + vbase);
#else
        if (ntiles - 1 - j >= 1) ATT_WAITV(5); else ATT_WAITV(0);
        att_bar4(bctr, nbar, lane);
        if (j + 2 < ntiles) A2_ISSUE(j + 2);
        const int sl = j % NSLOT;
        unsigned ka_ = (unsigned)(sl * KTB + kbase), va_ = (unsigned)(NSLOT * KTB + sl * VTB + vbase);
        const bool pend = false; (void)pend;
#endif
        asm volatile("" : "+v"(ka_), "+v"(va_));
        const LAS unsigned char* ks_ = lds + ka_;
        const LAS unsigned char* vs_ = lds + va_;
        i32x8a pf_prev; bool have_prev = false; (void)pf_prev;
#pragma unroll
        for (int bk = 0; bk < 2; ++bk) {
            const int qp0 = qpos0 + 128 * bk;
            if (CAUSAL && 64 * j > qp0 + 31) continue;
#if ATT_SPLITQK
            f32x16 p0, p1;
#pragma unroll
            for (int r = 0; r < 16; ++r) { p0[r] = 0.f; p1[r] = 0.f; }
#pragma unroll
            for (int s = 0; s < 3; ++s) {
                const i32x4a a0 = *(const LAS i32x4a*)(ks_ + s * 4096), b0 = *(const LAS i32x4a*)(ks_ + s * 4096 + 1024);
                const i32x8a k0 = __builtin_shufflevector(a0, b0, 0, 1, 2, 3, 4, 5, 6, 7);
                p0 = __builtin_amdgcn_mfma_scale_f32_32x32x64_f8f6f4(k0, qf[bk][s], p0, 0, 0, 0, S1, 0, SQ);
            }
            __builtin_amdgcn_sched_barrier(0);
#pragma unroll
            for (int s = 0; s < 3; ++s) {
                const i32x4a a1 = *(const LAS i32x4a*)(ks_ + s * 4096 + 512), b1 = *(const LAS i32x4a*)(ks_ + s * 4096 + 512 + 1024);
                const i32x8a k1 = __builtin_shufflevector(a1, b1, 0, 1, 2, 3, 4, 5, 6, 7);
                p1 = __builtin_amdgcn_mfma_scale_f32_32x32x64_f8f6f4(k1, qf[bk][s], p1, 0, 0, 0, S1, 0, SQ);
            }
            __builtin_amdgcn_sched_barrier(0);
            const bool diag = CAUSAL && 64 * j + 63 > qp0;
            const int dq = qp0 + r32 - 64 * j - 4 * hi;
            if (diag) {
#pragma unroll
                for (int r = 0; r < 16; ++r) { const int c = (r & 3) + 8 * (r >> 2); if (c > dq) p0[r] = -INFINITY; }
            }
            float mx = p0[0];
#pragma unroll
            for (int r = 1; r < 16; ++r) mx = fmaxf(mx, p0[r]);
            mx = ATT_PERMLANE ? xhalf_max(mx) : fmaxf(mx, __shfl_xor(mx, 32));
            if (__any(mx > mrun[bk] + 2.0f)) {
                const float mnew = fmaxf(mrun[bk], mx), alpha = __builtin_amdgcn_exp2f(mrun[bk] - mnew);
                lrun[bk] *= alpha;
#pragma unroll
                for (int d = 0; d < 4; ++d)
#pragma unroll
                    for (int r = 0; r < 16; ++r) o[bk][d][r] *= alpha;
                mrun[bk] = mnew;
            }
            float msh = mrun[bk] - 6.0f, ps = 0.f;
#pragma unroll
            for (int r = 0; r < 16; ++r) { p0[r] = __builtin_amdgcn_exp2f(p0[r] - msh); ps += p0[r]; }
            __builtin_amdgcn_sched_barrier(0);
            if (diag) {
#pragma unroll
                for (int r = 0; r < 16; ++r) { const int c = (r & 3) + 8 * (r >> 2); if (c + 32 > dq) p1[r] = -INFINITY; }
            }
            mx = p1[0];
#pragma unroll
            for (int r = 1; r < 16; ++r) mx = fmaxf(mx, p1[r]);
            mx = ATT_PERMLANE ? xhalf_max(mx) : fmaxf(mx, __shfl_xor(mx, 32));
            if (__any(mx > mrun[bk] + 2.0f)) {
                const float mnew = fmaxf(mrun[bk], mx), alpha = __builtin_amdgcn_exp2f(mrun[bk] - mnew);
                lrun[bk] *= alpha; ps *= alpha;
#pragma unroll
                for (int r = 0; r < 16; ++r) p0[r] *= alpha;
#pragma unroll
                for (int d = 0; d < 4; ++d)
#pragma unroll
                    for (int r = 0; r < 16; ++r) o[bk][d][r] *= alpha;
                mrun[bk] = mnew; msh = mnew - 6.0f;
            }
#pragma unroll
            for (int r = 0; r < 16; ++r) { p1[r] = __builtin_amdgcn_exp2f(p1[r] - msh); ps += p1[r]; }
            lrun[bk] += ps;
            i32x8a pf;
            pf[0] = (int)pk4_fp8(p0[0], p0[1], p0[2], p0[3]); pf[1] = (int)pk4_fp8(p0[4], p0[5], p0[6], p0[7]); pf[2] = (int)pk4_fp8(p0[8], p0[9], p0[10], p0[11]); pf[3] = (int)pk4_fp8(p0[12], p0[13], p0[14], p0[15]);
            pf[4] = (int)pk4_fp8(p1[0], p1[1], p1[2], p1[3]); pf[5] = (int)pk4_fp8(p1[4], p1[5], p1[6], p1[7]); pf[6] = (int)pk4_fp8(p1[8], p1[9], p1[10], p1[11]); pf[7] = (int)pk4_fp8(p1[12], p1[13], p1[14], p1[15]);
            asm volatile("" : "+v"(pf));
#pragma unroll
            for (int db = 0; db < 4; ++db) { const i32x4a a = *(const LAS i32x4a*)(vs_ + db * 512), b = *(const LAS i32x4a*)(vs_ + db * 512 + 2048);
                const i32x8a vfd = __builtin_shufflevector(a, b, 0, 1, 2, 3, 4, 5, 6, 7);
                asm volatile("v_mfma_scale_f32_32x32x64_f8f6f4 %0, %1, %2, %0, %3, %4 op_sel_hi:[0,0,0]" : "+v"(o[bk][db]) : "v"(vfd), "v"(pf), "v"(S1), "v"(SP));
                A2_SPREAD(6 + db); }
            if (ATT_SPREAD && ATT_PAIR && bk == 1 && pend) { A2_PIECE((j >> 1) + 1, 0); A2_PIECE((j >> 1) + 1, 1); A2_PIECE((j >> 1) + 1, 2); A2_PIECE((j >> 1) + 1, 3); A2_PIECE((j >> 1) + 1, 4); A2_PIECE((j >> 1) + 1, 5); }
#else
            f32x16 p0, p1;
#pragma unroll
            for (int r = 0; r < 16; ++r) { p0[r] = 0.f; p1[r] = 0.f; }
#pragma unroll
            for (int s = 0; s < 3; ++s) {
                const i32x4a a0 = *(const LAS i32x4a*)(ks_ + s * 4096), b0 = *(const LAS i32x4a*)(ks_ + s * 4096 + 1024);
                const i32x4a a1 = *(const LAS i32x4a*)(ks_ + s * 4096 + 512), b1 = *(const LAS i32x4a*)(ks_ + s * 4096 + 512 + 1024);
                const i32x8a k0 = __builtin_shufflevector(a0, b0, 0, 1, 2, 3, 4, 5, 6, 7), k1 = __builtin_shufflevector(a1, b1, 0, 1, 2, 3, 4, 5, 6, 7);
                p0 = __builtin_amdgcn_mfma_scale_f32_32x32x64_f8f6f4(k0, qf[bk][s], p0, 0, 0, 0, S1, 0, SQ);
                p1 = __builtin_amdgcn_mfma_scale_f32_32x32x64_f8f6f4(k1, qf[bk][s], p1, 0, 0, 0, S1, 0, SQ);
            }
#if ATT_DEFER
            if (bk == 1 && have_prev) {
                __builtin_amdgcn_sched_barrier(0);
#pragma unroll
                for (int db = 0; db < 4; ++db) { const i32x4a a = *(const LAS i32x4a*)(vs_ + db * 512), b = *(const LAS i32x4a*)(vs_ + db * 512 + 2048);
                    const i32x8a vfd = __builtin_shufflevector(a, b, 0, 1, 2, 3, 4, 5, 6, 7);
                    asm volatile("v_mfma_scale_f32_32x32x64_f8f6f4 %0, %1, %2, %0, %3, %4 op_sel_hi:[0,0,0]" : "+v"(o[0][db]) : "v"(vfd), "v"(pf_prev), "v"(S1), "v"(SP));
                    __builtin_amdgcn_sched_barrier(0); }
            }
#endif
            if (CAUSAL && 64 * j + 63 > qp0) {
                const int dq = qp0 + r32 - 64 * j - 4 * hi;
#pragma unroll
                for (int r = 0; r < 16; ++r) { const int c = (r & 3) + 8 * (r >> 2); if (c > dq) p0[r] = -INFINITY; if (c + 32 > dq) p1[r] = -INFINITY; }
            }
            float mx = p0[0];
#pragma unroll
            for (int r = 1; r < 16; ++r) mx = fmaxf(mx, p0[r]);
#pragma unroll
            for (int r = 0; r < 16; ++r) mx = fmaxf(mx, p1[r]);
            mx = ATT_PERMLANE ? xhalf_max(mx) : fmaxf(mx, __shfl_xor(mx, 32));
            const float mnew = fmaxf(mrun[bk], mx);
            if (__any(mx > mrun[bk] + 2.0f)) {
                const float alpha = __builtin_amdgcn_exp2f(mrun[bk] - mnew);
                lrun[bk] *= alpha;
#pragma unroll
                for (int d = 0; d < 4; ++d)
#pragma unroll
                    for (int r = 0; r < 16; ++r) o[bk][d][r] *= alpha;
                mrun[bk] = mnew;
            }
#if ATT_VPRE
            float ps = 0.f; const float msh = mrun[bk] - 6.0f;
            i32x8a pf;
#pragma unroll
            for (int r = 0; r < 16; ++r) { p0[r] = __builtin_amdgcn_exp2f(p0[r] - msh); ps += p0[r]; }
            pf[0] = (int)pk4_fp8(p0[0], p0[1], p0[2], p0[3]); pf[1] = (int)pk4_fp8(p0[4], p0[5], p0[6], p0[7]); pf[2] = (int)pk4_fp8(p0[8], p0[9], p0[10], p0[11]); pf[3] = (int)pk4_fp8(p0[12], p0[13], p0[14], p0[15]);
            asm volatile("" : "+v"(pf[0]), "+v"(pf[1]), "+v"(pf[2]), "+v"(pf[3]));
            i32x8a vf0, vf1, vf2, vf3;
            { const i32x4a a = *(const LAS i32x4a*)(vs_ + 0 * 512), b = *(const LAS i32x4a*)(vs_ + 0 * 512 + 2048); vf0 = __builtin_shufflevector(a, b, 0, 1, 2, 3, 4, 5, 6, 7); }
            { const i32x4a a = *(const LAS i32x4a*)(vs_ + 1 * 512), b = *(const LAS i32x4a*)(vs_ + 1 * 512 + 2048); vf1 = __builtin_shufflevector(a, b, 0, 1, 2, 3, 4, 5, 6, 7); }
            asm volatile("" ::: "memory");
#pragma unroll
            for (int r = 0; r < 16; ++r) { p1[r] = __builtin_amdgcn_exp2f(p1[r] - msh); ps += p1[r]; }
            lrun[bk] += ps;
            pf[4] = (int)pk4_fp8(p1[0], p1[1], p1[2], p1[3]); pf[5] = (int)pk4_fp8(p1[4], p1[5], p1[6], p1[7]); pf[6] = (int)pk4_fp8(p1[8], p1[9], p1[10], p1[11]); pf[7] = (int)pk4_fp8(p1[12], p1[13], p1[14], p1[15]);
            asm volatile("" : "+v"(pf));
            { const i32x4a a = *(const LAS i32x4a*)(vs_ + 2 * 512), b = *(const LAS i32x4a*)(vs_ + 2 * 512 + 2048); vf2 = __builtin_shufflevector(a, b, 0, 1, 2, 3, 4, 5, 6, 7); }
            { const i32x4a a = *(const LAS i32x4a*)(vs_ + 3 * 512), b = *(const LAS i32x4a*)(vs_ + 3 * 512 + 2048); vf3 = __builtin_shufflevector(a, b, 0, 1, 2, 3, 4, 5, 6, 7); }
            asm volatile("v_mfma_scale_f32_32x32x64_f8f6f4 %0, %1, %2, %0, %3, %4 op_sel_hi:[0,0,0]" : "+v"(o[bk][0]) : "v"(vf0), "v"(pf), "v"(S1), "v"(SP));
            asm volatile("v_mfma_scale_f32_32x32x64_f8f6f4 %0, %1, %2, %0, %3, %4 op_sel_hi:[0,0,0]" : "+v"(o[bk][1]) : "v"(vf1), "v"(pf), "v"(S1), "v"(SP));
            asm volatile("v_mfma_scale_f32_32x32x64_f8f6f4 %0, %1, %2, %0, %3, %4 op_sel_hi:[0,0,0]" : "+v"(o[bk][2]) : "v"(vf2), "v"(pf), "v"(S1), "v"(SP));
            asm volatile("v_mfma_scale_f32_32x32x64_f8f6f4 %0, %1, %2, %0, %3, %4 op_sel_hi:[0,0,0]" : "+v"(o[bk][3]) : "v"(vf3), "v"(pf), "v"(S1), "v"(SP));
#else
            float ps = 0.f; const float msh = mrun[bk] - 6.0f;
#pragma unroll
            for (int r = 0; r < 16; ++r) { p0[r] = __builtin_amdgcn_exp2f(p0[r] - msh); p1[r] = __builtin_amdgcn_exp2f(p1[r] - msh); ps += p0[r] + p1[r]; }
            lrun[bk] += ps;
            i32x8a pf;
            pf[0] = (int)pk4_fp8(p0[0], p0[1], p0[2], p0[3]); pf[1] = (int)pk4_fp8(p0[4], p0[5], p0[6], p0[7]); pf[2] = (int)pk4_fp8(p0[8], p0[9], p0[10], p0[11]); pf[3] = (int)pk4_fp8(p0[12], p0[13], p0[14], p0[15]);
            pf[4] = (int)pk4_fp8(p1[0], p1[1], p1[2], p1[3]); pf[5] = (int)pk4_fp8(p1[4], p1[5], p1[6], p1[7]); pf[6] = (int)pk4_fp8(p1[8], p1[9], p1[10], p1[11]); pf[7] = (int)pk4_fp8(p1[12], p1[13], p1[14], p1[15]);
            asm volatile("" : "+v"(pf));
#if ATT_DEFER
            if (bk == 0) { pf_prev = pf; have_prev = true; } else
#endif
            {
#pragma unroll
            for (int db = 0; db < 4; ++db) { const i32x4a a = *(const LAS i32x4a*)(vs_ + db * 512), b = *(const LAS i32x4a*)(vs_ + db * 512 + 2048);
                const i32x8a vfd = __builtin_shufflevector(a, b, 0, 1, 2, 3, 4, 5, 6, 7);
                asm volatile("v_mfma_scale_f32_32x32x64_f8f6f4 %0, %1, %2, %0, %3, %4 op_sel_hi:[0,0,0]" : "+v"(o[bk][db]) : "v"(vfd), "v"(pf), "v"(S1), "v"(SP)); }
            }
#endif
#endif
        }
    }
    asm volatile("s_nop 15\n s_nop 15" ::: "memory");
#pragma unroll
    for (int bk = 0; bk < 2; ++bk) {
        const float lt = ATT_PERMLANE ? xhalf_sum(lrun[bk]) : lrun[bk] + __shfl_xor(lrun[bk], 32);
        const float il = 64.0f * ATT_OS / lt;
#if ATT_OWIDE
        unsigned ooff_ = (unsigned)(r32 * opitch + 16 * hi); asm volatile("" : "+v"(ooff_));
        GAS unsigned char* op = (GAS unsigned char*)Ow + (size_t)(128 * bk) * opitch + ooff_;
#pragma unroll
        for (int db = 0; db < 4; ++db) {
            unsigned w[4];
#pragma unroll
            for (int rg = 0; rg < 4; ++rg) w[rg] = pk4_fp8(o[bk][db][4 * rg] * il, o[bk][db][4 * rg + 1] * il, o[bk][db][4 * rg + 2] * il, o[bk][db][4 * rg + 3] * il);
            const auto s02 = __builtin_amdgcn_permlane32_swap(w[0], w[2], false, false);
            const auto s13 = __builtin_amdgcn_permlane32_swap(w[1], w[3], false, false);
            v4u ov; ov.x = s02[0]; ov.y = s02[1]; ov.z = s13[0]; ov.w = s13[1];
            *(GAS v4u*)(op + 32 * db) = ov;
            __builtin_amdgcn_sched_barrier(0);
        }
    }
#else
        GAS unsigned char* op = (GAS unsigned char*)Ow + (size_t)(128 * bk + r32) * opitch + 4 * hi;
#pragma unroll
        for (int db = 0; db < 4; ++db)
#pragma unroll
            for (int rg = 0; rg < 4; ++rg) *(GAS unsigned*)(op + 32 * db + 8 * rg) = pk4_fp8(o[bk][db][4 * rg] * il, o[bk][db][4 * rg + 1] * il, o[bk][db][4 * rg + 2] * il, o[bk][db][4 * rg + 3] * il);
    }
#endif
    asm volatile("s_waitcnt vmcnt(0) lgkmcnt(0)" ::: "memory");
    att_bar4(bctr, nbar, lane);
#undef A2_ISSUE
#undef A2_PIECE
#undef A2_SPREAD
}
struct Frame {
    LAS unsigned char* lds;
    volatile LAS unsigned* MISC;
    gu32* ctl;
    int tid, lane, wave, vcu, G;
    unsigned char* ws;
};
#define WSP(T_, off) ((T_*)(F.ws + (off)))

template <int PART>
__device__ __forceinline__ void p0_prologue(Frame& F, const float* const* in, const int rank = 0, const int nrank = 0) {
    LAS float* scr = (LAS float*)(F.lds + RING_OFF + F.wave * 16640);
    const int gw = (PART == 1 ? rank : F.vcu) * NWAVES + F.wave, NGW = (PART == 1 ? nrank : F.G) * NWAVES, lane = F.lane;
    constexpr int I0 = 32 * 65, I1 = 32 * 96, I2 = 32 * 16, I3 = 32 * 16, I4 = 8 * 48, I5 = 8 * 64, I6 = 16 * 32, I7 = 32 * 32, I8 = 16 * 32, I9 = 32 * 32;
    constexpr int NITEMS = I0 + I1 + I2 + I3 + I4 + I5 + I6 + I7 + I8 + I9;
    bf16* W1T = WSP(bf16, WS_W1T);
    constexpr int NIT_A = I0 + I1 + I2 + I3;
    constexpr int NIT_B = (PRO_SPLIT == 2) ? NIT_A + I4 + I5 : NITEMS;
    const int it_lo = (PART == 1) ? NIT_A : 0, it_hi = (PART == 1) ? NIT_B : NITEMS;
    for (int it = it_lo + gw; it < it_hi; it += NGW) {
        if (PART == 0 && PRO_SPLIT && it >= NIT_A && it < NIT_B) continue;
        int r = it;
        if (r < I0) { const int kb = r / 65, cb = r % 65, c = 64 * cb;
            const int r0 = c < 3072 ? c : (c < 3136 ? 4096 + (c - 3072) : 3072 + (c - 3136));
            if (GATE_F8 && (UV_F8 == 1 || r0 >= (UV_F8 == 2 ? 1024 : 2048))) transpose_item64_f8(in[4], 4160, 64 * kb, c, WSP(unsigned char, WS_WG8U), 2048, r0, scr, lane, MOE_WSCALE);
            else transpose_item64(in[4], 4160, 64 * kb, c, W1T, HPITCH, r0, scr, lane);
            continue; } r -= I0;
        if (r < I1) { const int kb = r / 96, cb = r % 96;
            if (GATE_F8) transpose_item64_f8(in[5], 6144, 64 * kb, 64 * cb, WSP(unsigned char, WS_WG8), 2048, 9 * 256 + 64 * cb, scr, lane, MOE_WSCALE);
            else transpose_item64(in[5], 6144, 64 * kb, 64 * cb, W1T, HPITCH, P1_G + 64 * cb, scr, lane);
            continue; } r -= I1;
        if (r < I2) { const int kb = r / 16, cb = r % 16;
            if (GATE_F8) transpose_item64_f8(in[20], 1024, 64 * kb, 64 * cb, WSP(unsigned char, WS_WG8), 2048, 33 * 256 + 64 * cb, scr, lane, MOE_WSCALE);
            else transpose_item64(in[20], 1024, 64 * kb, 64 * cb, W1T, HPITCH, P1N + 64 * cb, scr, lane);
            continue; } r -= I2;
        if (r < I3) { const int kb = r / 16, cb = r % 16;
            if (GATE_F8) transpose_item64_f8(in[21], 1024, 64 * kb, 64 * cb, WSP(unsigned char, WS_WG8), 2048, 33 * 256 + 1024 + 64 * cb, scr, lane, MOE_WSCALE);
            else transpose_item64(in[21], 1024, 64 * kb, 64 * cb, W1T, HPITCH, P1N + 1024 + 64 * cb, scr, lane);
            continue; } r -= I3;
        if (r < I4) { const int kb = r / 48, cb = r % 48, hh = cb / 3, part = cb % 3;
            if (part < 2) transpose_item64_f8(in[13], 3072, 64 * kb, 64 * cb, WSP(unsigned char, WS_WUQT), 512, 256 * hh + 64 * part, scr, lane, UP_WSCALE);
            else transpose_item64_f8<true>(in[13], 3072, 64 * kb, 64 * cb, WSP(unsigned char, WS_WUQT), 512, 256 * hh + 128, scr, lane, UP_WSCALE);
            continue; } r -= I4;
        if (r < I5) { const int kb = r / 64, cb = r % 64; transpose_item64_f8(in[15], 4096, 64 * kb, 64 * cb, WSP(unsigned char, WS_WUKVT), 512, 64 * cb, scr, lane, UP_WSCALE); continue; } r -= I5;
        if (r < I6) { const int kb = r / 32, cb = r % 32; transpose_item64(in[11], 2048, 64 * kb, 64 * cb, WSP(bf16, WS_WPT), ABC_LD, 64 * cb, scr, lane, 0); continue; } r -= I6;
        if (r < I7) { const int kb = r / 32, cb = r % 32; transpose_item64_f8(in[18], 2048, 64 * kb, 64 * cb, WSP(unsigned char, WS_WPT) + ABC_BB, ABC_ROWB, 64 * cb, scr, lane, MOE_WSCALE); continue; } r -= I7;
        if (r < I8) { const int kb = r / 32, cb = r % 32; transpose_item64_f8(in[24], 2048, 64 * kb, 64 * cb, WSP(unsigned char, WS_WPT) + ABC_CB, ABC_ROWB, 64 * cb, scr, lane, MOE_WSCALE); continue; } r -= I8;
        { const int kb = r / 32, cb = r % 32; transpose_item64(in[25], 2048, 64 * kb, 64 * cb, WSP(bf16, WS_WOT), 2048, 64 * cb, scr, lane); }
    }
    if (PART == 1) return;
    const int gt = gw * 64 + lane, NGT = NGW * 64;
    for (int i = gt; i < 192 * 2048 / 8; i += NGT) { const int rr = i / 256, cc = i % 256; *(GAS v4u*)(W1T + (size_t)(4160 + rr) * HPITCH + (size_t)cc * 8) = (v4u){0u, 0u, 0u, 0u}; }
    if (GATE_F8) for (int i = gt; i < 192 * 2048 / 16; i += NGT) *(GAS v4u*)(WSP(unsigned char, WS_WG8) + (size_t)(2048 + 64) * 2048 + (size_t)i * 16) = (v4u){0u, 0u, 0u, 0u};
    for (int i = gt; i < 16 * 64 * 512 / 16; i += NGT) { const int hh = i / (64 * 512 / 16), q = i % (64 * 512 / 16); *(GAS v4u*)(WSP(unsigned char, WS_WUQT) + (size_t)(256 * hh + 192) * 512 + (size_t)q * 16) = (v4u){0u, 0u, 0u, 0u}; }
    { const float* wsrc = in[9]; bf16* wsm = WSP(bf16, WS_WSM);
      for (int i = gt; i < 8 * 128 * 128; i += NGT) { const int t = (i >> 7) & 127, s = i & 127; const float v = (s <= t) ? wsrc[i] : 0.f; wsm[i] = (bf16)(cvtpk(v, 0.f) & 0xffffu); } }
    { const float* rw = in[27]; const float* g2 = in[26]; float* rwg = WSP(float, WS_RWG);
#if ROUTER_BF16X2
      { bf16* wh = (bf16*)rwg; bf16* wl = wh + 32 * 2048;
        for (int i = gt; i < 2048 * 32; i += NGT) { const int k = i >> 5, ex = i & 31; const float w = rw[i] * g2[k];
            const unsigned h = cvtpk(w, 0.f) & 0xffffu; const float r = w - __uint_as_float(h << 16);
            wh[ex * 2048 + k] = (bf16)h; wl[ex * 2048 + k] = (bf16)(cvtpk(r, 0.f) & 0xffffu); } }
      (void)rwg; }
#else
      for (int i = gt; i < 2048 * 32; i += NGT) rwg[i] = rw[i] * g2[i >> 5]; }
#endif
    bf16* H = WSP(bf16, WS_H);
    for (int m = gw; m < T + MEMROWS; m += NGW) {
        if (m < T) rms_row_to_bf16(in[0] + (size_t)m * 2048, in[3], H + (size_t)m * HPITCH, lane, WSP(unsigned char, WS_H8) + (size_t)m * 2048);
        else rms_row_to_bf16(in[1] + (size_t)(m - T) * 2048, in[19], H + (size_t)m * HPITCH, lane, WSP(unsigned char, WS_H8) + (size_t)m * 2048);
    }
}

struct MoeItem { const float* src; size_t ldw; unsigned char* dst; int r0; int k0; };
__device__ __forceinline__ MoeItem moe_item(Frame& F, const float* const* in, int it) {
    constexpr int I10 = NE * 32 * 64;
    MoeItem m;
    if (it < I10) { const int e = it / 2048, q = it % 2048, kb = q / 64, cb = q % 64;
        m.r0 = cb < 32 ? 256 * (cb >> 1) + 64 * (cb & 1) : 256 * ((cb - 32) >> 1) + 128 + 64 * (cb & 1);
        m.src = in[29] + (size_t)e * 2048 * 4096 + (size_t)(64 * kb) * 4096 + 64 * cb; m.ldw = 4096; m.dst = WSP(unsigned char, WS_WGUT) + (size_t)e * 4096 * 2048; m.k0 = 64 * kb; }
    else { const int r = it - I10, e = r / 1024, q = r % 1024, kb = q / 32, cb = q % 32;
        m.r0 = 64 * cb; m.src = in[31] + (size_t)e * 2048 * 2048 + (size_t)(64 * kb) * 2048 + 64 * cb; m.ldw = 2048; m.dst = WSP(unsigned char, WS_WDT) + (size_t)e * 2048 * 2048; m.k0 = 64 * kb; }
    return m;
}
#define MOE_LOADS(v_, m_) do { const GAS float* src_ = (const GAS float*)(m_).src + (size_t)(4 * (lane >> 4)) * (m_).ldw + (lane & 15) * 4; \
        _Pragma("unroll") for (int j_ = 0; j_ < 4; ++j_) _Pragma("unroll") for (int r_ = 0; r_ < 4; ++r_) v_[4 * j_ + r_] = __builtin_nontemporal_load((const GAS f32x4*)(src_ + (size_t)(16 * j_ + r_) * (m_).ldw)); } while (0)
#define MOE_TOLDS(v_) do { LAS unsigned* s_ = scr + (4 * (lane & 15)) * 17 + (lane >> 4); \
        _Pragma("unroll") for (int j_ = 0; j_ < 4; ++j_) { \
            s_[0 * 17 + 4 * j_] = pk4_fp8(v_[4 * j_][0] * MOE_WSCALE, v_[4 * j_ + 1][0] * MOE_WSCALE, v_[4 * j_ + 2][0] * MOE_WSCALE, v_[4 * j_ + 3][0] * MOE_WSCALE); \
            s_[1 * 17 + 4 * j_] = pk4_fp8(v_[4 * j_][1] * MOE_WSCALE, v_[4 * j_ + 1][1] * MOE_WSCALE, v_[4 * j_ + 2][1] * MOE_WSCALE, v_[4 * j_ + 3][1] * MOE_WSCALE); \
            s_[2 * 17 + 4 * j_] = pk4_fp8(v_[4 * j_][2] * MOE_WSCALE, v_[4 * j_ + 1][2] * MOE_WSCALE, v_[4 * j_ + 2][2] * MOE_WSCALE, v_[4 * j_ + 3][2] * MOE_WSCALE); \
            s_[3 * 17 + 4 * j_] = pk4_fp8(v_[4 * j_][3] * MOE_WSCALE, v_[4 * j_ + 1][3] * MOE_WSCALE, v_[4 * j_ + 2][3] * MOE_WSCALE, v_[4 * j_ + 3][3] * MOE_WSCALE); } } while (0)
#define MOE_EMIT(m_) do { LDS_WAIT(); asm volatile("" ::: "memory"); \
        _Pragma("unroll") for (int jj_ = 0; jj_ < 4; ++jj_) { const int n_ = (lane >> 2) + 16 * jj_; const LAS unsigned* s_ = scr + n_ * 17 + 4 * (lane & 3); \
            v4u o_; o_.x = s_[0]; o_.y = s_[1]; o_.z = s_[2]; o_.w = s_[3]; \
            __builtin_nontemporal_store(o_, (GAS v4u*)((m_).dst + (size_t)((m_).r0 + n_) * 2048 + (m_).k0 + 16 * (lane & 3))); } \
        LDS_WAIT(); asm volatile("" ::: "memory"); } while (0)
template <int MODE>
__device__ __forceinline__ void moe_convert_share(Frame& F, const float* const* in) {
    LAS unsigned* scr = (LAS unsigned*)(F.lds + RING_OFF + F.wave * 4608);
    constexpr int NIT = NE * 32 * 64 + NE * 32 * 32;
    const int per = (NIT + F.G - 1) / F.G, lo = F.vcu * per, hi = (lo + per < NIT) ? lo + per : NIT, lane = F.lane;
    int it = lo + F.wave;
    f32x4 va[16], vb[16];
    MoeItem ma = moe_item(F, in, it < hi ? it : lo), mb = moe_item(F, in, it + NWAVES < hi ? it + NWAVES : lo);
    if (it < hi) MOE_LOADS(va, ma);
    if (it + NWAVES < hi) MOE_LOADS(vb, mb);
    for (; it < hi; it += 2 * NWAVES) {
        if (MODE == 0) MOE_TOLDS(va); else { _Pragma("unroll") for (int i_ = 0; i_ < 16; ++i_) asm volatile("" :: "v"(va[i_])); }
        const MoeItem na = moe_item(F, in, it + 2 * NWAVES < hi ? it + 2 * NWAVES : lo);
        if (it + 2 * NWAVES < hi) MOE_LOADS(va, na);
        if (MODE == 0) MOE_EMIT(ma);
        if (it + NWAVES < hi) {
            if (MODE == 0) MOE_TOLDS(vb); else { _Pragma("unroll") for (int i_ = 0; i_ < 16; ++i_) asm volatile("" :: "v"(vb[i_])); }
            const MoeItem nb = moe_item(F, in, it + 3 * NWAVES < hi ? it + 3 * NWAVES : lo);
            if (it + 3 * NWAVES < hi) MOE_LOADS(vb, nb);
            if (MODE == 0) MOE_EMIT(mb);
            mb = nb;
        }
        ma = na;
    }
    __syncthreads();
}
#define MOE_LOADS_ASM(v_, m_) do { const GAS float* src_ = (const GAS float*)(m_).src + (size_t)(4 * (lane >> 4)) * (m_).ldw + (lane & 15) * 4; \
        _Pragma("unroll") for (int j_ = 0; j_ < 4; ++j_) _Pragma("unroll") for (int r_ = 0; r_ < 4; ++r_) { const GAS float* p_ = src_ + (size_t)(16 * j_ + r_) * (m_).ldw; \
            asm volatile("global_load_dwordx4 %0, %1, off nt" : "=v"(v_[4 * j_ + r_]) : "v"(p_) : "memory"); } } while (0)
#define MOE_WAIT_ASM(v_, n_) asm volatile("s_waitcnt vmcnt(" #n_ ")" : "+v"(v_[0]), "+v"(v_[1]), "+v"(v_[2]), "+v"(v_[3]), "+v"(v_[4]), "+v"(v_[5]), "+v"(v_[6]), "+v"(v_[7]), \
        "+v"(v_[8]), "+v"(v_[9]), "+v"(v_[10]), "+v"(v_[11]), "+v"(v_[12]), "+v"(v_[13]), "+v"(v_[14]), "+v"(v_[15]) :: "memory")
__device__ __forceinline__ MoeItem moe_super(Frame& F, const float* const* in, int s) {
    constexpr int S10 = NE * 16 * 64;
    MoeItem m;
    if (s < S10) { const int e = s / 1024, q = s % 1024, kb = q / 64, cb = q % 64;
        m.r0 = cb < 32 ? 256 * (cb >> 1) + 64 * (cb & 1) : 256 * ((cb - 32) >> 1) + 128 + 64 * (cb & 1);
        m.src = in[29] + (size_t)e * 2048 * 4096 + (size_t)(128 * kb) * 4096 + 64 * cb; m.ldw = 4096; m.dst = WSP(unsigned char, WS_WGUT) + (size_t)e * 4096 * 2048; m.k0 = 128 * kb; }
    else { const int r = s - S10, e = r / 512, q = r % 512, kb = q / 32, cb = q % 32;
        m.r0 = 64 * cb; m.src = in[31] + (size_t)e * 2048 * 2048 + (size_t)(128 * kb) * 2048 + 64 * cb; m.ldw = 2048; m.dst = WSP(unsigned char, WS_WDT) + (size_t)e * 2048 * 2048; m.k0 = 128 * kb; }
    return m;
}
#define MOE_TOLDS33(v_, h_) do { LAS unsigned* s_ = scr + (4 * (lane & 15)) * 33 + (lane >> 4) + 16 * (h_); \
        _Pragma("unroll") for (int j_ = 0; j_ < 4; ++j_) { \
            s_[0 * 33 + 4 * j_] = pk4_fp8(v_[4 * j_][0] * MOE_WSCALE, v_[4 * j_ + 1][0] * MOE_WSCALE, v_[4 * j_ + 2][0] * MOE_WSCALE, v_[4 * j_ + 3][0] * MOE_WSCALE); \
            s_[1 * 33 + 4 * j_] = pk4_fp8(v_[4 * j_][1] * MOE_WSCALE, v_[4 * j_ + 1][1] * MOE_WSCALE, v_[4 * j_ + 2][1] * MOE_WSCALE, v_[4 * j_ + 3][1] * MOE_WSCALE); \
            s_[2 * 33 + 4 * j_] = pk4_fp8(v_[4 * j_][2] * MOE_WSCALE, v_[4 * j_ + 1][2] * MOE_WSCALE, v_[4 * j_ + 2][2] * MOE_WSCALE, v_[4 * j_ + 3][2] * MOE_WSCALE); \
            s_[3 * 33 + 4 * j_] = pk4_fp8(v_[4 * j_][3] * MOE_WSCALE, v_[4 * j_ + 1][3] * MOE_WSCALE, v_[4 * j_ + 2][3] * MOE_WSCALE, v_[4 * j_ + 3][3] * MOE_WSCALE); } } while (0)
#define MOE_EMIT33(m_) do { LDS_WAIT(); asm volatile("" ::: "memory"); \
        _Pragma("unroll") for (int jj_ = 0; jj_ < 8; ++jj_) { const int n_ = (lane >> 3) + 8 * jj_; const LAS unsigned* s_ = scr + n_ * 33 + 4 * (lane & 7); \
            v4u o_; o_.x = s_[0]; o_.y = s_[1]; o_.z = s_[2]; o_.w = s_[3]; \
            __builtin_nontemporal_store(o_, (GAS v4u*)((m_).dst + (size_t)((m_).r0 + n_) * 2048 + (m_).k0 + 16 * (lane & 7))); } \
        LDS_WAIT(); asm volatile("" ::: "memory"); } while (0)
template <int NW>
__device__ __forceinline__ void moe_convert_share_w(Frame& F, const float* const* in, const int cw, LAS unsigned* scr, const int lane) {
    constexpr int NSUP = NE * 16 * 64 + NE * 16 * 32, PER = NSUP / 256;
    static_assert(PER % NW == 0, "equal shares");
    const int lo = F.vcu * PER, hi = lo + PER;
    int it = lo + cw;
    f32x4 va[16], vb[16];
    MoeItem m = moe_super(F, in, it), mh = m;
    mh.src += (size_t)64 * m.ldw;
    MOE_LOADS_ASM(va, m);
    MOE_LOADS_ASM(vb, mh);
    bool first = true;
    for (; it < hi; it += NW) {
        MoeItem n = moe_super(F, in, it + NW < hi ? it + NW : lo), nh = n;
        nh.src += (size_t)64 * n.ldw;
        MOE_WAIT_ASM(va, 16);
        MOE_TOLDS33(va, 0);
        MOE_LOADS_ASM(va, n);
        MOE_WAIT_ASM(vb, 16);
        MOE_TOLDS33(vb, 1);
        MOE_LOADS_ASM(vb, nh);
        MOE_EMIT33(m);
        m = n; first = false;
    }
    MOE_WAIT_ASM(va, 0); MOE_WAIT_ASM(vb, 0);
}
#undef MOE_TOLDS33
#undef MOE_EMIT33
__device__ __forceinline__ MoeItem moe_super256(Frame& F, const float* const* in, int s) {
    constexpr int S10 = NE * 8 * 64;
    MoeItem m;
    if (s < S10) { const int e = s / 512, q = s % 512, kb = q / 64, cb = q % 64;
        m.r0 = cb < 32 ? 256 * (cb >> 1) + 64 * (cb & 1) : 256 * ((cb - 32) >> 1) + 128 + 64 * (cb & 1);
        m.src = in[29] + (size_t)e * 2048 * 4096 + (size_t)(256 * kb) * 4096 + 64 * cb; m.ldw = 4096; m.dst = WSP(unsigned char, WS_WGUT) + (size_t)e * 4096 * 2048; m.k0 = 256 * kb; }
    else { const int r = s - S10, e = r / 256, q = r % 256, kb = q / 32, cb = q % 32;
        m.r0 = 64 * cb; m.src = in[31] + (size_t)e * 2048 * 2048 + (size_t)(256 * kb) * 2048 + 64 * cb; m.ldw = 2048; m.dst = WSP(unsigned char, WS_WDT) + (size_t)e * 2048 * 2048; m.k0 = 256 * kb; }
    return m;
}
#define MOE_TOLDS65(v_, h_) do { LAS unsigned* s_ = scr + (4 * (lane & 15)) * 65 + (lane >> 4) + 16 * (h_); \
        _Pragma("unroll") for (int j_ = 0; j_ < 4; ++j_) { \
            s_[0 * 65 + 4 * j_] = pk4_fp8(v_[4 * j_][0] * MOE_WSCALE, v_[4 * j_ + 1][0] * MOE_WSCALE, v_[4 * j_ + 2][0] * MOE_WSCALE, v_[4 * j_ + 3][0] * MOE_WSCALE); \
            s_[1 * 65 + 4 * j_] = pk4_fp8(v_[4 * j_][1] * MOE_WSCALE, v_[4 * j_ + 1][1] * MOE_WSCALE, v_[4 * j_ + 2][1] * MOE_WSCALE, v_[4 * j_ + 3][1] * MOE_WSCALE); \
            s_[2 * 65 + 4 * j_] = pk4_fp8(v_[4 * j_][2] * MOE_WSCALE, v_[4 * j_ + 1][2] * MOE_WSCALE, v_[4 * j_ + 2][2] * MOE_WSCALE, v_[4 * j_ + 3][2] * MOE_WSCALE); \
            s_[3 * 65 + 4 * j_] = pk4_fp8(v_[4 * j_][3] * MOE_WSCALE, v_[4 * j_ + 1][3] * MOE_WSCALE, v_[4 * j_ + 2][3] * MOE_WSCALE, v_[4 * j_ + 3][3] * MOE_WSCALE); } } while (0)
#define MOE_EMIT65(m_) do { LDS_WAIT(); asm volatile("" ::: "memory"); \
        _Pragma("unroll") for (int jj_ = 0; jj_ < 16; ++jj_) { const int n_ = (lane >> 4) + 4 * jj_; const LAS unsigned* s_ = scr + n_ * 65 + 4 * (lane & 15); \
            v4u o_; o_.x = s_[0]; o_.y = s_[1]; o_.z = s_[2]; o_.w = s_[3]; \
            __builtin_nontemporal_store(o_, (GAS v4u*)((m_).dst + (size_t)((m_).r0 + n_) * 2048 + (m_).k0 + 16 * (lane & 15))); } \
        LDS_WAIT(); asm volatile("" ::: "memory"); } while (0)
#define MOE_Q(m_, q_) MoeItem{(m_).src + (size_t)(64 * (q_)) * (m_).ldw, (m_).ldw, (m_).dst, (m_).r0, (m_).k0}
template <int NW>
__device__ __forceinline__ void moe_convert_range256(Frame& F, const float* const* in, const int cw, LAS unsigned* scr, const int lane, const int lo, const int hi) {
    int it = lo + cw;
    f32x4 va[16], vb[16];
    MoeItem m = moe_super256(F, in, it);
    { const MoeItem q0 = MOE_Q(m, 0), q1 = MOE_Q(m, 1); MOE_LOADS_ASM(va, q0); MOE_LOADS_ASM(vb, q1); }
    bool first = true;
    for (; it < hi; it += NW) {
        const MoeItem n = moe_super256(F, in, it + NW < hi ? it + NW : lo);
        const MoeItem q2 = MOE_Q(m, 2), q3 = MOE_Q(m, 3), n0 = MOE_Q(n, 0), n1 = MOE_Q(n, 1);
        MOE_WAIT_ASM(va, 16);
        MOE_TOLDS65(va, 0); MOE_LOADS_ASM(va, q2);
        MOE_WAIT_ASM(vb, 16);
        MOE_TOLDS65(vb, 1); MOE_LOADS_ASM(vb, q3);
        MOE_WAIT_ASM(va, 16);
        MOE_TOLDS65(va, 2); MOE_LOADS_ASM(va, n0);
        MOE_WAIT_ASM(vb, 16);
        MOE_TOLDS65(vb, 3); MOE_LOADS_ASM(vb, n1);
        MOE_EMIT65(m);
        if (CONV_SLEEP > 0) __builtin_amdgcn_s_sleep(CONV_SLEEP);
        m = n; first = false;
    }
    MOE_WAIT_ASM(va, 0); MOE_WAIT_ASM(vb, 0);
}
constexpr int CONV_NSUP = NE * 8 * 64 + NE * 8 * 32, CONV_OFF_CUS = (CONV_OFFLOAD == 2) ? 160 : 128, CONV_OFF = CONV_OFFLOAD ? 8 * CONV_OFF_CUS : 0, CONV_PER5 = (CONV_NSUP - CONV_OFF) / 256;
static_assert((CONV_NSUP - CONV_OFF) % 256 == 0, "equal shares per workgroup");
template <int NW>
__device__ __forceinline__ void moe_convert_share_w256(Frame& F, const float* const* in, const int cw, LAS unsigned* scr, const int lane) {
    moe_convert_range256<NW>(F, in, cw, scr, lane, F.vcu * CONV_PER5, F.vcu * CONV_PER5 + CONV_PER5);
}
#undef MOE_TOLDS65
#undef MOE_EMIT65
#undef MOE_Q
#undef MOE_LOADS_ASM
#undef MOE_WAIT_ASM
#undef MOE_LOADS
#undef MOE_TOLDS
#undef MOE_EMIT

__device__ __forceinline__ void moe_convert_share_dma(Frame& F, const float* const* in) {
    LAS unsigned char* wbase = F.lds + RING_OFF + F.wave * 16640;
    LAS unsigned* tile2 = (LAS unsigned*)(wbase + 12288);
    constexpr int NIT = NE * 32 * 64 + NE * 32 * 32;
    const int per = (NIT + F.G - 1) / F.G, lo = F.vcu * per, hi = (lo + per < NIT) ? lo + per : NIT, lane = F.lane;
    const int nitems = (hi - lo - F.wave + NWAVES - 1) / NWAVES;
    if (nitems > 0) {
        const int nchunks = nitems * 4;
        const int ng = lane & 15, kr = lane >> 4;
#define CDMA_ISSUE(c_) do { const MoeItem m_ = moe_item(F, in, lo + F.wave + NWAVES * ((c_) >> 2)); const int kc_ = (c_) & 3; \
            const GAS unsigned char* g_ = (const GAS unsigned char*)m_.src + ((size_t)(16 * kc_ + kr) * m_.ldw + (size_t)ng * 4) * 4; LAS unsigned char* l_ = wbase + ((c_) % 3) * 4096; \
            _Pragma("unroll") for (int q_ = 0; q_ < 4; ++q_) __builtin_amdgcn_global_load_lds((const GAS unsigned*)(g_ + (size_t)(4 * q_) * m_.ldw * 4), (LAS unsigned*)(l_ + q_ * 1024), 16, 0, 2); } while (0)
        CDMA_ISSUE(0);
        if (nchunks > 1) CDMA_ISSUE(1);
        for (int c = 0; c < nchunks; ++c) {
            if (c + 2 < nchunks) { CDMA_ISSUE(c + 2); asm volatile("s_waitcnt vmcnt(8)" ::: "memory"); }
            else if (c + 1 < nchunks) asm volatile("s_waitcnt vmcnt(4)" ::: "memory");
            else asm volatile("s_waitcnt vmcnt(0)" ::: "memory");
            const LAS unsigned char* cb = wbase + (c % 3) * 4096 + (4 * kr) * 256 + ng * 16;
            const f32x4 r0 = *(const LAS f32x4*)(cb), r1 = *(const LAS f32x4*)(cb + 256), r2 = *(const LAS f32x4*)(cb + 512), r3 = *(const LAS f32x4*)(cb + 768);
            LAS unsigned* t2 = tile2 + (4 * ng) * 17 + 4 * (c & 3) + kr;
            t2[0 * 17] = pk4_fp8(r0[0] * MOE_WSCALE, r1[0] * MOE_WSCALE, r2[0] * MOE_WSCALE, r3[0] * MOE_WSCALE);
            t2[1 * 17] = pk4_fp8(r0[1] * MOE_WSCALE, r1[1] * MOE_WSCALE, r2[1] * MOE_WSCALE, r3[1] * MOE_WSCALE);
            t2[2 * 17] = pk4_fp8(r0[2] * MOE_WSCALE, r1[2] * MOE_WSCALE, r2[2] * MOE_WSCALE, r3[2] * MOE_WSCALE);
            t2[3 * 17] = pk4_fp8(r0[3] * MOE_WSCALE, r1[3] * MOE_WSCALE, r2[3] * MOE_WSCALE, r3[3] * MOE_WSCALE);
            LDS_WAIT(); asm volatile("" ::: "memory");
            if ((c & 3) == 3) {
                const MoeItem m = moe_item(F, in, lo + F.wave + NWAVES * (c >> 2));
#pragma unroll
                for (int jj = 0; jj < 4; ++jj) { const int n = (lane >> 2) + 16 * jj; const LAS unsigned* s = tile2 + n * 17 + 4 * (lane & 3);
                    v4u o; o.x = s[0]; o.y = s[1]; o.z = s[2]; o.w = s[3];
                    __builtin_nontemporal_store(o, (GAS v4u*)(m.dst + (size_t)(m.r0 + n) * 2048 + m.k0 + 16 * (lane & 3))); }
                LDS_WAIT(); asm volatile("" ::: "memory");
            }
        }
#undef CDMA_ISSUE
    }
    asm volatile("s_waitcnt vmcnt(0)" ::: "memory");
    __syncthreads();
}

struct MoeItem256 { const float* src; size_t ldw; unsigned char* dst; int rowbase; int rowmode; int k0; };
__device__ __forceinline__ MoeItem256 moe_item256(Frame& F, const float* const* in, int it) {
    constexpr int I10 = NE * 32 * 64;
    MoeItem256 m;
    if (it < I10) { const int e = it / 2048, q = it % 2048, kb = q / 16, cb = q % 16; const bool gate = cb < 8; const int grp0 = gate ? 2 * cb : 2 * (cb - 8);
        m.src = in[29] + (size_t)e * 2048 * 4096 + (size_t)(16 * kb) * 4096 + 256 * cb; m.ldw = 4096; m.dst = WSP(unsigned char, WS_WGUT) + (size_t)e * 4096 * 2048;
        m.rowbase = 256 * grp0 + (gate ? 0 : 128); m.rowmode = 1; m.k0 = 16 * kb; }
    else { const int r = it - I10, e = r / 1024, q = r % 1024, kb = q / 8, cb = q % 8;
        m.src = in[31] + (size_t)e * 2048 * 2048 + (size_t)(16 * kb) * 2048 + 256 * cb; m.ldw = 2048; m.dst = WSP(unsigned char, WS_WDT) + (size_t)e * 2048 * 2048;
        m.rowbase = 256 * cb; m.rowmode = 0; m.k0 = 16 * kb; }
    return m;
}
__device__ __forceinline__ void moe_convert_share_dma256(Frame& F, const float* const* in) {
    LAS unsigned char* wbase = F.lds + RING_OFF + F.wave * 16640;
    LAS unsigned* tile2 = (LAS unsigned*)(wbase + 12288);
    constexpr int NIT = NE * 32 * 64 + NE * 32 * 32;
    const int per = (NIT + F.G - 1) / F.G, lo = F.vcu * per, hi = (lo + per < NIT) ? lo + per : NIT, lane = F.lane;
    const int nitems = (hi - lo - F.wave + NWAVES - 1) / NWAVES;
    if (nitems > 0) {
        const int nchunks = nitems * 4;
#define C256_ISSUE(c_) do { const MoeItem256 m_ = moe_item256(F, in, lo + F.wave + NWAVES * ((c_) >> 2)); const int kc_ = (c_) & 3; \
            const GAS unsigned char* g_ = (const GAS unsigned char*)m_.src + ((size_t)(4 * kc_) * m_.ldw + (size_t)lane * 4) * 4; LAS unsigned char* l_ = wbase + ((c_) % 3) * 4096; \
            _Pragma("unroll") for (int r_ = 0; r_ < 4; ++r_) __builtin_amdgcn_global_load_lds((const GAS unsigned*)(g_ + (size_t)r_ * m_.ldw * 4), (LAS unsigned*)(l_ + r_ * 1024), 16, 0, 2); } while (0)
        C256_ISSUE(0);
        if (nchunks > 1) C256_ISSUE(1);
        for (int c = 0; c < nchunks; ++c) {
            if (c + 2 < nchunks) { C256_ISSUE(c + 2); asm volatile("s_waitcnt vmcnt(8)" ::: "memory"); }
            else if (c + 1 < nchunks) asm volatile("s_waitcnt vmcnt(4)" ::: "memory");
            else asm volatile("s_waitcnt vmcnt(0)" ::: "memory");
            const LAS float* cb = (const LAS float*)(wbase + (c % 3) * 4096) + lane;
            LAS unsigned* t2 = tile2 + (c & 3) * 256 + lane;
#pragma unroll
            for (int cc = 0; cc < 4; ++cc) t2[64 * cc] = pk4_fp8(cb[64 * cc] * MOE_WSCALE, cb[256 + 64 * cc] * MOE_WSCALE, cb[512 + 64 * cc] * MOE_WSCALE, cb[768 + 64 * cc] * MOE_WSCALE);
            LDS_WAIT(); asm volatile("" ::: "memory");
            if ((c & 3) == 3) {
                const MoeItem256 m = moe_item256(F, in, lo + F.wave + NWAVES * (c >> 2));
#pragma unroll
                for (int cc = 0; cc < 4; ++cc) { const LAS unsigned* s = tile2 + lane + 64 * cc;
                    v4u o; o.x = s[0]; o.y = s[256]; o.z = s[512]; o.w = s[768];
                    const int row = m.rowbase + (m.rowmode ? 256 * (cc >> 1) + lane + 64 * (cc & 1) : lane + 64 * cc);
                    __builtin_nontemporal_store(o, (GAS v4u*)(m.dst + (size_t)row * 2048 + m.k0)); }
                LDS_WAIT(); asm volatile("" ::: "memory");
            }
        }
#undef C256_ISSUE
    }
    asm volatile("s_waitcnt vmcnt(0)" ::: "memory");
    __syncthreads();
}

struct ConvState { int lo, nchunks, c, cw; };
template <int NCW>
__device__ __forceinline__ void conv_steps(Frame& F, const float* const* in, ConvState& S, LAS unsigned char* wbase, int nsteps, int lane) {
    LAS unsigned* tile2 = (LAS unsigned*)(wbase + 12288);
    const int ng = lane & 15, kr = lane >> 4;
#define CS_ISSUE(c_) do { const MoeItem m_ = moe_item(F, in, S.lo + S.cw + NCW * ((c_) >> 2)); const int kc_ = (c_) & 3; \
        const GAS unsigned char* g_ = (const GAS unsigned char*)m_.src + ((size_t)(16 * kc_ + kr) * m_.ldw + (size_t)ng * 4) * 4; LAS unsigned char* l_ = wbase + ((c_) % 3) * 4096; \
        _Pragma("unroll") for (int q_ = 0; q_ < 4; ++q_) __builtin_amdgcn_global_load_lds((const GAS unsigned*)(g_ + (size_t)(4 * q_) * m_.ldw * 4), (LAS unsigned*)(l_ + q_ * 1024), 16, 0, 2); } while (0)
    if (S.c < 0) { S.c = 0; if (S.nchunks > 0) CS_ISSUE(0); if (S.nchunks > 1) CS_ISSUE(1); }
    for (int st = 0; st < nsteps && S.c < S.nchunks; ++st) {
        const int c = S.c;
        if (c + 2 < S.nchunks) { CS_ISSUE(c + 2); asm volatile("s_waitcnt vmcnt(8)" ::: "memory"); }
        else if (c + 1 < S.nchunks) asm volatile("s_waitcnt vmcnt(4)" ::: "memory");
        else asm volatile("s_waitcnt vmcnt(0)" ::: "memory");
        const LAS unsigned char* cb = wbase + (c % 3) * 4096 + (4 * kr) * 256 + ng * 16;
        const f32x4 r0 = *(const LAS f32x4*)(cb), r1 = *(const LAS f32x4*)(cb + 256), r2 = *(const LAS f32x4*)(cb + 512), r3 = *(const LAS f32x4*)(cb + 768);
        LAS unsigned* t2 = tile2 + (4 * ng) * 17 + 4 * (c & 3) + kr;
        t2[0 * 17] = pk4_fp8(r0[0] * MOE_WSCALE, r1[0] * MOE_WSCALE, r2[0] * MOE_WSCALE, r3[0] * MOE_WSCALE);
        t2[1 * 17] = pk4_fp8(r0[1] * MOE_WSCALE, r1[1] * MOE_WSCALE, r2[1] * MOE_WSCALE, r3[1] * MOE_WSCALE);
        t2[2 * 17] = pk4_fp8(r0[2] * MOE_WSCALE, r1[2] * MOE_WSCALE, r2[2] * MOE_WSCALE, r3[2] * MOE_WSCALE);
        t2[3 * 17] = pk4_fp8(r0[3] * MOE_WSCALE, r1[3] * MOE_WSCALE, r2[3] * MOE_WSCALE, r3[3] * MOE_WSCALE);
        LDS_WAIT(); asm volatile("" ::: "memory");
        if ((c & 3) == 3) {
            const MoeItem m = moe_item(F, in, S.lo + S.cw + NCW * (c >> 2));
#pragma unroll
            for (int jj = 0; jj < 4; ++jj) { const int n = (lane >> 2) + 16 * jj; const LAS unsigned* s = tile2 + n * 17 + 4 * (lane & 3);
                v4u o; o.x = s[0]; o.y = s[1]; o.z = s[2]; o.w = s[3];
                __builtin_nontemporal_store(o, (GAS v4u*)(m.dst + (size_t)(m.r0 + n) * 2048 + m.k0 + 16 * (lane & 3))); }
            LDS_WAIT(); asm volatile("" ::: "memory");
        }
        S.c = c + 1;
    }
#undef CS_ISSUE
}

__device__ __forceinline__ float group16_sum(float v) { if (XL_FAST) return xl_sum16(v); v += __shfl_xor(v, 1); v += __shfl_xor(v, 2); v += __shfl_xor(v, 4); v += __shfl_xor(v, 8); return v; }
__device__ __forceinline__ void p2_token(Frame& F, const float* const* in, int t) {
    const int l = F.lane;
    const GAS bf16* row = (const GAS bf16*)WSP(bf16, WS_P1) + (size_t)t * P1N;
    { float a[8], b[8]; unpack8(*(const GAS v4u*)(row + P1_V + 16 * l), a); unpack8(*(const GAS v4u*)(row + P1_V + 16 * l + 8), b);
      float s = 0.f;
#pragma unroll
      for (int i = 0; i < 8; ++i) s += a[i] + b[i];
      const float mean = wave_sum(s) * (1.f / 1024.f); float q = 0.f;
#pragma unroll
      for (int i = 0; i < 8; ++i) { const float d0 = a[i] - mean, d1 = b[i] - mean; q += d0 * d0 + d1 * d1; }
      const float rstd = 1.0f * FAST_RSQ(wave_sum(q) * (1.f / 1024.f) + EPS);
      if (l == 0) { GAS float* vs = (GAS float*)WSP(float, WS_VSTAT) + (size_t)t * 2; vs[0] = mean; vs[1] = rstd; } }
#pragma unroll
    for (int w = 0; w < 2; ++w) {
        float a[8]; unpack8(*(const GAS v4u*)(row + (w ? P1_CKV : P1_CQ) + 8 * l), a);
        float s = 0.f;
#pragma unroll
        for (int i = 0; i < 8; ++i) s += a[i] * a[i];
        const float rs = 1.0f * FAST_RSQ(wave_sum(s) * (1.f / 512.f) + EPS);
        const GAS float* g = (const GAS float*)(w ? in[14] : in[12]) + 8 * l;
        const f32x4 g0 = *(const GAS f32x4*)g, g1 = *(const GAS f32x4*)(g + 4);
        float o[8] = {a[0] * rs * g0.x, a[1] * rs * g0.y, a[2] * rs * g0.z, a[3] * rs * g0.w, a[4] * rs * g1.x, a[5] * rs * g1.y, a[6] * rs * g1.z, a[7] * rs * g1.w};
        u32x2 w8; w8.x = pk4_fp8(o[0], o[1], o[2], o[3]); w8.y = pk4_fp8(o[4], o[5], o[6], o[7]);
        *(GAS u32x2*)((GAS unsigned char*)WSP(unsigned char, w ? WS_CKVN : WS_CQN) + (size_t)t * 512 + 8 * l) = w8;
    }
    { float a[8], b[8]; unpack8(*(const GAS v4u*)(row + P1_QM + 16 * l), a); unpack8(*(const GAS v4u*)(row + P1_QM + 16 * l + 8), b);
      float s = 0.f;
#pragma unroll
      for (int i = 0; i < 8; ++i) s += a[i] * a[i] + b[i] * b[i];
      const float rs = MEM_QSCALE * FAST_RSQ(group16_sum(s) * (1.f / 256.f) + EPS);
      const GAS float* g = (const GAS float*)in[22] + (l & 15) * 16;
      float ga[8], gb[8];
#pragma unroll
      for (int i = 0; i < 8; ++i) { ga[i] = g[i]; gb[i] = g[8 + i]; }
#pragma unroll
      for (int i = 0; i < 8; ++i) { a[i] *= rs * ga[i]; b[i] *= rs * gb[i]; }
      const int bb = t >> 12, tl = t & 4095, h = l >> 4;
      GAS bf16* dst = (GAS bf16*)WSP(bf16, WS_QMN) + ((size_t)((bb * 4 + h) * 4096 + tl)) * 256 + (l & 15) * 16;
      *(GAS v4u*)dst = packf8(a); *(GAS v4u*)(dst + 8) = packf8(b); }
    { float t1 = 0.f, t2 = 0.f;
      if (l < 32) { t1 = bflo((unsigned)row[P1_KR + l]); t2 = bflo((unsigned)row[P1_KR + 32 + l]); }
      const float ss = wave_sum(t1 * t1 + t2 * t2);
      if (l < 32) {
          const float pos = (float)((const GAS int*)in[2])[t];
          const float inv = 1.0f / powf(10000.0f, (float)(2 * l) / 64.0f);
          const float ang = pos * inv, c = cosf(ang), s = sinf(ang);
          GAS float* rp = (GAS float*)WSP(float, WS_ROPE) + (size_t)t * 64; rp[l] = c; rp[32 + l] = s;
          const GAS float* kg = (const GAS float*)in[17];
          const float a = t1 * kg[128 + l], b = t2 * kg[160 + l];
          GAS float* kr = (GAS float*)WSP(float, WS_KRR) + (size_t)t * 64; kr[l] = a * c - b * s; kr[32 + l] = a * s + b * c;
          if (l == 0) ((GAS float*)WSP(float, WS_KRSS))[t] = ss;
      } }
}
__device__ __forceinline__ void p2_memrow(Frame& F, const float* const* in, int m) {
    const int l = F.lane, bb = m >> 8, ml = m & 255, tile = ml >> 6, key = ml & 63, h = l >> 4, d0 = (l & 15) * 16;
    const GAS bf16* row = (const GAS bf16*)WSP(bf16, WS_MKV) + (size_t)m * 2048;
    { float a[8], b[8]; unpack8(*(const GAS v4u*)(row + 16 * l), a); unpack8(*(const GAS v4u*)(row + 16 * l + 8), b);
      float s = 0.f;
#pragma unroll
      for (int i = 0; i < 8; ++i) s += a[i] * a[i] + b[i] * b[i];
      const float rs = 1.0f * FAST_RSQ(group16_sum(s) * (1.f / 256.f) + EPS);
      const GAS float* g = (const GAS float*)in[23] + d0;
#pragma unroll
      for (int i = 0; i < 8; ++i) { a[i] *= rs * g[i]; b[i] *= rs * g[8 + i]; }
      GAS bf16* base = (GAS bf16*)WSP(bf16, WS_MKT) + (size_t)((bb * 4 + h) * 4 + tile) * (32 * 64 * 8);
      const int c0 = d0 >> 3;
      *(GAS v4u*)(base + ((size_t)c0 * 64 + key) * 8) = packf8(a); *(GAS v4u*)(base + ((size_t)(c0 + 1) * 64 + key) * 8) = packf8(b); }
    { const v4u a = *(const GAS v4u*)(row + 1024 + 16 * l), b = *(const GAS v4u*)(row + 1024 + 16 * l + 8);
      const int half = d0 >> 7, cb = (d0 & 127) >> 5, off = d0 & 31;
      GAS bf16* base = (GAS bf16*)WSP(bf16, WS_MVT) + (size_t)(((bb * 4 + h) * 2 + half) * 4 + tile) * (4 * 64 * 32);
      GAS bf16* dst = base + ((size_t)cb * 64 + key) * 32 + off;
      *(GAS v4u*)dst = a; *(GAS v4u*)(dst + 8) = b; }
}

__device__ __forceinline__ void gmlp_unit(Frame& F, const float* const* in, int u) {
    const int ci = u >> 3, g = u & 7, tok0 = ci * 128, tid = F.tid, l = F.lane, r32 = l & 31, hi = l >> 5;
    LAS bf16* VT = (LAS bf16*)(F.lds + RING_OFF);
    const GAS bf16* P1 = (const GAS bf16*)WSP(bf16, WS_P1);
    { const int s = tid >> 2, qd = tid & 3;
      const GAS float* vs = (const GAS float*)WSP(float, WS_VSTAT) + (size_t)(tok0 + s) * 2; const float mean = vs[0], rstd = vs[1];
      const GAS bf16* src = P1 + (size_t)(tok0 + s) * P1N + P1_V + g * 128 + qd * 32;
      const GAS float* lg = (const GAS float*)in[7] + g * 128 + qd * 32; const GAS float* lb = (const GAS float*)in[8] + g * 128 + qd * 32;
#pragma unroll
      for (int i = 0; i < 4; ++i) { float a[8]; unpack8(*(const GAS v4u*)(src + 8 * i), a);
#pragma unroll
          for (int k = 0; k < 8; ++k) { const int c = qd * 32 + 8 * i + k; const float v = (a[k] - mean) * rstd * lg[8 * i + k] + lb[8 * i + k]; VT[c * 136 + s] = (bf16)(cvtpk(v, 0.f) & 0xffffu); } } }
    __syncthreads();
    const int w = F.wave, tb = w >> 1, cbp = (w & 1) * 2;
    f32x16 acc[2];
#pragma unroll
    for (int r = 0; r < 16; ++r) { acc[0][r] = 0.f; acc[1][r] = 0.f; }
    const GAS bf16* wsm = (const GAS bf16*)WSP(bf16, WS_WSM) + ((size_t)(g * 128 + 32 * tb + r32)) * 128 + 8 * hi;
    for (int ks = 0; ks < 2 * (tb + 1); ++ks) {
        const bf16x8 af = *(const GAS bf16x8*)(wsm + 16 * ks);
#pragma unroll
        for (int cc = 0; cc < 2; ++cc) { const bf16x8 bfr = *(const LAS bf16x8*)(VT + (32 * (cbp + cc) + r32) * 136 + 16 * ks + 8 * hi);
            acc[cc] = __builtin_amdgcn_mfma_f32_32x32x16_bf16(af, bfr, acc[cc], 0, 0, 0); }
    }
    const GAS float* bs = (const GAS float*)in[10] + g * 128;
    GAS bf16* AO = (GAS bf16*)WSP(bf16, WS_ABC);
#pragma unroll
    for (int cc = 0; cc < 2; ++cc)
#pragma unroll
        for (int r = 0; r < 16; ++r) { const int t = 32 * tb + crow(r, hi), tok = tok0 + t, ch = g * 128 + 32 * (cbp + cc) + r32;
            const float uu = bflo((unsigned)P1[(size_t)tok * P1N + P1_U + ch]);
            AO[(size_t)tok * ABC_LD + ch] = (bf16)(cvtpk(uu * (acc[cc][r] + bs[t]), 0.f) & 0xffffu); }
    __syncthreads();
}

__device__ __forceinline__ void p4_token(Frame& F, const float* const* in, int t) {
    const int l = F.lane, bb = t >> 12, tl = t & 4095, tile = tl >> 6, key = tl & 63, h = l >> 2, sub = l & 3;
    const GAS float* rope = (const GAS float*)WSP(float, WS_ROPE) + (size_t)t * 64;
    { const GAS bf16* qr = (const GAS bf16*)WSP(bf16, WS_QRAW) + (size_t)t * 3072 + h * 192;
      float x[4][8], y[2][8];
#pragma unroll
      for (int i = 0; i < 4; ++i) unpack8(*(const GAS v4u*)(qr + sub * 32 + 8 * i), x[i]);
#pragma unroll
      for (int i = 0; i < 2; ++i) unpack8(*(const GAS v4u*)(qr + 128 + sub * 16 + 8 * i), y[i]);
      float s = 0.f;
#pragma unroll
      for (int i = 0; i < 4; ++i)
#pragma unroll
          for (int k = 0; k < 8; ++k) s += x[i][k] * x[i][k];
#pragma unroll
      for (int i = 0; i < 2; ++i)
#pragma unroll
          for (int k = 0; k < 8; ++k) s += y[i][k] * y[i][k];
      s += __shfl_xor(s, 1); s += __shfl_xor(s, 2);
      const float rs = 1.0f * FAST_RSQ(s * (1.f / 192.f) + EPS);
      const GAS float* qg = (const GAS float*)in[16];
      GAS bf16* dst = (GAS bf16*)WSP(bf16, WS_QF) + ((size_t)((bb * 16 + h) * 4096 + tl)) * 192;
#pragma unroll
      for (int i = 0; i < 4; ++i) {
#pragma unroll
          for (int k = 0; k < 8; ++k) x[i][k] *= rs * qg[sub * 32 + 8 * i + k] * MLA_QSCALE;
          *(GAS v4u*)(dst + sub * 32 + 8 * i) = packf8(x[i]); }
#pragma unroll
      for (int i = 0; i < 2; ++i) { float o[8];
#pragma unroll
          for (int k = 0; k < 8; ++k) { const float mine = y[i][k] * rs * qg[128 + sub * 16 + 8 * i + k]; const float other = __shfl_xor(mine, 2);
              const int j = (sub & 1) * 16 + 8 * i + k; const float c = rope[j], sn = rope[32 + j];
              o[k] = (sub < 2 ? mine * c - other * sn : other * sn + mine * c) * MLA_QSCALE; }
          *(GAS v4u*)(dst + 128 + sub * 16 + 8 * i) = packf8(o); } }
    { const GAS bf16* kr = (const GAS bf16*)WSP(bf16, WS_KVRAW) + (size_t)t * 4096 + h * 256;
      float x[4][8];
#pragma unroll
      for (int i = 0; i < 4; ++i) unpack8(*(const GAS v4u*)(kr + sub * 32 + 8 * i), x[i]);
      float s = 0.f;
#pragma unroll
      for (int i = 0; i < 4; ++i)
#pragma unroll
          for (int k = 0; k < 8; ++k) s += x[i][k] * x[i][k];
      s += __shfl_xor(s, 1); s += __shfl_xor(s, 2);
      s += ((const GAS float*)WSP(float, WS_KRSS))[t];
      const float rs = 1.0f * FAST_RSQ(s * (1.f / 192.f) + EPS);
      const GAS float* kg = (const GAS float*)in[17];
      GAS bf16* kbase = (GAS bf16*)WSP(bf16, WS_KFT) + (size_t)((bb * 16 + h) * 64 + tile) * (24 * 64 * 8);
#pragma unroll
      for (int i = 0; i < 4; ++i) {
#pragma unroll
          for (int k = 0; k < 8; ++k) x[i][k] *= rs * kg[sub * 32 + 8 * i + k];
          *(GAS v4u*)(kbase + ((size_t)(sub * 4 + i) * 64 + key) * 8) = packf8(x[i]); }
      const GAS float* krr = (const GAS float*)WSP(float, WS_KRR) + (size_t)t * 64 + sub * 16;
#pragma unroll
      for (int i = 0; i < 2; ++i) { float o[8];
#pragma unroll
          for (int k = 0; k < 8; ++k) o[k] = krr[8 * i + k] * rs;
          *(GAS v4u*)(kbase + ((size_t)(16 + 2 * sub + i) * 64 + key) * 8) = packf8(o); }
      GAS bf16* vdst = (GAS bf16*)WSP(bf16, WS_VFT) + (size_t)((bb * 16 + h) * 64 + tile) * (4 * 64 * 32) + ((size_t)sub * 64 + key) * 32;
#pragma unroll
      for (int i = 0; i < 4; ++i) *(GAS v4u*)(vdst + 8 * i) = *(const GAS v4u*)(kr + 128 + sub * 32 + 8 * i); }
}
__device__ __forceinline__ void p8_router(Frame& F, const float* const* in) {
    const int tid = F.tid, l = F.lane, r32 = l & 31, hi = l >> 5, w = F.wave, tk = w >> 2, kq = w & 3;
    LAS float* part = (LAS float*)(F.lds + RING_OFF);
    LAS float* ssp = part + 2 * 4 * 32 * 33;
    LAS int* lcnt = (LAS int*)(F.lds + LTAB_OFF) + 40;
    LAS int* gbase = lcnt + 32;
    const int tok0 = (blockIdx.x * 2 + tk) * 32;
    if (tid < 32) lcnt[tid] = 0;
#if ROUTER_BF16X2
    {   const GAS bf16* xr = (const GAS bf16*)WSP(bf16, WS_X1) + (size_t)(tok0 + r32) * 2048 + 8 * hi;
        const GAS bf16* wh = (const GAS bf16*)WSP(bf16, WS_RWG) + (size_t)r32 * 2048 + 8 * hi;
        f32x16 acc;
#pragma unroll
        for (int r = 0; r < 16; ++r) acc[r] = 0.f;
        float ss = 0.f;
#pragma unroll 4
        for (int it = 32 * kq; it < 32 * kq + 32; ++it) {
            const v4u aw = *(const GAS v4u*)(xr + 16 * it);
            const bf16x8 a = __builtin_bit_cast(bf16x8, aw);
            const bf16x8 bh = *(const GAS bf16x8*)(wh + 16 * it), bl = *(const GAS bf16x8*)(wh + 32 * 2048 + 16 * it);
            acc = __builtin_amdgcn_mfma_f32_32x32x16_bf16(a, bh, acc, 0, 0, 0);
            acc = __builtin_amdgcn_mfma_f32_32x32x16_bf16(a, bl, acc, 0, 0, 0);
            float fa[8]; unpack8(aw, fa);
            ss += ((fa[0] * fa[0] + fa[1] * fa[1]) + (fa[2] * fa[2] + fa[3] * fa[3])) + ((fa[4] * fa[4] + fa[5] * fa[5]) + (fa[6] * fa[6] + fa[7] * fa[7]));
        }
#else
    {   const GAS bf16* xr = (const GAS bf16*)WSP(bf16, WS_X1) + (size_t)(tok0 + r32) * 2048 + 4 * hi;
        const GAS float* rw = (const GAS float*)WSP(float, WS_RWG) + (size_t)(4 * hi) * 32 + r32;
        f32x16 acc;
#pragma unroll
        for (int r = 0; r < 16; ++r) acc[r] = 0.f;
        float ss = 0.f;
#pragma unroll 4
        for (int q = 64 * kq; q < 64 * kq + 64; ++q) {
            const u32x2 aw = *(const GAS u32x2*)(xr + 8 * q); f32x4 a; a.x = bflo(aw.x); a.y = bfhi(aw.x); a.z = bflo(aw.y); a.w = bfhi(aw.y);
            const GAS float* rq = rw + (size_t)(8 * q) * 32;
            const float b0 = rq[0], b1 = rq[32], b2 = rq[64], b3 = rq[96];
            acc = __builtin_amdgcn_mfma_f32_32x32x2f32(a.x, b0, acc, 0, 0, 0);
            acc = __builtin_amdgcn_mfma_f32_32x32x2f32(a.y, b1, acc, 0, 0, 0);
            acc = __builtin_amdgcn_mfma_f32_32x32x2f32(a.z, b2, acc, 0, 0, 0);
            acc = __builtin_amdgcn_mfma_f32_32x32x2f32(a.w, b3, acc, 0, 0, 0);
            ss += (a.x * a.x + a.y * a.y) + (a.z * a.z + a.w * a.w);
        }
#endif
        LAS float* pp = part + (size_t)((tk * 4 + kq) * 32) * 33;
#pragma unroll
        for (int r = 0; r < 16; ++r) pp[crow(r, hi) * 33 + r32] = acc[r];
        ssp[(tk * 4 + kq) * 64 + l] = ss;
    }
    __syncthreads();
    const bool sel = (kq == 0) && (l < 32);
    float v0 = -INFINITY, v1 = -INFINITY, v2 = -INFINITY, v3 = -INFINITY; int i0 = 0, i1 = 0, i2 = 0, i3 = 0; int lr0 = 0, lr1 = 0, lr2 = 0, lr3 = 0;
    if (sel) {
        float ss = 0.f;
#pragma unroll
        for (int k = 0; k < 4; ++k) ss += ssp[(tk * 4 + k) * 64 + l] + ssp[(tk * 4 + k) * 64 + 32 + l];
        const float rs = 1.0f * FAST_RSQ(ss * (1.f / 2048.f) + EPS);
        const GAS float* rb = (const GAS float*)in[28];
        const LAS float* pp = part + (size_t)(tk * 4 * 32 + l) * 33;
#pragma unroll
        for (int e = 0; e < 32; ++e) {
            const float x = ((pp[e] + pp[32 * 33 + e]) + (pp[2 * 32 * 33 + e] + pp[3 * 32 * 33 + e])) * rs + rb[e];
            if (x > v3) {
                if (x > v0) { v3 = v2; i3 = i2; v2 = v1; i2 = i1; v1 = v0; i1 = i0; v0 = x; i0 = e; }
                else if (x > v1) { v3 = v2; i3 = i2; v2 = v1; i2 = i1; v1 = x; i1 = e; }
                else if (x > v2) { v3 = v2; i3 = i2; v2 = x; i2 = e; }
                else { v3 = x; i3 = e; }
            }
        }
        lr0 = __hip_atomic_fetch_add(&lcnt[i0], 1, __ATOMIC_RELAXED, __HIP_MEMORY_SCOPE_WORKGROUP); lr1 = __hip_atomic_fetch_add(&lcnt[i1], 1, __ATOMIC_RELAXED, __HIP_MEMORY_SCOPE_WORKGROUP); lr2 = __hip_atomic_fetch_add(&lcnt[i2], 1, __ATOMIC_RELAXED, __HIP_MEMORY_SCOPE_WORKGROUP); lr3 = __hip_atomic_fetch_add(&lcnt[i3], 1, __ATOMIC_RELAXED, __HIP_MEMORY_SCOPE_WORKGROUP);
    }
    __syncthreads();
    if (tid < 32) { const int c = lcnt[tid]; gbase[tid] = c ? (int)__hip_atomic_fetch_add((unsigned*)(F.ctl + CW_CNT + CNT_STRIDE * tid), (unsigned)c, __ATOMIC_RELAXED, __HIP_MEMORY_SCOPE_AGENT) : 0; }
    __syncthreads();
    if (sel) {
        const int t = tok0 + l;
        const float e1 = expf(v1 - v0), e2 = expf(v2 - v0), e3 = expf(v3 - v0), inv = 1.0f / (1.0f + e1 + e2 + e3);
        GAS int* te = (GAS int*)WSP(int, WS_TKE) + t * 4; GAS int* tr = (GAS int*)WSP(int, WS_TKR) + t * 4; GAS float* tg = (GAS float*)WSP(float, WS_TKG) + t * 4;
        te[0] = i0; te[1] = i1; te[2] = i2; te[3] = i3;
        tr[0] = gbase[i0] + lr0; tr[1] = gbase[i1] + lr1; tr[2] = gbase[i2] + lr2; tr[3] = gbase[i3] + lr3;
        tg[0] = inv; tg[1] = e1 * inv; tg[2] = e2 * inv; tg[3] = e3 * inv;
    }
    __syncthreads();
}
__device__ __forceinline__ void build_moe_tab(Frame& F) {
    LAS int* tab = (LAS int*)(F.lds + LTAB_OFF);
#if CNT_SPREAD
    if (F.tid < NE) tab[40 + NE + NE + F.tid] = ((int)__hip_atomic_load(F.ctl + CW_CNT + CNT_STRIDE * F.tid, RLX_AGENT) + 255) >> 8;
    __syncthreads();
    if (F.tid == 0) { int s = 0; for (int e = 0; e < NE; ++e) { tab[e] = s; s += tab[40 + NE + NE + e]; } tab[NE] = s; }
    __syncthreads();
}
#else
    if (F.tid == 0) { int s = 0; for (int e = 0; e < NE; ++e) { tab[e] = s; s += ((int)__hip_atomic_load(F.ctl + CW_CNT + e, RLX_AGENT) + 255) >> 8; } tab[NE] = s; }
    __syncthreads();
}
#endif
__device__ __forceinline__ void p9_scatter_token(Frame& F, const float* const* in, int t) {
    const int lane = F.lane; const LAS int* tab = (const LAS int*)(F.lds + LTAB_OFF);
    const GAS u32x2* xr = (const GAS u32x2*)(WSP(bf16, WS_X1) + (size_t)t * 2048) + lane; const GAS f32x4* gr = (const GAS f32x4*)in[26] + lane;
    f32x4 v[8]; float s = 0.f;
#pragma unroll
    for (int j = 0; j < 8; ++j) { const u32x2 xw = xr[64 * j]; v[j].x = bflo(xw.x); v[j].y = bfhi(xw.x); v[j].z = bflo(xw.y); v[j].w = bfhi(xw.y); s += (v[j].x * v[j].x + v[j].y * v[j].y) + (v[j].z * v[j].z + v[j].w * v[j].w); }
    const float rs = 1.0f * FAST_RSQ(wave_sum(s) * (1.f / 2048.f) + EPS);
    unsigned w[8];
#pragma unroll
    for (int j = 0; j < 8; ++j) { const f32x4 g = gr[64 * j]; w[j] = pk4_fp8(v[j].x * rs * g.x, v[j].y * rs * g.y, v[j].z * rs * g.z, v[j].w * rs * g.w); }
    const GAS int* te = (const GAS int*)WSP(int, WS_TKE) + t * 4; const GAS int* tr = (const GAS int*)WSP(int, WS_TKR) + t * 4;
#pragma unroll
    for (int k = 0; k < 4; ++k) { const int e = te[k], rk = tr[k]; const size_t rowi = (size_t)tab[e] * 256 + rk;
        GAS unsigned* o4 = (GAS unsigned*)(WSP(unsigned char, WS_HS) + rowi * 2048) + lane;
#pragma unroll
        for (int j = 0; j < 8; ++j) o4[64 * j] = w[j]; }
}
__device__ __forceinline__ void p12_combine_token(Frame& F, float* out, int t) {
    const int lane = F.lane; const LAS int* tab = (const LAS int*)(F.lds + LTAB_OFF);
    const GAS u32x2* xr = (const GAS u32x2*)(WSP(bf16, WS_X1) + (size_t)t * 2048) + lane;
    f32x4 v[8];
#pragma unroll
    for (int j = 0; j < 8; ++j) { const u32x2 xw = xr[64 * j]; v[j].x = bflo(xw.x); v[j].y = bfhi(xw.x); v[j].z = bflo(xw.y); v[j].w = bfhi(xw.y); }
    const GAS int* te = (const GAS int*)WSP(int, WS_TKE) + t * 4; const GAS int* tr = (const GAS int*)WSP(int, WS_TKR) + t * 4; const GAS float* tg = (const GAS float*)WSP(float, WS_TKG) + t * 4;
#pragma unroll
    for (int k = 0; k < 4; ++k) { const int e = te[k], rk = tr[k]; const float g = tg[k]; const size_t rowi = (size_t)tab[e] * 256 + rk;
        const GAS unsigned* y4 = (const GAS unsigned*)(WSP(unsigned char, WS_Y) + rowi * 2048) + lane;
#pragma unroll
        for (int j = 0; j < 8; ++j) { const int yw = (int)y4[64 * j]; const f32x2 lo = __builtin_amdgcn_cvt_pk_f32_fp8(yw, false), hh = __builtin_amdgcn_cvt_pk_f32_fp8(yw, true);
            v[j].x += g * lo[0]; v[j].y += g * lo[1]; v[j].z += g * hh[0]; v[j].w += g * hh[1]; } }
    GAS f32x4* o = (GAS f32x4*)(out + (size_t)t * 2048) + lane;
#pragma unroll
    for (int j = 0; j < 8; ++j) o[64 * j] = v[j];
}

struct Args { const float* in[33]; float* out; unsigned char* ws; };
__global__ void __launch_bounds__(NWAVES * 64, 2) mk_fwd(Args args) {
    extern __shared__ __attribute__((aligned(16))) unsigned char lds[];
    Frame F;
    F.lds = (LAS unsigned char*)lds;
    F.MISC = (volatile LAS unsigned*)(F.lds + MISC_OFF);
    F.tid = threadIdx.x; F.lane = F.tid & 63; F.wave = __builtin_amdgcn_readfirstlane(F.tid >> 6);
    F.G = gridDim.x; { const int bx = blockIdx.x; F.vcu = (F.G % 8 == 0) ? (bx % 8) * (F.G / 8) + bx / 8 : bx; }
    F.ws = args.ws; F.ctl = (gu32*)(args.ws + WS_CTL);
    const float* const* in = args.in;
    for (int u = F.tid; u < (LDS_BYTES - LDSCTL_OFF) / 4; u += NWAVES * 64) ((LAS unsigned*)(F.lds + LDSCTL_OFF))[u] = 0u;
    __syncthreads();
#define PHASE_SEAM() do { xcd_barrier(bar); int l_ = pg8::pg8_lane(); asm volatile("" : "+v"(l_)); F.lane = l_; F.tid = F.wave * 64 + l_; } while (0)
    XcdBarrier bar = xcd_barrier_post((unsigned*)(F.ctl + CW_BAR), F.MISC + 8);
    const int gw = F.vcu * NWAVES + F.wave, NGW = F.G * NWAVES;
    typedef pg8::bf16_t pbf;

    for (int rep = 0; rep < REP_P0; ++rep) p0_prologue<0>(F, in);
    PHASE_SEAM();

    for (int rep = 0; rep < REP_P1; ++rep)
    {   pg8::Gemm g{WSP(pbf, WS_H), WSP(pbf, WS_W1T), T + MEMROWS, P1N + 2048, 2048, HPITCH, HPITCH};
        pg8::EpiP1 E{WSP(pbf, WS_P1), WSP(pbf, WS_MKV), in[6]};
        const int slot = (CONV_IN_P1 && (!ATTN_SPLIT || SPLIT_NOCONV) && rep == 0) ? (F.vcu % (GATE_F8 ? 5 : 10)) : 0;
        if (!(UV_F8 == 1 && GATE_F8))
        {   pg8::P1Order S; S.init(F.G, (int)blockIdx.x, 0, slot);
            pg8::gemm_phase<pg8::EpiP1, pg8::P1Order, GEMM_ALIGN, true>(F.lds + RING_OFF, g, S, E, F.wave); }
        if (CONV_IN_P1 && (!ATTN_SPLIT || SPLIT_NOCONV) && rep == 0) { __syncthreads(); if (CONV_DMA == 2) moe_convert_share_dma256(F, in); else if (CONV_DMA) moe_convert_share_dma(F, in); else moe_convert_share<0>(F, in); if (REP_CONV > 1) moe_convert_share<1>(F, in); }
        if (!(UV_F8 == 1 && GATE_F8))
        {   pg8::P1Order S; S.init(F.G, (int)blockIdx.x, slot, 1 << 20);
            pg8::gemm_phase<pg8::EpiP1, pg8::P1Order, GEMM_ALIGN, true>(F.lds + RING_OFF, g, S, E, F.wave); }
        if (GATE_F8) {
            pg8::Gemm g8{WSP(pbf, WS_H8), WSP(pbf, WS_WG8) - (size_t)8 * 256 * 1024, T + MEMROWS, 41 * 256, 1024, 1024, 1024, MOE_SW, MOE_SX};
            pg8::GateOrder SG; SG.init(F.G, (int)blockIdx.x);
            pg8::gemm_phase<pg8::EpiP1, pg8::GateOrder, GEMM_ALIGN, true, true, 0, (KROT_MASK & 4) != 0>(F.lds + RING_OFF, g8, SG, E, F.wave); }
        if (GATE_F8 && PRO_SPLIT == 1 && UV_F8 == 2 && rep == 0 && blockIdx.x >= 96) p0_prologue<1>(F, in, (int)blockIdx.x - 96, 160);
        if (GATE_F8 && PRO_SPLIT == 2 && UV_F8 == 2 && rep == 0 && blockIdx.x >= 224) p0_prologue<1>(F, in, (int)blockIdx.x - 224, 32);
        if (GATE_F8 && CONV_OFFLOAD && UV_F8 == 2 && rep == 0 && blockIdx.x >= 96 && blockIdx.x < 96 + CONV_OFF_CUS) {
            const int k0 = (CONV_NSUP - CONV_OFF) + 8 * ((int)blockIdx.x - 96);
            moe_convert_range256<8>(F, in, F.wave, (LAS unsigned*)(F.lds + RING_OFF + F.wave * 16640), F.lane, k0, k0 + 8); }
    }
    PHASE_SEAM();

    for (int rep = 0; rep < REP_P2; ++rep)
    for (int t = gw; t < T; t += NGW) p2_token(F, in, t);
    for (int m = gw; m < MEMROWS; m += NGW) p2_memrow(F, in, m);
    PHASE_SEAM();

    for (int rep = 0; rep < REP_P3; ++rep) {
    {   pg8::Gemm g{WSP(pbf, WS_CQN), WSP(pbf, WS_WUQT), T, 4096, 256, 256, 256, UP_SW, MOE_SX};
        pg8::StaticOrder S; S.init(T, 4096, F.G, (int)blockIdx.x);
#if ATTN_F8
        pg8::EpiQ8 E{(LAS float*)(F.lds + LEPI_OFF), in[16], WSP(float, WS_ROPE), WSP(unsigned char, WS_QF), MLA_QSCALE * 16.0f};
        pg8::gemm_phase<pg8::EpiQ8, pg8::StaticOrder, true, true, true>(F.lds + RING_OFF, g, S, E, F.wave);
#else
        pg8::EpiQ E{(LAS float*)(F.lds + LEPI_OFF), in[16], WSP(float, WS_ROPE), WSP(pbf, WS_QF), MLA_QSCALE};
        pg8::gemm_phase<pg8::EpiQ, pg8::StaticOrder, true, true, true>(F.lds + RING_OFF, g, S, E, F.wave);
#endif
    }
    {   pg8::Gemm g{WSP(pbf, WS_CKVN), WSP(pbf, WS_WUKVT), T, 4096, 256, 256, 256, UP_SW, MOE_SX};
        pg8::StaticOrder S; S.init(T, 4096, F.G, (int)blockIdx.x);
#if ATTN_F8
        pg8::EpiKV8 E{(LAS float*)(F.lds + LEPI_OFF), in[17], WSP(float, WS_KRSS), WSP(float, WS_KRR), WSP(unsigned char, WS_KFT), WSP(unsigned char, WS_VFT)};
        pg8::gemm_phase<pg8::EpiKV8, pg8::StaticOrder, true, true, true>(F.lds + RING_OFF, g, S, E, F.wave);
#else
        pg8::EpiKV E{(LAS float*)(F.lds + LEPI_OFF), in[17], WSP(float, WS_KRSS), WSP(float, WS_KRR), WSP(pbf, WS_KFT), WSP(pbf, WS_VFT)};
        pg8::gemm_phase<pg8::EpiKV, pg8::StaticOrder, true, true, true>(F.lds + RING_OFF, g, S, E, F.wave);
#endif
    }
    __syncthreads();
    for (int u = F.vcu; u < 1024; u += F.G) gmlp_unit(F, in, u);
    for (int u = F.vcu; u < 512; u += F.G) {
        const int half = u & 1, qb = (u >> 1) & 15, bh = u >> 5;
        const bf16* Q = WSP(bf16, WS_QMN) + ((size_t)bh * 4096 + qb * 256 + 32 * F.wave) * 256;
        const bf16* Kt = WSP(bf16, WS_MKT) + (size_t)bh * 4 * (32 * 64 * 8);
        const bf16* Vt = WSP(bf16, WS_MVT) + (size_t)(bh * 2 + half) * 4 * (4 * 64 * 32);
        unsigned char* O = WSP(unsigned char, WS_ABC) + ((size_t)(bh >> 2) * 4096 + qb * 256 + 32 * F.wave) * ABC_ROWB + ABC_CB + (bh & 3) * 256 + half * 128;
        attn_unit<256, 2, false>(F.lds + RING_OFF, Q, 256, Kt, Vt, 4, 0, O, ABC_ROWB, F.wave, F.lane);
    }
    }
    PHASE_SEAM();

#if ATTN_SPLIT
    {   const int s = F.vcu & 3;
#if !(ATTN_XCDMAP && ATTN_RB2)
        const int bh = F.vcu >> 2;
#endif
        constexpr int NIT = NE * 32 * 64 + NE * 32 * 32;
        ConvState cs; cs.lo = F.vcu * (NIT / 256); cs.cw = F.wave - 4; cs.c = -1;
        { const int nitems = (NIT / 256 - cs.cw + 3) / 4; cs.nchunks = (F.wave >= 4 && !SPLIT_NOCONV) ? nitems * 4 : 0; }
        LAS unsigned char* cbase = F.lds + RING_OFF + (ATT_PAIR && ATTN_RB2 ? 81920 : 61440) + (F.wave - 4) * 16640;
#if ATTN_RB2
#if ATTN_XCDMAP
#define P5_UNIT(i_) const int s16 = F.vcu & 15, s8 = (s16 + 8) & 15, qb = ((i_) == 0) ? s16 : ((i_) == 1) ? 15 - s16 : ((i_) == 2) ? s8 : 15 - s8, nt = 4 * (qb + 1), \
        bh = 8 * (F.vcu >> 5) + 2 * (i_) + ((F.vcu >> 4) & 1)
#else
#define P5_UNIT(i_) const int qb = ((i_) == 0) ? s : ((i_) == 1) ? 7 - s : ((i_) == 2) ? 8 + s : 15 - s, nt = 4 * (qb + 1)
#endif
#if ATT_REBAL
        LAS unsigned* bctr = (LAS unsigned*)(F.lds + MISC_OFF + 64);
        if (F.tid == 0) { bctr[0] = 0u; bctr[1] = 0u; }
        __syncthreads();
        const unsigned char* Kt = WSP(unsigned char, WS_KFT) + (size_t)bh * 64 * 12288;
        const unsigned char* Vt = WSP(unsigned char, WS_VFT) + (size_t)bh * 64 * 8192;
        if (F.wave < 4) {
            unsigned nbar = 0;
            const int nu = (s == 0) ? 2 : 3;
            for (int i = 0; i < nu; ++i) {
                const int qb = (s == 0) ? (i == 0 ? 15 : 13) : (s == 1) ? (i == 0 ? 14 : i == 1 ? 8 : 5) : (s == 2) ? (i == 0 ? 12 : i == 1 ? 9 : 6) : (i == 0 ? 11 : i == 1 ? 10 : 7);
                const unsigned char* Q = WSP(unsigned char, WS_QF) + ((size_t)bh * 4096 + qb * 256 + 32 * F.wave) * 192;
                unsigned char* O = WSP(unsigned char, WS_ABC) + ((size_t)(bh >> 4) * 4096 + qb * 256 + 32 * F.wave) * ABC_ROWB + ABC_BB + (bh & 15) * 128;
                attn8_unit2<true>(F.lds + RING_OFF, Q, Kt, Vt, 4 * (qb + 1), qb * 256 + 32 * F.wave, O, ABC_ROWB, F.wave, F.lane, bctr, nbar); }
        } else {
            moe_convert_share_w256<4>(F, in, F.wave - 4, (LAS unsigned*)cbase, F.lane);
            asm volatile("s_waitcnt vmcnt(0) lgkmcnt(0)" ::: "memory");
            unsigned nbar2 = 0; const int cw = F.wave - 4;
            att_bar4(bctr + 1, nbar2, F.lane);
            const int nu = (s == 3) ? 4 : 2;
            for (int i = 0; i < nu; ++i) {
                const int qh = (s == 0) ? (i == 0 ? 9 : 3) : (s == 1) ? (i == 0 ? 8 : 4) : (s == 2) ? (i == 0 ? 7 : 5) : (i == 0 ? 6 : i == 1 ? 2 : i == 2 ? 1 : 0);
                const unsigned char* Q = WSP(unsigned char, WS_QF) + ((size_t)bh * 4096 + qh * 128 + 32 * cw) * 192;
                unsigned char* O = WSP(unsigned char, WS_ABC) + ((size_t)(bh >> 4) * 4096 + qh * 128 + 32 * cw) * ABC_ROWB + ABC_BB + (bh & 15) * 128;
                attn8_unit<true, 4>(F.lds + RING_OFF + 61440, Q, Kt, Vt, 2 * (qh + 1), qh * 128 + 32 * cw, O, ABC_ROWB, cw, F.lane, bctr + 1, &nbar2); }
        }
#else
        LAS unsigned* bctr = (LAS unsigned*)(F.lds + MISC_OFF + 64);
        if (F.tid == 0) *bctr = 0u;
        __syncthreads();
        if (F.wave < 4) {
            unsigned nbar = 0;
            for (int rep = 0; rep < REP_P5; ++rep)
            for (int i = 0; i < 4; ++i) { P5_UNIT(i);
                const unsigned char* Q = WSP(unsigned char, WS_QF) + ((size_t)bh * 4096 + qb * 256 + 32 * F.wave) * 192;
                const unsigned char* Kt = WSP(unsigned char, WS_KFT) + (size_t)bh * 64 * 12288;
                const unsigned char* Vt = WSP(unsigned char, WS_VFT) + (size_t)bh * 64 * 8192;
                unsigned char* O = WSP(unsigned char, WS_ABC) + ((size_t)(bh >> 4) * 4096 + qb * 256 + 32 * F.wave) * ABC_ROWB + ABC_BB + (bh & 15) * 128;
                attn8_unit2<true>(F.lds + RING_OFF, Q, Kt, Vt, nt, qb * 256 + 32 * F.wave, O, ABC_ROWB, F.wave, F.lane, bctr, nbar); }
        } else {
#if !SPLIT_FREE
            int it = 0;
            for (int i = 0; i < 4; ++i) { P5_UNIT(i);
                for (int j = 0; j < nt; ++j, ++it) { conv_steps<4>(F, in, cs, cbase, 3, F.lane); __builtin_amdgcn_s_barrier(); asm volatile("" ::: "memory"); }
                __builtin_amdgcn_s_barrier(); asm volatile("" ::: "memory"); }
#endif
#if SPLIT_FREE == 2
            for (int rep = 0; rep < REP_CONV; ++rep) { if (CONV_ROWS == 256) moe_convert_share_w256<4>(F, in, F.wave - 4, (LAS unsigned*)cbase, F.lane); else moe_convert_share_w<4>(F, in, F.wave - 4, (LAS unsigned*)cbase, F.lane); }
            asm volatile("s_waitcnt vmcnt(0)" ::: "memory");
#else
            for (int rep = 0; rep < REP_CONV; ++rep) { cs.c = -1; conv_steps<4>(F, in, cs, cbase, 1 << 20, F.lane); asm volatile("s_waitcnt vmcnt(0)" ::: "memory"); }
#endif
        }
#endif
#undef P5_UNIT
#else
#define P5_UNIT(i_) const int qb = (((i_) >> 1) == 0) ? s : (((i_) >> 1) == 1) ? 7 - s : (((i_) >> 1) == 2) ? 8 + s : 15 - s, qh = 2 * qb + ((i_) & 1), nt = 2 * (qh + 1)
        if (F.wave < 4) {
            __builtin_amdgcn_s_setprio(SPLIT_PRIO);
            for (int i = 0; i < 8; ++i) { P5_UNIT(i);
                const unsigned char* Q = WSP(unsigned char, WS_QF) + ((size_t)bh * 4096 + qh * 128 + 32 * F.wave) * 192;
                const unsigned char* Kt = WSP(unsigned char, WS_KFT) + (size_t)bh * 64 * 12288;
                const unsigned char* Vt = WSP(unsigned char, WS_VFT) + (size_t)bh * 64 * 8192;
                unsigned char* O = WSP(unsigned char, WS_ABC) + ((size_t)(bh >> 4) * 4096 + qh * 128 + 32 * F.wave) * ABC_ROWB + ABC_BB + (bh & 15) * 128;
                attn8_unit<true, 4>(F.lds + RING_OFF, Q, Kt, Vt, nt, qh * 128 + 32 * F.wave, O, ABC_ROWB, F.wave, F.lane); }
            __builtin_amdgcn_s_setprio(0);
        } else {
            int it = 0;
            for (int i = 0; i < 8; ++i) { P5_UNIT(i);
                for (int j = 0; j < nt; ++j, ++it) { conv_steps<4>(F, in, cs, cbase, CONV_QUOTA(it), F.lane); __builtin_amdgcn_s_barrier(); asm volatile("" ::: "memory"); }
                __builtin_amdgcn_s_barrier(); asm volatile("" ::: "memory"); }
            conv_steps<4>(F, in, cs, cbase, 1 << 20, F.lane); asm volatile("s_waitcnt vmcnt(0)" ::: "memory");
        }
#undef P5_UNIT
#endif
        __syncthreads();
    }
    PHASE_SEAM();

#else
    for (int rep = 0; rep < REP_P5; ++rep)
    {   const int bh = F.vcu >> 2, s = F.vcu & 3;
        for (int i = 0; i < 4; ++i) {
            if (!CONV_IN_P1 && rep == 0 && i == ((F.vcu >> 2) & 3)) { moe_convert_share<0>(F, in); if (REP_CONV > 1) moe_convert_share<1>(F, in); }
            const int qb = (i == 0) ? s : (i == 1) ? 7 - s : (i == 2) ? 8 + s : 15 - s;
#if ATTN_F8
            const unsigned char* Q = WSP(unsigned char, WS_QF) + ((size_t)bh * 4096 + qb * 256 + 32 * F.wave) * 192;
            const unsigned char* Kt = WSP(unsigned char, WS_KFT) + (size_t)bh * 64 * 12288;
            const unsigned char* Vt = WSP(unsigned char, WS_VFT) + (size_t)bh * 64 * 8192;
            unsigned char* O = WSP(unsigned char, WS_ABC) + ((size_t)(bh >> 4) * 4096 + qb * 256 + 32 * F.wave) * ABC_ROWB + ABC_BB + (bh & 15) * 128;
            attn8_unit<true>(F.lds + RING_OFF, Q, Kt, Vt, 4 * (qb + 1), qb * 256 + 32 * F.wave, O, ABC_ROWB, F.wave, F.lane);
#else
            const bf16* Q = WSP(bf16, WS_QF) + ((size_t)bh * 4096 + qb * 256 + 32 * F.wave) * 192;
            const bf16* Kt = WSP(bf16, WS_KFT) + (size_t)bh * 64 * (24 * 64 * 8);
            const bf16* Vt = WSP(bf16, WS_VFT) + (size_t)bh * 64 * (4 * 64 * 32);
            unsigned char* O = WSP(unsigned char, WS_ABC) + ((size_t)(bh >> 4) * 4096 + qb * 256 + 32 * F.wave) * ABC_ROWB + ABC_BB + (bh & 15) * 128;
            attn_unit<192, 3, true>(F.lds + RING_OFF, Q, 192, Kt, Vt, 4 * (qb + 1), qb * 256 + 32 * F.wave, O, ABC_ROWB, F.wave, F.lane);
#endif
        }
    }
    PHASE_SEAM();

#endif
    for (int rep = 0; rep < REP_P6; ++rep)
    {   pg8::Gemm g{WSP(pbf, WS_ABC), WSP(pbf, WS_WPT), T, 2048, ABC_LD, ABC_LD, ABC_LD, MOE_SW, ATT_OSB};
        pg8::StaticOrder S; S.init(T, 2048, F.G, (int)blockIdx.x);
        pg8::EpiMergedT<16, 32> E{WSP(pbf, WS_P1), WSP(pbf, WS_MERGED)};
        pg8::gemm_phase<pg8::EpiMergedT<16, 32>, pg8::StaticOrder, GEMM_ALIGN, true, false, 16>(F.lds + RING_OFF, g, S, E, F.wave);
    }
    PHASE_SEAM();

    for (int rep = 0; rep < REP_P7; ++rep)
    {   pg8::Gemm g{WSP(pbf, WS_MERGED), WSP(pbf, WS_WOT), T, 2048, 2048, 2048, 2048};
        pg8::StaticOrder S; S.init(T, 2048, F.G, (int)blockIdx.x);
        pg8::EpiX1 E{in[0], WSP(pbf, WS_X1)};
        pg8::gemm_phase<pg8::EpiX1, pg8::StaticOrder, P7_ALIGN, true>(F.lds + RING_OFF, g, S, E, F.wave);
    }
    PHASE_SEAM();

    p8_router(F, in);
    PHASE_SEAM();

    build_moe_tab(F);
    for (int rep = 0; rep < REP_P9; ++rep)
    for (int t = gw; t < T; t += NGW) p9_scatter_token(F, in, t);
    PHASE_SEAM();

    for (int rep = 0; rep < REP_P10; ++rep)
    {   pg8::Gemm g{WSP(pbf, WS_HS), WSP(pbf, WS_WGUT), MAXSLOT, NE * 4096, 1024, 1024, 1024, MOE_SW, MOE_SX};
        pg8::MoeOrder S{(const LAS int*)(F.lds + LTAB_OFF), 16, (int)(blockIdx.x & 7), (int)(blockIdx.x >> 3)};
        pg8::EpiSwiGLU E{in[30], WSP(unsigned char, WS_ACT)};
#if P10_PROBE
        if (rep > 0) { pg8::EpiSwiGLUProbe<P10_PROBE> EP; EP.bgu = E.bgu; EP.ACT = E.ACT;
            pg8::gemm_phase<pg8::EpiSwiGLUProbe<P10_PROBE>, pg8::MoeOrder, GEMM_ALIGN, true, true>(F.lds + RING_OFF, g, S, EP, F.wave); }
        else
#endif
        pg8::gemm_phase<pg8::EpiSwiGLU, pg8::MoeOrder, GEMM_ALIGN, true, true, 0, (KROT_MASK & 1) != 0, (PFETCH_MASK & 1) != 0>(F.lds + RING_OFF, g, S, E, F.wave);
    }
    PHASE_SEAM();

    for (int rep = 0; rep < REP_P11; ++rep)
    {   pg8::Gemm g{WSP(pbf, WS_ACT), WSP(pbf, WS_WDT), MAXSLOT, NE * 2048, 1024, 1024, 1024, MOE_SW, MOE_SX};
        pg8::MoeOrder S{(const LAS int*)(F.lds + LTAB_OFF), 8, (int)(blockIdx.x & 7), (int)(blockIdx.x >> 3)};
        pg8::EpiDown E{in[32], WSP(unsigned char, WS_Y)};
        pg8::gemm_phase<pg8::EpiDown, pg8::MoeOrder, GEMM_ALIGN, true, true, 0, (KROT_MASK & 2) != 0>(F.lds + RING_OFF, g, S, E, F.wave);
    }
    PHASE_SEAM();

    for (int rep = 0; rep < REP_P12; ++rep)
    for (int t = gw; t < T; t += NGW) p12_combine_token(F, args.out, t);
}

extern "C" void kernel_launch(void* const* d_in, const int* in_sizes, int n_in, void* d_out, int out_size, void* d_ws, size_t ws_size, hipStream_t stream) {
    static int grid = 0;
    if (grid == 0) {
        if (n_in != 33 || out_size != T * D || ws_size < WS_END) { fprintf(stderr, "kernel_launch: unexpected problem (n_in %d out %d ws %zu need %zu)\n", n_in, out_size, ws_size, (size_t)WS_END); grid = -1; return; }
        (void)in_sizes;
        if (hipFuncSetAttribute((const void*)mk_fwd, hipFuncAttributeMaxDynamicSharedMemorySize, LDS_BYTES) != hipSuccess) { fprintf(stderr, "kernel_launch: hipFuncSetAttribute failed\n"); grid = -1; return; }
        int per_cu = 0;
        if (hipOccupancyMaxActiveBlocksPerMultiprocessor(&per_cu, (const void*)mk_fwd, NWAVES * 64, LDS_BYTES) != hipSuccess || per_cu < 1) fprintf(stderr, "kernel_launch: occupancy query reports %d\n", per_cu);
        (void)hipGetLastError();
        grid = 256;
    }
    if (grid < 0) return;
    if (hipMemsetAsync((char*)d_ws + WS_CTL, 0, CTL_ZERO_BYTES, stream) != hipSuccess) { fprintf(stderr, "kernel_launch: memset failed\n"); return; }
    Args a{};
    for (int i = 0; i < 33; ++i) a.in[i] = (const float*)d_in[i];
    a.out = (float*)d_out; a.ws = (unsigned char*)d_ws;
    hipLaunchKernelGGL(mk_fwd, dim3(grid), dim3(NWAVES * 64), LDS_BYTES, stream, a);
}
```

```cpp
#include <hip/hip_runtime.h>
#include <cstdio>
#include <cstdint>
#include <cmath>
#ifndef REP_P0
#define REP_P0 1
#endif
#ifndef REP_P1
#define REP_P1 1
#endif
#ifndef REP_P3
#define REP_P3 1
#endif
#ifndef REP_P5
#define REP_P5 1
#endif
#ifndef REP_P6
#define REP_P6 1
#endif
#ifndef REP_P10
#define REP_P10 1
#endif
#ifndef REP_P11
#define REP_P11 1
#endif
#ifndef REP_CONV
#define REP_CONV 1
#endif
#ifndef ATTN_RB2
#define ATTN_RB2 1
#endif
#ifndef SPLIT_FREE
#define SPLIT_FREE 2
#endif
#ifndef CONV_ROWS
#define CONV_ROWS 256
#endif
#ifndef UV_F8
#define UV_F8 2
#endif
#ifndef ATTN_XCDMAP
#define ATTN_XCDMAP 0
#endif
#ifndef P10_PROBE
#define P10_PROBE 0
#endif
#ifndef KROT_MASK
#define KROT_MASK 0
#endif
#ifndef ROUTER_BF16X2
#define ROUTER_BF16X2 1
#endif
#ifndef CONV_OFFLOAD
#define CONV_OFFLOAD 1
#endif
#ifndef STAGE_IN_MMA
#define STAGE_IN_MMA 0
#endif
#ifndef ATT_SLEEP
#define ATT_SLEEP 0
#endif
#ifndef ATT_VPRE
#define ATT_VPRE 0
#endif
#ifndef KSEG_BATCH16
#define KSEG_BATCH16 0
#endif
#ifndef ATT_PAIR
#define ATT_PAIR 1
#endif
#ifndef PFETCH_MASK
#define PFETCH_MASK 0
#endif
#ifndef CONV_SLEEP
#define CONV_SLEEP 0
#endif
#ifndef ATT_REBAL
#define ATT_REBAL 0
#endif
#ifndef ATT_SPLITQK
#define ATT_SPLITQK 1
#endif
#ifndef ATT_DEFER
#define ATT_DEFER 0
#endif
#ifndef PRO_SPLIT
#define PRO_SPLIT 0
#endif
#ifndef ATT_PERMLANE
#define ATT_PERMLANE 1
#endif
#ifndef ATT_POLL_SLEEP
#define ATT_POLL_SLEEP 1
#endif
#ifndef ATT_SPREAD
#define ATT_SPREAD 0
#endif
#ifndef STAGE_AUX
#define STAGE_AUX 0
#endif
#ifndef MOE_MAP2
#define MOE_MAP2 0
#endif
#ifndef ATT_OWIDE
#define ATT_OWIDE 1
#endif
#ifndef XL_FAST
#define XL_FAST 1
#endif
#ifndef EPIX1_BATCH
#define EPIX1_BATCH 0
#endif
#ifndef CNT_SPREAD
#define CNT_SPREAD 1
#endif
#ifndef SPLIT_PRIO
#define SPLIT_PRIO 0
#endif
#ifndef SPLIT_NOCONV
#define SPLIT_NOCONV 0
#endif
#ifndef CONV_QUOTA
#define CONV_QUOTA(it) (1 + ((it) & 1))
#endif
#ifndef ATTN_SPLIT
#define ATTN_SPLIT 1
#endif
#ifndef P7_ALIGN
#define P7_ALIGN true
#endif
#ifndef ATTN_F8
#define ATTN_F8 1
#endif
#ifndef GATE_BF16SPLIT
#define GATE_BF16SPLIT 0
#endif
#ifndef GATE_SKIP
#define GATE_SKIP 0
#endif
#ifndef GATE_F8
#define GATE_F8 1
#endif
#ifndef CONV_DMA
#define CONV_DMA 1
#endif
#ifndef PITCH_PAD
#define PITCH_PAD 0
#endif
#ifndef GEMM_ALIGN
#define GEMM_ALIGN true
#endif
#ifndef CONV_IN_P1
#define CONV_IN_P1 1
#endif
#ifndef REP_P7
#define REP_P7 1
#endif
#ifndef REP_P2
#define REP_P2 1
#endif
#ifndef REP_P4
#define REP_P4 1
#endif
#ifndef REP_P9
#define REP_P9 1
#endif
#ifndef REP_P12
#define REP_P12 1
#endif
constexpr int NWAVES = 8;
constexpr int T = 16384, D = 2048, NBATCH = 4, SEQ = 4096;
constexpr int HPITCH = 2048 + PITCH_PAD;
constexpr int P1N = 10496;
constexpr int P1_U = 0, P1_V = 1024, P1_CQ = 2048, P1_CKV = 2560, P1_QM = 3072, P1_KR = 4096, P1_G = 4352;
constexpr int P1_TILES = 41, MEMROWS = 1024;
constexpr int NH = 16, QKD = 192, NOPE = 128, ROPE = 64, VD = 128;
constexpr int NE = 32, DFF = 2048, MAXBLK = 288, MAXSLOT = MAXBLK * 256;
constexpr float EPS = 1e-6f;
constexpr float LOG2E = 1.4426950408889634f;
constexpr float MLA_QSCALE = 0.07216878364870322f * LOG2E;
constexpr float MEM_QSCALE = 0.0625f * LOG2E;
constexpr float MOE_WSCALE = 64.0f;
constexpr unsigned MOE_SW = 0x79797979u, MOE_SX = 0x7f7f7f7fu;
constexpr float UP_WSCALE = 16.0f;
constexpr unsigned UP_SW = 0x7b7b7b7bu;

constexpr size_t MiB = 1u << 20;
constexpr size_t WS_CTL = 0, CTL_ZERO_BYTES = 1 * MiB;
constexpr size_t WS_W1T   = 1 * MiB;
constexpr size_t WS_WUQT  = WS_W1T + (size_t)(P1N + 2048) * HPITCH * 2;
constexpr size_t WS_WUKVT = WS_WUQT + (size_t)4096 * 512 * 2;
constexpr size_t WS_WPT   = WS_WUKVT + (size_t)4096 * 512 * 2;
constexpr size_t WS_WOT   = WS_WPT + (size_t)2048 * 4096 * 2;
constexpr size_t WS_WGUT  = WS_WOT + (size_t)2048 * 2048 * 2;
constexpr size_t WS_WDT   = WS_WGUT + (size_t)NE * 4096 * 2048 * 2;
constexpr size_t WS_WSM   = WS_WDT + (size_t)NE * 2048 * 2048 * 2;
constexpr size_t WS_RWG   = WS_WSM + (size_t)8 * 128 * 128 * 2;
constexpr size_t WS_H     = WS_RWG + (size_t)2048 * 32 * 4;
constexpr size_t WS_P1    = WS_H + (size_t)(T + MEMROWS) * HPITCH * 2;
constexpr size_t WS_MKV   = WS_P1 + (size_t)T * P1N * 2;
constexpr size_t WS_VSTAT = WS_MKV + (size_t)MEMROWS * 2048 * 2;
constexpr size_t WS_CQN   = WS_VSTAT + (size_t)T * 8;
constexpr size_t WS_CKVN  = WS_CQN + (size_t)T * 512 * 2;
constexpr size_t WS_QMN   = WS_CKVN + (size_t)T * 512 * 2;
constexpr size_t WS_KRR   = WS_QMN + (size_t)T * 1024 * 2;
constexpr size_t WS_KRSS  = WS_KRR + (size_t)T * 64 * 4;
constexpr size_t WS_ROPE  = WS_KRSS + (size_t)T * 4;
constexpr size_t WS_MKT   = WS_ROPE + (size_t)T * 64 * 4;
constexpr size_t WS_MVT   = WS_MKT + (size_t)MEMROWS * 1024 * 2;
constexpr size_t WS_QRAW  = WS_MVT + (size_t)MEMROWS * 1024 * 2;
constexpr size_t WS_KVRAW = WS_QRAW + (size_t)T * 3072 * 2;
constexpr size_t WS_QF    = WS_KVRAW + (size_t)T * 4096 * 2;
constexpr size_t WS_KFT   = WS_QF + (size_t)T * 3072 * 2;
constexpr size_t WS_VFT   = WS_KFT + (size_t)T * 3072 * 2;
constexpr size_t WS_ABC   = WS_VFT + (size_t)T * 2048 * 2;
constexpr int ABC_LD = 2560, ABC_ROWB = 5120, ABC_BB = 2048, ABC_CB = 4096;
constexpr float ATT_OS = 32.0f; constexpr unsigned ATT_OSB = 0x7a7a7a7au;
constexpr size_t WS_MERGED= WS_ABC + (size_t)T * 4096 * 2;
constexpr size_t WS_X1    = WS_MERGED + (size_t)T * 2048 * 2;
constexpr size_t WS_TKE   = WS_X1 + (size_t)T * 2048 * 4;
constexpr size_t WS_TKR   = WS_TKE + (size_t)T * 16;
constexpr size_t WS_TKG   = WS_TKR + (size_t)T * 16;
constexpr size_t WS_HS    = WS_TKG + (size_t)T * 16;
constexpr size_t WS_ACT   = WS_HS + (size_t)MAXSLOT * 2048 * 2;
constexpr size_t WS_Y     = WS_ACT + (size_t)MAXSLOT * 2048 * 2;
constexpr size_t WS_H8    = WS_Y + (size_t)MAXSLOT * 2048 * 2;
constexpr size_t WS_WG8U  = WS_H8 + (size_t)(T + MEMROWS) * 2048;
constexpr size_t WS_WG8   = WS_WG8U + (size_t)8 * 256 * 2048;
constexpr size_t WS_END   = WS_WG8 + (size_t)41 * 256 * 2048;
constexpr int CW_TMO = 0, CW_CODE = 1;
constexpr int CW_CNT = 64, CNT_STRIDE = CNT_SPREAD ? 32 : 1;
constexpr int CW_CNT_OLD_ = 64;
constexpr int CW_BAR = 4096;

constexpr int RING_OFF = 0, RING_BYTES = ATT_PAIR ? 148480 : 133120;
constexpr int LDSCTL_OFF = RING_BYTES, MISC_OFF = LDSCTL_OFF + 320;
constexpr int LTAB_OFF = LDSCTL_OFF + 1024;
constexpr int LEPI_OFF = LDSCTL_OFF + 2048;
constexpr int LDS_BYTES = RING_BYTES + 14336;

#define XL_DPP(v, ctrl) __uint_as_float((unsigned)__builtin_amdgcn_update_dpp(0, (int)__float_as_uint(v), ctrl, 0xf, 0xf, true))
__device__ __forceinline__ float xl_sum16(float v) { v += XL_DPP(v, 0xB1); v += XL_DPP(v, 0x4E); v += XL_DPP(v, 0x141); v += XL_DPP(v, 0x140); return v; }
__device__ __forceinline__ float xl_swap16_sum(float v) { const auto r = __builtin_amdgcn_permlane16_swap(__float_as_uint(v), __float_as_uint(v), false, false); return __uint_as_float(r[0]) + __uint_as_float(r[1]); }
__device__ __forceinline__ float xl_swap32_sum(float v) { const auto r = __builtin_amdgcn_permlane32_swap(__float_as_uint(v), __float_as_uint(v), false, false); return __uint_as_float(r[0]) + __uint_as_float(r[1]); }
__device__ __forceinline__ float xl_swap32_max(float v) { const auto r = __builtin_amdgcn_permlane32_swap(__float_as_uint(v), __float_as_uint(v), false, false); return fmaxf(__uint_as_float(r[0]), __uint_as_float(r[1])); }

#ifndef RSQ_FAST
#define RSQ_FAST 1
#endif
#if RSQ_FAST
#define FAST_RSQ(x) __builtin_amdgcn_rsqf(x)
#else
#define FAST_RSQ(x) (1.0f / sqrtf(x))
#endif
namespace pg8 {
#define PG8_LAS __attribute__((address_space(3)))
typedef unsigned short bf16_t;
typedef short bf16x8 __attribute__((ext_vector_type(8)));
typedef float f32x4 __attribute__((ext_vector_type(4)));
typedef unsigned u32x4 __attribute__((ext_vector_type(4)));
constexpr int BM = 256, BK = 64, HALF = 128, HTB = HALF * BK * 2  , STAGE_BYTES = 8 * HTB, NXCD = 8, WGM = 8;

__host__ __device__ __forceinline__ int lds_byte(int r, int c) { const int st = (r >> 4) * 2 + (c >> 5), rr = r & 15, cc = c & 31, ob = rr * 64 + cc * 2; return st * 1024 + (ob ^ (((ob >> 9) & 1) << 5)); }
__host__ __device__ __forceinline__ void stage_rc(int b, int& R, int& C) { const int st = b / 1024, sb = b % 1024, swz = sb ^ (((sb >> 9) & 1) << 5); R = (st >> 1) * 16 + swz / 64; C = (st & 1) * 32 + (swz % 64) / 2; }
__host__ __device__ __forceinline__ int perm32(int rho) { const int n = rho >> 4, i = rho & 15; return 8 * (i >> 2) + 4 * n + (i & 3); }

__device__ __forceinline__ int pg8_lane() { int l; asm volatile("v_mbcnt_lo_u32_b32 %0, -1, 0\n\tv_mbcnt_hi_u32_b32 %0, -1, %0" : "=v"(l)); return l; }
struct Unit { int pm, pn; int kr = 0; };
typedef int i32x4 __attribute__((ext_vector_type(4)));
typedef int i32x8 __attribute__((ext_vector_type(8)));
struct Gemm { const bf16_t* A; const bf16_t* Bt; int M, N, K, lda, ldb; unsigned sw = 0x7f7f7f7fu, sx = 0x7f7f7f7fu; };

struct StaticOrder {
    int nM, nN, nwg, G, c;
    __host__ __device__ void init(int M, int N, int G_, int c_) { nM = M / BM; nN = N / BM; nwg = nM * nN; G = G_; c = c_; }
    __host__ __device__ bool next(int i, Unit& u) const {
        const long L = (long)i * G + c; if (L >= nwg) return false;
        int wgid = (int)L; { const int q = nwg / NXCD, r = nwg % NXCD, xcd = wgid % NXCD, off = wgid / NXCD; wgid = (xcd < r ? xcd * (q + 1) : r * (q + 1) + (xcd - r) * q) + off; }
        const int nig = WGM * nN, gid = wgid / nig, fm = gid * WGM, gsz = (nM - fm) < WGM ? (nM - fm) : WGM;
        u.pm = fm + ((wgid % nig) % gsz); u.pn = (wgid % nig) / gsz; return true;
    }
    __device__ __forceinline__ void a_ready(const Unit&) const {}
    __device__ __forceinline__ void done(const Unit&) const {}
};

__device__ __forceinline__ unsigned cvt_pk_bf16(float lo, float hi) { unsigned r; asm volatile("v_cvt_pk_bf16_f32 %0, %1, %2" : "=v"(r) : "v"(lo), "v"(hi)); return r; }
typedef float f32x2 __attribute__((ext_vector_type(2)));

template <class E, class = void> struct probe_of { static constexpr int v = 0; };
template <class E> struct probe_of<E, decltype((void)E::PROBE)> { static constexpr int v = E::PROBE; };
template <class Epi, class Sched, bool ALIGN_EPI = false, bool SP2 = false, bool F8 = false, int MIXT = 0, bool KROT = false, bool PFETCH = false>
__device__ __forceinline__ void gemm_phase(PG8_LAS unsigned char* lds, const Gemm g, const Sched& S, const Epi& E, const int wave_) {
    int tid_ = wave_ * 64 + pg8_lane(); asm volatile("" : "+v"(tid_));
    const int tid = tid_, wid = __builtin_amdgcn_readfirstlane(tid >> 6), lane = tid & 63, wr = wid >> 2, wc = wid & 3, fr = lane & 15, fq = lane >> 4;
    const int K = g.K, nt = K / BK;
    unsigned voffA[2], voffB[2];
#pragma unroll
    for (int i = 0; i < 2; ++i) { int R, C; stage_rc(tid * 16 + i * 8192, R, C); const int Rb = Epi::PERM ? ((R & ~31) + perm32(R & 31)) : R;
        voffA[i] = (unsigned)(R * g.lda + C) * 2u; voffB[i] = (unsigned)(Rb * g.ldb + C) * 2u; }
    const size_t kstep = (size_t)(BK * 2);
    const size_t hstepA = (size_t)HALF * g.lda * 2, hstepB = (size_t)HALF * g.ldb * 2;
    const size_t tstepA = 2 * hstepA, tstepB = 2 * hstepB;
    const unsigned ldsw = (unsigned)wid * 1024u;
    unsigned pfoff = 0;
    if constexpr (PFETCH) { const int prow = wid * 32 + (lane & 31); pfoff = (lane < 32) ? (unsigned)(prow * g.lda) * 2u : (unsigned)(prow * g.ldb) * 2u; }
    PG8_LAS unsigned* const pfl = (PG8_LAS unsigned*)(lds + RING_BYTES + 8192 + wid * 256);
#define PG8_PF(baseA_, baseB_) do { if constexpr (PFETCH) { const char* pb_ = (lane < 32) ? (const char*)(baseA_) : (const char*)(baseB_); \
        __builtin_amdgcn_global_load_lds((const unsigned*)(pb_ + pfoff), pfl, 4, 0, 0); } } while (0)
#define PG8_WV1 do { if constexpr (PFETCH) PG8_WAIT_V(9); else PG8_WAIT_V(8); } while (0)
#define PG8_WV2 do { if constexpr (PFETCH) PG8_WAIT_V(10); else PG8_WAIT_V(8); } while (0)
    const int aoff = lds_byte(wr * 64 + fr, fq * 8), boff = lds_byte(wc * 32 + fr, fq * 8);
#define PG8_SA(b, h) (((b) * 2 + (h)) * HTB)
#define PG8_SB(b, h) ((4 + (b) * 2 + (h)) * HTB)
#define PG8_STAGE(bufoff, gbase, voff) do { if constexpr (probe_of<Epi>::v != 3) _Pragma("unroll") for (int _i = 0; _i < 2; ++_i) \
        __builtin_amdgcn_global_load_lds((const unsigned*)((const char*)(gbase) + (voff)[_i]), (PG8_LAS unsigned*)(lds + (bufoff) + ldsw + _i * 8192), 16, 0, STAGE_AUX); } while (0)
#define PG8_LDA(dst, b, h) do { if constexpr (probe_of<Epi>::v != 2) _Pragma("unroll") for (int m = 0; m < 4; ++m) _Pragma("unroll") for (int k = 0; k < 2; ++k) dst[m][k] = *(const PG8_LAS bf16x8*)(lds + PG8_SA(b, h) + aoff + m * 2048 + k * 1024); } while (0)
#define PG8_LDB(dst, b, h) do { if constexpr (probe_of<Epi>::v != 2) _Pragma("unroll") for (int n = 0; n < 2; ++n) _Pragma("unroll") for (int k = 0; k < 2; ++k) dst[n][k] = *(const PG8_LAS bf16x8*)(lds + PG8_SB(b, h) + boff + n * 2048 + k * 1024); } while (0)
#define PG8_MMA(ai, bj, At, Bt) do { __builtin_amdgcn_s_setprio(1); \
        if (F8 || (MIXT > 0 && f8now)) { _Pragma("unroll") for (int m = 0; m < 4; ++m) _Pragma("unroll") for (int n = 0; n < 2; ++n) { \
            const i32x8 a8_ = __builtin_shufflevector(__builtin_bit_cast(i32x4, At[m][0]), __builtin_bit_cast(i32x4, At[m][1]), 0, 1, 2, 3, 4, 5, 6, 7); \
            const i32x8 b8_ = __builtin_shufflevector(__builtin_bit_cast(i32x4, Bt[n][0]), __builtin_bit_cast(i32x4, Bt[n][1]), 0, 1, 2, 3, 4, 5, 6, 7); \
            if constexpr (probe_of<Epi>::v == 0 || probe_of<Epi>::v == 3) asm volatile("v_mfma_scale_f32_16x16x128_f8f6f4 %0, %1, %2, %0, %3, %4 op_sel_hi:[0,0,0]" : "+v"(acc[ai][bj][m][n]) : "v"(b8_), "v"(a8_), "v"(sw_), "v"(sx_)); \
            else asm volatile("" :: "v"(b8_), "v"(a8_)); } } \
        else { _Pragma("unroll") for (int m = 0; m < 4; ++m) _Pragma("unroll") for (int n = 0; n < 2; ++n) _Pragma("unroll") for (int k = 0; k < 2; ++k) \
            acc[ai][bj][m][n] = __builtin_amdgcn_mfma_f32_16x16x32_bf16(Bt[n][k], At[m][k], acc[ai][bj][m][n], 0, 0, 0); } \
        __builtin_amdgcn_s_setprio(0); } while (0)
#define PG8_STAGE1(bufoff, gbase, voff, i_) __builtin_amdgcn_global_load_lds((const unsigned*)((const char*)(gbase) + (voff)[i_]), (PG8_LAS unsigned*)(lds + (bufoff) + ldsw + (i_) * 8192), 16, 0, 0)
#define PG8_MMAS(ai, bj, At, Bt, M0, S0, M1, S1) do { __builtin_amdgcn_s_setprio(1); \
        if (F8 || (MIXT > 0 && f8now)) { _Pragma("unroll") for (int m = 0; m < 4; ++m) { _Pragma("unroll") for (int n = 0; n < 2; ++n) { \
            const i32x8 a8_ = __builtin_shufflevector(__builtin_bit_cast(i32x4, At[m][0]), __builtin_bit_cast(i32x4, At[m][1]), 0, 1, 2, 3, 4, 5, 6, 7); \
            const i32x8 b8_ = __builtin_shufflevector(__builtin_bit_cast(i32x4, Bt[n][0]), __builtin_bit_cast(i32x4, Bt[n][1]), 0, 1, 2, 3, 4, 5, 6, 7); \
            if constexpr (probe_of<Epi>::v == 0 || probe_of<Epi>::v == 3) asm volatile("v_mfma_scale_f32_16x16x128_f8f6f4 %0, %1, %2, %0, %3, %4 op_sel_hi:[0,0,0]" : "+v"(acc[ai][bj][m][n]) : "v"(b8_), "v"(a8_), "v"(sw_), "v"(sx_)); \
            else asm volatile("" :: "v"(b8_), "v"(a8_)); } \
            if (m == (M0)) { PG8_SCHED; S0; PG8_SCHED; } if (m == (M1)) { PG8_SCHED; S1; PG8_SCHED; } } } \
        else { _Pragma("unroll") for (int m = 0; m < 4; ++m) { _Pragma("unroll") for (int n = 0; n < 2; ++n) _Pragma("unroll") for (int k = 0; k < 2; ++k) \
            acc[ai][bj][m][n] = __builtin_amdgcn_mfma_f32_16x16x32_bf16(Bt[n][k], At[m][k], acc[ai][bj][m][n], 0, 0, 0); \
            if (m == (M0)) { PG8_SCHED; S0; PG8_SCHED; } if (m == (M1)) { PG8_SCHED; S1; PG8_SCHED; } } } \
        __builtin_amdgcn_s_setprio(0); } while (0)
#define PG8_WAIT_V(n) asm volatile("s_waitcnt vmcnt(" #n ")" ::: "memory")
#define PG8_WAIT_L(n) asm volatile("s_waitcnt lgkmcnt(" #n ")" ::: "memory")
#define PG8_BAR __builtin_amdgcn_s_barrier()
#define PG8_SCHED __builtin_amdgcn_sched_barrier(0)
    Unit cur, nxt; int ui = 0;
    if (!S.next(0, cur)) return;
    f32x4 acc[2][2][4][2];
#pragma unroll
    for (int a = 0; a < 2; ++a)
#pragma unroll
        for (int b = 0; b < 2; ++b)
#pragma unroll
            for (int m = 0; m < 4; ++m)
#pragma unroll
                for (int n = 0; n < 2; ++n) acc[a][b][m][n] = (f32x4){0.f, 0.f, 0.f, 0.f};
    bf16x8 At[4][2], B0[2][2], B1[2][2];
    if constexpr (probe_of<Epi>::v == 2) {
#pragma unroll
        for (int m = 0; m < 4; ++m)
#pragma unroll
            for (int k = 0; k < 2; ++k) At[m][k] = (bf16x8){0, 0, 0, 0, 0, 0, 0, 0};
#pragma unroll
        for (int n = 0; n < 2; ++n)
#pragma unroll
            for (int k = 0; k < 2; ++k) { B0[n][k] = (bf16x8){0, 0, 0, 0, 0, 0, 0, 0}; B1[n][k] = (bf16x8){0, 0, 0, 0, 0, 0, 0, 0}; }
    }
    const int sw_ = (int)g.sw, sx_ = (int)g.sx;
    const char* cA = (const char*)g.A + (size_t)cur.pm * tstepA; const char* cB = (const char*)g.Bt + (size_t)cur.pn * tstepB;
    const int krs = (KROT && MIXT == 0 && !Epi::KSEG && (nt & 15) == 0) ? (nt >> 3) : 0;
    int ckr = krs * (cur.kr & 7);
    const char* const pA = cA + (size_t)ckr * kstep; const char* const pB = cB + (size_t)ckr * kstep;
    S.a_ready(cur);
    if constexpr (SP2) {
        PG8_STAGE(PG8_SB(0, 0), pB, voffB); PG8_STAGE(PG8_SB(0, 1), pB + hstepB, voffB); PG8_STAGE(PG8_SA(0, 0), pA, voffA); PG8_STAGE(PG8_SA(0, 1), pA + hstepA, voffA);
        if (wr == 1) PG8_BAR;
        PG8_WAIT_V(2); PG8_BAR;
        PG8_STAGE(PG8_SB(1, 0), pB + kstep, voffB); PG8_STAGE(PG8_SA(1, 0), pA + kstep, voffA); PG8_STAGE(PG8_SB(1, 1), pB + hstepB + kstep, voffB);
        PG8_PF(pA + 2 * kstep, pB + 2 * kstep);
        if constexpr (PFETCH) PG8_WAIT_V(7); else PG8_WAIT_V(6);
        PG8_BAR;
    } else {
        PG8_STAGE(PG8_SB(0, 0), pB, voffB); PG8_STAGE(PG8_SA(0, 0), pA, voffA); PG8_STAGE(PG8_SB(0, 1), pB + hstepB, voffB); PG8_STAGE(PG8_SA(0, 1), pA + hstepA, voffA);
        if (wr == 1) PG8_BAR;
        PG8_WAIT_V(4); PG8_BAR;
        PG8_STAGE(PG8_SB(1, 0), pB + kstep, voffB); PG8_STAGE(PG8_SA(1, 0), pA + kstep, voffA); PG8_STAGE(PG8_SB(1, 1), pB + hstepB + kstep, voffB);
        PG8_WAIT_V(6); PG8_BAR;
    }
    for (;;) {
        const bool has_next = S.next(ui + 1, nxt);
        const char* nA = has_next ? (const char*)g.A + (size_t)nxt.pm * tstepA : cA; const char* nB = has_next ? (const char*)g.Bt + (size_t)nxt.pn * tstepB : cB;
        const int nkr = has_next ? krs * (nxt.kr & 7) : ckr;
        for (int t = 0; t < (MIXT > 0 ? MIXT : nt); t += 2) {
            constexpr bool f8now = false; (void)f8now;
            const bool last = (t == nt - 2);
            if constexpr (Epi::KSEG) { if (t == Epi::KSEG_T1 || t == Epi::KSEG_T2) { if constexpr (F8 || MIXT > 0) asm volatile("s_nop 15\n\ts_nop 15" ::: "memory"); E.kseg(acc, cur, t, wr, wc, fr, fq); } }
            int r0 = t + ckr; if (r0 >= nt) r0 -= nt; int r2 = r0 + 2; if (r2 >= nt) r2 -= nt;
            const char* a1 = cA + (size_t)(r0 + 1) * kstep;
            const char* a2 = last ? nA + (size_t)nkr * kstep : cA + (size_t)r2 * kstep; const char* b2 = last ? nB + (size_t)nkr * kstep : cB + (size_t)r2 * kstep;
            const char* a3 = a2 + kstep; const char* b3 = b2 + kstep;
            int r4 = t + 4, k4 = ckr; const char* pfa4 = cA; const char* pfb4 = cB;
            if (r4 >= nt) { r4 -= nt; k4 = nkr; pfa4 = nA; pfb4 = nB; }
            r4 += k4; if (r4 >= nt) r4 -= nt;
            pfa4 += (size_t)r4 * kstep; pfb4 += (size_t)r4 * kstep;
            if (last && has_next) S.a_ready(nxt);
            if constexpr (SP2) {
#if STAGE_IN_MMA
            PG8_LDB(B0, 0, 0); PG8_LDB(B1, 0, 1); PG8_SCHED; PG8_LDA(At, 0, 0);
            PG8_WAIT_V(6); PG8_WAIT_L(0); PG8_BAR;
            PG8_MMAS(0, 0, At, B0, 1, PG8_STAGE1(PG8_SA(1, 1), a1 + hstepA, voffA, 0), 9, (void)0); PG8_MMAS(0, 1, At, B1, 1, PG8_STAGE1(PG8_SA(1, 1), a1 + hstepA, voffA, 1), 9, (void)0); PG8_BAR; PG8_SCHED;
            PG8_LDA(At, 0, 1); PG8_STAGE(PG8_SB(0, 0), b2, voffB);
            PG8_WAIT_V(4); PG8_WAIT_L(0); PG8_BAR;
            PG8_MMAS(1, 0, At, B0, 0, PG8_STAGE1(PG8_SB(0, 1), b2 + hstepB, voffB, 0), 2, PG8_STAGE1(PG8_SB(0, 1), b2 + hstepB, voffB, 1));
            PG8_MMAS(1, 1, At, B1, 0, PG8_STAGE1(PG8_SA(0, 0), a2, voffA, 0), 2, PG8_STAGE1(PG8_SA(0, 0), a2, voffA, 1)); PG8_BAR; PG8_SCHED;
            PG8_LDB(B0, 1, 0); PG8_LDB(B1, 1, 1); PG8_SCHED; PG8_LDA(At, 1, 0);
            PG8_WAIT_V(6); PG8_WAIT_L(0); PG8_BAR;
            PG8_MMAS(0, 0, At, B0, 1, PG8_STAGE1(PG8_SA(0, 1), a2 + hstepA, voffA, 0), 9, (void)0); PG8_MMAS(0, 1, At, B1, 1, PG8_STAGE1(PG8_SA(0, 1), a2 + hstepA, voffA, 1), 9, (void)0); PG8_BAR; PG8_SCHED;
            PG8_LDA(At, 1, 1); PG8_STAGE(PG8_SB(1, 0), b3, voffB);
            PG8_WAIT_V(4); PG8_WAIT_L(0); PG8_BAR;
            PG8_MMAS(1, 0, At, B0, 0, PG8_STAGE1(PG8_SB(1, 1), b3 + hstepB, voffB, 0), 2, PG8_STAGE1(PG8_SB(1, 1), b3 + hstepB, voffB, 1));
            PG8_MMAS(1, 1, At, B1, 0, PG8_STAGE1(PG8_SA(1, 0), a3, voffA, 0), 2, PG8_STAGE1(PG8_SA(1, 0), a3, voffA, 1)); PG8_BAR; PG8_SCHED;
#else
            PG8_LDB(B0, 0, 0); PG8_LDB(B1, 0, 1); PG8_SCHED; PG8_LDA(At, 0, 0); PG8_STAGE(PG8_SA(1, 1), a1 + hstepA, voffA);
            PG8_WV1; PG8_WAIT_L(0); PG8_BAR; PG8_MMA(0, 0, At, B0); PG8_MMA(0, 1, At, B1); PG8_BAR; PG8_SCHED;
            PG8_LDA(At, 0, 1); PG8_STAGE(PG8_SB(0, 0), b2, voffB); PG8_STAGE(PG8_SB(0, 1), b2 + hstepB, voffB); PG8_STAGE(PG8_SA(0, 0), a2, voffA); PG8_PF(pfa4, pfb4);
            PG8_WV2; PG8_WAIT_L(0); PG8_BAR; PG8_MMA(1, 0, At, B0); PG8_MMA(1, 1, At, B1); PG8_BAR; PG8_SCHED;
            PG8_LDB(B0, 1, 0); PG8_LDB(B1, 1, 1); PG8_SCHED; PG8_LDA(At, 1, 0); PG8_STAGE(PG8_SA(0, 1), a2 + hstepA, voffA);
            PG8_WV1; PG8_WAIT_L(0); PG8_BAR; PG8_MMA(0, 0, At, B0); PG8_MMA(0, 1, At, B1); PG8_BAR; PG8_SCHED;
            PG8_LDA(At, 1, 1); PG8_STAGE(PG8_SB(1, 0), b3, voffB); PG8_STAGE(PG8_SB(1, 1), b3 + hstepB, voffB); PG8_STAGE(PG8_SA(1, 0), a3, voffA); PG8_PF(pfa4 + kstep, pfb4 + kstep);
            PG8_WV2; PG8_WAIT_L(0); PG8_BAR; PG8_MMA(1, 0, At, B0); PG8_MMA(1, 1, At, B1); PG8_BAR; PG8_SCHED;
#endif
            } else {
            PG8_LDB(B0, 0, 0); PG8_SCHED; PG8_LDA(At, 0, 0); PG8_STAGE(PG8_SA(1, 1), a1 + hstepA, voffA);
            PG8_WAIT_L(8); PG8_BAR; PG8_WAIT_L(0); PG8_MMA(0, 0, At, B0); PG8_BAR; PG8_SCHED;
            PG8_LDB(B1, 0, 1); PG8_STAGE(PG8_SB(0, 0), b2, voffB);
            PG8_BAR; PG8_WAIT_L(0); PG8_MMA(0, 1, At, B1); PG8_BAR;
            PG8_LDA(At, 0, 1); PG8_STAGE(PG8_SA(0, 0), a2, voffA);
            PG8_BAR; PG8_WAIT_L(0); PG8_MMA(1, 0, At, B0); PG8_BAR; PG8_SCHED;
            PG8_STAGE(PG8_SB(0, 1), b2 + hstepB, voffB);
            PG8_WAIT_V(6); PG8_BAR; PG8_MMA(1, 1, At, B1); PG8_BAR;
            PG8_LDB(B0, 1, 0); PG8_SCHED; PG8_LDA(At, 1, 0); PG8_STAGE(PG8_SA(0, 1), a2 + hstepA, voffA);
            PG8_WAIT_L(8); PG8_BAR; PG8_WAIT_L(0); PG8_MMA(0, 0, At, B0); PG8_BAR; PG8_SCHED;
            PG8_LDB(B1, 1, 1); PG8_STAGE(PG8_SB(1, 0), b3, voffB);
            PG8_BAR; PG8_WAIT_L(0); PG8_MMA(0, 1, At, B1); PG8_BAR;
            PG8_LDA(At, 1, 1); PG8_STAGE(PG8_SA(1, 0), a3, voffA);
            PG8_BAR; PG8_WAIT_L(0); PG8_MMA(1, 0, At, B0); PG8_BAR; PG8_SCHED;
            PG8_STAGE(PG8_SB(1, 1), b3 + hstepB, voffB);
            PG8_WAIT_V(6); PG8_BAR; PG8_MMA(1, 1, At, B1); PG8_BAR;
            }
                }
        if constexpr (MIXT > 0) for (int t = MIXT; t < nt; t += 2) {
            constexpr bool f8now = true; (void)f8now;
            const bool last = (t == nt - 2);
            if constexpr (Epi::KSEG) { if (t == Epi::KSEG_T1 || t == Epi::KSEG_T2) { if constexpr (F8 || MIXT > 0) asm volatile("s_nop 15\n\ts_nop 15" ::: "memory"); E.kseg(acc, cur, t, wr, wc, fr, fq); } }
            int r0 = t + ckr; if (r0 >= nt) r0 -= nt; int r2 = r0 + 2; if (r2 >= nt) r2 -= nt;
            const char* a1 = cA + (size_t)(r0 + 1) * kstep;
            const char* a2 = last ? nA + (size_t)nkr * kstep : cA + (size_t)r2 * kstep; const char* b2 = last ? nB + (size_t)nkr * kstep : cB + (size_t)r2 * kstep;
            const char* a3 = a2 + kstep; const char* b3 = b2 + kstep;
            int r4 = t + 4, k4 = ckr; const char* pfa4 = cA; const char* pfb4 = cB;
            if (r4 >= nt) { r4 -= nt; k4 = nkr; pfa4 = nA; pfb4 = nB; }
            r4 += k4; if (r4 >= nt) r4 -= nt;
            pfa4 += (size_t)r4 * kstep; pfb4 += (size_t)r4 * kstep;
            if (last && has_next) S.a_ready(nxt);
            if constexpr (SP2) {
#if STAGE_IN_MMA
            PG8_LDB(B0, 0, 0); PG8_LDB(B1, 0, 1); PG8_SCHED; PG8_LDA(At, 0, 0);
            PG8_WAIT_V(6); PG8_WAIT_L(0); PG8_BAR;
            PG8_MMAS(0, 0, At, B0, 1, PG8_STAGE1(PG8_SA(1, 1), a1 + hstepA, voffA, 0), 9, (void)0); PG8_MMAS(0, 1, At, B1, 1, PG8_STAGE1(PG8_SA(1, 1), a1 + hstepA, voffA, 1), 9, (void)0); PG8_BAR; PG8_SCHED;
            PG8_LDA(At, 0, 1); PG8_STAGE(PG8_SB(0, 0), b2, voffB);
            PG8_WAIT_V(4); PG8_WAIT_L(0); PG8_BAR;
            PG8_MMAS(1, 0, At, B0, 0, PG8_STAGE1(PG8_SB(0, 1), b2 + hstepB, voffB, 0), 2, PG8_STAGE1(PG8_SB(0, 1), b2 + hstepB, voffB, 1));
            PG8_MMAS(1, 1, At, B1, 0, PG8_STAGE1(PG8_SA(0, 0), a2, voffA, 0), 2, PG8_STAGE1(PG8_SA(0, 0), a2, voffA, 1)); PG8_BAR; PG8_SCHED;
            PG8_LDB(B0, 1, 0); PG8_LDB(B1, 1, 1); PG8_SCHED; PG8_LDA(At, 1, 0);
            PG8_WAIT_V(6); PG8_WAIT_L(0); PG8_BAR;
            PG8_MMAS(0, 0, At, B0, 1, PG8_STAGE1(PG8_SA(0, 1), a2 + hstepA, voffA, 0), 9, (void)0); PG8_MMAS(0, 1, At, B1, 1, PG8_STAGE1(PG8_SA(0, 1), a2 + hstepA, voffA, 1), 9, (void)0); PG8_BAR; PG8_SCHED;
            PG8_LDA(At, 1, 1); PG8_STAGE(PG8_SB(1, 0), b3, voffB);
            PG8_WAIT_V(4); PG8_WAIT_L(0); PG8_BAR;
            PG8_MMAS(1, 0, At, B0, 0, PG8_STAGE1(PG8_SB(1, 1), b3 + hstepB, voffB, 0), 2, PG8_STAGE1(PG8_SB(1, 1), b3 + hstepB, voffB, 1));
            PG8_MMAS(1, 1, At, B1, 0, PG8_STAGE1(PG8_SA(1, 0), a3, voffA, 0), 2, PG8_STAGE1(PG8_SA(1, 0), a3, voffA, 1)); PG8_BAR; PG8_SCHED;
#else
            PG8_LDB(B0, 0, 0); PG8_LDB(B1, 0, 1); PG8_SCHED; PG8_LDA(At, 0, 0); PG8_STAGE(PG8_SA(1, 1), a1 + hstepA, voffA);
            PG8_WV1; PG8_WAIT_L(0); PG8_BAR; PG8_MMA(0, 0, At, B0); PG8_MMA(0, 1, At, B1); PG8_BAR; PG8_SCHED;
            PG8_LDA(At, 0, 1); PG8_STAGE(PG8_SB(0, 0), b2, voffB); PG8_STAGE(PG8_SB(0, 1), b2 + hstepB, voffB); PG8_STAGE(PG8_SA(0, 0), a2, voffA); PG8_PF(pfa4, pfb4);
            PG8_WV2; PG8_WAIT_L(0); PG8_BAR; PG8_MMA(1, 0, At, B0); PG8_MMA(1, 1, At, B1); PG8_BAR; PG8_SCHED;
            PG8_LDB(B0, 1, 0); PG8_LDB(B1, 1, 1); PG8_SCHED; PG8_LDA(At, 1, 0); PG8_STAGE(PG8_SA(0, 1), a2 + hstepA, voffA);
            PG8_WV1; PG8_WAIT_L(0); PG8_BAR; PG8_MMA(0, 0, At, B0); PG8_MMA(0, 1, At, B1); PG8_BAR; PG8_SCHED;
            PG8_LDA(At, 1, 1); PG8_STAGE(PG8_SB(1, 0), b3, voffB); PG8_STAGE(PG8_SB(1, 1), b3 + hstepB, voffB); PG8_STAGE(PG8_SA(1, 0), a3, voffA); PG8_PF(pfa4 + kstep, pfb4 + kstep);
            PG8_WV2; PG8_WAIT_L(0); PG8_BAR; PG8_MMA(1, 0, At, B0); PG8_MMA(1, 1, At, B1); PG8_BAR; PG8_SCHED;
#endif
            } else {
            PG8_LDB(B0, 0, 0); PG8_SCHED; PG8_LDA(At, 0, 0); PG8_STAGE(PG8_SA(1, 1), a1 + hstepA, voffA);
            PG8_WAIT_L(8); PG8_BAR; PG8_WAIT_L(0); PG8_MMA(0, 0, At, B0); PG8_BAR; PG8_SCHED;
            PG8_LDB(B1, 0, 1); PG8_STAGE(PG8_SB(0, 0), b2, voffB);
            PG8_BAR; PG8_WAIT_L(0); PG8_MMA(0, 1, At, B1); PG8_BAR;
            PG8_LDA(At, 0, 1); PG8_STAGE(PG8_SA(0, 0), a2, voffA);
            PG8_BAR; PG8_WAIT_L(0); PG8_MMA(1, 0, At, B0); PG8_BAR; PG8_SCHED;
            PG8_STAGE(PG8_SB(0, 1), b2 + hstepB, voffB);
            PG8_WAIT_V(6); PG8_BAR; PG8_MMA(1, 1, At, B1); PG8_BAR;
            PG8_LDB(B0, 1, 0); PG8_SCHED; PG8_LDA(At, 1, 0); PG8_STAGE(PG8_SA(0, 1), a2 + hstepA, voffA);
            PG8_WAIT_L(8); PG8_BAR; PG8_WAIT_L(0); PG8_MMA(0, 0, At, B0); PG8_BAR; PG8_SCHED;
            PG8_LDB(B1, 1, 1); PG8_STAGE(PG8_SB(1, 0), b3, voffB);
            PG8_BAR; PG8_WAIT_L(0); PG8_MMA(0, 1, At, B1); PG8_BAR;
            PG8_LDA(At, 1, 1); PG8_STAGE(PG8_SA(1, 0), a3, voffA);
            PG8_BAR; PG8_WAIT_L(0); PG8_MMA(1, 0, At, B0); PG8_BAR; PG8_SCHED;
            PG8_STAGE(PG8_SB(1, 1), b3 + hstepB, voffB);
            PG8_WAIT_V(6); PG8_BAR; PG8_MMA(1, 1, At, B1); PG8_BAR;
            }
                }
        if constexpr (ALIGN_EPI) { if (wr == 0) PG8_BAR; }
        if constexpr (F8 || MIXT > 0) asm volatile("s_nop 15\n\ts_nop 15" ::: "memory");
        if constexpr (!Epi::AFTER_DRAIN) { E(acc, cur, wr, wc, fr, fq); S.done(cur); }
        if (!has_next) break;
#pragma unroll
        for (int a = 0; a < 2; ++a)
#pragma unroll
            for (int b = 0; b < 2; ++b)
#pragma unroll
                for (int m = 0; m < 4; ++m)
#pragma unroll
                    for (int n = 0; n < 2; ++n) acc[a][b][m][n] = (f32x4){0.f, 0.f, 0.f, 0.f};
        cur = nxt; cA = nA; cB = nB; ckr = nkr; ++ui;
        if constexpr (ALIGN_EPI) { if (wr == 1) PG8_BAR; }
    }
    PG8_WAIT_V(0);
    if constexpr (!ALIGN_EPI) { if (wr == 0) PG8_BAR; }
    PG8_BAR;
    if constexpr (Epi::AFTER_DRAIN) { E.fused(acc, cur, wr, wc, fr, fq, lds, wid, lane); S.done(cur); }
#undef PG8_SA
#undef PG8_SB
#undef PG8_STAGE
#undef PG8_PF
#undef PG8_WV1
#undef PG8_WV2
#undef PG8_LDA
#undef PG8_LDB
#undef PG8_MMA
#undef PG8_MMAS
#undef PG8_STAGE1
#undef PG8_WAIT_V
#undef PG8_WAIT_L
#undef PG8_BAR
#undef PG8_SCHED
}
}
namespace pg8 {
__device__ __forceinline__ float sigm(float z) { return __builtin_amdgcn_rcpf(1.0f + __builtin_amdgcn_exp2f(-z * 1.4426950408889634f)); }
typedef unsigned u32x2 __attribute__((ext_vector_type(2)));
__device__ __forceinline__ unsigned pk4f8(const f32x4 v) { int r = __builtin_amdgcn_cvt_pk_fp8_f32(v[0], v[1], 0, false); r = __builtin_amdgcn_cvt_pk_fp8_f32(v[2], v[3], r, true); return (unsigned)r; }
__device__ __forceinline__ u32x4 pack8(const f32x4 v0, const f32x4 v1) { u32x4 w; w.x = cvt_pk_bf16(v0[0], v0[1]); w.y = cvt_pk_bf16(v0[2], v0[3]); w.z = cvt_pk_bf16(v1[0], v1[1]); w.w = cvt_pk_bf16(v1[2], v1[3]); return w; }
__device__ __forceinline__ f32x4 bf_lo4(const u32x4 w) { f32x4 r; r[0] = __uint_as_float(w.x << 16); r[1] = __uint_as_float(w.x & 0xffff0000u); r[2] = __uint_as_float(w.y << 16); r[3] = __uint_as_float(w.y & 0xffff0000u); return r; }
__device__ __forceinline__ f32x4 bf_hi4(const u32x4 w) { f32x4 r; r[0] = __uint_as_float(w.z << 16); r[1] = __uint_as_float(w.z & 0xffff0000u); r[2] = __uint_as_float(w.w << 16); r[3] = __uint_as_float(w.w & 0xffff0000u); return r; }


struct EpiP1 {
    static constexpr bool PERM = true, AFTER_DRAIN = false, KSEG = false;
    bf16_t* P1; bf16_t* MKV; const float* bgate;
    __device__ __forceinline__ void operator()(const f32x4 (&acc)[2][2][4][2], const Unit& u, int wr, int wc, int fr, int fq) const {
        const bool mem = u.pn >= 41, gate = (!mem) && u.pn >= 17;
        bf16_t* base = mem ? MKV + (size_t)((u.pm - 64) * BM + wr * 64 + fr) * 2048 + (u.pn - 41) * BM : P1 + (size_t)(u.pm * BM + wr * 64 + fr) * 10496 + u.pn * BM;
        const size_t ldc = mem ? 2048 : 10496;
        base += wc * 32 + 8 * fq;
        f32x4 bv[2][2];
#pragma unroll
        for (int bj = 0; bj < 2; ++bj)
#pragma unroll
            for (int n = 0; n < 2; ++n) bv[bj][n] = gate ? *(const f32x4*)(bgate + (u.pn - 17) * BM + wc * 32 + 8 * fq + bj * HALF + 4 * n) : (f32x4){0.f, 0.f, 0.f, 0.f};
#pragma unroll
        for (int ai = 0; ai < 2; ++ai)
#pragma unroll
            for (int m = 0; m < 4; ++m) { bf16_t* rowp = base + (size_t)(ai * HALF + m * 16) * ldc;
#pragma unroll
                for (int bj = 0; bj < 2; ++bj) { f32x4 v0 = acc[ai][bj][m][0] + bv[bj][0], v1 = acc[ai][bj][m][1] + bv[bj][1];
                    if (gate) {
#pragma unroll
                        for (int i = 0; i < 4; ++i) { v0[i] = sigm(v0[i]); v1[i] = sigm(v1[i]); } }
                    *(u32x4*)(rowp + bj * HALF) = pack8(v0, v1); } }
    }
};
struct EpiGate {
    static constexpr bool PERM = true, AFTER_DRAIN = false, KSEG = false;
    bf16_t* P1; const float* bgate;
    __device__ __forceinline__ void operator()(const f32x4 (&acc)[2][2][4][2], const Unit& u, int wr, int wc, int fr, int fq) const {
        bf16_t* base = P1 + (size_t)(u.pm * BM + wr * 64 + fr) * 10496 + 4352 + u.pn * BM + wc * 32 + 8 * fq;
        f32x4 bv[2][2];
#pragma unroll
        for (int bj = 0; bj < 2; ++bj)
#pragma unroll
            for (int n = 0; n < 2; ++n) bv[bj][n] = *(const f32x4*)(bgate + u.pn * BM + wc * 32 + 8 * fq + bj * HALF + 4 * n);
#pragma unroll
        for (int ai = 0; ai < 2; ++ai)
#pragma unroll
            for (int m = 0; m < 4; ++m) { bf16_t* rowp = base + (size_t)(ai * HALF + m * 16) * 10496;
#pragma unroll
                for (int bj = 0; bj < 2; ++bj) { f32x4 v0 = acc[ai][bj][m][0] + bv[bj][0], v1 = acc[ai][bj][m][1] + bv[bj][1];
#pragma unroll
                    for (int i = 0; i < 4; ++i) { v0[i] = sigm(v0[i]); v1[i] = sigm(v1[i]); }
                    *(u32x4*)(rowp + bj * HALF) = pack8(v0, v1); } }
    }
};
struct EpiPlain {
    static constexpr bool PERM = true, AFTER_DRAIN = false, KSEG = false;
    bf16_t* O; int ldc;
    __device__ __forceinline__ void operator()(const f32x4 (&acc)[2][2][4][2], const Unit& u, int wr, int wc, int fr, int fq) const {
        bf16_t* base = O + (size_t)(u.pm * BM + wr * 64 + fr) * ldc + u.pn * BM + wc * 32 + 8 * fq;
#pragma unroll
        for (int ai = 0; ai < 2; ++ai)
#pragma unroll
            for (int m = 0; m < 4; ++m) { bf16_t* rowp = base + (size_t)(ai * HALF + m * 16) * ldc;
#pragma unroll
                for (int bj = 0; bj < 2; ++bj) *(u32x4*)(rowp + bj * HALF) = pack8(acc[ai][bj][m][0], acc[ai][bj][m][1]); }
    }
};
template <bool FIRST> struct EpiGateAcc {
    static constexpr bool PERM = true, AFTER_DRAIN = false, KSEG = false;
    const bf16_t* G; int gcol0; bf16_t* Mg;
    __device__ __forceinline__ void operator()(const f32x4 (&acc)[2][2][4][2], const Unit& u, int wr, int wc, int fr, int fq) const {
        const int row0 = u.pm * BM + wr * 64 + fr, col0 = u.pn * BM + wc * 32 + 8 * fq;
#pragma unroll
        for (int ai = 0; ai < 2; ++ai)
#pragma unroll
            for (int m = 0; m < 4; ++m) { const size_t r = (size_t)(row0 + ai * HALF + m * 16);
#pragma unroll
                for (int bj = 0; bj < 2; ++bj) {
                    const u32x4 gw = *(const u32x4*)(G + r * 10496 + gcol0 + col0 + bj * HALF);
                    f32x4 v0 = acc[ai][bj][m][0] * bf_lo4(gw), v1 = acc[ai][bj][m][1] * bf_hi4(gw);
                    bf16_t* mp = Mg + r * 2048 + col0 + bj * HALF;
                    if (!FIRST) { const u32x4 ow = *(const u32x4*)mp; v0 = v0 + bf_lo4(ow); v1 = v1 + bf_hi4(ow); }
                    *(u32x4*)mp = pack8(v0, v1); } }
    }
};
__device__ __forceinline__ float rowsq8(const f32x4 a, const f32x4 b) { return (a[0] * a[0] + a[1] * a[1]) + (a[2] * a[2] + a[3] * a[3]) + (b[0] * b[0] + b[1] * b[1]) + (b[2] * b[2] + b[3] * b[3]); }
struct EpiKV {
    static constexpr bool PERM = true, AFTER_DRAIN = false, KSEG = false;
    PG8_LAS float* P; const float* kn_g; const float* krss; const float* krr; bf16_t* KFT; bf16_t* VFT;
    __device__ __forceinline__ void operator()(const f32x4 (&acc)[2][2][4][2], const Unit& u, int wr, int wc, int fr, int fq) const {
        asm volatile("" : "+v"(fr), "+v"(fq));
        const int h = u.pn, b = u.pm >> 4, tq = (u.pm & 15) * 4;
#pragma unroll
        for (int ai = 0; ai < 2; ++ai)
#pragma unroll
            for (int m = 0; m < 4; ++m) { float s = rowsq8(acc[ai][0][m][0], acc[ai][0][m][1]); if (XL_FAST) s = xl_swap32_sum(xl_swap16_sum(s)); else { s += __shfl_xor(s, 16); s += __shfl_xor(s, 32); }
                if (fq == 0) P[(ai * HALF + wr * 64 + m * 16 + fr) * 4 + wc] = s; }
        asm volatile("s_waitcnt lgkmcnt(0)" ::: "memory"); __builtin_amdgcn_s_barrier(); asm volatile("" ::: "memory");
        const f32x4 g0 = *(const f32x4*)(kn_g + wc * 32 + 8 * fq), g1 = *(const f32x4*)(kn_g + wc * 32 + 8 * fq + 4);
#pragma unroll
        for (int ai = 0; ai < 2; ++ai)
#pragma unroll
            for (int m = 0; m < 4; ++m) { const int row = ai * HALF + wr * 64 + m * 16 + fr, key = m * 16 + fr; const size_t t = (size_t)u.pm * BM + row;
                const f32x4 p4 = *(const PG8_LAS f32x4*)(P + row * 4);
                const float rs = 1.0f * FAST_RSQ(((p4[0] + p4[1]) + (p4[2] + p4[3]) + krss[t]) * (1.f / 192.f) + 1e-6f);
                const size_t tile = (size_t)(b * 16 + h) * 64 + tq + 2 * ai + wr;
                bf16_t* kb = KFT + tile * 12288 + key * 8;
                *(u32x4*)(kb + (4 * wc + fq) * 512) = pack8(acc[ai][0][m][0] * g0 * rs, acc[ai][0][m][1] * g1 * rs);
                *(u32x4*)(VFT + tile * 8192 + wc * 2048 + key * 32 + 8 * fq) = pack8(acc[ai][1][m][0], acc[ai][1][m][1]);
                if (fq < 2) { const int c = 2 * wc + fq; const f32x4 r0 = *(const f32x4*)(krr + t * 64 + 8 * c), r1 = *(const f32x4*)(krr + t * 64 + 8 * c + 4);
                    *(u32x4*)(kb + (16 + c) * 512) = pack8(r0 * rs, r1 * rs); }
                asm volatile("" ::: "memory"); }
    }
};
struct EpiQ {
    static constexpr bool PERM = true, AFTER_DRAIN = false, KSEG = false;
    PG8_LAS float* P; const float* qn_g; const float* rope; bf16_t* QF; float qscale;
    __device__ __forceinline__ void operator()(const f32x4 (&acc)[2][2][4][2], const Unit& u, int wr, int wc, int fr, int fq) const {
        asm volatile("" : "+v"(fr), "+v"(fq));
        const int h = u.pn, b = u.pm >> 4;
#pragma unroll
        for (int ai = 0; ai < 2; ++ai)
#pragma unroll
            for (int m = 0; m < 4; ++m) { float s = rowsq8(acc[ai][0][m][0], acc[ai][0][m][1]); if (wc < 2) s += rowsq8(acc[ai][1][m][0], acc[ai][1][m][1]);
                if (XL_FAST) s = xl_swap32_sum(xl_swap16_sum(s)); else { s += __shfl_xor(s, 16); s += __shfl_xor(s, 32); }
                if (fq == 0) P[(ai * HALF + wr * 64 + m * 16 + fr) * 4 + wc] = s; }
        asm volatile("s_waitcnt lgkmcnt(0)" ::: "memory"); __builtin_amdgcn_s_barrier(); asm volatile("" ::: "memory");
        const f32x4 g0 = *(const f32x4*)(qn_g + wc * 32 + 8 * fq) * qscale, g1 = *(const f32x4*)(qn_g + wc * 32 + 8 * fq + 4) * qscale;
        const int j = 4 * (4 * (wc & 1) + fq);
        const f32x4 gr1 = *(const f32x4*)(qn_g + 128 + j) * qscale, gr2 = *(const f32x4*)(qn_g + 160 + j) * qscale;
#pragma unroll
        for (int ai = 0; ai < 2; ++ai)
#pragma unroll
            for (int m = 0; m < 4; ++m) { const int row = ai * HALF + wr * 64 + m * 16 + fr; const size_t t = (size_t)u.pm * BM + row;
                const f32x4 p4 = *(const PG8_LAS f32x4*)(P + row * 4);
                const float rs = 1.0f * FAST_RSQ(((p4[0] + p4[1]) + (p4[2] + p4[3])) * (1.f / 192.f) + 1e-6f);
                bf16_t* qb = QF + ((size_t)(b * 16 + h) * 4096 + (t & 4095)) * 192;
                *(u32x4*)(qb + wc * 32 + 8 * fq) = pack8(acc[ai][0][m][0] * g0 * rs, acc[ai][0][m][1] * g1 * rs);
                if (wc < 2) { const f32x4 c4 = *(const f32x4*)(rope + t * 64 + j), s4 = *(const f32x4*)(rope + t * 64 + 32 + j);
                    const f32x4 t1 = acc[ai][1][m][0] * gr1 * rs, t2 = acc[ai][1][m][1] * gr2 * rs;
                    const f32x4 o1 = t1 * c4 - t2 * s4, o2 = t1 * s4 + t2 * c4;
                    u32x2 w1; w1.x = cvt_pk_bf16(o1[0], o1[1]); w1.y = cvt_pk_bf16(o1[2], o1[3]); *(u32x2*)(qb + 128 + j) = w1;
                    u32x2 w2; w2.x = cvt_pk_bf16(o2[0], o2[1]); w2.y = cvt_pk_bf16(o2[2], o2[3]); *(u32x2*)(qb + 160 + j) = w2; }
                asm volatile("" ::: "memory"); }
    }
};
__device__ __forceinline__ unsigned pk4f8s(const f32x4 v, float s) { int r = __builtin_amdgcn_cvt_pk_fp8_f32(v[0] * s, v[1] * s, 0, false); r = __builtin_amdgcn_cvt_pk_fp8_f32(v[2] * s, v[3] * s, r, true); return (unsigned)r; }
struct EpiKV8 {
    static constexpr bool PERM = true, AFTER_DRAIN = false, KSEG = false;
    PG8_LAS float* P; const float* kn_g; const float* krss; const float* krr; unsigned char* K8; unsigned char* V8;
    __device__ __forceinline__ void operator()(const f32x4 (&acc)[2][2][4][2], const Unit& u, int wr, int wc, int fr, int fq) const {
        asm volatile("" : "+v"(fr), "+v"(fq));
        const int h = u.pn, b = u.pm >> 4, tq = (u.pm & 15) * 4;
#pragma unroll
        for (int ai = 0; ai < 2; ++ai)
#pragma unroll
            for (int m = 0; m < 4; ++m) { float s = rowsq8(acc[ai][0][m][0], acc[ai][0][m][1]); if (XL_FAST) s = xl_swap32_sum(xl_swap16_sum(s)); else { s += __shfl_xor(s, 16); s += __shfl_xor(s, 32); }
                if (fq == 0) P[(ai * HALF + wr * 64 + m * 16 + fr) * 4 + wc] = s; }
        asm volatile("s_waitcnt lgkmcnt(0)" ::: "memory"); __builtin_amdgcn_s_barrier(); asm volatile("" ::: "memory");
        const f32x4 g0 = *(const f32x4*)(kn_g + wc * 32 + 8 * fq), g1 = *(const f32x4*)(kn_g + wc * 32 + 8 * fq + 4);
#pragma unroll
        for (int ai = 0; ai < 2; ++ai)
#pragma unroll
            for (int m = 0; m < 4; ++m) { const int row = ai * HALF + wr * 64 + m * 16 + fr, key = m * 16 + fr; const size_t t = (size_t)u.pm * BM + row;
                const f32x4 p4 = *(const PG8_LAS f32x4*)(P + row * 4);
                const float rs = 1.0f * FAST_RSQ(((p4[0] + p4[1]) + (p4[2] + p4[3]) + krss[t]) * (1.f / 192.f) + 1e-6f);
                const size_t tile = (size_t)(b * 16 + h) * 64 + tq + 2 * ai + wr;
                unsigned char* kb = K8 + tile * 12288 + key * 16;
                { u32x2 w; w.x = pk4f8s(acc[ai][0][m][0] * g0, rs); w.y = pk4f8s(acc[ai][0][m][1] * g1, rs); *(u32x2*)(kb + (2 * wc + (fq >> 1)) * 1024 + 8 * (fq & 1)) = w; }
                if (fq < 2) { const f32x4 r0 = *(const f32x4*)(krr + t * 64 + 16 * wc + 8 * fq), r1 = *(const f32x4*)(krr + t * 64 + 16 * wc + 8 * fq + 4);
                    u32x2 w; w.x = pk4f8s(r0, rs); w.y = pk4f8s(r1, rs); *(u32x2*)(kb + (8 + wc) * 1024 + 8 * fq) = w; }
                const int p = 32 * ((fr >> 2) & 1) + 16 * (m >> 1) + (fr & 3) + 4 * (2 * (m & 1) + (fr >> 3));
                unsigned char* vb = V8 + tile * 8192 + (p >> 4) * 2048 + (size_t)(wc * 32 + 8 * fq) * 16 + (p & 15);
                const unsigned w0 = pk4f8s(acc[ai][1][m][0], 1.0f), w1 = pk4f8s(acc[ai][1][m][1], 1.0f);
                vb[0] = (unsigned char)w0; vb[16] = (unsigned char)(w0 >> 8); vb[32] = (unsigned char)(w0 >> 16); vb[48] = (unsigned char)(w0 >> 24);
                vb[64] = (unsigned char)w1; vb[80] = (unsigned char)(w1 >> 8); vb[96] = (unsigned char)(w1 >> 16); vb[112] = (unsigned char)(w1 >> 24);
                asm volatile("" ::: "memory"); }
    }
};
struct EpiQ8 {
    static constexpr bool PERM = true, AFTER_DRAIN = false, KSEG = false;
    PG8_LAS float* P; const float* qn_g; const float* rope; unsigned char* Q8; float qscale;
    __device__ __forceinline__ void operator()(const f32x4 (&acc)[2][2][4][2], const Unit& u, int wr, int wc, int fr, int fq) const {
        asm volatile("" : "+v"(fr), "+v"(fq));
        const int h = u.pn, b = u.pm >> 4;
#pragma unroll
        for (int ai = 0; ai < 2; ++ai)
#pragma unroll
            for (int m = 0; m < 4; ++m) { float s = rowsq8(acc[ai][0][m][0], acc[ai][0][m][1]); if (wc < 2) s += rowsq8(acc[ai][1][m][0], acc[ai][1][m][1]);
                if (XL_FAST) s = xl_swap32_sum(xl_swap16_sum(s)); else { s += __shfl_xor(s, 16); s += __shfl_xor(s, 32); }
                if (fq == 0) P[(ai * HALF + wr * 64 + m * 16 + fr) * 4 + wc] = s; }
        asm volatile("s_waitcnt lgkmcnt(0)" ::: "memory"); __builtin_amdgcn_s_barrier(); asm volatile("" ::: "memory");
        const f32x4 g0 = *(const f32x4*)(qn_g + wc * 32 + 8 * fq) * qscale, g1 = *(const f32x4*)(qn_g + wc * 32 + 8 * fq + 4) * qscale;
        const int j = 4 * (4 * (wc & 1) + fq);
        const f32x4 gr1 = *(const f32x4*)(qn_g + 128 + j) * qscale, gr2 = *(const f32x4*)(qn_g + 160 + j) * qscale;
#pragma unroll
        for (int ai = 0; ai < 2; ++ai)
#pragma unroll
            for (int m = 0; m < 4; ++m) { const int row = ai * HALF + wr * 64 + m * 16 + fr; const size_t t = (size_t)u.pm * BM + row;
                const f32x4 p4 = *(const PG8_LAS f32x4*)(P + row * 4);
                const float rs = 1.0f * FAST_RSQ(((p4[0] + p4[1]) + (p4[2] + p4[3])) * (1.f / 192.f) + 1e-6f);
                unsigned char* qb = Q8 + ((size_t)(b * 16 + h) * 4096 + (t & 4095)) * 192;
                { u32x2 w; w.x = pk4f8s(acc[ai][0][m][0] * g0, rs); w.y = pk4f8s(acc[ai][0][m][1] * g1, rs); *(u32x2*)(qb + wc * 32 + 8 * fq) = w; }
                if (wc < 2) { const f32x4 c4 = *(const f32x4*)(rope + t * 64 + j), s4 = *(const f32x4*)(rope + t * 64 + 32 + j);
                    const f32x4 t1 = acc[ai][1][m][0] * gr1 * rs, t2 = acc[ai][1][m][1] * gr2 * rs;
                    *(unsigned*)(qb + 128 + j) = pk4f8s(t1 * c4 - t2 * s4, 1.0f); *(unsigned*)(qb + 160 + j) = pk4f8s(t1 * s4 + t2 * c4, 1.0f); }
                asm volatile("" ::: "memory"); }
    }
};
template <int T1_, int T2_> struct EpiMergedT {
    static constexpr bool PERM = true, AFTER_DRAIN = false, KSEG = true; static constexpr int KSEG_T1 = T1_, KSEG_T2 = T2_;
    const bf16_t* G; bf16_t* Mg;
    __device__ __forceinline__ void kseg(f32x4 (&acc)[2][2][4][2], const Unit& u, int t, int wr, int wc, int fr, int fq) const {
        const bf16_t* gp = G + (size_t)(u.pm * BM + wr * 64 + fr) * 10496 + 4352 + (t == KSEG_T1 ? 0 : 2048) + u.pn * BM + wc * 32 + 8 * fq;
#if KSEG_BATCH16
#pragma unroll
        for (int ai = 0; ai < 2; ++ai) {
            u32x4 gn[4][2], gd[4][2];
#pragma unroll
            for (int m = 0; m < 4; ++m)
#pragma unroll
                for (int bj = 0; bj < 2; ++bj) { const bf16_t* p = gp + (size_t)(ai * HALF + m * 16) * 10496 + bj * HALF; gn[m][bj] = *(const u32x4*)p; gd[m][bj] = *(const u32x4*)(p + 2048); }
#pragma unroll
            for (int m = 0; m < 4; ++m)
#pragma unroll
                for (int bj = 0; bj < 2; ++bj) {
                    f32x4 r0 = bf_lo4(gd[m][bj]), r1 = bf_hi4(gd[m][bj]);
#pragma unroll
                    for (int i = 0; i < 4; ++i) { r0[i] = __builtin_amdgcn_rcpf(r0[i]); r1[i] = __builtin_amdgcn_rcpf(r1[i]); }
                    acc[ai][bj][m][0] = acc[ai][bj][m][0] * (bf_lo4(gn[m][bj]) * r0); acc[ai][bj][m][1] = acc[ai][bj][m][1] * (bf_hi4(gn[m][bj]) * r1); }
            asm volatile("" : "+v"(acc[ai][0][0][0]), "+v"(acc[ai][0][0][1]), "+v"(acc[ai][1][0][0]), "+v"(acc[ai][1][0][1]), "+v"(acc[ai][0][1][0]), "+v"(acc[ai][0][1][1]), "+v"(acc[ai][1][1][0]), "+v"(acc[ai][1][1][1]),
                         "+v"(acc[ai][0][2][0]), "+v"(acc[ai][0][2][1]), "+v"(acc[ai][1][2][0]), "+v"(acc[ai][1][2][1]), "+v"(acc[ai][0][3][0]), "+v"(acc[ai][0][3][1]), "+v"(acc[ai][1][3][0]), "+v"(acc[ai][1][3][1]) :: "memory");
        }
    }
#else
#pragma unroll
        for (int ai = 0; ai < 2; ++ai)
#pragma unroll
            for (int mp = 0; mp < 2; ++mp) {
                u32x4 gn[2][2], gd[2][2];
#pragma unroll
                for (int mm = 0; mm < 2; ++mm)
#pragma unroll
                    for (int bj = 0; bj < 2; ++bj) { const bf16_t* p = gp + (size_t)(ai * HALF + (2 * mp + mm) * 16) * 10496 + bj * HALF; gn[mm][bj] = *(const u32x4*)p; gd[mm][bj] = *(const u32x4*)(p + 2048); }
#pragma unroll
                for (int mm = 0; mm < 2; ++mm)
#pragma unroll
                    for (int bj = 0; bj < 2; ++bj) { const int m = 2 * mp + mm;
                        f32x4 r0 = bf_lo4(gd[mm][bj]), r1 = bf_hi4(gd[mm][bj]);
#pragma unroll
                        for (int i = 0; i < 4; ++i) { r0[i] = __builtin_amdgcn_rcpf(r0[i]); r1[i] = __builtin_amdgcn_rcpf(r1[i]); }
                        acc[ai][bj][m][0] = acc[ai][bj][m][0] * (bf_lo4(gn[mm][bj]) * r0); acc[ai][bj][m][1] = acc[ai][bj][m][1] * (bf_hi4(gn[mm][bj]) * r1); }
                asm volatile("" : "+v"(acc[ai][0][2 * mp][0]), "+v"(acc[ai][0][2 * mp][1]), "+v"(acc[ai][1][2 * mp][0]), "+v"(acc[ai][1][2 * mp][1]), "+v"(acc[ai][0][2 * mp + 1][0]), "+v"(acc[ai][0][2 * mp + 1][1]), "+v"(acc[ai][1][2 * mp + 1][0]), "+v"(acc[ai][1][2 * mp + 1][1]) :: "memory");
            }
    }
#endif
    __device__ __forceinline__ void operator()(const f32x4 (&acc)[2][2][4][2], const Unit& u, int wr, int wc, int fr, int fq) const {
        const int row0 = u.pm * BM + wr * 64 + fr, col0 = u.pn * BM + wc * 32 + 8 * fq;
#pragma unroll
        for (int ai = 0; ai < 2; ++ai)
#pragma unroll
            for (int m = 0; m < 4; ++m) { const size_t r = (size_t)(row0 + ai * HALF + m * 16);
#pragma unroll
                for (int bj = 0; bj < 2; ++bj) {
                    const u32x4 gw = *(const u32x4*)(G + r * 10496 + 4352 + 4096 + col0 + bj * HALF);
                    *(u32x4*)(Mg + r * 2048 + col0 + bj * HALF) = pack8(acc[ai][bj][m][0] * bf_lo4(gw), acc[ai][bj][m][1] * bf_hi4(gw)); } }
    }
};
struct EpiX1 {
    static constexpr bool PERM = true, AFTER_DRAIN = false, KSEG = false;
    const float* X; bf16_t* O;
    __device__ __forceinline__ void operator()(const f32x4 (&acc)[2][2][4][2], const Unit& u, int wr, int wc, int fr, int fq) const {
        const int row0 = u.pm * BM + wr * 64 + fr, col0 = u.pn * BM + wc * 32 + 8 * fq;
#if EPIX1_BATCH
#pragma unroll
        for (int ai = 0; ai < 2; ++ai) {
            f32x4 xv[4][2][2];
#pragma unroll
            for (int m = 0; m < 4; ++m) { const size_t off = (size_t)(row0 + ai * HALF + m * 16) * 2048 + col0;
#pragma unroll
                for (int bj = 0; bj < 2; ++bj) { xv[m][bj][0] = *(const f32x4*)(X + off + bj * HALF); xv[m][bj][1] = *(const f32x4*)(X + off + bj * HALF + 4); } }
#pragma unroll
            for (int m = 0; m < 4; ++m) { const size_t off = (size_t)(row0 + ai * HALF + m * 16) * 2048 + col0;
#pragma unroll
                for (int bj = 0; bj < 2; ++bj) *(u32x4*)(O + off + bj * HALF) = pack8(xv[m][bj][0] + acc[ai][bj][m][0], xv[m][bj][1] + acc[ai][bj][m][1]); }
            asm volatile("" ::: "memory");
        }
    }
};
#else
#pragma unroll
        for (int ai = 0; ai < 2; ++ai)
#pragma unroll
            for (int m = 0; m < 4; ++m) { const size_t off = (size_t)(row0 + ai * HALF + m * 16) * 2048 + col0;
#pragma unroll
                for (int bj = 0; bj < 2; ++bj) { const f32x4 x0 = *(const f32x4*)(X + off + bj * HALF), x1 = *(const f32x4*)(X + off + bj * HALF + 4);
                    *(u32x4*)(O + off + bj * HALF) = pack8(x0 + acc[ai][bj][m][0], x1 + acc[ai][bj][m][1]); } }
    }
};
#endif
struct EpiSwiGLU {
    static constexpr bool PERM = true, AFTER_DRAIN = false, KSEG = false;
    const float* bgu; unsigned char* ACT;
    __device__ __forceinline__ void operator()(const f32x4 (&acc)[2][2][4][2], const Unit& u, int wr, int wc, int fr, int fq) const {
        const int e = u.pn >> 4, pnl = u.pn & 15, cl = pnl * HALF + wc * 32 + 8 * fq;
        const float* bp = bgu + (size_t)e * 4096 + cl;
        f32x4 bg[2], bu[2];
#pragma unroll
        for (int n = 0; n < 2; ++n) { bg[n] = *(const f32x4*)(bp + 4 * n); bu[n] = *(const f32x4*)(bp + 2048 + 4 * n); }
        unsigned char* base = ACT + (size_t)(u.pm * BM + wr * 64 + fr) * 2048 + cl;
#pragma unroll
        for (int ai = 0; ai < 2; ++ai)
#pragma unroll
            for (int m = 0; m < 4; ++m) { f32x4 o[2];
#pragma unroll
                for (int n = 0; n < 2; ++n) { const f32x4 g4 = acc[ai][0][m][n] + bg[n], u4 = acc[ai][1][m][n] + bu[n];
#pragma unroll
                    for (int i = 0; i < 4; ++i) { const float g = fminf(g4[i], 7.0f), up = fminf(fmaxf(u4[i], -7.0f), 7.0f); o[n][i] = (up + 1.0f) * g * sigm(1.702f * g); } }
                u32x2 w8; w8.x = pk4f8(o[0]); w8.y = pk4f8(o[1]); *(u32x2*)(base + (size_t)(ai * HALF + m * 16) * 2048) = w8; }
    }
};
template <int P_> struct EpiSwiGLUProbe : EpiSwiGLU { static constexpr int PROBE = P_;
    __device__ __forceinline__ void operator()(const f32x4 (&)[2][2][4][2], const Unit&, int, int, int, int) const {} };

struct EpiDown {
    static constexpr bool PERM = true, AFTER_DRAIN = false, KSEG = false;
    const float* bd; unsigned char* Y;
    __device__ __forceinline__ void operator()(const f32x4 (&acc)[2][2][4][2], const Unit& u, int wr, int wc, int fr, int fq) const {
        const int e = u.pn >> 3, pnl = u.pn & 7, cl = pnl * BM + wc * 32 + 8 * fq;
        const float* bp = bd + (size_t)e * 2048 + cl;
        f32x4 bv[2][2];
#pragma unroll
        for (int bj = 0; bj < 2; ++bj)
#pragma unroll
            for (int n = 0; n < 2; ++n) bv[bj][n] = *(const f32x4*)(bp + bj * HALF + 4 * n);
        unsigned char* base = Y + (size_t)(u.pm * BM + wr * 64 + fr) * 2048 + cl;
#pragma unroll
        for (int ai = 0; ai < 2; ++ai)
#pragma unroll
            for (int m = 0; m < 4; ++m) { unsigned char* rowp = base + (size_t)(ai * HALF + m * 16) * 2048;
#pragma unroll
                for (int bj = 0; bj < 2; ++bj) { u32x2 w; w.x = pk4f8(acc[ai][bj][m][0] + bv[bj][0]); w.y = pk4f8(acc[ai][bj][m][1] + bv[bj][1]); *(u32x2*)(rowp + bj * HALF) = w; } }
    }
};

struct P1Order {
    StaticOrder base; int i_off, i_lim;
    __device__ void init(int G_, int c_, int i_off_, int i_lim_) { base.init(16384, (GATE_F8 ? (UV_F8 == 2 ? 4 : 8) : 41) * 256, G_, c_); i_off = i_off_; i_lim = i_lim_; }
    __device__ bool next(int i_, Unit& u) const {
        const int i = i_ + i_off; if (i >= i_lim) return false;
        const long L = (long)i * base.G + base.c;
        if (L < base.nwg) return base.next(i, u);
        const int j = (int)(L - base.nwg); if (GATE_F8 || j >= 32) return false;
        u.pm = 64 + (j & 3); u.pn = 41 + (j >> 2); return true;
    }
    __device__ __forceinline__ void a_ready(const Unit&) const {}
    __device__ __forceinline__ void done(const Unit&) const {}
};
struct GateOrder {
    StaticOrder base;
    __device__ void init(int G_, int c_) { base.init(16384, (UV_F8 == 1 ? 41 : UV_F8 == 2 ? 37 : 33) * 256, G_, c_); }
    __device__ bool next(int i, Unit& u) const {
        const long L = (long)i * base.G + base.c;
        if (L < base.nwg) { base.next(i, u); u.pn += (UV_F8 == 1 ? 0 : UV_F8 == 2 ? 4 : 8); return true; }
        const int j = (int)(L - base.nwg);
        if (j < 32) { u.pm = 64 + (j & 3); u.pn = 41 + (j >> 2); return true; }
        return false;
    }
    __device__ __forceinline__ void a_ready(const Unit&) const {}
    __device__ __forceinline__ void done(const Unit&) const {}
};
struct MoeOrder {
    const PG8_LAS int* tab; int NT, x, j;
    __device__ bool next(int i, Unit& u) const {
#if MOE_MAP2
        const int g = NT >> 2, Lx = i * 32 + j, rbi = Lx / g, s = Lx - rbi * g, rb = 2 * rbi + (x >> 2);
        if (rb >= __builtin_amdgcn_readfirstlane(tab[32])) return false;
#if CNT_SPREAD
        const int e = __builtin_amdgcn_readfirstlane((int)((const PG8_LAS unsigned char*)(tab + 136))[rb]);
#else
        int e = 0;
        while (__builtin_amdgcn_readfirstlane(tab[e + 1]) <= rb) ++e;
#endif
        u.pm = rb; u.pn = e * NT + (x & 3) + 4 * s; u.kr = 0; return true;
#else
        const int ntx = NT >> 3, Lx = i * 32 + j, rb = Lx / ntx, s = Lx - rb * ntx;
        if (rb >= __builtin_amdgcn_readfirstlane(tab[32])) return false;
#if CNT_SPREAD
        const int e = __builtin_amdgcn_readfirstlane((int)((const PG8_LAS unsigned char*)(tab + 136))[rb]);
#else
        int e = 0;
        while (__builtin_amdgcn_readfirstlane(tab[e + 1]) <= rb) ++e;
#endif
        u.pm = rb; u.pn = e * NT + x + 8 * s; u.kr = (rb + 4 * s) & 7; return true;
#endif
    }
    __device__ __forceinline__ void a_ready(const Unit&) const {}
    __device__ __forceinline__ void done(const Unit&) const {}
};
}
#define GAS __attribute__((address_space(1)))
#define LAS __attribute__((address_space(3)))
typedef unsigned short bf16;
typedef unsigned v4u __attribute__((ext_vector_type(4)));
typedef float f32x4 __attribute__((ext_vector_type(4)));
typedef short bf16x8 __attribute__((ext_vector_type(8)));
typedef GAS unsigned gu32;
typedef GAS unsigned long long gu64;
#define RLX_AGENT __ATOMIC_RELAXED, __HIP_MEMORY_SCOPE_AGENT
#define LDS_WAIT() asm volatile("s_waitcnt lgkmcnt(0)" ::: "memory")
#define VM_WAIT() asm volatile("s_waitcnt vmcnt(0)" ::: "memory")
__device__ __forceinline__ unsigned long long rt() { return __builtin_amdgcn_s_memrealtime(); }
__device__ __forceinline__ unsigned f2bf(float f) { unsigned u = __builtin_bit_cast(unsigned, f); return (u + 0x7fffu + ((u >> 16) & 1u)) >> 16; }
__device__ __forceinline__ unsigned pk2(float lo, float hi) { return f2bf(lo) | (f2bf(hi) << 16); }
#define XB_TMO      128
#define XB_XCNT(j)  (256  + 64 * (j))
#define XB_XSUB(j)  (1280 + 64 * (j))
#define XB_XGEN(j)  (2304 + 64 * (j))
#define XB_TOP      3328
#define XB_TOPGEN   3392
#define XCD_BAR_WORDS 3456
#define XB_SPIN_CAP (1u << 18)

__device__ __forceinline__ unsigned xb_ld(unsigned* p)              { return __hip_atomic_load(p, __ATOMIC_RELAXED, __HIP_MEMORY_SCOPE_AGENT); }
__device__ __forceinline__ unsigned xb_add(unsigned* p, unsigned v) { return __hip_atomic_fetch_add(p, v, __ATOMIC_RELAXED, __HIP_MEMORY_SCOPE_AGENT); }
__device__ __forceinline__ unsigned xb_xcc_id() { return (unsigned)__builtin_amdgcn_s_getreg((3 << 11) | 20) & 0xFu; }
#define XB_SPIN(cond, bar) do { unsigned _sp = 0; while (cond) { __builtin_amdgcn_s_sleep(1); \
    if ((++_sp & 255u) == 0u) { if (xb_ld(&(bar)[XB_TMO])) break; if (_sp > XB_SPIN_CAP) { atomicAdd(&(bar)[XB_TMO], 1u); break; } } } } while (0)

struct XcdBarrier {
    unsigned* bar; unsigned x;
    volatile LAS unsigned* st;
};

__device__ __forceinline__ XcdBarrier xcd_barrier_post(unsigned* bar, volatile LAS unsigned* st) {
    XcdBarrier b; b.bar = bar; b.x = xb_xcc_id(); b.st = st;
    if (threadIdx.x == 0) (void)xb_add(&bar[XB_XCNT(b.x)], 1u);
    return b;
}
__device__ __forceinline__ void xcd_barrier_complete(unsigned* bar, unsigned x, unsigned& nloc, unsigned& nx) {
    const unsigned G = gridDim.x * gridDim.y * gridDim.z;
    unsigned sum, cnt, mine, sp = 0u;
    for (;;) {
        sum = 0u; cnt = 0u; mine = 0u;
#pragma unroll
        for (unsigned j = 0; j < 16; ++j) { const unsigned c = xb_ld(&bar[XB_XCNT(j)]); sum += c; cnt += (c > 0u) ? 1u : 0u; mine = (j == x) ? c : mine; }
        if (sum == G) break;
        __builtin_amdgcn_s_sleep(1);
        if ((++sp & 255u) == 0u) { if (xb_ld(&bar[XB_TMO])) break; if (sp > XB_SPIN_CAP) { atomicAdd(&bar[XB_TMO], 1u); break; } }
    }
    nloc = mine > 0u ? mine : 1u; nx = cnt > 0u ? cnt : 1u;
}

__device__ __forceinline__ void xcd_barrier(const XcdBarrier& b) {
    asm volatile("s_waitcnt vmcnt(0)" ::: "memory");
    __syncthreads();
    if (threadIdx.x == 0) {
        unsigned* bar = b.bar;
        __builtin_amdgcn_s_waitcnt(0);
        unsigned nloc = b.st[0], nx = b.st[1];
        if (nloc == 0u) { xcd_barrier_complete(bar, b.x, nloc, nx); b.st[0] = nloc; b.st[1] = nx; }
        const unsigned old = xb_add(&bar[XB_XSUB(b.x)], 1u);
        const unsigned gen = old / nloc;
        if (old + 1u == (gen + 1u) * nloc) {
            __builtin_amdgcn_fence(__ATOMIC_RELEASE, "agent");
            asm volatile("s_waitcnt vmcnt(0)" ::: "memory");
            const unsigned og = xb_add(&bar[XB_TOP], 1u);
            const unsigned tg = og / nx;
            if (og + 1u == (tg + 1u) * nx) xb_add(&bar[XB_TOPGEN], 1u);
            else XB_SPIN(xb_ld(&bar[XB_TOPGEN]) == tg, bar);
            __builtin_amdgcn_fence(__ATOMIC_ACQUIRE, "agent");
            xb_add(&bar[XB_XGEN(b.x)], 1u);
            asm volatile("s_waitcnt vmcnt(0)" ::: "memory");
        } else {
            XB_SPIN(xb_ld(&bar[XB_XGEN(b.x)]) == gen, bar);
            __builtin_amdgcn_fence(__ATOMIC_ACQUIRE, "agent");
            asm volatile("s_waitcnt vmcnt(0)" ::: "memory");
        }
    }
    __syncthreads();
}
typedef float f32x16 __attribute__((ext_vector_type(16)));
typedef float f32x2 __attribute__((ext_vector_type(2)));
typedef short s16x4 __attribute__((ext_vector_type(4)));
typedef unsigned u32x2 __attribute__((ext_vector_type(2)));
typedef short v4i16_t __attribute__((ext_vector_type(4)));
__device__ __forceinline__ unsigned cvtpk(float lo, float hi) { unsigned r; asm volatile("v_cvt_pk_bf16_f32 %0, %1, %2" : "=v"(r) : "v"(lo), "v"(hi)); return r; }
__device__ __forceinline__ float bflo(unsigned w) { return __uint_as_float(w << 16); }
__device__ __forceinline__ float bfhi(unsigned w) { return __uint_as_float(w & 0xffff0000u); }
__device__ __forceinline__ void unpack8(const v4u w, float (&f)[8]) { f[0] = bflo(w.x); f[1] = bfhi(w.x); f[2] = bflo(w.y); f[3] = bfhi(w.y); f[4] = bflo(w.z); f[5] = bfhi(w.z); f[6] = bflo(w.w); f[7] = bfhi(w.w); }
__device__ __forceinline__ v4u packf8(const float (&f)[8]) { v4u w; w.x = cvtpk(f[0], f[1]); w.y = cvtpk(f[2], f[3]); w.z = cvtpk(f[4], f[5]); w.w = cvtpk(f[6], f[7]); return w; }
__device__ __forceinline__ float wave_sum(float v) {
#if XL_FAST
    return xl_swap32_sum(xl_swap16_sum(xl_sum16(v)));
#else
#pragma unroll
    for (int o = 1; o < 64; o <<= 1) v += __shfl_xor(v, o);
    return v;
#endif
}
__device__ __forceinline__ int crow(int r, int hi) { return (r & 3) + 8 * (r >> 2) + 4 * hi; }

template <bool ROPEP = false>
__device__ __forceinline__ void transpose_item64(const float* W, size_t ldw, int k0, int n0, bf16* WT, size_t ldt, int r0, LAS float* scr, int lane, int kdst = 0) {
    const GAS float* src = (const GAS float*)W + (size_t)(k0 + (lane >> 4)) * ldw + n0 + (lane & 15) * 4;
    f32x4 v[16];
#pragma unroll
    for (int i = 0; i < 16; ++i) v[i] = *(const GAS f32x4*)(src + (size_t)(4 * i) * ldw);
#pragma unroll
    for (int i = 0; i < 16; ++i) { LAS float* s = scr + (4 * i + (lane >> 4)) * 65 + (lane & 15) * 4; s[0] = v[i].x; s[1] = v[i].y; s[2] = v[i].z; s[3] = v[i].w; }
    LDS_WAIT(); asm volatile("" ::: "memory");
    const int c = lane & 7;
#pragma unroll
    for (int j = 0; j < 8; ++j) { const int n = (lane >> 3) + 8 * j; const LAS float* s = scr + (8 * c) * 65 + n;
        v4u o; o.x = cvtpk(s[0 * 65], s[1 * 65]); o.y = cvtpk(s[2 * 65], s[3 * 65]); o.z = cvtpk(s[4 * 65], s[5 * 65]); o.w = cvtpk(s[6 * 65], s[7 * 65]);
        const int nd = ROPEP ? (((n >> 4) & 1) * 32 + ((n >> 2) & 3) * 8 + (n >> 5) * 4 + (n & 3)) : n;
        *(GAS v4u*)(WT + (size_t)(r0 + nd) * ldt + kdst + k0 + 8 * c) = o; }
    LDS_WAIT(); asm volatile("" ::: "memory");
}
__device__ __forceinline__ unsigned pk4_fp8(float a, float b, float c, float d) { int r = __builtin_amdgcn_cvt_pk_fp8_f32(a, b, 0, false); r = __builtin_amdgcn_cvt_pk_fp8_f32(c, d, r, true); return (unsigned)r; }
template <bool ROPEP = false>
__device__ __forceinline__ void transpose_item64_f8(const float* W, size_t ldw, int k0, int n0, unsigned char* WT, size_t ldt, int r0, LAS float* scr, int lane, float scale) {
    const GAS float* src = (const GAS float*)W + (size_t)(k0 + (lane >> 4)) * ldw + n0 + (lane & 15) * 4;
    f32x4 v[16];
#pragma unroll
    for (int i = 0; i < 16; ++i) v[i] = *(const GAS f32x4*)(src + (size_t)(4 * i) * ldw);
#pragma unroll
    for (int i = 0; i < 16; ++i) { LAS float* s = scr + (4 * i + (lane >> 4)) * 65 + (lane & 15) * 4; s[0] = v[i].x; s[1] = v[i].y; s[2] = v[i].z; s[3] = v[i].w; }
    LDS_WAIT(); asm volatile("" ::: "memory");
    const int c = lane & 7;
#pragma unroll
    for (int j = 0; j < 8; ++j) { const int n = (lane >> 3) + 8 * j; const LAS float* s = scr + (8 * c) * 65 + n;
        u32x2 o; o.x = pk4_fp8(s[0 * 65] * scale, s[1 * 65] * scale, s[2 * 65] * scale, s[3 * 65] * scale); o.y = pk4_fp8(s[4 * 65] * scale, s[5 * 65] * scale, s[6 * 65] * scale, s[7 * 65] * scale);
        const int nd = ROPEP ? (((n >> 4) & 1) * 32 + ((n >> 2) & 3) * 8 + (n >> 5) * 4 + (n & 3)) : n;
        *(GAS u32x2*)(WT + (size_t)(r0 + nd) * ldt + k0 + 8 * c) = o; }
    LDS_WAIT(); asm volatile("" ::: "memory");
}
__device__ __forceinline__ void rms_row_to_bf16(const float* xrow, const float* gain, bf16* orow, int lane, unsigned char* orow8 = nullptr) {
    const GAS f32x4* xr = (const GAS f32x4*)xrow + lane; const GAS f32x4* gr = (const GAS f32x4*)gain + lane;
    f32x4 v[8]; float s = 0.f;
#pragma unroll
    for (int j = 0; j < 8; ++j) { v[j] = xr[64 * j]; s += (v[j].x * v[j].x + v[j].y * v[j].y) + (v[j].z * v[j].z + v[j].w * v[j].w); }
    const float rs = 1.0f * FAST_RSQ(wave_sum(s) * (1.f / 2048.f) + EPS);
    GAS u32x2* o8 = (GAS u32x2*)orow + lane; GAS unsigned* o4 = (GAS unsigned*)orow8 + lane;
#pragma unroll
    for (int j = 0; j < 8; ++j) { const f32x4 g = gr[64 * j]; const float a0 = v[j].x * rs * g.x, a1 = v[j].y * rs * g.y, a2 = v[j].z * rs * g.z, a3 = v[j].w * rs * g.w;
        if (!(UV_F8 == 1 && GATE_F8)) { u32x2 w; w.x = cvtpk(a0, a1); w.y = cvtpk(a2, a3); o8[64 * j] = w; }
        if (orow8) o4[64 * j] = pk4_fp8(a0, a1, a2, a3); }
}
#define ATT_WAITV(n) asm volatile("s_waitcnt vmcnt(" #n ")" ::: "memory")
template <int DQK, int NSLOT, bool CAUSAL>
__device__ __forceinline__ void attn_unit(LAS unsigned char* lds, const bf16* Qw  , int qpitch, const bf16* Ktiles, const bf16* Vtiles,
                                          int ntiles, int qpos0  , unsigned char* Ow  , int opitch, int wid, int lane) {
    constexpr int KS = DQK / 16, KTB = 64 * DQK * 2, VTB = 64 * 128 * 2, KP = KTB / 1024 / 8  , VP = 2, NP = KP + VP, PF = NSLOT - 1;
    static_assert(KTB % 8192 == 0, "K tile pieces must split evenly over 8 waves");
    const int r32 = lane & 31, hi = lane >> 5;
    bf16x8 qf[KS];
    { const GAS bf16x8* qp = (const GAS bf16x8*)((const GAS bf16*)Qw + (size_t)r32 * qpitch + hi * 8);
#pragma unroll
      for (int ks = 0; ks < KS; ++ks) qf[ks] = qp[2 * ks]; }
    asm volatile("s_waitcnt vmcnt(0)" ::: "memory");
#pragma unroll
    for (int ks = 0; ks < KS; ++ks) asm volatile("" : "+v"(qf[ks]));
    const GAS unsigned char* kg = (const GAS unsigned char*)Ktiles + (size_t)wid * 1024;
    const GAS unsigned char* vg = (const GAS unsigned char*)Vtiles + (size_t)wid * 1024;
    const unsigned loff = (unsigned)lane * 16u;
    LAS unsigned char* kl = lds + wid * 1024; LAS unsigned char* vl = lds + NSLOT * KTB + wid * 1024;
#define ATT_ISSUE(t) do { const int sl_ = (t) % NSLOT; unsigned lo_ = loff; asm volatile("" : "+v"(lo_));   \
        _Pragma("unroll") for (int p_ = 0; p_ < KP; ++p_) __builtin_amdgcn_global_load_lds((const GAS unsigned*)(kg + ((size_t)(t) * KTB + p_ * 8192) + lo_), (LAS unsigned*)(kl + sl_ * KTB + p_ * 8192), 16, 0, 0); \
        _Pragma("unroll") for (int p_ = 0; p_ < VP; ++p_) __builtin_amdgcn_global_load_lds((const GAS unsigned*)(vg + ((size_t)(t) * VTB + p_ * 8192) + lo_), (LAS unsigned*)(vl + sl_ * VTB + p_ * 8192), 16, 0, 0); } while (0)
#pragma unroll
    for (int t = 0; t < PF; ++t) if (t < ntiles) ATT_ISSUE(t);
    f32x16 o[4];
#pragma unroll
    for (int d = 0; d < 4; ++d)
#pragma unroll
        for (int r = 0; r < 16; ++r) o[d][r] = 0.f;
    float mrun = -1e30f, lrun = 0.f;
    const int kbase = hi * 1024 + r32 * 16;
    const int g4 = lane >> 4, q4 = (lane >> 2) & 3, p4 = lane & 3;
    const int vbase = (4 * (g4 >> 1) + q4) * 64 + (16 * (g4 & 1) + 4 * p4) * 2;
    for (int j = 0; j < ntiles; ++j) {
        const int rem = ntiles - 1 - j;
        if (PF >= 2 && rem >= 1) { if (NP == 5) ATT_WAITV(5); else ATT_WAITV(6); } else ATT_WAITV(0);
        __builtin_amdgcn_s_barrier();
        asm volatile("" ::: "memory");
        if (j + PF < ntiles) ATT_ISSUE(j + PF);
        if (CAUSAL && 64 * j > qpos0 + 31) continue;
        const int sl = j % NSLOT;
        const LAS unsigned char* ks_ = lds + sl * KTB + kbase;
        const LAS unsigned char* vs_ = lds + NSLOT * KTB + sl * VTB + vbase;
        f32x16 p0, p1;
#pragma unroll
        for (int r = 0; r < 16; ++r) { p0[r] = 0.f; p1[r] = 0.f; }
        {   constexpr int NF = 2 * KS, KW = 8;
            bf16x8 kf[KW];
#pragma unroll
            for (int i = 0; i < KW; ++i) kf[i] = *(const LAS bf16x8*)(ks_ + (i >> 1) * 2048 + (i & 1) * 512);
            __builtin_amdgcn_sched_barrier(0);
#pragma unroll
            for (int i = 0; i < NF; ++i) {
                if (i & 1) p1 = __builtin_amdgcn_mfma_f32_32x32x16_bf16(kf[i % KW], qf[i >> 1], p1, 0, 0, 0);
                else       p0 = __builtin_amdgcn_mfma_f32_32x32x16_bf16(kf[i % KW], qf[i >> 1], p0, 0, 0, 0);
                if (i + KW < NF) kf[i % KW] = *(const LAS bf16x8*)(ks_ + ((i + KW) >> 1) * 2048 + ((i + KW) & 1) * 512);
                __builtin_amdgcn_sched_barrier(0);
            }
        }
        if (CAUSAL && 64 * j + 63 > qpos0) {
            const int dq = qpos0 + r32 - 64 * j - 4 * hi;
#pragma unroll
            for (int r = 0; r < 16; ++r) { const int c = (r & 3) + 8 * (r >> 2); if (c > dq) p0[r] = -INFINITY; if (c + 32 > dq) p1[r] = -INFINITY; }
        }
        float mx = p0[0];
#pragma unroll
        for (int r = 1; r < 16; ++r) mx = fmaxf(mx, p0[r]);
#pragma unroll
        for (int r = 0; r < 16; ++r) mx = fmaxf(mx, p1[r]);
        mx = XL_FAST ? xl_swap32_max(mx) : fmaxf(mx, __shfl_xor(mx, 32));
        const float mnew = fmaxf(mrun, mx);
        if (__any(mnew > mrun)) {
            const float alpha = __builtin_amdgcn_exp2f(mrun - mnew);
            lrun *= alpha;
#pragma unroll
            for (int d = 0; d < 4; ++d)
#pragma unroll
                for (int r = 0; r < 16; ++r) o[d][r] *= alpha;
            mrun = mnew;
        }
        float ps = 0.f;
#pragma unroll
        for (int r = 0; r < 16; ++r) { p0[r] = __builtin_amdgcn_exp2f(p0[r] - mrun); p1[r] = __builtin_amdgcn_exp2f(p1[r] - mrun); ps += p0[r] + p1[r]; }
        lrun += ps;
        bf16x8 pf[4];
        { v4u w;
          w.x = cvtpk(p0[0], p0[1]); w.y = cvtpk(p0[2], p0[3]); w.z = cvtpk(p0[4], p0[5]); w.w = cvtpk(p0[6], p0[7]); pf[0] = __builtin_bit_cast(bf16x8, w);
          w.x = cvtpk(p0[8], p0[9]); w.y = cvtpk(p0[10], p0[11]); w.z = cvtpk(p0[12], p0[13]); w.w = cvtpk(p0[14], p0[15]); pf[1] = __builtin_bit_cast(bf16x8, w);
          w.x = cvtpk(p1[0], p1[1]); w.y = cvtpk(p1[2], p1[3]); w.z = cvtpk(p1[4], p1[5]); w.w = cvtpk(p1[6], p1[7]); pf[2] = __builtin_bit_cast(bf16x8, w);
          w.x = cvtpk(p1[8], p1[9]); w.y = cvtpk(p1[10], p1[11]); w.z = cvtpk(p1[12], p1[13]); w.w = cvtpk(p1[14], p1[15]); pf[3] = __builtin_bit_cast(bf16x8, w); }
#define ATT_VLOAD(dst, s_) do { _Pragma("unroll") for (int db_ = 0; db_ < 4; ++db_) { \
            const s16x4 lo_ = __builtin_bit_cast(s16x4, __builtin_amdgcn_ds_read_tr16_b64_v4i16((LAS v4i16_t*)(vs_ + db_ * 4096 + (s_) * 1024))); \
            const s16x4 hh_ = __builtin_bit_cast(s16x4, __builtin_amdgcn_ds_read_tr16_b64_v4i16((LAS v4i16_t*)(vs_ + db_ * 4096 + (s_) * 1024 + 512))); \
            dst[db_] = (bf16x8){lo_[0], lo_[1], lo_[2], lo_[3], hh_[0], hh_[1], hh_[2], hh_[3]}; } } while (0)
        {   bf16x8 va[4], vb[4];
            ATT_VLOAD(va, 0);
            __builtin_amdgcn_sched_barrier(0);
            ATT_VLOAD(vb, 1);
#pragma unroll
            for (int db = 0; db < 4; ++db) o[db] = __builtin_amdgcn_mfma_f32_32x32x16_bf16(va[db], pf[0], o[db], 0, 0, 0);
            __builtin_amdgcn_sched_barrier(0);
            ATT_VLOAD(va, 2);
#pragma unroll
            for (int db = 0; db < 4; ++db) o[db] = __builtin_amdgcn_mfma_f32_32x32x16_bf16(vb[db], pf[1], o[db], 0, 0, 0);
            __builtin_amdgcn_sched_barrier(0);
            ATT_VLOAD(vb, 3);
#pragma unroll
            for (int db = 0; db < 4; ++db) o[db] = __builtin_amdgcn_mfma_f32_32x32x16_bf16(va[db], pf[2], o[db], 0, 0, 0);
            __builtin_amdgcn_sched_barrier(0);
#pragma unroll
            for (int db = 0; db < 4; ++db) o[db] = __builtin_amdgcn_mfma_f32_32x32x16_bf16(vb[db], pf[3], o[db], 0, 0, 0);
            __builtin_amdgcn_sched_barrier(0);
        }
#undef ATT_VLOAD
    }
    const float lt = XL_FAST ? xl_swap32_sum(lrun) : lrun + __shfl_xor(lrun, 32);
    const float il = ATT_OS / lt;
    GAS unsigned char* op = (GAS unsigned char*)Ow + (size_t)r32 * opitch + 4 * hi;
#pragma unroll
    for (int db = 0; db < 4; ++db)
#pragma unroll
        for (int rg = 0; rg < 4; ++rg) *(GAS unsigned*)(op + 32 * db + 8 * rg) = pk4_fp8(o[db][4 * rg] * il, o[db][4 * rg + 1] * il, o[db][4 * rg + 2] * il, o[db][4 * rg + 3] * il);
    asm volatile("s_waitcnt vmcnt(0) lgkmcnt(0)" ::: "memory");
    __builtin_amdgcn_s_barrier();
    asm volatile("" ::: "memory");
#undef ATT_ISSUE
}

typedef int i32x8a __attribute__((ext_vector_type(8)));
typedef int i32x4a __attribute__((ext_vector_type(4)));
__device__ __forceinline__ void att_bar4(LAS unsigned* ctr, unsigned& nbar, int lane) {
#if SPLIT_FREE
    nbar += 4;
    if (lane == 0) __hip_atomic_fetch_add(ctr, 1u, __ATOMIC_RELAXED, __HIP_MEMORY_SCOPE_WORKGROUP);
    for (;;) { const unsigned v = __builtin_amdgcn_readfirstlane(__hip_atomic_load(ctr, __ATOMIC_RELAXED, __HIP_MEMORY_SCOPE_WORKGROUP)); if (v >= nbar) break; if (ATT_POLL_SLEEP) __builtin_amdgcn_s_sleep(1); }
    asm volatile("" ::: "memory");
#else
    __builtin_amdgcn_s_barrier();
    asm volatile("" ::: "memory");
#endif
}
template <bool CAUSAL, int NWA = 8>
__device__ __forceinline__ void attn8_unit(LAS unsigned char* lds, const unsigned char* Qw  , const unsigned char* Ktiles, const unsigned char* Vtiles,
                                           int ntiles, int qpos0, unsigned char* Ow  , int opitch, int wid, int lane, LAS unsigned* bctr = nullptr, unsigned* nbar = nullptr) {
    constexpr int KTB = 12288, VTB = 8192, NSLOT = 3;
    const int r32 = lane & 31, hi = lane >> 5;
    i32x8a qf[3];
    { const GAS i32x4a* qp = (const GAS i32x4a*)((const GAS unsigned char*)Qw + (size_t)r32 * 192 + hi * 32);
#pragma unroll
      for (int s = 0; s < 3; ++s) { const i32x4a a = qp[4 * s], b = qp[4 * s + 1]; qf[s] = __builtin_shufflevector(a, b, 0, 1, 2, 3, 4, 5, 6, 7); } }
    asm volatile("s_waitcnt vmcnt(0)" ::: "memory");
#pragma unroll
    for (int s = 0; s < 3; ++s) asm volatile("" : "+v"(qf[s]));
    const GAS unsigned char* kg = (const GAS unsigned char*)Ktiles + (size_t)wid * 1024;
    const GAS unsigned char* vg = (const GAS unsigned char*)Vtiles + (size_t)wid * 1024;
    const unsigned loff = (unsigned)lane * 16u;
    LAS unsigned char* kl = lds + wid * 1024; LAS unsigned char* vl = lds + NSLOT * KTB + wid * 1024;
    const bool two = wid < 4;
#define A8_ISSUE(t) do { const int sl_ = (t) % NSLOT; unsigned lo_ = loff; asm volatile("" : "+v"(lo_)); \
        if (NWA == 8) { \
            __builtin_amdgcn_global_load_lds((const GAS unsigned*)(kg + (size_t)(t) * KTB + lo_), (LAS unsigned*)(kl + sl_ * KTB), 16, 0, 0); \
            if (two) __builtin_amdgcn_global_load_lds((const GAS unsigned*)(kg + ((size_t)(t) * KTB + 8192) + lo_), (LAS unsigned*)(kl + sl_ * KTB + 8192), 16, 0, 0); \
            __builtin_amdgcn_global_load_lds((const GAS unsigned*)(vg + (size_t)(t) * VTB + lo_), (LAS unsigned*)(vl + sl_ * VTB), 16, 0, 0); \
        } else {     \
            _Pragma("unroll") for (int p_ = 0; p_ < 3; ++p_) __builtin_amdgcn_global_load_lds((const GAS unsigned*)(kg + ((size_t)(t) * KTB + p_ * 4096) + lo_), (LAS unsigned*)(kl + sl_ * KTB + p_ * 4096), 16, 0, 0); \
            _Pragma("unroll") for (int p_ = 0; p_ < 2; ++p_) __builtin_amdgcn_global_load_lds((const GAS unsigned*)(vg + ((size_t)(t) * VTB + p_ * 4096) + lo_), (LAS unsigned*)(vl + sl_ * VTB + p_ * 4096), 16, 0, 0); \
        } } while (0)
    A8_ISSUE(0);
    if (ntiles > 1) A8_ISSUE(1);
    f32x16 o[4];
#pragma unroll
    for (int d = 0; d < 4; ++d)
#pragma unroll
        for (int r = 0; r < 16; ++r) o[d][r] = 0.f;
    float mrun = -1e30f, lrun = 0.f;
    const int kbase = (2 * hi) * 1024 + r32 * 16, vbase = (2 * hi) * 2048 + r32 * 16;
    const int SQ = 0x7b7b7b7b, SP = 0x79797979, S1 = 0x7f7f7f7f;
    for (int j = 0; j < ntiles; ++j) {
        if (ntiles - 1 - j >= 1) { if (NWA == 4) ATT_WAITV(5); else if (two) ATT_WAITV(3); else ATT_WAITV(2); } else ATT_WAITV(0);
        if (NWA == 4 && bctr) att_bar4(bctr, *nbar, lane); else { __builtin_amdgcn_s_barrier(); asm volatile("" ::: "memory"); }
        if (j + 2 < ntiles) A8_ISSUE(j + 2);
        if (CAUSAL && 64 * j > qpos0 + 31) continue;
        const int sl = j % NSLOT;
        const LAS unsigned char* ks_ = lds + sl * KTB + kbase;
        const LAS unsigned char* vs_ = lds + NSLOT * KTB + sl * VTB + vbase;
        i32x8a kf[3][2];
#pragma unroll
        for (int s = 0; s < 3; ++s)
#pragma unroll
            for (int kb = 0; kb < 2; ++kb) { const i32x4a a = *(const LAS i32x4a*)(ks_ + s * 4096 + kb * 512), b = *(const LAS i32x4a*)(ks_ + s * 4096 + kb * 512 + 1024);
                kf[s][kb] = __builtin_shufflevector(a, b, 0, 1, 2, 3, 4, 5, 6, 7); }
        f32x16 p0, p1;
#pragma unroll
        for (int r = 0; r < 16; ++r) { p0[r] = 0.f; p1[r] = 0.f; }
#pragma unroll
        for (int s = 0; s < 3; ++s) {
            p0 = __builtin_amdgcn_mfma_scale_f32_32x32x64_f8f6f4(kf[s][0], qf[s], p0, 0, 0, 0, S1, 0, SQ);
            p1 = __builtin_amdgcn_mfma_scale_f32_32x32x64_f8f6f4(kf[s][1], qf[s], p1, 0, 0, 0, S1, 0, SQ);
        }
        i32x8a vf[4];
#pragma unroll
        for (int db = 0; db < 4; ++db) { const i32x4a a = *(const LAS i32x4a*)(vs_ + db * 512), b = *(const LAS i32x4a*)(vs_ + db * 512 + 2048); vf[db] = __builtin_shufflevector(a, b, 0, 1, 2, 3, 4, 5, 6, 7); }
        __builtin_amdgcn_sched_barrier(0);
        if (CAUSAL && 64 * j + 63 > qpos0) {
            const int dq = qpos0 + r32 - 64 * j - 4 * hi;
#pragma unroll
            for (int r = 0; r < 16; ++r) { const int c = (r & 3) + 8 * (r >> 2); if (c > dq) p0[r] = -INFINITY; if (c + 32 > dq) p1[r] = -INFINITY; }
        }
        float mx = p0[0];
#pragma unroll
        for (int r = 1; r < 16; ++r) mx = fmaxf(mx, p0[r]);
#pragma unroll
        for (int r = 0; r < 16; ++r) mx = fmaxf(mx, p1[r]);
        mx = XL_FAST ? xl_swap32_max(mx) : fmaxf(mx, __shfl_xor(mx, 32));
        const float mnew = fmaxf(mrun, mx);
        if (__any(mx > mrun + 2.0f)) {
            const float alpha = __builtin_amdgcn_exp2f(mrun - mnew);
            lrun *= alpha;
#pragma unroll
            for (int d = 0; d < 4; ++d)
#pragma unroll
                for (int r = 0; r < 16; ++r) o[d][r] *= alpha;
            mrun = mnew;
        }
        float ps = 0.f; const float msh = mrun - 6.0f;
#pragma unroll
        for (int r = 0; r < 16; ++r) { p0[r] = __builtin_amdgcn_exp2f(p0[r] - msh); p1[r] = __builtin_amdgcn_exp2f(p1[r] - msh); ps += p0[r] + p1[r]; }
        lrun += ps;
        i32x8a pf;
        pf[0] = (int)pk4_fp8(p0[0], p0[1], p0[2], p0[3]); pf[1] = (int)pk4_fp8(p0[4], p0[5], p0[6], p0[7]); pf[2] = (int)pk4_fp8(p0[8], p0[9], p0[10], p0[11]); pf[3] = (int)pk4_fp8(p0[12], p0[13], p0[14], p0[15]);
        pf[4] = (int)pk4_fp8(p1[0], p1[1], p1[2], p1[3]); pf[5] = (int)pk4_fp8(p1[4], p1[5], p1[6], p1[7]); pf[6] = (int)pk4_fp8(p1[8], p1[9], p1[10], p1[11]); pf[7] = (int)pk4_fp8(p1[12], p1[13], p1[14], p1[15]);
#pragma unroll
        for (int db = 0; db < 4; ++db) o[db] = __builtin_amdgcn_mfma_scale_f32_32x32x64_f8f6f4(vf[db], pf, o[db], 0, 0, 0, S1, 0, SP);
    }
    const float lt = XL_FAST ? xl_swap32_sum(lrun) : lrun + __shfl_xor(lrun, 32);
    const float il = 64.0f * ATT_OS / lt;
    GAS unsigned char* op = (GAS unsigned char*)Ow + (size_t)r32 * opitch + 4 * hi;
#pragma unroll
    for (int db = 0; db < 4; ++db)
#pragma unroll
        for (int rg = 0; rg < 4; ++rg) *(GAS unsigned*)(op + 32 * db + 8 * rg) = pk4_fp8(o[db][4 * rg] * il, o[db][4 * rg + 1] * il, o[db][4 * rg + 2] * il, o[db][4 * rg + 3] * il);
    asm volatile("s_waitcnt vmcnt(0) lgkmcnt(0)" ::: "memory");
    if (NWA == 4 && bctr) att_bar4(bctr, *nbar, lane); else { __builtin_amdgcn_s_barrier(); asm volatile("" ::: "memory"); }
#undef A8_ISSUE
}

__device__ __forceinline__ float xhalf_max(float x) { const auto r = __builtin_amdgcn_permlane32_swap(__float_as_uint(x), __float_as_uint(x), false, false); return fmaxf(__uint_as_float(r[0]), __uint_as_float(r[1])); }
__device__ __forceinline__ float xhalf_sum(float x) { const auto r = __builtin_amdgcn_permlane32_swap(__float_as_uint(x), __float_as_uint(x), false, false); return __uint_as_float(r[0]) + __uint_as_float(r[1]); }
template <bool CAUSAL>
__device__ __forceinline__ void attn8_unit2(LAS unsigned char* lds, const unsigned char* Qw  , const unsigned char* Ktiles, const unsigned char* Vtiles,
                                            int ntiles, int qpos0  , unsigned char* Ow, int opitch, int wid, int lane, LAS unsigned* bctr, unsigned& nbar) {
    constexpr int KTB = 12288, VTB = 8192, NSLOT = ATT_PAIR ? 2 : 3, KSB = ATT_PAIR ? 2 * KTB : KTB, VSB = ATT_PAIR ? 2 * VTB : VTB;
    const int r32 = lane & 31, hi = lane >> 5;
    i32x8a qf[2][3];
#pragma unroll
    for (int bk = 0; bk < 2; ++bk) { const GAS i32x4a* qp = (const GAS i32x4a*)((const GAS unsigned char*)Qw + (size_t)(128 * bk + r32) * 192 + hi * 32);
#pragma unroll
      for (int s = 0; s < 3; ++s) { const i32x4a a = qp[4 * s], b = qp[4 * s + 1]; qf[bk][s] = __builtin_shufflevector(a, b, 0, 1, 2, 3, 4, 5, 6, 7); } }
    asm volatile("s_waitcnt vmcnt(0)" ::: "memory");
#pragma unroll
    for (int bk = 0; bk < 2; ++bk)
#pragma unroll
        for (int s = 0; s < 3; ++s) asm volatile("" : "+v"(qf[bk][s]));
    const GAS unsigned char* kg = (const GAS unsigned char*)Ktiles + (size_t)wid * 1024;
    const GAS unsigned char* vg = (const GAS unsigned char*)Vtiles + (size_t)wid * 1024;
    const unsigned loff = (unsigned)lane * 16u;
    LAS unsigned char* kl = lds + wid * 1024; LAS unsigned char* vl = lds + NSLOT * KSB + wid * 1024;
#define A2_ISSUE(t) do { const int sl_ = (t) % NSLOT; unsigned lo_ = loff; asm volatile("" : "+v"(lo_)); \
        _Pragma("unroll") for (int p_ = 0; p_ < KSB / 4096; ++p_) __builtin_amdgcn_global_load_lds((const GAS unsigned*)(kg + ((size_t)(t) * KSB + p_ * 4096) + lo_), (LAS unsigned*)(kl + sl_ * KSB + p_ * 4096), 16, 0, 0); \
        _Pragma("unroll") for (int p_ = 0; p_ < VSB / 4096; ++p_) __builtin_amdgcn_global_load_lds((const GAS unsigned*)(vg + ((size_t)(t) * VSB + p_ * 4096) + lo_), (LAS unsigned*)(vl + sl_ * VSB + p_ * 4096), 16, 0, 0); } while (0)
#define A2_PIECE(tp_, ix_) do { const int sl_ = (tp_) % NSLOT; unsigned lo_ = loff; asm volatile("" : "+v"(lo_)); \
        if ((ix_) < 6) __builtin_amdgcn_global_load_lds((const GAS unsigned*)(kg + ((size_t)(tp_) * KSB + (ix_) * 4096) + lo_), (LAS unsigned*)(kl + sl_ * KSB + (ix_) * 4096), 16, 0, 0); \
        else __builtin_amdgcn_global_load_lds((const GAS unsigned*)(vg + ((size_t)(tp_) * VSB + ((ix_) - 6) * 4096) + lo_), (LAS unsigned*)(vl + sl_ * VSB + ((ix_) - 6) * 4096), 16, 0, 0); } while (0)
#define A2_SPREAD(ix_) do { if (ATT_SPREAD && ATT_PAIR && bk == 1 && pend) { __builtin_amdgcn_sched_barrier(0); A2_PIECE((j >> 1) + 1, ix_); __builtin_amdgcn_sched_barrier(0); } } while (0)
    A2_ISSUE(0);
    if (!ATT_PAIR && ntiles > 1) A2_ISSUE(1);
    f32x16 o[2][4];
#pragma unroll
    for (int bk = 0; bk < 2; ++bk)
#pragma unroll
        for (int d = 0; d < 4; ++d)
#pragma unroll
            for (int r = 0; r < 16; ++r) o[bk][d][r] = 0.f;
    float mrun[2] = {-1e30f, -1e30f}, lrun[2] = {0.f, 0.f};
    const int kbase = (2 * hi) * 1024 + r32 * 16, vbase = (2 * hi) * 2048 + r32 * 16;
    const int SQ = 0x7b7b7b7b, SP = 0x79797979, S1 = 0x7f7f7f7f;
    for (int j = 0; j < ntiles; ++j) {
#if ATT_PAIR
        if ((j & 1) == 0) {
            ATT_WAITV(0);
            att_bar4(bctr, nbar, lane);
            if (!ATT_SPREAD && j + 2 < ntiles) A2_ISSUE((j >> 1) + 1);
        }
        const bool pend = ATT_SPREAD && (j & 1) == 0 && (j + 2 < ntiles); (void)pend;
        const int sl = (j >> 1) % NSLOT;
        unsigned ka_ = (unsigned)(sl * KSB + (j & 1) * KTB + kbase), va_ = (unsigned)(NSLOT * KSB + sl * VSB + (j & 1) * VTB + vbase);
#else
        if (ntiles - 1 - j >= 1) ATT_WAITV(5); else ATT_WAITV(0);
        att_bar4(bctr, nbar, lane);
        if (j + 2 < ntiles) A2_ISSUE(j + 2);
        const int sl = j % NSLOT;
        unsigned ka_ = (unsigned)(sl * KTB + kbase), va_ = (unsigned)(NSLOT * KTB + sl * VTB + vbase);
        const bool pend = false; (void)pend;
#endif
        asm volatile("" : "+v"(ka_), "+v"(va_));
        const LAS unsigned char* ks_ = lds + ka_;
        const LAS unsigned char* vs_ = lds + va_;
        i32x8a pf_prev; bool have_prev = false; (void)pf_prev;
#pragma unroll
        for (int bk = 0; bk < 2; ++bk) {
            const int qp0 = qpos0 + 128 * bk;
            if (CAUSAL && 64 * j > qp0 + 31) continue;
#if ATT_SPLITQK
            f32x16 p0, p1;
#pragma unroll
            for (int r = 0; r < 16; ++r) { p0[r] = 0.f; p1[r] = 0.f; }
#pragma unroll
            for (int s = 0; s < 3; ++s) {
                const i32x4a a0 = *(const LAS i32x4a*)(ks_ + s * 4096), b0 = *(const LAS i32x4a*)(ks_ + s * 4096 + 1024);
                const i32x8a k0 = __builtin_shufflevector(a0, b0, 0, 1, 2, 3, 4, 5, 6, 7);
                p0 = __builtin_amdgcn_mfma_scale_f32_32x32x64_f8f6f4(k0, qf[bk][s], p0, 0, 0, 0, S1, 0, SQ);
            }
            __builtin_amdgcn_sched_barrier(0);
#pragma unroll
            for (int s = 0; s < 3; ++s) {
                const i32x4a a1 = *(const LAS i32x4a*)(ks_ + s * 4096 + 512), b1 = *(const LAS i32x4a*)(ks_ + s * 4096 + 512 + 1024);
                const i32x8a k1 = __builtin_shufflevector(a1, b1, 0, 1, 2, 3, 4, 5, 6, 7);
                p1 = __builtin_amdgcn_mfma_scale_f32_32x32x64_f8f6f4(k1, qf[bk][s], p1, 0, 0, 0, S1, 0, SQ);
            }
            __builtin_amdgcn_sched_barrier(0);
            const bool diag = CAUSAL && 64 * j + 63 > qp0;
            const int dq = qp0 + r32 - 64 * j - 4 * hi;
            if (diag) {
#pragma unroll
                for (int r = 0; r < 16; ++r) { const int c = (r & 3) + 8 * (r >> 2); if (c > dq) p0[r] = -INFINITY; }
            }
            float mx = p0[0];
#pragma unroll
            for (int r = 1; r < 16; ++r) mx = fmaxf(mx, p0[r]);
            mx = ATT_PERMLANE ? xhalf_max(mx) : fmaxf(mx, __shfl_xor(mx, 32));
            if (__any(mx > mrun[bk] + 2.0f)) {
                const float mnew = fmaxf(mrun[bk], mx), alpha = __builtin_amdgcn_exp2f(mrun[bk] - mnew);
                lrun[bk] *= alpha;
#pragma unroll
                for (int d = 0; d < 4; ++d)
#pragma unroll
                    for (int r = 0; r < 16; ++r) o[bk][d][r] *= alpha;
                mrun[bk] = mnew;
            }
            float msh = mrun[bk] - 6.0f, ps = 0.f;
#pragma unroll
            for (int r = 0; r < 16; ++r) { p0[r] = __builtin_amdgcn_exp2f(p0[r] - msh); ps += p0[r]; }
            __builtin_amdgcn_sched_barrier(0);
            if (diag) {
#pragma unroll
                for (int r = 0; r < 16; ++r) { const int c = (r & 3) + 8 * (r >> 2); if (c + 32 > dq) p1[r] = -INFINITY; }
            }
            mx = p1[0];
#pragma unroll
            for (int r = 1; r < 16; ++r) mx = fmaxf(mx, p1[r]);
            mx = ATT_PERMLANE ? xhalf_max(mx) : fmaxf(mx, __shfl_xor(mx, 32));
            if (__any(mx > mrun[bk] + 2.0f)) {
                const float mnew = fmaxf(mrun[bk], mx), alpha = __builtin_amdgcn_exp2f(mrun[bk] - mnew);
                lrun[bk] *= alpha; ps *= alpha;
#pragma unroll
                for (int r = 0; r < 16; ++r) p0[r] *= alpha;
#pragma unroll
                for (int d = 0; d < 4; ++d)
#pragma unroll
                    for (int r = 0; r < 16; ++r) o[bk][d][r] *= alpha;
                mrun[bk] = mnew; msh = mnew - 6.0f;
            }
#pragma unroll
            for (int r = 0; r < 16; ++r) { p1[r] = __builtin_amdgcn_exp2f(p1[r] - msh); ps += p1[r]; }
            lrun[bk] += ps;
            i32x8a pf;
            pf[0] = (int)pk4_fp8(p0[0], p0[1], p0[2], p0[3]); pf[1] = (int)pk4_fp8(p0[4], p0[5], p0[6], p0[7]); pf[2] = (int)pk4_fp8(p0[8], p0[9], p0[10], p0[11]); pf[3] = (int)pk4_fp8(p0[12], p0[13], p0[14], p0[15]);
            pf[4] = (int)pk4_fp8(p1[0], p1[1], p1[2], p1[3]); pf[5] = (int)pk4_fp8(p1[4], p1[5], p1[6], p1[7]); pf[6] = (int)pk4_fp8(p1[8], p1[9], p1[10], p1[11]); pf[7] = (int)pk4_fp8(p1[12], p1[13], p1[14], p1[15]);
            asm volatile("" : "+v"(pf));
#pragma unroll
            for (int db = 0; db < 4; ++db) { const i32x4a a = *(const LAS i32x4a*)(vs_ + db * 512), b = *(const LAS i32x4a*)(vs_ + db * 512 + 2048);
                const i32x8a vfd = __builtin_shufflevector(a, b, 0, 1, 2, 3, 4, 5, 6, 7);
                asm volatile("v_mfma_scale_f32_32x32x64_f8f6f4 %0, %1, %2, %0, %3, %4 op_sel_hi:[0,0,0]" : "+v"(o[bk][db]) : "v"(vfd), "v"(pf), "v"(S1), "v"(SP));
                A2_SPREAD(6 + db); }
            if (ATT_SPREAD && ATT_PAIR && bk == 1 && pend) { A2_PIECE((j >> 1) + 1, 0); A2_PIECE((j >> 1) + 1, 1); A2_PIECE((j >> 1) + 1, 2); A2_PIECE((j >> 1) + 1, 3); A2_PIECE((j >> 1) + 1, 4); A2_PIECE((j >> 1) + 1, 5); }
#else
            f32x16 p0, p1;
#pragma unroll
            for (int r = 0; r < 16; ++r) { p0[r] = 0.f; p1[r] = 0.f; }
#pragma unroll
            for (int s = 0; s < 3; ++s) {
                const i32x4a a0 = *(const LAS i32x4a*)(ks_ + s * 4096), b0 = *(const LAS i32x4a*)(ks_ + s * 4096 + 1024);
                const i32x4a a1 = *(const LAS i32x4a*)(ks_ + s * 4096 + 512), b1 = *(const LAS i32x4a*)(ks_ + s * 4096 + 512 + 1024);
                const i32x8a k0 = __builtin_shufflevector(a0, b0, 0, 1, 2, 3, 4, 5, 6, 7), k1 = __builtin_shufflevector(a1, b1, 0, 1, 2, 3, 4, 5, 6, 7);
                p0 = __builtin_amdgcn_mfma_scale_f32_32x32x64_f8f6f4(k0, qf[bk][s], p0, 0, 0, 0, S1, 0, SQ);
                p1 = __builtin_amdgcn_mfma_scale_f32_32x32x64_f8f6f4(k1, qf[bk][s], p1, 0, 0, 0, S1, 0, SQ);
            }
#if ATT_DEFER
            if (bk == 1 && have_prev) {
                __builtin_amdgcn_sched_barrier(0);
#pragma unroll
                for (int db = 0; db < 4; ++db) { const i32x4a a = *(const LAS i32x4a*)(vs_ + db * 512), b = *(const LAS i32x4a*)(vs_ + db * 512 + 2048);
                    const i32x8a vfd = __builtin_shufflevector(a, b, 0, 1, 2, 3, 4, 5, 6, 7);
                    asm volatile("v_mfma_scale_f32_32x32x64_f8f6f4 %0, %1, %2, %0, %3, %4 op_sel_hi:[0,0,0]" : "+v"(o[0][db]) : "v"(vfd), "v"(pf_prev), "v"(S1), "v"(SP));
                    __builtin_amdgcn_sched_barrier(0); }
            }
#endif
            if (CAUSAL && 64 * j + 63 > qp0) {
                const int dq = qp0 + r32 - 64 * j - 4 * hi;
#pragma unroll
                for (int r = 0; r < 16; ++r) { const int c = (r & 3) + 8 * (r >> 2); if (c > dq) p0[r] = -INFINITY; if (c + 32 > dq) p1[r] = -INFINITY; }
            }
            float mx = p0[0];
#pragma unroll
            for (int r = 1; r < 16; ++r) mx = fmaxf(mx, p0[r]);
#pragma unroll
            for (int r = 0; r < 16; ++r) mx = fmaxf(mx, p1[r]);
            mx = ATT_PERMLANE ? xhalf_max(mx) : fmaxf(mx, __shfl_xor(mx, 32));
            const float mnew = fmaxf(mrun[bk], mx);
            if (__any(mx > mrun[bk] + 2.0f)) {
                const float alpha = __builtin_amdgcn_exp2f(mrun[bk] - mnew);
                lrun[bk] *= alpha;
#pragma unroll
                for (int d = 0; d < 4; ++d)
#pragma unroll
                    for (int r = 0; r < 16; ++r) o[bk][d][r] *= alpha;
                mrun[bk] = mnew;
            }
#if ATT_VPRE
            float ps = 0.f; const float msh = mrun[bk] - 6.0f;
            i32x8a pf;
#pragma unroll
            for (int r = 0; r < 16; ++r) { p0[r] = __builtin_amdgcn_exp2f(p0[r] - msh); ps += p0[r]; }
            pf[0] = (int)pk4_fp8(p0[0], p0[1], p0[2], p0[3]); pf[1] = (int)pk4_fp8(p0[4], p0[5], p0[6], p0[7]); pf[2] = (int)pk4_fp8(p0[8], p0[9], p0[10], p0[11]); pf[3] = (int)pk4_fp8(p0[12], p0[13], p0[14], p0[15]);
            asm volatile("" : "+v"(pf[0]), "+v"(pf[1]), "+v"(pf[2]), "+v"(pf[3]));
            i32x8a vf0, vf1, vf2, vf3;
            { const i32x4a a = *(const LAS i32x4a*)(vs_ + 0 * 512), b = *(const LAS i32x4a*)(vs_ + 0 * 512 + 2048); vf0 = __builtin_shufflevector(a, b, 0, 1, 2, 3, 4, 5, 6, 7); }
            { const i32x4a a = *(const LAS i32x4a*)(vs_ + 1 * 512), b = *(const LAS i32x4a*)(vs_ + 1 * 512 + 2048); vf1 = __builtin_shufflevector(a, b, 0, 1, 2, 3, 4, 5, 6, 7); }
            asm volatile("" ::: "memory");
#pragma unroll
            for (int r = 0; r < 16; ++r) { p1[r] = __builtin_amdgcn_exp2f(p1[r] - msh); ps += p1[r]; }
            lrun[bk] += ps;
            pf[4] = (int)pk4_fp8(p1[0], p1[1], p1[2], p1[3]); pf[5] = (int)pk4_fp8(p1[4], p1[5], p1[6], p1[7]); pf[6] = (int)pk4_fp8(p1[8], p1[9], p1[10], p1[11]); pf[7] = (int)pk4_fp8(p1[12], p1[13], p1[14], p1[15]);
            asm volatile("" : "+v"(pf));
            { const i32x4a a = *(const LAS i32x4a*)(vs_ + 2 * 512), b = *(const LAS i32x4a*)(vs_ + 2 * 512 + 2048); vf2 = __builtin_shufflevector(a, b, 0, 1, 2, 3, 4, 5, 6, 7); }
            { const i32x4a a = *(const LAS i32x4a*)(vs_ + 3 * 512), b = *(const LAS i32x4a*)(vs_ + 3 * 512 + 2048); vf3 = __builtin_shufflevector(a, b, 0, 1, 2, 3, 4, 5, 6, 7); }
            asm volatile("v_mfma_scale_f32_32x32x64_f8f6f4 %0, %1, %2, %0, %3, %4 op_sel_hi:[0,0,0]" : "+v"(o[bk][0]) : "v"(vf0), "v"(pf), "v"(S1), "v"(SP));
            asm volatile("v_mfma_scale_f32_32x32x64_f8f6f4 %0, %1, %2, %0, %3, %4 op_sel_hi:[0,0,0]" : "+v"(o[bk][1]) : "v"(vf1), "v"(pf), "v"(S1), "v"(SP));
            asm volatile("v_mfma_scale_f32_32x32x64_f8f6f4 %0, %1, %2, %0, %3, %4 op_sel_hi:[0,0,0]" : "+v"(o[bk][2]) : "v"(vf2), "v"(pf), "v"(S1), "v"(SP));
            asm volatile("v_mfma_scale_f32_32x32x64_f8f6f4 %0, %1, %2, %0, %3, %4 op_sel_hi:[0,0,0]" : "+v"(o[bk][3]) : "v"(vf3), "v"(pf), "v"(S1), "v"(SP));
#else
            float ps = 0.f; const float msh = mrun[bk] - 6.0f;
#pragma unroll
            for (int r = 0; r < 16; ++r) { p0[r] = __builtin_amdgcn_exp2f(p0[r] - msh); p1[r] = __builtin_amdgcn_exp2f(p1[r] - msh); ps += p0[r] + p1[r]; }
            lrun[bk] += ps;
            i32x8a pf;
            pf[0] = (int)pk4_fp8(p0[0], p0[1], p0[2], p0[3]); pf[1] = (int)pk4_fp8(p0[4], p0[5], p0[6], p0[7]); pf[2] = (int)pk4_fp8(p0[8], p0[9], p0[10], p0[11]); pf[3] = (int)pk4_fp8(p0[12], p0[13], p0[14], p0[15]);
            pf[4] = (int)pk4_fp8(p1[0], p1[1], p1[2], p1[3]); pf[5] = (int)pk4_fp8(p1[4], p1[5], p1[6], p1[7]); pf[6] = (int)pk4_fp8(p1[8], p1[9], p1[10], p1[11]); pf[7] = (int)pk4_fp8(p1[12], p1[13], p1[14], p1[15]);
            asm volatile("" : "+v"(pf));
#if ATT_DEFER
            if (bk == 0) { pf_prev = pf; have_prev = true; } else
#endif
            {
#pragma unroll
            for (int db = 0; db < 4; ++db) { const i32x4a a = *(const LAS i32x4a*)(vs_ + db * 512), b = *(const LAS i32x4a*)(vs_ + db * 512 + 2048);
                const i32x8a vfd = __builtin_shufflevector(a, b, 0, 1, 2, 3, 4, 5, 6, 7);
                asm volatile("v_mfma_scale_f32_32x32x64_f8f6f4 %0, %1, %2, %0, %3, %4 op_sel_hi:[0,0,0]" : "+v"(o[bk][db]) : "v"(vfd), "v"(pf), "v"(S1), "v"(SP)); }
            }
#endif
#endif
        }
    }
    asm volatile("s_nop 15\n s_nop 15" ::: "memory");
#pragma unroll
    for (int bk = 0; bk < 2; ++bk) {
        const float lt = ATT_PERMLANE ? xhalf_sum(lrun[bk]) : lrun[bk] + __shfl_xor(lrun[bk], 32);
        const float il = 64.0f * ATT_OS / lt;
#if ATT_OWIDE
        unsigned ooff_ = (unsigned)(r32 * opitch + 16 * hi); asm volatile("" : "+v"(ooff_));
        GAS unsigned char* op = (GAS unsigned char*)Ow + (size_t)(128 * bk) * opitch + ooff_;
#pragma unroll
        for (int db = 0; db < 4; ++db) {
            unsigned w[4];
#pragma unroll
            for (int rg = 0; rg < 4; ++rg) w[rg] = pk4_fp8(o[bk][db][4 * rg] * il, o[bk][db][4 * rg + 1] * il, o[bk][db][4 * rg + 2] * il, o[bk][db][4 * rg + 3] * il);
            const auto s02 = __builtin_amdgcn_permlane32_swap(w[0], w[2], false, false);
            const auto s13 = __builtin_amdgcn_permlane32_swap(w[1], w[3], false, false);
            v4u ov; ov.x = s02[0]; ov.y = s02[1]; ov.z = s13[0]; ov.w = s13[1];
            *(GAS v4u*)(op + 32 * db) = ov;
            __builtin_amdgcn_sched_barrier(0);
        }
    }
#else
        GAS unsigned char* op = (GAS unsigned char*)Ow + (size_t)(128 * bk + r32) * opitch + 4 * hi;
#pragma unroll
        for (int db = 0; db < 4; ++db)
#pragma unroll
            for (int rg = 0; rg < 4; ++rg) *(GAS unsigned*)(op + 32 * db + 8 * rg) = pk4_fp8(o[bk][db][4 * rg] * il, o[bk][db][4 * rg + 1] * il, o[bk][db][4 * rg + 2] * il, o[bk][db][4 * rg + 3] * il);
    }
#endif
    asm volatile("s_waitcnt vmcnt(0) lgkmcnt(0)" ::: "memory");
    att_bar4(bctr, nbar, lane);
#undef A2_ISSUE
#undef A2_PIECE
#undef A2_SPREAD
}
struct Frame {
    LAS unsigned char* lds;
    volatile LAS unsigned* MISC;
    gu32* ctl;
    int tid, lane, wave, vcu, G;
    unsigned char* ws;
};
#define WSP(T_, off) ((T_*)(F.ws + (off)))

template <int PART>
__device__ __forceinline__ void p0_prologue(Frame& F, const float* const* in, const int rank = 0, const int nrank = 0) {
    LAS float* scr = (LAS float*)(F.lds + RING_OFF + F.wave * 16640);
    const int gw = (PART == 1 ? rank : F.vcu) * NWAVES + F.wave, NGW = (PART == 1 ? nrank : F.G) * NWAVES, lane = F.lane;
    constexpr int I0 = 32 * 65, I1 = 32 * 96, I2 = 32 * 16, I3 = 32 * 16, I4 = 8 * 48, I5 = 8 * 64, I6 = 16 * 32, I7 = 32 * 32, I8 = 16 * 32, I9 = 32 * 32;
    constexpr int NITEMS = I0 + I1 + I2 + I3 + I4 + I5 + I6 + I7 + I8 + I9;
    bf16* W1T = WSP(bf16, WS_W1T);
    constexpr int NIT_A = I0 + I1 + I2 + I3;
    constexpr int NIT_B = (PRO_SPLIT == 2) ? NIT_A + I4 + I5 : NITEMS;
    const int it_lo = (PART == 1) ? NIT_A : 0, it_hi = (PART == 1) ? NIT_B : NITEMS;
    for (int it = it_lo + gw; it < it_hi; it += NGW) {
        if (PART == 0 && PRO_SPLIT && it >= NIT_A && it < NIT_B) continue;
        int r = it;
        if (r < I0) { const int kb = r / 65, cb = r % 65, c = 64 * cb;
            const int r0 = c < 3072 ? c : (c < 3136 ? 4096 + (c - 3072) : 3072 + (c - 3136));
            if (GATE_F8 && (UV_F8 == 1 || r0 >= (UV_F8 == 2 ? 1024 : 2048))) transpose_item64_f8(in[4], 4160, 64 * kb, c, WSP(unsigned char, WS_WG8U), 2048, r0, scr, lane, MOE_WSCALE);
            else transpose_item64(in[4], 4160, 64 * kb, c, W1T, HPITCH, r0, scr, lane);
            continue; } r -= I0;
        if (r < I1) { const int kb = r / 96, cb = r % 96;
            if (GATE_F8) transpose_item64_f8(in[5], 6144, 64 * kb, 64 * cb, WSP(unsigned char, WS_WG8), 2048, 9 * 256 + 64 * cb, scr, lane, MOE_WSCALE);
            else transpose_item64(in[5], 6144, 64 * kb, 64 * cb, W1T, HPITCH, P1_G + 64 * cb, scr, lane);
            continue; } r -= I1;
        if (r < I2) { const int kb = r / 16, cb = r % 16;
            if (GATE_F8) transpose_item64_f8(in[20], 1024, 64 * kb, 64 * cb, WSP(unsigned char, WS_WG8), 2048, 33 * 256 + 64 * cb, scr, lane, MOE_WSCALE);
            else transpose_item64(in[20], 1024, 64 * kb, 64 * cb, W1T, HPITCH, P1N + 64 * cb, scr, lane);
            continue; } r -= I2;
        if (r < I3) { const int kb = r / 16, cb = r % 16;
            if (GATE_F8) transpose_item64_f8(in[21], 1024, 64 * kb, 64 * cb, WSP(unsigned char, WS_WG8), 2048, 33 * 256 + 1024 + 64 * cb, scr, lane, MOE_WSCALE);
            else transpose_item64(in[21], 1024, 64 * kb, 64 * cb, W1T, HPITCH, P1N + 1024 + 64 * cb, scr, lane);
            continue; } r -= I3;
        if (r < I4) { const int kb = r / 48, cb = r % 48, hh = cb / 3, part = cb % 3;
            if (part < 2) transpose_item64_f8(in[13], 3072, 64 * kb, 64 * cb, WSP(unsigned char, WS_WUQT), 512, 256 * hh + 64 * part, scr, lane, UP_WSCALE);
            else transpose_item64_f8<true>(in[13], 3072, 64 * kb, 64 * cb, WSP(unsigned char, WS_WUQT), 512, 256 * hh + 128, scr, lane, UP_WSCALE);
            continue; } r -= I4;
        if (r < I5) { const int kb = r / 64, cb = r % 64; transpose_item64_f8(in[15], 4096, 64 * kb, 64 * cb, WSP(unsigned char, WS_WUKVT), 512, 64 * cb, scr, lane, UP_WSCALE); continue; } r -= I5;
        if (r < I6) { const int kb = r / 32, cb = r % 32; transpose_item64(in[11], 2048, 64 * kb, 64 * cb, WSP(bf16, WS_WPT), ABC_LD, 64 * cb, scr, lane, 0); continue; } r -= I6;
        if (r < I7) { const int kb = r / 32, cb = r % 32; transpose_item64_f8(in[18], 2048, 64 * kb, 64 * cb, WSP(unsigned char, WS_WPT) + ABC_BB, ABC_ROWB, 64 * cb, scr, lane, MOE_WSCALE); continue; } r -= I7;
        if (r < I8) { const int kb = r / 32, cb = r % 32; transpose_item64_f8(in[24], 2048, 64 * kb, 64 * cb, WSP(unsigned char, WS_WPT) + ABC_CB, ABC_ROWB, 64 * cb, scr, lane, MOE_WSCALE); continue; } r -= I8;
        { const int kb = r / 32, cb = r % 32; transpose_item64(in[25], 2048, 64 * kb, 64 * cb, WSP(bf16, WS_WOT), 2048, 64 * cb, scr, lane); }
    }
    if (PART == 1) return;
    const int gt = gw * 64 + lane, NGT = NGW * 64;
    for (int i = gt; i < 192 * 2048 / 8; i += NGT) { const int rr = i / 256, cc = i % 256; *(GAS v4u*)(W1T + (size_t)(4160 + rr) * HPITCH + (size_t)cc * 8) = (v4u){0u, 0u, 0u, 0u}; }
    if (GATE_F8) for (int i = gt; i < 192 * 2048 / 16; i += NGT) *(GAS v4u*)(WSP(unsigned char, WS_WG8) + (size_t)(2048 + 64) * 2048 + (size_t)i * 16) = (v4u){0u, 0u, 0u, 0u};
    for (int i = gt; i < 16 * 64 * 512 / 16; i += NGT) { const int hh = i / (64 * 512 / 16), q = i % (64 * 512 / 16); *(GAS v4u*)(WSP(unsigned char, WS_WUQT) + (size_t)(256 * hh + 192) * 512 + (size_t)q * 16) = (v4u){0u, 0u, 0u, 0u}; }
    { const float* wsrc = in[9]; bf16* wsm = WSP(bf16, WS_WSM);
      for (int i = gt; i < 8 * 128 * 128; i += NGT) { const int t = (i >> 7) & 127, s = i & 127; const float v = (s <= t) ? wsrc[i] : 0.f; wsm[i] = (bf16)(cvtpk(v, 0.f) & 0xffffu); } }
    { const float* rw = in[27]; const float* g2 = in[26]; float* rwg = WSP(float, WS_RWG);
#if ROUTER_BF16X2
      { bf16* wh = (bf16*)rwg; bf16* wl = wh + 32 * 2048;
        for (int i = gt; i < 2048 * 32; i += NGT) { const int k = i >> 5, ex = i & 31; const float w = rw[i] * g2[k];
            const unsigned h = cvtpk(w, 0.f) & 0xffffu; const float r = w - __uint_as_float(h << 16);
            wh[ex * 2048 + k] = (bf16)h; wl[ex * 2048 + k] = (bf16)(cvtpk(r, 0.f) & 0xffffu); } }
      (void)rwg; }
#else
      for (int i = gt; i < 2048 * 32; i += NGT) rwg[i] = rw[i] * g2[i >> 5]; }
#endif
    bf16* H = WSP(bf16, WS_H);
    for (int m = gw; m < T + MEMROWS; m += NGW) {
        if (m < T) rms_row_to_bf16(in[0] + (size_t)m * 2048, in[3], H + (size_t)m * HPITCH, lane, WSP(unsigned char, WS_H8) + (size_t)m * 2048);
        else rms_row_to_bf16(in[1] + (size_t)(m - T) * 2048, in[19], H + (size_t)m * HPITCH, lane, WSP(unsigned char, WS_H8) + (size_t)m * 2048);
    }
}

struct MoeItem { const float* src; size_t ldw; unsigned char* dst; int r0; int k0; };
__device__ __forceinline__ MoeItem moe_item(Frame& F, const float* const* in, int it) {
    constexpr int I10 = NE * 32 * 64;
    MoeItem m;
    if (it < I10) { const int e = it / 2048, q = it % 2048, kb = q / 64, cb = q % 64;
        m.r0 = cb < 32 ? 256 * (cb >> 1) + 64 * (cb & 1) : 256 * ((cb - 32) >> 1) + 128 + 64 * (cb & 1);
        m.src = in[29] + (size_t)e * 2048 * 4096 + (size_t)(64 * kb) * 4096 + 64 * cb; m.ldw = 4096; m.dst = WSP(unsigned char, WS_WGUT) + (size_t)e * 4096 * 2048; m.k0 = 64 * kb; }
    else { const int r = it - I10, e = r / 1024, q = r % 1024, kb = q / 32, cb = q % 32;
        m.r0 = 64 * cb; m.src = in[31] + (size_t)e * 2048 * 2048 + (size_t)(64 * kb) * 2048 + 64 * cb; m.ldw = 2048; m.dst = WSP(unsigned char, WS_WDT) + (size_t)e * 2048 * 2048; m.k0 = 64 * kb; }
    return m;
}
#define MOE_LOADS(v_, m_) do { const GAS float* src_ = (const GAS float*)(m_).src + (size_t)(4 * (lane >> 4)) * (m_).ldw + (lane & 15) * 4; \
        _Pragma("unroll") for (int j_ = 0; j_ < 4; ++j_) _Pragma("unroll") for (int r_ = 0; r_ < 4; ++r_) v_[4 * j_ + r_] = __builtin_nontemporal_load((const GAS f32x4*)(src_ + (size_t)(16 * j_ + r_) * (m_).ldw)); } while (0)
#define MOE_TOLDS(v_) do { LAS unsigned* s_ = scr + (4 * (lane & 15)) * 17 + (lane >> 4); \
        _Pragma("unroll") for (int j_ = 0; j_ < 4; ++j_) { \
            s_[0 * 17 + 4 * j_] = pk4_fp8(v_[4 * j_][0] * MOE_WSCALE, v_[4 * j_ + 1][0] * MOE_WSCALE, v_[4 * j_ + 2][0] * MOE_WSCALE, v_[4 * j_ + 3][0] * MOE_WSCALE); \
            s_[1 * 17 + 4 * j_] = pk4_fp8(v_[4 * j_][1] * MOE_WSCALE, v_[4 * j_ + 1][1] * MOE_WSCALE, v_[4 * j_ + 2][1] * MOE_WSCALE, v_[4 * j_ + 3][1] * MOE_WSCALE); \
            s_[2 * 17 + 4 * j_] = pk4_fp8(v_[4 * j_][2] * MOE_WSCALE, v_[4 * j_ + 1][2] * MOE_WSCALE, v_[4 * j_ + 2][2] * MOE_WSCALE, v_[4 * j_ + 3][2] * MOE_WSCALE); \
            s_[3 * 17 + 4 * j_] = pk4_fp8(v_[4 * j_][3] * MOE_WSCALE, v_[4 * j_ + 1][3] * MOE_WSCALE, v_[4 * j_ + 2][3] * MOE_WSCALE, v_[4 * j_ + 3][3] * MOE_WSCALE); } } while (0)
#define MOE_EMIT(m_) do { LDS_WAIT(); asm volatile("" ::: "memory"); \
        _Pragma("unroll") for (int jj_ = 0; jj_ < 4; ++jj_) { const int n_ = (lane >> 2) + 16 * jj_; const LAS unsigned* s_ = scr + n_ * 17 + 4 * (lane & 3); \
            v4u o_; o_.x = s_[0]; o_.y = s_[1]; o_.z = s_[2]; o_.w = s_[3]; \
            __builtin_nontemporal_store(o_, (GAS v4u*)((m_).dst + (size_t)((m_).r0 + n_) * 2048 + (m_).k0 + 16 * (lane & 3))); } \
        LDS_WAIT(); asm volatile("" ::: "memory"); } while (0)
template <int MODE>
__device__ __forceinline__ void moe_convert_share(Frame& F, const float* const* in) {
    LAS unsigned* scr = (LAS unsigned*)(F.lds + RING_OFF + F.wave * 4608);
    constexpr int NIT = NE * 32 * 64 + NE * 32 * 32;
    const int per = (NIT + F.G - 1) / F.G, lo = F.vcu * per, hi = (lo + per < NIT) ? lo + per : NIT, lane = F.lane;
    int it = lo + F.wave;
    f32x4 va[16], vb[16];
    MoeItem ma = moe_item(F, in, it < hi ? it : lo), mb = moe_item(F, in, it + NWAVES < hi ? it + NWAVES : lo);
    if (it < hi) MOE_LOADS(va, ma);
    if (it + NWAVES < hi) MOE_LOADS(vb, mb);
    for (; it < hi; it += 2 * NWAVES) {
        if (MODE == 0) MOE_TOLDS(va); else { _Pragma("unroll") for (int i_ = 0; i_ < 16; ++i_) asm volatile("" :: "v"(va[i_])); }
        const MoeItem na = moe_item(F, in, it + 2 * NWAVES < hi ? it + 2 * NWAVES : lo);
        if (it + 2 * NWAVES < hi) MOE_LOADS(va, na);
        if (MODE == 0) MOE_EMIT(ma);
        if (it + NWAVES < hi) {
            if (MODE == 0) MOE_TOLDS(vb); else { _Pragma("unroll") for (int i_ = 0; i_ < 16; ++i_) asm volatile("" :: "v"(vb[i_])); }
            const MoeItem nb = moe_item(F, in, it + 3 * NWAVES < hi ? it + 3 * NWAVES : lo);
            if (it + 3 * NWAVES < hi) MOE_LOADS(vb, nb);
            if (MODE == 0) MOE_EMIT(mb);
            mb = nb;
        }
        ma = na;
    }
    __syncthreads();
}
#define MOE_LOADS_ASM(v_, m_) do { const GAS float* src_ = (const GAS float*)(m_).src + (size_t)(4 * (lane >> 4)) * (m_).ldw + (lane & 15) * 4; \
        _Pragma("unroll") for (int j_ = 0; j_ < 4; ++j_) _Pragma("unroll") for (int r_ = 0; r_ < 4; ++r_) { const GAS float* p_ = src_ + (size_t)(16 * j_ + r_) * (m_).ldw; \
            asm volatile("global_load_dwordx4 %0, %1, off nt" : "=v"(v_[4 * j_ + r_]) : "v"(p_) : "memory"); } } while (0)
#define MOE_WAIT_ASM(v_, n_) asm volatile("s_waitcnt vmcnt(" #n_ ")" : "+v"(v_[0]), "+v"(v_[1]), "+v"(v_[2]), "+v"(v_[3]), "+v"(v_[4]), "+v"(v_[5]), "+v"(v_[6]), "+v"(v_[7]), \
        "+v"(v_[8]), "+v"(v_[9]), "+v"(v_[10]), "+v"(v_[11]), "+v"(v_[12]), "+v"(v_[13]), "+v"(v_[14]), "+v"(v_[15]) :: "memory")
__device__ __forceinline__ MoeItem moe_super(Frame& F, const float* const* in, int s) {
    constexpr int S10 = NE * 16 * 64;
    MoeItem m;
    if (s < S10) { const int e = s / 1024, q = s % 1024, kb = q / 64, cb = q % 64;
        m.r0 = cb < 32 ? 256 * (cb >> 1) + 64 * (cb & 1) : 256 * ((cb - 32) >> 1) + 128 + 64 * (cb & 1);
        m.src = in[29] + (size_t)e * 2048 * 4096 + (size_t)(128 * kb) * 4096 + 64 * cb; m.ldw = 4096; m.dst = WSP(unsigned char, WS_WGUT) + (size_t)e * 4096 * 2048; m.k0 = 128 * kb; }
    else { const int r = s - S10, e = r / 512, q = r % 512, kb = q / 32, cb = q % 32;
        m.r0 = 64 * cb; m.src = in[31] + (size_t)e * 2048 * 2048 + (size_t)(128 * kb) * 2048 + 64 * cb; m.ldw = 2048; m.dst = WSP(unsigned char, WS_WDT) + (size_t)e * 2048 * 2048; m.k0 = 128 * kb; }
    return m;
}
#define MOE_TOLDS33(v_, h_) do { LAS unsigned* s_ = scr + (4 * (lane & 15)) * 33 + (lane >> 4) + 16 * (h_); \
        _Pragma("unroll") for (int j_ = 0; j_ < 4; ++j_) { \
            s_[0 * 33 + 4 * j_] = pk4_fp8(v_[4 * j_][0] * MOE_WSCALE, v_[4 * j_ + 1][0] * MOE_WSCALE, v_[4 * j_ + 2][0] * MOE_WSCALE, v_[4 * j_ + 3][0] * MOE_WSCALE); \
            s_[1 * 33 + 4 * j_] = pk4_fp8(v_[4 * j_][1] * MOE_WSCALE, v_[4 * j_ + 1][1] * MOE_WSCALE, v_[4 * j_ + 2][1] * MOE_WSCALE, v_[4 * j_ + 3][1] * MOE_WSCALE); \
            s_[2 * 33 + 4 * j_] = pk4_fp8(v_[4 * j_][2] * MOE_WSCALE, v_[4 * j_ + 1][2] * MOE_WSCALE, v_[4 * j_ + 2][2] * MOE_WSCALE, v_[4 * j_ + 3][2] * MOE_WSCALE); \
            s_[3 * 33 + 4 * j_] = pk4_fp8(v_[4 * j_][3] * MOE_WSCALE, v_[4 * j_ + 1][3] * MOE_WSCALE, v_[4 * j_ + 2][3] * MOE_WSCALE, v_[4 * j_ + 3][3] * MOE_WSCALE); } } while (0)
#define MOE_EMIT33(m_) do { LDS_WAIT(); asm volatile("" ::: "memory"); \
        _Pragma("unroll") for (int jj_ = 0; jj_ < 8; ++jj_) { const int n_ = (lane >> 3) + 8 * jj_; const LAS unsigned* s_ = scr + n_ * 33 + 4 * (lane & 7); \
            v4u o_; o_.x = s_[0]; o_.y = s_[1]; o_.z = s_[2]; o_.w = s_[3]; \
            __builtin_nontemporal_store(o_, (GAS v4u*)((m_).dst + (size_t)((m_).r0 + n_) * 2048 + (m_).k0 + 16 * (lane & 7))); } \
        LDS_WAIT(); asm volatile("" ::: "memory"); } while (0)
template <int NW>
__device__ __forceinline__ void moe_convert_share_w(Frame& F, const float* const* in, const int cw, LAS unsigned* scr, const int lane) {
    constexpr int NSUP = NE * 16 * 64 + NE * 16 * 32, PER = NSUP / 256;
    static_assert(PER % NW == 0, "equal shares");
    const int lo = F.vcu * PER, hi = lo + PER;
    int it = lo + cw;
    f32x4 va[16], vb[16];
    MoeItem m = moe_super(F, in, it), mh = m;
    mh.src += (size_t)64 * m.ldw;
    MOE_LOADS_ASM(va, m);
    MOE_LOADS_ASM(vb, mh);
    bool first = true;
    for (; it < hi; it += NW) {
        MoeItem n = moe_super(F, in, it + NW < hi ? it + NW : lo), nh = n;
        nh.src += (size_t)64 * n.ldw;
        MOE_WAIT_ASM(va, 16);
        MOE_TOLDS33(va, 0);
        MOE_LOADS_ASM(va, n);
        MOE_WAIT_ASM(vb, 16);
        MOE_TOLDS33(vb, 1);
        MOE_LOADS_ASM(vb, nh);
        MOE_EMIT33(m);
        m = n; first = false;
    }
    MOE_WAIT_ASM(va, 0); MOE_WAIT_ASM(vb, 0);
}
#undef MOE_TOLDS33
#undef MOE_EMIT33
__device__ __forceinline__ MoeItem moe_super256(Frame& F, const float* const* in, int s) {
    constexpr int S10 = NE * 8 * 64;
    MoeItem m;
    if (s < S10) { const int e = s / 512, q = s % 512, kb = q / 64, cb = q % 64;
        m.r0 = cb < 32 ? 256 * (cb >> 1) + 64 * (cb & 1) : 256 * ((cb - 32) >> 1) + 128 + 64 * (cb & 1);
        m.src = in[29] + (size_t)e * 2048 * 4096 + (size_t)(256 * kb) * 4096 + 64 * cb; m.ldw = 4096; m.dst = WSP(unsigned char, WS_WGUT) + (size_t)e * 4096 * 2048; m.k0 = 256 * kb; }
    else { const int r = s - S10, e = r / 256, q = r % 256, kb = q / 32, cb = q % 32;
        m.r0 = 64 * cb; m.src = in[31] + (size_t)e * 2048 * 2048 + (size_t)(256 * kb) * 2048 + 64 * cb; m.ldw = 2048; m.dst = WSP(unsigned char, WS_WDT) + (size_t)e * 2048 * 2048; m.k0 = 256 * kb; }
    return m;
}
#define MOE_TOLDS65(v_, h_) do { LAS unsigned* s_ = scr + (4 * (lane & 15)) * 65 + (lane >> 4) + 16 * (h_); \
        _Pragma("unroll") for (int j_ = 0; j_ < 4; ++j_) { \
            s_[0 * 65 + 4 * j_] = pk4_fp8(v_[4 * j_][0] * MOE_WSCALE, v_[4 * j_ + 1][0] * MOE_WSCALE, v_[4 * j_ + 2][0] * MOE_WSCALE, v_[4 * j_ + 3][0] * MOE_WSCALE); \
            s_[1 * 65 + 4 * j_] = pk4_fp8(v_[4 * j_][1] * MOE_WSCALE, v_[4 * j_ + 1][1] * MOE_WSCALE, v_[4 * j_ + 2][1] * MOE_WSCALE, v_[4 * j_ + 3][1] * MOE_WSCALE); \
            s_[2 * 65 + 4 * j_] = pk4_fp8(v_[4 * j_][2] * MOE_WSCALE, v_[4 * j_ + 1][2] * MOE_WSCALE, v_[4 * j_ + 2][2] * MOE_WSCALE, v_[4 * j_ + 3][2] * MOE_WSCALE); \
            s_[3 * 65 + 4 * j_] = pk4_fp8(v_[4 * j_][3] * MOE_WSCALE, v_[4 * j_ + 1][3] * MOE_WSCALE, v_[4 * j_ + 2][3] * MOE_WSCALE, v_[4 * j_ + 3][3] * MOE_WSCALE); } } while (0)
#define MOE_EMIT65(m_) do { LDS_WAIT(); asm volatile("" ::: "memory"); \
        _Pragma("unroll") for (int jj_ = 0; jj_ < 16; ++jj_) { const int n_ = (lane >> 4) + 4 * jj_; const LAS unsigned* s_ = scr + n_ * 65 + 4 * (lane & 15); \
            v4u o_; o_.x = s_[0]; o_.y = s_[1]; o_.z = s_[2]; o_.w = s_[3]; \
            __builtin_nontemporal_store(o_, (GAS v4u*)((m_).dst + (size_t)((m_).r0 + n_) * 2048 + (m_).k0 + 16 * (lane & 15))); } \
        LDS_WAIT(); asm volatile("" ::: "memory"); } while (0)
#define MOE_Q(m_, q_) MoeItem{(m_).src + (size_t)(64 * (q_)) * (m_).ldw, (m_).ldw, (m_).dst, (m_).r0, (m_).k0}
template <int NW>
__device__ __forceinline__ void moe_convert_range256(Frame& F, const float* const* in, const int cw, LAS unsigned* scr, const int lane, const int lo, const int hi) {
    int it = lo + cw;
    f32x4 va[16], vb[16];
    MoeItem m = moe_super256(F, in, it);
    { const MoeItem q0 = MOE_Q(m, 0), q1 = MOE_Q(m, 1); MOE_LOADS_ASM(va, q0); MOE_LOADS_ASM(vb, q1); }
    bool first = true;
    for (; it < hi; it += NW) {
        const MoeItem n = moe_super256(F, in, it + NW < hi ? it + NW : lo);
        const MoeItem q2 = MOE_Q(m, 2), q3 = MOE_Q(m, 3), n0 = MOE_Q(n, 0), n1 = MOE_Q(n, 1);
        MOE_WAIT_ASM(va, 16);
        MOE_TOLDS65(va, 0); MOE_LOADS_ASM(va, q2);
        MOE_WAIT_ASM(vb, 16);
        MOE_TOLDS65(vb, 1); MOE_LOADS_ASM(vb, q3);
        MOE_WAIT_ASM(va, 16);
        MOE_TOLDS65(va, 2); MOE_LOADS_ASM(va, n0);
        MOE_WAIT_ASM(vb, 16);
        MOE_TOLDS65(vb, 3); MOE_LOADS_ASM(vb, n1);
        MOE_EMIT65(m);
        if (CONV_SLEEP > 0) __builtin_amdgcn_s_sleep(CONV_SLEEP);
        m = n; first = false;
    }
    MOE_WAIT_ASM(va, 0); MOE_WAIT_ASM(vb, 0);
}
constexpr int CONV_NSUP = NE * 8 * 64 + NE * 8 * 32, CONV_OFF_CUS = (CONV_OFFLOAD == 2) ? 160 : 128, CONV_OFF = CONV_OFFLOAD ? 8 * CONV_OFF_CUS : 0, CONV_PER5 = (CONV_NSUP - CONV_OFF) / 256;
static_assert((CONV_NSUP - CONV_OFF) % 256 == 0, "equal shares per workgroup");
template <int NW>
__device__ __forceinline__ void moe_convert_share_w256(Frame& F, const float* const* in, const int cw, LAS unsigned* scr, const int lane) {
    moe_convert_range256<NW>(F, in, cw, scr, lane, F.vcu * CONV_PER5, F.vcu * CONV_PER5 + CONV_PER5);
}
#undef MOE_TOLDS65
#undef MOE_EMIT65
#undef MOE_Q
#undef MOE_LOADS_ASM
#undef MOE_WAIT_ASM
#undef MOE_LOADS
#undef MOE_TOLDS
#undef MOE_EMIT

__device__ __forceinline__ void moe_convert_share_dma(Frame& F, const float* const* in) {
    LAS unsigned char* wbase = F.lds + RING_OFF + F.wave * 16640;
    LAS unsigned* tile2 = (LAS unsigned*)(wbase + 12288);
    constexpr int NIT = NE * 32 * 64 + NE * 32 * 32;
    const int per = (NIT + F.G - 1) / F.G, lo = F.vcu * per, hi = (lo + per < NIT) ? lo + per : NIT, lane = F.lane;
    const int nitems = (hi - lo - F.wave + NWAVES - 1) / NWAVES;
    if (nitems > 0) {
        const int nchunks = nitems * 4;
        const int ng = lane & 15, kr = lane >> 4;
#define CDMA_ISSUE(c_) do { const MoeItem m_ = moe_item(F, in, lo + F.wave + NWAVES * ((c_) >> 2)); const int kc_ = (c_) & 3; \
            const GAS unsigned char* g_ = (const GAS unsigned char*)m_.src + ((size_t)(16 * kc_ + kr) * m_.ldw + (size_t)ng * 4) * 4; LAS unsigned char* l_ = wbase + ((c_) % 3) * 4096; \
            _Pragma("unroll") for (int q_ = 0; q_ < 4; ++q_) __builtin_amdgcn_global_load_lds((const GAS unsigned*)(g_ + (size_t)(4 * q_) * m_.ldw * 4), (LAS unsigned*)(l_ + q_ * 1024), 16, 0, 2); } while (0)
        CDMA_ISSUE(0);
        if (nchunks > 1) CDMA_ISSUE(1);
        for (int c = 0; c < nchunks; ++c) {
            if (c + 2 < nchunks) { CDMA_ISSUE(c + 2); asm volatile("s_waitcnt vmcnt(8)" ::: "memory"); }
            else if (c + 1 < nchunks) asm volatile("s_waitcnt vmcnt(4)" ::: "memory");
            else asm volatile("s_waitcnt vmcnt(0)" ::: "memory");
            const LAS unsigned char* cb = wbase + (c % 3) * 4096 + (4 * kr) * 256 + ng * 16;
            const f32x4 r0 = *(const LAS f32x4*)(cb), r1 = *(const LAS f32x4*)(cb + 256), r2 = *(const LAS f32x4*)(cb + 512), r3 = *(const LAS f32x4*)(cb + 768);
            LAS unsigned* t2 = tile2 + (4 * ng) * 17 + 4 * (c & 3) + kr;
            t2[0 * 17] = pk4_fp8(r0[0] * MOE_WSCALE, r1[0] * MOE_WSCALE, r2[0] * MOE_WSCALE, r3[0] * MOE_WSCALE);
            t2[1 * 17] = pk4_fp8(r0[1] * MOE_WSCALE, r1[1] * MOE_WSCALE, r2[1] * MOE_WSCALE, r3[1] * MOE_WSCALE);
            t2[2 * 17] = pk4_fp8(r0[2] * MOE_WSCALE, r1[2] * MOE_WSCALE, r2[2] * MOE_WSCALE, r3[2] * MOE_WSCALE);
            t2[3 * 17] = pk4_fp8(r0[3] * MOE_WSCALE, r1[3] * MOE_WSCALE, r2[3] * MOE_WSCALE, r3[3] * MOE_WSCALE);
            LDS_WAIT(); asm volatile("" ::: "memory");
            if ((c & 3) == 3) {
                const MoeItem m = moe_item(F, in, lo + F.wave + NWAVES * (c >> 2));
#pragma unroll
                for (int jj = 0; jj < 4; ++jj) { const int n = (lane >> 2) + 16 * jj; const LAS unsigned* s = tile2 + n * 17 + 4 * (lane & 3);
                    v4u o; o.x = s[0]; o.y = s[1]; o.z = s[2]; o.w = s[3];
                    __builtin_nontemporal_store(o, (GAS v4u*)(m.dst + (size_t)(m.r0 + n) * 2048 + m.k0 + 16 * (lane & 3))); }
                LDS_WAIT(); asm volatile("" ::: "memory");
            }
        }
#undef CDMA_ISSUE
    }
    asm volatile("s_waitcnt vmcnt(0)" ::: "memory");
    __syncthreads();
}

struct MoeItem256 { const float* src; size_t ldw; unsigned char* dst; int rowbase; int rowmode; int k0; };
__device__ __forceinline__ MoeItem256 moe_item256(Frame& F, const float* const* in, int it) {
    constexpr int I10 = NE * 32 * 64;
    MoeItem256 m;
    if (it < I10) { const int e = it / 2048, q = it % 2048, kb = q / 16, cb = q % 16; const bool gate = cb < 8; const int grp0 = gate ? 2 * cb : 2 * (cb - 8);
        m.src = in[29] + (size_t)e * 2048 * 4096 + (size_t)(16 * kb) * 4096 + 256 * cb; m.ldw = 4096; m.dst = WSP(unsigned char, WS_WGUT) + (size_t)e * 4096 * 2048;
        m.rowbase = 256 * grp0 + (gate ? 0 : 128); m.rowmode = 1; m.k0 = 16 * kb; }
    else { const int r = it - I10, e = r / 1024, q = r % 1024, kb = q / 8, cb = q % 8;
        m.src = in[31] + (size_t)e * 2048 * 2048 + (size_t)(16 * kb) * 2048 + 256 * cb; m.ldw = 2048; m.dst = WSP(unsigned char, WS_WDT) + (size_t)e * 2048 * 2048;
        m.rowbase = 256 * cb; m.rowmode = 0; m.k0 = 16 * kb; }
    return m;
}
__device__ __forceinline__ void moe_convert_share_dma256(Frame& F, const float* const* in) {
    LAS unsigned char* wbase = F.lds + RING_OFF + F.wave * 16640;
    LAS unsigned* tile2 = (LAS unsigned*)(wbase + 12288);
    constexpr int NIT = NE * 32 * 64 + NE * 32 * 32;
    const int per = (NIT + F.G - 1) / F.G, lo = F.vcu * per, hi = (lo + per < NIT) ? lo + per : NIT, lane = F.lane;
    const int nitems = (hi - lo - F.wave + NWAVES - 1) / NWAVES;
    if (nitems > 0) {
        const int nchunks = nitems * 4;
#define C256_ISSUE(c_) do { const MoeItem256 m_ = moe_item256(F, in, lo + F.wave + NWAVES * ((c_) >> 2)); const int kc_ = (c_) & 3; \
            const GAS unsigned char* g_ = (const GAS unsigned char*)m_.src + ((size_t)(4 * kc_) * m_.ldw + (size_t)lane * 4) * 4; LAS unsigned char* l_ = wbase + ((c_) % 3) * 4096; \
            _Pragma("unroll") for (int r_ = 0; r_ < 4; ++r_) __builtin_amdgcn_global_load_lds((const GAS unsigned*)(g_ + (size_t)r_ * m_.ldw * 4), (LAS unsigned*)(l_ + r_ * 1024), 16, 0, 2); } while (0)
        C256_ISSUE(0);
        if (nchunks > 1) C256_ISSUE(1);
        for (int c = 0; c < nchunks; ++c) {
            if (c + 2 < nchunks) { C256_ISSUE(c + 2); asm volatile("s_waitcnt vmcnt(8)" ::: "memory"); }
            else if (c + 1 < nchunks) asm volatile("s_waitcnt vmcnt(4)" ::: "memory");
            else asm volatile("s_waitcnt vmcnt(0)" ::: "memory");
            const LAS float* cb = (const LAS float*)(wbase + (c % 3) * 4096) + lane;
            LAS unsigned* t2 = tile2 + (c & 3) * 256 + lane;
#pragma unroll
            for (int cc = 0; cc < 4; ++cc) t2[64 * cc] = pk4_fp8(cb[64 * cc] * MOE_WSCALE, cb[256 + 64 * cc] * MOE_WSCALE, cb[512 + 64 * cc] * MOE_WSCALE, cb[768 + 64 * cc] * MOE_WSCALE);
            LDS_WAIT(); asm volatile("" ::: "memory");
            if ((c & 3) == 3) {
                const MoeItem256 m = moe_item256(F, in, lo + F.wave + NWAVES * (c >> 2));
#pragma unroll
                for (int cc = 0; cc < 4; ++cc) { const LAS unsigned* s = tile2 + lane + 64 * cc;
                    v4u o; o.x = s[0]; o.y = s[256]; o.z = s[512]; o.w = s[768];
                    const int row = m.rowbase + (m.rowmode ? 256 * (cc >> 1) + lane + 64 * (cc & 1) : lane + 64 * cc);
                    __builtin_nontemporal_store(o, (GAS v4u*)(m.dst + (size_t)row * 2048 + m.k0)); }
                LDS_WAIT(); asm volatile("" ::: "memory");
            }
        }
#undef C256_ISSUE
    }
    asm volatile("s_waitcnt vmcnt(0)" ::: "memory");
    __syncthreads();
}

struct ConvState { int lo, nchunks, c, cw; };
template <int NCW>
__device__ __forceinline__ void conv_steps(Frame& F, const float* const* in, ConvState& S, LAS unsigned char* wbase, int nsteps, int lane) {
    LAS unsigned* tile2 = (LAS unsigned*)(wbase + 12288);
    const int ng = lane & 15, kr = lane >> 4;
#define CS_ISSUE(c_) do { const MoeItem m_ = moe_item(F, in, S.lo + S.cw + NCW * ((c_) >> 2)); const int kc_ = (c_) & 3; \
        const GAS unsigned char* g_ = (const GAS unsigned char*)m_.src + ((size_t)(16 * kc_ + kr) * m_.ldw + (size_t)ng * 4) * 4; LAS unsigned char* l_ = wbase + ((c_) % 3) * 4096; \
        _Pragma("unroll") for (int q_ = 0; q_ < 4; ++q_) __builtin_amdgcn_global_load_lds((const GAS unsigned*)(g_ + (size_t)(4 * q_) * m_.ldw * 4), (LAS unsigned*)(l_ + q_ * 1024), 16, 0, 2); } while (0)
    if (S.c < 0) { S.c = 0; if (S.nchunks > 0) CS_ISSUE(0); if (S.nchunks > 1) CS_ISSUE(1); }
    for (int st = 0; st < nsteps && S.c < S.nchunks; ++st) {
        const int c = S.c;
        if (c + 2 < S.nchunks) { CS_ISSUE(c + 2); asm volatile("s_waitcnt vmcnt(8)" ::: "memory"); }
        else if (c + 1 < S.nchunks) asm volatile("s_waitcnt vmcnt(4)" ::: "memory");
        else asm volatile("s_waitcnt vmcnt(0)" ::: "memory");
        const LAS unsigned char* cb = wbase + (c % 3) * 4096 + (4 * kr) * 256 + ng * 16;
        const f32x4 r0 = *(const LAS f32x4*)(cb), r1 = *(const LAS f32x4*)(cb + 256), r2 = *(const LAS f32x4*)(cb + 512), r3 = *(const LAS f32x4*)(cb + 768);
        LAS unsigned* t2 = tile2 + (4 * ng) * 17 + 4 * (c & 3) + kr;
        t2[0 * 17] = pk4_fp8(r0[0] * MOE_WSCALE, r1[0] * MOE_WSCALE, r2[0] * MOE_WSCALE, r3[0] * MOE_WSCALE);
        t2[1 * 17] = pk4_fp8(r0[1] * MOE_WSCALE, r1[1] * MOE_WSCALE, r2[1] * MOE_WSCALE, r3[1] * MOE_WSCALE);
        t2[2 * 17] = pk4_fp8(r0[2] * MOE_WSCALE, r1[2] * MOE_WSCALE, r2[2] * MOE_WSCALE, r3[2] * MOE_WSCALE);
        t2[3 * 17] = pk4_fp8(r0[3] * MOE_WSCALE, r1[3] * MOE_WSCALE, r2[3] * MOE_WSCALE, r3[3] * MOE_WSCALE);
        LDS_WAIT(); asm volatile("" ::: "memory");
        if ((c & 3) == 3) {
            const MoeItem m = moe_item(F, in, S.lo + S.cw + NCW * (c >> 2));
#pragma unroll
            for (int jj = 0; jj < 4; ++jj) { const int n = (lane >> 2) + 16 * jj; const LAS unsigned* s = tile2 + n * 17 + 4 * (lane & 3);
                v4u o; o.x = s[0]; o.y = s[1]; o.z = s[2]; o.w = s[3];
                __builtin_nontemporal_store(o, (GAS v4u*)(m.dst + (size_t)(m.r0 + n) * 2048 + m.k0 + 16 * (lane & 3))); }
            LDS_WAIT(); asm volatile("" ::: "memory");
        }
        S.c = c + 1;
    }
#undef CS_ISSUE
}

__device__ __forceinline__ float group16_sum(float v) { if (XL_FAST) return xl_sum16(v); v += __shfl_xor(v, 1); v += __shfl_xor(v, 2); v += __shfl_xor(v, 4); v += __shfl_xor(v, 8); return v; }
__device__ __forceinline__ void p2_token(Frame& F, const float* const* in, int t) {
    const int l = F.lane;
    const GAS bf16* row = (const GAS bf16*)WSP(bf16, WS_P1) + (size_t)t * P1N;
    { float a[8], b[8]; unpack8(*(const GAS v4u*)(row + P1_V + 16 * l), a); unpack8(*(const GAS v4u*)(row + P1_V + 16 * l + 8), b);
      float s = 0.f;
#pragma unroll
      for (int i = 0; i < 8; ++i) s += a[i] + b[i];
      const float mean = wave_sum(s) * (1.f / 1024.f); float q = 0.f;
#pragma unroll
      for (int i = 0; i < 8; ++i) { const float d0 = a[i] - mean, d1 = b[i] - mean; q += d0 * d0 + d1 * d1; }
      const float rstd = 1.0f * FAST_RSQ(wave_sum(q) * (1.f / 1024.f) + EPS);
      if (l == 0) { GAS float* vs = (GAS float*)WSP(float, WS_VSTAT) + (size_t)t * 2; vs[0] = mean; vs[1] = rstd; } }
#pragma unroll
    for (int w = 0; w < 2; ++w) {
        float a[8]; unpack8(*(const GAS v4u*)(row + (w ? P1_CKV : P1_CQ) + 8 * l), a);
        float s = 0.f;
#pragma unroll
        for (int i = 0; i < 8; ++i) s += a[i] * a[i];
        const float rs = 1.0f * FAST_RSQ(wave_sum(s) * (1.f / 512.f) + EPS);
        const GAS float* g = (const GAS float*)(w ? in[14] : in[12]) + 8 * l;
        const f32x4 g0 = *(const GAS f32x4*)g, g1 = *(const GAS f32x4*)(g + 4);
        float o[8] = {a[0] * rs * g0.x, a[1] * rs * g0.y, a[2] * rs * g0.z, a[3] * rs * g0.w, a[4] * rs * g1.x, a[5] * rs * g1.y, a[6] * rs * g1.z, a[7] * rs * g1.w};
        u32x2 w8; w8.x = pk4_fp8(o[0], o[1], o[2], o[3]); w8.y = pk4_fp8(o[4], o[5], o[6], o[7]);
        *(GAS u32x2*)((GAS unsigned char*)WSP(unsigned char, w ? WS_CKVN : WS_CQN) + (size_t)t * 512 + 8 * l) = w8;
    }
    { float a[8], b[8]; unpack8(*(const GAS v4u*)(row + P1_QM + 16 * l), a); unpack8(*(const GAS v4u*)(row + P1_QM + 16 * l + 8), b);
      float s = 0.f;
#pragma unroll
      for (int i = 0; i < 8; ++i) s += a[i] * a[i] + b[i] * b[i];
      const float rs = MEM_QSCALE * FAST_RSQ(group16_sum(s) * (1.f / 256.f) + EPS);
      const GAS float* g = (const GAS float*)in[22] + (l & 15) * 16;
      float ga[8], gb[8];
#pragma unroll
      for (int i = 0; i < 8; ++i) { ga[i] = g[i]; gb[i] = g[8 + i]; }
#pragma unroll
      for (int i = 0; i < 8; ++i) { a[i] *= rs * ga[i]; b[i] *= rs * gb[i]; }
      const int bb = t >> 12, tl = t & 4095, h = l >> 4;
      GAS bf16* dst = (GAS bf16*)WSP(bf16, WS_QMN) + ((size_t)((bb * 4 + h) * 4096 + tl)) * 256 + (l & 15) * 16;
      *(GAS v4u*)dst = packf8(a); *(GAS v4u*)(dst + 8) = packf8(b); }
    { float t1 = 0.f, t2 = 0.f;
      if (l < 32) { t1 = bflo((unsigned)row[P1_KR + l]); t2 = bflo((unsigned)row[P1_KR + 32 + l]); }
      const float ss = wave_sum(t1 * t1 + t2 * t2);
      if (l < 32) {
          const float pos = (float)((const GAS int*)in[2])[t];
          const float inv = 1.0f / powf(10000.0f, (float)(2 * l) / 64.0f);
          const float ang = pos * inv, c = cosf(ang), s = sinf(ang);
          GAS float* rp = (GAS float*)WSP(float, WS_ROPE) + (size_t)t * 64; rp[l] = c; rp[32 + l] = s;
          const GAS float* kg = (const GAS float*)in[17];
          const float a = t1 * kg[128 + l], b = t2 * kg[160 + l];
          GAS float* kr = (GAS float*)WSP(float, WS_KRR) + (size_t)t * 64; kr[l] = a * c - b * s; kr[32 + l] = a * s + b * c;
          if (l == 0) ((GAS float*)WSP(float, WS_KRSS))[t] = ss;
      } }
}
__device__ __forceinline__ void p2_memrow(Frame& F, const float* const* in, int m) {
    const int l = F.lane, bb = m >> 8, ml = m & 255, tile = ml >> 6, key = ml & 63, h = l >> 4, d0 = (l & 15) * 16;
    const GAS bf16* row = (const GAS bf16*)WSP(bf16, WS_MKV) + (size_t)m * 2048;
    { float a[8], b[8]; unpack8(*(const GAS v4u*)(row + 16 * l), a); unpack8(*(const GAS v4u*)(row + 16 * l + 8), b);
      float s = 0.f;
#pragma unroll
      for (int i = 0; i < 8; ++i) s += a[i] * a[i] + b[i] * b[i];
      const float rs = 1.0f * FAST_RSQ(group16_sum(s) * (1.f / 256.f) + EPS);
      const GAS float* g = (const GAS float*)in[23] + d0;
#pragma unroll
      for (int i = 0; i < 8; ++i) { a[i] *= rs * g[i]; b[i] *= rs * g[8 + i]; }
      GAS bf16* base = (GAS bf16*)WSP(bf16, WS_MKT) + (size_t)((bb * 4 + h) * 4 + tile) * (32 * 64 * 8);
      const int c0 = d0 >> 3;
      *(GAS v4u*)(base + ((size_t)c0 * 64 + key) * 8) = packf8(a); *(GAS v4u*)(base + ((size_t)(c0 + 1) * 64 + key) * 8) = packf8(b); }
    { const v4u a = *(const GAS v4u*)(row + 1024 + 16 * l), b = *(const GAS v4u*)(row + 1024 + 16 * l + 8);
      const int half = d0 >> 7, cb = (d0 & 127) >> 5, off = d0 & 31;
      GAS bf16* base = (GAS bf16*)WSP(bf16, WS_MVT) + (size_t)(((bb * 4 + h) * 2 + half) * 4 + tile) * (4 * 64 * 32);
      GAS bf16* dst = base + ((size_t)cb * 64 + key) * 32 + off;
      *(GAS v4u*)dst = a; *(GAS v4u*)(dst + 8) = b; }
}

__device__ __forceinline__ void gmlp_unit(Frame& F, const float* const* in, int u) {
    const int ci = u >> 3, g = u & 7, tok0 = ci * 128, tid = F.tid, l = F.lane, r32 = l & 31, hi = l >> 5;
    LAS bf16* VT = (LAS bf16*)(F.lds + RING_OFF);
    const GAS bf16* P1 = (const GAS bf16*)WSP(bf16, WS_P1);
    { const int s = tid >> 2, qd = tid & 3;
      const GAS float* vs = (const GAS float*)WSP(float, WS_VSTAT) + (size_t)(tok0 + s) * 2; const float mean = vs[0], rstd = vs[1];
      const GAS bf16* src = P1 + (size_t)(tok0 + s) * P1N + P1_V + g * 128 + qd * 32;
      const GAS float* lg = (const GAS float*)in[7] + g * 128 + qd * 32; const GAS float* lb = (const GAS float*)in[8] + g * 128 + qd * 32;
#pragma unroll
      for (int i = 0; i < 4; ++i) { float a[8]; unpack8(*(const GAS v4u*)(src + 8 * i), a);
#pragma unroll
          for (int k = 0; k < 8; ++k) { const int c = qd * 32 + 8 * i + k; const float v = (a[k] - mean) * rstd * lg[8 * i + k] + lb[8 * i + k]; VT[c * 136 + s] = (bf16)(cvtpk(v, 0.f) & 0xffffu); } } }
    __syncthreads();
    const int w = F.wave, tb = w >> 1, cbp = (w & 1) * 2;
    f32x16 acc[2];
#pragma unroll
    for (int r = 0; r < 16; ++r) { acc[0][r] = 0.f; acc[1][r] = 0.f; }
    const GAS bf16* wsm = (const GAS bf16*)WSP(bf16, WS_WSM) + ((size_t)(g * 128 + 32 * tb + r32)) * 128 + 8 * hi;
    for (int ks = 0; ks < 2 * (tb + 1); ++ks) {
        const bf16x8 af = *(const GAS bf16x8*)(wsm + 16 * ks);
#pragma unroll
        for (int cc = 0; cc < 2; ++cc) { const bf16x8 bfr = *(const LAS bf16x8*)(VT + (32 * (cbp + cc) + r32) * 136 + 16 * ks + 8 * hi);
            acc[cc] = __builtin_amdgcn_mfma_f32_32x32x16_bf16(af, bfr, acc[cc], 0, 0, 0); }
    }
    const GAS float* bs = (const GAS float*)in[10] + g * 128;
    GAS bf16* AO = (GAS bf16*)WSP(bf16, WS_ABC);
#pragma unroll
    for (int cc = 0; cc < 2; ++cc)
#pragma unroll
        for (int r = 0; r < 16; ++r) { const int t = 32 * tb + crow(r, hi), tok = tok0 + t, ch = g * 128 + 32 * (cbp + cc) + r32;
            const float uu = bflo((unsigned)P1[(size_t)tok * P1N + P1_U + ch]);
            AO[(size_t)tok * ABC_LD + ch] = (bf16)(cvtpk(uu * (acc[cc][r] + bs[t]), 0.f) & 0xffffu); }
    __syncthreads();
}

__device__ __forceinline__ void p4_token(Frame& F, const float* const* in, int t) {
    const int l = F.lane, bb = t >> 12, tl = t & 4095, tile = tl >> 6, key = tl & 63, h = l >> 2, sub = l & 3;
    const GAS float* rope = (const GAS float*)WSP(float, WS_ROPE) + (size_t)t * 64;
    { const GAS bf16* qr = (const GAS bf16*)WSP(bf16, WS_QRAW) + (size_t)t * 3072 + h * 192;
      float x[4][8], y[2][8];
#pragma unroll
      for (int i = 0; i < 4; ++i) unpack8(*(const GAS v4u*)(qr + sub * 32 + 8 * i), x[i]);
#pragma unroll
      for (int i = 0; i < 2; ++i) unpack8(*(const GAS v4u*)(qr + 128 + sub * 16 + 8 * i), y[i]);
      float s = 0.f;
#pragma unroll
      for (int i = 0; i < 4; ++i)
#pragma unroll
          for (int k = 0; k < 8; ++k) s += x[i][k] * x[i][k];
#pragma unroll
      for (int i = 0; i < 2; ++i)
#pragma unroll
          for (int k = 0; k < 8; ++k) s += y[i][k] * y[i][k];
      s += __shfl_xor(s, 1); s += __shfl_xor(s, 2);
      const float rs = 1.0f * FAST_RSQ(s * (1.f / 192.f) + EPS);
      const GAS float* qg = (const GAS float*)in[16];
      GAS bf16* dst = (GAS bf16*)WSP(bf16, WS_QF) + ((size_t)((bb * 16 + h) * 4096 + tl)) * 192;
#pragma unroll
      for (int i = 0; i < 4; ++i) {
#pragma unroll
          for (int k = 0; k < 8; ++k) x[i][k] *= rs * qg[sub * 32 + 8 * i + k] * MLA_QSCALE;
          *(GAS v4u*)(dst + sub * 32 + 8 * i) = packf8(x[i]); }
#pragma unroll
      for (int i = 0; i < 2; ++i) { float o[8];
#pragma unroll
          for (int k = 0; k < 8; ++k) { const float mine = y[i][k] * rs * qg[128 + sub * 16 + 8 * i + k]; const float other = __shfl_xor(mine, 2);
              const int j = (sub & 1) * 16 + 8 * i + k; const float c = rope[j], sn = rope[32 + j];
              o[k] = (sub < 2 ? mine * c - other * sn : other * sn + mine * c) * MLA_QSCALE; }
          *(GAS v4u*)(dst + 128 + sub * 16 + 8 * i) = packf8(o); } }
    { const GAS bf16* kr = (const GAS bf16*)WSP(bf16, WS_KVRAW) + (size_t)t * 4096 + h * 256;
      float x[4][8];
#pragma unroll
      for (int i = 0; i < 4; ++i) unpack8(*(const GAS v4u*)(kr + sub * 32 + 8 * i), x[i]);
      float s = 0.f;
#pragma unroll
      for (int i = 0; i < 4; ++i)
#pragma unroll
          for (int k = 0; k < 8; ++k) s += x[i][k] * x[i][k];
      s += __shfl_xor(s, 1); s += __shfl_xor(s, 2);
      s += ((const GAS float*)WSP(float, WS_KRSS))[t];
      const float rs = 1.0f * FAST_RSQ(s * (1.f / 192.f) + EPS);
      const GAS float* kg = (const GAS float*)in[17];
      GAS bf16* kbase = (GAS bf16*)WSP(bf16, WS_KFT) + (size_t)((bb * 16 + h) * 64 + tile) * (24 * 64 * 8);
#pragma unroll
      for (int i = 0; i < 4; ++i) {
#pragma unroll
          for (int k = 0; k < 8; ++k) x[i][k] *= rs * kg[sub * 32 + 8 * i + k];
          *(GAS v4u*)(kbase + ((size_t)(sub * 4 + i) * 64 + key) * 8) = packf8(x[i]); }
      const GAS float* krr = (const GAS float*)WSP(float, WS_KRR) + (size_t)t * 64 + sub * 16;
#pragma unroll
      for (int i = 0; i < 2; ++i) { float o[8];
#pragma unroll
          for (int k = 0; k < 8; ++k) o[k] = krr[8 * i + k] * rs;
          *(GAS v4u*)(kbase + ((size_t)(16 + 2 * sub + i) * 64 + key) * 8) = packf8(o); }
      GAS bf16* vdst = (GAS bf16*)WSP(bf16, WS_VFT) + (size_t)((bb * 16 + h) * 64 + tile) * (4 * 64 * 32) + ((size_t)sub * 64 + key) * 32;
#pragma unroll
      for (int i = 0; i < 4; ++i) *(GAS v4u*)(vdst + 8 * i) = *(const GAS v4u*)(kr + 128 + sub * 32 + 8 * i); }
}
__device__ __forceinline__ void p8_router(Frame& F, const float* const* in) {
    const int tid = F.tid, l = F.lane, r32 = l & 31, hi = l >> 5, w = F.wave, tk = w >> 2, kq = w & 3;
    LAS float* part = (LAS float*)(F.lds + RING_OFF);
    LAS float* ssp = part + 2 * 4 * 32 * 33;
    LAS int* lcnt = (LAS int*)(F.lds + LTAB_OFF) + 40;
    LAS int* gbase = lcnt + 32;
    const int tok0 = (blockIdx.x * 2 + tk) * 32;
    if (tid < 32) lcnt[tid] = 0;
#if ROUTER_BF16X2
    {   const GAS bf16* xr = (const GAS bf16*)WSP(bf16, WS_X1) + (size_t)(tok0 + r32) * 2048 + 8 * hi;
        const GAS bf16* wh = (const GAS bf16*)WSP(bf16, WS_RWG) + (size_t)r32 * 2048 + 8 * hi;
        f32x16 acc;
#pragma unroll
        for (int r = 0; r < 16; ++r) acc[r] = 0.f;
        float ss = 0.f;
#pragma unroll 4
        for (int it = 32 * kq; it < 32 * kq + 32; ++it) {
            const v4u aw = *(const GAS v4u*)(xr + 16 * it);
            const bf16x8 a = __builtin_bit_cast(bf16x8, aw);
            const bf16x8 bh = *(const GAS bf16x8*)(wh + 16 * it), bl = *(const GAS bf16x8*)(wh + 32 * 2048 + 16 * it);
            acc = __builtin_amdgcn_mfma_f32_32x32x16_bf16(a, bh, acc, 0, 0, 0);
            acc = __builtin_amdgcn_mfma_f32_32x32x16_bf16(a, bl, acc, 0, 0, 0);
            float fa[8]; unpack8(aw, fa);
            ss += ((fa[0] * fa[0] + fa[1] * fa[1]) + (fa[2] * fa[2] + fa[3] * fa[3])) + ((fa[4] * fa[4] + fa[5] * fa[5]) + (fa[6] * fa[6] + fa[7] * fa[7]));
        }
#else
    {   const GAS bf16* xr = (const GAS bf16*)WSP(bf16, WS_X1) + (size_t)(tok0 + r32) * 2048 + 4 * hi;
        const GAS float* rw = (const GAS float*)WSP(float, WS_RWG) + (size_t)(4 * hi) * 32 + r32;
        f32x16 acc;
#pragma unroll
        for (int r = 0; r < 16; ++r) acc[r] = 0.f;
        float ss = 0.f;
#pragma unroll 4
        for (int q = 64 * kq; q < 64 * kq + 64; ++q) {
            const u32x2 aw = *(const GAS u32x2*)(xr + 8 * q); f32x4 a; a.x = bflo(aw.x); a.y = bfhi(aw.x); a.z = bflo(aw.y); a.w = bfhi(aw.y);
            const GAS float* rq = rw + (size_t)(8 * q) * 32;
            const float b0 = rq[0], b1 = rq[32], b2 = rq[64], b3 = rq[96];
            acc = __builtin_amdgcn_mfma_f32_32x32x2f32(a.x, b0, acc, 0, 0, 0);
            acc = __builtin_amdgcn_mfma_f32_32x32x2f32(a.y, b1, acc, 0, 0, 0);
            acc = __builtin_amdgcn_mfma_f32_32x32x2f32(a.z, b2, acc, 0, 0, 0);
            acc = __builtin_amdgcn_mfma_f32_32x32x2f32(a.w, b3, acc, 0, 0, 0);
            ss += (a.x * a.x + a.y * a.y) + (a.z * a.z + a.w * a.w);
        }
#endif
        LAS float* pp = part + (size_t)((tk * 4 + kq) * 32) * 33;
#pragma unroll
        for (int r = 0; r < 16; ++r) pp[crow(r, hi) * 33 + r32] = acc[r];
        ssp[(tk * 4 + kq) * 64 + l] = ss;
    }
    __syncthreads();
    const bool sel = (kq == 0) && (l < 32);
    float v0 = -INFINITY, v1 = -INFINITY, v2 = -INFINITY, v3 = -INFINITY; int i0 = 0, i1 = 0, i2 = 0, i3 = 0; int lr0 = 0, lr1 = 0, lr2 = 0, lr3 = 0;
    if (sel) {
        float ss = 0.f;
#pragma unroll
        for (int k = 0; k < 4; ++k) ss += ssp[(tk * 4 + k) * 64 + l] + ssp[(tk * 4 + k) * 64 + 32 + l];
        const float rs = 1.0f * FAST_RSQ(ss * (1.f / 2048.f) + EPS);
        const GAS float* rb = (const GAS float*)in[28];
        const LAS float* pp = part + (size_t)(tk * 4 * 32 + l) * 33;
#pragma unroll
        for (int e = 0; e < 32; ++e) {
            const float x = ((pp[e] + pp[32 * 33 + e]) + (pp[2 * 32 * 33 + e] + pp[3 * 32 * 33 + e])) * rs + rb[e];
            if (x > v3) {
                if (x > v0) { v3 = v2; i3 = i2; v2 = v1; i2 = i1; v1 = v0; i1 = i0; v0 = x; i0 = e; }
                else if (x > v1) { v3 = v2; i3 = i2; v2 = v1; i2 = i1; v1 = x; i1 = e; }
                else if (x > v2) { v3 = v2; i3 = i2; v2 = x; i2 = e; }
                else { v3 = x; i3 = e; }
            }
        }
        lr0 = __hip_atomic_fetch_add(&lcnt[i0], 1, __ATOMIC_RELAXED, __HIP_MEMORY_SCOPE_WORKGROUP); lr1 = __hip_atomic_fetch_add(&lcnt[i1], 1, __ATOMIC_RELAXED, __HIP_MEMORY_SCOPE_WORKGROUP); lr2 = __hip_atomic_fetch_add(&lcnt[i2], 1, __ATOMIC_RELAXED, __HIP_MEMORY_SCOPE_WORKGROUP); lr3 = __hip_atomic_fetch_add(&lcnt[i3], 1, __ATOMIC_RELAXED, __HIP_MEMORY_SCOPE_WORKGROUP);
    }
    __syncthreads();
    if (tid < 32) { const int c = lcnt[tid]; gbase[tid] = c ? (int)__hip_atomic_fetch_add((unsigned*)(F.ctl + CW_CNT + CNT_STRIDE * tid), (unsigned)c, __ATOMIC_RELAXED, __HIP_MEMORY_SCOPE_AGENT) : 0; }
    __syncthreads();
    if (sel) {
        const int t = tok0 + l;
        const float e1 = expf(v1 - v0), e2 = expf(v2 - v0), e3 = expf(v3 - v0), inv = 1.0f / (1.0f + e1 + e2 + e3);
        GAS int* te = (GAS int*)WSP(int, WS_TKE) + t * 4; GAS int* tr = (GAS int*)WSP(int, WS_TKR) + t * 4; GAS float* tg = (GAS float*)WSP(float, WS_TKG) + t * 4;
        te[0] = i0; te[1] = i1; te[2] = i2; te[3] = i3;
        tr[0] = gbase[i0] + lr0; tr[1] = gbase[i1] + lr1; tr[2] = gbase[i2] + lr2; tr[3] = gbase[i3] + lr3;
        tg[0] = inv; tg[1] = e1 * inv; tg[2] = e2 * inv; tg[3] = e3 * inv;
    }
    __syncthreads();
}
__device__ __forceinline__ void build_moe_tab(Frame& F) {
    LAS int* tab = (LAS int*)(F.lds + LTAB_OFF);
#if CNT_SPREAD
    if (F.tid < NE) tab[40 + NE + NE + F.tid] = ((int)__hip_atomic_load(F.ctl + CW_CNT + CNT_STRIDE * F.tid, RLX_AGENT) + 255) >> 8;
    __syncthreads();
    if (F.tid == 0) { int s = 0; for (int e = 0; e < NE; ++e) { tab[e] = s; s += tab[40 + NE + NE + e]; } tab[NE] = s; }
    __syncthreads();
    if (F.tid < MAXBLK) { int e = 0; while (e < NE - 1 && tab[e + 1] <= F.tid) ++e; ((LAS unsigned char*)(tab + 136))[F.tid] = (unsigned char)e; }
    __syncthreads();
}
#else
    if (F.tid == 0) { int s = 0; for (int e = 0; e < NE; ++e) { tab[e] = s; s += ((int)__hip_atomic_load(F.ctl + CW_CNT + e, RLX_AGENT) + 255) >> 8; } tab[NE] = s; }
    __syncthreads();
}
#endif
__device__ __forceinline__ void p9_scatter_token(Frame& F, const float* const* in, int t) {
    const int lane = F.lane; const LAS int* tab = (const LAS int*)(F.lds + LTAB_OFF);
    const GAS u32x2* xr = (const GAS u32x2*)(WSP(bf16, WS_X1) + (size_t)t * 2048) + lane; const GAS f32x4* gr = (const GAS f32x4*)in[26] + lane;
    f32x4 v[8]; float s = 0.f;
#pragma unroll
    for (int j = 0; j < 8; ++j) { const u32x2 xw = xr[64 * j]; v[j].x = bflo(xw.x); v[j].y = bfhi(xw.x); v[j].z = bflo(xw.y); v[j].w = bfhi(xw.y); s += (v[j].x * v[j].x + v[j].y * v[j].y) + (v[j].z * v[j].z + v[j].w * v[j].w); }
    const float rs = 1.0f * FAST_RSQ(wave_sum(s) * (1.f / 2048.f) + EPS);
    unsigned w[8];
#pragma unroll
    for (int j = 0; j < 8; ++j) { const f32x4 g = gr[64 * j]; w[j] = pk4_fp8(v[j].x * rs * g.x, v[j].y * rs * g.y, v[j].z * rs * g.z, v[j].w * rs * g.w); }
    const GAS int* te = (const GAS int*)WSP(int, WS_TKE) + t * 4; const GAS int* tr = (const GAS int*)WSP(int, WS_TKR) + t * 4;
#pragma unroll
    for (int k = 0; k < 4; ++k) { const int e = te[k], rk = tr[k]; const size_t rowi = (size_t)tab[e] * 256 + rk;
        GAS unsigned* o4 = (GAS unsigned*)(WSP(unsigned char, WS_HS) + rowi * 2048) + lane;
#pragma unroll
        for (int j = 0; j < 8; ++j) o4[64 * j] = w[j]; }
}
__device__ __forceinline__ void p12_combine_token(Frame& F, float* out, int t) {
    const int lane = F.lane; const LAS int* tab = (const LAS int*)(F.lds + LTAB_OFF);
    const GAS u32x2* xr = (const GAS u32x2*)(WSP(bf16, WS_X1) + (size_t)t * 2048) + lane;
    f32x4 v[8];
#pragma unroll
    for (int j = 0; j < 8; ++j) { const u32x2 xw = xr[64 * j]; v[j].x = bflo(xw.x); v[j].y = bfhi(xw.x); v[j].z = bflo(xw.y); v[j].w = bfhi(xw.y); }
    const GAS int* te = (const GAS int*)WSP(int, WS_TKE) + t * 4; const GAS int* tr = (const GAS int*)WSP(int, WS_TKR) + t * 4; const GAS float* tg = (const GAS float*)WSP(float, WS_TKG) + t * 4;
#pragma unroll
    for (int k = 0; k < 4; ++k) { const int e = te[k], rk = tr[k]; const float g = tg[k]; const size_t rowi = (size_t)tab[e] * 256 + rk;
        const GAS unsigned* y4 = (const GAS unsigned*)(WSP(unsigned char, WS_Y) + rowi * 2048) + lane;
#pragma unroll
        for (int j = 0; j < 8; ++j) { const int yw = (int)y4[64 * j]; const f32x2 lo = __builtin_amdgcn_cvt_pk_f32_fp8(yw, false), hh = __builtin_amdgcn_cvt_pk_f32_fp8(yw, true);
            v[j].x += g * lo[0]; v[j].y += g * lo[1]; v[j].z += g * hh[0]; v[j].w += g * hh[1]; } }
    GAS f32x4* o = (GAS f32x4*)(out + (size_t)t * 2048) + lane;
#pragma unroll
    for (int j = 0; j < 8; ++j) o[64 * j] = v[j];
}

struct Args { const float* in[33]; float* out; unsigned char* ws; };
__global__ void __launch_bounds__(NWAVES * 64, 2) mk_fwd(Args args) {
    extern __shared__ __attribute__((aligned(16))) unsigned char lds[];
    Frame F;
    F.lds = (LAS unsigned char*)lds;
    F.MISC = (volatile LAS unsigned*)(F.lds + MISC_OFF);
    F.tid = threadIdx.x; F.lane = F.tid & 63; F.wave = __builtin_amdgcn_readfirstlane(F.tid >> 6);
    F.G = gridDim.x; { const int bx = blockIdx.x; F.vcu = (F.G % 8 == 0) ? (bx % 8) * (F.G / 8) + bx / 8 : bx; }
    F.ws = args.ws; F.ctl = (gu32*)(args.ws + WS_CTL);
    const float* const* in = args.in;
    for (int u = F.tid; u < (LDS_BYTES - LDSCTL_OFF) / 4; u += NWAVES * 64) ((LAS unsigned*)(F.lds + LDSCTL_OFF))[u] = 0u;
    __syncthreads();
#define PHASE_SEAM() do { xcd_barrier(bar); int l_ = pg8::pg8_lane(); asm volatile("" : "+v"(l_)); F.lane = l_; F.tid = F.wave * 64 + l_; } while (0)
    XcdBarrier bar = xcd_barrier_post((unsigned*)(F.ctl + CW_BAR), F.MISC + 8);
    const int gw = F.vcu * NWAVES + F.wave, NGW = F.G * NWAVES;
    typedef pg8::bf16_t pbf;

    for (int rep = 0; rep < REP_P0; ++rep) p0_prologue<0>(F, in);
    PHASE_SEAM();

    for (int rep = 0; rep < REP_P1; ++rep)
    {   pg8::Gemm g{WSP(pbf, WS_H), WSP(pbf, WS_W1T), T + MEMROWS, P1N + 2048, 2048, HPITCH, HPITCH};
        pg8::EpiP1 E{WSP(pbf, WS_P1), WSP(pbf, WS_MKV), in[6]};
        const int slot = (CONV_IN_P1 && (!ATTN_SPLIT || SPLIT_NOCONV) && rep == 0) ? (F.vcu % (GATE_F8 ? 5 : 10)) : 0;
        if (!(UV_F8 == 1 && GATE_F8))
        {   pg8::P1Order S; S.init(F.G, (int)blockIdx.x, 0, slot);
            pg8::gemm_phase<pg8::EpiP1, pg8::P1Order, GEMM_ALIGN, true>(F.lds + RING_OFF, g, S, E, F.wave); }
        if (CONV_IN_P1 && (!ATTN_SPLIT || SPLIT_NOCONV) && rep == 0) { __syncthreads(); if (CONV_DMA == 2) moe_convert_share_dma256(F, in); else if (CONV_DMA) moe_convert_share_dma(F, in); else moe_convert_share<0>(F, in); if (REP_CONV > 1) moe_convert_share<1>(F, in); }
        if (!(UV_F8 == 1 && GATE_F8))
        {   pg8::P1Order S; S.init(F.G, (int)blockIdx.x, slot, 1 << 20);
            pg8::gemm_phase<pg8::EpiP1, pg8::P1Order, GEMM_ALIGN, true>(F.lds + RING_OFF, g, S, E, F.wave); }
        if (GATE_F8) {
            pg8::Gemm g8{WSP(pbf, WS_H8), WSP(pbf, WS_WG8) - (size_t)8 * 256 * 1024, T + MEMROWS, 41 * 256, 1024, 1024, 1024, MOE_SW, MOE_SX};
            pg8::GateOrder SG; SG.init(F.G, (int)blockIdx.x);
            pg8::gemm_phase<pg8::EpiP1, pg8::GateOrder, GEMM_ALIGN, true, true, 0, (KROT_MASK & 4) != 0>(F.lds + RING_OFF, g8, SG, E, F.wave); }
        if (GATE_F8 && PRO_SPLIT == 1 && UV_F8 == 2 && rep == 0 && blockIdx.x >= 96) p0_prologue<1>(F, in, (int)blockIdx.x - 96, 160);
        if (GATE_F8 && PRO_SPLIT == 2 && UV_F8 == 2 && rep == 0 && blockIdx.x >= 224) p0_prologue<1>(F, in, (int)blockIdx.x - 224, 32);
        if (GATE_F8 && CONV_OFFLOAD && UV_F8 == 2 && rep == 0 && blockIdx.x >= 96 && blockIdx.x < 96 + CONV_OFF_CUS) {
            const int k0 = (CONV_NSUP - CONV_OFF) + 8 * ((int)blockIdx.x - 96);
            moe_convert_range256<8>(F, in, F.wave, (LAS unsigned*)(F.lds + RING_OFF + F.wave * 16640), F.lane, k0, k0 + 8); }
    }
    PHASE_SEAM();

    for (int rep = 0; rep < REP_P2; ++rep)
    for (int t = gw; t < T; t += NGW) p2_token(F, in, t);
    for (int m = gw; m < MEMROWS; m += NGW) p2_memrow(F, in, m);
    PHASE_SEAM();

    for (int rep = 0; rep < REP_P3; ++rep) {
    {   pg8::Gemm g{WSP(pbf, WS_CQN), WSP(pbf, WS_WUQT), T, 4096, 256, 256, 256, UP_SW, MOE_SX};
        pg8::StaticOrder S; S.init(T, 4096, F.G, (int)blockIdx.x);
#if ATTN_F8
        pg8::EpiQ8 E{(LAS float*)(F.lds + LEPI_OFF), in[16], WSP(float, WS_ROPE), WSP(unsigned char, WS_QF), MLA_QSCALE * 16.0f};
        pg8::gemm_phase<pg8::EpiQ8, pg8::StaticOrder, true, true, true>(F.lds + RING_OFF, g, S, E, F.wave);
#else
        pg8::EpiQ E{(LAS float*)(F.lds + LEPI_OFF), in[16], WSP(float, WS_ROPE), WSP(pbf, WS_QF), MLA_QSCALE};
        pg8::gemm_phase<pg8::EpiQ, pg8::StaticOrder, true, true, true>(F.lds + RING_OFF, g, S, E, F.wave);
#endif
    }
    {   pg8::Gemm g{WSP(pbf, WS_CKVN), WSP(pbf, WS_WUKVT), T, 4096, 256, 256, 256, UP_SW, MOE_SX};
        pg8::StaticOrder S; S.init(T, 4096, F.G, (int)blockIdx.x);
#if ATTN_F8
        pg8::EpiKV8 E{(LAS float*)(F.lds + LEPI_OFF), in[17], WSP(float, WS_KRSS), WSP(float, WS_KRR), WSP(unsigned char, WS_KFT), WSP(unsigned char, WS_VFT)};
        pg8::gemm_phase<pg8::EpiKV8, pg8::StaticOrder, true, true, true>(F.lds + RING_OFF, g, S, E, F.wave);
#else
        pg8::EpiKV E{(LAS float*)(F.lds + LEPI_OFF), in[17], WSP(float, WS_KRSS), WSP(float, WS_KRR), WSP(pbf, WS_KFT), WSP(pbf, WS_VFT)};
        pg8::gemm_phase<pg8::EpiKV, pg8::StaticOrder, true, true, true>(F.lds + RING_OFF, g, S, E, F.wave);
#endif
    }
    __syncthreads();
    for (int u = F.vcu; u < 1024; u += F.G) gmlp_unit(F, in, u);
    for (int u = F.vcu; u < 512; u += F.G) {
        const int half = u & 1, qb = (u >> 1) & 15, bh = u >> 5;
        const bf16* Q = WSP(bf16, WS_QMN) + ((size_t)bh * 4096 + qb * 256 + 32 * F.wave) * 256;
        const bf16* Kt = WSP(bf16, WS_MKT) + (size_t)bh * 4 * (32 * 64 * 8);
        const bf16* Vt = WSP(bf16, WS_MVT) + (size_t)(bh * 2 + half) * 4 * (4 * 64 * 32);
        unsigned char* O = WSP(unsigned char, WS_ABC) + ((size_t)(bh >> 2) * 4096 + qb * 256 + 32 * F.wave) * ABC_ROWB + ABC_CB + (bh & 3) * 256 + half * 128;
        attn_unit<256, 2, false>(F.lds + RING_OFF, Q, 256, Kt, Vt, 4, 0, O, ABC_ROWB, F.wave, F.lane);
    }
    }
    PHASE_SEAM();

#if ATTN_SPLIT
    {   const int s = F.vcu & 3;
#if !(ATTN_XCDMAP && ATTN_RB2)
        const int bh = F.vcu >> 2;
#endif
        constexpr int NIT = NE * 32 * 64 + NE * 32 * 32;
        ConvState cs; cs.lo = F.vcu * (NIT / 256); cs.cw = F.wave - 4; cs.c = -1;
        { const int nitems = (NIT / 256 - cs.cw + 3) / 4; cs.nchunks = (F.wave >= 4 && !SPLIT_NOCONV) ? nitems * 4 : 0; }
        LAS unsigned char* cbase = F.lds + RING_OFF + (ATT_PAIR && ATTN_RB2 ? 81920 : 61440) + (F.wave - 4) * 16640;
#if ATTN_RB2
#if ATTN_XCDMAP
#define P5_UNIT(i_) const int s16 = F.vcu & 15, s8 = (s16 + 8) & 15, qb = ((i_) == 0) ? s16 : ((i_) == 1) ? 15 - s16 : ((i_) == 2) ? s8 : 15 - s8, nt = 4 * (qb + 1), \
        bh = 8 * (F.vcu >> 5) + 2 * (i_) + ((F.vcu >> 4) & 1)
#else
#define P5_UNIT(i_) const int qb = ((i_) == 0) ? s : ((i_) == 1) ? 7 - s : ((i_) == 2) ? 8 + s : 15 - s, nt = 4 * (qb + 1)
#endif
#if ATT_REBAL
        LAS unsigned* bctr = (LAS unsigned*)(F.lds + MISC_OFF + 64);
        if (F.tid == 0) { bctr[0] = 0u; bctr[1] = 0u; }
        __syncthreads();
        const unsigned char* Kt = WSP(unsigned char, WS_KFT) + (size_t)bh * 64 * 12288;
        const unsigned char* Vt = WSP(unsigned char, WS_VFT) + (size_t)bh * 64 * 8192;
        if (F.wave < 4) {
            unsigned nbar = 0;
            const int nu = (s == 0) ? 2 : 3;
            for (int i = 0; i < nu; ++i) {
                const int qb = (s == 0) ? (i == 0 ? 15 : 13) : (s == 1) ? (i == 0 ? 14 : i == 1 ? 8 : 5) : (s == 2) ? (i == 0 ? 12 : i == 1 ? 9 : 6) : (i == 0 ? 11 : i == 1 ? 10 : 7);
                const unsigned char* Q = WSP(unsigned char, WS_QF) + ((size_t)bh * 4096 + qb * 256 + 32 * F.wave) * 192;
                unsigned char* O = WSP(unsigned char, WS_ABC) + ((size_t)(bh >> 4) * 4096 + qb * 256 + 32 * F.wave) * ABC_ROWB + ABC_BB + (bh & 15) * 128;
                attn8_unit2<true>(F.lds + RING_OFF, Q, Kt, Vt, 4 * (qb + 1), qb * 256 + 32 * F.wave, O, ABC_ROWB, F.wave, F.lane, bctr, nbar); }
        } else {
            moe_convert_share_w256<4>(F, in, F.wave - 4, (LAS unsigned*)cbase, F.lane);
            asm volatile("s_waitcnt vmcnt(0) lgkmcnt(0)" ::: "memory");
            unsigned nbar2 = 0; const int cw = F.wave - 4;
            att_bar4(bctr + 1, nbar2, F.lane);
            const int nu = (s == 3) ? 4 : 2;
            for (int i = 0; i < nu; ++i) {
                const int qh = (s == 0) ? (i == 0 ? 9 : 3) : (s == 1) ? (i == 0 ? 8 : 4) : (s == 2) ? (i == 0 ? 7 : 5) : (i == 0 ? 6 : i == 1 ? 2 : i == 2 ? 1 : 0);
                const unsigned char* Q = WSP(unsigned char, WS_QF) + ((size_t)bh * 4096 + qh * 128 + 32 * cw) * 192;
                unsigned char* O = WSP(unsigned char, WS_ABC) + ((size_t)(bh >> 4) * 4096 + qh * 128 + 32 * cw) * ABC_ROWB + ABC_BB + (bh & 15) * 128;
                attn8_unit<true, 4>(F.lds + RING_OFF + 61440, Q, Kt, Vt, 2 * (qh + 1), qh * 128 + 32 * cw, O, ABC_ROWB, cw, F.lane, bctr + 1, &nbar2); }
        }
#else
        LAS unsigned* bctr = (LAS unsigned*)(F.lds + MISC_OFF + 64);
        if (F.tid == 0) *bctr = 0u;
        __syncthreads();
        if (F.wave < 4) {
            unsigned nbar = 0;
            for (int rep = 0; rep < REP_P5; ++rep)
            for (int i = 0; i < 4; ++i) { P5_UNIT(i);
                const unsigned char* Q = WSP(unsigned char, WS_QF) + ((size_t)bh * 4096 + qb * 256 + 32 * F.wave) * 192;
                const unsigned char* Kt = WSP(unsigned char, WS_KFT) + (size_t)bh * 64 * 12288;
                const unsigned char* Vt = WSP(unsigned char, WS_VFT) + (size_t)bh * 64 * 8192;
                unsigned char* O = WSP(unsigned char, WS_ABC) + ((size_t)(bh >> 4) * 4096 + qb * 256 + 32 * F.wave) * ABC_ROWB + ABC_BB + (bh & 15) * 128;
                attn8_unit2<true>(F.lds + RING_OFF, Q, Kt, Vt, nt, qb * 256 + 32 * F.wave, O, ABC_ROWB, F.wave, F.lane, bctr, nbar); }
        } else {
#if !SPLIT_FREE
            int it = 0;
            for (int i = 0; i < 4; ++i) { P5_UNIT(i);
                for (int j = 0; j < nt; ++j, ++it) { conv_steps<4>(F, in, cs, cbase, 3, F.lane); __builtin_amdgcn_s_barrier(); asm volatile("" ::: "memory"); }
                __builtin_amdgcn_s_barrier(); asm volatile("" ::: "memory"); }
#endif
#if SPLIT_FREE == 2
            for (int rep = 0; rep < REP_CONV; ++rep) { if (CONV_ROWS == 256) moe_convert_share_w256<4>(F, in, F.wave - 4, (LAS unsigned*)cbase, F.lane); else moe_convert_share_w<4>(F, in, F.wave - 4, (LAS unsigned*)cbase, F.lane); }
            asm volatile("s_waitcnt vmcnt(0)" ::: "memory");
#else
            for (int rep = 0; rep < REP_CONV; ++rep) { cs.c = -1; conv_steps<4>(F, in, cs, cbase, 1 << 20, F.lane); asm volatile("s_waitcnt vmcnt(0)" ::: "memory"); }
#endif
        }
#endif
#undef P5_UNIT
#else
#define P5_UNIT(i_) const int qb = (((i_) >> 1) == 0) ? s : (((i_) >> 1) == 1) ? 7 - s : (((i_) >> 1) == 2) ? 8 + s : 15 - s, qh = 2 * qb + ((i_) & 1), nt = 2 * (qh + 1)
        if (F.wave < 4) {
            __builtin_amdgcn_s_setprio(SPLIT_PRIO);
            for (int i = 0; i < 8; ++i) { P5_UNIT(i);
                const unsigned char* Q = WSP(unsigned char, WS_QF) + ((size_t)bh * 4096 + qh * 128 + 32 * F.wave) * 192;
                const unsigned char* Kt = WSP(unsigned char, WS_KFT) + (size_t)bh * 64 * 12288;
                const unsigned char* Vt = WSP(unsigned char, WS_VFT) + (size_t)bh * 64 * 8192;
                unsigned char* O = WSP(unsigned char, WS_ABC) + ((size_t)(bh >> 4) * 4096 + qh * 128 + 32 * F.wave) * ABC_ROWB + ABC_BB + (bh & 15) * 128;
                attn8_unit<true, 4>(F.lds + RING_OFF, Q, Kt, Vt, nt, qh * 128 + 32 * F.wave, O, ABC_ROWB, F.wave, F.lane); }
            __builtin_amdgcn_s_setprio(0);
        } else {
            int it = 0;
            for (int i = 0; i < 8; ++i) { P5_UNIT(i);
                for (int j = 0; j < nt; ++j, ++it) { conv_steps<4>(F, in, cs, cbase, CONV_QUOTA(it), F.lane); __builtin_amdgcn_s_barrier(); asm volatile("" ::: "memory"); }
                __builtin_amdgcn_s_barrier(); asm volatile("" ::: "memory"); }
            conv_steps<4>(F, in, cs, cbase, 1 << 20, F.lane); asm volatile("s_waitcnt vmcnt(0)" ::: "memory");
        }
#undef P5_UNIT
#endif
        __syncthreads();
    }
    PHASE_SEAM();

#else
    for (int rep = 0; rep < REP_P5; ++rep)
    {   const int bh = F.vcu >> 2, s = F.vcu & 3;
        for (int i = 0; i < 4; ++i) {
            if (!CONV_IN_P1 && rep == 0 && i == ((F.vcu >> 2) & 3)) { moe_convert_share<0>(F, in); if (REP_CONV > 1) moe_convert_share<1>(F, in); }
            const int qb = (i == 0) ? s : (i == 1) ? 7 - s : (i == 2) ? 8 + s : 15 - s;
#if ATTN_F8
            const unsigned char* Q = WSP(unsigned char, WS_QF) + ((size_t)bh * 4096 + qb * 256 + 32 * F.wave) * 192;
            const unsigned char* Kt = WSP(unsigned char, WS_KFT) + (size_t)bh * 64 * 12288;
            const unsigned char* Vt = WSP(unsigned char, WS_VFT) + (size_t)bh * 64 * 8192;
            unsigned char* O = WSP(unsigned char, WS_ABC) + ((size_t)(bh >> 4) * 4096 + qb * 256 + 32 * F.wave) * ABC_ROWB + ABC_BB + (bh & 15) * 128;
            attn8_unit<true>(F.lds + RING_OFF, Q, Kt, Vt, 4 * (qb + 1), qb * 256 + 32 * F.wave, O, ABC_ROWB, F.wave, F.lane);
#else
            const bf16* Q = WSP(bf16, WS_QF) + ((size_t)bh * 4096 + qb * 256 + 32 * F.wave) * 192;
            const bf16* Kt = WSP(bf16, WS_KFT) + (size_t)bh * 64 * (24 * 64 * 8);
            const bf16* Vt = WSP(bf16, WS_VFT) + (size_t)bh * 64 * (4 * 64 * 32);
            unsigned char* O = WSP(unsigned char, WS_ABC) + ((size_t)(bh >> 4) * 4096 + qb * 256 + 32 * F.wave) * ABC_ROWB + ABC_BB + (bh & 15) * 128;
            attn_unit<192, 3, true>(F.lds + RING_OFF, Q, 192, Kt, Vt, 4 * (qb + 1), qb * 256 + 32 * F.wave, O, ABC_ROWB, F.wave, F.lane);
#endif
        }
    }
    PHASE_SEAM();

#endif
    for (int rep = 0; rep < REP_P6; ++rep)
    {   pg8::Gemm g{WSP(pbf, WS_ABC), WSP(pbf, WS_WPT), T, 2048, ABC_LD, ABC_LD, ABC_LD, MOE_SW, ATT_OSB};
        pg8::StaticOrder S; S.init(T, 2048, F.G, (int)blockIdx.x);
        pg8::EpiMergedT<16, 32> E{WSP(pbf, WS_P1), WSP(pbf, WS_MERGED)};
        pg8::gemm_phase<pg8::EpiMergedT<16, 32>, pg8::StaticOrder, GEMM_ALIGN, true, false, 16>(F.lds + RING_OFF, g, S, E, F.wave);
    }
    PHASE_SEAM();

    for (int rep = 0; rep < REP_P7; ++rep)
    {   pg8::Gemm g{WSP(pbf, WS_MERGED), WSP(pbf, WS_WOT), T, 2048, 2048, 2048, 2048};
        pg8::StaticOrder S; S.init(T, 2048, F.G, (int)blockIdx.x);
        pg8::EpiX1 E{in[0], WSP(pbf, WS_X1)};
        pg8::gemm_phase<pg8::EpiX1, pg8::StaticOrder, P7_ALIGN, true>(F.lds + RING_OFF, g, S, E, F.wave);
    }
    PHASE_SEAM();

    p8_router(F, in);
    PHASE_SEAM();

    build_moe_tab(F);
    for (int rep = 0; rep < REP_P9; ++rep)
    for (int t = gw; t < T; t += NGW) p9_scatter_token(F, in, t);
    PHASE_SEAM();

    for (int rep = 0; rep < REP_P10; ++rep)
    {   pg8::Gemm g{WSP(pbf, WS_HS), WSP(pbf, WS_WGUT), MAXSLOT, NE * 4096, 1024, 1024, 1024, MOE_SW, MOE_SX};
        pg8::MoeOrder S{(const LAS int*)(F.lds + LTAB_OFF), 16, (int)(blockIdx.x & 7), (int)(blockIdx.x >> 3)};
        pg8::EpiSwiGLU E{in[30], WSP(unsigned char, WS_ACT)};
#if P10_PROBE
        if (rep > 0) { pg8::EpiSwiGLUProbe<P10_PROBE> EP; EP.bgu = E.bgu; EP.ACT = E.ACT;
            pg8::gemm_phase<pg8::EpiSwiGLUProbe<P10_PROBE>, pg8::MoeOrder, GEMM_ALIGN, true, true>(F.lds + RING_OFF, g, S, EP, F.wave); }
        else
#endif
        pg8::gemm_phase<pg8::EpiSwiGLU, pg8::MoeOrder, GEMM_ALIGN, true, true, 0, (KROT_MASK & 1) != 0, (PFETCH_MASK & 1) != 0>(F.lds + RING_OFF, g, S, E, F.wave);
    }
    PHASE_SEAM();

    for (int rep = 0; rep < REP_P11; ++rep)
    {   pg8::Gemm g{WSP(pbf, WS_ACT), WSP(pbf, WS_WDT), MAXSLOT, NE * 2048, 1024, 1024, 1024, MOE_SW, MOE_SX};
        pg8::MoeOrder S{(const LAS int*)(F.lds + LTAB_OFF), 8, (int)(blockIdx.x & 7), (int)(blockIdx.x >> 3)};
        pg8::EpiDown E{in[32], WSP(unsigned char, WS_Y)};
        pg8::gemm_phase<pg8::EpiDown, pg8::MoeOrder, GEMM_ALIGN, true, true, 0, (KROT_MASK & 2) != 0>(F.lds + RING_OFF, g, S, E, F.wave);
    }
    PHASE_SEAM();

    for (int rep = 0; rep < REP_P12; ++rep)
    for (int t = gw; t < T; t += NGW) p12_combine_token(F, args.out, t);
}

extern "C" void kernel_launch(void* const* d_in, const int* in_sizes, int n_in, void* d_out, int out_size, void* d_ws, size_t ws_size, hipStream_t stream) {
    static int grid = 0;
    if (grid == 0) {
        if (n_in != 33 || out_size != T * D || ws_size < WS_END) { fprintf(stderr, "kernel_launch: unexpected problem (n_in %d out %d ws %zu need %zu)\n", n_in, out_size, ws_size, (size_t)WS_END); grid = -1; return; }
        (void)in_sizes;
        if (hipFuncSetAttribute((const void*)mk_fwd, hipFuncAttributeMaxDynamicSharedMemorySize, LDS_BYTES) != hipSuccess) { fprintf(stderr, "kernel_launch: hipFuncSetAttribute failed\n"); grid = -1; return; }
        int per_cu = 0;
        if (hipOccupancyMaxActiveBlocksPerMultiprocessor(&per_cu, (const void*)mk_fwd, NWAVES * 64, LDS_BYTES) != hipSuccess || per_cu < 1) fprintf(stderr, "kernel_launch: occupancy query reports %d\n", per_cu);
        (void)hipGetLastError();
        grid = 256;
    }
    if (grid < 0) return;
    if (hipMemsetAsync((char*)d_ws + WS_CTL, 0, CTL_ZERO_BYTES, stream) != hipSuccess) { fprintf(stderr, "kernel_launch: memset failed\n"); return; }
    Args a{};
    for (int i = 0; i < 33; ++i) a.in[i] = (const float*)d_in[i];
    a.out = (float*)d_out; a.ws = (unsigned char*)d_ws;
    hipLaunchKernelGGL(mk_fwd, dim3(grid), dim3(NWAVES * 64), LDS_BYTES, stream, a);
}
```

```cpp
#include <hip/hip_runtime.h>
#include <cstdio>
#include <cstdint>
#include <cmath>
#ifndef REP_P0
#define REP_P0 1
#endif
#ifndef REP_P1
#define REP_P1 1
#endif
#ifndef REP_P3
#define REP_P3 1
#endif
#ifndef REP_P5
#define REP_P5 1
#endif
#ifndef REP_P6
#define REP_P6 1
#endif
#ifndef REP_P10
#define REP_P10 1
#endif
#ifndef REP_P11
#define REP_P11 1
#endif
#ifndef REP_CONV
#define REP_CONV 1
#endif
#ifndef ATTN_RB2
#define ATTN_RB2 1
#endif
#ifndef SPLIT_FREE
#define SPLIT_FREE 2
#endif
#ifndef CONV_ROWS
#define CONV_ROWS 256
#endif
#ifndef UV_F8
#define UV_F8 2
#endif
#ifndef ATTN_XCDMAP
#define ATTN_XCDMAP 0
#endif
#ifndef P10_PROBE
#define P10_PROBE 0
#endif
#ifndef KROT_MASK
#define KROT_MASK 0
#endif
#ifndef ROUTER_BF16X2
#define ROUTER_BF16X2 1
#endif
#ifndef CONV_OFFLOAD
#define CONV_OFFLOAD 1
#endif
#ifndef STAGE_IN_MMA
#define STAGE_IN_MMA 0
#endif
#ifndef ATT_SLEEP
#define ATT_SLEEP 0
#endif
#ifndef ATT_VPRE
#define ATT_VPRE 0
#endif
#ifndef KSEG_BATCH16
#define KSEG_BATCH16 0
#endif
#ifndef ATT_PAIR
#define ATT_PAIR 1
#endif
#ifndef PFETCH_MASK
#define PFETCH_MASK 0
#endif
#ifndef CONV_SLEEP
#define CONV_SLEEP 0
#endif
#ifndef ATT_REBAL
#define ATT_REBAL 0
#endif
#ifndef ATT_SPLITQK
#define ATT_SPLITQK 1
#endif
#ifndef ATT_DEFER
#define ATT_DEFER 0
#endif
#ifndef PRO_SPLIT
#define PRO_SPLIT 0
#endif
#ifndef ATT_PERMLANE
#define ATT_PERMLANE 1
#endif
#ifndef ATT_POLL_SLEEP
#define ATT_POLL_SLEEP 1
#endif
#ifndef ATT_SPREAD
#define ATT_SPREAD 0
#endif
#ifndef STAGE_AUX
#define STAGE_AUX 0
#endif
#ifndef MOE_MAP2
#define MOE_MAP2 0
#endif
#ifndef ATT_OWIDE
#define ATT_OWIDE 1
#endif
#ifndef XL_FAST
#define XL_FAST 1
#endif
#ifndef EPIX1_BATCH
#define EPIX1_BATCH 0
#endif
#ifndef CNT_SPREAD
#define CNT_SPREAD 1
#endif
#ifndef SPLIT_PRIO
#define SPLIT_PRIO 0
#endif
#ifndef SPLIT_NOCONV
#define SPLIT_NOCONV 0
#endif
#ifndef CONV_QUOTA
#define CONV_QUOTA(it) (1 + ((it) & 1))
#endif
#ifndef ATTN_SPLIT
#define ATTN_SPLIT 1
#endif
#ifndef P7_ALIGN
#define P7_ALIGN true
#endif
#ifndef ATTN_F8
#define ATTN_F8 1
#endif
#ifndef GATE_BF16SPLIT
#define GATE_BF16SPLIT 0
#endif
#ifndef GATE_SKIP
#define GATE_SKIP 0
#endif
#ifndef GATE_F8
#define GATE_F8 1
#endif
#ifndef CONV_DMA
#define CONV_DMA 1
#endif
#ifndef PITCH_PAD
#define PITCH_PAD 0
#endif
#ifndef GEMM_ALIGN
#define GEMM_ALIGN true
#endif
#ifndef CONV_IN_P1
#define CONV_IN_P1 1
#endif
#ifndef REP_P7
#define REP_P7 1
#endif
#ifndef REP_P2
#define REP_P2 1
#endif
#ifndef REP_P4
#define REP_P4 1
#endif
#ifndef REP_P9
#define REP_P9 1
#endif
#ifndef REP_P12
#define REP_P12 1
#endif
constexpr int NWAVES = 8;
constexpr int T = 16384, D = 2048, NBATCH = 4, SEQ = 4096;
constexpr int HPITCH = 2048 + PITCH_PAD;
constexpr int P1N = 10496;
constexpr int P1_U = 0, P1_V = 1024, P1_CQ = 2048, P1_CKV = 2560, P1_QM = 3072, P1_KR = 4096, P1_G = 4352;
constexpr int P1_TILES = 41, MEMROWS = 1024;
constexpr int NH = 16, QKD = 192, NOPE = 128, ROPE = 64, VD = 128;
constexpr int NE = 32, DFF = 2048, MAXBLK = 288, MAXSLOT = MAXBLK * 256;
constexpr float EPS = 1e-6f;
constexpr float LOG2E = 1.4426950408889634f;
constexpr float MLA_QSCALE = 0.07216878364870322f * LOG2E;
constexpr float MEM_QSCALE = 0.0625f * LOG2E;
constexpr float MOE_WSCALE = 64.0f;
constexpr unsigned MOE_SW = 0x79797979u, MOE_SX = 0x7f7f7f7fu;
constexpr float UP_WSCALE = 16.0f;
constexpr unsigned UP_SW = 0x7b7b7b7bu;

constexpr size_t MiB = 1u << 20;
constexpr size_t WS_CTL = 0, CTL_ZERO_BYTES = 1 * MiB;
constexpr size_t WS_W1T   = 1 * MiB;
constexpr size_t WS_WUQT  = WS_W1T + (size_t)(P1N + 2048) * HPITCH * 2;
constexpr size_t WS_WUKVT = WS_WUQT + (size_t)4096 * 512 * 2;
constexpr size_t WS_WPT   = WS_WUKVT + (size_t)4096 * 512 * 2;
constexpr size_t WS_WOT   = WS_WPT + (size_t)2048 * 4096 * 2;
constexpr size_t WS_WGUT  = WS_WOT + (size_t)2048 * 2048 * 2;
constexpr size_t WS_WDT   = WS_WGUT + (size_t)NE * 4096 * 2048 * 2;
constexpr size_t WS_WSM   = WS_WDT + (size_t)NE * 2048 * 2048 * 2;
constexpr size_t WS_RWG   = WS_WSM + (size_t)8 * 128 * 128 * 2;
constexpr size_t WS_H     = WS_RWG + (size_t)2048 * 32 * 4;
constexpr size_t WS_P1    = WS_H + (size_t)(T + MEMROWS) * HPITCH * 2;
constexpr size_t WS_MKV   = WS_P1 + (size_t)T * P1N * 2;
constexpr size_t WS_VSTAT = WS_MKV + (size_t)MEMROWS * 2048 * 2;
constexpr size_t WS_CQN   = WS_VSTAT + (size_t)T * 8;
constexpr size_t WS_CKVN  = WS_CQN + (size_t)T * 512 * 2;
constexpr size_t WS_QMN   = WS_CKVN + (size_t)T * 512 * 2;
constexpr size_t WS_KRR   = WS_QMN + (size_t)T * 1024 * 2;
constexpr size_t WS_KRSS  = WS_KRR + (size_t)T * 64 * 4;
constexpr size_t WS_ROPE  = WS_KRSS + (size_t)T * 4;
constexpr size_t WS_MKT   = WS_ROPE + (size_t)T * 64 * 4;
constexpr size_t WS_MVT   = WS_MKT + (size_t)MEMROWS * 1024 * 2;
constexpr size_t WS_QRAW  = WS_MVT + (size_t)MEMROWS * 1024 * 2;
constexpr size_t WS_KVRAW = WS_QRAW + (size_t)T * 3072 * 2;
constexpr size_t WS_QF    = WS_KVRAW + (size_t)T * 4096 * 2;
constexpr size_t WS_KFT   = WS_QF + (size_t)T * 3072 * 2;
constexpr size_t WS_VFT   = WS_KFT + (size_t)T * 3072 * 2;
constexpr size_t WS_ABC   = WS_VFT + (size_t)T * 2048 * 2;
constexpr int ABC_LD = 2560, ABC_ROWB = 5120, ABC_BB = 2048, ABC_CB = 4096;
constexpr float ATT_OS = 32.0f; constexpr unsigned ATT_OSB = 0x7a7a7a7au;
constexpr size_t WS_MERGED= WS_ABC + (size_t)T * 4096 * 2;
constexpr size_t WS_X1    = WS_MERGED + (size_t)T * 2048 * 2;
constexpr size_t WS_TKE   = WS_X1 + (size_t)T * 2048 * 4;
constexpr size_t WS_TKR   = WS_TKE + (size_t)T * 16;
constexpr size_t WS_TKG   = WS_TKR + (size_t)T * 16;
constexpr size_t WS_HS    = WS_TKG + (size_t)T * 16;
constexpr size_t WS_ACT   = WS_HS + (size_t)MAXSLOT * 2048 * 2;
constexpr size_t WS_Y     = WS_ACT + (size_t)MAXSLOT * 2048 * 2;
constexpr size_t WS_H8    = WS_Y + (size_t)MAXSLOT * 2048 * 2;
constexpr size_t WS_WG8U  = WS_H8 + (size_t)(T + MEMROWS) * 2048;
constexpr size_t WS_WG8   = WS_WG8U + (size_t)8 * 256 * 2048;
constexpr size_t WS_END   = WS_WG8 + (size_t)41 * 256 * 2048;
constexpr int CW_TMO = 0, CW_CODE = 1;
constexpr int CW_CNT = 64, CNT_STRIDE = CNT_SPREAD ? 32 : 1;
constexpr int CW_CNT_OLD_ = 64;
constexpr int CW_BAR = 4096;

constexpr int RING_OFF = 0, RING_BYTES = ATT_PAIR ? 148480 : 133120;
constexpr int LDSCTL_OFF = RING_BYTES, MISC_OFF = LDSCTL_OFF + 320;
constexpr int LTAB_OFF = LDSCTL_OFF + 1024;
constexpr int LEPI_OFF = LDSCTL_OFF + 2048;
constexpr int LDS_BYTES = RING_BYTES + 14336;

#define XL_DPP(v, ctrl) __uint_as_float((unsigned)__builtin_amdgcn_update_dpp(0, (int)__float_as_uint(v), ctrl, 0xf, 0xf, true))
__device__ __forceinline__ float xl_sum16(float v) { v += XL_DPP(v, 0xB1); v += XL_DPP(v, 0x4E); v += XL_DPP(v, 0x141); v += XL_DPP(v, 0x140); return v; }
__device__ __forceinline__ float xl_swap16_sum(float v) { const auto r = __builtin_amdgcn_permlane16_swap(__float_as_uint(v), __float_as_uint(v), false, false); return __uint_as_float(r[0]) + __uint_as_float(r[1]); }
__device__ __forceinline__ float xl_swap32_sum(float v) { const auto r = __builtin_amdgcn_permlane32_swap(__float_as_uint(v), __float_as_uint(v), false, false); return __uint_as_float(r[0]) + __uint_as_float(r[1]); }
__device__ __forceinline__ float xl_swap32_max(float v) { const auto r = __builtin_amdgcn_permlane32_swap(__float_as_uint(v), __float_as_uint(v), false, false); return fmaxf(__uint_as_float(r[0]), __uint_as_float(r[1])); }

#ifndef RSQ_FAST
#define RSQ_FAST 1
#endif
#if RSQ_FAST
#define FAST_RSQ(x) __builtin_amdgcn_rsqf(x)
#else
#define FAST_RSQ(x) (1.0f / sqrtf(x))
#endif
namespace pg8 {
#define PG8_LAS __attribute__((address_space(3)))
typedef unsigned short bf16_t;
typedef short bf16x8 __attribute__((ext_vector_type(8)));
typedef float f32x4 __attribute__((ext_vector_type(4)));
typedef unsigned u32x4 __attribute__((ext_vector_type(4)));
constexpr int BM = 256, BK = 64, HALF = 128, HTB = HALF * BK * 2  , STAGE_BYTES = 8 * HTB, NXCD = 8, WGM = 8;

__host__ __device__ __forceinline__ int lds_byte(int r, int c) { const int st = (r >> 4) * 2 + (c >> 5), rr = r & 15, cc = c & 31, ob = rr * 64 + cc * 2; return st * 1024 + (ob ^ (((ob >> 9) & 1) << 5)); }
__host__ __device__ __forceinline__ void stage_rc(int b, int& R, int& C) { const int st = b / 1024, sb = b % 1024, swz = sb ^ (((sb >> 9) & 1) << 5); R = (st >> 1) * 16 + swz / 64; C = (st & 1) * 32 + (swz % 64) / 2; }
__host__ __device__ __forceinline__ int perm32(int rho) { const int n = rho >> 4, i = rho & 15; return 8 * (i >> 2) + 4 * n + (i & 3); }

__device__ __forceinline__ int pg8_lane() { int l; asm volatile("v_mbcnt_lo_u32_b32 %0, -1, 0\n\tv_mbcnt_hi_u32_b32 %0, -1, %0" : "=v"(l)); return l; }
struct Unit { int pm, pn; int kr = 0; };
typedef int i32x4 __attribute__((ext_vector_type(4)));
typedef int i32x8 __attribute__((ext_vector_type(8)));
struct Gemm { const bf16_t* A; const bf16_t* Bt; int M, N, K, lda, ldb; unsigned sw = 0x7f7f7f7fu, sx = 0x7f7f7f7fu; };

struct StaticOrder {
    int nM, nN, nwg, G, c;
    __host__ __device__ void init(int M, int N, int G_, int c_) { nM = M / BM; nN = N / BM; nwg = nM * nN; G = G_; c = c_; }
    __host__ __device__ bool next(int i, Unit& u) const {
        const long L = (long)i * G + c; if (L >= nwg) return false;
        int wgid = (int)L; { const int q = nwg / NXCD, r = nwg % NXCD, xcd = wgid % NXCD, off = wgid / NXCD; wgid = (xcd < r ? xcd * (q + 1) : r * (q + 1) + (xcd - r) * q) + off; }
        const int nig = WGM * nN, gid = wgid / nig, fm = gid * WGM, gsz = (nM - fm) < WGM ? (nM - fm) : WGM;
        u.pm = fm + ((wgid % nig) % gsz); u.pn = (wgid % nig) / gsz; return true;
    }
    __device__ __forceinline__ void a_ready(const Unit&) const {}
    __device__ __forceinline__ void done(const Unit&) const {}
};

__device__ __forceinline__ unsigned cvt_pk_bf16(float lo, float hi) { unsigned r; asm volatile("v_cvt_pk_bf16_f32 %0, %1, %2" : "=v"(r) : "v"(lo), "v"(hi)); return r; }
typedef float f32x2 __attribute__((ext_vector_type(2)));

template <class E, class = void> struct probe_of { static constexpr int v = 0; };
template <class E> struct probe_of<E, decltype((void)E::PROBE)> { static constexpr int v = E::PROBE; };
template <class Epi, class Sched, bool ALIGN_EPI = false, bool SP2 = false, bool F8 = false, int MIXT = 0, bool KROT = false, bool PFETCH = false>
__device__ __forceinline__ void gemm_phase(PG8_LAS unsigned char* lds, const Gemm g, const Sched& S, const Epi& E, const int wave_) {
    int tid_ = wave_ * 64 + pg8_lane(); asm volatile("" : "+v"(tid_));
    const int tid = tid_, wid = __builtin_amdgcn_readfirstlane(tid >> 6), lane = tid & 63, wr = wid >> 2, wc = wid & 3, fr = lane & 15, fq = lane >> 4;
    const int K = g.K, nt = K / BK;
    unsigned voffA[2], voffB[2];
#pragma unroll
    for (int i = 0; i < 2; ++i) { int R, C; stage_rc(tid * 16 + i * 8192, R, C); const int Rb = Epi::PERM ? ((R & ~31) + perm32(R & 31)) : R;
        voffA[i] = (unsigned)(R * g.lda + C) * 2u; voffB[i] = (unsigned)(Rb * g.ldb + C) * 2u; }
    const size_t kstep = (size_t)(BK * 2);
    const size_t hstepA = (size_t)HALF * g.lda * 2, hstepB = (size_t)HALF * g.ldb * 2;
    const size_t tstepA = 2 * hstepA, tstepB = 2 * hstepB;
    const unsigned ldsw = (unsigned)wid * 1024u;
    unsigned pfoff = 0;
    if constexpr (PFETCH) { const int prow = wid * 32 + (lane & 31); pfoff = (lane < 32) ? (unsigned)(prow * g.lda) * 2u : (unsigned)(prow * g.ldb) * 2u; }
    PG8_LAS unsigned* const pfl = (PG8_LAS unsigned*)(lds + RING_BYTES + 8192 + wid * 256);
#define PG8_PF(baseA_, baseB_) do { if constexpr (PFETCH) { const char* pb_ = (lane < 32) ? (const char*)(baseA_) : (const char*)(baseB_); \
        __builtin_amdgcn_global_load_lds((const unsigned*)(pb_ + pfoff), pfl, 4, 0, 0); } } while (0)
#define PG8_WV1 do { if constexpr (PFETCH) PG8_WAIT_V(9); else PG8_WAIT_V(8); } while (0)
#define PG8_WV2 do { if constexpr (PFETCH) PG8_WAIT_V(10); else PG8_WAIT_V(8); } while (0)
    const int aoff = lds_byte(wr * 64 + fr, fq * 8), boff = lds_byte(wc * 32 + fr, fq * 8);
#define PG8_SA(b, h) (((b) * 2 + (h)) * HTB)
#define PG8_SB(b, h) ((4 + (b) * 2 + (h)) * HTB)
#define PG8_STAGE(bufoff, gbase, voff) do { if constexpr (probe_of<Epi>::v != 3) _Pragma("unroll") for (int _i = 0; _i < 2; ++_i) \
        __builtin_amdgcn_global_load_lds((const unsigned*)((const char*)(gbase) + (voff)[_i]), (PG8_LAS unsigned*)(lds + (bufoff) + ldsw + _i * 8192), 16, 0, STAGE_AUX); } while (0)
#define PG8_LDA(dst, b, h) do { if constexpr (probe_of<Epi>::v != 2) _Pragma("unroll") for (int m = 0; m < 4; ++m) _Pragma("unroll") for (int k = 0; k < 2; ++k) dst[m][k] = *(const PG8_LAS bf16x8*)(lds + PG8_SA(b, h) + aoff + m * 2048 + k * 1024); } while (0)
#define PG8_LDB(dst, b, h) do { if constexpr (probe_of<Epi>::v != 2) _Pragma("unroll") for (int n = 0; n < 2; ++n) _Pragma("unroll") for (int k = 0; k < 2; ++k) dst[n][k] = *(const PG8_LAS bf16x8*)(lds + PG8_SB(b, h) + boff + n * 2048 + k * 1024); } while (0)
#define PG8_MMA(ai, bj, At, Bt) do { __builtin_amdgcn_s_setprio(1); \
        if (F8 || (MIXT > 0 && f8now)) { _Pragma("unroll") for (int m = 0; m < 4; ++m) _Pragma("unroll") for (int n = 0; n < 2; ++n) { \
            const i32x8 a8_ = __builtin_shufflevector(__builtin_bit_cast(i32x4, At[m][0]), __builtin_bit_cast(i32x4, At[m][1]), 0, 1, 2, 3, 4, 5, 6, 7); \
            const i32x8 b8_ = __builtin_shufflevector(__builtin_bit_cast(i32x4, Bt[n][0]), __builtin_bit_cast(i32x4, Bt[n][1]), 0, 1, 2, 3, 4, 5, 6, 7); \
            if constexpr (probe_of<Epi>::v == 0 || probe_of<Epi>::v == 3) asm volatile("v_mfma_scale_f32_16x16x128_f8f6f4 %0, %1, %2, %0, %3, %4 op_sel_hi:[0,0,0]" : "+v"(acc[ai][bj][m][n]) : "v"(b8_), "v"(a8_), "v"(sw_), "v"(sx_)); \
            else asm volatile("" :: "v"(b8_), "v"(a8_)); } } \
        else { _Pragma("unroll") for (int m = 0; m < 4; ++m) _Pragma("unroll") for (int n = 0; n < 2; ++n) _Pragma("unroll") for (int k = 0; k < 2; ++k) \
            acc[ai][bj][m][n] = __builtin_amdgcn_mfma_f32_16x16x32_bf16(Bt[n][k], At[m][k], acc[ai][bj][m][n], 0, 0, 0); } \
        __builtin_amdgcn_s_setprio(0); } while (0)
#define PG8_STAGE1(bufoff, gbase, voff, i_) __builtin_amdgcn_global_load_lds((const unsigned*)((const char*)(gbase) + (voff)[i_]), (PG8_LAS unsigned*)(lds + (bufoff) + ldsw + (i_) * 8192), 16, 0, 0)
#define PG8_MMAS(ai, bj, At, Bt, M0, S0, M1, S1) do { __builtin_amdgcn_s_setprio(1); \
        if (F8 || (MIXT > 0 && f8now)) { _Pragma("unroll") for (int m = 0; m < 4; ++m) { _Pragma("unroll") for (int n = 0; n < 2; ++n) { \
            const i32x8 a8_ = __builtin_shufflevector(__builtin_bit_cast(i32x4, At[m][0]), __builtin_bit_cast(i32x4, At[m][1]), 0, 1, 2, 3, 4, 5, 6, 7); \
            const i32x8 b8_ = __builtin_shufflevector(__builtin_bit_cast(i32x4, Bt[n][0]), __builtin_bit_cast(i32x4, Bt[n][1]), 0, 1, 2, 3, 4, 5, 6, 7); \
            if constexpr (probe_of<Epi>::v == 0 || probe_of<Epi>::v == 3) asm volatile("v_mfma_scale_f32_16x16x128_f8f6f4 %0, %1, %2, %0, %3, %4 op_sel_hi:[0,0,0]" : "+v"(acc[ai][bj][m][n]) : "v"(b8_), "v"(a8_), "v"(sw_), "v"(sx_)); \
            else asm volatile("" :: "v"(b8_), "v"(a8_)); } \
            if (m == (M0)) { PG8_SCHED; S0; PG8_SCHED; } if (m == (M1)) { PG8_SCHED; S1; PG8_SCHED; } } } \
        else { _Pragma("unroll") for (int m = 0; m < 4; ++m) { _Pragma("unroll") for (int n = 0; n < 2; ++n) _Pragma("unroll") for (int k = 0; k < 2; ++k) \
            acc[ai][bj][m][n] = __builtin_amdgcn_mfma_f32_16x16x32_bf16(Bt[n][k], At[m][k], acc[ai][bj][m][n], 0, 0, 0); \
            if (m == (M0)) { PG8_SCHED; S0; PG8_SCHED; } if (m == (M1)) { PG8_SCHED; S1; PG8_SCHED; } } } \
        __builtin_amdgcn_s_setprio(0); } while (0)
#define PG8_WAIT_V(n) asm volatile("s_waitcnt vmcnt(" #n ")" ::: "memory")
#define PG8_WAIT_L(n) asm volatile("s_waitcnt lgkmcnt(" #n ")" ::: "memory")
#define PG8_BAR __builtin_amdgcn_s_barrier()
#define PG8_SCHED __builtin_amdgcn_sched_barrier(0)
    Unit cur, nxt; int ui = 0;
    if (!S.next(0, cur)) return;
    f32x4 acc[2][2][4][2];
#pragma unroll
    for (int a = 0; a < 2; ++a)
#pragma unroll
        for (int b = 0; b < 2; ++b)
#pragma unroll
            for (int m = 0; m < 4; ++m)
#pragma unroll
                for (int n = 0; n < 2; ++n) acc[a][b][m][n] = (f32x4){0.f, 0.f, 0.f, 0.f};
    bf16x8 At[4][2], B0[2][2], B1[2][2];
    if constexpr (probe_of<Epi>::v == 2) {
#pragma unroll
        for (int m = 0; m < 4; ++m)
#pragma unroll
            for (int k = 0; k < 2; ++k) At[m][k] = (bf16x8){0, 0, 0, 0, 0, 0, 0, 0};
#pragma unroll
        for (int n = 0; n < 2; ++n)
#pragma unroll
            for (int k = 0; k < 2; ++k) { B0[n][k] = (bf16x8){0, 0, 0, 0, 0, 0, 0, 0}; B1[n][k] = (bf16x8){0, 0, 0, 0, 0, 0, 0, 0}; }
    }
    const int sw_ = (int)g.sw, sx_ = (int)g.sx;
    const char* cA = (const char*)g.A + (size_t)cur.pm * tstepA; const char* cB = (const char*)g.Bt + (size_t)cur.pn * tstepB;
    const int krs = (KROT && MIXT == 0 && !Epi::KSEG && (nt & 15) == 0) ? (nt >> 3) : 0;
    int ckr = krs * (cur.kr & 7);
    const char* const pA = cA + (size_t)ckr * kstep; const char* const pB = cB + (size_t)ckr * kstep;
    S.a_ready(cur);
    if constexpr (SP2) {
        PG8_STAGE(PG8_SB(0, 0), pB, voffB); PG8_STAGE(PG8_SB(0, 1), pB + hstepB, voffB); PG8_STAGE(PG8_SA(0, 0), pA, voffA); PG8_STAGE(PG8_SA(0, 1), pA + hstepA, voffA);
        if (wr == 1) PG8_BAR;
        PG8_WAIT_V(2); PG8_BAR;
        PG8_STAGE(PG8_SB(1, 0), pB + kstep, voffB); PG8_STAGE(PG8_SA(1, 0), pA + kstep, voffA); PG8_STAGE(PG8_SB(1, 1), pB + hstepB + kstep, voffB);
        PG8_PF(pA + 2 * kstep, pB + 2 * kstep);
        if constexpr (PFETCH) PG8_WAIT_V(7); else PG8_WAIT_V(6);
        PG8_BAR;
    } else {
        PG8_STAGE(PG8_SB(0, 0), pB, voffB); PG8_STAGE(PG8_SA(0, 0), pA, voffA); PG8_STAGE(PG8_SB(0, 1), pB + hstepB, voffB); PG8_STAGE(PG8_SA(0, 1), pA + hstepA, voffA);
        if (wr == 1) PG8_BAR;
        PG8_WAIT_V(4); PG8_BAR;
        PG8_STAGE(PG8_SB(1, 0), pB + kstep, voffB); PG8_STAGE(PG8_SA(1, 0), pA + kstep, voffA); PG8_STAGE(PG8_SB(1, 1), pB + hstepB + kstep, voffB);
        PG8_WAIT_V(6); PG8_BAR;
    }
    for (;;) {
        const bool has_next = S.next(ui + 1, nxt);
        const char* nA = has_next ? (const char*)g.A + (size_t)nxt.pm * tstepA : cA; const char* nB = has_next ? (const char*)g.Bt + (size_t)nxt.pn * tstepB : cB;
        const int nkr = has_next ? krs * (nxt.kr & 7) : ckr;
        for (int t = 0; t < (MIXT > 0 ? MIXT : nt); t += 2) {
            constexpr bool f8now = false; (void)f8now;
            const bool last = (t == nt - 2);
            if constexpr (Epi::KSEG) { if (t == Epi::KSEG_T1 || t == Epi::KSEG_T2) { if constexpr (F8 || MIXT > 0) asm volatile("s_nop 15\n\ts_nop 15" ::: "memory"); E.kseg(acc, cur, t, wr, wc, fr, fq); } }
            int r0 = t + ckr; if (r0 >= nt) r0 -= nt; int r2 = r0 + 2; if (r2 >= nt) r2 -= nt;
            const char* a1 = cA + (size_t)(r0 + 1) * kstep;
            const char* a2 = last ? nA + (size_t)nkr * kstep : cA + (size_t)r2 * kstep; const char* b2 = last ? nB + (size_t)nkr * kstep : cB + (size_t)r2 * kstep;
            const char* a3 = a2 + kstep; const char* b3 = b2 + kstep;
            int r4 = t + 4, k4 = ckr; const char* pfa4 = cA; const char* pfb4 = cB;
            if (r4 >= nt) { r4 -= nt; k4 = nkr; pfa4 = nA; pfb4 = nB; }
            r4 += k4; if (r4 >= nt) r4 -= nt;
            pfa4 += (size_t)r4 * kstep; pfb4 += (size_t)r4 * kstep;
            if (last && has_next) S.a_ready(nxt);
            if constexpr (SP2) {
#if STAGE_IN_MMA
            PG8_LDB(B0, 0, 0); PG8_LDB(B1, 0, 1); PG8_SCHED; PG8_LDA(At, 0, 0);
            PG8_WAIT_V(6); PG8_WAIT_L(0); PG8_BAR;
            PG8_MMAS(0, 0, At, B0, 1, PG8_STAGE1(PG8_SA(1, 1), a1 + hstepA, voffA, 0), 9, (void)0); PG8_MMAS(0, 1, At, B1, 1, PG8_STAGE1(PG8_SA(1, 1), a1 + hstepA, voffA, 1), 9, (void)0); PG8_BAR; PG8_SCHED;
            PG8_LDA(At, 0, 1); PG8_STAGE(PG8_SB(0, 0), b2, voffB);
            PG8_WAIT_V(4); PG8_WAIT_L(0); PG8_BAR;
            PG8_MMAS(1, 0, At, B0, 0, PG8_STAGE1(PG8_SB(0, 1), b2 + hstepB, voffB, 0), 2, PG8_STAGE1(PG8_SB(0, 1), b2 + hstepB, voffB, 1));
            PG8_MMAS(1, 1, At, B1, 0, PG8_STAGE1(PG8_SA(0, 0), a2, voffA, 0), 2, PG8_STAGE1(PG8_SA(0, 0), a2, voffA, 1)); PG8_BAR; PG8_SCHED;
            PG8_LDB(B0, 1, 0); PG8_LDB(B1, 1, 1); PG8_SCHED; PG8_LDA(At, 1, 0);
            PG8_WAIT_V(6); PG8_WAIT_L(0); PG8_BAR;
            PG8_MMAS(0, 0, At, B0, 1, PG8_STAGE1(PG8_SA(0, 1), a2 + hstepA, voffA, 0), 9, (void)0); PG8_MMAS(0, 1, At, B1, 1, PG8_STAGE1(PG8_SA(0, 1), a2 + hstepA, voffA, 1), 9, (void)0); PG8_BAR; PG8_SCHED;
            PG8_LDA(At, 1, 1); PG8_STAGE(PG8_SB(1, 0), b3, voffB);
            PG8_WAIT_V(4); PG8_WAIT_L(0); PG8_BAR;
            PG8_MMAS(1, 0, At, B0, 0, PG8_STAGE1(PG8_SB(1, 1), b3 + hstepB, voffB, 0), 2, PG8_STAGE1(PG8_SB(1, 1), b3 + hstepB, voffB, 1));
            PG8_MMAS(1, 1, At, B1, 0, PG8_STAGE1(PG8_SA(1, 0), a3, voffA, 0), 2, PG8_STAGE1(PG8_SA(1, 0), a3, voffA, 1)); PG8_BAR; PG8_SCHED;
#else
            PG8_LDB(B0, 0, 0); PG8_LDB(B1, 0, 1); PG8_SCHED; PG8_LDA(At, 0, 0); PG8_STAGE(PG8_SA(1, 1), a1 + hstepA, voffA);
            PG8_WV1; PG8_WAIT_L(0); PG8_BAR; PG8_MMA(0, 0, At, B0); PG8_MMA(0, 1, At, B1); PG8_BAR; PG8_SCHED;
            PG8_LDA(At, 0, 1); PG8_STAGE(PG8_SB(0, 0), b2, voffB); PG8_STAGE(PG8_SB(0, 1), b2 + hstepB, voffB); PG8_STAGE(PG8_SA(0, 0), a2, voffA); PG8_PF(pfa4, pfb4);
            PG8_WV2; PG8_WAIT_L(0); PG8_BAR; PG8_MMA(1, 0, At, B0); PG8_MMA(1, 1, At, B1); PG8_BAR; PG8_SCHED;
            PG8_LDB(B0, 1, 0); PG8_LDB(B1, 1, 1); PG8_SCHED; PG8_LDA(At, 1, 0); PG8_STAGE(PG8_SA(0, 1), a2 + hstepA, voffA);
            PG8_WV1; PG8_WAIT_L(0); PG8_BAR; PG8_MMA(0, 0, At, B0); PG8_MMA(0, 1, At, B1); PG8_BAR; PG8_SCHED;
            PG8_LDA(At, 1, 1); PG8_STAGE(PG8_SB(1, 0), b3, voffB); PG8_STAGE(PG8_SB(1, 1), b3 + hstepB, voffB); PG8_STAGE(PG8_SA(1, 0), a3, voffA); PG8_PF(pfa4 + kstep, pfb4 + kstep);
            PG8_WV2; PG8_WAIT_L(0); PG8_BAR; PG8_MMA(1, 0, At, B0); PG8_MMA(1, 1, At, B1); PG8_BAR; PG8_SCHED;
#endif
            } else {
            PG8_LDB(B0, 0, 0); PG8_SCHED; PG8_LDA(At, 0, 0); PG8_STAGE(PG8_SA(1, 1), a1 + hstepA, voffA);
            PG8_WAIT_L(8); PG8_BAR; PG8_WAIT_L(0); PG8_MMA(0, 0, At, B0); PG8_BAR; PG8_SCHED;
            PG8_LDB(B1, 0, 1); PG8_STAGE(PG8_SB(0, 0), b2, voffB);
            PG8_BAR; PG8_WAIT_L(0); PG8_MMA(0, 1, At, B1); PG8_BAR;
            PG8_LDA(At, 0, 1); PG8_STAGE(PG8_SA(0, 0), a2, voffA);
            PG8_BAR; PG8_WAIT_L(0); PG8_MMA(1, 0, At, B0); PG8_BAR; PG8_SCHED;
            PG8_STAGE(PG8_SB(0, 1), b2 + hstepB, voffB);
            PG8_WAIT_V(6); PG8_BAR; PG8_MMA(1, 1, At, B1); PG8_BAR;
            PG8_LDB(B0, 1, 0); PG8_SCHED; PG8_LDA(At, 1, 0); PG8_STAGE(PG8_SA(0, 1), a2 + hstepA, voffA);
            PG8_WAIT_L(8); PG8_BAR; PG8_WAIT_L(0); PG8_MMA(0, 0, At, B0); PG8_BAR; PG8_SCHED;
            PG8_LDB(B1, 1, 1); PG8_STAGE(PG8_SB(1, 0), b3, voffB);
            PG8_BAR; PG8_WAIT_L(0); PG8_MMA(0, 1, At, B1); PG8_BAR;
            PG8_LDA(At, 1, 1); PG8_STAGE(PG8_SA(1, 0), a3, voffA);
            PG8_BAR; PG8_WAIT_L(0); PG8_MMA(1, 0, At, B0); PG8_BAR; PG8_SCHED;
            PG8_STAGE(PG8_SB(1, 1), b3 + hstepB, voffB);
            PG8_WAIT_V(6); PG8_BAR; PG8_MMA(1, 1, At, B1); PG8_BAR;
            }
                }
        if constexpr (MIXT > 0) for (int t = MIXT; t < nt; t += 2) {
            constexpr bool f8now = true; (void)f8now;
            const bool last = (t == nt - 2);
            if constexpr (Epi::KSEG) { if (t == Epi::KSEG_T1 || t == Epi::KSEG_T2) { if constexpr (F8 || MIXT > 0) asm volatile("s_nop 15\n\ts_nop 15" ::: "memory"); E.kseg(acc, cur, t, wr, wc, fr, fq); } }
            int r0 = t + ckr; if (r0 >= nt) r0 -= nt; int r2 = r0 + 2; if (r2 >= nt) r2 -= nt;
            const char* a1 = cA + (size_t)(r0 + 1) * kstep;
            const char* a2 = last ? nA + (size_t)nkr * kstep : cA + (size_t)r2 * kstep; const char* b2 = last ? nB + (size_t)nkr * kstep : cB + (size_t)r2 * kstep;
            const char* a3 = a2 + kstep; const char* b3 = b2 + kstep;
            int r4 = t + 4, k4 = ckr; const char* pfa4 = cA; const char* pfb4 = cB;
            if (r4 >= nt) { r4 -= nt; k4 = nkr; pfa4 = nA; pfb4 = nB; }
            r4 += k4; if (r4 >= nt) r4 -= nt;
            pfa4 += (size_t)r4 * kstep; pfb4 += (size_t)r4 * kstep;
            if (last && has_next) S.a_ready(nxt);
            if constexpr (SP2) {
#if STAGE_IN_MMA
            PG8_LDB(B0, 0, 0); PG8_LDB(B1, 0, 1); PG8_SCHED; PG8_LDA(At, 0, 0);
            PG8_WAIT_V(6); PG8_WAIT_L(0); PG8_BAR;
            PG8_MMAS(0, 0, At, B0, 1, PG8_STAGE1(PG8_SA(1, 1), a1 + hstepA, voffA, 0), 9, (void)0); PG8_MMAS(0, 1, At, B1, 1, PG8_STAGE1(PG8_SA(1, 1), a1 + hstepA, voffA, 1), 9, (void)0); PG8_BAR; PG8_SCHED;
            PG8_LDA(At, 0, 1); PG8_STAGE(PG8_SB(0, 0), b2, voffB);
            PG8_WAIT_V(4); PG8_WAIT_L(0); PG8_BAR;
            PG8_MMAS(1, 0, At, B0, 0, PG8_STAGE1(PG8_SB(0, 1), b2 + hstepB, voffB, 0), 2, PG8_STAGE1(PG8_SB(0, 1), b2 + hstepB, voffB, 1));
            PG8_MMAS(1, 1, At, B1, 0, PG8_STAGE1(PG8_SA(0, 0), a2, voffA, 0), 2, PG8_STAGE1(PG8_SA(0, 0), a2, voffA, 1)); PG8_BAR; PG8_SCHED;
            PG8_LDB(B0, 1, 0); PG8_LDB(B1, 1, 1); PG8_SCHED; PG8_LDA(At, 1, 0);
            PG8_WAIT_V(6); PG8_WAIT_L(0); PG8_BAR;
            PG8_MMAS(0, 0, At, B0, 1, PG8_STAGE1(PG8_SA(0, 1), a2 + hstepA, voffA, 0), 9, (void)0); PG8_MMAS(0, 1, At, B1, 1, PG8_STAGE1(PG8_SA(0, 1), a2 + hstepA, voffA, 1), 9, (void)0); PG8_BAR; PG8_SCHED;
            PG8_LDA(At, 1, 1); PG8_STAGE(PG8_SB(1, 0), b3, voffB);
            PG8_WAIT_V(4); PG8_WAIT_L(0); PG8_BAR;
            PG8_MMAS(1, 0, At, B0, 0, PG8_STAGE1(PG8_SB(1, 1), b3 + hstepB, voffB, 0), 2, PG8_STAGE1(PG8_SB(1, 1), b3 + hstepB, voffB, 1));
            PG8_MMAS(1, 1, At, B1, 0, PG8_STAGE1(PG8_SA(1, 0), a3, voffA, 0), 2, PG8_STAGE1(PG8_SA(1, 0), a3, voffA, 1)); PG8_BAR; PG8_SCHED;
#else
            PG8_LDB(B0, 0, 0); PG8_LDB(B1, 0, 1); PG8_SCHED; PG8_LDA(At, 0, 0); PG8_STAGE(PG8_SA(1, 1), a1 + hstepA, voffA);
            PG8_WV1; PG8_WAIT_L(0); PG8_BAR; PG8_MMA(0, 0, At, B0); PG8_MMA(0, 1, At, B1); PG8_BAR; PG8_SCHED;
            PG8_LDA(At, 0, 1); PG8_STAGE(PG8_SB(0, 0), b2, voffB); PG8_STAGE(PG8_SB(0, 1), b2 + hstepB, voffB); PG8_STAGE(PG8_SA(0, 0), a2, voffA); PG8_PF(pfa4, pfb4);
            PG8_WV2; PG8_WAIT_L(0); PG8_BAR; PG8_MMA(1, 0, At, B0); PG8_MMA(1, 1, At, B1); PG8_BAR; PG8_SCHED;
            PG8_LDB(B0, 1, 0); PG8_LDB(B1, 1, 1); PG8_SCHED; PG8_LDA(At, 1, 0); PG8_STAGE(PG8_SA(0, 1), a2 + hstepA, voffA);
            PG8_WV1; PG8_WAIT_L(0); PG8_BAR; PG8_MMA(0, 0, At, B0); PG8_MMA(0, 1, At, B1); PG8_BAR; PG8_SCHED;
            PG8_LDA(At, 1, 1); PG8_STAGE(PG8_SB(1, 0), b3, voffB); PG8_STAGE(PG8_SB(1, 1), b3 + hstepB, voffB); PG8_STAGE(PG8_SA(1, 0), a3, voffA); PG8_PF(pfa4 + kstep, pfb4 + kstep);
            PG8_WV2; PG8_WAIT_L(0); PG8_BAR; PG8_MMA(1, 0, At, B0); PG8_MMA(1, 1, At, B1); PG8_BAR; PG8_SCHED;
#endif
            } else {
            PG8_LDB(B0, 0, 0); PG8_SCHED; PG8_LDA(At, 0, 0); PG8_STAGE(PG8_SA(1, 1), a1 + hstepA, voffA);
            PG8_WAIT_L(8); PG8_BAR; PG8_WAIT_L(0); PG8_MMA(0, 0, At, B0); PG8_BAR; PG8_SCHED;
            PG8_LDB(B1, 0, 1); PG8_STAGE(PG8_SB(0, 0), b2, voffB);
            PG8_BAR; PG8_WAIT_L(0); PG8_MMA(0, 1, At, B1); PG8_BAR;
            PG8_LDA(At, 0, 1); PG8_STAGE(PG8_SA(0, 0), a2, voffA);
            PG8_BAR; PG8_WAIT_L(0); PG8_MMA(1, 0, At, B0); PG8_BAR; PG8_SCHED;
            PG8_STAGE(PG8_SB(0, 1), b2 + hstepB, voffB);
            PG8_WAIT_V(6); PG8_BAR; PG8_MMA(1, 1, At, B1); PG8_BAR;
            PG8_LDB(B0, 1, 0); PG8_SCHED; PG8_LDA(At, 1, 0); PG8_STAGE(PG8_SA(0, 1), a2 + hstepA, voffA);
            PG8_WAIT_L(8); PG8_BAR; PG8_WAIT_L(0); PG8_MMA(0, 0, At, B0); PG8_BAR; PG8_SCHED;
            PG8_LDB(B1, 1, 1); PG8_STAGE(PG8_SB(1, 0), b3, voffB);
            PG8_BAR; PG8_WAIT_L(0); PG8_MMA(0, 1, At, B1); PG8_BAR;
            PG8_LDA(At, 1, 1); PG8_STAGE(PG8_SA(1, 0), a3, voffA);
            PG8_BAR; PG8_WAIT_L(0); PG8_MMA(1, 0, At, B0); PG8_BAR; PG8_SCHED;
            PG8_STAGE(PG8_SB(1, 1), b3 + hstepB, voffB);
            PG8_WAIT_V(6); PG8_BAR; PG8_MMA(1, 1, At, B1); PG8_BAR;
            }
                }
        if constexpr (ALIGN_EPI) { if (wr == 0) PG8_BAR; }
        if constexpr (F8 || MIXT > 0) asm volatile("s_nop 15\n\ts_nop 15" ::: "memory");
        if constexpr (!Epi::AFTER_DRAIN) { E(acc, cur, wr, wc, fr, fq); S.done(cur); }
        if (!has_next) break;
#pragma unroll
        for (int a = 0; a < 2; ++a)
#pragma unroll
            for (int b = 0; b < 2; ++b)
#pragma unroll
                for (int m = 0; m < 4; ++m)
#pragma unroll
                    for (int n = 0; n < 2; ++n) acc[a][b][m][n] = (f32x4){0.f, 0.f, 0.f, 0.f};
        cur = nxt; cA = nA; cB = nB; ckr = nkr; ++ui;
        if constexpr (ALIGN_EPI) { if (wr == 1) PG8_BAR; }
    }
    PG8_WAIT_V(0);
    if constexpr (!ALIGN_EPI) { if (wr == 0) PG8_BAR; }
    PG8_BAR;
    if constexpr (Epi::AFTER_DRAIN) { E.fused(acc, cur, wr, wc, fr, fq, lds, wid, lane); S.done(cur); }
#undef PG8_SA
#undef PG8_SB
#undef PG8_STAGE
#undef PG8_PF
#undef PG8_WV1
#undef PG8_WV2
#undef PG8_LDA
#undef PG8_LDB
#undef PG8_MMA
#undef PG8_MMAS
#undef PG8_STAGE1
#undef PG8_WAIT_V
#undef PG8_WAIT_L
#undef PG8_BAR
#undef PG8_SCHED
}
}
namespace pg8 {
__device__ __forceinline__ float sigm(float z) { return __builtin_amdgcn_rcpf(1.0f + __builtin_amdgcn_exp2f(-z * 1.4426950408889634f)); }
typedef unsigned u32x2 __attribute__((ext_vector_type(2)));
__device__ __forceinline__ unsigned pk4f8(const f32x4 v) { int r = __builtin_amdgcn_cvt_pk_fp8_f32(v[0], v[1], 0, false); r = __builtin_amdgcn_cvt_pk_fp8_f32(v[2], v[3], r, true); return (unsigned)r; }
__device__ __forceinline__ u32x4 pack8(const f32x4 v0, const f32x4 v1) { u32x4 w; w.x = cvt_pk_bf16(v0[0], v0[1]); w.y = cvt_pk_bf16(v0[2], v0[3]); w.z = cvt_pk_bf16(v1[0], v1[1]); w.w = cvt_pk_bf16(v1[2], v1[3]); return w; }
__device__ __forceinline__ f32x4 bf_lo4(const u32x4 w) { f32x4 r; r[0] = __uint_as_float(w.x << 16); r[1] = __uint_as_float(w.x & 0xffff0000u); r[2] = __uint_as_float(w.y << 16); r[3] = __uint_as_float(w.y & 0xffff0000u); return r; }
__device__ __forceinline__ f32x4 bf_hi4(const u32x4 w) { f32x4 r; r[0] = __uint_as_float(w.z << 16); r[1] = __uint_as_float(w.z & 0xffff0000u); r[2] = __uint_as_float(w.w << 16); r[3] = __uint_as_float(w.w & 0xffff0000u); return r; }


struct EpiP1 {
    static constexpr bool PERM = true, AFTER_DRAIN = false, KSEG = false;
    bf16_t* P1; bf16_t* MKV; const float* bgate;
    __device__ __forceinline__ void operator()(const f32x4 (&acc)[2][2][4][2], const Unit& u, int wr, int wc, int fr, int fq) const {
        const bool mem = u.pn >= 41, gate = (!mem) && u.pn >= 17;
        bf16_t* base = mem ? MKV + (size_t)((u.pm - 64) * BM + wr * 64 + fr) * 2048 + (u.pn - 41) * BM : P1 + (size_t)(u.pm * BM + wr * 64 + fr) * 10496 + u.pn * BM;
        const size_t ldc = mem ? 2048 : 10496;
        base += wc * 32 + 8 * fq;
        f32x4 bv[2][2];
#pragma unroll
        for (int bj = 0; bj < 2; ++bj)
#pragma unroll
            for (int n = 0; n < 2; ++n) bv[bj][n] = gate ? *(const f32x4*)(bgate + (u.pn - 17) * BM + wc * 32 + 8 * fq + bj * HALF + 4 * n) : (f32x4){0.f, 0.f, 0.f, 0.f};
#pragma unroll
        for (int ai = 0; ai < 2; ++ai)
#pragma unroll
            for (int m = 0; m < 4; ++m) { bf16_t* rowp = base + (size_t)(ai * HALF + m * 16) * ldc;
#pragma unroll
                for (int bj = 0; bj < 2; ++bj) { f32x4 v0 = acc[ai][bj][m][0] + bv[bj][0], v1 = acc[ai][bj][m][1] + bv[bj][1];
                    if (gate) {
#pragma unroll
                        for (int i = 0; i < 4; ++i) { v0[i] = sigm(v0[i]); v1[i] = sigm(v1[i]); } }
                    *(u32x4*)(rowp + bj * HALF) = pack8(v0, v1); } }
    }
};
struct EpiGate {
    static constexpr bool PERM = true, AFTER_DRAIN = false, KSEG = false;
    bf16_t* P1; const float* bgate;
    __device__ __forceinline__ void operator()(const f32x4 (&acc)[2][2][4][2], const Unit& u, int wr, int wc, int fr, int fq) const {
        bf16_t* base = P1 + (size_t)(u.pm * BM + wr * 64 + fr) * 10496 + 4352 + u.pn * BM + wc * 32 + 8 * fq;
        f32x4 bv[2][2];
#pragma unroll
        for (int bj = 0; bj < 2; ++bj)
#pragma unroll
            for (int n = 0; n < 2; ++n) bv[bj][n] = *(const f32x4*)(bgate + u.pn * BM + wc * 32 + 8 * fq + bj * HALF + 4 * n);
#pragma unroll
        for (int ai = 0; ai < 2; ++ai)
#pragma unroll
            for (int m = 0; m < 4; ++m) { bf16_t* rowp = base + (size_t)(ai * HALF + m * 16) * 10496;
#pragma unroll
                for (int bj = 0; bj < 2; ++bj) { f32x4 v0 = acc[ai][bj][m][0] + bv[bj][0], v1 = acc[ai][bj][m][1] + bv[bj][1];
#pragma unroll
                    for (int i = 0; i < 4; ++i) { v0[i] = sigm(v0[i]); v1[i] = sigm(v1[i]); }
                    *(u32x4*)(rowp + bj * HALF) = pack8(v0, v1); } }
    }
};
struct EpiPlain {
    static constexpr bool PERM = true, AFTER_DRAIN = false, KSEG = false;
    bf16_t* O; int ldc;
    __device__ __forceinline__ void operator()(const f32x4 (&acc)[2][2][4][2], const Unit& u, int wr, int wc, int fr, int fq) const {
        bf16_t* base = O + (size_t)(u.pm * BM + wr * 64 + fr) * ldc + u.pn * BM + wc * 32 + 8 * fq;
#pragma unroll
        for (int ai = 0; ai < 2; ++ai)
#pragma unroll
            for (int m = 0; m < 4; ++m) { bf16_t* rowp = base + (size_t)(ai * HALF + m * 16) * ldc;
#pragma unroll
                for (int bj = 0; bj < 2; ++bj) *(u32x4*)(rowp + bj * HALF) = pack8(acc[ai][bj][m][0], acc[ai][bj][m][1]); }
    }
};
template <bool FIRST> struct EpiGateAcc {
    static constexpr bool PERM = true, AFTER_DRAIN = false, KSEG = false;
    const bf16_t* G; int gcol0; bf16_t* Mg;
    __device__ __forceinline__ void operator()(const f32x4 (&acc)[2][2][4][2], const Unit& u, int wr, int wc, int fr, int fq) const {
        const int row0 = u.pm * BM + wr * 64 + fr, col0 = u.pn * BM + wc * 32 + 8 * fq;
#pragma unroll
        for (int ai = 0; ai < 2; ++ai)
#pragma unroll
            for (int m = 0; m < 4; ++m) { const size_t r = (size_t)(row0 + ai * HALF + m * 16);
#pragma unroll
                for (int bj = 0; bj < 2; ++bj) {
                    const u32x4 gw = *(const u32x4*)(G + r * 10496 + gcol0 + col0 + bj * HALF);
                    f32x4 v0 = acc[ai][bj][m][0] * bf_lo4(gw), v1 = acc[ai][bj][m][1] * bf_hi4(gw);
                    bf16_t* mp = Mg + r * 2048 + col0 + bj * HALF;
                    if (!FIRST) { const u32x4 ow = *(const u32x4*)mp; v0 = v0 + bf_lo4(ow); v1 = v1 + bf_hi4(ow); }
                    *(u32x4*)mp = pack8(v0, v1); } }
    }
};
__device__ __forceinline__ float rowsq8(const f32x4 a, const f32x4 b) { return (a[0] * a[0] + a[1] * a[1]) + (a[2] * a[2] + a[3] * a[3]) + (b[0] * b[0] + b[1] * b[1]) + (b[2] * b[2] + b[3] * b[3]); }
struct EpiKV {
    static constexpr bool PERM = true, AFTER_DRAIN = false, KSEG = false;
    PG8_LAS float* P; const float* kn_g; const float* krss; const float* krr; bf16_t* KFT; bf16_t* VFT;
    __device__ __forceinline__ void operator()(const f32x4 (&acc)[2][2][4][2], const Unit& u, int wr, int wc, int fr, int fq) const {
        asm volatile("" : "+v"(fr), "+v"(fq));
        const int h = u.pn, b = u.pm >> 4, tq = (u.pm & 15) * 4;
#pragma unroll
        for (int ai = 0; ai < 2; ++ai)
#pragma unroll
            for (int m = 0; m < 4; ++m) { float s = rowsq8(acc[ai][0][m][0], acc[ai][0][m][1]); if (XL_FAST) s = xl_swap32_sum(xl_swap16_sum(s)); else { s += __shfl_xor(s, 16); s += __shfl_xor(s, 32); }
                if (fq == 0) P[(ai * HALF + wr * 64 + m * 16 + fr) * 4 + wc] = s; }
        asm volatile("s_waitcnt lgkmcnt(0)" ::: "memory"); __builtin_amdgcn_s_barrier(); asm volatile("" ::: "memory");
        const f32x4 g0 = *(const f32x4*)(kn_g + wc * 32 + 8 * fq), g1 = *(const f32x4*)(kn_g + wc * 32 + 8 * fq + 4);
#pragma unroll
        for (int ai = 0; ai < 2; ++ai)
#pragma unroll
            for (int m = 0; m < 4; ++m) { const int row = ai * HALF + wr * 64 + m * 16 + fr, key = m * 16 + fr; const size_t t = (size_t)u.pm * BM + row;
                const f32x4 p4 = *(const PG8_LAS f32x4*)(P + row * 4);
                const float rs = 1.0f * FAST_RSQ(((p4[0] + p4[1]) + (p4[2] + p4[3]) + krss[t]) * (1.f / 192.f) + 1e-6f);
                const size_t tile = (size_t)(b * 16 + h) * 64 + tq + 2 * ai + wr;
                bf16_t* kb = KFT + tile * 12288 + key * 8;
                *(u32x4*)(kb + (4 * wc + fq) * 512) = pack8(acc[ai][0][m][0] * g0 * rs, acc[ai][0][m][1] * g1 * rs);
                *(u32x4*)(VFT + tile * 8192 + wc * 2048 + key * 32 + 8 * fq) = pack8(acc[ai][1][m][0], acc[ai][1][m][1]);
                if (fq < 2) { const int c = 2 * wc + fq; const f32x4 r0 = *(const f32x4*)(krr + t * 64 + 8 * c), r1 = *(const f32x4*)(krr + t * 64 + 8 * c + 4);
                    *(u32x4*)(kb + (16 + c) * 512) = pack8(r0 * rs, r1 * rs); }
                asm volatile("" ::: "memory"); }
    }
};
struct EpiQ {
    static constexpr bool PERM = true, AFTER_DRAIN = false, KSEG = false;
    PG8_LAS float* P; const float* qn_g; const float* rope; bf16_t* QF; float qscale;
    __device__ __forceinline__ void operator()(const f32x4 (&acc)[2][2][4][2], const Unit& u, int wr, int wc, int fr, int fq) const {
        asm volatile("" : "+v"(fr), "+v"(fq));
        const int h = u.pn, b = u.pm >> 4;
#pragma unroll
        for (int ai = 0; ai < 2; ++ai)
#pragma unroll
            for (int m = 0; m < 4; ++m) { float s = rowsq8(acc[ai][0][m][0], acc[ai][0][m][1]); if (wc < 2) s += rowsq8(acc[ai][1][m][0], acc[ai][1][m][1]);
                if (XL_FAST) s = xl_swap32_sum(xl_swap16_sum(s)); else { s += __shfl_xor(s, 16); s += __shfl_xor(s, 32); }
                if (fq == 0) P[(ai * HALF + wr * 64 + m * 16 + fr) * 4 + wc] = s; }
        asm volatile("s_waitcnt lgkmcnt(0)" ::: "memory"); __builtin_amdgcn_s_barrier(); asm volatile("" ::: "memory");
        const f32x4 g0 = *(const f32x4*)(qn_g + wc * 32 + 8 * fq) * qscale, g1 = *(const f32x4*)(qn_g + wc * 32 + 8 * fq + 4) * qscale;
        const int j = 4 * (4 * (wc & 1) + fq);
        const f32x4 gr1 = *(const f32x4*)(qn_g + 128 + j) * qscale, gr2 = *(const f32x4*)(qn_g + 160 + j) * qscale;
#pragma unroll
        for (int ai = 0; ai < 2; ++ai)
#pragma unroll
            for (int m = 0; m < 4; ++m) { const int row = ai * HALF + wr * 64 + m * 16 + fr; const size_t t = (size_t)u.pm * BM + row;
                const f32x4 p4 = *(const PG8_LAS f32x4*)(P + row * 4);
                const float rs = 1.0f * FAST_RSQ(((p4[0] + p4[1]) + (p4[2] + p4[3])) * (1.f / 192.f) + 1e-6f);
                bf16_t* qb = QF + ((size_t)(b * 16 + h) * 4096 + (t & 4095)) * 192;
                *(u32x4*)(qb + wc * 32 + 8 * fq) = pack8(acc[ai][0][m][0] * g0 * rs, acc[ai][0][m][1] * g1 * rs);
                if (wc < 2) { const f32x4 c4 = *(const f32x4*)(rope + t * 64 + j), s4 = *(const f32x4*)(rope + t * 64 + 32 + j);
                    const f32x4 t1 = acc[ai][1][m][0] * gr1 * rs, t2 = acc[ai][1][m][1] * gr2 * rs;
                    const f32x4 o1 = t1 * c4 - t2 * s4, o2 = t1 * s4 + t2 * c4;
                    u32x2 w1; w1.x = cvt_pk_bf16(o1[0], o1[1]); w1.y = cvt_pk_bf16(o1[2], o1[3]); *(u32x2*)(qb + 128 + j) = w1;
                    u32x2 w2; w2.x = cvt_pk_bf16(o2[0], o2[1]); w2.y = cvt_pk_bf16(o2[2], o2[3]); *(u32x2*)(qb + 160 + j) = w2; }
                asm volatile("" ::: "memory"); }
    }
};
__device__ __forceinline__ unsigned pk4f8s(const f32x4 v, float s) { int r = __builtin_amdgcn_cvt_pk_fp8_f32(v[0] * s, v[1] * s, 0, false); r = __builtin_amdgcn_cvt_pk_fp8_f32(v[2] * s, v[3] * s, r, true); return (unsigned)r; }
struct EpiKV8 {
    static constexpr bool PERM = true, AFTER_DRAIN = false, KSEG = false;
    PG8_LAS float* P; const float* kn_g; const float* krss; const float* krr; unsigned char* K8; unsigned char* V8;
    __device__ __forceinline__ void operator()(const f32x4 (&acc)[2][2][4][2], const Unit& u, int wr, int wc, int fr, int fq) const {
        asm volatile("" : "+v"(fr), "+v"(fq));
        const int h = u.pn, b = u.pm >> 4, tq = (u.pm & 15) * 4;
#pragma unroll
        for (int ai = 0; ai < 2; ++ai)
#pragma unroll
            for (int m = 0; m < 4; ++m) { float s = rowsq8(acc[ai][0][m][0], acc[ai][0][m][1]); if (XL_FAST) s = xl_swap32_sum(xl_swap16_sum(s)); else { s += __shfl_xor(s, 16); s += __shfl_xor(s, 32); }
                if (fq == 0) P[(ai * HALF + wr * 64 + m * 16 + fr) * 4 + wc] = s; }
        asm volatile("s_waitcnt lgkmcnt(0)" ::: "memory"); __builtin_amdgcn_s_barrier(); asm volatile("" ::: "memory");
        const f32x4 g0 = *(const f32x4*)(kn_g + wc * 32 + 8 * fq), g1 = *(const f32x4*)(kn_g + wc * 32 + 8 * fq + 4);
#pragma unroll
        for (int ai = 0; ai < 2; ++ai)
#pragma unroll
            for (int m = 0; m < 4; ++m) { const int row = ai * HALF + wr * 64 + m * 16 + fr, key = m * 16 + fr; const size_t t = (size_t)u.pm * BM + row;
                const f32x4 p4 = *(const PG8_LAS f32x4*)(P + row * 4);
                const float rs = 1.0f * FAST_RSQ(((p4[0] + p4[1]) + (p4[2] + p4[3]) + krss[t]) * (1.f / 192.f) + 1e-6f);
                const size_t tile = (size_t)(b * 16 + h) * 64 + tq + 2 * ai + wr;
                unsigned char* kb = K8 + tile * 12288 + key * 16;
                { u32x2 w; w.x = pk4f8s(acc[ai][0][m][0] * g0, rs); w.y = pk4f8s(acc[ai][0][m][1] * g1, rs); *(u32x2*)(kb + (2 * wc + (fq >> 1)) * 1024 + 8 * (fq & 1)) = w; }
                if (fq < 2) { const f32x4 r0 = *(const f32x4*)(krr + t * 64 + 16 * wc + 8 * fq), r1 = *(const f32x4*)(krr + t * 64 + 16 * wc + 8 * fq + 4);
                    u32x2 w; w.x = pk4f8s(r0, rs); w.y = pk4f8s(r1, rs); *(u32x2*)(kb + (8 + wc) * 1024 + 8 * fq) = w; }
                const int p = 32 * ((fr >> 2) & 1) + 16 * (m >> 1) + (fr & 3) + 4 * (2 * (m & 1) + (fr >> 3));
                unsigned char* vb = V8 + tile * 8192 + (p >> 4) * 2048 + (size_t)(wc * 32 + 8 * fq) * 16 + (p & 15);
                const unsigned w0 = pk4f8s(acc[ai][1][m][0], 1.0f), w1 = pk4f8s(acc[ai][1][m][1], 1.0f);
                vb[0] = (unsigned char)w0; vb[16] = (unsigned char)(w0 >> 8); vb[32] = (unsigned char)(w0 >> 16); vb[48] = (unsigned char)(w0 >> 24);
                vb[64] = (unsigned char)w1; vb[80] = (unsigned char)(w1 >> 8); vb[96] = (unsigned char)(w1 >> 16); vb[112] = (unsigned char)(w1 >> 24);
                asm volatile("" ::: "memory"); }
    }
};
struct EpiQ8 {
    static constexpr bool PERM = true, AFTER_DRAIN = false, KSEG = false;
    PG8_LAS float* P; const float* qn_g; const float* rope; unsigned char* Q8; float qscale;
    __device__ __forceinline__ void operator()(const f32x4 (&acc)[2][2][4][2], const Unit& u, int wr, int wc, int fr, int fq) const {
        asm volatile("" : "+v"(fr), "+v"(fq));
        const int h = u.pn, b = u.pm >> 4;
#pragma unroll
        for (int ai = 0; ai < 2; ++ai)
#pragma unroll
            for (int m = 0; m < 4; ++m) { float s = rowsq8(acc[ai][0][m][0], acc[ai][0][m][1]); if (wc < 2) s += rowsq8(acc[ai][1][m][0], acc[ai][1][m][1]);
                if (XL_FAST) s = xl_swap32_sum(xl_swap16_sum(s)); else { s += __shfl_xor(s, 16); s += __shfl_xor(s, 32); }
                if (fq == 0) P[(ai * HALF + wr * 64 + m * 16 + fr) * 4 + wc] = s; }
        asm volatile("s_waitcnt lgkmcnt(0)" ::: "memory"); __builtin_amdgcn_s_barrier(); asm volatile("" ::: "memory");
        const f32x4 g0 = *(const f32x4*)(qn_g + wc * 32 + 8 * fq) * qscale, g1 = *(const f32x4*)(qn_g + wc * 32 + 8 * fq + 4) * qscale;
        const int j = 4 * (4 * (wc & 1) + fq);
        const f32x4 gr1 = *(const f32x4*)(qn_g + 128 + j) * qscale, gr2 = *(const f32x4*)(qn_g + 160 + j) * qscale;
#pragma unroll
        for (int ai = 0; ai < 2; ++ai)
#pragma unroll
            for (int m = 0; m < 4; ++m) { const int row = ai * HALF + wr * 64 + m * 16 + fr; const size_t t = (size_t)u.pm * BM + row;
                const f32x4 p4 = *(const PG8_LAS f32x4*)(P + row * 4);
                const float rs = 1.0f * FAST_RSQ(((p4[0] + p4[1]) + (p4[2] + p4[3])) * (1.f / 192.f) + 1e-6f);
                unsigned char* qb = Q8 + ((size_t)(b * 16 + h) * 4096 + (t & 4095)) * 192;
                { u32x2 w; w.x = pk4f8s(acc[ai][0][m][0] * g0, rs); w.y = pk4f8s(acc[ai][0][m][1] * g1, rs); *(u32x2*)(qb + wc * 32 + 8 * fq) = w; }
                if (wc < 2) { const f32x4 c4 = *(const f32x4*)(rope + t * 64 + j), s4 = *(const f32x4*)(rope + t * 64 + 32 + j);
                    const f32x4 t1 = acc[ai][1][m][0] * gr1 * rs, t2 = acc[ai][1][m][1] * gr2 * rs;
                    *(unsigned*)(qb + 128 + j) = pk4f8s(t1 * c4 - t2 * s4, 1.0f); *(unsigned*)(qb + 160 + j) = pk4f8s(t1 * s4 + t2 * c4, 1.0f); }
                asm volatile("" ::: "memory"); }
    }
};
template <int T1_, int T2_> struct EpiMergedT {
    static constexpr bool PERM = true, AFTER_DRAIN = false, KSEG = true; static constexpr int KSEG_T1 = T1_, KSEG_T2 = T2_;
    const bf16_t* G; bf16_t* Mg;
    __device__ __forceinline__ void kseg(f32x4 (&acc)[2][2][4][2], const Unit& u, int t, int wr, int wc, int fr, int fq) const {
        const bf16_t* gp = G + (size_t)(u.pm * BM + wr * 64 + fr) * 10496 + 4352 + (t == KSEG_T1 ? 0 : 2048) + u.pn * BM + wc * 32 + 8 * fq;
#if KSEG_BATCH16
#pragma unroll
        for (int ai = 0; ai < 2; ++ai) {
            u32x4 gn[4][2], gd[4][2];
#pragma unroll
            for (int m = 0; m < 4; ++m)
#pragma unroll
                for (int bj = 0; bj < 2; ++bj) { const bf16_t* p = gp + (size_t)(ai * HALF + m * 16) * 10496 + bj * HALF; gn[m][bj] = *(const u32x4*)p; gd[m][bj] = *(const u32x4*)(p + 2048); }
#pragma unroll
            for (int m = 0; m < 4; ++m)
#pragma unroll
                for (int bj = 0; bj < 2; ++bj) {
                    f32x4 r0 = bf_lo4(gd[m][bj]), r1 = bf_hi4(gd[m][bj]);
#pragma unroll
                    for (int i = 0; i < 4; ++i) { r0[i] = __builtin_amdgcn_rcpf(r0[i]); r1[i] = __builtin_amdgcn_rcpf(r1[i]); }
                    acc[ai][bj][m][0] = acc[ai][bj][m][0] * (bf_lo4(gn[m][bj]) * r0); acc[ai][bj][m][1] = acc[ai][bj][m][1] * (bf_hi4(gn[m][bj]) * r1); }
            asm volatile("" : "+v"(acc[ai][0][0][0]), "+v"(acc[ai][0][0][1]), "+v"(acc[ai][1][0][0]), "+v"(acc[ai][1][0][1]), "+v"(acc[ai][0][1][0]), "+v"(acc[ai][0][1][1]), "+v"(acc[ai][1][1][0]), "+v"(acc[ai][1][1][1]),
                         "+v"(acc[ai][0][2][0]), "+v"(acc[ai][0][2][1]), "+v"(acc[ai][1][2][0]), "+v"(acc[ai][1][2][1]), "+v"(acc[ai][0][3][0]), "+v"(acc[ai][0][3][1]), "+v"(acc[ai][1][3][0]), "+v"(acc[ai][1][3][1]) :: "memory");
        }
    }
#else
#pragma unroll
        for (int ai = 0; ai < 2; ++ai)
#pragma unroll
            for (int mp = 0; mp < 2; ++mp) {
                u32x4 gn[2][2], gd[2][2];
#pragma unroll
                for (int mm = 0; mm < 2; ++mm)
#pragma unroll
                    for (int bj = 0; bj < 2; ++bj) { const bf16_t* p = gp + (size_t)(ai * HALF + (2 * mp + mm) * 16) * 10496 + bj * HALF; gn[mm][bj] = *(const u32x4*)p; gd[mm][bj] = *(const u32x4*)(p + 2048); }
#pragma unroll
                for (int mm = 0; mm < 2; ++mm)
#pragma unroll
                    for (int bj = 0; bj < 2; ++bj) { const int m = 2 * mp + mm;
                        f32x4 r0 = bf_lo4(gd[mm][bj]), r1 = bf_hi4(gd[mm][bj]);
#pragma unroll
                        for (int i = 0; i < 4; ++i) { r0[i] = __builtin_amdgcn_rcpf(r0[i]); r1[i] = __builtin_amdgcn_rcpf(r1[i]); }
                        acc[ai][bj][m][0] = acc[ai][bj][m][0] * (bf_lo4(gn[mm][bj]) * r0); acc[ai][bj][m][1] = acc[ai][bj][m][1] * (bf_hi4(gn[mm][bj]) * r1); }
                asm volatile("" : "+v"(acc[ai][0][2 * mp][0]), "+v"(acc[ai][0][2 * mp][1]), "+v"(acc[ai][1][2 * mp][0]), "+v"(acc[ai][1][2 * mp][1]), "+v"(acc[ai][0][2 * mp + 1][0]), "+v"(acc[ai][0][2 * mp + 1][1]), "+v"(acc[ai][1][2 * mp + 1][0]), "+v"(acc[ai][1][2 * mp + 1][1]) :: "memory");
            }
    }
#endif
    __device__ __forceinline__ void operator()(const f32x4 (&acc)[2][2][4][2], const Unit& u, int wr, int wc, int fr, int fq) const {
        const int row0 = u.pm * BM + wr * 64 + fr, col0 = u.pn * BM + wc * 32 + 8 * fq;
#pragma unroll
        for (int ai = 0; ai < 2; ++ai)
#pragma unroll
            for (int m = 0; m < 4; ++m) { const size_t r = (size_t)(row0 + ai * HALF + m * 16);
#pragma unroll
                for (int bj = 0; bj < 2; ++bj) {
                    const u32x4 gw = *(const u32x4*)(G + r * 10496 + 4352 + 4096 + col0 + bj * HALF);
                    *(u32x4*)(Mg + r * 2048 + col0 + bj * HALF) = pack8(acc[ai][bj][m][0] * bf_lo4(gw), acc[ai][bj][m][1] * bf_hi4(gw)); } }
    }
};
struct EpiX1 {
    static constexpr bool PERM = true, AFTER_DRAIN = false, KSEG = false;
    const float* X; bf16_t* O;
    __device__ __forceinline__ void operator()(const f32x4 (&acc)[2][2][4][2], const Unit& u, int wr, int wc, int fr, int fq) const {
        const int row0 = u.pm * BM + wr * 64 + fr, col0 = u.pn * BM + wc * 32 + 8 * fq;
#if EPIX1_BATCH
#pragma unroll
        for (int ai = 0; ai < 2; ++ai) {
            f32x4 xv[4][2][2];
#pragma unroll
            for (int m = 0; m < 4; ++m) { const size_t off = (size_t)(row0 + ai * HALF + m * 16) * 2048 + col0;
#pragma unroll
                for (int bj = 0; bj < 2; ++bj) { xv[m][bj][0] = *(const f32x4*)(X + off + bj * HALF); xv[m][bj][1] = *(const f32x4*)(X + off + bj * HALF + 4); } }
#pragma unroll
            for (int m = 0; m < 4; ++m) { const size_t off = (size_t)(row0 + ai * HALF + m * 16) * 2048 + col0;
#pragma unroll
                for (int bj = 0; bj < 2; ++bj) *(u32x4*)(O + off + bj * HALF) = pack8(xv[m][bj][0] + acc[ai][bj][m][0], xv[m][bj][1] + acc[ai][bj][m][1]); }
            asm volatile("" ::: "memory");
        }
    }
};
#else
#pragma unroll
        for (int ai = 0; ai < 2; ++ai)
#pragma unroll
            for (int m = 0; m < 4; ++m) { const size_t off = (size_t)(row0 + ai * HALF + m * 16) * 2048 + col0;
#pragma unroll
                for (int bj = 0; bj < 2; ++bj) { const f32x4 x0 = *(const f32x4*)(X + off + bj * HALF), x1 = *(const f32x4*)(X + off + bj * HALF + 4);
                    *(u32x4*)(O + off + bj * HALF) = pack8(x0 + acc[ai][bj][m][0], x1 + acc[ai][bj][m][1]); } }
    }
};
#endif
struct EpiSwiGLU {
    static constexpr bool PERM = true, AFTER_DRAIN = false, KSEG = false;
    const float* bgu; unsigned char* ACT;
    __device__ __forceinline__ void operator()(const f32x4 (&acc)[2][2][4][2], const Unit& u, int wr, int wc, int fr, int fq) const {
        const int e = u.pn >> 4, pnl = u.pn & 15, cl = pnl * HALF + wc * 32 + 8 * fq;
        const float* bp = bgu + (size_t)e * 4096 + cl;
        f32x4 bg[2], bu[2];
#pragma unroll
        for (int n = 0; n < 2; ++n) { bg[n] = *(const f32x4*)(bp + 4 * n); bu[n] = *(const f32x4*)(bp + 2048 + 4 * n); }
        unsigned char* base = ACT + (size_t)(u.pm * BM + wr * 64 + fr) * 2048 + cl;
#pragma unroll
        for (int ai = 0; ai < 2; ++ai)
#pragma unroll
            for (int m = 0; m < 4; ++m) { f32x4 o[2];
#pragma unroll
                for (int n = 0; n < 2; ++n) { const f32x4 g4 = acc[ai][0][m][n] + bg[n], u4 = acc[ai][1][m][n] + bu[n];
#pragma unroll
                    for (int i = 0; i < 4; ++i) { const float g = fminf(g4[i], 7.0f), up = fminf(fmaxf(u4[i], -7.0f), 7.0f); o[n][i] = (up + 1.0f) * g * sigm(1.702f * g); } }
                u32x2 w8; w8.x = pk4f8(o[0]); w8.y = pk4f8(o[1]); *(u32x2*)(base + (size_t)(ai * HALF + m * 16) * 2048) = w8; }
    }
};
template <int P_> struct EpiSwiGLUProbe : EpiSwiGLU { static constexpr int PROBE = P_;
    __device__ __forceinline__ void operator()(const f32x4 (&)[2][2][4][2], const Unit&, int, int, int, int) const {} };

struct EpiDown {
    static constexpr bool PERM = true, AFTER_DRAIN = false, KSEG = false;
    const float* bd; unsigned char* Y;
    __device__ __forceinline__ void operator()(const f32x4 (&acc)[2][2][4][2], const Unit& u, int wr, int wc, int fr, int fq) const {
        const int e = u.pn >> 3, pnl = u.pn & 7, cl = pnl * BM + wc * 32 + 8 * fq;
        const float* bp = bd + (size_t)e * 2048 + cl;
        f32x4 bv[2][2];
#pragma unroll
        for (int bj = 0; bj < 2; ++bj)
#pragma unroll
            for (int n = 0; n < 2; ++n) bv[bj][n] = *(const f32x4*)(bp + bj * HALF + 4 * n);
        unsigned char* base = Y + (size_t)(u.pm * BM + wr * 64 + fr) * 2048 + cl;
#pragma unroll
        for (int ai = 0; ai < 2; ++ai)
#pragma unroll
            for (int m = 0; m < 4; ++m) { unsigned char* rowp = base + (size_t)(ai * HALF + m * 16) * 2048;
#pragma unroll
                for (int bj = 0; bj < 2; ++bj) { u32x2 w; w.x = pk4f8(acc[ai][bj][m][0] + bv[bj][0]); w.y = pk4f8(acc[ai][bj][m][1] + bv[bj][1]); *(u32x2*)(rowp + bj * HALF) = w; } }
    }
};

struct P1Order {
    StaticOrder base; int i_off, i_lim;
    __device__ void init(int G_, int c_, int i_off_, int i_lim_) { base.init(16384, (GATE_F8 ? (UV_F8 == 2 ? 4 : 8) : 41) * 256, G_, c_); i_off = i_off_; i_lim = i_lim_; }
    __device__ bool next(int i_, Unit& u) const {
        const int i = i_ + i_off; if (i >= i_lim) return false;
        const long L = (long)i * base.G + base.c;
        if (L < base.nwg) return base.next(i, u);
        const int j = (int)(L - base.nwg); if (GATE_F8 || j >= 32) return false;
        u.pm = 64 + (j & 3); u.pn = 41 + (j >> 2); return true;
    }
    __device__ __forceinline__ void a_ready(const Unit&) const {}
    __device__ __forceinline__ void done(const Unit&) const {}
};
struct GateOrder {
    StaticOrder base;
    __device__ void init(int G_, int c_) { base.init(16384, (UV_F8 == 1 ? 41 : UV_F8 == 2 ? 37 : 33) * 256, G_, c_); }
    __device__ bool next(int i, Unit& u) const {
        const long L = (long)i * base.G + base.c;
        if (L < base.nwg) { base.next(i, u); u.pn += (UV_F8 == 1 ? 0 : UV_F8 == 2 ? 4 : 8); return true; }
        const int j = (int)(L - base.nwg);
        if (j < 32) { u.pm = 64 + (j & 3); u.pn = 41 + (j >> 2); return true; }
        return false;
    }
    __device__ __forceinline__ void a_ready(const Unit&) const {}
    __device__ __forceinline__ void done(const Unit&) const {}
};
struct MoeOrder {
    const PG8_LAS int* tab; int NT, x, j;
    __device__ bool next(int i, Unit& u) const {
#if MOE_MAP2
        const int g = NT >> 2, Lx = i * 32 + j, rbi = Lx / g, s = Lx - rbi * g, rb = 2 * rbi + (x >> 2);
        if (rb >= __builtin_amdgcn_readfirstlane(tab[32])) return false;
#if CNT_SPREAD
        const int e = __builtin_amdgcn_readfirstlane((int)((const PG8_LAS unsigned char*)(tab + 136))[rb]);
#else
        int e = 0;
        while (__builtin_amdgcn_readfirstlane(tab[e + 1]) <= rb) ++e;
#endif
        u.pm = rb; u.pn = e * NT + (x & 3) + 4 * s; u.kr = 0; return true;
#else
        const int ntx = NT >> 3, Lx = i * 32 + j, rb = Lx / ntx, s = Lx - rb * ntx;
        if (rb >= __builtin_amdgcn_readfirstlane(tab[32])) return false;
#if CNT_SPREAD
        const int e = __builtin_amdgcn_readfirstlane((int)((const PG8_LAS unsigned char*)(tab + 136))[rb]);
#else
        int e = 0;
        while (__builtin_amdgcn_readfirstlane(tab[e + 1]) <= rb) ++e;
#endif
        u.pm = rb; u.pn = e * NT + x + 8 * s; u.kr = (rb + 4 * s) & 7; return true;
#endif
    }
    __device__ __forceinline__ void a_ready(const Unit&) const {}
    __device__ __forceinline__ void done(const Unit&) const {}
};
}
#define GAS __attribute__((address_space(1)))
#define LAS __attribute__((address_space(3)))
typedef unsigned short bf16;
typedef unsigned v4u __attribute__((ext_vector_type(4)));
typedef float f32x4 __attribute__((ext_vector_type(4)));
typedef short bf16x8 __attribute__((ext_vector_type(8)));
typedef GAS unsigned gu32;
typedef GAS unsigned long long gu64;
#define RLX_AGENT __ATOMIC_RELAXED, __HIP_MEMORY_SCOPE_AGENT
#define LDS_WAIT() asm volatile("s_waitcnt lgkmcnt(0)" ::: "memory")
#define VM_WAIT() asm volatile("s_waitcnt vmcnt(0)" ::: "memory")
__device__ __forceinline__ unsigned long long rt() { return __builtin_amdgcn_s_memrealtime(); }
__device__ __forceinline__ unsigned f2bf(float f) { unsigned u = __builtin_bit_cast(unsigned, f); return (u + 0x7fffu + ((u >> 16) & 1u)) >> 16; }
__device__ __forceinline__ unsigned pk2(float lo, float hi) { return f2bf(lo) | (f2bf(hi) << 16); }
#define XB_TMO      128
#define XB_XCNT(j)  (256  + 64 * (j))
#define XB_XSUB(j)  (1280 + 64 * (j))
#define XB_XGEN(j)  (2304 + 64 * (j))
#define XB_TOP      3328
#define XB_TOPGEN   3392
#define XCD_BAR_WORDS 3456
#define XB_SPIN_CAP (1u << 18)

__device__ __forceinline__ unsigned xb_ld(unsigned* p)              { return __hip_atomic_load(p, __ATOMIC_RELAXED, __HIP_MEMORY_SCOPE_AGENT); }
__device__ __forceinline__ unsigned xb_add(unsigned* p, unsigned v) { return __hip_atomic_fetch_add(p, v, __ATOMIC_RELAXED, __HIP_MEMORY_SCOPE_AGENT); }
__device__ __forceinline__ unsigned xb_xcc_id() { return (unsigned)__builtin_amdgcn_s_getreg((3 << 11) | 20) & 0xFu; }
#define XB_SPIN(cond, bar) do { unsigned _sp = 0; while (cond) { __builtin_amdgcn_s_sleep(1); \
    if ((++_sp & 255u) == 0u) { if (xb_ld(&(bar)[XB_TMO])) break; if (_sp > XB_SPIN_CAP) { atomicAdd(&(bar)[XB_TMO], 1u); break; } } } } while (0)

struct XcdBarrier {
    unsigned* bar; unsigned x;
    volatile LAS unsigned* st;
};

__device__ __forceinline__ XcdBarrier xcd_barrier_post(unsigned* bar, volatile LAS unsigned* st) {
    XcdBarrier b; b.bar = bar; b.x = xb_xcc_id(); b.st = st;
    if (threadIdx.x == 0) (void)xb_add(&bar[XB_XCNT(b.x)], 1u);
    return b;
}
__device__ __forceinline__ void xcd_barrier_complete(unsigned* bar, unsigned x, unsigned& nloc, unsigned& nx) {
    const unsigned G = gridDim.x * gridDim.y * gridDim.z;
    unsigned sum, cnt, mine, sp = 0u;
    for (;;) {
        sum = 0u; cnt = 0u; mine = 0u;
#pragma unroll
        for (unsigned j = 0; j < 16; ++j) { const unsigned c = xb_ld(&bar[XB_XCNT(j)]); sum += c; cnt += (c > 0u) ? 1u : 0u; mine = (j == x) ? c : mine; }
        if (sum == G) break;
        __builtin_amdgcn_s_sleep(1);
        if ((++sp & 255u) == 0u) { if (xb_ld(&bar[XB_TMO])) break; if (sp > XB_SPIN_CAP) { atomicAdd(&bar[XB_TMO], 1u); break; } }
    }
    nloc = mine > 0u ? mine : 1u; nx = cnt > 0u ? cnt : 1u;
}

__device__ __forceinline__ void xcd_barrier(const XcdBarrier& b) {
    asm volatile("s_waitcnt vmcnt(0)" ::: "memory");
    __syncthreads();
    if (threadIdx.x == 0) {
        unsigned* bar = b.bar;
        __builtin_amdgcn_s_waitcnt(0);
        unsigned nloc = b.st[0], nx = b.st[1];
        if (nloc == 0u) { xcd_barrier_complete(bar, b.x, nloc, nx); b.st[0] = nloc; b.st[1] = nx; }
        const unsigned old = xb_add(&bar[XB_XSUB(b.x)], 1u);
        const unsigned gen = old / nloc;
        if (old + 1u == (gen + 1u) * nloc) {
            __builtin_amdgcn_fence(__ATOMIC_RELEASE, "agent");
            asm volatile("s_waitcnt vmcnt(0)" ::: "memory");
            const unsigned og = xb_add(&bar[XB_TOP], 1u);
            const unsigned tg = og / nx;
            if (og + 1u == (tg + 1u) * nx) xb_add(&bar[XB_TOPGEN], 1u);
            else XB_SPIN(xb_ld(&bar[XB_TOPGEN]) == tg, bar);
            __builtin_amdgcn_fence(__ATOMIC_ACQUIRE, "agent");
            xb_add(&bar[XB_XGEN(b.x)], 1u);
            asm volatile("s_waitcnt vmcnt(0)" ::: "memory");
        } else {
            XB_SPIN(xb_ld(&bar[XB_XGEN(b.x)]) == gen, bar);
            __builtin_amdgcn_fence(__ATOMIC_ACQUIRE, "agent");
            asm volatile("s_waitcnt vmcnt(0)" ::: "memory");
        }
    }
    __syncthreads();
}
typedef float f32x16 __attribute__((ext_vector_type(16)));
typedef float f32x2 __attribute__((ext_vector_type(2)));
typedef short s16x4 __attribute__((ext_vector_type(4)));
typedef unsigned u32x2 __attribute__((ext_vector_type(2)));
typedef short v4i16_t __attribute__((ext_vector_type(4)));
__device__ __forceinline__ unsigned cvtpk(float lo, float hi) { unsigned r; asm volatile("v_cvt_pk_bf16_f32 %0, %1, %2" : "=v"(r) : "v"(lo), "v"(hi)); return r; }
__device__ __forceinline__ float bflo(unsigned w) { return __uint_as_float(w << 16); }
__device__ __forceinline__ float bfhi(unsigned w) { return __uint_as_float(w & 0xffff0000u); }
__device__ __forceinline__ void unpack8(const v4u w, float (&f)[8]) { f[0] = bflo(w.x); f[1] = bfhi(w.x); f[2] = bflo(w.y); f[3] = bfhi(w.y); f[4] = bflo(w.z); f[5] = bfhi(w.z); f[6] = bflo(w.w); f[7] = bfhi(w.w); }
__device__ __forceinline__ v4u packf8(const float (&f)[8]) { v4u w; w.x = cvtpk(f[0], f[1]); w.y = cvtpk(f[2], f[3]); w.z = cvtpk(f[4], f[5]); w.w = cvtpk(f[6], f[7]); return w; }
__device__ __forceinline__ float wave_sum(float v) {
#if XL_FAST
    return xl_swap32_sum(xl_swap16_sum(xl_sum16(v)));
#else
#pragma unroll
    for (int o = 1; o < 64; o <<= 1) v += __shfl_xor(v, o);
    return v;
#endif
}
__device__ __forceinline__ int crow(int r, int hi) { return (r & 3) + 8 * (r >> 2) + 4 * hi; }

template <bool ROPEP = false>
__device__ __forceinline__ void transpose_item64(const float* W, size_t ldw, int k0, int n0, bf16* WT, size_t ldt, int r0, LAS float* scr, int lane, int kdst = 0) {
    const GAS float* src = (const GAS float*)W + (size_t)(k0 + (lane >> 4)) * ldw + n0 + (lane & 15) * 4;
    f32x4 v[16];
#pragma unroll
    for (int i = 0; i < 16; ++i) v[i] = *(const GAS f32x4*)(src + (size_t)(4 * i) * ldw);
#pragma unroll
    for (int i = 0; i < 16; ++i) { LAS float* s = scr + (4 * i + (lane >> 4)) * 65 + (lane & 15) * 4; s[0] = v[i].x; s[1] = v[i].y; s[2] = v[i].z; s[3] = v[i].w; }
    LDS_WAIT(); asm volatile("" ::: "memory");
    const int c = lane & 7;
#pragma unroll
    for (int j = 0; j < 8; ++j) { const int n = (lane >> 3) + 8 * j; const LAS float* s = scr + (8 * c) * 65 + n;
        v4u o; o.x = cvtpk(s[0 * 65], s[1 * 65]); o.y = cvtpk(s[2 * 65], s[3 * 65]); o.z = cvtpk(s[4 * 65], s[5 * 65]); o.w = cvtpk(s[6 * 65], s[7 * 65]);
        const int nd = ROPEP ? (((n >> 4) & 1) * 32 + ((n >> 2) & 3) * 8 + (n >> 5) * 4 + (n & 3)) : n;
        *(GAS v4u*)(WT + (size_t)(r0 + nd) * ldt + kdst + k0 + 8 * c) = o; }
    LDS_WAIT(); asm volatile("" ::: "memory");
}
__device__ __forceinline__ unsigned pk4_fp8(float a, float b, float c, float d) { int r = __builtin_amdgcn_cvt_pk_fp8_f32(a, b, 0, false); r = __builtin_amdgcn_cvt_pk_fp8_f32(c, d, r, true); return (unsigned)r; }
template <bool ROPEP = false>
__device__ __forceinline__ void transpose_item64_f8(const float* W, size_t ldw, int k0, int n0, unsigned char* WT, size_t ldt, int r0, LAS float* scr, int lane, float scale) {
    const GAS float* src = (const GAS float*)W + (size_t)(k0 + (lane >> 4)) * ldw + n0 + (lane & 15) * 4;
    f32x4 v[16];
#pragma unroll
    for (int i = 0; i < 16; ++i) v[i] = *(const GAS f32x4*)(src + (size_t)(4 * i) * ldw);
#pragma unroll
    for (int i = 0; i < 16; ++i) { LAS float* s = scr + (4 * i + (lane >> 4)) * 65 + (lane & 15) * 4; s[0] = v[i].x; s[1] = v[i].y; s[2] = v[i].z; s[3] = v[i].w; }
    LDS_WAIT(); asm volatile("" ::: "memory");
    const int c = lane & 7;
#pragma unroll
    for (int j = 0; j < 8; ++j) { const int n = (lane >> 3) + 8 * j; const LAS float* s = scr + (8 * c) * 65 + n;
        u32x2 o; o.x = pk4_fp8(s[0 * 65] * scale, s[1 * 65] * scale, s[2 * 65] * scale, s[3 * 65] * scale); o.y = pk4_fp8(s[4 * 65] * scale, s[5 * 65] * scale, s[6 * 65] * scale, s[7 * 65] * scale);
        const int nd = ROPEP ? (((n >> 4) & 1) * 32 + ((n >> 2) & 3) * 8 + (n >> 5) * 4 + (n & 3)) : n;
        *(GAS u32x2*)(WT + (size_t)(r0 + nd) * ldt + k0 + 8 * c) = o; }
    LDS_WAIT(); asm volatile("" ::: "memory");
}
__device__ __forceinline__ void rms_row_to_bf16(const float* xrow, const float* gain, bf16* orow, int lane, unsigned char* orow8 = nullptr) {
    const GAS f32x4* xr = (const GAS f32x4*)xrow + lane; const GAS f32x4* gr = (const GAS f32x4*)gain + lane;
    f32x4 v[8]; float s = 0.f;
#pragma unroll
    for (int j = 0; j < 8; ++j) { v[j] = xr[64 * j]; s += (v[j].x * v[j].x + v[j].y * v[j].y) + (v[j].z * v[j].z + v[j].w * v[j].w); }
    const float rs = 1.0f * FAST_RSQ(wave_sum(s) * (1.f / 2048.f) + EPS);
    GAS u32x2* o8 = (GAS u32x2*)orow + lane; GAS unsigned* o4 = (GAS unsigned*)orow8 + lane;
#pragma unroll
    for (int j = 0; j < 8; ++j) { const f32x4 g = gr[64 * j]; const float a0 = v[j].x * rs * g.x, a1 = v[j].y * rs * g.y, a2 = v[j].z * rs * g.z, a3 = v[j].w * rs * g.w;
        if (!(UV_F8 == 1 && GATE_F8)) { u32x2 w; w.x = cvtpk(a0, a1); w.y = cvtpk(a2, a3); o8[64 * j] = w; }
        if (orow8) o4[64 * j] = pk4_fp8(a0, a1, a2, a3); }
}
#define ATT_WAITV(n) asm volatile("s_waitcnt vmcnt(" #n ")" ::: "memory")
template <int DQK, int NSLOT, bool CAUSAL>
__device__ __forceinline__ void attn_unit(LAS unsigned char* lds, const bf16* Qw  , int qpitch, const bf16* Ktiles, const bf16* Vtiles,
                                          int ntiles, int qpos0  , unsigned char* Ow  , int opitch, int wid, int lane) {
    constexpr int KS = DQK / 16, KTB = 64 * DQK * 2, VTB = 64 * 128 * 2, KP = KTB / 1024 / 8  , VP = 2, NP = KP + VP, PF = NSLOT - 1;
    static_assert(KTB % 8192 == 0, "K tile pieces must split evenly over 8 waves");
    const int r32 = lane & 31, hi = lane >> 5;
    bf16x8 qf[KS];
    { const GAS bf16x8* qp = (const GAS bf16x8*)((const GAS bf16*)Qw + (size_t)r32 * qpitch + hi * 8);
#pragma unroll
      for (int ks = 0; ks < KS; ++ks) qf[ks] = qp[2 * ks]; }
    asm volatile("s_waitcnt vmcnt(0)" ::: "memory");
#pragma unroll
    for (int ks = 0; ks < KS; ++ks) asm volatile("" : "+v"(qf[ks]));
    const GAS unsigned char* kg = (const GAS unsigned char*)Ktiles + (size_t)wid * 1024;
    const GAS unsigned char* vg = (const GAS unsigned char*)Vtiles + (size_t)wid * 1024;
    const unsigned loff = (unsigned)lane * 16u;
    LAS unsigned char* kl = lds + wid * 1024; LAS unsigned char* vl = lds + NSLOT * KTB + wid * 1024;
#define ATT_ISSUE(t) do { const int sl_ = (t) % NSLOT; unsigned lo_ = loff; asm volatile("" : "+v"(lo_));   \
        _Pragma("unroll") for (int p_ = 0; p_ < KP; ++p_) __builtin_amdgcn_global_load_lds((const GAS unsigned*)(kg + ((size_t)(t) * KTB + p_ * 8192) + lo_), (LAS unsigned*)(kl + sl_ * KTB + p_ * 8192), 16, 0, 0); \
        _Pragma("unroll") for (int p_ = 0; p_ < VP; ++p_) __builtin_amdgcn_global_load_lds((const GAS unsigned*)(vg + ((size_t)(t) * VTB + p_ * 8192) + lo_), (LAS unsigned*)(vl + sl_ * VTB + p_ * 8192), 16, 0, 0); } while (0)
#pragma unroll
    for (int t = 0; t < PF; ++t) if (t < ntiles) ATT_ISSUE(t);
    f32x16 o[4];
#pragma unroll
    for (int d = 0; d < 4; ++d)
#pragma unroll
        for (int r = 0; r < 16; ++r) o[d][r] = 0.f;
    float mrun = -1e30f, lrun = 0.f;
    const int kbase = hi * 1024 + r32 * 16;
    const int g4 = lane >> 4, q4 = (lane >> 2) & 3, p4 = lane & 3;
    const int vbase = (4 * (g4 >> 1) + q4) * 64 + (16 * (g4 & 1) + 4 * p4) * 2;
    for (int j = 0; j < ntiles; ++j) {
        const int rem = ntiles - 1 - j;
        if (PF >= 2 && rem >= 1) { if (NP == 5) ATT_WAITV(5); else ATT_WAITV(6); } else ATT_WAITV(0);
        __builtin_amdgcn_s_barrier();
        asm volatile("" ::: "memory");
        if (j + PF < ntiles) ATT_ISSUE(j + PF);
        if (CAUSAL && 64 * j > qpos0 + 31) continue;
        const int sl = j % NSLOT;
        const LAS unsigned char* ks_ = lds + sl * KTB + kbase;
        const LAS unsigned char* vs_ = lds + NSLOT * KTB + sl * VTB + vbase;
        f32x16 p0, p1;
#pragma unroll
        for (int r = 0; r < 16; ++r) { p0[r] = 0.f; p1[r] = 0.f; }
        {   constexpr int NF = 2 * KS, KW = 8;
            bf16x8 kf[KW];
#pragma unroll
            for (int i = 0; i < KW; ++i) kf[i] = *(const LAS bf16x8*)(ks_ + (i >> 1) * 2048 + (i & 1) * 512);
            __builtin_amdgcn_sched_barrier(0);
#pragma unroll
            for (int i = 0; i < NF; ++i) {
                if (i & 1) p1 = __builtin_amdgcn_mfma_f32_32x32x16_bf16(kf[i % KW], qf[i >> 1], p1, 0, 0, 0);
                else       p0 = __builtin_amdgcn_mfma_f32_32x32x16_bf16(kf[i % KW], qf[i >> 1], p0, 0, 0, 0);
                if (i + KW < NF) kf[i % KW] = *(const LAS bf16x8*)(ks_ + ((i + KW) >> 1) * 2048 + ((i + KW) & 1) * 512);
                __builtin_amdgcn_sched_barrier(0);
            }
        }
        if (CAUSAL && 64 * j + 63 > qpos0) {
            const int dq = qpos0 + r32 - 64 * j - 4 * hi;
#pragma unroll
            for (int r = 0; r < 16; ++r) { const int c = (r & 3) + 8 * (r >> 2); if (c > dq) p0[r] = -INFINITY; if (c + 32 > dq) p1[r] = -INFINITY; }
        }
        float mx = p0[0];
#pragma unroll
        for (int r = 1; r < 16; ++r) mx = fmaxf(mx, p0[r]);
#pragma unroll
        for (int r = 0; r < 16; ++r) mx = fmaxf(mx, p1[r]);
        mx = XL_FAST ? xl_swap32_max(mx) : fmaxf(mx, __shfl_xor(mx, 32));
        const float mnew = fmaxf(mrun, mx);
        if (__any(mnew > mrun)) {
            const float alpha = __builtin_amdgcn_exp2f(mrun - mnew);
            lrun *= alpha;
#pragma unroll
            for (int d = 0; d < 4; ++d)
#pragma unroll
                for (int r = 0; r < 16; ++r) o[d][r] *= alpha;
            mrun = mnew;
        }
        float ps = 0.f;
#pragma unroll
        for (int r = 0; r < 16; ++r) { p0[r] = __builtin_amdgcn_exp2f(p0[r] - mrun); p1[r] = __builtin_amdgcn_exp2f(p1[r] - mrun); ps += p0[r] + p1[r]; }
        lrun += ps;
        bf16x8 pf[4];
        { v4u w;
          w.x = cvtpk(p0[0], p0[1]); w.y = cvtpk(p0[2], p0[3]); w.z = cvtpk(p0[4], p0[5]); w.w = cvtpk(p0[6], p0[7]); pf[0] = __builtin_bit_cast(bf16x8, w);
          w.x = cvtpk(p0[8], p0[9]); w.y = cvtpk(p0[10], p0[11]); w.z = cvtpk(p0[12], p0[13]); w.w = cvtpk(p0[14], p0[15]); pf[1] = __builtin_bit_cast(bf16x8, w);
          w.x = cvtpk(p1[0], p1[1]); w.y = cvtpk(p1[2], p1[3]); w.z = cvtpk(p1[4], p1[5]); w.w = cvtpk(p1[6], p1[7]); pf[2] = __builtin_bit_cast(bf16x8, w);
          w.x = cvtpk(p1[8], p1[9]); w.y = cvtpk(p1[10], p1[11]); w.z = cvtpk(p1[12], p1[13]); w.w = cvtpk(p1[14], p1[15]); pf[3] = __builtin_bit_cast(bf16x8, w); }
#define ATT_VLOAD(dst, s_) do { _Pragma("unroll") for (int db_ = 0; db_ < 4; ++db_) { \
            const s16x4 lo_ = __builtin_bit_cast(s16x4, __builtin_amdgcn_ds_read_tr16_b64_v4i16((LAS v4i16_t*)(vs_ + db_ * 4096 + (s_) * 1024))); \
            const s16x4 hh_ = __builtin_bit_cast(s16x4, __builtin_amdgcn_ds_read_tr16_b64_v4i16((LAS v4i16_t*)(vs_ + db_ * 4096 + (s_) * 1024 + 512))); \
            dst[db_] = (bf16x8){lo_[0], lo_[1], lo_[2], lo_[3], hh_[0], hh_[1], hh_[2], hh_[3]}; } } while (0)
        {   bf16x8 va[4], vb[4];
            ATT_VLOAD(va, 0);
            __builtin_amdgcn_sched_barrier(0);
            ATT_VLOAD(vb, 1);
#pragma unroll
            for (int db = 0; db < 4; ++db) o[db] = __builtin_amdgcn_mfma_f32_32x32x16_bf16(va[db], pf[0], o[db], 0, 0, 0);
            __builtin_amdgcn_sched_barrier(0);
            ATT_VLOAD(va, 2);
#pragma unroll
            for (int db = 0; db < 4; ++db) o[db] = __builtin_amdgcn_mfma_f32_32x32x16_bf16(vb[db], pf[1], o[db], 0, 0, 0);
            __builtin_amdgcn_sched_barrier(0);
            ATT_VLOAD(vb, 3);
#pragma unroll
            for (int db = 0; db < 4; ++db) o[db] = __builtin_amdgcn_mfma_f32_32x32x16_bf16(va[db], pf[2], o[db], 0, 0, 0);
            __builtin_amdgcn_sched_barrier(0);
#pragma unroll
            for (int db = 0; db < 4; ++db) o[db] = __builtin_amdgcn_mfma_f32_32x32x16_bf16(vb[db], pf[3], o[db], 0, 0, 0);
            __builtin_amdgcn_sched_barrier(0);
        }
#undef ATT_VLOAD
    }
    const float lt = XL_FAST ? xl_swap32_sum(lrun) : lrun + __shfl_xor(lrun, 32);
    const float il = ATT_OS / lt;
    GAS unsigned char* op = (GAS unsigned char*)Ow + (size_t)r32 * opitch + 4 * hi;
#pragma unroll
    for (int db = 0; db < 4; ++db)
#pragma unroll
        for (int rg = 0; rg < 4; ++rg) *(GAS unsigned*)(op + 32 * db + 8 * rg) = pk4_fp8(o[db][4 * rg] * il, o[db][4 * rg + 1] * il, o[db][4 * rg + 2] * il, o[db][4 * rg + 3] * il);
    asm volatile("s_waitcnt vmcnt(0) lgkmcnt(0)" ::: "memory");
    __builtin_amdgcn_s_barrier();
    asm volatile("" ::: "memory");
#undef ATT_ISSUE
}

typedef int i32x8a __attribute__((ext_vector_type(8)));
typedef int i32x4a __attribute__((ext_vector_type(4)));
__device__ __forceinline__ void att_bar4(LAS unsigned* ctr, unsigned& nbar, int lane) {
#if SPLIT_FREE
    nbar += 4;
    if (lane == 0) __hip_atomic_fetch_add(ctr, 1u, __ATOMIC_RELAXED, __HIP_MEMORY_SCOPE_WORKGROUP);
    for (;;) { const unsigned v = __builtin_amdgcn_readfirstlane(__hip_atomic_load(ctr, __ATOMIC_RELAXED, __HIP_MEMORY_SCOPE_WORKGROUP)); if (v >= nbar) break; if (ATT_POLL_SLEEP) __builtin_amdgcn_s_sleep(1); }
    asm volatile("" ::: "memory");
#else
    __builtin_amdgcn_s_barrier();
    asm volatile("" ::: "memory");
#endif
}
template <bool CAUSAL, int NWA = 8>
__device__ __forceinline__ void attn8_unit(LAS unsigned char* lds, const unsigned char* Qw  , const unsigned char* Ktiles, const unsigned char* Vtiles,
                                           int ntiles, int qpos0, unsigned char* Ow  , int opitch, int wid, int lane, LAS unsigned* bctr = nullptr, unsigned* nbar = nullptr) {
    constexpr int KTB = 12288, VTB = 8192, NSLOT = 3;
    const int r32 = lane & 31, hi = lane >> 5;
    i32x8a qf[3];
    { const GAS i32x4a* qp = (const GAS i32x4a*)((const GAS unsigned char*)Qw + (size_t)r32 * 192 + hi * 32);
#pragma unroll
      for (int s = 0; s < 3; ++s) { const i32x4a a = qp[4 * s], b = qp[4 * s + 1]; qf[s] = __builtin_shufflevector(a, b, 0, 1, 2, 3, 4, 5, 6, 7); } }
    asm volatile("s_waitcnt vmcnt(0)" ::: "memory");
#pragma unroll
    for (int s = 0; s < 3; ++s) asm volatile("" : "+v"(qf[s]));
    const GAS unsigned char* kg = (const GAS unsigned char*)Ktiles + (size_t)wid * 1024;
    const GAS unsigned char* vg = (const GAS unsigned char*)Vtiles + (size_t)wid * 1024;
    const unsigned loff = (unsigned)lane * 16u;
    LAS unsigned char* kl = lds + wid * 1024; LAS unsigned char* vl = lds + NSLOT * KTB + wid * 1024;
    const bool two = wid < 4;
#define A8_ISSUE(t) do { const int sl_ = (t) % NSLOT; unsigned lo_ = loff; asm volatile("" : "+v"(lo_)); \
        if (NWA == 8) { \
            __builtin_amdgcn_global_load_lds((const GAS unsigned*)(kg + (size_t)(t) * KTB + lo_), (LAS unsigned*)(kl + sl_ * KTB), 16, 0, 0); \
            if (two) __builtin_amdgcn_global_load_lds((const GAS unsigned*)(kg + ((size_t)(t) * KTB + 8192) + lo_), (LAS unsigned*)(kl + sl_ * KTB + 8192), 16, 0, 0); \
            __builtin_amdgcn_global_load_lds((const GAS unsigned*)(vg + (size_t)(t) * VTB + lo_), (LAS unsigned*)(vl + sl_ * VTB), 16, 0, 0); \
        } else {     \
            _Pragma("unroll") for (int p_ = 0; p_ < 3; ++p_) __builtin_amdgcn_global_load_lds((const GAS unsigned*)(kg + ((size_t)(t) * KTB + p_ * 4096) + lo_), (LAS unsigned*)(kl + sl_ * KTB + p_ * 4096), 16, 0, 0); \
            _Pragma("unroll") for (int p_ = 0; p_ < 2; ++p_) __builtin_amdgcn_global_load_lds((const GAS unsigned*)(vg + ((size_t)(t) * VTB + p_ * 4096) + lo_), (LAS unsigned*)(vl + sl_ * VTB + p_ * 4096), 16, 0, 0); \
        } } while (0)
    A8_ISSUE(0);
    if (ntiles > 1) A8_ISSUE(1);
    f32x16 o[4];
#pragma unroll
    for (int d = 0; d < 4; ++d)
#pragma unroll
        for (int r = 0; r < 16; ++r) o[d][r] = 0.f;
    float mrun = -1e30f, lrun = 0.f;
    const int kbase = (2 * hi) * 1024 + r32 * 16, vbase = (2 * hi) * 2048 + r32 * 16;
    const int SQ = 0x7b7b7b7b, SP = 0x79797979, S1 = 0x7f7f7f7f;
    for (int j = 0; j < ntiles; ++j) {
        if (ntiles - 1 - j >= 1) { if (NWA == 4) ATT_WAITV(5); else if (two) ATT_WAITV(3); else ATT_WAITV(2); } else ATT_WAITV(0);
        if (NWA == 4 && bctr) att_bar4(bctr, *nbar, lane); else { __builtin_amdgcn_s_barrier(); asm volatile("" ::: "memory"); }
        if (j + 2 < ntiles) A8_ISSUE(j + 2);
        if (CAUSAL && 64 * j > qpos0 + 31) continue;
        const int sl = j % NSLOT;
        const LAS unsigned char* ks_ = lds + sl * KTB + kbase;
        const LAS unsigned char* vs_ = lds + NSLOT * KTB + sl * VTB + vbase;
        i32x8a kf[3][2];
#pragma unroll
        for (int s = 0; s < 3; ++s)
#pragma unroll
            for (int kb = 0; kb < 2; ++kb) { const i32x4a a = *(const LAS i32x4a*)(ks_ + s * 4096 + kb * 512), b = *(const LAS i32x4a*)(ks_ + s * 4096 + kb * 512 + 1024);
                kf[s][kb] = __builtin_shufflevector(a, b, 0, 1, 2, 3, 4, 5, 6, 7); }
        f32x16 p0, p1;
#pragma unroll
        for (int r = 0; r < 16; ++r) { p0[r] = 0.f; p1[r] = 0.f; }
#pragma unroll
        for (int s = 0; s < 3; ++s) {
            p0 = __builtin_amdgcn_mfma_scale_f32_32x32x64_f8f6f4(kf[s][0], qf[s], p0, 0, 0, 0, S1, 0, SQ);
            p1 = __builtin_amdgcn_mfma_scale_f32_32x32x64_f8f6f4(kf[s][1], qf[s], p1, 0, 0, 0, S1, 0, SQ);
        }
        i32x8a vf[4];
#pragma unroll
        for (int db = 0; db < 4; ++db) { const i32x4a a = *(const LAS i32x4a*)(vs_ + db * 512), b = *(const LAS i32x4a*)(vs_ + db * 512 + 2048); vf[db] = __builtin_shufflevector(a, b, 0, 1, 2, 3, 4, 5, 6, 7); }
        __builtin_amdgcn_sched_barrier(0);
        if (CAUSAL && 64 * j + 63 > qpos0) {
            const int dq = qpos0 + r32 - 64 * j - 4 * hi;
#pragma unroll
            for (int r = 0; r < 16; ++r) { const int c = (r & 3) + 8 * (r >> 2); if (c > dq) p0[r] = -INFINITY; if (c + 32 > dq) p1[r] = -INFINITY; }
        }
        float mx = p0[0];
#pragma unroll
        for (int r = 1; r < 16; ++r) mx = fmaxf(mx, p0[r]);
#pragma unroll
        for (int r = 0; r < 16; ++r) mx = fmaxf(mx, p1[r]);
        mx = XL_FAST ? xl_swap32_max(mx) : fmaxf(mx, __shfl_xor(mx, 32));
        const float mnew = fmaxf(mrun, mx);
        if (__any(mx > mrun + 2.0f)) {
            const float alpha = __builtin_amdgcn_exp2f(mrun - mnew);
            lrun *= alpha;
#pragma unroll
            for (int d = 0; d < 4; ++d)
#pragma unroll
                for (int r = 0; r < 16; ++r) o[d][r] *= alpha;
            mrun = mnew;
        }
        float ps = 0.f; const float msh = mrun - 6.0f;
#pragma unroll
        for (int r = 0; r < 16; ++r) { p0[r] = __builtin_amdgcn_exp2f(p0[r] - msh); p1[r] = __builtin_amdgcn_exp2f(p1[r] - msh); ps += p0[r] + p1[r]; }
        lrun += ps;
        i32x8a pf;
        pf[0] = (int)pk4_fp8(p0[0], p0[1], p0[2], p0[3]); pf[1] = (int)pk4_fp8(p0[4], p0[5], p0[6], p0[7]); pf[2] = (int)pk4_fp8(p0[8], p0[9], p0[10], p0[11]); pf[3] = (int)pk4_fp8(p0[12], p0[13], p0[14], p0[15]);
        pf[4] = (int)pk4_fp8(p1[0], p1[1], p1[2], p1[3]); pf[5] = (int)pk4_fp8(p1[4], p1[5], p1[6], p1[7]); pf[6] = (int)pk4_fp8(p1[8], p1[9], p1[10], p1[11]); pf[7] = (int)pk4_fp8(p1[12], p1[13], p1[14], p1[15]);
#pragma unroll
        for (int db = 0; db < 4; ++db) o[db] = __builtin_amdgcn_mfma_scale_f32_32x32x64_f8f6f4(vf[db], pf, o[db], 0, 0, 0, S1, 0, SP);
    }
    const float lt = XL_FAST ? xl_swap32_sum(lrun) : lrun + __shfl_xor(lrun, 32);
    const float il = 64.0f * ATT_OS / lt;
    GAS unsigned char* op = (GAS unsigned char*)Ow + (size_t)r32 * opitch + 4 * hi;
#pragma unroll
    for (int db = 0; db < 4; ++db)
#pragma unroll
        for (int rg = 0; rg < 4; ++rg) *(GAS unsigned*)(op + 32 * db + 8 * rg) = pk4_fp8(o[db][4 * rg] * il, o[db][4 * rg + 1] * il, o[db][4 * rg + 2] * il, o[db][4 * rg + 3] * il);
    asm volatile("s_waitcnt vmcnt(0) lgkmcnt(0)" ::: "memory");
    if (NWA == 4 && bctr) att_bar4(bctr, *nbar, lane); else { __builtin_amdgcn_s_barrier(); asm volatile("" ::: "memory"); }
#undef A8_ISSUE
}

__device__ __forceinline__ float xhalf_max(float x) { const auto r = __builtin_amdgcn_permlane32_swap(__float_as_uint(x), __float_as_uint(x), false, false); return fmaxf(__uint_as_float(r[0]), __uint_as_float(r[1])); }
__device__ __forceinline__ float xhalf_sum(float x) { const auto r = __builtin_amdgcn_permlane32_swap(__float_as_uint(x), __float_as_uint(x), false, false); return __uint_as_float(r[0]) + __uint_as_float(r[1]); }
template <bool CAUSAL>
__device__ __forceinline__ void attn8_unit2(LAS unsigned char* lds, const unsigned char* Qw  , const unsigned char* Ktiles, const unsigned char* Vtiles,
                                            int ntiles, int qpos0  , unsigned char* Ow, int opitch, int wid, int lane, LAS unsigned* bctr, unsigned& nbar) {
    constexpr int KTB = 12288, VTB = 8192, NSLOT = ATT_PAIR ? 2 : 3, KSB = ATT_PAIR ? 2 * KTB : KTB, VSB = ATT_PAIR ? 2 * VTB : VTB;
    const int r32 = lane & 31, hi = lane >> 5;
    i32x8a qf[2][3];
#pragma unroll
    for (int bk = 0; bk < 2; ++bk) { const GAS i32x4a* qp = (const GAS i32x4a*)((const GAS unsigned char*)Qw + (size_t)(128 * bk + r32) * 192 + hi * 32);
#pragma unroll
      for (int s = 0; s < 3; ++s) { const i32x4a a = qp[4 * s], b = qp[4 * s + 1]; qf[bk][s] = __builtin_shufflevector(a, b, 0, 1, 2, 3, 4, 5, 6, 7); } }
    asm volatile("s_waitcnt vmcnt(0)" ::: "memory");
#pragma unroll
    for (int bk = 0; bk < 2; ++bk)
#pragma unroll
        for (int s = 0; s < 3; ++s) asm volatile("" : "+v"(qf[bk][s]));
    const GAS unsigned char* kg = (const GAS unsigned char*)Ktiles + (size_t)wid * 1024;
    const GAS unsigned char* vg = (const GAS unsigned char*)Vtiles + (size_t)wid * 1024;
    const unsigned loff = (unsigned)lane * 16u;
    LAS unsigned char* kl = lds + wid * 1024; LAS unsigned char* vl = lds + NSLOT * KSB + wid * 1024;
#define A2_ISSUE(t) do { const int sl_ = (t) % NSLOT; unsigned lo_ = loff; asm volatile("" : "+v"(lo_)); \
        _Pragma("unroll") for (int p_ = 0; p_ < KSB / 4096; ++p_) __builtin_amdgcn_global_load_lds((const GAS unsigned*)(kg + ((size_t)(t) * KSB + p_ * 4096) + lo_), (LAS unsigned*)(kl + sl_ * KSB + p_ * 4096), 16, 0, 0); \
        _Pragma("unroll") for (int p_ = 0; p_ < VSB / 4096; ++p_) __builtin_amdgcn_global_load_lds((const GAS unsigned*)(vg + ((size_t)(t) * VSB + p_ * 4096) + lo_), (LAS unsigned*)(vl + sl_ * VSB + p_ * 4096), 16, 0, 0); } while (0)
#define A2_PIECE(tp_, ix_) do { const int sl_ = (tp_) % NSLOT; unsigned lo_ = loff; asm volatile("" : "+v"(lo_)); \
        if ((ix_) < 6) __builtin_amdgcn_global_load_lds((const GAS unsigned*)(kg + ((size_t)(tp_) * KSB + (ix_) * 4096) + lo_), (LAS unsigned*)(kl + sl_ * KSB + (ix_) * 4096), 16, 0, 0); \
        else __builtin_amdgcn_global_load_lds((const GAS unsigned*)(vg + ((size_t)(tp_) * VSB + ((ix_) - 6) * 4096) + lo_), (LAS unsigned*)(vl + sl_ * VSB + ((ix_) - 6) * 4096), 16, 0, 0); } while (0)
#define A2_SPREAD(ix_) do { if (ATT_SPREAD && ATT_PAIR && bk == 1 && pend) { __builtin_amdgcn_sched_barrier(0); A2_PIECE((j >> 1) + 1, ix_); __builtin_amdgcn_sched_barrier(0); } } while (0)
    A2_ISSUE(0);
    if (!ATT_PAIR && ntiles > 1) A2_ISSUE(1);
    f32x16 o[2][4];
#pragma unroll
    for (int bk = 0; bk < 2; ++bk)
#pragma unroll
        for (int d = 0; d < 4; ++d)
#pragma unroll
            for (int r = 0; r < 16; ++r) o[bk][d][r] = 0.f;
    float mrun[2] = {-1e30f, -1e30f}, lrun[2] = {0.f, 0.f};
    const int kbase = (2 * hi) * 1024 + r32 * 16, vbase = (2 * hi) * 2048 + r32 * 16;
    const int SQ = 0x7b7b7b7b, SP = 0x79797979, S1 = 0x7f7f7f7f;
    for (int j = 0; j < ntiles; ++j) {
#if ATT_PAIR
        if ((j & 1) == 0) {
            ATT_WAITV(0);
            att_bar4(bctr, nbar, lane);
            if (!ATT_SPREAD && j + 2 < ntiles) A2_ISSUE((j >> 1) + 1);
        }
        const bool pend = ATT_SPREAD && (j & 1) == 0 && (j + 2 < ntiles); (void)pend;
        const int sl = (j >> 1) % NSLOT;
        unsigned ka_ = (unsigned)(sl * KSB + (j & 1) * KTB + kbase), va_ = (unsigned)(NSLOT * KSB + sl * VSB + (j & 1) * VTB + vbase);
#else
        if (ntiles - 1 - j >= 1) ATT_WAITV(5); else ATT_WAITV(0);
        att_bar4(bctr, nbar, lane);
        if (j + 2 < ntiles) A2_ISSUE(j + 2);
        const int sl = j % NSLOT;
        unsigned ka_ = (unsigned)(sl * KTB + kbase), va_ = (unsigned)(NSLOT * KTB + sl * VTB + vbase);
        const bool pend = false; (void)pend;
#endif
        asm volatile("" : "+v"(ka_), "+v"(va_));
        const LAS unsigned char* ks_ = lds + ka_;
        const LAS unsigned char* vs_ = lds + va_;
        i32x8a pf_prev; bool have_prev = false; (void)pf_prev;
#pragma unroll
        for (int bk = 0; bk < 2; ++bk) {
            const int qp0 = qpos0 + 128 * bk;
            if (CAUSAL && 64 * j > qp0 + 31) continue;
#if ATT_SPLITQK
            f32x16 p0, p1;
#pragma unroll
            for (int r = 0; r < 16; ++r) { p0[r] = 0.f; p1[r] = 0.f; }
#pragma unroll
            for (int s = 0; s < 3; ++s) {
                const i32x4a a0 = *(const LAS i32x4a*)(ks_ + s * 4096), b0 = *(const LAS i32x4a*)(ks_ + s * 4096 + 1024);
                const i32x8a k0 = __builtin_shufflevector(a0, b0, 0, 1, 2, 3, 4, 5, 6, 7);
                p0 = __builtin_amdgcn_mfma_scale_f32_32x32x64_f8f6f4(k0, qf[bk][s], p0, 0, 0, 0, S1, 0, SQ);
            }
            __builtin_amdgcn_sched_barrier(0);
#pragma unroll
            for (int s = 0; s < 3; ++s) {
                const i32x4a a1 = *(const LAS i32x4a*)(ks_ + s * 4096 + 512), b1 = *(const LAS i32x4a*)(ks_ + s * 4096 + 512 + 1024);
                const i32x8a k1 = __builtin_shufflevector(a1, b1, 0, 1, 2, 3, 4, 5, 6, 7);
                p1 = __builtin_amdgcn_mfma_scale_f32_32x32x64_f8f6f4(k1, qf[bk][s], p1, 0, 0, 0, S1, 0, SQ);
            }
            __builtin_amdgcn_sched_barrier(0);
            const bool diag = CAUSAL && 64 * j + 63 > qp0;
            const int dq = qp0 + r32 - 64 * j - 4 * hi;
            if (diag) {
#pragma unroll
                for (int r = 0; r < 16; ++r) { const int c = (r & 3) + 8 * (r >> 2); if (c > dq) p0[r] = -INFINITY; }
            }
            float mx = p0[0];
#pragma unroll
            for (int r = 1; r < 16; ++r) mx = fmaxf(mx, p0[r]);
            mx = ATT_PERMLANE ? xhalf_max(mx) : fmaxf(mx, __shfl_xor(mx, 32));
            if (__any(mx > mrun[bk] + 2.0f)) {
                const float mnew = fmaxf(mrun[bk], mx), alpha = __builtin_amdgcn_exp2f(mrun[bk] - mnew);
                lrun[bk] *= alpha;
#pragma unroll
                for (int d = 0; d < 4; ++d)
#pragma unroll
                    for (int r = 0; r < 16; ++r) o[bk][d][r] *= alpha;
                mrun[bk] = mnew;
            }
            float msh = mrun[bk] - 6.0f, ps = 0.f;
#pragma unroll
            for (int r = 0; r < 16; ++r) { p0[r] = __builtin_amdgcn_exp2f(p0[r] - msh); ps += p0[r]; }
            __builtin_amdgcn_sched_barrier(0);
            if (diag) {
#pragma unroll
                for (int r = 0; r < 16; ++r) { const int c = (r & 3) + 8 * (r >> 2); if (c + 32 > dq) p1[r] = -INFINITY; }
            }
            mx = p1[0];
#pragma unroll
            for (int r = 1; r < 16; ++r) mx = fmaxf(mx, p1[r]);
            mx = ATT_PERMLANE ? xhalf_max(mx) : fmaxf(mx, __shfl_xor(mx, 32));
            if (__any(mx > mrun[bk] + 2.0f)) {
                const float mnew = fmaxf(mrun[bk], mx), alpha = __builtin_amdgcn_exp2f(mrun[bk] - mnew);
                lrun[bk] *= alpha; ps *= alpha;
#pragma unroll
                for (int r = 0; r < 16; ++r) p0[r] *= alpha;
#pragma unroll
                for (int d = 0; d < 4; ++d)
#pragma unroll
                    for (int r = 0; r < 16; ++r) o[bk][d][r] *= alpha;
                mrun[bk] = mnew; msh = mnew - 6.0f;
            }
#pragma unroll
            for (int r = 0; r < 16; ++r) { p1[r] = __builtin_amdgcn_exp2f(p1[r] - msh); ps += p1[r]; }
            lrun[bk] += ps;
            i32x8a pf;
            pf[0] = (int)pk4_fp8(p0[0], p0[1], p0[2], p0[3]); pf[1] = (int)pk4_fp8(p0[4], p0[5], p0[6], p0[7]); pf[2] = (int)pk4_fp8(p0[8], p0[9], p0[10], p0[11]); pf[3] = (int)pk4_fp8(p0[12], p0[13], p0[14], p0[15]);
            pf[4] = (int)pk4_fp8(p1[0], p1[1], p1[2], p1[3]); pf[5] = (int)pk4_fp8(p1[4], p1[5], p1[6], p1[7]); pf[6] = (int)pk4_fp8(p1[8], p1[9], p1[10], p1[11]); pf[7] = (int)pk4_fp8(p1[12], p1[13], p1[14], p1[15]);
            asm volatile("" : "+v"(pf));
#pragma unroll
            for (int db = 0; db < 4; ++db) { const i32x4a a = *(const LAS i32x4a*)(vs_ + db * 512), b = *(const LAS i32x4a*)(vs_ + db * 512 + 2048);
                const i32x8a vfd = __builtin_shufflevector(a, b, 0, 1, 2, 3, 4, 5, 6, 7);
                asm volatile("v_mfma_scale_f32_32x32x64_f8f6f4 %0, %1, %2, %0, %3, %4 op_sel_hi:[0,0,0]" : "+v"(o[bk][db]) : "v"(vfd), "v"(pf), "v"(S1), "v"(SP));
                A2_SPREAD(6 + db); }
            if (ATT_SPREAD && ATT_PAIR && bk == 1 && pend) { A2_PIECE((j >> 1) + 1, 0); A2_PIECE((j >> 1) + 1, 1); A2_PIECE((j >> 1) + 1, 2); A2_PIECE((j >> 1) + 1, 3); A2_PIECE((j >> 1) + 1, 4); A2_PIECE((j >> 1) + 1, 5); }
#else
            f32x16 p0, p1;
#pragma unroll
            for (int r = 0; r < 16; ++r) { p0[r] = 0.f; p1[r] = 0.f; }
#pragma unroll
            for (int s = 0; s < 3; ++s) {
                const i32x4a a0 = *(const LAS i32x4a*)(ks_ + s * 4096), b0 = *(const LAS i32x4a*)(ks_ + s * 4096 + 1024);
                const i32x4a a1 = *(const LAS i32x4a*)(ks_ + s * 4096 + 512), b1 = *(const LAS i32x4a*)(ks_ + s * 4096 + 512 + 1024);
                const i32x8a k0 = __builtin_shufflevector(a0, b0, 0, 1, 2, 3, 4, 5, 6, 7), k1 = __builtin_shufflevector(a1, b1, 0, 1, 2, 3, 4, 5, 6, 7);
                p0 = __builtin_amdgcn_mfma_scale_f32_32x32x64_f8f6f4(k0, qf[bk][s], p0, 0, 0, 0, S1, 0, SQ);
                p1 = __builtin_amdgcn_mfma_scale_f32_32x32x64_f8f6f4(k1, qf[bk][s], p1, 0, 0, 0, S1, 0, SQ);
            }
#if ATT_DEFER
            if (bk == 1 && have_prev) {
                __builtin_amdgcn_sched_barrier(0);
#pragma unroll
                for (int db = 0; db < 4; ++db) { const i32x4a a = *(const LAS i32x4a*)(vs_ + db * 512), b = *(const LAS i32x4a*)(vs_ + db * 512 + 2048);
                    const i32x8a vfd = __builtin_shufflevector(a, b, 0, 1, 2, 3, 4, 5, 6, 7);
                    asm volatile("v_mfma_scale_f32_32x32x64_f8f6f4 %0, %1, %2, %0, %3, %4 op_sel_hi:[0,0,0]" : "+v"(o[0][db]) : "v"(vfd), "v"(pf_prev), "v"(S1), "v"(SP));
                    __builtin_amdgcn_sched_barrier(0); }
            }
#endif
            if (CAUSAL && 64 * j + 63 > qp0) {
                const int dq = qp0 + r32 - 64 * j - 4 * hi;
#pragma unroll
                for (int r = 0; r < 16; ++r) { const int c = (r & 3) + 8 * (r >> 2); if (c > dq) p0[r] = -INFINITY; if (c + 32 > dq) p1[r] = -INFINITY; }
            }
            float mx = p0[0];
#pragma unroll
            for (int r = 1; r < 16; ++r) mx = fmaxf(mx, p0[r]);
#pragma unroll
            for (int r = 0; r < 16; ++r) mx = fmaxf(mx, p1[r]);
            mx = ATT_PERMLANE ? xhalf_max(mx) : fmaxf(mx, __shfl_xor(mx, 32));
            const float mnew = fmaxf(mrun[bk], mx);
            if (__any(mx > mrun[bk] + 2.0f)) {
                const float alpha = __builtin_amdgcn_exp2f(mrun[bk] - mnew);
                lrun[bk] *= alpha;
#pragma unroll
                for (int d = 0; d < 4; ++d)
#pragma unroll
                    for (int r = 0; r < 16; ++r) o[bk][d][r] *= alpha;
                mrun[bk] = mnew;
            }
#if ATT_VPRE
            float ps = 0.f; const float msh = mrun[bk] - 6.0f;
            i32x8a pf;
#pragma unroll
            for (int r = 0; r < 16; ++r) { p0[r] = __builtin_amdgcn_exp2f(p0[r] - msh); ps += p0[r]; }
            pf[0] = (int)pk4_fp8(p0[0], p0[1], p0[2], p0[3]); pf[1] = (int)pk4_fp8(p0[4], p0[5], p0[6], p0[7]); pf[2] = (int)pk4_fp8(p0[8], p0[9], p0[10], p0[11]); pf[3] = (int)pk4_fp8(p0[12], p0[13], p0[14], p0[15]);
            asm volatile("" : "+v"(pf[0]), "+v"(pf[1]), "+v"(pf[2]), "+v"(pf[3]));
            i32x8a vf0, vf1, vf2, vf3;
            { const i32x4a a = *(const LAS i32x4a*)(vs_ + 0 * 512), b = *(const LAS i32x4a*)(vs_ + 0 * 512 + 2048); vf0 = __builtin_shufflevector(a, b, 0, 1, 2, 3, 4, 5, 6, 7); }
            { const i32x4a a = *(const LAS i32x4a*)(vs_ + 1 * 512), b = *(const LAS i32x4a*)(vs_ + 1 * 512 + 2048); vf1 = __builtin_shufflevector(a, b, 0, 1, 2, 3, 4, 5, 6, 7); }
            asm volatile("" ::: "memory");
#pragma unroll
            for (int r = 0; r < 16; ++r) { p1[r] = __builtin_amdgcn_exp2f(p1[r] - msh); ps += p1[r]; }
            lrun[bk] += ps;
            pf[4] = (int)pk4_fp8(p1[0], p1[1], p1[2], p1[3]); pf[5] = (int)pk4_fp8(p1[4], p1[5], p1[6], p1[7]); pf[6] = (int)pk4_fp8(p1[8], p1[9], p1[10], p1[11]); pf[7] = (int)pk4_fp8(p1[12], p1[13], p1[14], p1[15]);
            asm volatile("" : "+v"(pf));
            { const i32x4a a = *(const LAS i32x4a*)(vs_ + 2 * 512), b = *(const LAS i32x4a*)(vs_ + 2 * 512 + 2048); vf2 = __builtin_shufflevector(a, b, 0, 1, 2, 3, 4, 5, 6, 7); }
            { const i32x4a a = *(const LAS i32x4a*)(vs_ + 3 * 512), b = *(const LAS i32x4a*)(vs_ + 3 * 512 + 2048); vf3 = __builtin_shufflevector(a, b, 0, 1, 2, 3, 4, 5, 6, 7); }
            asm volatile("v_mfma_scale_f32_32x32x64_f8f6f4 %0, %1, %2, %0, %3, %4 op_sel_hi:[0,0,0]" : "+v"(o[bk][0]) : "v"(vf0), "v"(pf), "v"(S1), "v"(SP));
            asm volatile("v_mfma_scale_f32_32x32x64_f8f6f4 %0, %1, %2, %0, %3, %4 op_sel_hi:[0,0,0]" : "+v"(o[bk][1]) : "v"(vf1), "v"(pf), "v"(S1), "v"(SP));
            asm volatile("v_mfma_scale_f32_32x32x64_f8f6f4 %0, %1, %2, %0, %3, %4 op_sel_hi:[0,0,0]" : "+v"(o[bk][2]) : "v"(vf2), "v"(pf), "v"(S1), "v"(SP));
            asm volatile("v_mfma_scale_f32_32x32x64_f8f6f4 %0, %1, %2, %0, %3, %4 op_sel_hi:[0,0,0]" : "+v"(o[bk][3]) : "v"(vf3), "v"(pf), "v"(S1), "v"(SP));
#else
            float ps = 0.f; const float msh = mrun[bk] - 6.0f;
#pragma unroll
            for (int r = 0; r < 16; ++r) { p0[r] = __builtin_amdgcn_exp2f(p0[r] - msh); p1[r] = __builtin_amdgcn_exp2f(p1[r] - msh); ps += p0[r] + p1[r]; }
            lrun[bk] += ps;
            i32x8a pf;
            pf[0] = (int)pk4_fp8(p0[0], p0[1], p0[2], p0[3]); pf[1] = (int)pk4_fp8(p0[4], p0[5], p0[6], p0[7]); pf[2] = (int)pk4_fp8(p0[8], p0[9], p0[10], p0[11]); pf[3] = (int)pk4_fp8(p0[12], p0[13], p0[14], p0[15]);
            pf[4] = (int)pk4_fp8(p1[0], p1[1], p1[2], p1[3]); pf[5] = (int)pk4_fp8(p1[4], p1[5], p1[6], p1[7]); pf[6] = (int)pk4_fp8(p1[8], p1[9], p1[10], p1[11]); pf[7] = (int)pk4_fp8(p1[12], p1[13], p1[14], p1[15]);
            asm volatile("" : "+v"(pf));
#if ATT_DEFER
            if (bk == 0) { pf_prev = pf; have_prev = true; } else
#endif
            {
#pragma unroll
            for (int db = 0; db < 4; ++db) { const i32x4a a = *(const LAS i32x4a*)(vs_ + db * 512), b = *(const LAS i32x4a*)(vs_ + db * 512 + 2048);
                const i32x8a vfd = __builtin_shufflevector(a, b, 0, 1, 2, 3, 4, 5, 6, 7);
                asm volatile("v_mfma_scale_f32_32x32x64_f8f6f4 %0, %1, %2, %0, %3, %4 op_sel_hi:[0,0,0]" : "+v"(o[bk][db]) : "v"(vfd), "v"(pf), "v"(S1), "v"(SP)); }
            }
#endif
#endif
        }
    }
    asm volatile("s_nop 15\n s_nop 15" ::: "memory");
#pragma unroll
    for (int bk = 0; bk < 2; ++bk) {
        const float lt = ATT_PERMLANE ? xhalf_sum(lrun[bk]) : lrun[bk] + __shfl_xor(lrun[bk], 32);
        const float il = 64.0f * ATT_OS / lt;
#if ATT_OWIDE
        unsigned ooff_ = (unsigned)(r32 * opitch + 16 * hi); asm volatile("" : "+v"(ooff_));
        GAS unsigned char* op = (GAS unsigned char*)Ow + (size_t)(128 * bk) * opitch + ooff_;
#pragma unroll
        for (int db = 0; db < 4; ++db) {
            unsigned w[4];
#pragma unroll
            for (int rg = 0; rg < 4; ++rg) w[rg] = pk4_fp8(o[bk][db][4 * rg] * il, o[bk][db][4 * rg + 1] * il, o[bk][db][4 * rg + 2] * il, o[bk][db][4 * rg + 3] * il);
            const auto s02 = __builtin_amdgcn_permlane32_swap(w[0], w[2], false, false);
            const auto s13 = __builtin_amdgcn_permlane32_swap(w[1], w[3], false, false);
            v4u ov; ov.x = s02[0]; ov.y = s02[1]; ov.z = s13[0]; ov.w = s13[1];
            *(GAS v4u*)(op + 32 * db) = ov;
            __builtin_amdgcn_sched_barrier(0);
        }
    }
#else
        GAS unsigned char* op = (GAS unsigned char*)Ow + (size_t)(128 * bk + r32) * opitch + 4 * hi;
#pragma unroll
        for (int db = 0; db < 4; ++db)
#pragma unroll
            for (int rg = 0; rg < 4; ++rg) *(GAS unsigned*)(op + 32 * db + 8 * rg) = pk4_fp8(o[bk][db][4 * rg] * il, o[bk][db][4 * rg + 1] * il, o[bk][db][4 * rg + 2] * il, o[bk][db][4 * rg + 3] * il);
    }
#endif
    asm volatile("s_waitcnt vmcnt(0) lgkmcnt(0)" ::: "memory");
    att_bar4(bctr, nbar, lane);
#undef A2_ISSUE
#undef A2_PIECE
#undef A2_SPREAD
}
struct Frame {
    LAS unsigned char* lds;
    volatile LAS unsigned* MISC;
    gu32* ctl;
    int tid, lane, wave, vcu, G;
    unsigned char* ws;
};
#define WSP(T_, off) ((T_*)(F.ws + (off)))

template <int PART>
__device__ __forceinline__ void p0_prologue(Frame& F, const float* const* in, const int rank = 0, const int nrank = 0) {
    LAS float* scr = (LAS float*)(F.lds + RING_OFF + F.wave * 16640);
    const int gw = (PART == 1 ? rank : F.vcu) * NWAVES + F.wave, NGW = (PART == 1 ? nrank : F.G) * NWAVES, lane = F.lane;
    constexpr int I0 = 32 * 65, I1 = 32 * 96, I2 = 32 * 16, I3 = 32 * 16, I4 = 8 * 48, I5 = 8 * 64, I6 = 16 * 32, I7 = 32 * 32, I8 = 16 * 32, I9 = 32 * 32;
    constexpr int NITEMS = I0 + I1 + I2 + I3 + I4 + I5 + I6 + I7 + I8 + I9;
    bf16* W1T = WSP(bf16, WS_W1T);
    constexpr int NIT_A = I0 + I1 + I2 + I3;
    constexpr int NIT_B = (PRO_SPLIT == 2) ? NIT_A + I4 + I5 : NITEMS;
    const int it_lo = (PART == 1) ? NIT_A : 0, it_hi = (PART == 1) ? NIT_B : NITEMS;
    for (int it = it_lo + gw; it < it_hi; it += NGW) {
        if (PART == 0 && PRO_SPLIT && it >= NIT_A && it < NIT_B) continue;
        int r = it;
        if (r < I0) { const int kb = r / 65, cb = r % 65, c = 64 * cb;
            const int r0 = c < 3072 ? c : (c < 3136 ? 4096 + (c - 3072) : 3072 + (c - 3136));
            if (GATE_F8 && (UV_F8 == 1 || r0 >= (UV_F8 == 2 ? 1024 : 2048))) transpose_item64_f8(in[4], 4160, 64 * kb, c, WSP(unsigned char, WS_WG8U), 2048, r0, scr, lane, MOE_WSCALE);
            else transpose_item64(in[4], 4160, 64 * kb, c, W1T, HPITCH, r0, scr, lane);
            continue; } r -= I0;
        if (r < I1) { const int kb = r / 96, cb = r % 96;
            if (GATE_F8) transpose_item64_f8(in[5], 6144, 64 * kb, 64 * cb, WSP(unsigned char, WS_WG8), 2048, 9 * 256 + 64 * cb, scr, lane, MOE_WSCALE);
            else transpose_item64(in[5], 6144, 64 * kb, 64 * cb, W1T, HPITCH, P1_G + 64 * cb, scr, lane);
            continue; } r -= I1;
        if (r < I2) { const int kb = r / 16, cb = r % 16;
            if (GATE_F8) transpose_item64_f8(in[20], 1024, 64 * kb, 64 * cb, WSP(unsigned char, WS_WG8), 2048, 33 * 256 + 64 * cb, scr, lane, MOE_WSCALE);
            else transpose_item64(in[20], 1024, 64 * kb, 64 * cb, W1T, HPITCH, P1N + 64 * cb, scr, lane);
            continue; } r -= I2;
        if (r < I3) { const int kb = r / 16, cb = r % 16;
            if (GATE_F8) transpose_item64_f8(in[21], 1024, 64 * kb, 64 * cb, WSP(unsigned char, WS_WG8), 2048, 33 * 256 + 1024 + 64 * cb, scr, lane, MOE_WSCALE);
            else transpose_item64(in[21], 1024, 64 * kb, 64 * cb, W1T, HPITCH, P1N + 1024 + 64 * cb, scr, lane);
            continue; } r -= I3;
        if (r < I4) { const int kb = r / 48, cb = r % 48, hh = cb / 3, part = cb % 3;
            if (part < 2) transpose_item64_f8(in[13], 3072, 64 * kb, 64 * cb, WSP(unsigned char, WS_WUQT), 512, 256 * hh + 64 * part, scr, lane, UP_WSCALE);
            else transpose_item64_f8<true>(in[13], 3072, 64 * kb, 64 * cb, WSP(unsigned char, WS_WUQT), 512, 256 * hh + 128, scr, lane, UP_WSCALE);
            continue; } r -= I4;
        if (r < I5) { const int kb = r / 64, cb = r % 64; transpose_item64_f8(in[15], 4096, 64 * kb, 64 * cb, WSP(unsigned char, WS_WUKVT), 512, 64 * cb, scr, lane, UP_WSCALE); continue; } r -= I5;
        if (r < I6) { const int kb = r / 32, cb = r % 32; transpose_item64(in[11], 2048, 64 * kb, 64 * cb, WSP(bf16, WS_WPT), ABC_LD, 64 * cb, scr, lane, 0); continue; } r -= I6;
        if (r < I7) { const int kb = r / 32, cb = r % 32; transpose_item64_f8(in[18], 2048, 64 * kb, 64 * cb, WSP(unsigned char, WS_WPT) + ABC_BB, ABC_ROWB, 64 * cb, scr, lane, MOE_WSCALE); continue; } r -= I7;
        if (r < I8) { const int kb = r / 32, cb = r % 32; transpose_item64_f8(in[24], 2048, 64 * kb, 64 * cb, WSP(unsigned char, WS_WPT) + ABC_CB, ABC_ROWB, 64 * cb, scr, lane, MOE_WSCALE); continue; } r -= I8;
        { const int kb = r / 32, cb = r % 32; transpose_item64(in[25], 2048, 64 * kb, 64 * cb, WSP(bf16, WS_WOT), 2048, 64 * cb, scr, lane); }
    }
    if (PART == 1) return;
    const int gt = gw * 64 + lane, NGT = NGW * 64;
    for (int i = gt; i < 192 * 2048 / 8; i += NGT) { const int rr = i / 256, cc = i % 256; *(GAS v4u*)(W1T + (size_t)(4160 + rr) * HPITCH + (size_t)cc * 8) = (v4u){0u, 0u, 0u, 0u}; }
    if (GATE_F8) for (int i = gt; i < 192 * 2048 / 16; i += NGT) *(GAS v4u*)(WSP(unsigned char, WS_WG8) + (size_t)(2048 + 64) * 2048 + (size_t)i * 16) = (v4u){0u, 0u, 0u, 0u};
    for (int i = gt; i < 16 * 64 * 512 / 16; i += NGT) { const int hh = i / (64 * 512 / 16), q = i % (64 * 512 / 16); *(GAS v4u*)(WSP(unsigned char, WS_WUQT) + (size_t)(256 * hh + 192) * 512 + (size_t)q * 16) = (v4u){0u, 0u, 0u, 0u}; }
    { const float* wsrc = in[9]; bf16* wsm = WSP(bf16, WS_WSM);
      for (int i = gt; i < 8 * 128 * 128; i += NGT) { const int t = (i >> 7) & 127, s = i & 127; const float v = (s <= t) ? wsrc[i] : 0.f; wsm[i] = (bf16)(cvtpk(v, 0.f) & 0xffffu); } }
    { const float* rw = in[27]; const float* g2 = in[26]; float* rwg = WSP(float, WS_RWG);
#if ROUTER_BF16X2
      { bf16* wh = (bf16*)rwg; bf16* wl = wh + 32 * 2048;
        for (int i = gt; i < 2048 * 32; i += NGT) { const int k = i >> 5, ex = i & 31; const float w = rw[i] * g2[k];
            const unsigned h = cvtpk(w, 0.f) & 0xffffu; const float r = w - __uint_as_float(h << 16);
            wh[ex * 2048 + k] = (bf16)h; wl[ex * 2048 + k] = (bf16)(cvtpk(r, 0.f) & 0xffffu); } }
      (void)rwg; }
#else
      for (int i = gt; i < 2048 * 32; i += NGT) rwg[i] = rw[i] * g2[i >> 5]; }
#endif
    bf16* H = WSP(bf16, WS_H);
    for (int m = gw; m < T + MEMROWS; m += NGW) {
        if (m < T) rms_row_to_bf16(in[0] + (size_t)m * 2048, in[3], H + (size_t)m * HPITCH, lane, WSP(unsigned char, WS_H8) + (size_t)m * 2048);
        else rms_row_to_bf16(in[1] + (size_t)(m - T) * 2048, in[19], H + (size_t)m * HPITCH, lane, WSP(unsigned char, WS_H8) + (size_t)m * 2048);
    }
}

struct MoeItem { const float* src; size_t ldw; unsigned char* dst; int r0; int k0; };
__device__ __forceinline__ MoeItem moe_item(Frame& F, const float* const* in, int it) {
    constexpr int I10 = NE * 32 * 64;
    MoeItem m;
    if (it < I10) { const int e = it / 2048, q = it % 2048, kb = q / 64, cb = q % 64;
        m.r0 = cb < 32 ? 256 * (cb >> 1) + 64 * (cb & 1) : 256 * ((cb - 32) >> 1) + 128 + 64 * (cb & 1);
        m.src = in[29] + (size_t)e * 2048 * 4096 + (size_t)(64 * kb) * 4096 + 64 * cb; m.ldw = 4096; m.dst = WSP(unsigned char, WS_WGUT) + (size_t)e * 4096 * 2048; m.k0 = 64 * kb; }
    else { const int r = it - I10, e = r / 1024, q = r % 1024, kb = q / 32, cb = q % 32;
        m.r0 = 64 * cb; m.src = in[31] + (size_t)e * 2048 * 2048 + (size_t)(64 * kb) * 2048 + 64 * cb; m.ldw = 2048; m.dst = WSP(unsigned char, WS_WDT) + (size_t)e * 2048 * 2048; m.k0 = 64 * kb; }
    return m;
}
#define MOE_LOADS(v_, m_) do { const GAS float* src_ = (const GAS float*)(m_).src + (size_t)(4 * (lane >> 4)) * (m_).ldw + (lane & 15) * 4; \
        _Pragma("unroll") for (int j_ = 0; j_ < 4; ++j_) _Pragma("unroll") for (int r_ = 0; r_ < 4; ++r_) v_[4 * j_ + r_] = __builtin_nontemporal_load((const GAS f32x4*)(src_ + (size_t)(16 * j_ + r_) * (m_).ldw)); } while (0)
#define MOE_TOLDS(v_) do { LAS unsigned* s_ = scr + (4 * (lane & 15)) * 17 + (lane >> 4); \
        _Pragma("unroll") for (int j_ = 0; j_ < 4; ++j_) { \
            s_[0 * 17 + 4 * j_] = pk4_fp8(v_[4 * j_][0] * MOE_WSCALE, v_[4 * j_ + 1][0] * MOE_WSCALE, v_[4 * j_ + 2][0] * MOE_WSCALE, v_[4 * j_ + 3][0] * MOE_WSCALE); \
            s_[1 * 17 + 4 * j_] = pk4_fp8(v_[4 * j_][1] * MOE_WSCALE, v_[4 * j_ + 1][1] * MOE_WSCALE, v_[4 * j_ + 2][1] * MOE_WSCALE, v_[4 * j_ + 3][1] * MOE_WSCALE); \
            s_[2 * 17 + 4 * j_] = pk4_fp8(v_[4 * j_][2] * MOE_WSCALE, v_[4 * j_ + 1][2] * MOE_WSCALE, v_[4 * j_ + 2][2] * MOE_WSCALE, v_[4 * j_ + 3][2] * MOE_WSCALE); \
            s_[3 * 17 + 4 * j_] = pk4_fp8(v_[4 * j_][3] * MOE_WSCALE, v_[4 * j_ + 1][3] * MOE_WSCALE, v_[4 * j_ + 2][3] * MOE_WSCALE, v_[4 * j_ + 3][3] * MOE_WSCALE); } } while (0)
#define MOE_EMIT(m_) do { LDS_WAIT(); asm volatile("" ::: "memory"); \
        _Pragma("unroll") for (int jj_ = 0; jj_ < 4; ++jj_) { const int n_ = (lane >> 2) + 16 * jj_; const LAS unsigned* s_ = scr + n_ * 17 + 4 * (lane & 3); \
            v4u o_; o_.x = s_[0]; o_.y = s_[1]; o_.z = s_[2]; o_.w = s_[3]; \
            __builtin_nontemporal_store(o_, (GAS v4u*)((m_).dst + (size_t)((m_).r0 + n_) * 2048 + (m_).k0 + 16 * (lane & 3))); } \
        LDS_WAIT(); asm volatile("" ::: "memory"); } while (0)
template <int MODE>
__device__ __forceinline__ void moe_convert_share(Frame& F, const float* const* in) {
    LAS unsigned* scr = (LAS unsigned*)(F.lds + RING_OFF + F.wave * 4608);
    constexpr int NIT = NE * 32 * 64 + NE * 32 * 32;
    const int per = (NIT + F.G - 1) / F.G, lo = F.vcu * per, hi = (lo + per < NIT) ? lo + per : NIT, lane = F.lane;
    int it = lo + F.wave;
    f32x4 va[16], vb[16];
    MoeItem ma = moe_item(F, in, it < hi ? it : lo), mb = moe_item(F, in, it + NWAVES < hi ? it + NWAVES : lo);
    if (it < hi) MOE_LOADS(va, ma);
    if (it + NWAVES < hi) MOE_LOADS(vb, mb);
    for (; it < hi; it += 2 * NWAVES) {
        if (MODE == 0) MOE_TOLDS(va); else { _Pragma("unroll") for (int i_ = 0; i_ < 16; ++i_) asm volatile("" :: "v"(va[i_])); }
        const MoeItem na = moe_item(F, in, it + 2 * NWAVES < hi ? it + 2 * NWAVES : lo);
        if (it + 2 * NWAVES < hi) MOE_LOADS(va, na);
        if (MODE == 0) MOE_EMIT(ma);
        if (it + NWAVES < hi) {
            if (MODE == 0) MOE_TOLDS(vb); else { _Pragma("unroll") for (int i_ = 0; i_ < 16; ++i_) asm volatile("" :: "v"(vb[i_])); }
            const MoeItem nb = moe_item(F, in, it + 3 * NWAVES < hi ? it + 3 * NWAVES : lo);
            if (it + 3 * NWAVES < hi) MOE_LOADS(vb, nb);
            if (MODE == 0) MOE_EMIT(mb);
            mb = nb;
        }
        ma = na;
    }
    __syncthreads();
}
#define MOE_LOADS_ASM(v_, m_) do { const GAS float* src_ = (const GAS float*)(m_).src + (size_t)(4 * (lane >> 4)) * (m_).ldw + (lane & 15) * 4; \
        _Pragma("unroll") for (int j_ = 0; j_ < 4; ++j_) _Pragma("unroll") for (int r_ = 0; r_ < 4; ++r_) { const GAS float* p_ = src_ + (size_t)(16 * j_ + r_) * (m_).ldw; \
            asm volatile("global_load_dwordx4 %0, %1, off nt" : "=v"(v_[4 * j_ + r_]) : "v"(p_) : "memory"); } } while (0)
#define MOE_WAIT_ASM(v_, n_) asm volatile("s_waitcnt vmcnt(" #n_ ")" : "+v"(v_[0]), "+v"(v_[1]), "+v"(v_[2]), "+v"(v_[3]), "+v"(v_[4]), "+v"(v_[5]), "+v"(v_[6]), "+v"(v_[7]), \
        "+v"(v_[8]), "+v"(v_[9]), "+v"(v_[10]), "+v"(v_[11]), "+v"(v_[12]), "+v"(v_[13]), "+v"(v_[14]), "+v"(v_[15]) :: "memory")
__device__ __forceinline__ MoeItem moe_super(Frame& F, const float* const* in, int s) {
    constexpr int S10 = NE * 16 * 64;
    MoeItem m;
    if (s < S10) { const int e = s / 1024, q = s % 1024, kb = q / 64, cb = q % 64;
        m.r0 = cb < 32 ? 256 * (cb >> 1) + 64 * (cb & 1) : 256 * ((cb - 32) >> 1) + 128 + 64 * (cb & 1);
        m.src = in[29] + (size_t)e * 2048 * 4096 + (size_t)(128 * kb) * 4096 + 64 * cb; m.ldw = 4096; m.dst = WSP(unsigned char, WS_WGUT) + (size_t)e * 4096 * 2048; m.k0 = 128 * kb; }
    else { const int r = s - S10, e = r / 512, q = r % 512, kb = q / 32, cb = q % 32;
        m.r0 = 64 * cb; m.src = in[31] + (size_t)e * 2048 * 2048 + (size_t)(128 * kb) * 2048 + 64 * cb; m.ldw = 2048; m.dst = WSP(unsigned char, WS_WDT) + (size_t)e * 2048 * 2048; m.k0 = 128 * kb; }
    return m;
}
#define MOE_TOLDS33(v_, h_) do { LAS unsigned* s_ = scr + (4 * (lane & 15)) * 33 + (lane >> 4) + 16 * (h_); \
        _Pragma("unroll") for (int j_ = 0; j_ < 4; ++j_) { \
            s_[0 * 33 + 4 * j_] = pk4_fp8(v_[4 * j_][0] * MOE_WSCALE, v_[4 * j_ + 1][0] * MOE_WSCALE, v_[4 * j_ + 2][0] * MOE_WSCALE, v_[4 * j_ + 3][0] * MOE_WSCALE); \
            s_[1 * 33 + 4 * j_] = pk4_fp8(v_[4 * j_][1] * MOE_WSCALE, v_[4 * j_ + 1][1] * MOE_WSCALE, v_[4 * j_ + 2][1] * MOE_WSCALE, v_[4 * j_ + 3][1] * MOE_WSCALE); \
            s_[2 * 33 + 4 * j_] = pk4_fp8(v_[4 * j_][2] * MOE_WSCALE, v_[4 * j_ + 1][2] * MOE_WSCALE, v_[4 * j_ + 2][2] * MOE_WSCALE, v_[4 * j_ + 3][2] * MOE_WSCALE); \
            s_[3 * 33 + 4 * j_] = pk4_fp8(v_[4 * j_][3] * MOE_WSCALE, v_[4 * j_ + 1][3] * MOE_WSCALE, v_[4 * j_ + 2][3] * MOE_WSCALE, v_[4 * j_ + 3][3] * MOE_WSCALE); } } while (0)
#define MOE_EMIT33(m_) do { LDS_WAIT(); asm volatile("" ::: "memory"); \
        _Pragma("unroll") for (int jj_ = 0; jj_ < 8; ++jj_) { const int n_ = (lane >> 3) + 8 * jj_; const LAS unsigned* s_ = scr + n_ * 33 + 4 * (lane & 7); \
            v4u o_; o_.x = s_[0]; o_.y = s_[1]; o_.z = s_[2]; o_.w = s_[3]; \
            __builtin_nontemporal_store(o_, (GAS v4u*)((m_).dst + (size_t)((m_).r0 + n_) * 2048 + (m_).k0 + 16 * (lane & 7))); } \
        LDS_WAIT(); asm volatile("" ::: "memory"); } while (0)
template <int NW>
__device__ __forceinline__ void moe_convert_share_w(Frame& F, const float* const* in, const int cw, LAS unsigned* scr, const int lane) {
    constexpr int NSUP = NE * 16 * 64 + NE * 16 * 32, PER = NSUP / 256;
    static_assert(PER % NW == 0, "equal shares");
    const int lo = F.vcu * PER, hi = lo + PER;
    int it = lo + cw;
    f32x4 va[16], vb[16];
    MoeItem m = moe_super(F, in, it), mh = m;
    mh.src += (size_t)64 * m.ldw;
    MOE_LOADS_ASM(va, m);
    MOE_LOADS_ASM(vb, mh);
    bool first = true;
    for (; it < hi; it += NW) {
        MoeItem n = moe_super(F, in, it + NW < hi ? it + NW : lo), nh = n;
        nh.src += (size_t)64 * n.ldw;
        MOE_WAIT_ASM(va, 16);
        MOE_TOLDS33(va, 0);
        MOE_LOADS_ASM(va, n);
        MOE_WAIT_ASM(vb, 16);
        MOE_TOLDS33(vb, 1);
        MOE_LOADS_ASM(vb, nh);
        MOE_EMIT33(m);
        m = n; first = false;
    }
    MOE_WAIT_ASM(va, 0); MOE_WAIT_ASM(vb, 0);
}
#undef MOE_TOLDS33
#undef MOE_EMIT33
__device__ __forceinline__ MoeItem moe_super256(Frame& F, const float* const* in, int s) {
    constexpr int S10 = NE * 8 * 64;
    MoeItem m;
    if (s < S10) { const int e = s / 512, q = s % 512, kb = q / 64, cb = q % 64;
        m.r0 = cb < 32 ? 256 * (cb >> 1) + 64 * (cb & 1) : 256 * ((cb - 32) >> 1) + 128 + 64 * (cb & 1);
        m.src = in[29] + (size_t)e * 2048 * 4096 + (size_t)(256 * kb) * 4096 + 64 * cb; m.ldw = 4096; m.dst = WSP(unsigned char, WS_WGUT) + (size_t)e * 4096 * 2048; m.k0 = 256 * kb; }
    else { const int r = s - S10, e = r / 256, q = r % 256, kb = q / 32, cb = q % 32;
        m.r0 = 64 * cb; m.src = in[31] + (size_t)e * 2048 * 2048 + (size_t)(256 * kb) * 2048 + 64 * cb; m.ldw = 2048; m.dst = WSP(unsigned char, WS_WDT) + (size_t)e * 2048 * 2048; m.k0 = 256 * kb; }
    return m;
}
#define MOE_TOLDS65(v_, h_) do { LAS unsigned* s_ = scr + (4 * (lane & 15)) * 65 + (lane >> 4) + 16 * (h_); \
        _Pragma("unroll") for (int j_ = 0; j_ < 4; ++j_) { \
            s_[0 * 65 + 4 * j_] = pk4_fp8(v_[4 * j_][0] * MOE_WSCALE, v_[4 * j_ + 1][0] * MOE_WSCALE, v_[4 * j_ + 2][0] * MOE_WSCALE, v_[4 * j_ + 3][0] * MOE_WSCALE); \
            s_[1 * 65 + 4 * j_] = pk4_fp8(v_[4 * j_][1] * MOE_WSCALE, v_[4 * j_ + 1][1] * MOE_WSCALE, v_[4 * j_ + 2][1] * MOE_WSCALE, v_[4 * j_ + 3][1] * MOE_WSCALE); \
            s_[2 * 65 + 4 * j_] = pk4_fp8(v_[4 * j_][2] * MOE_WSCALE, v_[4 * j_ + 1][2] * MOE_WSCALE, v_[4 * j_ + 2][2] * MOE_WSCALE, v_[4 * j_ + 3][2] * MOE_WSCALE); \
            s_[3 * 65 + 4 * j_] = pk4_fp8(v_[4 * j_][3] * MOE_WSCALE, v_[4 * j_ + 1][3] * MOE_WSCALE, v_[4 * j_ + 2][3] * MOE_WSCALE, v_[4 * j_ + 3][3] * MOE_WSCALE); } } while (0)
#define MOE_EMIT65(m_) do { LDS_WAIT(); asm volatile("" ::: "memory"); \
        _Pragma("unroll") for (int jj_ = 0; jj_ < 16; ++jj_) { const int n_ = (lane >> 4) + 4 * jj_; const LAS unsigned* s_ = scr + n_ * 65 + 4 * (lane & 15); \
            v4u o_; o_.x = s_[0]; o_.y = s_[1]; o_.z = s_[2]; o_.w = s_[3]; \
            __builtin_nontemporal_store(o_, (GAS v4u*)((m_).dst + (size_t)((m_).r0 + n_) * 2048 + (m_).k0 + 16 * (lane & 15))); } \
        LDS_WAIT(); asm volatile("" ::: "memory"); } while (0)
#define MOE_Q(m_, q_) MoeItem{(m_).src + (size_t)(64 * (q_)) * (m_).ldw, (m_).ldw, (m_).dst, (m_).r0, (m_).k0}
template <int NW>
__device__ __forceinline__ void moe_convert_range256(Frame& F, const float* const* in, const int cw, LAS unsigned* scr, const int lane, const int lo, const int hi) {
    int it = lo + cw;
    f32x4 va[16], vb[16];
    MoeItem m = moe_super256(F, in, it);
    { const MoeItem q0 = MOE_Q(m, 0), q1 = MOE_Q(m, 1); MOE_LOADS_ASM(va, q0); MOE_LOADS_ASM(vb, q1); }
    bool first = true;
    for (; it < hi; it += NW) {
        const MoeItem n = moe_super256(F, in, it + NW < hi ? it + NW : lo);
        const MoeItem q2 = MOE_Q(m, 2), q3 = MOE_Q(m, 3), n0 = MOE_Q(n, 0), n1 = MOE_Q(n, 1);
        MOE_WAIT_ASM(va, 16);
        MOE_TOLDS65(va, 0); MOE_LOADS_ASM(va, q2);
        MOE_WAIT_ASM(vb, 16);
        MOE_TOLDS65(vb, 1); MOE_LOADS_ASM(vb, q3);
        MOE_WAIT_ASM(va, 16);
        MOE_TOLDS65(va, 2); MOE_LOADS_ASM(va, n0);
        MOE_WAIT_ASM(vb, 16);
        MOE_TOLDS65(vb, 3); MOE_LOADS_ASM(vb, n1);
        MOE_EMIT65(m);
        if (CONV_SLEEP > 0) __builtin_amdgcn_s_sleep(CONV_SLEEP);
        m = n; first = false;
    }
    MOE_WAIT_ASM(va, 0); MOE_WAIT_ASM(vb, 0);
}
constexpr int CONV_NSUP = NE * 8 * 64 + NE * 8 * 32, CONV_OFF_CUS = (CONV_OFFLOAD == 2) ? 160 : 128, CONV_OFF = CONV_OFFLOAD ? 8 * CONV_OFF_CUS : 0, CONV_PER5 = (CONV_NSUP - CONV_OFF) / 256;
static_assert((CONV_NSUP - CONV_OFF) % 256 == 0, "equal shares per workgroup");
template <int NW>
__device__ __forceinline__ void moe_convert_share_w256(Frame& F, const float* const* in, const int cw, LAS unsigned* scr, const int lane) {
    moe_convert_range256<NW>(F, in, cw, scr, lane, F.vcu * CONV_PER5, F.vcu * CONV_PER5 + CONV_PER5);
}
#undef MOE_TOLDS65
#undef MOE_EMIT65
#undef MOE_Q
#undef MOE_LOADS_ASM
#undef MOE_WAIT_ASM
#undef MOE_LOADS
#undef MOE_TOLDS
#undef MOE_EMIT

__device__ __forceinline__ void moe_convert_share_dma(Frame& F, const float* const* in) {
    LAS unsigned char* wbase = F.lds + RING_OFF + F.wave * 16640;
    LAS unsigned* tile2 = (LAS unsigned*)(wbase + 12288);
    constexpr int NIT = NE * 32 * 64 + NE * 32 * 32;
    const int per = (NIT + F.G - 1) / F.G, lo = F.vcu * per, hi = (lo + per < NIT) ? lo + per : NIT, lane = F.lane;
    const int nitems = (hi - lo - F.wave + NWAVES - 1) / NWAVES;
    if (nitems > 0) {
        const int nchunks = nitems * 4;
        const int ng = lane & 15, kr = lane >> 4;
#define CDMA_ISSUE(c_) do { const MoeItem m_ = moe_item(F, in, lo + F.wave + NWAVES * ((c_) >> 2)); const int kc_ = (c_) & 3; \
            const GAS unsigned char* g_ = (const GAS unsigned char*)m_.src + ((size_t)(16 * kc_ + kr) * m_.ldw + (size_t)ng * 4) * 4; LAS unsigned char* l_ = wbase + ((c_) % 3) * 4096; \
            _Pragma("unroll") for (int q_ = 0; q_ < 4; ++q_) __builtin_amdgcn_global_load_lds((const GAS unsigned*)(g_ + (size_t)(4 * q_) * m_.ldw * 4), (LAS unsigned*)(l_ + q_ * 1024), 16, 0, 2); } while (0)
        CDMA_ISSUE(0);
        if (nchunks > 1) CDMA_ISSUE(1);
        for (int c = 0; c < nchunks; ++c) {
            if (c + 2 < nchunks) { CDMA_ISSUE(c + 2); asm volatile("s_waitcnt vmcnt(8)" ::: "memory"); }
            else if (c + 1 < nchunks) asm volatile("s_waitcnt vmcnt(4)" ::: "memory");
            else asm volatile("s_waitcnt vmcnt(0)" ::: "memory");
            const LAS unsigned char* cb = wbase + (c % 3) * 4096 + (4 * kr) * 256 + ng * 16;
            const f32x4 r0 = *(const LAS f32x4*)(cb), r1 = *(const LAS f32x4*)(cb + 256), r2 = *(const LAS f32x4*)(cb + 512), r3 = *(const LAS f32x4*)(cb + 768);
            LAS unsigned* t2 = tile2 + (4 * ng) * 17 + 4 * (c & 3) + kr;
            t2[0 * 17] = pk4_fp8(r0[0] * MOE_WSCALE, r1[0] * MOE_WSCALE, r2[0] * MOE_WSCALE, r3[0] * MOE_WSCALE);
            t2[1 * 17] = pk4_fp8(r0[1] * MOE_WSCALE, r1[1] * MOE_WSCALE, r2[1] * MOE_WSCALE, r3[1] * MOE_WSCALE);
            t2[2 * 17] = pk4_fp8(r0[2] * MOE_WSCALE, r1[2] * MOE_WSCALE, r2[2] * MOE_WSCALE, r3[2] * MOE_WSCALE);
            t2[3 * 17] = pk4_fp8(r0[3] * MOE_WSCALE, r1[3] * MOE_WSCALE, r2[3] * MOE_WSCALE, r3[3] * MOE_WSCALE);
            LDS_WAIT(); asm volatile("" ::: "memory");
            if ((c & 3) == 3) {
                const MoeItem m = moe_item(F, in, lo + F.wave + NWAVES * (c >> 2));
#pragma unroll
                for (int jj = 0; jj < 4; ++jj) { const int n = (lane >> 2) + 16 * jj; const LAS unsigned* s = tile2 + n * 17 + 4 * (lane & 3);
                    v4u o; o.x = s[0]; o.y = s[1]; o.z = s[2]; o.w = s[3];
                    __builtin_nontemporal_store(o, (GAS v4u*)(m.dst + (size_t)(m.r0 + n) * 2048 + m.k0 + 16 * (lane & 3))); }
                LDS_WAIT(); asm volatile("" ::: "memory");
            }
        }
#undef CDMA_ISSUE
    }
    asm volatile("s_waitcnt vmcnt(0)" ::: "memory");
    __syncthreads();
}

struct MoeItem256 { const float* src; size_t ldw; unsigned char* dst; int rowbase; int rowmode; int k0; };
__device__ __forceinline__ MoeItem256 moe_item256(Frame& F, const float* const* in, int it) {
    constexpr int I10 = NE * 32 * 64;
    MoeItem256 m;
    if (it < I10) { const int e = it / 2048, q = it % 2048, kb = q / 16, cb = q % 16; const bool gate = cb < 8; const int grp0 = gate ? 2 * cb : 2 * (cb - 8);
        m.src = in[29] + (size_t)e * 2048 * 4096 + (size_t)(16 * kb) * 4096 + 256 * cb; m.ldw = 4096; m.dst = WSP(unsigned char, WS_WGUT) + (size_t)e * 4096 * 2048;
        m.rowbase = 256 * grp0 + (gate ? 0 : 128); m.rowmode = 1; m.k0 = 16 * kb; }
    else { const int r = it - I10, e = r / 1024, q = r % 1024, kb = q / 8, cb = q % 8;
        m.src = in[31] + (size_t)e * 2048 * 2048 + (size_t)(16 * kb) * 2048 + 256 * cb; m.ldw = 2048; m.dst = WSP(unsigned char, WS_WDT) + (size_t)e * 2048 * 2048;
        m.rowbase = 256 * cb; m.rowmode = 0; m.k0 = 16 * kb; }
    return m;
}
__device__ __forceinline__ void moe_convert_share_dma256(Frame& F, const float* const* in) {
    LAS unsigned char* wbase = F.lds + RING_OFF + F.wave * 16640;
    LAS unsigned* tile2 = (LAS unsigned*)(wbase + 12288);
    constexpr int NIT = NE * 32 * 64 + NE * 32 * 32;
    const int per = (NIT + F.G - 1) / F.G, lo = F.vcu * per, hi = (lo + per < NIT) ? lo + per : NIT, lane = F.lane;
    const int nitems = (hi - lo - F.wave + NWAVES - 1) / NWAVES;
    if (nitems > 0) {
        const int nchunks = nitems * 4;
#define C256_ISSUE(c_) do { const MoeItem256 m_ = moe_item256(F, in, lo + F.wave + NWAVES * ((c_) >> 2)); const int kc_ = (c_) & 3; \
            const GAS unsigned char* g_ = (const GAS unsigned char*)m_.src + ((size_t)(4 * kc_) * m_.ldw + (size_t)lane * 4) * 4; LAS unsigned char* l_ = wbase + ((c_) % 3) * 4096; \
            _Pragma("unroll") for (int r_ = 0; r_ < 4; ++r_) __builtin_amdgcn_global_load_lds((const GAS unsigned*)(g_ + (size_t)r_ * m_.ldw * 4), (LAS unsigned*)(l_ + r_ * 1024), 16, 0, 2); } while (0)
        C256_ISSUE(0);
        if (nchunks > 1) C256_ISSUE(1);
        for (int c = 0; c < nchunks; ++c) {
            if (c + 2 < nchunks) { C256_ISSUE(c + 2); asm volatile("s_waitcnt vmcnt(8)" ::: "memory"); }
            else if (c + 1 < nchunks) asm volatile("s_waitcnt vmcnt(4)" ::: "memory");
            else asm volatile("s_waitcnt vmcnt(0)" ::: "memory");
            const LAS float* cb = (const LAS float*)(wbase + (c % 3) * 4096) + lane;
            LAS unsigned* t2 = tile2 + (c & 3) * 256 + lane;
#pragma unroll
            for (int cc = 0; cc < 4; ++cc) t2[64 * cc] = pk4_fp8(cb[64 * cc] * MOE_WSCALE, cb[256 + 64 * cc] * MOE_WSCALE, cb[512 + 64 * cc] * MOE_WSCALE, cb[768 + 64 * cc] * MOE_WSCALE);
            LDS_WAIT(); asm volatile("" ::: "memory");
            if ((c & 3) == 3) {
                const MoeItem256 m = moe_item256(F, in, lo + F.wave + NWAVES * (c >> 2));
#pragma unroll
                for (int cc = 0; cc < 4; ++cc) { const LAS unsigned* s = tile2 + lane + 64 * cc;
                    v4u o; o.x = s[0]; o.y = s[256]; o.z = s[512]; o.w = s[768];
                    const int row = m.rowbase + (m.rowmode ? 256 * (cc >> 1) + lane + 64 * (cc & 1) : lane + 64 * cc);
                    __builtin_nontemporal_store(o, (GAS v4u*)(m.dst + (size_t)row * 2048 + m.k0)); }
                LDS_WAIT(); asm volatile("" ::: "memory");
            }
        }
#undef C256_ISSUE
    }
    asm volatile("s_waitcnt vmcnt(0)" ::: "memory");
    __syncthreads();
}

struct ConvState { int lo, nchunks, c, cw; };
template <int NCW>
__device__ __forceinline__ void conv_steps(Frame& F, const float* const* in, ConvState& S, LAS unsigned char* wbase, int nsteps, int lane) {
    LAS unsigned* tile2 = (LAS unsigned*)(wbase + 12288);
    const int ng = lane & 15, kr = lane >> 4;
#define CS_ISSUE(c_) do { const MoeItem m_ = moe_item(F, in, S.lo + S.cw + NCW * ((c_) >> 2)); const int kc_ = (c_) & 3; \
        const GAS unsigned char* g_ = (const GAS unsigned char*)m_.src + ((size_t)(16 * kc_ + kr) * m_.ldw + (size_t)ng * 4) * 4; LAS unsigned char* l_ = wbase + ((c_) % 3) * 4096; \
        _Pragma("unroll") for (int q_ = 0; q_ < 4; ++q_) __builtin_amdgcn_global_load_lds((const GAS unsigned*)(g_ + (size_t)(4 * q_) * m_.ldw * 4), (LAS unsigned*)(l_ + q_ * 1024), 16, 0, 2); } while (0)
    if (S.c < 0) { S.c = 0; if (S.nchunks > 0) CS_ISSUE(0); if (S.nchunks > 1) CS_ISSUE(1); }
    for (int st = 0; st < nsteps && S.c < S.nchunks; ++st) {
        const int c = S.c;
        if (c + 2 < S.nchunks) { CS_ISSUE(c + 2); asm volatile("s_waitcnt vmcnt(8)" ::: "memory"); }
        else if (c + 1 < S.nchunks) asm volatile("s_waitcnt vmcnt(4)" ::: "memory");
        else asm volatile("s_waitcnt vmcnt(0)" ::: "memory");
        const LAS unsigned char* cb = wbase + (c % 3) * 4096 + (4 * kr) * 256 + ng * 16;
        const f32x4 r0 = *(const LAS f32x4*)(cb), r1 = *(const LAS f32x4*)(cb + 256), r2 = *(const LAS f32x4*)(cb + 512), r3 = *(const LAS f32x4*)(cb + 768);
        LAS unsigned* t2 = tile2 + (4 * ng) * 17 + 4 * (c & 3) + kr;
        t2[0 * 17] = pk4_fp8(r0[0] * MOE_WSCALE, r1[0] * MOE_WSCALE, r2[0] * MOE_WSCALE, r3[0] * MOE_WSCALE);
        t2[1 * 17] = pk4_fp8(r0[1] * MOE_WSCALE, r1[1] * MOE_WSCALE, r2[1] * MOE_WSCALE, r3[1] * MOE_WSCALE);
        t2[2 * 17] = pk4_fp8(r0[2] * MOE_WSCALE, r1[2] * MOE_WSCALE, r2[2] * MOE_WSCALE, r3[2] * MOE_WSCALE);
        t2[3 * 17] = pk4_fp8(r0[3] * MOE_WSCALE, r1[3] * MOE_WSCALE, r2[3] * MOE_WSCALE, r3[3] * MOE_WSCALE);
        LDS_WAIT(); asm volatile("" ::: "memory");
        if ((c & 3) == 3) {
            const MoeItem m = moe_item(F, in, S.lo + S.cw + NCW * (c >> 2));
#pragma unroll
            for (int jj = 0; jj < 4; ++jj) { const int n = (lane >> 2) + 16 * jj; const LAS unsigned* s = tile2 + n * 17 + 4 * (lane & 3);
                v4u o; o.x = s[0]; o.y = s[1]; o.z = s[2]; o.w = s[3];
                __builtin_nontemporal_store(o, (GAS v4u*)(m.dst + (size_t)(m.r0 + n) * 2048 + m.k0 + 16 * (lane & 3))); }
            LDS_WAIT(); asm volatile("" ::: "memory");
        }
        S.c = c + 1;
    }
#undef CS_ISSUE
}

__device__ __forceinline__ float group16_sum(float v) { if (XL_FAST) return xl_sum16(v); v += __shfl_xor(v, 1); v += __shfl_xor(v, 2); v += __shfl_xor(v, 4); v += __shfl_xor(v, 8); return v; }
__device__ __forceinline__ void p2_token(Frame& F, const float* const* in, int t) {
    const int l = F.lane;
    const GAS bf16* row = (const GAS bf16*)WSP(bf16, WS_P1) + (size_t)t * P1N;
    { float a[8], b[8]; unpack8(*(const GAS v4u*)(row + P1_V + 16 * l), a); unpack8(*(const GAS v4u*)(row + P1_V + 16 * l + 8), b);
      float s = 0.f;
#pragma unroll
      for (int i = 0; i < 8; ++i) s += a[i] + b[i];
      const float mean = wave_sum(s) * (1.f / 1024.f); float q = 0.f;
#pragma unroll
      for (int i = 0; i < 8; ++i) { const float d0 = a[i] - mean, d1 = b[i] - mean; q += d0 * d0 + d1 * d1; }
      const float rstd = 1.0f * FAST_RSQ(wave_sum(q) * (1.f / 1024.f) + EPS);
      if (l == 0) { GAS float* vs = (GAS float*)WSP(float, WS_VSTAT) + (size_t)t * 2; vs[0] = mean; vs[1] = rstd; } }
#pragma unroll
    for (int w = 0; w < 2; ++w) {
        float a[8]; unpack8(*(const GAS v4u*)(row + (w ? P1_CKV : P1_CQ) + 8 * l), a);
        float s = 0.f;
#pragma unroll
        for (int i = 0; i < 8; ++i) s += a[i] * a[i];
        const float rs = 1.0f * FAST_RSQ(wave_sum(s) * (1.f / 512.f) + EPS);
        const GAS float* g = (const GAS float*)(w ? in[14] : in[12]) + 8 * l;
        const f32x4 g0 = *(const GAS f32x4*)g, g1 = *(const GAS f32x4*)(g + 4);
        float o[8] = {a[0] * rs * g0.x, a[1] * rs * g0.y, a[2] * rs * g0.z, a[3] * rs * g0.w, a[4] * rs * g1.x, a[5] * rs * g1.y, a[6] * rs * g1.z, a[7] * rs * g1.w};
        u32x2 w8; w8.x = pk4_fp8(o[0], o[1], o[2], o[3]); w8.y = pk4_fp8(o[4], o[5], o[6], o[7]);
        *(GAS u32x2*)((GAS unsigned char*)WSP(unsigned char, w ? WS_CKVN : WS_CQN) + (size_t)t * 512 + 8 * l) = w8;
    }
    { float a[8], b[8]; unpack8(*(const GAS v4u*)(row + P1_QM + 16 * l), a); unpack8(*(const GAS v4u*)(row + P1_QM + 16 * l + 8), b);
      float s = 0.f;
#pragma unroll
      for (int i = 0; i < 8; ++i) s += a[i] * a[i] + b[i] * b[i];
      const float rs = MEM_QSCALE * FAST_RSQ(group16_sum(s) * (1.f / 256.f) + EPS);
      const GAS float* g = (const GAS float*)in[22] + (l & 15) * 16;
      float ga[8], gb[8];
#pragma unroll
      for (int i = 0; i < 8; ++i) { ga[i] = g[i]; gb[i] = g[8 + i]; }
#pragma unroll
      for (int i = 0; i < 8; ++i) { a[i] *= rs * ga[i]; b[i] *= rs * gb[i]; }
      const int bb = t >> 12, tl = t & 4095, h = l >> 4;
      GAS bf16* dst = (GAS bf16*)WSP(bf16, WS_QMN) + ((size_t)((bb * 4 + h) * 4096 + tl)) * 256 + (l & 15) * 16;
      *(GAS v4u*)dst = packf8(a); *(GAS v4u*)(dst + 8) = packf8(b); }
    { float t1 = 0.f, t2 = 0.f;
      if (l < 32) { t1 = bflo((unsigned)row[P1_KR + l]); t2 = bflo((unsigned)row[P1_KR + 32 + l]); }
      const float ss = wave_sum(t1 * t1 + t2 * t2);
      if (l < 32) {
          const float pos = (float)((const GAS int*)in[2])[t];
          const float inv = 1.0f / powf(10000.0f, (float)(2 * l) / 64.0f);
          const float ang = pos * inv, c = cosf(ang), s = sinf(ang);
          GAS float* rp = (GAS float*)WSP(float, WS_ROPE) + (size_t)t * 64; rp[l] = c; rp[32 + l] = s;
          const GAS float* kg = (const GAS float*)in[17];
          const float a = t1 * kg[128 + l], b = t2 * kg[160 + l];
          GAS float* kr = (GAS float*)WSP(float, WS_KRR) + (size_t)t * 64; kr[l] = a * c - b * s; kr[32 + l] = a * s + b * c;
          if (l == 0) ((GAS float*)WSP(float, WS_KRSS))[t] = ss;
      } }
}
__device__ __forceinline__ void p2_memrow(Frame& F, const float* const* in, int m) {
    const int l = F.lane, bb = m >> 8, ml = m & 255, tile = ml >> 6, key = ml & 63, h = l >> 4, d0 = (l & 15) * 16;
    const GAS bf16* row = (const GAS bf16*)WSP(bf16, WS_MKV) + (size_t)m * 2048;
    { float a[8], b[8]; unpack8(*(const GAS v4u*)(row + 16 * l), a); unpack8(*(const GAS v4u*)(row + 16 * l + 8), b);
      float s = 0.f;
#pragma unroll
      for (int i = 0; i < 8; ++i) s += a[i] * a[i] + b[i] * b[i];
      const float rs = 1.0f * FAST_RSQ(group16_sum(s) * (1.f / 256.f) + EPS);
      const GAS float* g = (const GAS float*)in[23] + d0;
#pragma unroll
      for (int i = 0; i < 8; ++i) { a[i] *= rs * g[i]; b[i] *= rs * g[8 + i]; }
      GAS bf16* base = (GAS bf16*)WSP(bf16, WS_MKT) + (size_t)((bb * 4 + h) * 4 + tile) * (32 * 64 * 8);
      const int c0 = d0 >> 3;
      *(GAS v4u*)(base + ((size_t)c0 * 64 + key) * 8) = packf8(a); *(GAS v4u*)(base + ((size_t)(c0 + 1) * 64 + key) * 8) = packf8(b); }
    { const v4u a = *(const GAS v4u*)(row + 1024 + 16 * l), b = *(const GAS v4u*)(row + 1024 + 16 * l + 8);
      const int half = d0 >> 7, cb = (d0 & 127) >> 5, off = d0 & 31;
      GAS bf16* base = (GAS bf16*)WSP(bf16, WS_MVT) + (size_t)(((bb * 4 + h) * 2 + half) * 4 + tile) * (4 * 64 * 32);
      GAS bf16* dst = base + ((size_t)cb * 64 + key) * 32 + off;
      *(GAS v4u*)dst = a; *(GAS v4u*)(dst + 8) = b; }
}

__device__ __forceinline__ void gmlp_unit(Frame& F, const float* const* in, int u) {
    const int ci = u >> 3, g = u & 7, tok0 = ci * 128, tid = F.tid, l = F.lane, r32 = l & 31, hi = l >> 5;
    LAS bf16* VT = (LAS bf16*)(F.lds + RING_OFF);
    const GAS bf16* P1 = (const GAS bf16*)WSP(bf16, WS_P1);
    { const int s = tid >> 2, qd = tid & 3;
      const GAS float* vs = (const GAS float*)WSP(float, WS_VSTAT) + (size_t)(tok0 + s) * 2; const float mean = vs[0], rstd = vs[1];
      const GAS bf16* src = P1 + (size_t)(tok0 + s) * P1N + P1_V + g * 128 + qd * 32;
      const GAS float* lg = (const GAS float*)in[7] + g * 128 + qd * 32; const GAS float* lb = (const GAS float*)in[8] + g * 128 + qd * 32;
#pragma unroll
      for (int i = 0; i < 4; ++i) { float a[8]; unpack8(*(const GAS v4u*)(src + 8 * i), a);
#pragma unroll
          for (int k = 0; k < 8; ++k) { const int c = qd * 32 + 8 * i + k; const float v = (a[k] - mean) * rstd * lg[8 * i + k] + lb[8 * i + k]; VT[c * 136 + s] = (bf16)(cvtpk(v, 0.f) & 0xffffu); } } }
    __syncthreads();
    const int w = F.wave, tb = w >> 1, cbp = (w & 1) * 2;
    f32x16 acc[2];
#pragma unroll
    for (int r = 0; r < 16; ++r) { acc[0][r] = 0.f; acc[1][r] = 0.f; }
    const GAS bf16* wsm = (const GAS bf16*)WSP(bf16, WS_WSM) + ((size_t)(g * 128 + 32 * tb + r32)) * 128 + 8 * hi;
    for (int ks = 0; ks < 2 * (tb + 1); ++ks) {
        const bf16x8 af = *(const GAS bf16x8*)(wsm + 16 * ks);
#pragma unroll
        for (int cc = 0; cc < 2; ++cc) { const bf16x8 bfr = *(const LAS bf16x8*)(VT + (32 * (cbp + cc) + r32) * 136 + 16 * ks + 8 * hi);
            acc[cc] = __builtin_amdgcn_mfma_f32_32x32x16_bf16(af, bfr, acc[cc], 0, 0, 0); }
    }
    const GAS float* bs = (const GAS float*)in[10] + g * 128;
    GAS bf16* AO = (GAS bf16*)WSP(bf16, WS_ABC);
#pragma unroll
    for (int cc = 0; cc < 2; ++cc)
#pragma unroll
        for (int r = 0; r < 16; ++r) { const int t = 32 * tb + crow(r, hi), tok = tok0 + t, ch = g * 128 + 32 * (cbp + cc) + r32;
            const float uu = bflo((unsigned)P1[(size_t)tok * P1N + P1_U + ch]);
            AO[(size_t)tok * ABC_LD + ch] = (bf16)(cvtpk(uu * (acc[cc][r] + bs[t]), 0.f) & 0xffffu); }
    __syncthreads();
}

__device__ __forceinline__ void p4_token(Frame& F, const float* const* in, int t) {
    const int l = F.lane, bb = t >> 12, tl = t & 4095, tile = tl >> 6, key = tl & 63, h = l >> 2, sub = l & 3;
    const GAS float* rope = (const GAS float*)WSP(float, WS_ROPE) + (size_t)t * 64;
    { const GAS bf16* qr = (const GAS bf16*)WSP(bf16, WS_QRAW) + (size_t)t * 3072 + h * 192;
      float x[4][8], y[2][8];
#pragma unroll
      for (int i = 0; i < 4; ++i) unpack8(*(const GAS v4u*)(qr + sub * 32 + 8 * i), x[i]);
#pragma unroll
      for (int i = 0; i < 2; ++i) unpack8(*(const GAS v4u*)(qr + 128 + sub * 16 + 8 * i), y[i]);
      float s = 0.f;
#pragma unroll
      for (int i = 0; i < 4; ++i)
#pragma unroll
          for (int k = 0; k < 8; ++k) s += x[i][k] * x[i][k];
#pragma unroll
      for (int i = 0; i < 2; ++i)
#pragma unroll
          for (int k = 0; k < 8; ++k) s += y[i][k] * y[i][k];
      s += __shfl_xor(s, 1); s += __shfl_xor(s, 2);
      const float rs = 1.0f * FAST_RSQ(s * (1.f / 192.f) + EPS);
      const GAS float* qg = (const GAS float*)in[16];
      GAS bf16* dst = (GAS bf16*)WSP(bf16, WS_QF) + ((size_t)((bb * 16 + h) * 4096 + tl)) * 192;
#pragma unroll
      for (int i = 0; i < 4; ++i) {
#pragma unroll
          for (int k = 0; k < 8; ++k) x[i][k] *= rs * qg[sub * 32 + 8 * i + k] * MLA_QSCALE;
          *(GAS v4u*)(dst + sub * 32 + 8 * i) = packf8(x[i]); }
#pragma unroll
      for (int i = 0; i < 2; ++i) { float o[8];
#pragma unroll
          for (int k = 0; k < 8; ++k) { const float mine = y[i][k] * rs * qg[128 + sub * 16 + 8 * i + k]; const float other = __shfl_xor(mine, 2);
              const int j = (sub & 1) * 16 + 8 * i + k; const float c = rope[j], sn = rope[32 + j];
              o[k] = (sub < 2 ? mine * c - other * sn : other * sn + mine * c) * MLA_QSCALE; }
          *(GAS v4u*)(dst + 128 + sub * 16 + 8 * i) = packf8(o); } }
    { const GAS bf16* kr = (const GAS bf16*)WSP(bf16, WS_KVRAW) + (size_t)t * 4096 + h * 256;
      float x[4][8];
#pragma unroll
      for (int i = 0; i < 4; ++i) unpack8(*(const GAS v4u*)(kr + sub * 32 + 8 * i), x[i]);
      float s = 0.f;
#pragma unroll
      for (int i = 0; i < 4; ++i)
#pragma unroll
          for (int k = 0; k < 8; ++k) s += x[i][k] * x[i][k];
      s += __shfl_xor(s, 1); s += __shfl_xor(s, 2);
      s += ((const GAS float*)WSP(float, WS_KRSS))[t];
      const float rs = 1.0f * FAST_RSQ(s * (1.f / 192.f) + EPS);
      const GAS float* kg = (const GAS float*)in[17];
      GAS bf16* kbase = (GAS bf16*)WSP(bf16, WS_KFT) + (size_t)((bb * 16 + h) * 64 + tile) * (24 * 64 * 8);
#pragma unroll
      for (int i = 0; i < 4; ++i) {
#pragma unroll
          for (int k = 0; k < 8; ++k) x[i][k] *= rs * kg[sub * 32 + 8 * i + k];
          *(GAS v4u*)(kbase + ((size_t)(sub * 4 + i) * 64 + key) * 8) = packf8(x[i]); }
      const GAS float* krr = (const GAS float*)WSP(float, WS_KRR) + (size_t)t * 64 + sub * 16;
#pragma unroll
      for (int i = 0; i < 2; ++i) { float o[8];
#pragma unroll
          for (int k = 0; k < 8; ++k) o[k] = krr[8 * i + k] * rs;
          *(GAS v4u*)(kbase + ((size_t)(16 + 2 * sub + i) * 64 + key) * 8) = packf8(o); }
      GAS bf16* vdst = (GAS bf16*)WSP(bf16, WS_VFT) + (size_t)((bb * 16 + h) * 64 + tile) * (4 * 64 * 32) + ((size_t)sub * 64 + key) * 32;
#pragma unroll
      for (int i = 0; i < 4; ++i) *(GAS v4u*)(vdst + 8 * i) = *(const GAS v4u*)(kr + 128 + sub * 32 + 8 * i); }
}
__device__ __forceinline__ void p8_router(Frame& F, const float* const* in) {
    const int tid = F.tid, l = F.lane, r32 = l & 31, hi = l >> 5, w = F.wave, tk = w >> 2, kq = w & 3;
    LAS float* part = (LAS float*)(F.lds + RING_OFF);
    LAS float* ssp = part + 2 * 4 * 32 * 33;
    LAS int* lcnt = (LAS int*)(F.lds + LTAB_OFF) + 40;
    LAS int* gbase = lcnt + 32;
    const int tok0 = (blockIdx.x * 2 + tk) * 32;
    if (tid < 32) lcnt[tid] = 0;
#if ROUTER_BF16X2
    {   const GAS bf16* xr = (const GAS bf16*)WSP(bf16, WS_X1) + (size_t)(tok0 + r32) * 2048 + 8 * hi;
        const GAS bf16* wh = (const GAS bf16*)WSP(bf16, WS_RWG) + (size_t)r32 * 2048 + 8 * hi;
        f32x16 acc;
#pragma unroll
        for (int r = 0; r < 16; ++r) acc[r] = 0.f;
        float ss = 0.f;
#pragma unroll 4
        for (int it = 32 * kq; it < 32 * kq + 32; ++it) {
            const v4u aw = *(const GAS v4u*)(xr + 16 * it);
            const bf16x8 a = __builtin_bit_cast(bf16x8, aw);
            const bf16x8 bh = *(const GAS bf16x8*)(wh + 16 * it), bl = *(const GAS bf16x8*)(wh + 32 * 2048 + 16 * it);
            acc = __builtin_amdgcn_mfma_f32_32x32x16_bf16(a, bh, acc, 0, 0, 0);
            acc = __builtin_amdgcn_mfma_f32_32x32x16_bf16(a, bl, acc, 0, 0, 0);
            float fa[8]; unpack8(aw, fa);
            ss += ((fa[0] * fa[0] + fa[1] * fa[1]) + (fa[2] * fa[2] + fa[3] * fa[3])) + ((fa[4] * fa[4] + fa[5] * fa[5]) + (fa[6] * fa[6] + fa[7] * fa[7]));
        }
#else
    {   const GAS bf16* xr = (const GAS bf16*)WSP(bf16, WS_X1) + (size_t)(tok0 + r32) * 2048 + 4 * hi;
        const GAS float* rw = (const GAS float*)WSP(float, WS_RWG) + (size_t)(4 * hi) * 32 + r32;
        f32x16 acc;
#pragma unroll
        for (int r = 0; r < 16; ++r) acc[r] = 0.f;
        float ss = 0.f;
#pragma unroll 4
        for (int q = 64 * kq; q < 64 * kq + 64; ++q) {
            const u32x2 aw = *(const GAS u32x2*)(xr + 8 * q); f32x4 a; a.x = bflo(aw.x); a.y = bfhi(aw.x); a.z = bflo(aw.y); a.w = bfhi(aw.y);
            const GAS float* rq = rw + (size_t)(8 * q) * 32;
            const float b0 = rq[0], b1 = rq[32], b2 = rq[64], b3 = rq[96];
            acc = __builtin_amdgcn_mfma_f32_32x32x2f32(a.x, b0, acc, 0, 0, 0);
            acc = __builtin_amdgcn_mfma_f32_32x32x2f32(a.y, b1, acc, 0, 0, 0);
            acc = __builtin_amdgcn_mfma_f32_32x32x2f32(a.z, b2, acc, 0, 0, 0);
            acc = __builtin_amdgcn_mfma_f32_32x32x2f32(a.w, b3, acc, 0, 0, 0);
            ss += (a.x * a.x + a.y * a.y) + (a.z * a.z + a.w * a.w);
        }
#endif
        LAS float* pp = part + (size_t)((tk * 4 + kq) * 32) * 33;
#pragma unroll
        for (int r = 0; r < 16; ++r) pp[crow(r, hi) * 33 + r32] = acc[r];
        ssp[(tk * 4 + kq) * 64 + l] = ss;
    }
    __syncthreads();
    const bool sel = (kq == 0) && (l < 32);
    float v0 = -INFINITY, v1 = -INFINITY, v2 = -INFINITY, v3 = -INFINITY; int i0 = 0, i1 = 0, i2 = 0, i3 = 0; int lr0 = 0, lr1 = 0, lr2 = 0, lr3 = 0;
    if (sel) {
        float ss = 0.f;
#pragma unroll
        for (int k = 0; k < 4; ++k) ss += ssp[(tk * 4 + k) * 64 + l] + ssp[(tk * 4 + k) * 64 + 32 + l];
        const float rs = 1.0f * FAST_RSQ(ss * (1.f / 2048.f) + EPS);
        const GAS float* rb = (const GAS float*)in[28];
        const LAS float* pp = part + (size_t)(tk * 4 * 32 + l) * 33;
#pragma unroll
        for (int e = 0; e < 32; ++e) {
            const float x = ((pp[e] + pp[32 * 33 + e]) + (pp[2 * 32 * 33 + e] + pp[3 * 32 * 33 + e])) * rs + rb[e];
            if (x > v3) {
                if (x > v0) { v3 = v2; i3 = i2; v2 = v1; i2 = i1; v1 = v0; i1 = i0; v0 = x; i0 = e; }
                else if (x > v1) { v3 = v2; i3 = i2; v2 = v1; i2 = i1; v1 = x; i1 = e; }
                else if (x > v2) { v3 = v2; i3 = i2; v2 = x; i2 = e; }
                else { v3 = x; i3 = e; }
            }
        }
        lr0 = __hip_atomic_fetch_add(&lcnt[i0], 1, __ATOMIC_RELAXED, __HIP_MEMORY_SCOPE_WORKGROUP); lr1 = __hip_atomic_fetch_add(&lcnt[i1], 1, __ATOMIC_RELAXED, __HIP_MEMORY_SCOPE_WORKGROUP); lr2 = __hip_atomic_fetch_add(&lcnt[i2], 1, __ATOMIC_RELAXED, __HIP_MEMORY_SCOPE_WORKGROUP); lr3 = __hip_atomic_fetch_add(&lcnt[i3], 1, __ATOMIC_RELAXED, __HIP_MEMORY_SCOPE_WORKGROUP);
    }
    __syncthreads();
    if (tid < 32) { const int c = lcnt[tid]; gbase[tid] = c ? (int)__hip_atomic_fetch_add((unsigned*)(F.ctl + CW_CNT + CNT_STRIDE * tid), (unsigned)c, __ATOMIC_RELAXED, __HIP_MEMORY_SCOPE_AGENT) : 0; }
    __syncthreads();
    if (sel) {
        const int t = tok0 + l;
        const float e1 = expf(v1 - v0), e2 = expf(v2 - v0), e3 = expf(v3 - v0), inv = 1.0f / (1.0f + e1 + e2 + e3);
        GAS int* te = (GAS int*)WSP(int, WS_TKE) + t * 4; GAS int* tr = (GAS int*)WSP(int, WS_TKR) + t * 4; GAS float* tg = (GAS float*)WSP(float, WS_TKG) + t * 4;
        te[0] = i0; te[1] = i1; te[2] = i2; te[3] = i3;
        tr[0] = gbase[i0] + lr0; tr[1] = gbase[i1] + lr1; tr[2] = gbase[i2] + lr2; tr[3] = gbase[i3] + lr3;
        tg[0] = inv; tg[1] = e1 * inv; tg[2] = e2 * inv; tg[3] = e3 * inv;
    }
    __syncthreads();
}
__device__ __forceinline__ void build_moe_tab(Frame& F) {
    LAS int* tab = (LAS int*)(F.lds + LTAB_OFF);
#if CNT_SPREAD
    if (F.tid < NE) tab[40 + NE + NE + F.tid] = ((int)__hip_atomic_load(F.ctl + CW_CNT + CNT_STRIDE * F.tid, RLX_AGENT) + 255) >> 8;
    __syncthreads();
    if (F.tid == 0) { int s = 0; for (int e = 0; e < NE; ++e) { tab[e] = s; s += tab[40 + NE + NE + e]; } tab[NE] = s; }
    __syncthreads();
    if (F.tid < MAXBLK) { int e = 0; while (e < NE - 1 && tab[e + 1] <= F.tid) ++e; ((LAS unsigned char*)(tab + 136))[F.tid] = (unsigned char)e; }
    __syncthreads();
}
#else
    if (F.tid == 0) { int s = 0; for (int e = 0; e < NE; ++e) { tab[e] = s; s += ((int)__hip_atomic_load(F.ctl + CW_CNT + e, RLX_AGENT) + 255) >> 8; } tab[NE] = s; }
    __syncthreads();
}
#endif
__device__ __forceinline__ void p9_scatter_token(Frame& F, const float* const* in, int t) {
    const int lane = F.lane; const LAS int* tab = (const LAS int*)(F.lds + LTAB_OFF);
    const GAS u32x2* xr = (const GAS u32x2*)(WSP(bf16, WS_X1) + (size_t)t * 2048) + lane; const GAS f32x4* gr = (const GAS f32x4*)in[26] + lane;
    f32x4 v[8]; float s = 0.f;
#pragma unroll
    for (int j = 0; j < 8; ++j) { const u32x2 xw = xr[64 * j]; v[j].x = bflo(xw.x); v[j].y = bfhi(xw.x); v[j].z = bflo(xw.y); v[j].w = bfhi(xw.y); s += (v[j].x * v[j].x + v[j].y * v[j].y) + (v[j].z * v[j].z + v[j].w * v[j].w); }
    const float rs = 1.0f * FAST_RSQ(wave_sum(s) * (1.f / 2048.f) + EPS);
    unsigned w[8];
#pragma unroll
    for (int j = 0; j < 8; ++j) { const f32x4 g = gr[64 * j]; w[j] = pk4_fp8(v[j].x * rs * g.x, v[j].y * rs * g.y, v[j].z * rs * g.z, v[j].w * rs * g.w); }
    const GAS int* te = (const GAS int*)WSP(int, WS_TKE) + t * 4; const GAS int* tr = (const GAS int*)WSP(int, WS_TKR) + t * 4;
#pragma unroll
    for (int k = 0; k < 4; ++k) { const int e = te[k], rk = tr[k]; const size_t rowi = (size_t)tab[e] * 256 + rk;
        GAS unsigned* o4 = (GAS unsigned*)(WSP(unsigned char, WS_HS) + rowi * 2048) + lane;
#pragma unroll
        for (int j = 0; j < 8; ++j) o4[64 * j] = w[j]; }
}
struct P12Idx { int e[4], r[4]; float g[4]; };
__device__ __forceinline__ P12Idx p12_load_idx(Frame& F, int t) {
    P12Idx x; const GAS int* te = (const GAS int*)WSP(int, WS_TKE) + t * 4; const GAS int* tr = (const GAS int*)WSP(int, WS_TKR) + t * 4; const GAS float* tg = (const GAS float*)WSP(float, WS_TKG) + t * 4;
#pragma unroll
    for (int k = 0; k < 4; ++k) { x.e[k] = te[k]; x.r[k] = tr[k]; x.g[k] = tg[k]; }
    return x;
}
__device__ __forceinline__ void p12_combine_token(Frame& F, float* out, int t, const P12Idx& ix) {
    const int lane = F.lane; const LAS int* tab = (const LAS int*)(F.lds + LTAB_OFF);
    const GAS u32x2* xr = (const GAS u32x2*)(WSP(bf16, WS_X1) + (size_t)t * 2048) + lane;
    u32x2 xw[8]; unsigned yw[4][8];
#pragma unroll
    for (int j = 0; j < 8; ++j) xw[j] = xr[64 * j];
#pragma unroll
    for (int k = 0; k < 4; ++k) { const size_t rowi = (size_t)tab[ix.e[k]] * 256 + ix.r[k];
        const GAS unsigned* y4 = (const GAS unsigned*)(WSP(unsigned char, WS_Y) + rowi * 2048) + lane;
#pragma unroll
        for (int j = 0; j < 8; ++j) yw[k][j] = y4[64 * j]; }
    f32x4 v[8];
#pragma unroll
    for (int j = 0; j < 8; ++j) { v[j].x = bflo(xw[j].x); v[j].y = bfhi(xw[j].x); v[j].z = bflo(xw[j].y); v[j].w = bfhi(xw[j].y); }
#pragma unroll
    for (int k = 0; k < 4; ++k) { const float g = ix.g[k];
#pragma unroll
        for (int j = 0; j < 8; ++j) { const f32x2 lo = __builtin_amdgcn_cvt_pk_f32_fp8((int)yw[k][j], false), hh = __builtin_amdgcn_cvt_pk_f32_fp8((int)yw[k][j], true);
            v[j].x += g * lo[0]; v[j].y += g * lo[1]; v[j].z += g * hh[0]; v[j].w += g * hh[1]; } }
    GAS f32x4* o = (GAS f32x4*)(out + (size_t)t * 2048) + lane;
#pragma unroll
    for (int j = 0; j < 8; ++j) o[64 * j] = v[j];
}

struct Args { const float* in[33]; float* out; unsigned char* ws; };
__global__ void __launch_bounds__(NWAVES * 64, 2) mk_fwd(Args args) {
    extern __shared__ __attribute__((aligned(16))) unsigned char lds[];
    Frame F;
    F.lds = (LAS unsigned char*)lds;
    F.MISC = (volatile LAS unsigned*)(F.lds + MISC_OFF);
    F.tid = threadIdx.x; F.lane = F.tid & 63; F.wave = __builtin_amdgcn_readfirstlane(F.tid >> 6);
    F.G = gridDim.x; { const int bx = blockIdx.x; F.vcu = (F.G % 8 == 0) ? (bx % 8) * (F.G / 8) + bx / 8 : bx; }
    F.ws = args.ws; F.ctl = (gu32*)(args.ws + WS_CTL);
    const float* const* in = args.in;
    for (int u = F.tid; u < (LDS_BYTES - LDSCTL_OFF) / 4; u += NWAVES * 64) ((LAS unsigned*)(F.lds + LDSCTL_OFF))[u] = 0u;
    __syncthreads();
#define PHASE_SEAM() do { xcd_barrier(bar); int l_ = pg8::pg8_lane(); asm volatile("" : "+v"(l_)); F.lane = l_; F.tid = F.wave * 64 + l_; } while (0)
    XcdBarrier bar = xcd_barrier_post((unsigned*)(F.ctl + CW_BAR), F.MISC + 8);
    const int gw = F.vcu * NWAVES + F.wave, NGW = F.G * NWAVES;
    typedef pg8::bf16_t pbf;

    for (int rep = 0; rep < REP_P0; ++rep) p0_prologue<0>(F, in);
    PHASE_SEAM();

    for (int rep = 0; rep < REP_P1; ++rep)
    {   pg8::Gemm g{WSP(pbf, WS_H), WSP(pbf, WS_W1T), T + MEMROWS, P1N + 2048, 2048, HPITCH, HPITCH};
        pg8::EpiP1 E{WSP(pbf, WS_P1), WSP(pbf, WS_MKV), in[6]};
        const int slot = (CONV_IN_P1 && (!ATTN_SPLIT || SPLIT_NOCONV) && rep == 0) ? (F.vcu % (GATE_F8 ? 5 : 10)) : 0;
        if (!(UV_F8 == 1 && GATE_F8))
        {   pg8::P1Order S; S.init(F.G, (int)blockIdx.x, 0, slot);
            pg8::gemm_phase<pg8::EpiP1, pg8::P1Order, GEMM_ALIGN, true>(F.lds + RING_OFF, g, S, E, F.wave); }
        if (CONV_IN_P1 && (!ATTN_SPLIT || SPLIT_NOCONV) && rep == 0) { __syncthreads(); if (CONV_DMA == 2) moe_convert_share_dma256(F, in); else if (CONV_DMA) moe_convert_share_dma(F, in); else moe_convert_share<0>(F, in); if (REP_CONV > 1) moe_convert_share<1>(F, in); }
        if (!(UV_F8 == 1 && GATE_F8))
        {   pg8::P1Order S; S.init(F.G, (int)blockIdx.x, slot, 1 << 20);
            pg8::gemm_phase<pg8::EpiP1, pg8::P1Order, GEMM_ALIGN, true>(F.lds + RING_OFF, g, S, E, F.wave); }
        if (GATE_F8) {
            pg8::Gemm g8{WSP(pbf, WS_H8), WSP(pbf, WS_WG8) - (size_t)8 * 256 * 1024, T + MEMROWS, 41 * 256, 1024, 1024, 1024, MOE_SW, MOE_SX};
            pg8::GateOrder SG; SG.init(F.G, (int)blockIdx.x);
            pg8::gemm_phase<pg8::EpiP1, pg8::GateOrder, GEMM_ALIGN, true, true, 0, (KROT_MASK & 4) != 0>(F.lds + RING_OFF, g8, SG, E, F.wave); }
        if (GATE_F8 && PRO_SPLIT == 1 && UV_F8 == 2 && rep == 0 && blockIdx.x >= 96) p0_prologue<1>(F, in, (int)blockIdx.x - 96, 160);
        if (GATE_F8 && PRO_SPLIT == 2 && UV_F8 == 2 && rep == 0 && blockIdx.x >= 224) p0_prologue<1>(F, in, (int)blockIdx.x - 224, 32);
        if (GATE_F8 && CONV_OFFLOAD && UV_F8 == 2 && rep == 0 && blockIdx.x >= 96 && blockIdx.x < 96 + CONV_OFF_CUS) {
            const int k0 = (CONV_NSUP - CONV_OFF) + 8 * ((int)blockIdx.x - 96);
            moe_convert_range256<8>(F, in, F.wave, (LAS unsigned*)(F.lds + RING_OFF + F.wave * 16640), F.lane, k0, k0 + 8); }
    }
    PHASE_SEAM();

    for (int rep = 0; rep < REP_P2; ++rep)
    for (int t = gw; t < T; t += NGW) p2_token(F, in, t);
    for (int m = gw; m < MEMROWS; m += NGW) p2_memrow(F, in, m);
    PHASE_SEAM();

    for (int rep = 0; rep < REP_P3; ++rep) {
    {   pg8::Gemm g{WSP(pbf, WS_CQN), WSP(pbf, WS_WUQT), T, 4096, 256, 256, 256, UP_SW, MOE_SX};
        pg8::StaticOrder S; S.init(T, 4096, F.G, (int)blockIdx.x);
#if ATTN_F8
        pg8::EpiQ8 E{(LAS float*)(F.lds + LEPI_OFF), in[16], WSP(float, WS_ROPE), WSP(unsigned char, WS_QF), MLA_QSCALE * 16.0f};
        pg8::gemm_phase<pg8::EpiQ8, pg8::StaticOrder, true, true, true>(F.lds + RING_OFF, g, S, E, F.wave);
#else
        pg8::EpiQ E{(LAS float*)(F.lds + LEPI_OFF), in[16], WSP(float, WS_ROPE), WSP(pbf, WS_QF), MLA_QSCALE};
        pg8::gemm_phase<pg8::EpiQ, pg8::StaticOrder, true, true, true>(F.lds + RING_OFF, g, S, E, F.wave);
#endif
    }
    {   pg8::Gemm g{WSP(pbf, WS_CKVN), WSP(pbf, WS_WUKVT), T, 4096, 256, 256, 256, UP_SW, MOE_SX};
        pg8::StaticOrder S; S.init(T, 4096, F.G, (int)blockIdx.x);
#if ATTN_F8
        pg8::EpiKV8 E{(LAS float*)(F.lds + LEPI_OFF), in[17], WSP(float, WS_KRSS), WSP(float, WS_KRR), WSP(unsigned char, WS_KFT), WSP(unsigned char, WS_VFT)};
        pg8::gemm_phase<pg8::EpiKV8, pg8::StaticOrder, true, true, true>(F.lds + RING_OFF, g, S, E, F.wave);
#else
        pg8::EpiKV E{(LAS float*)(F.lds + LEPI_OFF), in[17], WSP(float, WS_KRSS), WSP(float, WS_KRR), WSP(pbf, WS_KFT), WSP(pbf, WS_VFT)};
        pg8::gemm_phase<pg8::EpiKV, pg8::StaticOrder, true, true, true>(F.lds + RING_OFF, g, S, E, F.wave);
#endif
    }
    __syncthreads();
    for (int u = F.vcu; u < 1024; u += F.G) gmlp_unit(F, in, u);
    for (int u = F.vcu; u < 512; u += F.G) {
        const int half = u & 1, qb = (u >> 1) & 15, bh = u >> 5;
        const bf16* Q = WSP(bf16, WS_QMN) + ((size_t)bh * 4096 + qb * 256 + 32 * F.wave) * 256;
        const bf16* Kt = WSP(bf16, WS_MKT) + (size_t)bh * 4 * (32 * 64 * 8);
        const bf16* Vt = WSP(bf16, WS_MVT) + (size_t)(bh * 2 + half) * 4 * (4 * 64 * 32);
        unsigned char* O = WSP(unsigned char, WS_ABC) + ((size_t)(bh >> 2) * 4096 + qb * 256 + 32 * F.wave) * ABC_ROWB + ABC_CB + (bh & 3) * 256 + half * 128;
        attn_unit<256, 2, false>(F.lds + RING_OFF, Q, 256, Kt, Vt, 4, 0, O, ABC_ROWB, F.wave, F.lane);
    }
    }
    PHASE_SEAM();

#if ATTN_SPLIT
    {   const int s = F.vcu & 3;
#if !(ATTN_XCDMAP && ATTN_RB2)
        const int bh = F.vcu >> 2;
#endif
        constexpr int NIT = NE * 32 * 64 + NE * 32 * 32;
        ConvState cs; cs.lo = F.vcu * (NIT / 256); cs.cw = F.wave - 4; cs.c = -1;
        { const int nitems = (NIT / 256 - cs.cw + 3) / 4; cs.nchunks = (F.wave >= 4 && !SPLIT_NOCONV) ? nitems * 4 : 0; }
        LAS unsigned char* cbase = F.lds + RING_OFF + (ATT_PAIR && ATTN_RB2 ? 81920 : 61440) + (F.wave - 4) * 16640;
#if ATTN_RB2
#if ATTN_XCDMAP
#define P5_UNIT(i_) const int s16 = F.vcu & 15, s8 = (s16 + 8) & 15, qb = ((i_) == 0) ? s16 : ((i_) == 1) ? 15 - s16 : ((i_) == 2) ? s8 : 15 - s8, nt = 4 * (qb + 1), \
        bh = 8 * (F.vcu >> 5) + 2 * (i_) + ((F.vcu >> 4) & 1)
#else
#define P5_UNIT(i_) const int qb = ((i_) == 0) ? s : ((i_) == 1) ? 7 - s : ((i_) == 2) ? 8 + s : 15 - s, nt = 4 * (qb + 1)
#endif
#if ATT_REBAL
        LAS unsigned* bctr = (LAS unsigned*)(F.lds + MISC_OFF + 64);
        if (F.tid == 0) { bctr[0] = 0u; bctr[1] = 0u; }
        __syncthreads();
        const unsigned char* Kt = WSP(unsigned char, WS_KFT) + (size_t)bh * 64 * 12288;
        const unsigned char* Vt = WSP(unsigned char, WS_VFT) + (size_t)bh * 64 * 8192;
        if (F.wave < 4) {
            unsigned nbar = 0;
            const int nu = (s == 0) ? 2 : 3;
            for (int i = 0; i < nu; ++i) {
                const int qb = (s == 0) ? (i == 0 ? 15 : 13) : (s == 1) ? (i == 0 ? 14 : i == 1 ? 8 : 5) : (s == 2) ? (i == 0 ? 12 : i == 1 ? 9 : 6) : (i == 0 ? 11 : i == 1 ? 10 : 7);
                const unsigned char* Q = WSP(unsigned char, WS_QF) + ((size_t)bh * 4096 + qb * 256 + 32 * F.wave) * 192;
                unsigned char* O = WSP(unsigned char, WS_ABC) + ((size_t)(bh >> 4) * 4096 + qb * 256 + 32 * F.wave) * ABC_ROWB + ABC_BB + (bh & 15) * 128;
                attn8_unit2<true>(F.lds + RING_OFF, Q, Kt, Vt, 4 * (qb + 1), qb * 256 + 32 * F.wave, O, ABC_ROWB, F.wave, F.lane, bctr, nbar); }
        } else {
            moe_convert_share_w256<4>(F, in, F.wave - 4, (LAS unsigned*)cbase, F.lane);
            asm volatile("s_waitcnt vmcnt(0) lgkmcnt(0)" ::: "memory");
            unsigned nbar2 = 0; const int cw = F.wave - 4;
            att_bar4(bctr + 1, nbar2, F.lane);
            const int nu = (s == 3) ? 4 : 2;
            for (int i = 0; i < nu; ++i) {
                const int qh = (s == 0) ? (i == 0 ? 9 : 3) : (s == 1) ? (i == 0 ? 8 : 4) : (s == 2) ? (i == 0 ? 7 : 5) : (i == 0 ? 6 : i == 1 ? 2 : i == 2 ? 1 : 0);
                const unsigned char* Q = WSP(unsigned char, WS_QF) + ((size_t)bh * 4096 + qh * 128 + 32 * cw) * 192;
                unsigned char* O = WSP(unsigned char, WS_ABC) + ((size_t)(bh >> 4) * 4096 + qh * 128 + 32 * cw) * ABC_ROWB + ABC_BB + (bh & 15) * 128;
                attn8_unit<true, 4>(F.lds + RING_OFF + 61440, Q, Kt, Vt, 2 * (qh + 1), qh * 128 + 32 * cw, O, ABC_ROWB, cw, F.lane, bctr + 1, &nbar2); }
        }
#else
        LAS unsigned* bctr = (LAS unsigned*)(F.lds + MISC_OFF + 64);
        if (F.tid == 0) *bctr = 0u;
        __syncthreads();
        if (F.wave < 4) {
            unsigned nbar = 0;
            for (int rep = 0; rep < REP_P5; ++rep)
            for (int i = 0; i < 4; ++i) { P5_UNIT(i);
                const unsigned char* Q = WSP(unsigned char, WS_QF) + ((size_t)bh * 4096 + qb * 256 + 32 * F.wave) * 192;
                const unsigned char* Kt = WSP(unsigned char, WS_KFT) + (size_t)bh * 64 * 12288;
                const unsigned char* Vt = WSP(unsigned char, WS_VFT) + (size_t)bh * 64 * 8192;
                unsigned char* O = WSP(unsigned char, WS_ABC) + ((size_t)(bh >> 4) * 4096 + qb * 256 + 32 * F.wave) * ABC_ROWB + ABC_BB + (bh & 15) * 128;
                attn8_unit2<true>(F.lds + RING_OFF, Q, Kt, Vt, nt, qb * 256 + 32 * F.wave, O, ABC_ROWB, F.wave, F.lane, bctr, nbar); }
        } else {
#if !SPLIT_FREE
            int it = 0;
            for (int i = 0; i < 4; ++i) { P5_UNIT(i);
                for (int j = 0; j < nt; ++j, ++it) { conv_steps<4>(F, in, cs, cbase, 3, F.lane); __builtin_amdgcn_s_barrier(); asm volatile("" ::: "memory"); }
                __builtin_amdgcn_s_barrier(); asm volatile("" ::: "memory"); }
#endif
#if SPLIT_FREE == 2
            for (int rep = 0; rep < REP_CONV; ++rep) { if (CONV_ROWS == 256) moe_convert_share_w256<4>(F, in, F.wave - 4, (LAS unsigned*)cbase, F.lane); else moe_convert_share_w<4>(F, in, F.wave - 4, (LAS unsigned*)cbase, F.lane); }
            asm volatile("s_waitcnt vmcnt(0)" ::: "memory");
#else
            for (int rep = 0; rep < REP_CONV; ++rep) { cs.c = -1; conv_steps<4>(F, in, cs, cbase, 1 << 20, F.lane); asm volatile("s_waitcnt vmcnt(0)" ::: "memory"); }
#endif
        }
#endif
#undef P5_UNIT
#else
#define P5_UNIT(i_) const int qb = (((i_) >> 1) == 0) ? s : (((i_) >> 1) == 1) ? 7 - s : (((i_) >> 1) == 2) ? 8 + s : 15 - s, qh = 2 * qb + ((i_) & 1), nt = 2 * (qh + 1)
        if (F.wave < 4) {
            __builtin_amdgcn_s_setprio(SPLIT_PRIO);
            for (int i = 0; i < 8; ++i) { P5_UNIT(i);
                const unsigned char* Q = WSP(unsigned char, WS_QF) + ((size_t)bh * 4096 + qh * 128 + 32 * F.wave) * 192;
                const unsigned char* Kt = WSP(unsigned char, WS_KFT) + (size_t)bh * 64 * 12288;
                const unsigned char* Vt = WSP(unsigned char, WS_VFT) + (size_t)bh * 64 * 8192;
                unsigned char* O = WSP(unsigned char, WS_ABC) + ((size_t)(bh >> 4) * 4096 + qh * 128 + 32 * F.wave) * ABC_ROWB + ABC_BB + (bh & 15) * 128;
                attn8_unit<true, 4>(F.lds + RING_OFF, Q, Kt, Vt, nt, qh * 128 + 32 * F.wave, O, ABC_ROWB, F.wave, F.lane); }
            __builtin_amdgcn_s_setprio(0);
        } else {
            int it = 0;
            for (int i = 0; i < 8; ++i) { P5_UNIT(i);
                for (int j = 0; j < nt; ++j, ++it) { conv_steps<4>(F, in, cs, cbase, CONV_QUOTA(it), F.lane); __builtin_amdgcn_s_barrier(); asm volatile("" ::: "memory"); }
                __builtin_amdgcn_s_barrier(); asm volatile("" ::: "memory"); }
            conv_steps<4>(F, in, cs, cbase, 1 << 20, F.lane); asm volatile("s_waitcnt vmcnt(0)" ::: "memory");
        }
#undef P5_UNIT
#endif
        __syncthreads();
    }
    PHASE_SEAM();

#else
    for (int rep = 0; rep < REP_P5; ++rep)
    {   const int bh = F.vcu >> 2, s = F.vcu & 3;
        for (int i = 0; i < 4; ++i) {
            if (!CONV_IN_P1 && rep == 0 && i == ((F.vcu >> 2) & 3)) { moe_convert_share<0>(F, in); if (REP_CONV > 1) moe_convert_share<1>(F, in); }
            const int qb = (i == 0) ? s : (i == 1) ? 7 - s : (i == 2) ? 8 + s : 15 - s;
#if ATTN_F8
            const unsigned char* Q = WSP(unsigned char, WS_QF) + ((size_t)bh * 4096 + qb * 256 + 32 * F.wave) * 192;
            const unsigned char* Kt = WSP(unsigned char, WS_KFT) + (size_t)bh * 64 * 12288;
            const unsigned char* Vt = WSP(unsigned char, WS_VFT) + (size_t)bh * 64 * 8192;
            unsigned char* O = WSP(unsigned char, WS_ABC) + ((size_t)(bh >> 4) * 4096 + qb * 256 + 32 * F.wave) * ABC_ROWB + ABC_BB + (bh & 15) * 128;
            attn8_unit<true>(F.lds + RING_OFF, Q, Kt, Vt, 4 * (qb + 1), qb * 256 + 32 * F.wave, O, ABC_ROWB, F.wave, F.lane);
#else
            const bf16* Q = WSP(bf16, WS_QF) + ((size_t)bh * 4096 + qb * 256 + 32 * F.wave) * 192;
            const bf16* Kt = WSP(bf16, WS_KFT) + (size_t)bh * 64 * (24 * 64 * 8);
            const bf16* Vt = WSP(bf16, WS_VFT) + (size_t)bh * 64 * (4 * 64 * 32);
            unsigned char* O = WSP(unsigned char, WS_ABC) + ((size_t)(bh >> 4) * 4096 + qb * 256 + 32 * F.wave) * ABC_ROWB + ABC_BB + (bh & 15) * 128;
            attn_unit<192, 3, true>(F.lds + RING_OFF, Q, 192, Kt, Vt, 4 * (qb + 1), qb * 256 + 32 * F.wave, O, ABC_ROWB, F.wave, F.lane);
#endif
        }
    }
    PHASE_SEAM();

#endif
    for (int rep = 0; rep < REP_P6; ++rep)
    {   pg8::Gemm g{WSP(pbf, WS_ABC), WSP(pbf, WS_WPT), T, 2048, ABC_LD, ABC_LD, ABC_LD, MOE_SW, ATT_OSB};
        pg8::StaticOrder S; S.init(T, 2048, F.G, (int)blockIdx.x);
        pg8::EpiMergedT<16, 32> E{WSP(pbf, WS_P1), WSP(pbf, WS_MERGED)};
        pg8::gemm_phase<pg8::EpiMergedT<16, 32>, pg8::StaticOrder, GEMM_ALIGN, true, false, 16>(F.lds + RING_OFF, g, S, E, F.wave);
    }
    PHASE_SEAM();

    for (int rep = 0; rep < REP_P7; ++rep)
    {   pg8::Gemm g{WSP(pbf, WS_MERGED), WSP(pbf, WS_WOT), T, 2048, 2048, 2048, 2048};
        pg8::StaticOrder S; S.init(T, 2048, F.G, (int)blockIdx.x);
        pg8::EpiX1 E{in[0], WSP(pbf, WS_X1)};
        pg8::gemm_phase<pg8::EpiX1, pg8::StaticOrder, P7_ALIGN, true>(F.lds + RING_OFF, g, S, E, F.wave);
    }
    PHASE_SEAM();

    p8_router(F, in);
    PHASE_SEAM();

    build_moe_tab(F);
    for (int rep = 0; rep < REP_P9; ++rep)
    for (int t = gw; t < T; t += NGW) p9_scatter_token(F, in, t);
    PHASE_SEAM();

    for (int rep = 0; rep < REP_P10; ++rep)
    {   pg8::Gemm g{WSP(pbf, WS_HS), WSP(pbf, WS_WGUT), MAXSLOT, NE * 4096, 1024, 1024, 1024, MOE_SW, MOE_SX};
        pg8::MoeOrder S{(const LAS int*)(F.lds + LTAB_OFF), 16, (int)(blockIdx.x & 7), (int)(blockIdx.x >> 3)};
        pg8::EpiSwiGLU E{in[30], WSP(unsigned char, WS_ACT)};
#if P10_PROBE
        if (rep > 0) { pg8::EpiSwiGLUProbe<P10_PROBE> EP; EP.bgu = E.bgu; EP.ACT = E.ACT;
            pg8::gemm_phase<pg8::EpiSwiGLUProbe<P10_PROBE>, pg8::MoeOrder, GEMM_ALIGN, true, true>(F.lds + RING_OFF, g, S, EP, F.wave); }
        else
#endif
        pg8::gemm_phase<pg8::EpiSwiGLU, pg8::MoeOrder, GEMM_ALIGN, true, true, 0, (KROT_MASK & 1) != 0, (PFETCH_MASK & 1) != 0>(F.lds + RING_OFF, g, S, E, F.wave);
    }
    PHASE_SEAM();

    for (int rep = 0; rep < REP_P11; ++rep)
    {   pg8::Gemm g{WSP(pbf, WS_ACT), WSP(pbf, WS_WDT), MAXSLOT, NE * 2048, 1024, 1024, 1024, MOE_SW, MOE_SX};
        pg8::MoeOrder S{(const LAS int*)(F.lds + LTAB_OFF), 8, (int)(blockIdx.x & 7), (int)(blockIdx.x >> 3)};
        pg8::EpiDown E{in[32], WSP(unsigned char, WS_Y)};
        pg8::gemm_phase<pg8::EpiDown, pg8::MoeOrder, GEMM_ALIGN, true, true, 0, (KROT_MASK & 2) != 0>(F.lds + RING_OFF, g, S, E, F.wave);
    }
    PHASE_SEAM();

    for (int rep = 0; rep < REP_P12; ++rep)
    {   P12Idx ix = p12_load_idx(F, gw < T ? gw : 0);
        for (int t = gw; t < T; t += NGW) { const P12Idx nx = p12_load_idx(F, t + NGW < T ? t + NGW : t); p12_combine_token(F, args.out, t, ix); ix = nx; } }
}

extern "C" void kernel_launch(void* const* d_in, const int* in_sizes, int n_in, void* d_out, int out_size, void* d_ws, size_t ws_size, hipStream_t stream) {
    static int grid = 0;
    if (grid == 0) {
        if (n_in != 33 || out_size != T * D || ws_size < WS_END) { fprintf(stderr, "kernel_launch: unexpected problem (n_in %d out %d ws %zu need %zu)\n", n_in, out_size, ws_size, (size_t)WS_END); grid = -1; return; }
        (void)in_sizes;
        if (hipFuncSetAttribute((const void*)mk_fwd, hipFuncAttributeMaxDynamicSharedMemorySize, LDS_BYTES) != hipSuccess) { fprintf(stderr, "kernel_launch: hipFuncSetAttribute failed\n"); grid = -1; return; }
        int per_cu = 0;
        if (hipOccupancyMaxActiveBlocksPerMultiprocessor(&per_cu, (const void*)mk_fwd, NWAVES * 64, LDS_BYTES) != hipSuccess || per_cu < 1) fprintf(stderr, "kernel_launch: occupancy query reports %d\n", per_cu);
        (void)hipGetLastError();
        grid = 256;
    }
    if (grid < 0) return;
    if (hipMemsetAsync((char*)d_ws + WS_CTL, 0, CTL_ZERO_BYTES, stream) != hipSuccess) { fprintf(stderr, "kernel_launch: memset failed\n"); return; }
    Args a{};
    for (int i = 0; i < 33; ++i) a.in[i] = (const float*)d_in[i];
    a.out = (float*)d_out; a.ws = (unsigned char*)d_ws;
    hipLaunchKernelGGL(mk_fwd, dim3(grid), dim3(NWAVES * 64), LDS_BYTES, stream, a);
}
```

```cpp
#include <hip/hip_runtime.h>
#include <cstdio>
#include <cstdint>
#include <cmath>
#ifndef REP_P0
#define REP_P0 1
#endif
#ifndef REP_P1
#define REP_P1 1
#endif
#ifndef REP_P3
#define REP_P3 1
#endif
#ifndef REP_P5
#define REP_P5 1
#endif
#ifndef REP_P6
#define REP_P6 1
#endif
#ifndef REP_P10
#define REP_P10 1
#endif
#ifndef REP_P11
#define REP_P11 1
#endif
#ifndef REP_CONV
#define REP_CONV 1
#endif
#ifndef ATTN_RB2
#define ATTN_RB2 1
#endif
#ifndef SPLIT_FREE
#define SPLIT_FREE 2
#endif
#ifndef CONV_ROWS
#define CONV_ROWS 256
#endif
#ifndef UV_F8
#define UV_F8 2
#endif
#ifndef ATTN_XCDMAP
#define ATTN_XCDMAP 0
#endif
#ifndef P10_PROBE
#define P10_PROBE 0
#endif
#ifndef KROT_MASK
#define KROT_MASK 0
#endif
#ifndef ROUTER_BF16X2
#define ROUTER_BF16X2 1
#endif
#ifndef CONV_OFFLOAD
#define CONV_OFFLOAD 1
#endif
#ifndef STAGE_IN_MMA
#define STAGE_IN_MMA 0
#endif
#ifndef ATT_SLEEP
#define ATT_SLEEP 0
#endif
#ifndef ATT_VPRE
#define ATT_VPRE 0
#endif
#ifndef KSEG_BATCH16
#define KSEG_BATCH16 0
#endif
#ifndef ATT_PAIR
#define ATT_PAIR 1
#endif
#ifndef PFETCH_MASK
#define PFETCH_MASK 0
#endif
#ifndef CONV_SLEEP
#define CONV_SLEEP 0
#endif
#ifndef ATT_REBAL
#define ATT_REBAL 0
#endif
#ifndef ATT_SPLITQK
#define ATT_SPLITQK 1
#endif
#ifndef ATT_DEFER
#define ATT_DEFER 0
#endif
#ifndef PRO_SPLIT
#define PRO_SPLIT 0
#endif
#ifndef ATT_PERMLANE
#define ATT_PERMLANE 1
#endif
#ifndef ATT_POLL_SLEEP
#define ATT_POLL_SLEEP 1
#endif
#ifndef ATT_SPREAD
#define ATT_SPREAD 0
#endif
#ifndef STAGE_AUX
#define STAGE_AUX 0
#endif
#ifndef MOE_MAP2
#define MOE_MAP2 0
#endif
#ifndef ATT_OWIDE
#define ATT_OWIDE 1
#endif
#ifndef XL_FAST
#define XL_FAST 1
#endif
#ifndef EPIX1_BATCH
#define EPIX1_BATCH 0
#endif
#ifndef CNT_SPREAD
#define CNT_SPREAD 1
#endif
#ifndef SPLIT_PRIO
#define SPLIT_PRIO 0
#endif
#ifndef SPLIT_NOCONV
#define SPLIT_NOCONV 0
#endif
#ifndef CONV_QUOTA
#define CONV_QUOTA(it) (1 + ((it) & 1))
#endif
#ifndef ATTN_SPLIT
#define ATTN_SPLIT 1
#endif
#ifndef P7_ALIGN
#define P7_ALIGN true
#endif
#ifndef ATTN_F8
#define ATTN_F8 1
#endif
#ifndef GATE_BF16SPLIT
#define GATE_BF16SPLIT 0
#endif
#ifndef GATE_SKIP
#define GATE_SKIP 0
#endif
#ifndef GATE_F8
#define GATE_F8 1
#endif
#ifndef CONV_DMA
#define CONV_DMA 1
#endif
#ifndef PITCH_PAD
#define PITCH_PAD 0
#endif
#ifndef GEMM_ALIGN
#define GEMM_ALIGN true
#endif
#ifndef CONV_IN_P1
#define CONV_IN_P1 1
#endif
#ifndef REP_P7
#define REP_P7 1
#endif
#ifndef REP_P2
#define REP_P2 1
#endif
#ifndef REP_P4
#define REP_P4 1
#endif
#ifndef REP_P9
#define REP_P9 1
#endif
#ifndef REP_P12
#define REP_P12 1
#endif
constexpr int NWAVES = 8;
constexpr int T = 16384, D = 2048, NBATCH = 4, SEQ = 4096;
constexpr int HPITCH = 2048 + PITCH_PAD;
constexpr int P1N = 10496;
constexpr int P1_U = 0, P1_V = 1024, P1_CQ = 2048, P1_CKV = 2560, P1_QM = 3072, P1_KR = 4096, P1_G = 4352;
constexpr int P1_TILES = 41, MEMROWS = 1024;
constexpr int NH = 16, QKD = 192, NOPE = 128, ROPE = 64, VD = 128;
constexpr int NE = 32, DFF = 2048, MAXBLK = 288, MAXSLOT = MAXBLK * 256;
constexpr float EPS = 1e-6f;
constexpr float LOG2E = 1.4426950408889634f;
constexpr float MLA_QSCALE = 0.07216878364870322f * LOG2E;
constexpr float MEM_QSCALE = 0.0625f * LOG2E;
constexpr float MOE_WSCALE = 64.0f;
constexpr unsigned MOE_SW = 0x79797979u, MOE_SX = 0x7f7f7f7fu;
constexpr float UP_WSCALE = 16.0f;
constexpr unsigned UP_SW = 0x7b7b7b7bu;

constexpr size_t MiB = 1u << 20;
constexpr size_t WS_CTL = 0, CTL_ZERO_BYTES = 1 * MiB;
constexpr size_t WS_W1T   = 1 * MiB;
constexpr size_t WS_WUQT  = WS_W1T + (size_t)(P1N + 2048) * HPITCH * 2;
constexpr size_t WS_WUKVT = WS_WUQT + (size_t)4096 * 512 * 2;
constexpr size_t WS_WPT   = WS_WUKVT + (size_t)4096 * 512 * 2;
constexpr size_t WS_WOT   = WS_WPT + (size_t)2048 * 4096 * 2;
constexpr size_t WS_WGUT  = WS_WOT + (size_t)2048 * 2048 * 2;
constexpr size_t WS_WDT   = WS_WGUT + (size_t)NE * 4096 * 2048 * 2;
constexpr size_t WS_WSM   = WS_WDT + (size_t)NE * 2048 * 2048 * 2;
constexpr size_t WS_RWG   = WS_WSM + (size_t)8 * 128 * 128 * 2;
constexpr size_t WS_H     = WS_RWG + (size_t)2048 * 32 * 4;
constexpr size_t WS_P1    = WS_H + (size_t)(T + MEMROWS) * HPITCH * 2;
constexpr size_t WS_MKV   = WS_P1 + (size_t)T * P1N * 2;
constexpr size_t WS_VSTAT = WS_MKV + (size_t)MEMROWS * 2048 * 2;
constexpr size_t WS_CQN   = WS_VSTAT + (size_t)T * 8;
constexpr size_t WS_CKVN  = WS_CQN + (size_t)T * 512 * 2;
constexpr size_t WS_QMN   = WS_CKVN + (size_t)T * 512 * 2;
constexpr size_t WS_KRR   = WS_QMN + (size_t)T * 1024 * 2;
constexpr size_t WS_KRSS  = WS_KRR + (size_t)T * 64 * 4;
constexpr size_t WS_ROPE  = WS_KRSS + (size_t)T * 4;
constexpr size_t WS_MKT   = WS_ROPE + (size_t)T * 64 * 4;
constexpr size_t WS_MVT   = WS_MKT + (size_t)MEMROWS * 1024 * 2;
constexpr size_t WS_QRAW  = WS_MVT + (size_t)MEMROWS * 1024 * 2;
constexpr size_t WS_KVRAW = WS_QRAW + (size_t)T * 3072 * 2;
constexpr size_t WS_QF    = WS_KVRAW + (size_t)T * 4096 * 2;
constexpr size_t WS_KFT   = WS_QF + (size_t)T * 3072 * 2;
constexpr size_t WS_VFT   = WS_KFT + (size_t)T * 3072 * 2;
constexpr size_t WS_ABC   = WS_VFT + (size_t)T * 2048 * 2;
constexpr int ABC_LD = 2560, ABC_ROWB = 5120, ABC_BB = 2048, ABC_CB = 4096;
constexpr float ATT_OS = 32.0f; constexpr unsigned ATT_OSB = 0x7a7a7a7au;
constexpr size_t WS_MERGED= WS_ABC + (size_t)T * 4096 * 2;
constexpr size_t WS_X1    = WS_MERGED + (size_t)T * 2048 * 2;
constexpr size_t WS_TKE   = WS_X1 + (size_t)T * 2048 * 4;
constexpr size_t WS_TKR   = WS_TKE + (size_t)T * 16;
constexpr size_t WS_TKG   = WS_TKR + (size_t)T * 16;
constexpr size_t WS_HS    = WS_TKG + (size_t)T * 16;
constexpr size_t WS_ACT   = WS_HS + (size_t)MAXSLOT * 2048 * 2;
constexpr size_t WS_Y     = WS_ACT + (size_t)MAXSLOT * 2048 * 2;
constexpr size_t WS_H8    = WS_Y + (size_t)MAXSLOT * 2048 * 2;
constexpr size_t WS_WG8U  = WS_H8 + (size_t)(T + MEMROWS) * 2048;
constexpr size_t WS_WG8   = WS_WG8U + (size_t)8 * 256 * 2048;
constexpr size_t WS_END   = WS_WG8 + (size_t)41 * 256 * 2048;
constexpr int CW_TMO = 0, CW_CODE = 1;
constexpr int CW_CNT = 64, CNT_STRIDE = CNT_SPREAD ? 32 : 1;
constexpr int CW_CNT_OLD_ = 64;
constexpr int CW_BAR = 4096;

constexpr int RING_OFF = 0, RING_BYTES = ATT_PAIR ? 148480 : 133120;
constexpr int LDSCTL_OFF = RING_BYTES, MISC_OFF = LDSCTL_OFF + 320;
constexpr int LTAB_OFF = LDSCTL_OFF + 1024;
constexpr int LEPI_OFF = LDSCTL_OFF + 2048;
constexpr int LDS_BYTES = RING_BYTES + 14336;

#define XL_DPP(v, ctrl) __uint_as_float((unsigned)__builtin_amdgcn_update_dpp(0, (int)__float_as_uint(v), ctrl, 0xf, 0xf, true))
__device__ __forceinline__ float xl_sum16(float v) { v += XL_DPP(v, 0xB1); v += XL_DPP(v, 0x4E); v += XL_DPP(v, 0x141); v += XL_DPP(v, 0x140); return v; }
__device__ __forceinline__ float xl_swap16_sum(float v) { const auto r = __builtin_amdgcn_permlane16_swap(__float_as_uint(v), __float_as_uint(v), false, false); return __uint_as_float(r[0]) + __uint_as_float(r[1]); }
__device__ __forceinline__ float xl_swap32_sum(float v) { const auto r = __builtin_amdgcn_permlane32_swap(__float_as_uint(v), __float_as_uint(v), false, false); return __uint_as_float(r[0]) + __uint_as_float(r[1]); }
__device__ __forceinline__ float xl_swap32_max(float v) { const auto r = __builtin_amdgcn_permlane32_swap(__float_as_uint(v), __float_as_uint(v), false, false); return fmaxf(__uint_as_float(r[0]), __uint_as_float(r[1])); }

#ifndef RSQ_FAST
#define RSQ_FAST 1
#endif
#if RSQ_FAST
#define FAST_RSQ(x) __builtin_amdgcn_rsqf(x)
#else
#define FAST_RSQ(x) (1.0f / sqrtf(x))
#endif
namespace pg8 {
#define PG8_LAS __attribute__((address_space(3)))
typedef unsigned short bf16_t;
typedef short bf16x8 __attribute__((ext_vector_type(8)));
typedef float f32x4 __attribute__((ext_vector_type(4)));
typedef unsigned u32x4 __attribute__((ext_vector_type(4)));
constexpr int BM = 256, BK = 64, HALF = 128, HTB = HALF * BK * 2  , STAGE_BYTES = 8 * HTB, NXCD = 8, WGM = 8;

__host__ __device__ __forceinline__ int lds_byte(int r, int c) { const int st = (r >> 4) * 2 + (c >> 5), rr = r & 15, cc = c & 31, ob = rr * 64 + cc * 2; return st * 1024 + (ob ^ (((ob >> 9) & 1) << 5)); }
__host__ __device__ __forceinline__ void stage_rc(int b, int& R, int& C) { const int st = b / 1024, sb = b % 1024, swz = sb ^ (((sb >> 9) & 1) << 5); R = (st >> 1) * 16 + swz / 64; C = (st & 1) * 32 + (swz % 64) / 2; }
__host__ __device__ __forceinline__ int perm32(int rho) { const int n = rho >> 4, i = rho & 15; return 8 * (i >> 2) + 4 * n + (i & 3); }

__device__ __forceinline__ int pg8_lane() { int l; asm volatile("v_mbcnt_lo_u32_b32 %0, -1, 0\n\tv_mbcnt_hi_u32_b32 %0, -1, %0" : "=v"(l)); return l; }
struct Unit { int pm, pn; int kr = 0; };
typedef int i32x4 __attribute__((ext_vector_type(4)));
typedef int i32x8 __attribute__((ext_vector_type(8)));
struct Gemm { const bf16_t* A; const bf16_t* Bt; int M, N, K, lda, ldb; unsigned sw = 0x7f7f7f7fu, sx = 0x7f7f7f7fu; };

struct StaticOrder {
    int nM, nN, nwg, G, c;
    __host__ __device__ void init(int M, int N, int G_, int c_) { nM = M / BM; nN = N / BM; nwg = nM * nN; G = G_; c = c_; }
    __host__ __device__ bool next(int i, Unit& u) const {
        const long L = (long)i * G + c; if (L >= nwg) return false;
        int wgid = (int)L; { const int q = nwg / NXCD, r = nwg % NXCD, xcd = wgid % NXCD, off = wgid / NXCD; wgid = (xcd < r ? xcd * (q + 1) : r * (q + 1) + (xcd - r) * q) + off; }
        const int nig = WGM * nN, gid = wgid / nig, fm = gid * WGM, gsz = (nM - fm) < WGM ? (nM - fm) : WGM;
        u.pm = fm + ((wgid % nig) % gsz); u.pn = (wgid % nig) / gsz; return true;
    }
    __device__ __forceinline__ void a_ready(const Unit&) const {}
    __device__ __forceinline__ void done(const Unit&) const {}
};

__device__ __forceinline__ unsigned cvt_pk_bf16(float lo, float hi) { unsigned r; asm volatile("v_cvt_pk_bf16_f32 %0, %1, %2" : "=v"(r) : "v"(lo), "v"(hi)); return r; }
typedef float f32x2 __attribute__((ext_vector_type(2)));

template <class E, class = void> struct probe_of { static constexpr int v = 0; };
template <class E> struct probe_of<E, decltype((void)E::PROBE)> { static constexpr int v = E::PROBE; };
template <class Epi, class Sched, bool ALIGN_EPI = false, bool SP2 = false, bool F8 = false, int MIXT = 0, bool KROT = false, bool PFETCH = false>
__device__ __forceinline__ void gemm_phase(PG8_LAS unsigned char* lds, const Gemm g, const Sched& S, const Epi& E, const int wave_) {
    int tid_ = wave_ * 64 + pg8_lane(); asm volatile("" : "+v"(tid_));
    const int tid = tid_, wid = __builtin_amdgcn_readfirstlane(tid >> 6), lane = tid & 63, wr = wid >> 2, wc = wid & 3, fr = lane & 15, fq = lane >> 4;
    const int K = g.K, nt = K / BK;
    unsigned voffA[2], voffB[2];
#pragma unroll
    for (int i = 0; i < 2; ++i) { int R, C; stage_rc(tid * 16 + i * 8192, R, C); const int Rb = Epi::PERM ? ((R & ~31) + perm32(R & 31)) : R;
        voffA[i] = (unsigned)(R * g.lda + C) * 2u; voffB[i] = (unsigned)(Rb * g.ldb + C) * 2u; }
    const size_t kstep = (size_t)(BK * 2);
    const size_t hstepA = (size_t)HALF * g.lda * 2, hstepB = (size_t)HALF * g.ldb * 2;
    const size_t tstepA = 2 * hstepA, tstepB = 2 * hstepB;
    const unsigned ldsw = (unsigned)wid * 1024u;
    unsigned pfoff = 0;
    if constexpr (PFETCH) { const int prow = wid * 32 + (lane & 31); pfoff = (lane < 32) ? (unsigned)(prow * g.lda) * 2u : (unsigned)(prow * g.ldb) * 2u; }
    PG8_LAS unsigned* const pfl = (PG8_LAS unsigned*)(lds + RING_BYTES + 8192 + wid * 256);
#define PG8_PF(baseA_, baseB_) do { if constexpr (PFETCH) { const char* pb_ = (lane < 32) ? (const char*)(baseA_) : (const char*)(baseB_); \
        __builtin_amdgcn_global_load_lds((const unsigned*)(pb_ + pfoff), pfl, 4, 0, 0); } } while (0)
#define PG8_WV1 do { if constexpr (PFETCH) PG8_WAIT_V(9); else PG8_WAIT_V(8); } while (0)
#define PG8_WV2 do { if constexpr (PFETCH) PG8_WAIT_V(10); else PG8_WAIT_V(8); } while (0)
    const int aoff = lds_byte(wr * 64 + fr, fq * 8), boff = lds_byte(wc * 32 + fr, fq * 8);
#define PG8_SA(b, h) (((b) * 2 + (h)) * HTB)
#define PG8_SB(b, h) ((4 + (b) * 2 + (h)) * HTB)
#define PG8_STAGE(bufoff, gbase, voff) do { if constexpr (probe_of<Epi>::v != 3) _Pragma("unroll") for (int _i = 0; _i < 2; ++_i) \
        __builtin_amdgcn_global_load_lds((const unsigned*)((const char*)(gbase) + (voff)[_i]), (PG8_LAS unsigned*)(lds + (bufoff) + ldsw + _i * 8192), 16, 0, STAGE_AUX); } while (0)
#define PG8_LDA(dst, b, h) do { if constexpr (probe_of<Epi>::v != 2) _Pragma("unroll") for (int m = 0; m < 4; ++m) _Pragma("unroll") for (int k = 0; k < 2; ++k) dst[m][k] = *(const PG8_LAS bf16x8*)(lds + PG8_SA(b, h) + aoff + m * 2048 + k * 1024); } while (0)
#define PG8_LDB(dst, b, h) do { if constexpr (probe_of<Epi>::v != 2) _Pragma("unroll") for (int n = 0; n < 2; ++n) _Pragma("unroll") for (int k = 0; k < 2; ++k) dst[n][k] = *(const PG8_LAS bf16x8*)(lds + PG8_SB(b, h) + boff + n * 2048 + k * 1024); } while (0)
#define PG8_MMA(ai, bj, At, Bt) do { __builtin_amdgcn_s_setprio(1); \
        if (F8 || (MIXT > 0 && f8now)) { _Pragma("unroll") for (int m = 0; m < 4; ++m) _Pragma("unroll") for (int n = 0; n < 2; ++n) { \
            const i32x8 a8_ = __builtin_shufflevector(__builtin_bit_cast(i32x4, At[m][0]), __builtin_bit_cast(i32x4, At[m][1]), 0, 1, 2, 3, 4, 5, 6, 7); \
            const i32x8 b8_ = __builtin_shufflevector(__builtin_bit_cast(i32x4, Bt[n][0]), __builtin_bit_cast(i32x4, Bt[n][1]), 0, 1, 2, 3, 4, 5, 6, 7); \
            if constexpr (probe_of<Epi>::v == 0 || probe_of<Epi>::v == 3) asm volatile("v_mfma_scale_f32_16x16x128_f8f6f4 %0, %1, %2, %0, %3, %4 op_sel_hi:[0,0,0]" : "+v"(acc[ai][bj][m][n]) : "v"(b8_), "v"(a8_), "v"(sw_), "v"(sx_)); \
            else asm volatile("" :: "v"(b8_), "v"(a8_)); } } \
        else { _Pragma("unroll") for (int m = 0; m < 4; ++m) _Pragma("unroll") for (int n = 0; n < 2; ++n) _Pragma("unroll") for (int k = 0; k < 2; ++k) \
            acc[ai][bj][m][n] = __builtin_amdgcn_mfma_f32_16x16x32_bf16(Bt[n][k], At[m][k], acc[ai][bj][m][n], 0, 0, 0); } \
        __builtin_amdgcn_s_setprio(0); } while (0)
#define PG8_STAGE1(bufoff, gbase, voff, i_) __builtin_amdgcn_global_load_lds((const unsigned*)((const char*)(gbase) + (voff)[i_]), (PG8_LAS unsigned*)(lds + (bufoff) + ldsw + (i_) * 8192), 16, 0, 0)
#define PG8_MMAS(ai, bj, At, Bt, M0, S0, M1, S1) do { __builtin_amdgcn_s_setprio(1); \
        if (F8 || (MIXT > 0 && f8now)) { _Pragma("unroll") for (int m = 0; m < 4; ++m) { _Pragma("unroll") for (int n = 0; n < 2; ++n) { \
            const i32x8 a8_ = __builtin_shufflevector(__builtin_bit_cast(i32x4, At[m][0]), __builtin_bit_cast(i32x4, At[m][1]), 0, 1, 2, 3, 4, 5, 6, 7); \
            const i32x8 b8_ = __builtin_shufflevector(__builtin_bit_cast(i32x4, Bt[n][0]), __builtin_bit_cast(i32x4, Bt[n][1]), 0, 1, 2, 3, 4, 5, 6, 7); \
            if constexpr (probe_of<Epi>::v == 0 || probe_of<Epi>::v == 3) asm volatile("v_mfma_scale_f32_16x16x128_f8f6f4 %0, %1, %2, %0, %3, %4 op_sel_hi:[0,0,0]" : "+v"(acc[ai][bj][m][n]) : "v"(b8_), "v"(a8_), "v"(sw_), "v"(sx_)); \
            else asm volatile("" :: "v"(b8_), "v"(a8_)); } \
            if (m == (M0)) { PG8_SCHED; S0; PG8_SCHED; } if (m == (M1)) { PG8_SCHED; S1; PG8_SCHED; } } } \
        else { _Pragma("unroll") for (int m = 0; m < 4; ++m) { _Pragma("unroll") for (int n = 0; n < 2; ++n) _Pragma("unroll") for (int k = 0; k < 2; ++k) \
            acc[ai][bj][m][n] = __builtin_amdgcn_mfma_f32_16x16x32_bf16(Bt[n][k], At[m][k], acc[ai][bj][m][n], 0, 0, 0); \
            if (m == (M0)) { PG8_SCHED; S0; PG8_SCHED; } if (m == (M1)) { PG8_SCHED; S1; PG8_SCHED; } } } \
        __builtin_amdgcn_s_setprio(0); } while (0)
#define PG8_WAIT_V(n) asm volatile("s_waitcnt vmcnt(" #n ")" ::: "memory")
#define PG8_WAIT_L(n) asm volatile("s_waitcnt lgkmcnt(" #n ")" ::: "memory")
#define PG8_BAR __builtin_amdgcn_s_barrier()
#define PG8_SCHED __builtin_amdgcn_sched_barrier(0)
    Unit cur, nxt; int ui = 0;
    if (!S.next(0, cur)) return;
    f32x4 acc[2][2][4][2];
#pragma unroll
    for (int a = 0; a < 2; ++a)
#pragma unroll
        for (int b = 0; b < 2; ++b)
#pragma unroll
            for (int m = 0; m < 4; ++m)
#pragma unroll
                for (int n = 0; n < 2; ++n) acc[a][b][m][n] = (f32x4){0.f, 0.f, 0.f, 0.f};
    bf16x8 At[4][2], B0[2][2], B1[2][2];
    if constexpr (probe_of<Epi>::v == 2) {
#pragma unroll
        for (int m = 0; m < 4; ++m)
#pragma unroll
            for (int k = 0; k < 2; ++k) At[m][k] = (bf16x8){0, 0, 0, 0, 0, 0, 0, 0};
#pragma unroll
        for (int n = 0; n < 2; ++n)
#pragma unroll
            for (int k = 0; k < 2; ++k) { B0[n][k] = (bf16x8){0, 0, 0, 0, 0, 0, 0, 0}; B1[n][k] = (bf16x8){0, 0, 0, 0, 0, 0, 0, 0}; }
    }
    const int sw_ = (int)g.sw, sx_ = (int)g.sx;
    const char* cA = (const char*)g.A + (size_t)cur.pm * tstepA; const char* cB = (const char*)g.Bt + (size_t)cur.pn * tstepB;
    const int krs = (KROT && MIXT == 0 && !Epi::KSEG && (nt & 15) == 0) ? (nt >> 3) : 0;
    int ckr = krs * (cur.kr & 7);
    const char* const pA = cA + (size_t)ckr * kstep; const char* const pB = cB + (size_t)ckr * kstep;
    S.a_ready(cur);
    if constexpr (SP2) {
        PG8_STAGE(PG8_SB(0, 0), pB, voffB); PG8_STAGE(PG8_SB(0, 1), pB + hstepB, voffB); PG8_STAGE(PG8_SA(0, 0), pA, voffA); PG8_STAGE(PG8_SA(0, 1), pA + hstepA, voffA);
        if (wr == 1) PG8_BAR;
        PG8_WAIT_V(2); PG8_BAR;
        PG8_STAGE(PG8_SB(1, 0), pB + kstep, voffB); PG8_STAGE(PG8_SA(1, 0), pA + kstep, voffA); PG8_STAGE(PG8_SB(1, 1), pB + hstepB + kstep, voffB);
        PG8_PF(pA + 2 * kstep, pB + 2 * kstep);
        if constexpr (PFETCH) PG8_WAIT_V(7); else PG8_WAIT_V(6);
        PG8_BAR;
    } else {
        PG8_STAGE(PG8_SB(0, 0), pB, voffB); PG8_STAGE(PG8_SA(0, 0), pA, voffA); PG8_STAGE(PG8_SB(0, 1), pB + hstepB, voffB); PG8_STAGE(PG8_SA(0, 1), pA + hstepA, voffA);
        if (wr == 1) PG8_BAR;
        PG8_WAIT_V(4); PG8_BAR;
        PG8_STAGE(PG8_SB(1, 0), pB + kstep, voffB); PG8_STAGE(PG8_SA(1, 0), pA + kstep, voffA); PG8_STAGE(PG8_SB(1, 1), pB + hstepB + kstep, voffB);
        PG8_WAIT_V(6); PG8_BAR;
    }
    for (;;) {
        const bool has_next = S.next(ui + 1, nxt);
        const char* nA = has_next ? (const char*)g.A + (size_t)nxt.pm * tstepA : cA; const char* nB = has_next ? (const char*)g.Bt + (size_t)nxt.pn * tstepB : cB;
        const int nkr = has_next ? krs * (nxt.kr & 7) : ckr;
        for (int t = 0; t < (MIXT > 0 ? MIXT : nt); t += 2) {
            constexpr bool f8now = false; (void)f8now;
            const bool last = (t == nt - 2);
            if constexpr (Epi::KSEG) { if (t == Epi::KSEG_T1 || t == Epi::KSEG_T2) { if constexpr (F8 || MIXT > 0) asm volatile("s_nop 15\n\ts_nop 15" ::: "memory"); E.kseg(acc, cur, t, wr, wc, fr, fq); } }
            int r0 = t + ckr; if (r0 >= nt) r0 -= nt; int r2 = r0 + 2; if (r2 >= nt) r2 -= nt;
            const char* a1 = cA + (size_t)(r0 + 1) * kstep;
            const char* a2 = last ? nA + (size_t)nkr * kstep : cA + (size_t)r2 * kstep; const char* b2 = last ? nB + (size_t)nkr * kstep : cB + (size_t)r2 * kstep;
            const char* a3 = a2 + kstep; const char* b3 = b2 + kstep;
            int r4 = t + 4, k4 = ckr; const char* pfa4 = cA; const char* pfb4 = cB;
            if (r4 >= nt) { r4 -= nt; k4 = nkr; pfa4 = nA; pfb4 = nB; }
            r4 += k4; if (r4 >= nt) r4 -= nt;
            pfa4 += (size_t)r4 * kstep; pfb4 += (size_t)r4 * kstep;
            if (last && has_next) S.a_ready(nxt);
            if constexpr (SP2) {
#if STAGE_IN_MMA
            PG8_LDB(B0, 0, 0); PG8_LDB(B1, 0, 1); PG8_SCHED; PG8_LDA(At, 0, 0);
            PG8_WAIT_V(6); PG8_WAIT_L(0); PG8_BAR;
            PG8_MMAS(0, 0, At, B0, 1, PG8_STAGE1(PG8_SA(1, 1), a1 + hstepA, voffA, 0), 9, (void)0); PG8_MMAS(0, 1, At, B1, 1, PG8_STAGE1(PG8_SA(1, 1), a1 + hstepA, voffA, 1), 9, (void)0); PG8_BAR; PG8_SCHED;
            PG8_LDA(At, 0, 1); PG8_STAGE(PG8_SB(0, 0), b2, voffB);
            PG8_WAIT_V(4); PG8_WAIT_L(0); PG8_BAR;
            PG8_MMAS(1, 0, At, B0, 0, PG8_STAGE1(PG8_SB(0, 1), b2 + hstepB, voffB, 0), 2, PG8_STAGE1(PG8_SB(0, 1), b2 + hstepB, voffB, 1));
            PG8_MMAS(1, 1, At, B1, 0, PG8_STAGE1(PG8_SA(0, 0), a2, voffA, 0), 2, PG8_STAGE1(PG8_SA(0, 0), a2, voffA, 1)); PG8_BAR; PG8_SCHED;
            PG8_LDB(B0, 1, 0); PG8_LDB(B1, 1, 1); PG8_SCHED; PG8_LDA(At, 1, 0);
            PG8_WAIT_V(6); PG8_WAIT_L(0); PG8_BAR;
            PG8_MMAS(0, 0, At, B0, 1, PG8_STAGE1(PG8_SA(0, 1), a2 + hstepA, voffA, 0), 9, (void)0); PG8_MMAS(0, 1, At, B1, 1, PG8_STAGE1(PG8_SA(0, 1), a2 + hstepA, voffA, 1), 9, (void)0); PG8_BAR; PG8_SCHED;
            PG8_LDA(At, 1, 1); PG8_STAGE(PG8_SB(1, 0), b3, voffB);
            PG8_WAIT_V(4); PG8_WAIT_L(0); PG8_BAR;
            PG8_MMAS(1, 0, At, B0, 0, PG8_STAGE1(PG8_SB(1, 1), b3 + hstepB, voffB, 0), 2, PG8_STAGE1(PG8_SB(1, 1), b3 + hstepB, voffB, 1));
            PG8_MMAS(1, 1, At, B1, 0, PG8_STAGE1(PG8_SA(1, 0), a3, voffA, 0), 2, PG8_STAGE1(PG8_SA(1, 0), a3, voffA, 1)); PG8_BAR; PG8_SCHED;
#else
            PG8_LDB(B0, 0, 0); PG8_LDB(B1, 0, 1); PG8_SCHED; PG8_LDA(At, 0, 0); PG8_STAGE(PG8_SA(1, 1), a1 + hstepA, voffA);
            PG8_WV1; PG8_WAIT_L(0); PG8_BAR; PG8_MMA(0, 0, At, B0); PG8_MMA(0, 1, At, B1); PG8_BAR; PG8_SCHED;
            PG8_LDA(At, 0, 1); PG8_STAGE(PG8_SB(0, 0), b2, voffB); PG8_STAGE(PG8_SB(0, 1), b2 + hstepB, voffB); PG8_STAGE(PG8_SA(0, 0), a2, voffA); PG8_PF(pfa4, pfb4);
            PG8_WV2; PG8_WAIT_L(0); PG8_BAR; PG8_MMA(1, 0, At, B0); PG8_MMA(1, 1, At, B1); PG8_BAR; PG8_SCHED;
            PG8_LDB(B0, 1, 0); PG8_LDB(B1, 1, 1); PG8_SCHED; PG8_LDA(At, 1, 0); PG8_STAGE(PG8_SA(0, 1), a2 + hstepA, voffA);
            PG8_WV1; PG8_WAIT_L(0); PG8_BAR; PG8_MMA(0, 0, At, B0); PG8_MMA(0, 1, At, B1); PG8_BAR; PG8_SCHED;
            PG8_LDA(At, 1, 1); PG8_STAGE(PG8_SB(1, 0), b3, voffB); PG8_STAGE(PG8_SB(1, 1), b3 + hstepB, voffB); PG8_STAGE(PG8_SA(1, 0), a3, voffA); PG8_PF(pfa4 + kstep, pfb4 + kstep);
            PG8_WV2; PG8_WAIT_L(0); PG8_BAR; PG8_MMA(1, 0, At, B0); PG8_MMA(1, 1, At, B1); PG8_BAR; PG8_SCHED;
#endif
            } else {
            PG8_LDB(B0, 0, 0); PG8_SCHED; PG8_LDA(At, 0, 0); PG8_STAGE(PG8_SA(1, 1), a1 + hstepA, voffA);
            PG8_WAIT_L(8); PG8_BAR; PG8_WAIT_L(0); PG8_MMA(0, 0, At, B0); PG8_BAR; PG8_SCHED;
            PG8_LDB(B1, 0, 1); PG8_STAGE(PG8_SB(0, 0), b2, voffB);
            PG8_BAR; PG8_WAIT_L(0); PG8_MMA(0, 1, At, B1); PG8_BAR;
            PG8_LDA(At, 0, 1); PG8_STAGE(PG8_SA(0, 0), a2, voffA);
            PG8_BAR; PG8_WAIT_L(0); PG8_MMA(1, 0, At, B0); PG8_BAR; PG8_SCHED;
            PG8_STAGE(PG8_SB(0, 1), b2 + hstepB, voffB);
            PG8_WAIT_V(6); PG8_BAR; PG8_MMA(1, 1, At, B1); PG8_BAR;
            PG8_LDB(B0, 1, 0); PG8_SCHED; PG8_LDA(At, 1, 0); PG8_STAGE(PG8_SA(0, 1), a2 + hstepA, voffA);
            PG8_WAIT_L(8); PG8_BAR; PG8_WAIT_L(0); PG8_MMA(0, 0, At, B0); PG8_BAR; PG8_SCHED;
            PG8_LDB(B1, 1, 1); PG8_STAGE(PG8_SB(1, 0), b3, voffB);
            PG8_BAR; PG8_WAIT_L(0); PG8_MMA(0, 1, At, B1); PG8_BAR;
            PG8_LDA(At, 1, 1); PG8_STAGE(PG8_SA(1, 0), a3, voffA);
            PG8_BAR; PG8_WAIT_L(0); PG8_MMA(1, 0, At, B0); PG8_BAR; PG8_SCHED;
            PG8_STAGE(PG8_SB(1, 1), b3 + hstepB, voffB);
            PG8_WAIT_V(6); PG8_BAR; PG8_MMA(1, 1, At, B1); PG8_BAR;
            }
                }
        if constexpr (MIXT > 0) for (int t = MIXT; t < nt; t += 2) {
            constexpr bool f8now = true; (void)f8now;
            const bool last = (t == nt - 2);
            if constexpr (Epi::KSEG) { if (t == Epi::KSEG_T1 || t == Epi::KSEG_T2) { if constexpr (F8 || MIXT > 0) asm volatile("s_nop 15\n\ts_nop 15" ::: "memory"); E.kseg(acc, cur, t, wr, wc, fr, fq); } }
            int r0 = t + ckr; if (r0 >= nt) r0 -= nt; int r2 = r0 + 2; if (r2 >= nt) r2 -= nt;
            const char* a1 = cA + (size_t)(r0 + 1) * kstep;
            const char* a2 = last ? nA + (size_t)nkr * kstep : cA + (size_t)r2 * kstep; const char* b2 = last ? nB + (size_t)nkr * kstep : cB + (size_t)r2 * kstep;
            const char* a3 = a2 + kstep; const char* b3 = b2 + kstep;
            int r4 = t + 4, k4 = ckr; const char* pfa4 = cA; const char* pfb4 = cB;
            if (r4 >= nt) { r4 -= nt; k4 = nkr; pfa4 = nA; pfb4 = nB; }
            r4 += k4; if (r4 >= nt) r4 -= nt;
            pfa4 += (size_t)r4 * kstep; pfb4 += (size_t)r4 * kstep;
            if (last && has_next) S.a_ready(nxt);
            if constexpr (SP2) {
#if STAGE_IN_MMA
            PG8_LDB(B0, 0, 0); PG8_LDB(B1, 0, 1); PG8_SCHED; PG8_LDA(At, 0, 0);
            PG8_WAIT_V(6); PG8_WAIT_L(0); PG8_BAR;
            PG8_MMAS(0, 0, At, B0, 1, PG8_STAGE1(PG8_SA(1, 1), a1 + hstepA, voffA, 0), 9, (void)0); PG8_MMAS(0, 1, At, B1, 1, PG8_STAGE1(PG8_SA(1, 1), a1 + hstepA, voffA, 1), 9, (void)0); PG8_BAR; PG8_SCHED;
            PG8_LDA(At, 0, 1); PG8_STAGE(PG8_SB(0, 0), b2, voffB);
            PG8_WAIT_V(4); PG8_WAIT_L(0); PG8_BAR;
            PG8_MMAS(1, 0, At, B0, 0, PG8_STAGE1(PG8_SB(0, 1), b2 + hstepB, voffB, 0), 2, PG8_STAGE1(PG8_SB(0, 1), b2 + hstepB, voffB, 1));
            PG8_MMAS(1, 1, At, B1, 0, PG8_STAGE1(PG8_SA(0, 0), a2, voffA, 0), 2, PG8_STAGE1(PG8_SA(0, 0), a2, voffA, 1)); PG8_BAR; PG8_SCHED;
            PG8_LDB(B0, 1, 0); PG8_LDB(B1, 1, 1); PG8_SCHED; PG8_LDA(At, 1, 0);
            PG8_WAIT_V(6); PG8_WAIT_L(0); PG8_BAR;
            PG8_MMAS(0, 0, At, B0, 1, PG8_STAGE1(PG8_SA(0, 1), a2 + hstepA, voffA, 0), 9, (void)0); PG8_MMAS(0, 1, At, B1, 1, PG8_STAGE1(PG8_SA(0, 1), a2 + hstepA, voffA, 1), 9, (void)0); PG8_BAR; PG8_SCHED;
            PG8_LDA(At, 1, 1); PG8_STAGE(PG8_SB(1, 0), b3, voffB);
            PG8_WAIT_V(4); PG8_WAIT_L(0); PG8_BAR;
            PG8_MMAS(1, 0, At, B0, 0, PG8_STAGE1(PG8_SB(1, 1), b3 + hstepB, voffB, 0), 2, PG8_STAGE1(PG8_SB(1, 1), b3 + hstepB, voffB, 1));
            PG8_MMAS(1, 1, At, B1, 0, PG8_STAGE1(PG8_SA(1, 0), a3, voffA, 0), 2, PG8_STAGE1(PG8_SA(1, 0), a3, voffA, 1)); PG8_BAR; PG8_SCHED;
#else
            PG8_LDB(B0, 0, 0); PG8_LDB(B1, 0, 1); PG8_SCHED; PG8_LDA(At, 0, 0); PG8_STAGE(PG8_SA(1, 1), a1 + hstepA, voffA);
            PG8_WV1; PG8_WAIT_L(0); PG8_BAR; PG8_MMA(0, 0, At, B0); PG8_MMA(0, 1, At, B1); PG8_BAR; PG8_SCHED;
            PG8_LDA(At, 0, 1); PG8_STAGE(PG8_SB(0, 0), b2, voffB); PG8_STAGE(PG8_SB(0, 1), b2 + hstepB, voffB); PG8_STAGE(PG8_SA(0, 0), a2, voffA); PG8_PF(pfa4, pfb4);
            PG8_WV2; PG8_WAIT_L(0); PG8_BAR; PG8_MMA(1, 0, At, B0); PG8_MMA(1, 1, At, B1); PG8_BAR; PG8_SCHED;
            PG8_LDB(B0, 1, 0); PG8_LDB(B1, 1, 1); PG8_SCHED; PG8_LDA(At, 1, 0); PG8_STAGE(PG8_SA(0, 1), a2 + hstepA, voffA);
            PG8_WV1; PG8_WAIT_L(0); PG8_BAR; PG8_MMA(0, 0, At, B0); PG8_MMA(0, 1, At, B1); PG8_BAR; PG8_SCHED;
            PG8_LDA(At, 1, 1); PG8_STAGE(PG8_SB(1, 0), b3, voffB); PG8_STAGE(PG8_SB(1, 1), b3 + hstepB, voffB); PG8_STAGE(PG8_SA(1, 0), a3, voffA); PG8_PF(pfa4 + kstep, pfb4 + kstep);
            PG8_WV2; PG8_WAIT_L(0); PG8_BAR; PG8_MMA(1, 0, At, B0); PG8_MMA(1, 1, At, B1); PG8_BAR; PG8_SCHED;
#endif
            } else {
            PG8_LDB(B0, 0, 0); PG8_SCHED; PG8_LDA(At, 0, 0); PG8_STAGE(PG8_SA(1, 1), a1 + hstepA, voffA);
            PG8_WAIT_L(8); PG8_BAR; PG8_WAIT_L(0); PG8_MMA(0, 0, At, B0); PG8_BAR; PG8_SCHED;
            PG8_LDB(B1, 0, 1); PG8_STAGE(PG8_SB(0, 0), b2, voffB);
            PG8_BAR; PG8_WAIT_L(0); PG8_MMA(0, 1, At, B1); PG8_BAR;
            PG8_LDA(At, 0, 1); PG8_STAGE(PG8_SA(0, 0), a2, voffA);
            PG8_BAR; PG8_WAIT_L(0); PG8_MMA(1, 0, At, B0); PG8_BAR; PG8_SCHED;
            PG8_STAGE(PG8_SB(0, 1), b2 + hstepB, voffB);
            PG8_WAIT_V(6); PG8_BAR; PG8_MMA(1, 1, At, B1); PG8_BAR;
            PG8_LDB(B0, 1, 0); PG8_SCHED; PG8_LDA(At, 1, 0); PG8_STAGE(PG8_SA(0, 1), a2 + hstepA, voffA);
            PG8_WAIT_L(8); PG8_BAR; PG8_WAIT_L(0); PG8_MMA(0, 0, At, B0); PG8_BAR; PG8_SCHED;
            PG8_LDB(B1, 1, 1); PG8_STAGE(PG8_SB(1, 0), b3, voffB);
            PG8_BAR; PG8_WAIT_L(0); PG8_MMA(0, 1, At, B1); PG8_BAR;
            PG8_LDA(At, 1, 1); PG8_STAGE(PG8_SA(1, 0), a3, voffA);
            PG8_BAR; PG8_WAIT_L(0); PG8_MMA(1, 0, At, B0); PG8_BAR; PG8_SCHED;
            PG8_STAGE(PG8_SB(1, 1), b3 + hstepB, voffB);
            PG8_WAIT_V(6); PG8_BAR; PG8_MMA(1, 1, At, B1); PG8_BAR;
            }
                }
        if constexpr (ALIGN_EPI) { if (wr == 0) PG8_BAR; }
        if constexpr (F8 || MIXT > 0) asm volatile("s_nop 15\n\ts_nop 15" ::: "memory");
        if constexpr (!Epi::AFTER_DRAIN) { E(acc, cur, wr, wc, fr, fq); S.done(cur); }
        if (!has_next) break;
#pragma unroll
        for (int a = 0; a < 2; ++a)
#pragma unroll
            for (int b = 0; b < 2; ++b)
#pragma unroll
                for (int m = 0; m < 4; ++m)
#pragma unroll
                    for (int n = 0; n < 2; ++n) acc[a][b][m][n] = (f32x4){0.f, 0.f, 0.f, 0.f};
        cur = nxt; cA = nA; cB = nB; ckr = nkr; ++ui;
        if constexpr (ALIGN_EPI) { if (wr == 1) PG8_BAR; }
    }
    PG8_WAIT_V(0);
    if constexpr (!ALIGN_EPI) { if (wr == 0) PG8_BAR; }
    PG8_BAR;
    if constexpr (Epi::AFTER_DRAIN) { E.fused(acc, cur, wr, wc, fr, fq, lds, wid, lane); S.done(cur); }
#undef PG8_SA
#undef PG8_SB
#undef PG8_STAGE
#undef PG8_PF
#undef PG8_WV1
#undef PG8_WV2
#undef PG8_LDA
#undef PG8_LDB
#undef PG8_MMA
#undef PG8_MMAS
#undef PG8_STAGE1
#undef PG8_WAIT_V
#undef PG8_WAIT_L
#undef PG8_BAR
#undef PG8_SCHED
}
}
namespace pg8 {
__device__ __forceinline__ float sigm(float z) { return __builtin_amdgcn_rcpf(1.0f + __builtin_amdgcn_exp2f(-z * 1.4426950408889634f)); }
typedef unsigned u32x2 __attribute__((ext_vector_type(2)));
__device__ __forceinline__ unsigned pk4f8(const f32x4 v) { int r = __builtin_amdgcn_cvt_pk_fp8_f32(v[0], v[1], 0, false); r = __builtin_amdgcn_cvt_pk_fp8_f32(v[2], v[3], r, true); return (unsigned)r; }
__device__ __forceinline__ u32x4 pack8(const f32x4 v0, const f32x4 v1) { u32x4 w; w.x = cvt_pk_bf16(v0[0], v0[1]); w.y = cvt_pk_bf16(v0[2], v0[3]); w.z = cvt_pk_bf16(v1[0], v1[1]); w.w = cvt_pk_bf16(v1[2], v1[3]); return w; }
__device__ __forceinline__ f32x4 bf_lo4(const u32x4 w) { f32x4 r; r[0] = __uint_as_float(w.x << 16); r[1] = __uint_as_float(w.x & 0xffff0000u); r[2] = __uint_as_float(w.y << 16); r[3] = __uint_as_float(w.y & 0xffff0000u); return r; }
__device__ __forceinline__ f32x4 bf_hi4(const u32x4 w) { f32x4 r; r[0] = __uint_as_float(w.z << 16); r[1] = __uint_as_float(w.z & 0xffff0000u); r[2] = __uint_as_float(w.w << 16); r[3] = __uint_as_float(w.w & 0xffff0000u); return r; }


struct EpiP1 {
    static constexpr bool PERM = true, AFTER_DRAIN = false, KSEG = false;
    bf16_t* P1; bf16_t* MKV; const float* bgate;
    __device__ __forceinline__ void operator()(const f32x4 (&acc)[2][2][4][2], const Unit& u, int wr, int wc, int fr, int fq) const {
        const bool mem = u.pn >= 41, gate = (!mem) && u.pn >= 17;
        bf16_t* base = mem ? MKV + (size_t)((u.pm - 64) * BM + wr * 64 + fr) * 2048 + (u.pn - 41) * BM : P1 + (size_t)(u.pm * BM + wr * 64 + fr) * 10496 + u.pn * BM;
        const size_t ldc = mem ? 2048 : 10496;
        base += wc * 32 + 8 * fq;
        f32x4 bv[2][2];
#pragma unroll
        for (int bj = 0; bj < 2; ++bj)
#pragma unroll
            for (int n = 0; n < 2; ++n) bv[bj][n] = gate ? *(const f32x4*)(bgate + (u.pn - 17) * BM + wc * 32 + 8 * fq + bj * HALF + 4 * n) : (f32x4){0.f, 0.f, 0.f, 0.f};
#pragma unroll
        for (int ai = 0; ai < 2; ++ai)
#pragma unroll
            for (int m = 0; m < 4; ++m) { bf16_t* rowp = base + (size_t)(ai * HALF + m * 16) * ldc;
#pragma unroll
                for (int bj = 0; bj < 2; ++bj) { f32x4 v0 = acc[ai][bj][m][0] + bv[bj][0], v1 = acc[ai][bj][m][1] + bv[bj][1];
                    if (gate) {
#pragma unroll
                        for (int i = 0; i < 4; ++i) { v0[i] = sigm(v0[i]); v1[i] = sigm(v1[i]); } }
                    *(u32x4*)(rowp + bj * HALF) = pack8(v0, v1); } }
    }
};
struct EpiGate {
    static constexpr bool PERM = true, AFTER_DRAIN = false, KSEG = false;
    bf16_t* P1; const float* bgate;
    __device__ __forceinline__ void operator()(const f32x4 (&acc)[2][2][4][2], const Unit& u, int wr, int wc, int fr, int fq) const {
        bf16_t* base = P1 + (size_t)(u.pm * BM + wr * 64 + fr) * 10496 + 4352 + u.pn * BM + wc * 32 + 8 * fq;
        f32x4 bv[2][2];
#pragma unroll
        for (int bj = 0; bj < 2; ++bj)
#pragma unroll
            for (int n = 0; n < 2; ++n) bv[bj][n] = *(const f32x4*)(bgate + u.pn * BM + wc * 32 + 8 * fq + bj * HALF + 4 * n);
#pragma unroll
        for (int ai = 0; ai < 2; ++ai)
#pragma unroll
            for (int m = 0; m < 4; ++m) { bf16_t* rowp = base + (size_t)(ai * HALF + m * 16) * 10496;
#pragma unroll
                for (int bj = 0; bj < 2; ++bj) { f32x4 v0 = acc[ai][bj][m][0] + bv[bj][0], v1 = acc[ai][bj][m][1] + bv[bj][1];
#pragma unroll
                    for (int i = 0; i < 4; ++i) { v0[i] = sigm(v0[i]); v1[i] = sigm(v1[i]); }
                    *(u32x4*)(rowp + bj * HALF) = pack8(v0, v1); } }
    }
};
struct EpiPlain {
    static constexpr bool PERM = true, AFTER_DRAIN = false, KSEG = false;
    bf16_t* O; int ldc;
    __device__ __forceinline__ void operator()(const f32x4 (&acc)[2][2][4][2], const Unit& u, int wr, int wc, int fr, int fq) const {
        bf16_t* base = O + (size_t)(u.pm * BM + wr * 64 + fr) * ldc + u.pn * BM + wc * 32 + 8 * fq;
#pragma unroll
        for (int ai = 0; ai < 2; ++ai)
#pragma unroll
            for (int m = 0; m < 4; ++m) { bf16_t* rowp = base + (size_t)(ai * HALF + m * 16) * ldc;
#pragma unroll
                for (int bj = 0; bj < 2; ++bj) *(u32x4*)(rowp + bj * HALF) = pack8(acc[ai][bj][m][0], acc[ai][bj][m][1]); }
    }
};
template <bool FIRST> struct EpiGateAcc {
    static constexpr bool PERM = true, AFTER_DRAIN = false, KSEG = false;
    const bf16_t* G; int gcol0; bf16_t* Mg;
    __device__ __forceinline__ void operator()(const f32x4 (&acc)[2][2][4][2], const Unit& u, int wr, int wc, int fr, int fq) const {
        const int row0 = u.pm * BM + wr * 64 + fr, col0 = u.pn * BM + wc * 32 + 8 * fq;
#pragma unroll
        for (int ai = 0; ai < 2; ++ai)
#pragma unroll
            for (int m = 0; m < 4; ++m) { const size_t r = (size_t)(row0 + ai * HALF + m * 16);
#pragma unroll
                for (int bj = 0; bj < 2; ++bj) {
                    const u32x4 gw = *(const u32x4*)(G + r * 10496 + gcol0 + col0 + bj * HALF);
                    f32x4 v0 = acc[ai][bj][m][0] * bf_lo4(gw), v1 = acc[ai][bj][m][1] * bf_hi4(gw);
                    bf16_t* mp = Mg + r * 2048 + col0 + bj * HALF;
                    if (!FIRST) { const u32x4 ow = *(const u32x4*)mp; v0 = v0 + bf_lo4(ow); v1 = v1 + bf_hi4(ow); }
                    *(u32x4*)mp = pack8(v0, v1); } }
    }
};
__device__ __forceinline__ float rowsq8(const f32x4 a, const f32x4 b) { return (a[0] * a[0] + a[1] * a[1]) + (a[2] * a[2] + a[3] * a[3]) + (b[0] * b[0] + b[1] * b[1]) + (b[2] * b[2] + b[3] * b[3]); }
struct EpiKV {
    static constexpr bool PERM = true, AFTER_DRAIN = false, KSEG = false;
    PG8_LAS float* P; const float* kn_g; const float* krss; const float* krr; bf16_t* KFT; bf16_t* VFT;
    __device__ __forceinline__ void operator()(const f32x4 (&acc)[2][2][4][2], const Unit& u, int wr, int wc, int fr, int fq) const {
        asm volatile("" : "+v"(fr), "+v"(fq));
        const int h = u.pn, b = u.pm >> 4, tq = (u.pm & 15) * 4;
#pragma unroll
        for (int ai = 0; ai < 2; ++ai)
#pragma unroll
            for (int m = 0; m < 4; ++m) { float s = rowsq8(acc[ai][0][m][0], acc[ai][0][m][1]); if (XL_FAST) s = xl_swap32_sum(xl_swap16_sum(s)); else { s += __shfl_xor(s, 16); s += __shfl_xor(s, 32); }
                if (fq == 0) P[(ai * HALF + wr * 64 + m * 16 + fr) * 4 + wc] = s; }
        asm volatile("s_waitcnt lgkmcnt(0)" ::: "memory"); __builtin_amdgcn_s_barrier(); asm volatile("" ::: "memory");
        const f32x4 g0 = *(const f32x4*)(kn_g + wc * 32 + 8 * fq), g1 = *(const f32x4*)(kn_g + wc * 32 + 8 * fq + 4);
#pragma unroll
        for (int ai = 0; ai < 2; ++ai)
#pragma unroll
            for (int m = 0; m < 4; ++m) { const int row = ai * HALF + wr * 64 + m * 16 + fr, key = m * 16 + fr; const size_t t = (size_t)u.pm * BM + row;
                const f32x4 p4 = *(const PG8_LAS f32x4*)(P + row * 4);
                const float rs = 1.0f * FAST_RSQ(((p4[0] + p4[1]) + (p4[2] + p4[3]) + krss[t]) * (1.f / 192.f) + 1e-6f);
                const size_t tile = (size_t)(b * 16 + h) * 64 + tq + 2 * ai + wr;
                bf16_t* kb = KFT + tile * 12288 + key * 8;
                *(u32x4*)(kb + (4 * wc + fq) * 512) = pack8(acc[ai][0][m][0] * g0 * rs, acc[ai][0][m][1] * g1 * rs);
                *(u32x4*)(VFT + tile * 8192 + wc * 2048 + key * 32 + 8 * fq) = pack8(acc[ai][1][m][0], acc[ai][1][m][1]);
                if (fq < 2) { const int c = 2 * wc + fq; const f32x4 r0 = *(const f32x4*)(krr + t * 64 + 8 * c), r1 = *(const f32x4*)(krr + t * 64 + 8 * c + 4);
                    *(u32x4*)(kb + (16 + c) * 512) = pack8(r0 * rs, r1 * rs); }
                asm volatile("" ::: "memory"); }
    }
};
struct EpiQ {
    static constexpr bool PERM = true, AFTER_DRAIN = false, KSEG = false;
    PG8_LAS float* P; const float* qn_g; const float* rope; bf16_t* QF; float qscale;
    __device__ __forceinline__ void operator()(const f32x4 (&acc)[2][2][4][2], const Unit& u, int wr, int wc, int fr, int fq) const {
        asm volatile("" : "+v"(fr), "+v"(fq));
        const int h = u.pn, b = u.pm >> 4;
#pragma unroll
        for (int ai = 0; ai < 2; ++ai)
#pragma unroll
            for (int m = 0; m < 4; ++m) { float s = rowsq8(acc[ai][0][m][0], acc[ai][0][m][1]); if (wc < 2) s += rowsq8(acc[ai][1][m][0], acc[ai][1][m][1]);
                if (XL_FAST) s = xl_swap32_sum(xl_swap16_sum(s)); else { s += __shfl_xor(s, 16); s += __shfl_xor(s, 32); }
                if (fq == 0) P[(ai * HALF + wr * 64 + m * 16 + fr) * 4 + wc] = s; }
        asm volatile("s_waitcnt lgkmcnt(0)" ::: "memory"); __builtin_amdgcn_s_barrier(); asm volatile("" ::: "memory");
        const f32x4 g0 = *(const f32x4*)(qn_g + wc * 32 + 8 * fq) * qscale, g1 = *(const f32x4*)(qn_g + wc * 32 + 8 * fq + 4) * qscale;
        const int j = 4 * (4 * (wc & 1) + fq);
        const f32x4 gr1 = *(const f32x4*)(qn_g + 128 + j) * qscale, gr2 = *(const f32x4*)(qn_g + 160 + j) * qscale;
#pragma unroll
        for (int ai = 0; ai < 2; ++ai)
#pragma unroll
            for (int m = 0; m < 4; ++m) { const int row = ai * HALF + wr * 64 + m * 16 + fr; const size_t t = (size_t)u.pm * BM + row;
                const f32x4 p4 = *(const PG8_LAS f32x4*)(P + row * 4);
                const float rs = 1.0f * FAST_RSQ(((p4[0] + p4[1]) + (p4[2] + p4[3])) * (1.f / 192.f) + 1e-6f);
                bf16_t* qb = QF + ((size_t)(b * 16 + h) * 4096 + (t & 4095)) * 192;
                *(u32x4*)(qb + wc * 32 + 8 * fq) = pack8(acc[ai][0][m][0] * g0 * rs, acc[ai][0][m][1] * g1 * rs);
                if (wc < 2) { const f32x4 c4 = *(const f32x4*)(rope + t * 64 + j), s4 = *(const f32x4*)(rope + t * 64 + 32 + j);
                    const f32x4 t1 = acc[ai][1][m][0] * gr1 * rs, t2 = acc[ai][1][m][1] * gr2 * rs;
                    const f32x4 o1 = t1 * c4 - t2 * s4, o2 = t1 * s4 + t2 * c4;
                    u32x2 w1; w1.x = cvt_pk_bf16(o1[0], o1[1]); w1.y = cvt_pk_bf16(o1[2], o1[3]); *(u32x2*)(qb + 128 + j) = w1;
                    u32x2 w2; w2.x = cvt_pk_bf16(o2[0], o2[1]); w2.y = cvt_pk_bf16(o2[2], o2[3]); *(u32x2*)(qb + 160 + j) = w2; }
                asm volatile("" ::: "memory"); }
    }
};
__device__ __forceinline__ unsigned pk4f8s(const f32x4 v, float s) { int r = __builtin_amdgcn_cvt_pk_fp8_f32(v[0] * s, v[1] * s, 0, false); r = __builtin_amdgcn_cvt_pk_fp8_f32(v[2] * s, v[3] * s, r, true); return (unsigned)r; }
struct EpiKV8 {
    static constexpr bool PERM = true, AFTER_DRAIN = false, KSEG = false;
    PG8_LAS float* P; const float* kn_g; const float* krss; const float* krr; unsigned char* K8; unsigned char* V8;
    __device__ __forceinline__ void operator()(const f32x4 (&acc)[2][2][4][2], const Unit& u, int wr, int wc, int fr, int fq) const {
        asm volatile("" : "+v"(fr), "+v"(fq));
        const int h = u.pn, b = u.pm >> 4, tq = (u.pm & 15) * 4;
#pragma unroll
        for (int ai = 0; ai < 2; ++ai)
#pragma unroll
            for (int m = 0; m < 4; ++m) { float s = rowsq8(acc[ai][0][m][0], acc[ai][0][m][1]); if (XL_FAST) s = xl_swap32_sum(xl_swap16_sum(s)); else { s += __shfl_xor(s, 16); s += __shfl_xor(s, 32); }
                if (fq == 0) P[(ai * HALF + wr * 64 + m * 16 + fr) * 4 + wc] = s; }
        asm volatile("s_waitcnt lgkmcnt(0)" ::: "memory"); __builtin_amdgcn_s_barrier(); asm volatile("" ::: "memory");
        const f32x4 g0 = *(const f32x4*)(kn_g + wc * 32 + 8 * fq), g1 = *(const f32x4*)(kn_g + wc * 32 + 8 * fq + 4);
#pragma unroll
        for (int ai = 0; ai < 2; ++ai)
#pragma unroll
            for (int m = 0; m < 4; ++m) { const int row = ai * HALF + wr * 64 + m * 16 + fr, key = m * 16 + fr; const size_t t = (size_t)u.pm * BM + row;
                const f32x4 p4 = *(const PG8_LAS f32x4*)(P + row * 4);
                const float rs = 1.0f * FAST_RSQ(((p4[0] + p4[1]) + (p4[2] + p4[3]) + krss[t]) * (1.f / 192.f) + 1e-6f);
                const size_t tile = (size_t)(b * 16 + h) * 64 + tq + 2 * ai + wr;
                unsigned char* kb = K8 + tile * 12288 + key * 16;
                { u32x2 w; w.x = pk4f8s(acc[ai][0][m][0] * g0, rs); w.y = pk4f8s(acc[ai][0][m][1] * g1, rs); *(u32x2*)(kb + (2 * wc + (fq >> 1)) * 1024 + 8 * (fq & 1)) = w; }
                if (fq < 2) { const f32x4 r0 = *(const f32x4*)(krr + t * 64 + 16 * wc + 8 * fq), r1 = *(const f32x4*)(krr + t * 64 + 16 * wc + 8 * fq + 4);
                    u32x2 w; w.x = pk4f8s(r0, rs); w.y = pk4f8s(r1, rs); *(u32x2*)(kb + (8 + wc) * 1024 + 8 * fq) = w; }
                const int p = 32 * ((fr >> 2) & 1) + 16 * (m >> 1) + (fr & 3) + 4 * (2 * (m & 1) + (fr >> 3));
                unsigned char* vb = V8 + tile * 8192 + (p >> 4) * 2048 + (size_t)(wc * 32 + 8 * fq) * 16 + (p & 15);
                const unsigned w0 = pk4f8s(acc[ai][1][m][0], 1.0f), w1 = pk4f8s(acc[ai][1][m][1], 1.0f);
                vb[0] = (unsigned char)w0; vb[16] = (unsigned char)(w0 >> 8); vb[32] = (unsigned char)(w0 >> 16); vb[48] = (unsigned char)(w0 >> 24);
                vb[64] = (unsigned char)w1; vb[80] = (unsigned char)(w1 >> 8); vb[96] = (unsigned char)(w1 >> 16); vb[112] = (unsigned char)(w1 >> 24);
                asm volatile("" ::: "memory"); }
    }
};
struct EpiQ8 {
    static constexpr bool PERM = true, AFTER_DRAIN = false, KSEG = false;
    PG8_LAS float* P; const float* qn_g; const float* rope; unsigned char* Q8; float qscale;
    __device__ __forceinline__ void operator()(const f32x4 (&acc)[2][2][4][2], const Unit& u, int wr, int wc, int fr, int fq) const {
        asm volatile("" : "+v"(fr), "+v"(fq));
        const int h = u.pn, b = u.pm >> 4;
#pragma unroll
        for (int ai = 0; ai < 2; ++ai)
#pragma unroll
            for (int m = 0; m < 4; ++m) { float s = rowsq8(acc[ai][0][m][0], acc[ai][0][m][1]); if (wc < 2) s += rowsq8(acc[ai][1][m][0], acc[ai][1][m][1]);
                if (XL_FAST) s = xl_swap32_sum(xl_swap16_sum(s)); else { s += __shfl_xor(s, 16); s += __shfl_xor(s, 32); }
                if (fq == 0) P[(ai * HALF + wr * 64 + m * 16 + fr) * 4 + wc] = s; }
        asm volatile("s_waitcnt lgkmcnt(0)" ::: "memory"); __builtin_amdgcn_s_barrier(); asm volatile("" ::: "memory");
        const f32x4 g0 = *(const f32x4*)(qn_g + wc * 32 + 8 * fq) * qscale, g1 = *(const f32x4*)(qn_g + wc * 32 + 8 * fq + 4) * qscale;
        const int j = 4 * (4 * (wc & 1) + fq);
        const f32x4 gr1 = *(const f32x4*)(qn_g + 128 + j) * qscale, gr2 = *(const f32x4*)(qn_g + 160 + j) * qscale;
#pragma unroll
        for (int ai = 0; ai < 2; ++ai)
#pragma unroll
            for (int m = 0; m < 4; ++m) { const int row = ai * HALF + wr * 64 + m * 16 + fr; const size_t t = (size_t)u.pm * BM + row;
                const f32x4 p4 = *(const PG8_LAS f32x4*)(P + row * 4);
                const float rs = 1.0f * FAST_RSQ(((p4[0] + p4[1]) + (p4[2] + p4[3])) * (1.f / 192.f) + 1e-6f);
                unsigned char* qb = Q8 + ((size_t)(b * 16 + h) * 4096 + (t & 4095)) * 192;
                { u32x2 w; w.x = pk4f8s(acc[ai][0][m][0] * g0, rs); w.y = pk4f8s(acc[ai][0][m][1] * g1, rs); *(u32x2*)(qb + wc * 32 + 8 * fq) = w; }
                if (wc < 2) { const f32x4 c4 = *(const f32x4*)(rope + t * 64 + j), s4 = *(const f32x4*)(rope + t * 64 + 32 + j);
                    const f32x4 t1 = acc[ai][1][m][0] * gr1 * rs, t2 = acc[ai][1][m][1] * gr2 * rs;
                    *(unsigned*)(qb + 128 + j) = pk4f8s(t1 * c4 - t2 * s4, 1.0f); *(unsigned*)(qb + 160 + j) = pk4f8s(t1 * s4 + t2 * c4, 1.0f); }
                asm volatile("" ::: "memory"); }
    }
};
template <int T1_, int T2_> struct EpiMergedT {
    static constexpr bool PERM = true, AFTER_DRAIN = false, KSEG = true; static constexpr int KSEG_T1 = T1_, KSEG_T2 = T2_;
    const bf16_t* G; bf16_t* Mg;
    __device__ __forceinline__ void kseg(f32x4 (&acc)[2][2][4][2], const Unit& u, int t, int wr, int wc, int fr, int fq) const {
        const bf16_t* gp = G + (size_t)(u.pm * BM + wr * 64 + fr) * 10496 + 4352 + (t == KSEG_T1 ? 0 : 2048) + u.pn * BM + wc * 32 + 8 * fq;
#if KSEG_BATCH16
#pragma unroll
        for (int ai = 0; ai < 2; ++ai) {
            u32x4 gn[4][2], gd[4][2];
#pragma unroll
            for (int m = 0; m < 4; ++m)
#pragma unroll
                for (int bj = 0; bj < 2; ++bj) { const bf16_t* p = gp + (size_t)(ai * HALF + m * 16) * 10496 + bj * HALF; gn[m][bj] = *(const u32x4*)p; gd[m][bj] = *(const u32x4*)(p + 2048); }
#pragma unroll
            for (int m = 0; m < 4; ++m)
#pragma unroll
                for (int bj = 0; bj < 2; ++bj) {
                    f32x4 r0 = bf_lo4(gd[m][bj]), r1 = bf_hi4(gd[m][bj]);
#pragma unroll
                    for (int i = 0; i < 4; ++i) { r0[i] = __builtin_amdgcn_rcpf(r0[i]); r1[i] = __builtin_amdgcn_rcpf(r1[i]); }
                    acc[ai][bj][m][0] = acc[ai][bj][m][0] * (bf_lo4(gn[m][bj]) * r0); acc[ai][bj][m][1] = acc[ai][bj][m][1] * (bf_hi4(gn[m][bj]) * r1); }
            asm volatile("" : "+v"(acc[ai][0][0][0]), "+v"(acc[ai][0][0][1]), "+v"(acc[ai][1][0][0]), "+v"(acc[ai][1][0][1]), "+v"(acc[ai][0][1][0]), "+v"(acc[ai][0][1][1]), "+v"(acc[ai][1][1][0]), "+v"(acc[ai][1][1][1]),
                         "+v"(acc[ai][0][2][0]), "+v"(acc[ai][0][2][1]), "+v"(acc[ai][1][2][0]), "+v"(acc[ai][1][2][1]), "+v"(acc[ai][0][3][0]), "+v"(acc[ai][0][3][1]), "+v"(acc[ai][1][3][0]), "+v"(acc[ai][1][3][1]) :: "memory");
        }
    }
#else
#pragma unroll
        for (int ai = 0; ai < 2; ++ai)
#pragma unroll
            for (int mp = 0; mp < 2; ++mp) {
                u32x4 gn[2][2], gd[2][2];
#pragma unroll
                for (int mm = 0; mm < 2; ++mm)
#pragma unroll
                    for (int bj = 0; bj < 2; ++bj) { const bf16_t* p = gp + (size_t)(ai * HALF + (2 * mp + mm) * 16) * 10496 + bj * HALF; gn[mm][bj] = *(const u32x4*)p; gd[mm][bj] = *(const u32x4*)(p + 2048); }
#pragma unroll
                for (int mm = 0; mm < 2; ++mm)
#pragma unroll
                    for (int bj = 0; bj < 2; ++bj) { const int m = 2 * mp + mm;
                        f32x4 r0 = bf_lo4(gd[mm][bj]), r1 = bf_hi4(gd[mm][bj]);
#pragma unroll
                        for (int i = 0; i < 4; ++i) { r0[i] = __builtin_amdgcn_rcpf(r0[i]); r1[i] = __builtin_amdgcn_rcpf(r1[i]); }
                        acc[ai][bj][m][0] = acc[ai][bj][m][0] * (bf_lo4(gn[mm][bj]) * r0); acc[ai][bj][m][1] = acc[ai][bj][m][1] * (bf_hi4(gn[mm][bj]) * r1); }
                asm volatile("" : "+v"(acc[ai][0][2 * mp][0]), "+v"(acc[ai][0][2 * mp][1]), "+v"(acc[ai][1][2 * mp][0]), "+v"(acc[ai][1][2 * mp][1]), "+v"(acc[ai][0][2 * mp + 1][0]), "+v"(acc[ai][0][2 * mp + 1][1]), "+v"(acc[ai][1][2 * mp + 1][0]), "+v"(acc[ai][1][2 * mp + 1][1]) :: "memory");
            }
    }
#endif
    __device__ __forceinline__ void operator()(const f32x4 (&acc)[2][2][4][2], const Unit& u, int wr, int wc, int fr, int fq) const {
        const int row0 = u.pm * BM + wr * 64 + fr, col0 = u.pn * BM + wc * 32 + 8 * fq;
#pragma unroll
        for (int ai = 0; ai < 2; ++ai)
#pragma unroll
            for (int m = 0; m < 4; ++m) { const size_t r = (size_t)(row0 + ai * HALF + m * 16);
#pragma unroll
                for (int bj = 0; bj < 2; ++bj) {
                    const u32x4 gw = *(const u32x4*)(G + r * 10496 + 4352 + 4096 + col0 + bj * HALF);
                    *(u32x4*)(Mg + r * 2048 + col0 + bj * HALF) = pack8(acc[ai][bj][m][0] * bf_lo4(gw), acc[ai][bj][m][1] * bf_hi4(gw)); } }
    }
};
struct EpiX1 {
    static constexpr bool PERM = true, AFTER_DRAIN = false, KSEG = false;
    const float* X; bf16_t* O;
    __device__ __forceinline__ void operator()(const f32x4 (&acc)[2][2][4][2], const Unit& u, int wr, int wc, int fr, int fq) const {
        const int row0 = u.pm * BM + wr * 64 + fr, col0 = u.pn * BM + wc * 32 + 8 * fq;
#if EPIX1_BATCH
#pragma unroll
        for (int ai = 0; ai < 2; ++ai) {
            f32x4 xv[4][2][2];
#pragma unroll
            for (int m = 0; m < 4; ++m) { const size_t off = (size_t)(row0 + ai * HALF + m * 16) * 2048 + col0;
#pragma unroll
                for (int bj = 0; bj < 2; ++bj) { xv[m][bj][0] = *(const f32x4*)(X + off + bj * HALF); xv[m][bj][1] = *(const f32x4*)(X + off + bj * HALF + 4); } }
#pragma unroll
            for (int m = 0; m < 4; ++m) { const size_t off = (size_t)(row0 + ai * HALF + m * 16) * 2048 + col0;
#pragma unroll
                for (int bj = 0; bj < 2; ++bj) *(u32x4*)(O + off + bj * HALF) = pack8(xv[m][bj][0] + acc[ai][bj][m][0], xv[m][bj][1] + acc[ai][bj][m][1]); }
            asm volatile("" ::: "memory");
        }
    }
};
#else
#pragma unroll
        for (int ai = 0; ai < 2; ++ai)
#pragma unroll
            for (int m = 0; m < 4; ++m) { const size_t off = (size_t)(row0 + ai * HALF + m * 16) * 2048 + col0;
#pragma unroll
                for (int bj = 0; bj < 2; ++bj) { const f32x4 x0 = *(const f32x4*)(X + off + bj * HALF), x1 = *(const f32x4*)(X + off + bj * HALF + 4);
                    *(u32x4*)(O + off + bj * HALF) = pack8(x0 + acc[ai][bj][m][0], x1 + acc[ai][bj][m][1]); } }
    }
};
#endif
struct EpiSwiGLU {
    static constexpr bool PERM = true, AFTER_DRAIN = false, KSEG = false;
    const float* bgu; unsigned char* ACT;
    __device__ __forceinline__ void operator()(const f32x4 (&acc)[2][2][4][2], const Unit& u, int wr, int wc, int fr, int fq) const {
        const int e = u.pn >> 4, pnl = u.pn & 15, cl = pnl * HALF + wc * 32 + 8 * fq;
        const float* bp = bgu + (size_t)e * 4096 + cl;
        f32x4 bg[2], bu[2];
#pragma unroll
        for (int n = 0; n < 2; ++n) { bg[n] = *(const f32x4*)(bp + 4 * n); bu[n] = *(const f32x4*)(bp + 2048 + 4 * n); }
        unsigned char* base = ACT + (size_t)(u.pm * BM + wr * 64 + fr) * 2048 + cl;
#pragma unroll
        for (int ai = 0; ai < 2; ++ai)
#pragma unroll
            for (int m = 0; m < 4; ++m) { f32x4 o[2];
#pragma unroll
                for (int n = 0; n < 2; ++n) { const f32x4 g4 = acc[ai][0][m][n] + bg[n], u4 = acc[ai][1][m][n] + bu[n];
#pragma unroll
                    for (int i = 0; i < 4; ++i) { const float g = fminf(g4[i], 7.0f), up = fminf(fmaxf(u4[i], -7.0f), 7.0f); o[n][i] = (up + 1.0f) * g * sigm(1.702f * g); } }
                u32x2 w8; w8.x = pk4f8(o[0]); w8.y = pk4f8(o[1]); *(u32x2*)(base + (size_t)(ai * HALF + m * 16) * 2048) = w8; }
    }
};
template <int P_> struct EpiSwiGLUProbe : EpiSwiGLU { static constexpr int PROBE = P_;
    __device__ __forceinline__ void operator()(const f32x4 (&)[2][2][4][2], const Unit&, int, int, int, int) const {} };

struct EpiDown {
    static constexpr bool PERM = true, AFTER_DRAIN = false, KSEG = false;
    const float* bd; unsigned char* Y;
    __device__ __forceinline__ void operator()(const f32x4 (&acc)[2][2][4][2], const Unit& u, int wr, int wc, int fr, int fq) const {
        const int e = u.pn >> 3, pnl = u.pn & 7, cl = pnl * BM + wc * 32 + 8 * fq;
        const float* bp = bd + (size_t)e * 2048 + cl;
        f32x4 bv[2][2];
#pragma unroll
        for (int bj = 0; bj < 2; ++bj)
#pragma unroll
            for (int n = 0; n < 2; ++n) bv[bj][n] = *(const f32x4*)(bp + bj * HALF + 4 * n);
        unsigned char* base = Y + (size_t)(u.pm * BM + wr * 64 + fr) * 2048 + cl;
#pragma unroll
        for (int ai = 0; ai < 2; ++ai)
#pragma unroll
            for (int m = 0; m < 4; ++m) { unsigned char* rowp = base + (size_t)(ai * HALF + m * 16) * 2048;
#pragma unroll
                for (int bj = 0; bj < 2; ++bj) { u32x2 w; w.x = pk4f8(acc[ai][bj][m][0] + bv[bj][0]); w.y = pk4f8(acc[ai][bj][m][1] + bv[bj][1]); *(u32x2*)(rowp + bj * HALF) = w; } }
    }
};

struct P1Order {
    StaticOrder base; int i_off, i_lim;
    __device__ void init(int G_, int c_, int i_off_, int i_lim_) { base.init(16384, (GATE_F8 ? (UV_F8 == 2 ? 4 : 8) : 41) * 256, G_, c_); i_off = i_off_; i_lim = i_lim_; }
    __device__ bool next(int i_, Unit& u) const {
        const int i = i_ + i_off; if (i >= i_lim) return false;
        const long L = (long)i * base.G + base.c;
        if (L < base.nwg) return base.next(i, u);
        const int j = (int)(L - base.nwg); if (GATE_F8 || j >= 32) return false;
        u.pm = 64 + (j & 3); u.pn = 41 + (j >> 2); return true;
    }
    __device__ __forceinline__ void a_ready(const Unit&) const {}
    __device__ __forceinline__ void done(const Unit&) const {}
};
struct GateOrder {
    StaticOrder base;
    __device__ void init(int G_, int c_) { base.init(16384, (UV_F8 == 1 ? 41 : UV_F8 == 2 ? 37 : 33) * 256, G_, c_); }
    __device__ bool next(int i, Unit& u) const {
        const long L = (long)i * base.G + base.c;
        if (L < base.nwg) { base.next(i, u); u.pn += (UV_F8 == 1 ? 0 : UV_F8 == 2 ? 4 : 8); return true; }
        const int j = (int)(L - base.nwg);
        if (j < 32) { u.pm = 64 + (j & 3); u.pn = 41 + (j >> 2); return true; }
        return false;
    }
    __device__ __forceinline__ void a_ready(const Unit&) const {}
    __device__ __forceinline__ void done(const Unit&) const {}
};
struct MoeOrder {
    const PG8_LAS int* tab; int NT, x, j;
    __device__ bool next(int i, Unit& u) const {
#if MOE_MAP2
        const int g = NT >> 2, Lx = i * 32 + j, rbi = Lx / g, s = Lx - rbi * g, rb = 2 * rbi + (x >> 2);
        if (rb >= __builtin_amdgcn_readfirstlane(tab[32])) return false;
#if CNT_SPREAD
        const int e = __builtin_amdgcn_readfirstlane((int)((const PG8_LAS unsigned char*)(tab + 136))[rb]);
#else
        int e = 0;
        while (__builtin_amdgcn_readfirstlane(tab[e + 1]) <= rb) ++e;
#endif
        u.pm = rb; u.pn = e * NT + (x & 3) + 4 * s; u.kr = 0; return true;
#else
        const int ntx = NT >> 3, Lx = i * 32 + j, rb = Lx / ntx, s = Lx - rb * ntx;
        if (rb >= __builtin_amdgcn_readfirstlane(tab[32])) return false;
#if CNT_SPREAD
        const int e = __builtin_amdgcn_readfirstlane((int)((const PG8_LAS unsigned char*)(tab + 136))[rb]);
#else
        int e = 0;
        while (__builtin_amdgcn_readfirstlane(tab[e + 1]) <= rb) ++e;
#endif
        u.pm = rb; u.pn = e * NT + x + 8 * s; u.kr = (rb + 4 * s) & 7; return true;
#endif
    }
    __device__ __forceinline__ void a_ready(const Unit&) const {}
    __device__ __forceinline__ void done(const Unit&) const {}
};
}
#define GAS __attribute__((address_space(1)))
#define LAS __attribute__((address_space(3)))
typedef unsigned short bf16;
typedef unsigned v4u __attribute__((ext_vector_type(4)));
typedef float f32x4 __attribute__((ext_vector_type(4)));
typedef short bf16x8 __attribute__((ext_vector_type(8)));
typedef GAS unsigned gu32;
typedef GAS unsigned long long gu64;
#define RLX_AGENT __ATOMIC_RELAXED, __HIP_MEMORY_SCOPE_AGENT
#define LDS_WAIT() asm volatile("s_waitcnt lgkmcnt(0)" ::: "memory")
#define VM_WAIT() asm volatile("s_waitcnt vmcnt(0)" ::: "memory")
__device__ __forceinline__ unsigned long long rt() { return __builtin_amdgcn_s_memrealtime(); }
__device__ __forceinline__ unsigned f2bf(float f) { unsigned u = __builtin_bit_cast(unsigned, f); return (u + 0x7fffu + ((u >> 16) & 1u)) >> 16; }
__device__ __forceinline__ unsigned pk2(float lo, float hi) { return f2bf(lo) | (f2bf(hi) << 16); }
#define XB_TMO      128
#define XB_XCNT(j)  (256  + 64 * (j))
#define XB_XSUB(j)  (1280 + 64 * (j))
#define XB_XGEN(j)  (2304 + 64 * (j))
#define XB_TOP      3328
#define XB_TOPGEN   3392
#define XCD_BAR_WORDS 3456
#define XB_SPIN_CAP (1u << 18)

__device__ __forceinline__ unsigned xb_ld(unsigned* p)              { return __hip_atomic_load(p, __ATOMIC_RELAXED, __HIP_MEMORY_SCOPE_AGENT); }
__device__ __forceinline__ unsigned xb_add(unsigned* p, unsigned v) { return __hip_atomic_fetch_add(p, v, __ATOMIC_RELAXED, __HIP_MEMORY_SCOPE_AGENT); }
__device__ __forceinline__ unsigned xb_xcc_id() { return (unsigned)__builtin_amdgcn_s_getreg((3 << 11) | 20) & 0xFu; }
#define XB_SPIN(cond, bar) do { unsigned _sp = 0; while (cond) { __builtin_amdgcn_s_sleep(1); \
    if ((++_sp & 255u) == 0u) { if (xb_ld(&(bar)[XB_TMO])) break; if (_sp > XB_SPIN_CAP) { atomicAdd(&(bar)[XB_TMO], 1u); break; } } } } while (0)

struct XcdBarrier {
    unsigned* bar; unsigned x;
    volatile LAS unsigned* st;
};

__device__ __forceinline__ XcdBarrier xcd_barrier_post(unsigned* bar, volatile LAS unsigned* st) {
    XcdBarrier b; b.bar = bar; b.x = xb_xcc_id(); b.st = st;
    if (threadIdx.x == 0) (void)xb_add(&bar[XB_XCNT(b.x)], 1u);
    return b;
}
__device__ __forceinline__ void xcd_barrier_complete(unsigned* bar, unsigned x, unsigned& nloc, unsigned& nx) {
    const unsigned G = gridDim.x * gridDim.y * gridDim.z;
    unsigned sum, cnt, mine, sp = 0u;
    for (;;) {
        sum = 0u; cnt = 0u; mine = 0u;
#pragma unroll
        for (unsigned j = 0; j < 16; ++j) { const unsigned c = xb_ld(&bar[XB_XCNT(j)]); sum += c; cnt += (c > 0u) ? 1u : 0u; mine = (j == x) ? c : mine; }
        if (sum == G) break;
        __builtin_amdgcn_s_sleep(1);
        if ((++sp & 255u) == 0u) { if (xb_ld(&bar[XB_TMO])) break; if (sp > XB_SPIN_CAP) { atomicAdd(&bar[XB_TMO], 1u); break; } }
    }
    nloc = mine > 0u ? mine : 1u; nx = cnt > 0u ? cnt : 1u;
}

__device__ __forceinline__ void xcd_barrier(const XcdBarrier& b) {
    asm volatile("s_waitcnt vmcnt(0)" ::: "memory");
    __syncthreads();
    if (threadIdx.x == 0) {
        unsigned* bar = b.bar;
        __builtin_amdgcn_s_waitcnt(0);
        unsigned nloc = b.st[0], nx = b.st[1];
        if (nloc == 0u) { xcd_barrier_complete(bar, b.x, nloc, nx); b.st[0] = nloc; b.st[1] = nx; }
        const unsigned old = xb_add(&bar[XB_XSUB(b.x)], 1u);
        const unsigned gen = old / nloc;
        if (old + 1u == (gen + 1u) * nloc) {
            __builtin_amdgcn_fence(__ATOMIC_RELEASE, "agent");
            asm volatile("s_waitcnt vmcnt(0)" ::: "memory");
            const unsigned og = xb_add(&bar[XB_TOP], 1u);
            const unsigned tg = og / nx;
            if (og + 1u == (tg + 1u) * nx) xb_add(&bar[XB_TOPGEN], 1u);
            else XB_SPIN(xb_ld(&bar[XB_TOPGEN]) == tg, bar);
            __builtin_amdgcn_fence(__ATOMIC_ACQUIRE, "agent");
            xb_add(&bar[XB_XGEN(b.x)], 1u);
            asm volatile("s_waitcnt vmcnt(0)" ::: "memory");
        } else {
            XB_SPIN(xb_ld(&bar[XB_XGEN(b.x)]) == gen, bar);
            __builtin_amdgcn_fence(__ATOMIC_ACQUIRE, "agent");
            asm volatile("s_waitcnt vmcnt(0)" ::: "memory");
        }
    }
    __syncthreads();
}
typedef float f32x16 __attribute__((ext_vector_type(16)));
typedef float f32x2 __attribute__((ext_vector_type(2)));
typedef short s16x4 __attribute__((ext_vector_type(4)));
typedef unsigned u32x2 __attribute__((ext_vector_type(2)));
typedef short v4i16_t __attribute__((ext_vector_type(4)));
__device__ __forceinline__ unsigned cvtpk(float lo, float hi) { unsigned r; asm volatile("v_cvt_pk_bf16_f32 %0, %1, %2" : "=v"(r) : "v"(lo), "v"(hi)); return r; }
__device__ __forceinline__ float bflo(unsigned w) { return __uint_as_float(w << 16); }
__device__ __forceinline__ float bfhi(unsigned w) { return __uint_as_float(w & 0xffff0000u); }
__device__ __forceinline__ void unpack8(const v4u w, float (&f)[8]) { f[0] = bflo(w.x); f[1] = bfhi(w.x); f[2] = bflo(w.y); f[3] = bfhi(w.y); f[4] = bflo(w.z); f[5] = bfhi(w.z); f[6] = bflo(w.w); f[7] = bfhi(w.w); }
__device__ __forceinline__ v4u packf8(const float (&f)[8]) { v4u w; w.x = cvtpk(f[0], f[1]); w.y = cvtpk(f[2], f[3]); w.z = cvtpk(f[4], f[5]); w.w = cvtpk(f[6], f[7]); return w; }
__device__ __forceinline__ float wave_sum(float v) {
#if XL_FAST
    return xl_swap32_sum(xl_swap16_sum(xl_sum16(v)));
#else
#pragma unroll
    for (int o = 1; o < 64; o <<= 1) v += __shfl_xor(v, o);
    return v;
#endif
}
__device__ __forceinline__ int crow(int r, int hi) { return (r & 3) + 8 * (r >> 2) + 4 * hi; }

template <bool ROPEP = false>
__device__ __forceinline__ void transpose_item64(const float* W, size_t ldw, int k0, int n0, bf16* WT, size_t ldt, int r0, LAS float* scr, int lane, int kdst = 0) {
    const GAS float* src = (const GAS float*)W + (size_t)(k0 + (lane >> 4)) * ldw + n0 + (lane & 15) * 4;
    f32x4 v[16];
#pragma unroll
    for (int i = 0; i < 16; ++i) v[i] = *(const GAS f32x4*)(src + (size_t)(4 * i) * ldw);
#pragma unroll
    for (int i = 0; i < 16; ++i) { LAS float* s = scr + (4 * i + (lane >> 4)) * 65 + (lane & 15) * 4; s[0] = v[i].x; s[1] = v[i].y; s[2] = v[i].z; s[3] = v[i].w; }
    LDS_WAIT(); asm volatile("" ::: "memory");
    const int c = lane & 7;
#pragma unroll
    for (int j = 0; j < 8; ++j) { const int n = (lane >> 3) + 8 * j; const LAS float* s = scr + (8 * c) * 65 + n;
        v4u o; o.x = cvtpk(s[0 * 65], s[1 * 65]); o.y = cvtpk(s[2 * 65], s[3 * 65]); o.z = cvtpk(s[4 * 65], s[5 * 65]); o.w = cvtpk(s[6 * 65], s[7 * 65]);
        const int nd = ROPEP ? (((n >> 4) & 1) * 32 + ((n >> 2) & 3) * 8 + (n >> 5) * 4 + (n & 3)) : n;
        *(GAS v4u*)(WT + (size_t)(r0 + nd) * ldt + kdst + k0 + 8 * c) = o; }
    LDS_WAIT(); asm volatile("" ::: "memory");
}
__device__ __forceinline__ unsigned pk4_fp8(float a, float b, float c, float d) { int r = __builtin_amdgcn_cvt_pk_fp8_f32(a, b, 0, false); r = __builtin_amdgcn_cvt_pk_fp8_f32(c, d, r, true); return (unsigned)r; }
template <bool ROPEP = false>
__device__ __forceinline__ void transpose_item64_f8(const float* W, size_t ldw, int k0, int n0, unsigned char* WT, size_t ldt, int r0, LAS float* scr, int lane, float scale) {
    const GAS float* src = (const GAS float*)W + (size_t)(k0 + (lane >> 4)) * ldw + n0 + (lane & 15) * 4;
    f32x4 v[16];
#pragma unroll
    for (int i = 0; i < 16; ++i) v[i] = *(const GAS f32x4*)(src + (size_t)(4 * i) * ldw);
#pragma unroll
    for (int i = 0; i < 16; ++i) { LAS float* s = scr + (4 * i + (lane >> 4)) * 65 + (lane & 15) * 4; s[0] = v[i].x; s[1] = v[i].y; s[2] = v[i].z; s[3] = v[i].w; }
    LDS_WAIT(); asm volatile("" ::: "memory");
    const int c = lane & 7;
#pragma unroll
    for (int j = 0; j < 8; ++j) { const int n = (lane >> 3) + 8 * j; const LAS float* s = scr + (8 * c) * 65 + n;
        u32x2 o; o.x = pk4_fp8(s[0 * 65] * scale, s[1 * 65] * scale, s[2 * 65] * scale, s[3 * 65] * scale); o.y = pk4_fp8(s[4 * 65] * scale, s[5 * 65] * scale, s[6 * 65] * scale, s[7 * 65] * scale);
        const int nd = ROPEP ? (((n >> 4) & 1) * 32 + ((n >> 2) & 3) * 8 + (n >> 5) * 4 + (n & 3)) : n;
        *(GAS u32x2*)(WT + (size_t)(r0 + nd) * ldt + k0 + 8 * c) = o; }
    LDS_WAIT(); asm volatile("" ::: "memory");
}
__device__ __forceinline__ void rms_row_to_bf16(const float* xrow, const float* gain, bf16* orow, int lane, unsigned char* orow8 = nullptr) {
    const GAS f32x4* xr = (const GAS f32x4*)xrow + lane; const GAS f32x4* gr = (const GAS f32x4*)gain + lane;
    f32x4 v[8]; float s = 0.f;
#pragma unroll
    for (int j = 0; j < 8; ++j) { v[j] = xr[64 * j]; s += (v[j].x * v[j].x + v[j].y * v[j].y) + (v[j].z * v[j].z + v[j].w * v[j].w); }
    const float rs = 1.0f * FAST_RSQ(wave_sum(s) * (1.f / 2048.f) + EPS);
    GAS u32x2* o8 = (GAS u32x2*)orow + lane; GAS unsigned* o4 = (GAS unsigned*)orow8 + lane;
#pragma unroll
    for (int j = 0; j < 8; ++j) { const f32x4 g = gr[64 * j]; const float a0 = v[j].x * rs * g.x, a1 = v[j].y * rs * g.y, a2 = v[j].z * rs * g.z, a3 = v[j].w * rs * g.w;
        if (!(UV_F8 == 1 && GATE_F8)) { u32x2 w; w.x = cvtpk(a0, a1); w.y = cvtpk(a2, a3); o8[64 * j] = w; }
        if (orow8) o4[64 * j] = pk4_fp8(a0, a1, a2, a3); }
}
#define ATT_WAITV(n) asm volatile("s_waitcnt vmcnt(" #n ")" ::: "memory")
template <int DQK, int NSLOT, bool CAUSAL>
__device__ __forceinline__ void attn_unit(LAS unsigned char* lds, const bf16* Qw  , int qpitch, const bf16* Ktiles, const bf16* Vtiles,
                                          int ntiles, int qpos0  , unsigned char* Ow  , int opitch, int wid, int lane) {
    constexpr int KS = DQK / 16, KTB = 64 * DQK * 2, VTB = 64 * 128 * 2, KP = KTB / 1024 / 8  , VP = 2, NP = KP + VP, PF = NSLOT - 1;
    static_assert(KTB % 8192 == 0, "K tile pieces must split evenly over 8 waves");
    const int r32 = lane & 31, hi = lane >> 5;
    bf16x8 qf[KS];
    { const GAS bf16x8* qp = (const GAS bf16x8*)((const GAS bf16*)Qw + (size_t)r32 * qpitch + hi * 8);
#pragma unroll
      for (int ks = 0; ks < KS; ++ks) qf[ks] = qp[2 * ks]; }
    asm volatile("s_waitcnt vmcnt(0)" ::: "memory");
#pragma unroll
    for (int ks = 0; ks < KS; ++ks) asm volatile("" : "+v"(qf[ks]));
    const GAS unsigned char* kg = (const GAS unsigned char*)Ktiles + (size_t)wid * 1024;
    const GAS unsigned char* vg = (const GAS unsigned char*)Vtiles + (size_t)wid * 1024;
    const unsigned loff = (unsigned)lane * 16u;
    LAS unsigned char* kl = lds + wid * 1024; LAS unsigned char* vl = lds + NSLOT * KTB + wid * 1024;
#define ATT_ISSUE(t) do { const int sl_ = (t) % NSLOT; unsigned lo_ = loff; asm volatile("" : "+v"(lo_));   \
        _Pragma("unroll") for (int p_ = 0; p_ < KP; ++p_) __builtin_amdgcn_global_load_lds((const GAS unsigned*)(kg + ((size_t)(t) * KTB + p_ * 8192) + lo_), (LAS unsigned*)(kl + sl_ * KTB + p_ * 8192), 16, 0, 0); \
        _Pragma("unroll") for (int p_ = 0; p_ < VP; ++p_) __builtin_amdgcn_global_load_lds((const GAS unsigned*)(vg + ((size_t)(t) * VTB + p_ * 8192) + lo_), (LAS unsigned*)(vl + sl_ * VTB + p_ * 8192), 16, 0, 0); } while (0)
#pragma unroll
    for (int t = 0; t < PF; ++t) if (t < ntiles) ATT_ISSUE(t);
    f32x16 o[4];
#pragma unroll
    for (int d = 0; d < 4; ++d)
#pragma unroll
        for (int r = 0; r < 16; ++r) o[d][r] = 0.f;
    float mrun = -1e30f, lrun = 0.f;
    const int kbase = hi * 1024 + r32 * 16;
    const int g4 = lane >> 4, q4 = (lane >> 2) & 3, p4 = lane & 3;
    const int vbase = (4 * (g4 >> 1) + q4) * 64 + (16 * (g4 & 1) + 4 * p4) * 2;
    for (int j = 0; j < ntiles; ++j) {
        const int rem = ntiles - 1 - j;
        if (PF >= 2 && rem >= 1) { if (NP == 5) ATT_WAITV(5); else ATT_WAITV(6); } else ATT_WAITV(0);
        __builtin_amdgcn_s_barrier();
        asm volatile("" ::: "memory");
        if (j + PF < ntiles) ATT_ISSUE(j + PF);
        if (CAUSAL && 64 * j > qpos0 + 31) continue;
        const int sl = j % NSLOT;
        const LAS unsigned char* ks_ = lds + sl * KTB + kbase;
        const LAS unsigned char* vs_ = lds + NSLOT * KTB + sl * VTB + vbase;
        f32x16 p0, p1;
#pragma unroll
        for (int r = 0; r < 16; ++r) { p0[r] = 0.f; p1[r] = 0.f; }
        {   constexpr int NF = 2 * KS, KW = 8;
            bf16x8 kf[KW];
#pragma unroll
            for (int i = 0; i < KW; ++i) kf[i] = *(const LAS bf16x8*)(ks_ + (i >> 1) * 2048 + (i & 1) * 512);
            __builtin_amdgcn_sched_barrier(0);
#pragma unroll
            for (int i = 0; i < NF; ++i) {
                if (i & 1) p1 = __builtin_amdgcn_mfma_f32_32x32x16_bf16(kf[i % KW], qf[i >> 1], p1, 0, 0, 0);
                else       p0 = __builtin_amdgcn_mfma_f32_32x32x16_bf16(kf[i % KW], qf[i >> 1], p0, 0, 0, 0);
                if (i + KW < NF) kf[i % KW] = *(const LAS bf16x8*)(ks_ + ((i + KW) >> 1) * 2048 + ((i + KW) & 1) * 512);
                __builtin_amdgcn_sched_barrier(0);
            }
        }
        if (CAUSAL && 64 * j + 63 > qpos0) {
            const int dq = qpos0 + r32 - 64 * j - 4 * hi;
#pragma unroll
            for (int r = 0; r < 16; ++r) { const int c = (r & 3) + 8 * (r >> 2); if (c > dq) p0[r] = -INFINITY; if (c + 32 > dq) p1[r] = -INFINITY; }
        }
        float mx = p0[0];
#pragma unroll
        for (int r = 1; r < 16; ++r) mx = fmaxf(mx, p0[r]);
#pragma unroll
        for (int r = 0; r < 16; ++r) mx = fmaxf(mx, p1[r]);
        mx = XL_FAST ? xl_swap32_max(mx) : fmaxf(mx, __shfl_xor(mx, 32));
        const float mnew = fmaxf(mrun, mx);
        if (__any(mnew > mrun)) {
            const float alpha = __builtin_amdgcn_exp2f(mrun - mnew);
            lrun *= alpha;
#pragma unroll
            for (int d = 0; d < 4; ++d)
#pragma unroll
                for (int r = 0; r < 16; ++r) o[d][r] *= alpha;
            mrun = mnew;
        }
        float ps = 0.f;
#pragma unroll
        for (int r = 0; r < 16; ++r) { p0[r] = __builtin_amdgcn_exp2f(p0[r] - mrun); p1[r] = __builtin_amdgcn_exp2f(p1[r] - mrun); ps += p0[r] + p1[r]; }
        lrun += ps;
        bf16x8 pf[4];
        { v4u w;
          w.x = cvtpk(p0[0], p0[1]); w.y = cvtpk(p0[2], p0[3]); w.z = cvtpk(p0[4], p0[5]); w.w = cvtpk(p0[6], p0[7]); pf[0] = __builtin_bit_cast(bf16x8, w);
          w.x = cvtpk(p0[8], p0[9]); w.y = cvtpk(p0[10], p0[11]); w.z = cvtpk(p0[12], p0[13]); w.w = cvtpk(p0[14], p0[15]); pf[1] = __builtin_bit_cast(bf16x8, w);
          w.x = cvtpk(p1[0], p1[1]); w.y = cvtpk(p1[2], p1[3]); w.z = cvtpk(p1[4], p1[5]); w.w = cvtpk(p1[6], p1[7]); pf[2] = __builtin_bit_cast(bf16x8, w);
          w.x = cvtpk(p1[8], p1[9]); w.y = cvtpk(p1[10], p1[11]); w.z = cvtpk(p1[12], p1[13]); w.w = cvtpk(p1[14], p1[15]); pf[3] = __builtin_bit_cast(bf16x8, w); }
#define ATT_VLOAD(dst, s_) do { _Pragma("unroll") for (int db_ = 0; db_ < 4; ++db_) { \
            const s16x4 lo_ = __builtin_bit_cast(s16x4, __builtin_amdgcn_ds_read_tr16_b64_v4i16((LAS v4i16_t*)(vs_ + db_ * 4096 + (s_) * 1024))); \
            const s16x4 hh_ = __builtin_bit_cast(s16x4, __builtin_amdgcn_ds_read_tr16_b64_v4i16((LAS v4i16_t*)(vs_ + db_ * 4096 + (s_) * 1024 + 512))); \
            dst[db_] = (bf16x8){lo_[0], lo_[1], lo_[2], lo_[3], hh_[0], hh_[1], hh_[2], hh_[3]}; } } while (0)
        {   bf16x8 va[4], vb[4];
            ATT_VLOAD(va, 0);
            __builtin_amdgcn_sched_barrier(0);
            ATT_VLOAD(vb, 1);
#pragma unroll
            for (int db = 0; db < 4; ++db) o[db] = __builtin_amdgcn_mfma_f32_32x32x16_bf16(va[db], pf[0], o[db], 0, 0, 0);
            __builtin_amdgcn_sched_barrier(0);
            ATT_VLOAD(va, 2);
#pragma unroll
            for (int db = 0; db < 4; ++db) o[db] = __builtin_amdgcn_mfma_f32_32x32x16_bf16(vb[db], pf[1], o[db], 0, 0, 0);
            __builtin_amdgcn_sched_barrier(0);
            ATT_VLOAD(vb, 3);
#pragma unroll
            for (int db = 0; db < 4; ++db) o[db] = __builtin_amdgcn_mfma_f32_32x32x16_bf16(va[db], pf[2], o[db], 0, 0, 0);
            __builtin_amdgcn_sched_barrier(0);
#pragma unroll
            for (int db = 0; db < 4; ++db) o[db] = __builtin_amdgcn_mfma_f32_32x32x16_bf16(vb[db], pf[3], o[db], 0, 0, 0);
            __builtin_amdgcn_sched_barrier(0);
        }
#undef ATT_VLOAD
    }
    const float lt = XL_FAST ? xl_swap32_sum(lrun) : lrun + __shfl_xor(lrun, 32);
    const float il = ATT_OS / lt;
    GAS unsigned char* op = (GAS unsigned char*)Ow + (size_t)r32 * opitch + 4 * hi;
#pragma unroll
    for (int db = 0; db < 4; ++db)
#pragma unroll
        for (int rg = 0; rg < 4; ++rg) *(GAS unsigned*)(op + 32 * db + 8 * rg) = pk4_fp8(o[db][4 * rg] * il, o[db][4 * rg + 1] * il, o[db][4 * rg + 2] * il, o[db][4 * rg + 3] * il);
    asm volatile("s_waitcnt vmcnt(0) lgkmcnt(0)" ::: "memory");
    __builtin_amdgcn_s_barrier();
    asm volatile("" ::: "memory");
#undef ATT_ISSUE
}

typedef int i32x8a __attribute__((ext_vector_type(8)));
typedef int i32x4a __attribute__((ext_vector_type(4)));
__device__ __forceinline__ void att_bar4(LAS unsigned* ctr, unsigned& nbar, int lane) {
#if SPLIT_FREE
    nbar += 4;
    if (lane == 0) __hip_atomic_fetch_add(ctr, 1u, __ATOMIC_RELAXED, __HIP_MEMORY_SCOPE_WORKGROUP);
    for (;;) { const unsigned v = __builtin_amdgcn_readfirstlane(__hip_atomic_load(ctr, __ATOMIC_RELAXED, __HIP_MEMORY_SCOPE_WORKGROUP)); if (v >= nbar) break; if (ATT_POLL_SLEEP) __builtin_amdgcn_s_sleep(1); }
    asm volatile("" ::: "memory");
#else
    __builtin_amdgcn_s_barrier();
    asm volatile("" ::: "memory");
#endif
}
template <bool CAUSAL, int NWA = 8>
__device__ __forceinline__ void attn8_unit(LAS unsigned char* lds, const unsigned char* Qw  , const unsigned char* Ktiles, const unsigned char* Vtiles,
                                           int ntiles, int qpos0, unsigned char* Ow  , int opitch, int wid, int lane, LAS unsigned* bctr = nullptr, unsigned* nbar = nullptr) {
    constexpr int KTB = 12288, VTB = 8192, NSLOT = 3;
    const int r32 = lane & 31, hi = lane >> 5;
    i32x8a qf[3];
    { const GAS i32x4a* qp = (const GAS i32x4a*)((const GAS unsigned char*)Qw + (size_t)r32 * 192 + hi * 32);
#pragma unroll
      for (int s = 0; s < 3; ++s) { const i32x4a a = qp[4 * s], b = qp[4 * s + 1]; qf[s] = __builtin_shufflevector(a, b, 0, 1, 2, 3, 4, 5, 6, 7); } }
    asm volatile("s_waitcnt vmcnt(0)" ::: "memory");
#pragma unroll
    for (int s = 0; s < 3; ++s) asm volatile("" : "+v"(qf[s]));
    const GAS unsigned char* kg = (const GAS unsigned char*)Ktiles + (size_t)wid * 1024;
    const GAS unsigned char* vg = (const GAS unsigned char*)Vtiles + (size_t)wid * 1024;
    const unsigned loff = (unsigned)lane * 16u;
    LAS unsigned char* kl = lds + wid * 1024; LAS unsigned char* vl = lds + NSLOT * KTB + wid * 1024;
    const bool two = wid < 4;
#define A8_ISSUE(t) do { const int sl_ = (t) % NSLOT; unsigned lo_ = loff; asm volatile("" : "+v"(lo_)); \
        if (NWA == 8) { \
            __builtin_amdgcn_global_load_lds((const GAS unsigned*)(kg + (size_t)(t) * KTB + lo_), (LAS unsigned*)(kl + sl_ * KTB), 16, 0, 0); \
            if (two) __builtin_amdgcn_global_load_lds((const GAS unsigned*)(kg + ((size_t)(t) * KTB + 8192) + lo_), (LAS unsigned*)(kl + sl_ * KTB + 8192), 16, 0, 0); \
            __builtin_amdgcn_global_load_lds((const GAS unsigned*)(vg + (size_t)(t) * VTB + lo_), (LAS unsigned*)(vl + sl_ * VTB), 16, 0, 0); \
        } else {     \
            _Pragma("unroll") for (int p_ = 0; p_ < 3; ++p_) __builtin_amdgcn_global_load_lds((const GAS unsigned*)(kg + ((size_t)(t) * KTB + p_ * 4096) + lo_), (LAS unsigned*)(kl + sl_ * KTB + p_ * 4096), 16, 0, 0); \
            _Pragma("unroll") for (int p_ = 0; p_ < 2; ++p_) __builtin_amdgcn_global_load_lds((const GAS unsigned*)(vg + ((size_t)(t) * VTB + p_ * 4096) + lo_), (LAS unsigned*)(vl + sl_ * VTB + p_ * 4096), 16, 0, 0); \
        } } while (0)
    A8_ISSUE(0);
    if (ntiles > 1) A8_ISSUE(1);
    f32x16 o[4];
#pragma unroll
    for (int d = 0; d < 4; ++d)
#pragma unroll
        for (int r = 0; r < 16; ++r) o[d][r] = 0.f;
    float mrun = -1e30f, lrun = 0.f;
    const int kbase = (2 * hi) * 1024 + r32 * 16, vbase = (2 * hi) * 2048 + r32 * 16;
    const int SQ = 0x7b7b7b7b, SP = 0x79797979, S1 = 0x7f7f7f7f;
    for (int j = 0; j < ntiles; ++j) {
        if (ntiles - 1 - j >= 1) { if (NWA == 4) ATT_WAITV(5); else if (two) ATT_WAITV(3); else ATT_WAITV(2); } else ATT_WAITV(0);
        if (NWA == 4 && bctr) att_bar4(bctr, *nbar, lane); else { __builtin_amdgcn_s_barrier(); asm volatile("" ::: "memory"); }
        if (j + 2 < ntiles) A8_ISSUE(j + 2);
        if (CAUSAL && 64 * j > qpos0 + 31) continue;
        const int sl = j % NSLOT;
        const LAS unsigned char* ks_ = lds + sl * KTB + kbase;
        const LAS unsigned char* vs_ = lds + NSLOT * KTB + sl * VTB + vbase;
        i32x8a kf[3][2];
#pragma unroll
        for (int s = 0; s < 3; ++s)
#pragma unroll
            for (int kb = 0; kb < 2; ++kb) { const i32x4a a = *(const LAS i32x4a*)(ks_ + s * 4096 + kb * 512), b = *(const LAS i32x4a*)(ks_ + s * 4096 + kb * 512 + 1024);
                kf[s][kb] = __builtin_shufflevector(a, b, 0, 1, 2, 3, 4, 5, 6, 7); }
        f32x16 p0, p1;
#pragma unroll
        for (int r = 0; r < 16; ++r) { p0[r] = 0.f; p1[r] = 0.f; }
#pragma unroll
        for (int s = 0; s < 3; ++s) {
            p0 = __builtin_amdgcn_mfma_scale_f32_32x32x64_f8f6f4(kf[s][0], qf[s], p0, 0, 0, 0, S1, 0, SQ);
            p1 = __builtin_amdgcn_mfma_scale_f32_32x32x64_f8f6f4(kf[s][1], qf[s], p1, 0, 0, 0, S1, 0, SQ);
        }
        i32x8a vf[4];
#pragma unroll
        for (int db = 0; db < 4; ++db) { const i32x4a a = *(const LAS i32x4a*)(vs_ + db * 512), b = *(const LAS i32x4a*)(vs_ + db * 512 + 2048); vf[db] = __builtin_shufflevector(a, b, 0, 1, 2, 3, 4, 5, 6, 7); }
        __builtin_amdgcn_sched_barrier(0);
        if (CAUSAL && 64 * j + 63 > qpos0) {
            const int dq = qpos0 + r32 - 64 * j - 4 * hi;
#pragma unroll
            for (int r = 0; r < 16; ++r) { const int c = (r & 3) + 8 * (r >> 2); if (c > dq) p0[r] = -INFINITY; if (c + 32 > dq) p1[r] = -INFINITY; }
        }
        float mx = p0[0];
#pragma unroll
        for (int r = 1; r < 16; ++r) mx = fmaxf(mx, p0[r]);
#pragma unroll
        for (int r = 0; r < 16; ++r) mx = fmaxf(mx, p1[r]);
        mx = XL_FAST ? xl_swap32_max(mx) : fmaxf(mx, __shfl_xor(mx, 32));
        const float mnew = fmaxf(mrun, mx);
        if (__any(mx > mrun + 2.0f)) {
            const float alpha = __builtin_amdgcn_exp2f(mrun - mnew);
            lrun *= alpha;
#pragma unroll
            for (int d = 0; d < 4; ++d)
#pragma unroll
                for (int r = 0; r < 16; ++r) o[d][r] *= alpha;
            mrun = mnew;
        }
        float ps = 0.f; const float msh = mrun - 6.0f;
#pragma unroll
        for (int r = 0; r < 16; ++r) { p0[r] = __builtin_amdgcn_exp2f(p0[r] - msh); p1[r] = __builtin_amdgcn_exp2f(p1[r] - msh); ps += p0[r] + p1[r]; }
        lrun += ps;
        i32x8a pf;
        pf[0] = (int)pk4_fp8(p0[0], p0[1], p0[2], p0[3]); pf[1] = (int)pk4_fp8(p0[4], p0[5], p0[6], p0[7]); pf[2] = (int)pk4_fp8(p0[8], p0[9], p0[10], p0[11]); pf[3] = (int)pk4_fp8(p0[12], p0[13], p0[14], p0[15]);
        pf[4] = (int)pk4_fp8(p1[0], p1[1], p1[2], p1[3]); pf[5] = (int)pk4_fp8(p1[4], p1[5], p1[6], p1[7]); pf[6] = (int)pk4_fp8(p1[8], p1[9], p1[10], p1[11]); pf[7] = (int)pk4_fp8(p1[12], p1[13], p1[14], p1[15]);
#pragma unroll
        for (int db = 0; db < 4; ++db) o[db] = __builtin_amdgcn_mfma_scale_f32_32x32x64_f8f6f4(vf[db], pf, o[db], 0, 0, 0, S1, 0, SP);
    }
    const float lt = XL_FAST ? xl_swap32_sum(lrun) : lrun + __shfl_xor(lrun, 32);
    const float il = 64.0f * ATT_OS / lt;
    GAS unsigned char* op = (GAS unsigned char*)Ow + (size_t)r32 * opitch + 4 * hi;
#pragma unroll
    for (int db = 0; db < 4; ++db)
#pragma unroll
        for (int rg = 0; rg < 4; ++rg) *(GAS unsigned*)(op + 32 * db + 8 * rg) = pk4_fp8(o[db][4 * rg] * il, o[db][4 * rg + 1] * il, o[db][4 * rg + 2] * il, o[db][4 * rg + 3] * il);
    asm volatile("s_waitcnt vmcnt(0) lgkmcnt(0)" ::: "memory");
    if (NWA == 4 && bctr) att_bar4(bctr, *nbar, lane); else { __builtin_amdgcn_s_barrier(); asm volatile("" ::: "memory"); }
#undef A8_ISSUE
}

__device__ __forceinline__ float xhalf_max(float x) { const auto r = __builtin_amdgcn_permlane32_swap(__float_as_uint(x), __float_as_uint(x), false, false); return fmaxf(__uint_as_float(r[0]), __uint_as_float(r[1])); }
__device__ __forceinline__ float xhalf_sum(float x) { const auto r = __builtin_amdgcn_permlane32_swap(__float_as_uint(x), __float_as_uint(x), false, false); return __uint_as_float(r[0]) + __uint_as_float(r[1]); }
template <bool CAUSAL>
__device__ __forceinline__ void attn8_unit2(LAS unsigned char* lds, const unsigned char* Qw  , const unsigned char* Ktiles, const unsigned char* Vtiles,
                                            int ntiles, int qpos0  , unsigned char* Ow, int opitch, int wid, int lane, LAS unsigned* bctr, unsigned& nbar) {
    constexpr int KTB = 12288, VTB = 8192, NSLOT = ATT_PAIR ? 2 : 3, KSB = ATT_PAIR ? 2 * KTB : KTB, VSB = ATT_PAIR ? 2 * VTB : VTB;
    const int r32 = lane & 31, hi = lane >> 5;
    i32x8a qf[2][3];
#pragma unroll
    for (int bk = 0; bk < 2; ++bk) { const GAS i32x4a* qp = (const GAS i32x4a*)((const GAS unsigned char*)Qw + (size_t)(128 * bk + r32) * 192 + hi * 32);
#pragma unroll
      for (int s = 0; s < 3; ++s) { const i32x4a a = qp[4 * s], b = qp[4 * s + 1]; qf[bk][s] = __builtin_shufflevector(a, b, 0, 1, 2, 3, 4, 5, 6, 7); } }
    asm volatile("s_waitcnt vmcnt(0)" ::: "memory");
#pragma unroll
    for (int bk = 0; bk < 2; ++bk)
#pragma unroll
        for (int s = 0; s < 3; ++s) asm volatile("" : "+v"(qf[bk][s]));
    const GAS unsigned char* kg = (const GAS unsigned char*)Ktiles + (size_t)wid * 1024;
    const GAS unsigned char* vg = (const GAS unsigned char*)Vtiles + (size_t)wid * 1024;
    const unsigned loff = (unsigned)lane * 16u;
    LAS unsigned char* kl = lds + wid * 1024; LAS unsigned char* vl = lds + NSLOT * KSB + wid * 1024;
#define A2_ISSUE(t) do { const int sl_ = (t) % NSLOT; unsigned lo_ = loff; asm volatile("" : "+v"(lo_)); \
        _Pragma("unroll") for (int p_ = 0; p_ < KSB / 4096; ++p_) __builtin_amdgcn_global_load_lds((const GAS unsigned*)(kg + ((size_t)(t) * KSB + p_ * 4096) + lo_), (LAS unsigned*)(kl + sl_ * KSB + p_ * 4096), 16, 0, 0); \
        _Pragma("unroll") for (int p_ = 0; p_ < VSB / 4096; ++p_) __builtin_amdgcn_global_load_lds((const GAS unsigned*)(vg + ((size_t)(t) * VSB + p_ * 4096) + lo_), (LAS unsigned*)(vl + sl_ * VSB + p_ * 4096), 16, 0, 0); } while (0)
#define A2_PIECE(tp_, ix_) do { const int sl_ = (tp_) % NSLOT; unsigned lo_ = loff; asm volatile("" : "+v"(lo_)); \
        if ((ix_) < 6) __builtin_amdgcn_global_load_lds((const GAS unsigned*)(kg + ((size_t)(tp_) * KSB + (ix_) * 4096) + lo_), (LAS unsigned*)(kl + sl_ * KSB + (ix_) * 4096), 16, 0, 0); \
        else __builtin_amdgcn_global_load_lds((const GAS unsigned*)(vg + ((size_t)(tp_) * VSB + ((ix_) - 6) * 4096) + lo_), (LAS unsigned*)(vl + sl_ * VSB + ((ix_) - 6) * 4096), 16, 0, 0); } while (0)
#define A2_SPREAD(ix_) do { if (ATT_SPREAD && ATT_PAIR && bk == 1 && pend) { __builtin_amdgcn_sched_barrier(0); A2_PIECE((j >> 1) + 1, ix_); __builtin_amdgcn_sched_barrier(0); } } while (0)
    A2_ISSUE(0);
    if (!ATT_PAIR && ntiles > 1) A2_ISSUE(1);
    f32x16 o[2][4];
#pragma unroll
    for (int bk = 0; bk < 2; ++bk)
#pragma unroll
        for (int d = 0; d < 4; ++d)
#pragma unroll
            for (int r = 0; r < 16; ++r) o[bk][d][r] = 0.f;
    float mrun[2] = {-1e30f, -1e30f}, lrun[2] = {0.f, 0.f};
    const int kbase = (2 * hi) * 1024 + r32 * 16, vbase = (2 * hi) * 2048 + r32 * 16;
    const int SQ = 0x7b7b7b7b, SP = 0x79797979, S1 = 0x7f7f7f7f;
    for (int j = 0; j < ntiles; ++j) {
#if ATT_PAIR
        if ((j & 1) == 0) {
            ATT_WAITV(0);
            att_bar4(bctr, nbar, lane);
            if (!ATT_SPREAD && j + 2 < ntiles) A2_ISSUE((j >> 1) + 1);
        }
        const bool pend = ATT_SPREAD && (j & 1) == 0 && (j + 2 < ntiles); (void)pend;
        const int sl = (j >> 1) % NSLOT;
        unsigned ka_ = (unsigned)(sl * KSB + (j & 1) * KTB + kbase), va_ = (unsigned)(NSLOT * KSB + sl * VSB + (j & 1) * VTB + vbase);
#else
        if (ntiles - 1 - j >= 1) ATT_WAITV(5); else ATT_WAITV(0);
        att_bar4(bctr, nbar, lane);
        if (j + 2 < ntiles) A2_ISSUE(j + 2);
        const int sl = j % NSLOT;
        unsigned ka_ = (unsigned)(sl * KTB + kbase), va_ = (unsigned)(NSLOT * KTB + sl * VTB + vbase);
        const bool pend = false; (void)pend;
#endif
        asm volatile("" : "+v"(ka_), "+v"(va_));
        const LAS unsigned char* ks_ = lds + ka_;
        const LAS unsigned char* vs_ = lds + va_;
        i32x8a pf_prev; bool have_prev = false; (void)pf_prev;
#pragma unroll
        for (int bk = 0; bk < 2; ++bk) {
            const int qp0 = qpos0 + 128 * bk;
            if (CAUSAL && 64 * j > qp0 + 31) continue;
#if ATT_SPLITQK
            f32x16 p0, p1;
#pragma unroll
            for (int r = 0; r < 16; ++r) { p0[r] = 0.f; p1[r] = 0.f; }
#pragma unroll
            for (int s = 0; s < 3; ++s) {
                const i32x4a a0 = *(const LAS i32x4a*)(ks_ + s * 4096), b0 = *(const LAS i32x4a*)(ks_ + s * 4096 + 1024);
                const i32x8a k0 = __builtin_shufflevector(a0, b0, 0, 1, 2, 3, 4, 5, 6, 7);
                p0 = __builtin_amdgcn_mfma_scale_f32_32x32x64_f8f6f4(k0, qf[bk][s], p0, 0, 0, 0, S1, 0, SQ);
            }
            __builtin_amdgcn_sched_barrier(0);
#pragma unroll
            for (int s = 0; s < 3; ++s) {
                const i32x4a a1 = *(const LAS i32x4a*)(ks_ + s * 4096 + 512), b1 = *(const LAS i32x4a*)(ks_ + s * 4096 + 512 + 1024);
                const i32x8a k1 = __builtin_shufflevector(a1, b1, 0, 1, 2, 3, 4, 5, 6, 7);
                p1 = __builtin_amdgcn_mfma_scale_f32_32x32x64_f8f6f4(k1, qf[bk][s], p1, 0, 0, 0, S1, 0, SQ);
            }
            __builtin_amdgcn_sched_barrier(0);
            const bool diag = CAUSAL && 64 * j + 63 > qp0;
            const int dq = qp0 + r32 - 64 * j - 4 * hi;
            if (diag) {
#pragma unroll
                for (int r = 0; r < 16; ++r) { const int c = (r & 3) + 8 * (r >> 2); if (c > dq) p0[r] = -INFINITY; }
            }
            float mx = p0[0];
#pragma unroll
            for (int r = 1; r < 16; ++r) mx = fmaxf(mx, p0[r]);
            mx = ATT_PERMLANE ? xhalf_max(mx) : fmaxf(mx, __shfl_xor(mx, 32));
            if (__any(mx > mrun[bk] + 2.0f)) {
                const float mnew = fmaxf(mrun[bk], mx), alpha = __builtin_amdgcn_exp2f(mrun[bk] - mnew);
                lrun[bk] *= alpha;
#pragma unroll
                for (int d = 0; d < 4; ++d)
#pragma unroll
                    for (int r = 0; r < 16; ++r) o[bk][d][r] *= alpha;
                mrun[bk] = mnew;
            }
            float msh = mrun[bk] - 6.0f, ps = 0.f;
#pragma unroll
            for (int r = 0; r < 16; ++r) { p0[r] = __builtin_amdgcn_exp2f(p0[r] - msh); ps += p0[r]; }
            __builtin_amdgcn_sched_barrier(0);
            if (diag) {
#pragma unroll
                for (int r = 0; r < 16; ++r) { const int c = (r & 3) + 8 * (r >> 2); if (c + 32 > dq) p1[r] = -INFINITY; }
            }
            mx = p1[0];
#pragma unroll
            for (int r = 1; r < 16; ++r) mx = fmaxf(mx, p1[r]);
            mx = ATT_PERMLANE ? xhalf_max(mx) : fmaxf(mx, __shfl_xor(mx, 32));
            if (__any(mx > mrun[bk] + 2.0f)) {
                const float mnew = fmaxf(mrun[bk], mx), alpha = __builtin_amdgcn_exp2f(mrun[bk] - mnew);
                lrun[bk] *= alpha; ps *= alpha;
#pragma unroll
                for (int r = 0; r < 16; ++r) p0[r] *= alpha;
#pragma unroll
                for (int d = 0; d < 4; ++d)
#pragma unroll
                    for (int r = 0; r < 16; ++r) o[bk][d][r] *= alpha;
                mrun[bk] = mnew; msh = mnew - 6.0f;
            }
#pragma unroll
            for (int r = 0; r < 16; ++r) { p1[r] = __builtin_amdgcn_exp2f(p1[r] - msh); ps += p1[r]; }
            lrun[bk] += ps;
            i32x8a pf;
            pf[0] = (int)pk4_fp8(p0[0], p0[1], p0[2], p0[3]); pf[1] = (int)pk4_fp8(p0[4], p0[5], p0[6], p0[7]); pf[2] = (int)pk4_fp8(p0[8], p0[9], p0[10], p0[11]); pf[3] = (int)pk4_fp8(p0[12], p0[13], p0[14], p0[15]);
            pf[4] = (int)pk4_fp8(p1[0], p1[1], p1[2], p1[3]); pf[5] = (int)pk4_fp8(p1[4], p1[5], p1[6], p1[7]); pf[6] = (int)pk4_fp8(p1[8], p1[9], p1[10], p1[11]); pf[7] = (int)pk4_fp8(p1[12], p1[13], p1[14], p1[15]);
            asm volatile("" : "+v"(pf));
#pragma unroll
            for (int db = 0; db < 4; ++db) { const i32x4a a = *(const LAS i32x4a*)(vs_ + db * 512), b = *(const LAS i32x4a*)(vs_ + db * 512 + 2048);
                const i32x8a vfd = __builtin_shufflevector(a, b, 0, 1, 2, 3, 4, 5, 6, 7);
                asm volatile("v_mfma_scale_f32_32x32x64_f8f6f4 %0, %1, %2, %0, %3, %4 op_sel_hi:[0,0,0]" : "+v"(o[bk][db]) : "v"(vfd), "v"(pf), "v"(S1), "v"(SP));
                A2_SPREAD(6 + db); }
            if (ATT_SPREAD && ATT_PAIR && bk == 1 && pend) { A2_PIECE((j >> 1) + 1, 0); A2_PIECE((j >> 1) + 1, 1); A2_PIECE((j >> 1) + 1, 2); A2_PIECE((j >> 1) + 1, 3); A2_PIECE((j >> 1) + 1, 4); A2_PIECE((j >> 1) + 1, 5); }
#else
            f32x16 p0, p1;
#pragma unroll
            for (int r = 0; r < 16; ++r) { p0[r] = 0.f; p1[r] = 0.f; }
#pragma unroll
            for (int s = 0; s < 3; ++s) {
                const i32x4a a0 = *(const LAS i32x4a*)(ks_ + s * 4096), b0 = *(const LAS i32x4a*)(ks_ + s * 4096 + 1024);
                const i32x4a a1 = *(const LAS i32x4a*)(ks_ + s * 4096 + 512), b1 = *(const LAS i32x4a*)(ks_ + s * 4096 + 512 + 1024);
                const i32x8a k0 = __builtin_shufflevector(a0, b0, 0, 1, 2, 3, 4, 5, 6, 7), k1 = __builtin_shufflevector(a1, b1, 0, 1, 2, 3, 4, 5, 6, 7);
                p0 = __builtin_amdgcn_mfma_scale_f32_32x32x64_f8f6f4(k0, qf[bk][s], p0, 0, 0, 0, S1, 0, SQ);
                p1 = __builtin_amdgcn_mfma_scale_f32_32x32x64_f8f6f4(k1, qf[bk][s], p1, 0, 0, 0, S1, 0, SQ);
            }
#if ATT_DEFER
            if (bk == 1 && have_prev) {
                __builtin_amdgcn_sched_barrier(0);
#pragma unroll
                for (int db = 0; db < 4; ++db) { const i32x4a a = *(const LAS i32x4a*)(vs_ + db * 512), b = *(const LAS i32x4a*)(vs_ + db * 512 + 2048);
                    const i32x8a vfd = __builtin_shufflevector(a, b, 0, 1, 2, 3, 4, 5, 6, 7);
                    asm volatile("v_mfma_scale_f32_32x32x64_f8f6f4 %0, %1, %2, %0, %3, %4 op_sel_hi:[0,0,0]" : "+v"(o[0][db]) : "v"(vfd), "v"(pf_prev), "v"(S1), "v"(SP));
                    __builtin_amdgcn_sched_barrier(0); }
            }
#endif
            if (CAUSAL && 64 * j + 63 > qp0) {
                const int dq = qp0 + r32 - 64 * j - 4 * hi;
#pragma unroll
                for (int r = 0; r < 16; ++r) { const int c = (r & 3) + 8 * (r >> 2); if (c > dq) p0[r] = -INFINITY; if (c + 32 > dq) p1[r] = -INFINITY; }
            }
            float mx = p0[0];
#pragma unroll
            for (int r = 1; r < 16; ++r) mx = fmaxf(mx, p0[r]);
#pragma unroll
            for (int r = 0; r < 16; ++r) mx = fmaxf(mx, p1[r]);
            mx = ATT_PERMLANE ? xhalf_max(mx) : fmaxf(mx, __shfl_xor(mx, 32));
            const float mnew = fmaxf(mrun[bk], mx);
            if (__any(mx > mrun[bk] + 2.0f)) {
                const float alpha = __builtin_amdgcn_exp2f(mrun[bk] - mnew);
                lrun[bk] *= alpha;
#pragma unroll
                for (int d = 0; d < 4; ++d)
#pragma unroll
                    for (int r = 0; r < 16; ++r) o[bk][d][r] *= alpha;
                mrun[bk] = mnew;
            }
#if ATT_VPRE
            float ps = 0.f; const float msh = mrun[bk] - 6.0f;
            i32x8a pf;
#pragma unroll
            for (int r = 0; r < 16; ++r) { p0[r] = __builtin_amdgcn_exp2f(p0[r] - msh); ps += p0[r]; }
            pf[0] = (int)pk4_fp8(p0[0], p0[1], p0[2], p0[3]); pf[1] = (int)pk4_fp8(p0[4], p0[5], p0[6], p0[7]); pf[2] = (int)pk4_fp8(p0[8], p0[9], p0[10], p0[11]); pf[3] = (int)pk4_fp8(p0[12], p0[13], p0[14], p0[15]);
            asm volatile("" : "+v"(pf[0]), "+v"(pf[1]), "+v"(pf[2]), "+v"(pf[3]));
            i32x8a vf0, vf1, vf2, vf3;
            { const i32x4a a = *(const LAS i32x4a*)(vs_ + 0 * 512), b = *(const LAS i32x4a*)(vs_ + 0 * 512 + 2048); vf0 = __builtin_shufflevector(a, b, 0, 1, 2, 3, 4, 5, 6, 7); }
            { const i32x4a a = *(const LAS i32x4a*)(vs_ + 1 * 512), b = *(const LAS i32x4a*)(vs_ + 1 * 512 + 2048); vf1 = __builtin_shufflevector(a, b, 0, 1, 2, 3, 4, 5, 6, 7); }
            asm volatile("" ::: "memory");
#pragma unroll
            for (int r = 0; r < 16; ++r) { p1[r] = __builtin_amdgcn_exp2f(p1[r] - msh); ps += p1[r]; }
            lrun[bk] += ps;
            pf[4] = (int)pk4_fp8(p1[0], p1[1], p1[2], p1[3]); pf[5] = (int)pk4_fp8(p1[4], p1[5], p1[6], p1[7]); pf[6] = (int)pk4_fp8(p1[8], p1[9], p1[10], p1[11]); pf[7] = (int)pk4_fp8(p1[12], p1[13], p1[14], p1[15]);
            asm volatile("" : "+v"(pf));
            { const i32x4a a = *(const LAS i32x4a*)(vs_ + 2 * 512), b = *(const LAS i32x4a*)(vs_ + 2 * 512 + 2048); vf2 = __builtin_shufflevector(a, b, 0, 1, 2, 3, 4, 5, 6, 7); }
            { const i32x4a a = *(const LAS i32x4a*)(vs_ + 3 * 512), b = *(const LAS i32x4a*)(vs_ + 3 * 512 + 2048); vf3 = __builtin_shufflevector(a, b, 0, 1, 2, 3, 4, 5, 6, 7); }
            asm volatile("v_mfma_scale_f32_32x32x64_f8f6f4 %0, %1, %2, %0, %3, %4 op_sel_hi:[0,0,0]" : "+v"(o[bk][0]) : "v"(vf0), "v"(pf), "v"(S1), "v"(SP));
            asm volatile("v_mfma_scale_f32_32x32x64_f8f6f4 %0, %1, %2, %0, %3, %4 op_sel_hi:[0,0,0]" : "+v"(o[bk][1]) : "v"(vf1), "v"(pf), "v"(S1), "v"(SP));
            asm volatile("v_mfma_scale_f32_32x32x64_f8f6f4 %0, %1, %2, %0, %3, %4 op_sel_hi:[0,0,0]" : "+v"(o[bk][2]) : "v"(vf2), "v"(pf), "v"(S1), "v"(SP));
            asm volatile("v_mfma_scale_f32_32x32x64_f8f6f4 %0, %1, %2, %0, %3, %4 op_sel_hi:[0,0,0]" : "+v"(o[bk][3]) : "v"(vf3), "v"(pf), "v"(S1), "v"(SP));
#else
            float ps = 0.f; const float msh = mrun[bk] - 6.0f;
#pragma unroll
            for (int r = 0; r < 16; ++r) { p0[r] = __builtin_amdgcn_exp2f(p0[r] - msh); p1[r] = __builtin_amdgcn_exp2f(p1[r] - msh); ps += p0[r] + p1[r]; }
            lrun[bk] += ps;
            i32x8a pf;
            pf[0] = (int)pk4_fp8(p0[0], p0[1], p0[2], p0[3]); pf[1] = (int)pk4_fp8(p0[4], p0[5], p0[6], p0[7]); pf[2] = (int)pk4_fp8(p0[8], p0[9], p0[10], p0[11]); pf[3] = (int)pk4_fp8(p0[12], p0[13], p0[14], p0[15]);
            pf[4] = (int)pk4_fp8(p1[0], p1[1], p1[2], p1[3]); pf[5] = (int)pk4_fp8(p1[4], p1[5], p1[6], p1[7]); pf[6] = (int)pk4_fp8(p1[8], p1[9], p1[10], p1[11]); pf[7] = (int)pk4_fp8(p1[12], p1[13], p1[14], p1[15]);
            asm volatile("" : "+v"(pf));
#if ATT_DEFER
            if (bk == 0) { pf_prev = pf; have_prev = true; } else
#endif
            {
#pragma unroll
            for (int db = 0; db < 4; ++db) { const i32x4a a = *(const LAS i32x4a*)(vs_ + db * 512), b = *(const LAS i32x4a*)(vs_ + db * 512 + 2048);
                const i32x8a vfd = __builtin_shufflevector(a, b, 0, 1, 2, 3, 4, 5, 6, 7);
                asm volatile("v_mfma_scale_f32_32x32x64_f8f6f4 %0, %1, %2, %0, %3, %4 op_sel_hi:[0,0,0]" : "+v"(o[bk][db]) : "v"(vfd), "v"(pf), "v"(S1), "v"(SP)); }
            }
#endif
#endif
        }
    }
    asm volatile("s_nop 15\n s_nop 15" ::: "memory");
#pragma unroll
    for (int bk = 0; bk < 2; ++bk) {
        const float lt = ATT_PERMLANE ? xhalf_sum(lrun[bk]) : lrun[bk] + __shfl_xor(lrun[bk], 32);
        const float il = 64.0f * ATT_OS / lt;
#if ATT_OWIDE
        unsigned ooff_ = (unsigned)(r32 * opitch + 16 * hi); asm volatile("" : "+v"(ooff_));
        GAS unsigned char* op = (GAS unsigned char*)Ow + (size_t)(128 * bk) * opitch + ooff_;
#pragma unroll
        for (int db = 0; db < 4; ++db) {
            unsigned w[4];
#pragma unroll
            for (int rg = 0; rg < 4; ++rg) w[rg] = pk4_fp8(o[bk][db][4 * rg] * il, o[bk][db][4 * rg + 1] * il, o[bk][db][4 * rg + 2] * il, o[bk][db][4 * rg + 3] * il);
            const auto s02 = __builtin_amdgcn_permlane32_swap(w[0], w[2], false, false);
            const auto s13 = __builtin_amdgcn_permlane32_swap(w[1], w[3], false, false);
            v4u ov; ov.x = s02[0]; ov.y = s02[1]; ov.z = s13[0]; ov.w = s13[1];
            *(GAS v4u*)(op + 32 * db) = ov;
            __builtin_amdgcn_sched_barrier(0);
        }
    }
#else
        GAS unsigned char* op = (GAS unsigned char*)Ow + (size_t)(128 * bk + r32) * opitch + 4 * hi;
#pragma unroll
        for (int db = 0; db < 4; ++db)
#pragma unroll
            for (int rg = 0; rg < 4; ++rg) *(GAS unsigned*)(op + 32 * db + 8 * rg) = pk4_fp8(o[bk][db][4 * rg] * il, o[bk][db][4 * rg + 1] * il, o[bk][db][4 * rg + 2] * il, o[bk][db][4 * rg + 3] * il);
    }
#endif
    asm volatile("s_waitcnt vmcnt(0) lgkmcnt(0)" ::: "memory");
    att_bar4(bctr, nbar, lane);
#undef A2_ISSUE
#undef A2_PIECE
#undef A2_SPREAD
}
struct Frame {
    LAS unsigned char* lds;
    volatile LAS unsigned* MISC;
    gu32* ctl;
    int tid, lane, wave, vcu, G;
    unsigned char* ws;
};
#define WSP(T_, off) ((T_*)(F.ws + (off)))

template <int PART>
__device__ __forceinline__ void p0_prologue(Frame& F, const float* const* in, const int rank = 0, const int nrank = 0) {
    LAS float* scr = (LAS float*)(F.lds + RING_OFF + F.wave * 16640);
    const int gw = (PART == 1 ? rank : F.vcu) * NWAVES + F.wave, NGW = (PART == 1 ? nrank : F.G) * NWAVES, lane = F.lane;
    constexpr int I0 = 32 * 65, I1 = 32 * 96, I2 = 32 * 16, I3 = 32 * 16, I4 = 8 * 48, I5 = 8 * 64, I6 = 16 * 32, I7 = 32 * 32, I8 = 16 * 32, I9 = 32 * 32;
    constexpr int NITEMS = I0 + I1 + I2 + I3 + I4 + I5 + I6 + I7 + I8 + I9;
    bf16* W1T = WSP(bf16, WS_W1T);
    constexpr int NIT_A = I0 + I1 + I2 + I3;
    constexpr int NIT_B = (PRO_SPLIT == 2) ? NIT_A + I4 + I5 : NITEMS;
    const int it_lo = (PART == 1) ? NIT_A : 0, it_hi = (PART == 1) ? NIT_B : NITEMS;
    for (int it = it_lo + gw; it < it_hi; it += NGW) {
        if (PART == 0 && PRO_SPLIT && it >= NIT_A && it < NIT_B) continue;
        int r = it;
        if (r < I0) { const int kb = r / 65, cb = r % 65, c = 64 * cb;
            const int r0 = c < 3072 ? c : (c < 3136 ? 4096 + (c - 3072) : 3072 + (c - 3136));
            if (GATE_F8 && (UV_F8 == 1 || r0 >= (UV_F8 == 2 ? 1024 : 2048))) transpose_item64_f8(in[4], 4160, 64 * kb, c, WSP(unsigned char, WS_WG8U), 2048, r0, scr, lane, MOE_WSCALE);
            else transpose_item64(in[4], 4160, 64 * kb, c, W1T, HPITCH, r0, scr, lane);
            continue; } r -= I0;
        if (r < I1) { const int kb = r / 96, cb = r % 96;
            if (GATE_F8) transpose_item64_f8(in[5], 6144, 64 * kb, 64 * cb, WSP(unsigned char, WS_WG8), 2048, 9 * 256 + 64 * cb, scr, lane, MOE_WSCALE);
            else transpose_item64(in[5], 6144, 64 * kb, 64 * cb, W1T, HPITCH, P1_G + 64 * cb, scr, lane);
            continue; } r -= I1;
        if (r < I2) { const int kb = r / 16, cb = r % 16;
            if (GATE_F8) transpose_item64_f8(in[20], 1024, 64 * kb, 64 * cb, WSP(unsigned char, WS_WG8), 2048, 33 * 256 + 64 * cb, scr, lane, MOE_WSCALE);
            else transpose_item64(in[20], 1024, 64 * kb, 64 * cb, W1T, HPITCH, P1N + 64 * cb, scr, lane);
            continue; } r -= I2;
        if (r < I3) { const int kb = r / 16, cb = r % 16;
            if (GATE_F8) transpose_item64_f8(in[21], 1024, 64 * kb, 64 * cb, WSP(unsigned char, WS_WG8), 2048, 33 * 256 + 1024 + 64 * cb, scr, lane, MOE_WSCALE);
            else transpose_item64(in[21], 1024, 64 * kb, 64 * cb, W1T, HPITCH, P1N + 1024 + 64 * cb, scr, lane);
            continue; } r -= I3;
        if (r < I4) { const int kb = r / 48, cb = r % 48, hh = cb / 3, part = cb % 3;
            if (part < 2) transpose_item64_f8(in[13], 3072, 64 * kb, 64 * cb, WSP(unsigned char, WS_WUQT), 512, 256 * hh + 64 * part, scr, lane, UP_WSCALE);
            else transpose_item64_f8<true>(in[13], 3072, 64 * kb, 64 * cb, WSP(unsigned char, WS_WUQT), 512, 256 * hh + 128, scr, lane, UP_WSCALE);
            continue; } r -= I4;
        if (r < I5) { const int kb = r / 64, cb = r % 64; transpose_item64_f8(in[15], 4096, 64 * kb, 64 * cb, WSP(unsigned char, WS_WUKVT), 512, 64 * cb, scr, lane, UP_WSCALE); continue; } r -= I5;
        if (r < I6) { const int kb = r / 32, cb = r % 32; transpose_item64(in[11], 2048, 64 * kb, 64 * cb, WSP(bf16, WS_WPT), ABC_LD, 64 * cb, scr, lane, 0); continue; } r -= I6;
        if (r < I7) { const int kb = r / 32, cb = r % 32; transpose_item64_f8(in[18], 2048, 64 * kb, 64 * cb, WSP(unsigned char, WS_WPT) + ABC_BB, ABC_ROWB, 64 * cb, scr, lane, MOE_WSCALE); continue; } r -= I7;
        if (r < I8) { const int kb = r / 32, cb = r % 32; transpose_item64_f8(in[24], 2048, 64 * kb, 64 * cb, WSP(unsigned char, WS_WPT) + ABC_CB, ABC_ROWB, 64 * cb, scr, lane, MOE_WSCALE); continue; } r -= I8;
        { const int kb = r / 32, cb = r % 32; transpose_item64(in[25], 2048, 64 * kb, 64 * cb, WSP(bf16, WS_WOT), 2048, 64 * cb, scr, lane); }
    }
    if (PART == 1) return;
    const int gt = gw * 64 + lane, NGT = NGW * 64;
    for (int i = gt; i < 192 * 2048 / 8; i += NGT) { const int rr = i / 256, cc = i % 256; *(GAS v4u*)(W1T + (size_t)(4160 + rr) * HPITCH + (size_t)cc * 8) = (v4u){0u, 0u, 0u, 0u}; }
    if (GATE_F8) for (int i = gt; i < 192 * 2048 / 16; i += NGT) *(GAS v4u*)(WSP(unsigned char, WS_WG8) + (size_t)(2048 + 64) * 2048 + (size_t)i * 16) = (v4u){0u, 0u, 0u, 0u};
    for (int i = gt; i < 16 * 64 * 512 / 16; i += NGT) { const int hh = i / (64 * 512 / 16), q = i % (64 * 512 / 16); *(GAS v4u*)(WSP(unsigned char, WS_WUQT) + (size_t)(256 * hh + 192) * 512 + (size_t)q * 16) = (v4u){0u, 0u, 0u, 0u}; }
    { const float* wsrc = in[9]; bf16* wsm = WSP(bf16, WS_WSM);
      for (int i = gt; i < 8 * 128 * 128; i += NGT) { const int t = (i >> 7) & 127, s = i & 127; const float v = (s <= t) ? wsrc[i] : 0.f; wsm[i] = (bf16)(cvtpk(v, 0.f) & 0xffffu); } }
    { const float* rw = in[27]; const float* g2 = in[26]; float* rwg = WSP(float, WS_RWG);
#if ROUTER_BF16X2
      { bf16* wh = (bf16*)rwg; bf16* wl = wh + 32 * 2048;
        for (int i = gt; i < 2048 * 32; i += NGT) { const int k = i >> 5, ex = i & 31; const float w = rw[i] * g2[k];
            const unsigned h = cvtpk(w, 0.f) & 0xffffu; const float r = w - __uint_as_float(h << 16);
            wh[ex * 2048 + k] = (bf16)h; wl[ex * 2048 + k] = (bf16)(cvtpk(r, 0.f) & 0xffffu); } }
      (void)rwg; }
#else
      for (int i = gt; i < 2048 * 32; i += NGT) rwg[i] = rw[i] * g2[i >> 5]; }
#endif
    bf16* H = WSP(bf16, WS_H);
    for (int m = gw; m < T + MEMROWS; m += NGW) {
        if (m < T) rms_row_to_bf16(in[0] + (size_t)m * 2048, in[3], H + (size_t)m * HPITCH, lane, WSP(unsigned char, WS_H8) + (size_t)m * 2048);
        else rms_row_to_bf16(in[1] + (size_t)(m - T) * 2048, in[19], H + (size_t)m * HPITCH, lane, WSP(unsigned char, WS_H8) + (size_t)m * 2048);
    }
}

struct MoeItem { const float* src; size_t ldw; unsigned char* dst; int r0; int k0; };
__device__ __forceinline__ MoeItem moe_item(Frame& F, const float* const* in, int it) {
    constexpr int I10 = NE * 32 * 64;
    MoeItem m;
    if (it < I10) { const int e = it / 2048, q = it % 2048, kb = q / 64, cb = q % 64;
        m.r0 = cb < 32 ? 256 * (cb >> 1) + 64 * (cb & 1) : 256 * ((cb - 32) >> 1) + 128 + 64 * (cb & 1);
        m.src = in[29] + (size_t)e * 2048 * 4096 + (size_t)(64 * kb) * 4096 + 64 * cb; m.ldw = 4096; m.dst = WSP(unsigned char, WS_WGUT) + (size_t)e * 4096 * 2048; m.k0 = 64 * kb; }
    else { const int r = it - I10, e = r / 1024, q = r % 1024, kb = q / 32, cb = q % 32;
        m.r0 = 64 * cb; m.src = in[31] + (size_t)e * 2048 * 2048 + (size_t)(64 * kb) * 2048 + 64 * cb; m.ldw = 2048; m.dst = WSP(unsigned char, WS_WDT) + (size_t)e * 2048 * 2048; m.k0 = 64 * kb; }
    return m;
}
#define MOE_LOADS(v_, m_) do { const GAS float* src_ = (const GAS float*)(m_).src + (size_t)(4 * (lane >> 4)) * (m_).ldw + (lane & 15) * 4; \
        _Pragma("unroll") for (int j_ = 0; j_ < 4; ++j_) _Pragma("unroll") for (int r_ = 0; r_ < 4; ++r_) v_[4 * j_ + r_] = __builtin_nontemporal_load((const GAS f32x4*)(src_ + (size_t)(16 * j_ + r_) * (m_).ldw)); } while (0)
#define MOE_TOLDS(v_) do { LAS unsigned* s_ = scr + (4 * (lane & 15)) * 17 + (lane >> 4); \
        _Pragma("unroll") for (int j_ = 0; j_ < 4; ++j_) { \
            s_[0 * 17 + 4 * j_] = pk4_fp8(v_[4 * j_][0] * MOE_WSCALE, v_[4 * j_ + 1][0] * MOE_WSCALE, v_[4 * j_ + 2][0] * MOE_WSCALE, v_[4 * j_ + 3][0] * MOE_WSCALE); \
            s_[1 * 17 + 4 * j_] = pk4_fp8(v_[4 * j_][1] * MOE_WSCALE, v_[4 * j_ + 1][1] * MOE_WSCALE, v_[4 * j_ + 2][1] * MOE_WSCALE, v_[4 * j_ + 3][1] * MOE_WSCALE); \
            s_[2 * 17 + 4 * j_] = pk4_fp8(v_[4 * j_][2] * MOE_WSCALE, v_[4 * j_ + 1][2] * MOE_WSCALE, v_[4 * j_ + 2][2] * MOE_WSCALE, v_[4 * j_ + 3][2] * MOE_WSCALE); \
            s_[3 * 17 + 4 * j_] = pk4_fp8(v_[4 * j_][3] * MOE_WSCALE, v_[4 * j_ + 1][3] * MOE_WSCALE, v_[4 * j_ + 2][3] * MOE_WSCALE, v_[4 * j_ + 3][3] * MOE_WSCALE); } } while (0)
#define MOE_EMIT(m_) do { LDS_WAIT(); asm volatile("" ::: "memory"); \
        _Pragma("unroll") for (int jj_ = 0; jj_ < 4; ++jj_) { const int n_ = (lane >> 2) + 16 * jj_; const LAS unsigned* s_ = scr + n_ * 17 + 4 * (lane & 3); \
            v4u o_; o_.x = s_[0]; o_.y = s_[1]; o_.z = s_[2]; o_.w = s_[3]; \
            __builtin_nontemporal_store(o_, (GAS v4u*)((m_).dst + (size_t)((m_).r0 + n_) * 2048 + (m_).k0 + 16 * (lane & 3))); } \
        LDS_WAIT(); asm volatile("" ::: "memory"); } while (0)
template <int MODE>
__device__ __forceinline__ void moe_convert_share(Frame& F, const float* const* in) {
    LAS unsigned* scr = (LAS unsigned*)(F.lds + RING_OFF + F.wave * 4608);
    constexpr int NIT = NE * 32 * 64 + NE * 32 * 32;
    const int per = (NIT + F.G - 1) / F.G, lo = F.vcu * per, hi = (lo + per < NIT) ? lo + per : NIT, lane = F.lane;
    int it = lo + F.wave;
    f32x4 va[16], vb[16];
    MoeItem ma = moe_item(F, in, it < hi ? it : lo), mb = moe_item(F, in, it + NWAVES < hi ? it + NWAVES : lo);
    if (it < hi) MOE_LOADS(va, ma);
    if (it + NWAVES < hi) MOE_LOADS(vb, mb);
    for (; it < hi; it += 2 * NWAVES) {
        if (MODE == 0) MOE_TOLDS(va); else { _Pragma("unroll") for (int i_ = 0; i_ < 16; ++i_) asm volatile("" :: "v"(va[i_])); }
        const MoeItem na = moe_item(F, in, it + 2 * NWAVES < hi ? it + 2 * NWAVES : lo);
        if (it + 2 * NWAVES < hi) MOE_LOADS(va, na);
        if (MODE == 0) MOE_EMIT(ma);
        if (it + NWAVES < hi) {
            if (MODE == 0) MOE_TOLDS(vb); else { _Pragma("unroll") for (int i_ = 0; i_ < 16; ++i_) asm volatile("" :: "v"(vb[i_])); }
            const MoeItem nb = moe_item(F, in, it + 3 * NWAVES < hi ? it + 3 * NWAVES : lo);
            if (it + 3 * NWAVES < hi) MOE_LOADS(vb, nb);
            if (MODE == 0) MOE_EMIT(mb);
            mb = nb;
        }
        ma = na;
    }
    __syncthreads();
}
#define MOE_LOADS_ASM(v_, m_) do { const GAS float* src_ = (const GAS float*)(m_).src + (size_t)(4 * (lane >> 4)) * (m_).ldw + (lane & 15) * 4; \
        _Pragma("unroll") for (int j_ = 0; j_ < 4; ++j_) _Pragma("unroll") for (int r_ = 0; r_ < 4; ++r_) { const GAS float* p_ = src_ + (size_t)(16 * j_ + r_) * (m_).ldw; \
            asm volatile("global_load_dwordx4 %0, %1, off nt" : "=v"(v_[4 * j_ + r_]) : "v"(p_) : "memory"); } } while (0)
#define MOE_WAIT_ASM(v_, n_) asm volatile("s_waitcnt vmcnt(" #n_ ")" : "+v"(v_[0]), "+v"(v_[1]), "+v"(v_[2]), "+v"(v_[3]), "+v"(v_[4]), "+v"(v_[5]), "+v"(v_[6]), "+v"(v_[7]), \
        "+v"(v_[8]), "+v"(v_[9]), "+v"(v_[10]), "+v"(v_[11]), "+v"(v_[12]), "+v"(v_[13]), "+v"(v_[14]), "+v"(v_[15]) :: "memory")
__device__ __forceinline__ MoeItem moe_super(Frame& F, const float* const* in, int s) {
    constexpr int S10 = NE * 16 * 64;
    MoeItem m;
    if (s < S10) { const int e = s / 1024, q = s % 1024, kb = q / 64, cb = q % 64;
        m.r0 = cb < 32 ? 256 * (cb >> 1) + 64 * (cb & 1) : 256 * ((cb - 32) >> 1) + 128 + 64 * (cb & 1);
        m.src = in[29] + (size_t)e * 2048 * 4096 + (size_t)(128 * kb) * 4096 + 64 * cb; m.ldw = 4096; m.dst = WSP(unsigned char, WS_WGUT) + (size_t)e * 4096 * 2048; m.k0 = 128 * kb; }
    else { const int r = s - S10, e = r / 512, q = r % 512, kb = q / 32, cb = q % 32;
        m.r0 = 64 * cb; m.src = in[31] + (size_t)e * 2048 * 2048 + (size_t)(128 * kb) * 2048 + 64 * cb; m.ldw = 2048; m.dst = WSP(unsigned char, WS_WDT) + (size_t)e * 2048 * 2048; m.k0 = 128 * kb; }
    return m;
}
#define MOE_TOLDS33(v_, h_) do { LAS unsigned* s_ = scr + (4 * (lane & 15)) * 33 + (lane >> 4) + 16 * (h_); \
        _Pragma("unroll") for (int j_ = 0; j_ < 4; ++j_) { \
            s_[0 * 33 + 4 * j_] = pk4_fp8(v_[4 * j_][0] * MOE_WSCALE, v_[4 * j_ + 1][0] * MOE_WSCALE, v_[4 * j_ + 2][0] * MOE_WSCALE, v_[4 * j_ + 3][0] * MOE_WSCALE); \
            s_[1 * 33 + 4 * j_] = pk4_fp8(v_[4 * j_][1] * MOE_WSCALE, v_[4 * j_ + 1][1] * MOE_WSCALE, v_[4 * j_ + 2][1] * MOE_WSCALE, v_[4 * j_ + 3][1] * MOE_WSCALE); \
            s_[2 * 33 + 4 * j_] = pk4_fp8(v_[4 * j_][2] * MOE_WSCALE, v_[4 * j_ + 1][2] * MOE_WSCALE, v_[4 * j_ + 2][2] * MOE_WSCALE, v_[4 * j_ + 3][2] * MOE_WSCALE); \
            s_[3 * 33 + 4 * j_] = pk4_fp8(v_[4 * j_][3] * MOE_WSCALE, v_[4 * j_ + 1][3] * MOE_WSCALE, v_[4 * j_ + 2][3] * MOE_WSCALE, v_[4 * j_ + 3][3] * MOE_WSCALE); } } while (0)
#define MOE_EMIT33(m_) do { LDS_WAIT(); asm volatile("" ::: "memory"); \
        _Pragma("unroll") for (int jj_ = 0; jj_ < 8; ++jj_) { const int n_ = (lane >> 3) + 8 * jj_; const LAS unsigned* s_ = scr + n_ * 33 + 4 * (lane & 7); \
            v4u o_; o_.x = s_[0]; o_.y = s_[1]; o_.z = s_[2]; o_.w = s_[3]; \
            __builtin_nontemporal_store(o_, (GAS v4u*)((m_).dst + (size_t)((m_).r0 + n_) * 2048 + (m_).k0 + 16 * (lane & 7))); } \
        LDS_WAIT(); asm volatile("" ::: "memory"); } while (0)
template <int NW>
__device__ __forceinline__ void moe_convert_share_w(Frame& F, const float* const* in, const int cw, LAS unsigned* scr, const int lane) {
    constexpr int NSUP = NE * 16 * 64 + NE * 16 * 32, PER = NSUP / 256;
    static_assert(PER % NW == 0, "equal shares");
    const int lo = F.vcu * PER, hi = lo + PER;
    int it = lo + cw;
    f32x4 va[16], vb[16];
    MoeItem m = moe_super(F, in, it), mh = m;
    mh.src += (size_t)64 * m.ldw;
    MOE_LOADS_ASM(va, m);
    MOE_LOADS_ASM(vb, mh);
    bool first = true;
    for (; it < hi; it += NW) {
        MoeItem n = moe_super(F, in, it + NW < hi ? it + NW : lo), nh = n;
        nh.src += (size_t)64 * n.ldw;
        MOE_WAIT_ASM(va, 16);
        MOE_TOLDS33(va, 0);
        MOE_LOADS_ASM(va, n);
        MOE_WAIT_ASM(vb, 16);
        MOE_TOLDS33(vb, 1);
        MOE_LOADS_ASM(vb, nh);
        MOE_EMIT33(m);
        m = n; first = false;
    }
    MOE_WAIT_ASM(va, 0); MOE_WAIT_ASM(vb, 0);
}
#undef MOE_TOLDS33
#undef MOE_EMIT33
__device__ __forceinline__ MoeItem moe_super256(Frame& F, const float* const* in, int s) {
    constexpr int S10 = NE * 8 * 64;
    MoeItem m;
    if (s < S10) { const int e = s / 512, q = s % 512, kb = q / 64, cb = q % 64;
        m.r0 = cb < 32 ? 256 * (cb >> 1) + 64 * (cb & 1) : 256 * ((cb - 32) >> 1) + 128 + 64 * (cb & 1);
        m.src = in[29] + (size_t)e * 2048 * 4096 + (size_t)(256 * kb) * 4096 + 64 * cb; m.ldw = 4096; m.dst = WSP(unsigned char, WS_WGUT) + (size_t)e * 4096 * 2048; m.k0 = 256 * kb; }
    else { const int r = s - S10, e = r / 256, q = r % 256, kb = q / 32, cb = q % 32;
        m.r0 = 64 * cb; m.src = in[31] + (size_t)e * 2048 * 2048 + (size_t)(256 * kb) * 2048 + 64 * cb; m.ldw = 2048; m.dst = WSP(unsigned char, WS_WDT) + (size_t)e * 2048 * 2048; m.k0 = 256 * kb; }
    return m;
}
#define MOE_TOLDS65(v_, h_) do { LAS unsigned* s_ = scr + (4 * (lane & 15)) * 65 + (lane >> 4) + 16 * (h_); \
        _Pragma("unroll") for (int j_ = 0; j_ < 4; ++j_) { \
            s_[0 * 65 + 4 * j_] = pk4_fp8(v_[4 * j_][0] * MOE_WSCALE, v_[4 * j_ + 1][0] * MOE_WSCALE, v_[4 * j_ + 2][0] * MOE_WSCALE, v_[4 * j_ + 3][0] * MOE_WSCALE); \
            s_[1 * 65 + 4 * j_] = pk4_fp8(v_[4 * j_][1] * MOE_WSCALE, v_[4 * j_ + 1][1] * MOE_WSCALE, v_[4 * j_ + 2][1] * MOE_WSCALE, v_[4 * j_ + 3][1] * MOE_WSCALE); \
            s_[2 * 65 + 4 * j_] = pk4_fp8(v_[4 * j_][2] * MOE_WSCALE, v_[4 * j_ + 1][2] * MOE_WSCALE, v_[4 * j_ + 2][2] * MOE_WSCALE, v_[4 * j_ + 3][2] * MOE_WSCALE); \
            s_[3 * 65 + 4 * j_] = pk4_fp8(v_[4 * j_][3] * MOE_WSCALE, v_[4 * j_ + 1][3] * MOE_WSCALE, v_[4 * j_ + 2][3] * MOE_WSCALE, v_[4 * j_ + 3][3] * MOE_WSCALE); } } while (0)
#define MOE_EMIT65(m_) do { LDS_WAIT(); asm volatile("" ::: "memory"); \
        _Pragma("unroll") for (int jj_ = 0; jj_ < 16; ++jj_) { const int n_ = (lane >> 4) + 4 * jj_; const LAS unsigned* s_ = scr + n_ * 65 + 4 * (lane & 15); \
            v4u o_; o_.x = s_[0]; o_.y = s_[1]; o_.z = s_[2]; o_.w = s_[3]; \
            __builtin_nontemporal_store(o_, (GAS v4u*)((m_).dst + (size_t)((m_).r0 + n_) * 2048 + (m_).k0 + 16 * (lane & 15))); } \
        LDS_WAIT(); asm volatile("" ::: "memory"); } while (0)
#define MOE_Q(m_, q_) MoeItem{(m_).src + (size_t)(64 * (q_)) * (m_).ldw, (m_).ldw, (m_).dst, (m_).r0, (m_).k0}
template <int NW>
__device__ __forceinline__ void moe_convert_range256(Frame& F, const float* const* in, const int cw, LAS unsigned* scr, const int lane, const int lo, const int hi) {
    int it = lo + cw;
    f32x4 va[16], vb[16];
    MoeItem m = moe_super256(F, in, it);
    { const MoeItem q0 = MOE_Q(m, 0), q1 = MOE_Q(m, 1); MOE_LOADS_ASM(va, q0); MOE_LOADS_ASM(vb, q1); }
    bool first = true;
    for (; it < hi; it += NW) {
        const MoeItem n = moe_super256(F, in, it + NW < hi ? it + NW : lo);
        const MoeItem q2 = MOE_Q(m, 2), q3 = MOE_Q(m, 3), n0 = MOE_Q(n, 0), n1 = MOE_Q(n, 1);
        MOE_WAIT_ASM(va, 16);
        MOE_TOLDS65(va, 0); MOE_LOADS_ASM(va, q2);
        MOE_WAIT_ASM(vb, 16);
        MOE_TOLDS65(vb, 1); MOE_LOADS_ASM(vb, q3);
        MOE_WAIT_ASM(va, 16);
        MOE_TOLDS65(va, 2); MOE_LOADS_ASM(va, n0);
        MOE_WAIT_ASM(vb, 16);
        MOE_TOLDS65(vb, 3); MOE_LOADS_ASM(vb, n1);
        MOE_EMIT65(m);
        if (CONV_SLEEP > 0) __builtin_amdgcn_s_sleep(CONV_SLEEP);
        m = n; first = false;
    }
    MOE_WAIT_ASM(va, 0); MOE_WAIT_ASM(vb, 0);
}
constexpr int CONV_NSUP = NE * 8 * 64 + NE * 8 * 32, CONV_OFF_CUS = (CONV_OFFLOAD == 2) ? 160 : 128, CONV_OFF = CONV_OFFLOAD ? 8 * CONV_OFF_CUS : 0, CONV_PER5 = (CONV_NSUP - CONV_OFF) / 256;
static_assert((CONV_NSUP - CONV_OFF) % 256 == 0, "equal shares per workgroup");
template <int NW>
__device__ __forceinline__ void moe_convert_share_w256(Frame& F, const float* const* in, const int cw, LAS unsigned* scr, const int lane) {
    moe_convert_range256<NW>(F, in, cw, scr, lane, F.vcu * CONV_PER5, F.vcu * CONV_PER5 + CONV_PER5);
}
#undef MOE_TOLDS65
#undef MOE_EMIT65
#undef MOE_Q
#undef MOE_LOADS_ASM
#undef MOE_WAIT_ASM
#undef MOE_LOADS
#undef MOE_TOLDS
#undef MOE_EMIT

__device__ __forceinline__ void moe_convert_share_dma(Frame& F, const float* const* in) {
    LAS unsigned char* wbase = F.lds + RING_OFF + F.wave * 16640;
    LAS unsigned* tile2 = (LAS unsigned*)(wbase + 12288);
    constexpr int NIT = NE * 32 * 64 + NE * 32 * 32;
    const int per = (NIT + F.G - 1) / F.G, lo = F.vcu * per, hi = (lo + per < NIT) ? lo + per : NIT, lane = F.lane;
    const int nitems = (hi - lo - F.wave + NWAVES - 1) / NWAVES;
    if (nitems > 0) {
        const int nchunks = nitems * 4;
        const int ng = lane & 15, kr = lane >> 4;
#define CDMA_ISSUE(c_) do { const MoeItem m_ = moe_item(F, in, lo + F.wave + NWAVES * ((c_) >> 2)); const int kc_ = (c_) & 3; \
            const GAS unsigned char* g_ = (const GAS unsigned char*)m_.src + ((size_t)(16 * kc_ + kr) * m_.ldw + (size_t)ng * 4) * 4; LAS unsigned char* l_ = wbase + ((c_) % 3) * 4096; \
            _Pragma("unroll") for (int q_ = 0; q_ < 4; ++q_) __builtin_amdgcn_global_load_lds((const GAS unsigned*)(g_ + (size_t)(4 * q_) * m_.ldw * 4), (LAS unsigned*)(l_ + q_ * 1024), 16, 0, 2); } while (0)
        CDMA_ISSUE(0);
        if (nchunks > 1) CDMA_ISSUE(1);
        for (int c = 0; c < nchunks; ++c) {
            if (c + 2 < nchunks) { CDMA_ISSUE(c + 2); asm volatile("s_waitcnt vmcnt(8)" ::: "memory"); }
            else if (c + 1 < nchunks) asm volatile("s_waitcnt vmcnt(4)" ::: "memory");
            else asm volatile("s_waitcnt vmcnt(0)" ::: "memory");
            const LAS unsigned char* cb = wbase + (c % 3) * 4096 + (4 * kr) * 256 + ng * 16;
            const f32x4 r0 = *(const LAS f32x4*)(cb), r1 = *(const LAS f32x4*)(cb + 256), r2 = *(const LAS f32x4*)(cb + 512), r3 = *(const LAS f32x4*)(cb + 768);
            LAS unsigned* t2 = tile2 + (4 * ng) * 17 + 4 * (c & 3) + kr;
            t2[0 * 17] = pk4_fp8(r0[0] * MOE_WSCALE, r1[0] * MOE_WSCALE, r2[0] * MOE_WSCALE, r3[0] * MOE_WSCALE);
            t2[1 * 17] = pk4_fp8(r0[1] * MOE_WSCALE, r1[1] * MOE_WSCALE, r2[1] * MOE_WSCALE, r3[1] * MOE_WSCALE);
            t2[2 * 17] = pk4_fp8(r0[2] * MOE_WSCALE, r1[2] * MOE_WSCALE, r2[2] * MOE_WSCALE, r3[2] * MOE_WSCALE);
            t2[3 * 17] = pk4_fp8(r0[3] * MOE_WSCALE, r1[3] * MOE_WSCALE, r2[3] * MOE_WSCALE, r3[3] * MOE_WSCALE);
            LDS_WAIT(); asm volatile("" ::: "memory");
            if ((c & 3) == 3) {
                const MoeItem m = moe_item(F, in, lo + F.wave + NWAVES * (c >> 2));
#pragma unroll
                for (int jj = 0; jj < 4; ++jj) { const int n = (lane >> 2) + 16 * jj; const LAS unsigned* s = tile2 + n * 17 + 4 * (lane & 3);
                    v4u o; o.x = s[0]; o.y = s[1]; o.z = s[2]; o.w = s[3];
                    __builtin_nontemporal_store(o, (GAS v4u*)(m.dst + (size_t)(m.r0 + n) * 2048 + m.k0 + 16 * (lane & 3))); }
                LDS_WAIT(); asm volatile("" ::: "memory");
            }
        }
#undef CDMA_ISSUE
    }
    asm volatile("s_waitcnt vmcnt(0)" ::: "memory");
    __syncthreads();
}

struct MoeItem256 { const float* src; size_t ldw; unsigned char* dst; int rowbase; int rowmode; int k0; };
__device__ __forceinline__ MoeItem256 moe_item256(Frame& F, const float* const* in, int it) {
    constexpr int I10 = NE * 32 * 64;
    MoeItem256 m;
    if (it < I10) { const int e = it / 2048, q = it % 2048, kb = q / 16, cb = q % 16; const bool gate = cb < 8; const int grp0 = gate ? 2 * cb : 2 * (cb - 8);
        m.src = in[29] + (size_t)e * 2048 * 4096 + (size_t)(16 * kb) * 4096 + 256 * cb; m.ldw = 4096; m.dst = WSP(unsigned char, WS_WGUT) + (size_t)e * 4096 * 2048;
        m.rowbase = 256 * grp0 + (gate ? 0 : 128); m.rowmode = 1; m.k0 = 16 * kb; }
    else { const int r = it - I10, e = r / 1024, q = r % 1024, kb = q / 8, cb = q % 8;
        m.src = in[31] + (size_t)e * 2048 * 2048 + (size_t)(16 * kb) * 2048 + 256 * cb; m.ldw = 2048; m.dst = WSP(unsigned char, WS_WDT) + (size_t)e * 2048 * 2048;
        m.rowbase = 256 * cb; m.rowmode = 0; m.k0 = 16 * kb; }
    return m;
}
__device__ __forceinline__ void moe_convert_share_dma256(Frame& F, const float* const* in) {
    LAS unsigned char* wbase = F.lds + RING_OFF + F.wave * 16640;
    LAS unsigned* tile2 = (LAS unsigned*)(wbase + 12288);
    constexpr int NIT = NE * 32 * 64 + NE * 32 * 32;
    const int per = (NIT + F.G - 1) / F.G, lo = F.vcu * per, hi = (lo + per < NIT) ? lo + per : NIT, lane = F.lane;
    const int nitems = (hi - lo - F.wave + NWAVES - 1) / NWAVES;
    if (nitems > 0) {
        const int nchunks = nitems * 4;
#define C256_ISSUE(c_) do { const MoeItem256 m_ = moe_item256(F, in, lo + F.wave + NWAVES * ((c_) >> 2)); const int kc_ = (c_) & 3; \
            const GAS unsigned char* g_ = (const GAS unsigned char*)m_.src + ((size_t)(4 * kc_) * m_.ldw + (size_t)lane * 4) * 4; LAS unsigned char* l_ = wbase + ((c_) % 3) * 4096; \
            _Pragma("unroll") for (int r_ = 0; r_ < 4; ++r_) __builtin_amdgcn_global_load_lds((const GAS unsigned*)(g_ + (size_t)r_ * m_.ldw * 4), (LAS unsigned*)(l_ + r_ * 1024), 16, 0, 2); } while (0)
        C256_ISSUE(0);
        if (nchunks > 1) C256_ISSUE(1);
        for (int c = 0; c < nchunks; ++c) {
            if (c + 2 < nchunks) { C256_ISSUE(c + 2); asm volatile("s_waitcnt vmcnt(8)" ::: "memory"); }
            else if (c + 1 < nchunks) asm volatile("s_waitcnt vmcnt(4)" ::: "memory");
            else asm volatile("s_waitcnt vmcnt(0)" ::: "memory");
            const LAS float* cb = (const LAS float*)(wbase + (c % 3) * 4096) + lane;
            LAS unsigned* t2 = tile2 + (c & 3) * 256 + lane;
#pragma unroll
            for (int cc = 0; cc < 4; ++cc) t2[64 * cc] = pk4_fp8(cb[64 * cc] * MOE_WSCALE, cb[256 + 64 * cc] * MOE_WSCALE, cb[512 + 64 * cc] * MOE_WSCALE, cb[768 + 64 * cc] * MOE_WSCALE);
            LDS_WAIT(); asm volatile("" ::: "memory");
            if ((c & 3) == 3) {
                const MoeItem256 m = moe_item256(F, in, lo + F.wave + NWAVES * (c >> 2));
#pragma unroll
                for (int cc = 0; cc < 4; ++cc) { const LAS unsigned* s = tile2 + lane + 64 * cc;
                    v4u o; o.x = s[0]; o.y = s[256]; o.z = s[512]; o.w = s[768];
                    const int row = m.rowbase + (m.rowmode ? 256 * (cc >> 1) + lane + 64 * (cc & 1) : lane + 64 * cc);
                    __builtin_nontemporal_store(o, (GAS v4u*)(m.dst + (size_t)row * 2048 + m.k0)); }
                LDS_WAIT(); asm volatile("" ::: "memory");
            }
        }
#undef C256_ISSUE
    }
    asm volatile("s_waitcnt vmcnt(0)" ::: "memory");
    __syncthreads();
}

struct ConvState { int lo, nchunks, c, cw; };
template <int NCW>
__device__ __forceinline__ void conv_steps(Frame& F, const float* const* in, ConvState& S, LAS unsigned char* wbase, int nsteps, int lane) {
    LAS unsigned* tile2 = (LAS unsigned*)(wbase + 12288);
    const int ng = lane & 15, kr = lane >> 4;
#define CS_ISSUE(c_) do { const MoeItem m_ = moe_item(F, in, S.lo + S.cw + NCW * ((c_) >> 2)); const int kc_ = (c_) & 3; \
        const GAS unsigned char* g_ = (const GAS unsigned char*)m_.src + ((size_t)(16 * kc_ + kr) * m_.ldw + (size_t)ng * 4) * 4; LAS unsigned char* l_ = wbase + ((c_) % 3) * 4096; \
        _Pragma("unroll") for (int q_ = 0; q_ < 4; ++q_) __builtin_amdgcn_global_load_lds((const GAS unsigned*)(g_ + (size_t)(4 * q_) * m_.ldw * 4), (LAS unsigned*)(l_ + q_ * 1024), 16, 0, 2); } while (0)
    if (S.c < 0) { S.c = 0; if (S.nchunks > 0) CS_ISSUE(0); if (S.nchunks > 1) CS_ISSUE(1); }
    for (int st = 0; st < nsteps && S.c < S.nchunks; ++st) {
        const int c = S.c;
        if (c + 2 < S.nchunks) { CS_ISSUE(c + 2); asm volatile("s_waitcnt vmcnt(8)" ::: "memory"); }
        else if (c + 1 < S.nchunks) asm volatile("s_waitcnt vmcnt(4)" ::: "memory");
        else asm volatile("s_waitcnt vmcnt(0)" ::: "memory");
        const LAS unsigned char* cb = wbase + (c % 3) * 4096 + (4 * kr) * 256 + ng * 16;
        const f32x4 r0 = *(const LAS f32x4*)(cb), r1 = *(const LAS f32x4*)(cb + 256), r2 = *(const LAS f32x4*)(cb + 512), r3 = *(const LAS f32x4*)(cb + 768);
        LAS unsigned* t2 = tile2 + (4 * ng) * 17 + 4 * (c & 3) + kr;
        t2[0 * 17] = pk4_fp8(r0[0] * MOE_WSCALE, r1[0] * MOE_WSCALE, r2[0] * MOE_WSCALE, r3[0] * MOE_WSCALE);
        t2[1 * 17] = pk4_fp8(r0[1] * MOE_WSCALE, r1[1] * MOE_WSCALE, r2[1] * MOE_WSCALE, r3[1] * MOE_WSCALE);
        t2[2 * 17] = pk4_fp8(r0[2] * MOE_WSCALE, r1[2] * MOE_WSCALE, r2[2] * MOE_WSCALE, r3[2] * MOE_WSCALE);
        t2[3 * 17] = pk4_fp8(r0[3] * MOE_WSCALE, r1[3] * MOE_WSCALE, r2[3] * MOE_WSCALE, r3[3] * MOE_WSCALE);
        LDS_WAIT(); asm volatile("" ::: "memory");
        if ((c & 3) == 3) {
            const MoeItem m = moe_item(F, in, S.lo + S.cw + NCW * (c >> 2));
#pragma unroll
            for (int jj = 0; jj < 4; ++jj) { const int n = (lane >> 2) + 16 * jj; const LAS unsigned* s = tile2 + n * 17 + 4 * (lane & 3);
                v4u o; o.x = s[0]; o.y = s[1]; o.z = s[2]; o.w = s[3];
                __builtin_nontemporal_store(o, (GAS v4u*)(m.dst + (size_t)(m.r0 + n) * 2048 + m.k0 + 16 * (lane & 3))); }
            LDS_WAIT(); asm volatile("" ::: "memory");
        }
        S.c = c + 1;
    }
#undef CS_ISSUE
}

__device__ __forceinline__ float group16_sum(float v) { if (XL_FAST) return xl_sum16(v); v += __shfl_xor(v, 1); v += __shfl_xor(v, 2); v += __shfl_xor(v, 4); v += __shfl_xor(v, 8); return v; }
__device__ __forceinline__ void p2_token(Frame& F, const float* const* in, int t) {
    const int l = F.lane;
    const GAS bf16* row = (const GAS bf16*)WSP(bf16, WS_P1) + (size_t)t * P1N;
    { float a[8], b[8]; unpack8(*(const GAS v4u*)(row + P1_V + 16 * l), a); unpack8(*(const GAS v4u*)(row + P1_V + 16 * l + 8), b);
      float s = 0.f;
#pragma unroll
      for (int i = 0; i < 8; ++i) s += a[i] + b[i];
      const float mean = wave_sum(s) * (1.f / 1024.f); float q = 0.f;
#pragma unroll
      for (int i = 0; i < 8; ++i) { const float d0 = a[i] - mean, d1 = b[i] - mean; q += d0 * d0 + d1 * d1; }
      const float rstd = 1.0f * FAST_RSQ(wave_sum(q) * (1.f / 1024.f) + EPS);
      if (l == 0) { GAS float* vs = (GAS float*)WSP(float, WS_VSTAT) + (size_t)t * 2; vs[0] = mean; vs[1] = rstd; } }
#pragma unroll
    for (int w = 0; w < 2; ++w) {
        float a[8]; unpack8(*(const GAS v4u*)(row + (w ? P1_CKV : P1_CQ) + 8 * l), a);
        float s = 0.f;
#pragma unroll
        for (int i = 0; i < 8; ++i) s += a[i] * a[i];
        const float rs = 1.0f * FAST_RSQ(wave_sum(s) * (1.f / 512.f) + EPS);
        const GAS float* g = (const GAS float*)(w ? in[14] : in[12]) + 8 * l;
        const f32x4 g0 = *(const GAS f32x4*)g, g1 = *(const GAS f32x4*)(g + 4);
        float o[8] = {a[0] * rs * g0.x, a[1] * rs * g0.y, a[2] * rs * g0.z, a[3] * rs * g0.w, a[4] * rs * g1.x, a[5] * rs * g1.y, a[6] * rs * g1.z, a[7] * rs * g1.w};
        u32x2 w8; w8.x = pk4_fp8(o[0], o[1], o[2], o[3]); w8.y = pk4_fp8(o[4], o[5], o[6], o[7]);
        *(GAS u32x2*)((GAS unsigned char*)WSP(unsigned char, w ? WS_CKVN : WS_CQN) + (size_t)t * 512 + 8 * l) = w8;
    }
    { float a[8], b[8]; unpack8(*(const GAS v4u*)(row + P1_QM + 16 * l), a); unpack8(*(const GAS v4u*)(row + P1_QM + 16 * l + 8), b);
      float s = 0.f;
#pragma unroll
      for (int i = 0; i < 8; ++i) s += a[i] * a[i] + b[i] * b[i];
      const float rs = MEM_QSCALE * FAST_RSQ(group16_sum(s) * (1.f / 256.f) + EPS);
      const GAS float* g = (const GAS float*)in[22] + (l & 15) * 16;
      float ga[8], gb[8];
#pragma unroll
      for (int i = 0; i < 8; ++i) { ga[i] = g[i]; gb[i] = g[8 + i]; }
#pragma unroll
      for (int i = 0; i < 8; ++i) { a[i] *= rs * ga[i]; b[i] *= rs * gb[i]; }
      const int bb = t >> 12, tl = t & 4095, h = l >> 4;
      GAS bf16* dst = (GAS bf16*)WSP(bf16, WS_QMN) + ((size_t)((bb * 4 + h) * 4096 + tl)) * 256 + (l & 15) * 16;
      *(GAS v4u*)dst = packf8(a); *(GAS v4u*)(dst + 8) = packf8(b); }
    { float t1 = 0.f, t2 = 0.f;
      if (l < 32) { t1 = bflo((unsigned)row[P1_KR + l]); t2 = bflo((unsigned)row[P1_KR + 32 + l]); }
      const float ss = wave_sum(t1 * t1 + t2 * t2);
      if (l < 32) {
          const float pos = (float)((const GAS int*)in[2])[t];
          const float inv = 1.0f / powf(10000.0f, (float)(2 * l) / 64.0f);
          const float ang = pos * inv, c = cosf(ang), s = sinf(ang);
          GAS float* rp = (GAS float*)WSP(float, WS_ROPE) + (size_t)t * 64; rp[l] = c; rp[32 + l] = s;
          const GAS float* kg = (const GAS float*)in[17];
          const float a = t1 * kg[128 + l], b = t2 * kg[160 + l];
          GAS float* kr = (GAS float*)WSP(float, WS_KRR) + (size_t)t * 64; kr[l] = a * c - b * s; kr[32 + l] = a * s + b * c;
          if (l == 0) ((GAS float*)WSP(float, WS_KRSS))[t] = ss;
      } }
}
__device__ __forceinline__ void p2_memrow(Frame& F, const float* const* in, int m) {
    const int l = F.lane, bb = m >> 8, ml = m & 255, tile = ml >> 6, key = ml & 63, h = l >> 4, d0 = (l & 15) * 16;
    const GAS bf16* row = (const GAS bf16*)WSP(bf16, WS_MKV) + (size_t)m * 2048;
    { float a[8], b[8]; unpack8(*(const GAS v4u*)(row + 16 * l), a); unpack8(*(const GAS v4u*)(row + 16 * l + 8), b);
      float s = 0.f;
#pragma unroll
      for (int i = 0; i < 8; ++i) s += a[i] * a[i] + b[i] * b[i];
      const float rs = 1.0f * FAST_RSQ(group16_sum(s) * (1.f / 256.f) + EPS);
      const GAS float* g = (const GAS float*)in[23] + d0;
#pragma unroll
      for (int i = 0; i < 8; ++i) { a[i] *= rs * g[i]; b[i] *= rs * g[8 + i]; }
      GAS bf16* base = (GAS bf16*)WSP(bf16, WS_MKT) + (size_t)((bb * 4 + h) * 4 + tile) * (32 * 64 * 8);
      const int c0 = d0 >> 3;
      *(GAS v4u*)(base + ((size_t)c0 * 64 + key) * 8) = packf8(a); *(GAS v4u*)(base + ((size_t)(c0 + 1) * 64 + key) * 8) = packf8(b); }
    { const v4u a = *(const GAS v4u*)(row + 1024 + 16 * l), b = *(const GAS v4u*)(row + 1024 + 16 * l + 8);
      const int half = d0 >> 7, cb = (d0 & 127) >> 5, off = d0 & 31;
      GAS bf16* base = (GAS bf16*)WSP(bf16, WS_MVT) + (size_t)(((bb * 4 + h) * 2 + half) * 4 + tile) * (4 * 64 * 32);
      GAS bf16* dst = base + ((size_t)cb * 64 + key) * 32 + off;
      *(GAS v4u*)dst = a; *(GAS v4u*)(dst + 8) = b; }
}

__device__ __forceinline__ void gmlp_unit(Frame& F, const float* const* in, int u) {
    const int ci = u >> 3, g = u & 7, tok0 = ci * 128, tid = F.tid, l = F.lane, r32 = l & 31, hi = l >> 5;
    LAS bf16* VT = (LAS bf16*)(F.lds + RING_OFF);
    const GAS bf16* P1 = (const GAS bf16*)WSP(bf16, WS_P1);
    { const int s = tid >> 2, qd = tid & 3;
      const GAS float* vs = (const GAS float*)WSP(float, WS_VSTAT) + (size_t)(tok0 + s) * 2; const float mean = vs[0], rstd = vs[1];
      const GAS bf16* src = P1 + (size_t)(tok0 + s) * P1N + P1_V + g * 128 + qd * 32;
      const GAS float* lg = (const GAS float*)in[7] + g * 128 + qd * 32; const GAS float* lb = (const GAS float*)in[8] + g * 128 + qd * 32;
#pragma unroll
      for (int i = 0; i < 4; ++i) { float a[8]; unpack8(*(const GAS v4u*)(src + 8 * i), a);
#pragma unroll
          for (int k = 0; k < 8; ++k) { const int c = qd * 32 + 8 * i + k; const float v = (a[k] - mean) * rstd * lg[8 * i + k] + lb[8 * i + k]; VT[c * 136 + s] = (bf16)(cvtpk(v, 0.f) & 0xffffu); } } }
    __syncthreads();
    const int w = F.wave, tb = w >> 1, cbp = (w & 1) * 2;
    f32x16 acc[2];
#pragma unroll
    for (int r = 0; r < 16; ++r) { acc[0][r] = 0.f; acc[1][r] = 0.f; }
    const GAS bf16* wsm = (const GAS bf16*)WSP(bf16, WS_WSM) + ((size_t)(g * 128 + 32 * tb + r32)) * 128 + 8 * hi;
    for (int ks = 0; ks < 2 * (tb + 1); ++ks) {
        const bf16x8 af = *(const GAS bf16x8*)(wsm + 16 * ks);
#pragma unroll
        for (int cc = 0; cc < 2; ++cc) { const bf16x8 bfr = *(const LAS bf16x8*)(VT + (32 * (cbp + cc) + r32) * 136 + 16 * ks + 8 * hi);
            acc[cc] = __builtin_amdgcn_mfma_f32_32x32x16_bf16(af, bfr, acc[cc], 0, 0, 0); }
    }
    const GAS float* bs = (const GAS float*)in[10] + g * 128;
    GAS bf16* AO = (GAS bf16*)WSP(bf16, WS_ABC);
#pragma unroll
    for (int cc = 0; cc < 2; ++cc)
#pragma unroll
        for (int r = 0; r < 16; ++r) { const int t = 32 * tb + crow(r, hi), tok = tok0 + t, ch = g * 128 + 32 * (cbp + cc) + r32;
            const float uu = bflo((unsigned)P1[(size_t)tok * P1N + P1_U + ch]);
            AO[(size_t)tok * ABC_LD + ch] = (bf16)(cvtpk(uu * (acc[cc][r] + bs[t]), 0.f) & 0xffffu); }
    __syncthreads();
}

__device__ __forceinline__ void p4_token(Frame& F, const float* const* in, int t) {
    const int l = F.lane, bb = t >> 12, tl = t & 4095, tile = tl >> 6, key = tl & 63, h = l >> 2, sub = l & 3;
    const GAS float* rope = (const GAS float*)WSP(float, WS_ROPE) + (size_t)t * 64;
    { const GAS bf16* qr = (const GAS bf16*)WSP(bf16, WS_QRAW) + (size_t)t * 3072 + h * 192;
      float x[4][8], y[2][8];
#pragma unroll
      for (int i = 0; i < 4; ++i) unpack8(*(const GAS v4u*)(qr + sub * 32 + 8 * i), x[i]);
#pragma unroll
      for (int i = 0; i < 2; ++i) unpack8(*(const GAS v4u*)(qr + 128 + sub * 16 + 8 * i), y[i]);
      float s = 0.f;
#pragma unroll
      for (int i = 0; i < 4; ++i)
#pragma unroll
          for (int k = 0; k < 8; ++k) s += x[i][k] * x[i][k];
#pragma unroll
      for (int i = 0; i < 2; ++i)
#pragma unroll
          for (int k = 0; k < 8; ++k) s += y[i][k] * y[i][k];
      s += __shfl_xor(s, 1); s += __shfl_xor(s, 2);
      const float rs = 1.0f * FAST_RSQ(s * (1.f / 192.f) + EPS);
      const GAS float* qg = (const GAS float*)in[16];
      GAS bf16* dst = (GAS bf16*)WSP(bf16, WS_QF) + ((size_t)((bb * 16 + h) * 4096 + tl)) * 192;
#pragma unroll
      for (int i = 0; i < 4; ++i) {
#pragma unroll
          for (int k = 0; k < 8; ++k) x[i][k] *= rs * qg[sub * 32 + 8 * i + k] * MLA_QSCALE;
          *(GAS v4u*)(dst + sub * 32 + 8 * i) = packf8(x[i]); }
#pragma unroll
      for (int i = 0; i < 2; ++i) { float o[8];
#pragma unroll
          for (int k = 0; k < 8; ++k) { const float mine = y[i][k] * rs * qg[128 + sub * 16 + 8 * i + k]; const float other = __shfl_xor(mine, 2);
              const int j = (sub & 1) * 16 + 8 * i + k; const float c = rope[j], sn = rope[32 + j];
              o[k] = (sub < 2 ? mine * c - other * sn : other * sn + mine * c) * MLA_QSCALE; }
          *(GAS v4u*)(dst + 128 + sub * 16 + 8 * i) = packf8(o); } }
    { const GAS bf16* kr = (const GAS bf16*)WSP(bf16, WS_KVRAW) + (size_t)t * 4096 + h * 256;
      float x[4][8];
#pragma unroll
      for (int i = 0; i < 4; ++i) unpack8(*(const GAS v4u*)(kr + sub * 32 + 8 * i), x[i]);
      float s = 0.f;
#pragma unroll
      for (int i = 0; i < 4; ++i)
#pragma unroll
          for (int k = 0; k < 8; ++k) s += x[i][k] * x[i][k];
      s += __shfl_xor(s, 1); s += __shfl_xor(s, 2);
      s += ((const GAS float*)WSP(float, WS_KRSS))[t];
      const float rs = 1.0f * FAST_RSQ(s * (1.f / 192.f) + EPS);
      const GAS float* kg = (const GAS float*)in[17];
      GAS bf16* kbase = (GAS bf16*)WSP(bf16, WS_KFT) + (size_t)((bb * 16 + h) * 64 + tile) * (24 * 64 * 8);
#pragma unroll
      for (int i = 0; i < 4; ++i) {
#pragma unroll
          for (int k = 0; k < 8; ++k) x[i][k] *= rs * kg[sub * 32 + 8 * i + k];
          *(GAS v4u*)(kbase + ((size_t)(sub * 4 + i) * 64 + key) * 8) = packf8(x[i]); }
      const GAS float* krr = (const GAS float*)WSP(float, WS_KRR) + (size_t)t * 64 + sub * 16;
#pragma unroll
      for (int i = 0; i < 2; ++i) { float o[8];
#pragma unroll
          for (int k = 0; k < 8; ++k) o[k] = krr[8 * i + k] * rs;
          *(GAS v4u*)(kbase + ((size_t)(16 + 2 * sub + i) * 64 + key) * 8) = packf8(o); }
      GAS bf16* vdst = (GAS bf16*)WSP(bf16, WS_VFT) + (size_t)((bb * 16 + h) * 64 + tile) * (4 * 64 * 32) + ((size_t)sub * 64 + key) * 32;
#pragma unroll
      for (int i = 0; i < 4; ++i) *(GAS v4u*)(vdst + 8 * i) = *(const GAS v4u*)(kr + 128 + sub * 32 + 8 * i); }
}
__device__ __forceinline__ void p8_router(Frame& F, const float* const* in) {
    const int tid = F.tid, l = F.lane, r32 = l & 31, hi = l >> 5, w = F.wave, tk = w >> 2, kq = w & 3;
    LAS float* part = (LAS float*)(F.lds + RING_OFF);
    LAS float* ssp = part + 2 * 4 * 32 * 33;
    LAS int* lcnt = (LAS int*)(F.lds + LTAB_OFF) + 40;
    LAS int* gbase = lcnt + 32;
    const int tok0 = (blockIdx.x * 2 + tk) * 32;
    if (tid < 32) lcnt[tid] = 0;
#if ROUTER_BF16X2
    {   const GAS bf16* xr = (const GAS bf16*)WSP(bf16, WS_X1) + (size_t)(tok0 + r32) * 2048 + 8 * hi;
        const GAS bf16* wh = (const GAS bf16*)WSP(bf16, WS_RWG) + (size_t)r32 * 2048 + 8 * hi;
        f32x16 acc;
#pragma unroll
        for (int r = 0; r < 16; ++r) acc[r] = 0.f;
        float ss = 0.f;
#pragma unroll 4
        for (int it = 32 * kq; it < 32 * kq + 32; ++it) {
            const v4u aw = *(const GAS v4u*)(xr + 16 * it);
            const bf16x8 a = __builtin_bit_cast(bf16x8, aw);
            const bf16x8 bh = *(const GAS bf16x8*)(wh + 16 * it), bl = *(const GAS bf16x8*)(wh + 32 * 2048 + 16 * it);
            acc = __builtin_amdgcn_mfma_f32_32x32x16_bf16(a, bh, acc, 0, 0, 0);
            acc = __builtin_amdgcn_mfma_f32_32x32x16_bf16(a, bl, acc, 0, 0, 0);
            float fa[8]; unpack8(aw, fa);
            ss += ((fa[0] * fa[0] + fa[1] * fa[1]) + (fa[2] * fa[2] + fa[3] * fa[3])) + ((fa[4] * fa[4] + fa[5] * fa[5]) + (fa[6] * fa[6] + fa[7] * fa[7]));
        }
#else
    {   const GAS bf16* xr = (const GAS bf16*)WSP(bf16, WS_X1) + (size_t)(tok0 + r32) * 2048 + 4 * hi;
        const GAS float* rw = (const GAS float*)WSP(float, WS_RWG) + (size_t)(4 * hi) * 32 + r32;
        f32x16 acc;
#pragma unroll
        for (int r = 0; r < 16; ++r) acc[r] = 0.f;
        float ss = 0.f;
#pragma unroll 4
        for (int q = 64 * kq; q < 64 * kq + 64; ++q) {
            const u32x2 aw = *(const GAS u32x2*)(xr + 8 * q); f32x4 a; a.x = bflo(aw.x); a.y = bfhi(aw.x); a.z = bflo(aw.y); a.w = bfhi(aw.y);
            const GAS float* rq = rw + (size_t)(8 * q) * 32;
            const float b0 = rq[0], b1 = rq[32], b2 = rq[64], b3 = rq[96];
            acc = __builtin_amdgcn_mfma_f32_32x32x2f32(a.x, b0, acc, 0, 0, 0);
            acc = __builtin_amdgcn_mfma_f32_32x32x2f32(a.y, b1, acc, 0, 0, 0);
            acc = __builtin_amdgcn_mfma_f32_32x32x2f32(a.z, b2, acc, 0, 0, 0);
            acc = __builtin_amdgcn_mfma_f32_32x32x2f32(a.w, b3, acc, 0, 0, 0);
            ss += (a.x * a.x + a.y * a.y) + (a.z * a.z + a.w * a.w);
        }
#endif
        LAS float* pp = part + (size_t)((tk * 4 + kq) * 32) * 33;
#pragma unroll
        for (int r = 0; r < 16; ++r) pp[crow(r, hi) * 33 + r32] = acc[r];
        ssp[(tk * 4 + kq) * 64 + l] = ss;
    }
    __syncthreads();
    const bool sel = (kq == 0) && (l < 32);
    float v0 = -INFINITY, v1 = -INFINITY, v2 = -INFINITY, v3 = -INFINITY; int i0 = 0, i1 = 0, i2 = 0, i3 = 0; int lr0 = 0, lr1 = 0, lr2 = 0, lr3 = 0;
    if (sel) {
        float ss = 0.f;
#pragma unroll
        for (int k = 0; k < 4; ++k) ss += ssp[(tk * 4 + k) * 64 + l] + ssp[(tk * 4 + k) * 64 + 32 + l];
        const float rs = 1.0f * FAST_RSQ(ss * (1.f / 2048.f) + EPS);
        const GAS float* rb = (const GAS float*)in[28];
        const LAS float* pp = part + (size_t)(tk * 4 * 32 + l) * 33;
#pragma unroll
        for (int e = 0; e < 32; ++e) {
            const float x = ((pp[e] + pp[32 * 33 + e]) + (pp[2 * 32 * 33 + e] + pp[3 * 32 * 33 + e])) * rs + rb[e];
            if (x > v3) {
                if (x > v0) { v3 = v2; i3 = i2; v2 = v1; i2 = i1; v1 = v0; i1 = i0; v0 = x; i0 = e; }
                else if (x > v1) { v3 = v2; i3 = i2; v2 = v1; i2 = i1; v1 = x; i1 = e; }
                else if (x > v2) { v3 = v2; i3 = i2; v2 = x; i2 = e; }
                else { v3 = x; i3 = e; }
            }
        }
        lr0 = __hip_atomic_fetch_add(&lcnt[i0], 1, __ATOMIC_RELAXED, __HIP_MEMORY_SCOPE_WORKGROUP); lr1 = __hip_atomic_fetch_add(&lcnt[i1], 1, __ATOMIC_RELAXED, __HIP_MEMORY_SCOPE_WORKGROUP); lr2 = __hip_atomic_fetch_add(&lcnt[i2], 1, __ATOMIC_RELAXED, __HIP_MEMORY_SCOPE_WORKGROUP); lr3 = __hip_atomic_fetch_add(&lcnt[i3], 1, __ATOMIC_RELAXED, __HIP_MEMORY_SCOPE_WORKGROUP);
    }
    __syncthreads();
    if (tid < 32) { const int c = lcnt[tid]; gbase[tid] = c ? (int)__hip_atomic_fetch_add((unsigned*)(F.ctl + CW_CNT + CNT_STRIDE * tid), (unsigned)c, __ATOMIC_RELAXED, __HIP_MEMORY_SCOPE_AGENT) : 0; }
    __syncthreads();
    if (sel) {
        const int t = tok0 + l;
        const float e1 = expf(v1 - v0), e2 = expf(v2 - v0), e3 = expf(v3 - v0), inv = 1.0f / (1.0f + e1 + e2 + e3);
        GAS int* te = (GAS int*)WSP(int, WS_TKE) + t * 4; GAS int* tr = (GAS int*)WSP(int, WS_TKR) + t * 4; GAS float* tg = (GAS float*)WSP(float, WS_TKG) + t * 4;
        te[0] = i0; te[1] = i1; te[2] = i2; te[3] = i3;
        tr[0] = gbase[i0] + lr0; tr[1] = gbase[i1] + lr1; tr[2] = gbase[i2] + lr2; tr[3] = gbase[i3] + lr3;
        tg[0] = inv; tg[1] = e1 * inv; tg[2] = e2 * inv; tg[3] = e3 * inv;
    }
    __syncthreads();
}
__device__ __forceinline__ void build_moe_tab(Frame& F) {
    LAS int* tab = (LAS int*)(F.lds + LTAB_OFF);
#if CNT_SPREAD
    if (F.tid < NE) tab[40 + NE + NE + F.tid] = ((int)__hip_atomic_load(F.ctl + CW_CNT + CNT_STRIDE * F.tid, RLX_AGENT) + 255) >> 8;
    __syncthreads();
    if (F.tid == 0) { int s = 0; for (int e = 0; e < NE; ++e) { tab[e] = s; s += tab[40 + NE + NE + e]; } tab[NE] = s; }
    __syncthreads();
    if (F.tid < MAXBLK) { int e = 0; while (e < NE - 1 && tab[e + 1] <= F.tid) ++e; ((LAS unsigned char*)(tab + 136))[F.tid] = (unsigned char)e; }
    __syncthreads();
}
#else
    if (F.tid == 0) { int s = 0; for (int e = 0; e < NE; ++e) { tab[e] = s; s += ((int)__hip_atomic_load(F.ctl + CW_CNT + e, RLX_AGENT) + 255) >> 8; } tab[NE] = s; }
    __syncthreads();
}
#endif
struct P9Pre { u32x2 xw[8]; int e[4], r[4]; };
__device__ __forceinline__ P9Pre p9_load(Frame& F, int t) {
    P9Pre p; const GAS u32x2* xr = (const GAS u32x2*)(WSP(bf16, WS_X1) + (size_t)t * 2048) + F.lane;
#pragma unroll
    for (int j = 0; j < 8; ++j) p.xw[j] = xr[64 * j];
    const GAS int* te = (const GAS int*)WSP(int, WS_TKE) + t * 4; const GAS int* tr = (const GAS int*)WSP(int, WS_TKR) + t * 4;
#pragma unroll
    for (int k = 0; k < 4; ++k) { p.e[k] = te[k]; p.r[k] = tr[k]; }
    return p;
}
__device__ __forceinline__ void p9_scatter_token(Frame& F, const float* const* in, const P9Pre& p) {
    const int lane = F.lane; const LAS int* tab = (const LAS int*)(F.lds + LTAB_OFF);
    const GAS f32x4* gr = (const GAS f32x4*)in[26] + lane;
    f32x4 v[8]; float s = 0.f;
#pragma unroll
    for (int j = 0; j < 8; ++j) { const u32x2 xw = p.xw[j]; v[j].x = bflo(xw.x); v[j].y = bfhi(xw.x); v[j].z = bflo(xw.y); v[j].w = bfhi(xw.y); s += (v[j].x * v[j].x + v[j].y * v[j].y) + (v[j].z * v[j].z + v[j].w * v[j].w); }
    const float rs = 1.0f * FAST_RSQ(wave_sum(s) * (1.f / 2048.f) + EPS);
    unsigned w[8];
#pragma unroll
    for (int j = 0; j < 8; ++j) { const f32x4 g = gr[64 * j]; w[j] = pk4_fp8(v[j].x * rs * g.x, v[j].y * rs * g.y, v[j].z * rs * g.z, v[j].w * rs * g.w); }
#pragma unroll
    for (int k = 0; k < 4; ++k) { const size_t rowi = (size_t)tab[p.e[k]] * 256 + p.r[k];
        GAS unsigned* o4 = (GAS unsigned*)(WSP(unsigned char, WS_HS) + rowi * 2048) + lane;
#pragma unroll
        for (int j = 0; j < 8; ++j) o4[64 * j] = w[j]; }
}
struct P12Idx { int e[4], r[4]; float g[4]; };
__device__ __forceinline__ P12Idx p12_load_idx(Frame& F, int t) {
    P12Idx x; const GAS int* te = (const GAS int*)WSP(int, WS_TKE) + t * 4; const GAS int* tr = (const GAS int*)WSP(int, WS_TKR) + t * 4; const GAS float* tg = (const GAS float*)WSP(float, WS_TKG) + t * 4;
#pragma unroll
    for (int k = 0; k < 4; ++k) { x.e[k] = te[k]; x.r[k] = tr[k]; x.g[k] = tg[k]; }
    return x;
}
__device__ __forceinline__ void p12_combine_token(Frame& F, float* out, int t, const P12Idx& ix) {
    const int lane = F.lane; const LAS int* tab = (const LAS int*)(F.lds + LTAB_OFF);
    const GAS u32x2* xr = (const GAS u32x2*)(WSP(bf16, WS_X1) + (size_t)t * 2048) + lane;
    u32x2 xw[8]; unsigned yw[4][8];
#pragma unroll
    for (int j = 0; j < 8; ++j) xw[j] = xr[64 * j];
#pragma unroll
    for (int k = 0; k < 4; ++k) { const size_t rowi = (size_t)tab[ix.e[k]] * 256 + ix.r[k];
        const GAS unsigned* y4 = (const GAS unsigned*)(WSP(unsigned char, WS_Y) + rowi * 2048) + lane;
#pragma unroll
        for (int j = 0; j < 8; ++j) yw[k][j] = y4[64 * j]; }
    f32x4 v[8];
#pragma unroll
    for (int j = 0; j < 8; ++j) { v[j].x = bflo(xw[j].x); v[j].y = bfhi(xw[j].x); v[j].z = bflo(xw[j].y); v[j].w = bfhi(xw[j].y); }
#pragma unroll
    for (int k = 0; k < 4; ++k) { const float g = ix.g[k];
#pragma unroll
        for (int j = 0; j < 8; ++j) { const f32x2 lo = __builtin_amdgcn_cvt_pk_f32_fp8((int)yw[k][j], false), hh = __builtin_amdgcn_cvt_pk_f32_fp8((int)yw[k][j], true);
            v[j].x += g * lo[0]; v[j].y += g * lo[1]; v[j].z += g * hh[0]; v[j].w += g * hh[1]; } }
    GAS f32x4* o = (GAS f32x4*)(out + (size_t)t * 2048) + lane;
#pragma unroll
    for (int j = 0; j < 8; ++j) o[64 * j] = v[j];
}

struct Args { const float* in[33]; float* out; unsigned char* ws; };
__global__ void __launch_bounds__(NWAVES * 64, 2) mk_fwd(Args args) {
    extern __shared__ __attribute__((aligned(16))) unsigned char lds[];
    Frame F;
    F.lds = (LAS unsigned char*)lds;
    F.MISC = (volatile LAS unsigned*)(F.lds + MISC_OFF);
    F.tid = threadIdx.x; F.lane = F.tid & 63; F.wave = __builtin_amdgcn_readfirstlane(F.tid >> 6);
    F.G = gridDim.x; { const int bx = blockIdx.x; F.vcu = (F.G % 8 == 0) ? (bx % 8) * (F.G / 8) + bx / 8 : bx; }
    F.ws = args.ws; F.ctl = (gu32*)(args.ws + WS_CTL);
    const float* const* in = args.in;
    for (int u = F.tid; u < (LDS_BYTES - LDSCTL_OFF) / 4; u += NWAVES * 64) ((LAS unsigned*)(F.lds + LDSCTL_OFF))[u] = 0u;
    __syncthreads();
#define PHASE_SEAM() do { xcd_barrier(bar); int l_ = pg8::pg8_lane(); asm volatile("" : "+v"(l_)); F.lane = l_; F.tid = F.wave * 64 + l_; } while (0)
    XcdBarrier bar = xcd_barrier_post((unsigned*)(F.ctl + CW_BAR), F.MISC + 8);
    const int gw = F.vcu * NWAVES + F.wave, NGW = F.G * NWAVES;
    typedef pg8::bf16_t pbf;

    for (int rep = 0; rep < REP_P0; ++rep) p0_prologue<0>(F, in);
    PHASE_SEAM();

    for (int rep = 0; rep < REP_P1; ++rep)
    {   pg8::Gemm g{WSP(pbf, WS_H), WSP(pbf, WS_W1T), T + MEMROWS, P1N + 2048, 2048, HPITCH, HPITCH};
        pg8::EpiP1 E{WSP(pbf, WS_P1), WSP(pbf, WS_MKV), in[6]};
        const int slot = (CONV_IN_P1 && (!ATTN_SPLIT || SPLIT_NOCONV) && rep == 0) ? (F.vcu % (GATE_F8 ? 5 : 10)) : 0;
        if (!(UV_F8 == 1 && GATE_F8))
        {   pg8::P1Order S; S.init(F.G, (int)blockIdx.x, 0, slot);
            pg8::gemm_phase<pg8::EpiP1, pg8::P1Order, GEMM_ALIGN, true>(F.lds + RING_OFF, g, S, E, F.wave); }
        if (CONV_IN_P1 && (!ATTN_SPLIT || SPLIT_NOCONV) && rep == 0) { __syncthreads(); if (CONV_DMA == 2) moe_convert_share_dma256(F, in); else if (CONV_DMA) moe_convert_share_dma(F, in); else moe_convert_share<0>(F, in); if (REP_CONV > 1) moe_convert_share<1>(F, in); }
        if (!(UV_F8 == 1 && GATE_F8))
        {   pg8::P1Order S; S.init(F.G, (int)blockIdx.x, slot, 1 << 20);
            pg8::gemm_phase<pg8::EpiP1, pg8::P1Order, GEMM_ALIGN, true>(F.lds + RING_OFF, g, S, E, F.wave); }
        if (GATE_F8) {
            pg8::Gemm g8{WSP(pbf, WS_H8), WSP(pbf, WS_WG8) - (size_t)8 * 256 * 1024, T + MEMROWS, 41 * 256, 1024, 1024, 1024, MOE_SW, MOE_SX};
            pg8::GateOrder SG; SG.init(F.G, (int)blockIdx.x);
            pg8::gemm_phase<pg8::EpiP1, pg8::GateOrder, GEMM_ALIGN, true, true, 0, (KROT_MASK & 4) != 0>(F.lds + RING_OFF, g8, SG, E, F.wave); }
        if (GATE_F8 && PRO_SPLIT == 1 && UV_F8 == 2 && rep == 0 && blockIdx.x >= 96) p0_prologue<1>(F, in, (int)blockIdx.x - 96, 160);
        if (GATE_F8 && PRO_SPLIT == 2 && UV_F8 == 2 && rep == 0 && blockIdx.x >= 224) p0_prologue<1>(F, in, (int)blockIdx.x - 224, 32);
        if (GATE_F8 && CONV_OFFLOAD && UV_F8 == 2 && rep == 0 && blockIdx.x >= 96 && blockIdx.x < 96 + CONV_OFF_CUS) {
            const int k0 = (CONV_NSUP - CONV_OFF) + 8 * ((int)blockIdx.x - 96);
            moe_convert_range256<8>(F, in, F.wave, (LAS unsigned*)(F.lds + RING_OFF + F.wave * 16640), F.lane, k0, k0 + 8); }
    }
    PHASE_SEAM();

    for (int rep = 0; rep < REP_P2; ++rep)
    for (int t = gw; t < T; t += NGW) p2_token(F, in, t);
    for (int m = gw; m < MEMROWS; m += NGW) p2_memrow(F, in, m);
    PHASE_SEAM();

    for (int rep = 0; rep < REP_P3; ++rep) {
    {   pg8::Gemm g{WSP(pbf, WS_CQN), WSP(pbf, WS_WUQT), T, 4096, 256, 256, 256, UP_SW, MOE_SX};
        pg8::StaticOrder S; S.init(T, 4096, F.G, (int)blockIdx.x);
#if ATTN_F8
        pg8::EpiQ8 E{(LAS float*)(F.lds + LEPI_OFF), in[16], WSP(float, WS_ROPE), WSP(unsigned char, WS_QF), MLA_QSCALE * 16.0f};
        pg8::gemm_phase<pg8::EpiQ8, pg8::StaticOrder, true, true, true>(F.lds + RING_OFF, g, S, E, F.wave);
#else
        pg8::EpiQ E{(LAS float*)(F.lds + LEPI_OFF), in[16], WSP(float, WS_ROPE), WSP(pbf, WS_QF), MLA_QSCALE};
        pg8::gemm_phase<pg8::EpiQ, pg8::StaticOrder, true, true, true>(F.lds + RING_OFF, g, S, E, F.wave);
#endif
    }
    {   pg8::Gemm g{WSP(pbf, WS_CKVN), WSP(pbf, WS_WUKVT), T, 4096, 256, 256, 256, UP_SW, MOE_SX};
        pg8::StaticOrder S; S.init(T, 4096, F.G, (int)blockIdx.x);
#if ATTN_F8
        pg8::EpiKV8 E{(LAS float*)(F.lds + LEPI_OFF), in[17], WSP(float, WS_KRSS), WSP(float, WS_KRR), WSP(unsigned char, WS_KFT), WSP(unsigned char, WS_VFT)};
        pg8::gemm_phase<pg8::EpiKV8, pg8::StaticOrder, true, true, true>(F.lds + RING_OFF, g, S, E, F.wave);
#else
        pg8::EpiKV E{(LAS float*)(F.lds + LEPI_OFF), in[17], WSP(float, WS_KRSS), WSP(float, WS_KRR), WSP(pbf, WS_KFT), WSP(pbf, WS_VFT)};
        pg8::gemm_phase<pg8::EpiKV, pg8::StaticOrder, true, true, true>(F.lds + RING_OFF, g, S, E, F.wave);
#endif
    }
    __syncthreads();
    for (int u = F.vcu; u < 1024; u += F.G) gmlp_unit(F, in, u);
    for (int u = F.vcu; u < 512; u += F.G) {
        const int half = u & 1, qb = (u >> 1) & 15, bh = u >> 5;
        const bf16* Q = WSP(bf16, WS_QMN) + ((size_t)bh * 4096 + qb * 256 + 32 * F.wave) * 256;
        const bf16* Kt = WSP(bf16, WS_MKT) + (size_t)bh * 4 * (32 * 64 * 8);
        const bf16* Vt = WSP(bf16, WS_MVT) + (size_t)(bh * 2 + half) * 4 * (4 * 64 * 32);
        unsigned char* O = WSP(unsigned char, WS_ABC) + ((size_t)(bh >> 2) * 4096 + qb * 256 + 32 * F.wave) * ABC_ROWB + ABC_CB + (bh & 3) * 256 + half * 128;
        attn_unit<256, 2, false>(F.lds + RING_OFF, Q, 256, Kt, Vt, 4, 0, O, ABC_ROWB, F.wave, F.lane);
    }
    }
    PHASE_SEAM();

#if ATTN_SPLIT
    {   const int s = F.vcu & 3;
#if !(ATTN_XCDMAP && ATTN_RB2)
        const int bh = F.vcu >> 2;
#endif
        constexpr int NIT = NE * 32 * 64 + NE * 32 * 32;
        ConvState cs; cs.lo = F.vcu * (NIT / 256); cs.cw = F.wave - 4; cs.c = -1;
        { const int nitems = (NIT / 256 - cs.cw + 3) / 4; cs.nchunks = (F.wave >= 4 && !SPLIT_NOCONV) ? nitems * 4 : 0; }
        LAS unsigned char* cbase = F.lds + RING_OFF + (ATT_PAIR && ATTN_RB2 ? 81920 : 61440) + (F.wave - 4) * 16640;
#if ATTN_RB2
#if ATTN_XCDMAP
#define P5_UNIT(i_) const int s16 = F.vcu & 15, s8 = (s16 + 8) & 15, qb = ((i_) == 0) ? s16 : ((i_) == 1) ? 15 - s16 : ((i_) == 2) ? s8 : 15 - s8, nt = 4 * (qb + 1), \
        bh = 8 * (F.vcu >> 5) + 2 * (i_) + ((F.vcu >> 4) & 1)
#else
#define P5_UNIT(i_) const int qb = ((i_) == 0) ? s : ((i_) == 1) ? 7 - s : ((i_) == 2) ? 8 + s : 15 - s, nt = 4 * (qb + 1)
#endif
#if ATT_REBAL
        LAS unsigned* bctr = (LAS unsigned*)(F.lds + MISC_OFF + 64);
        if (F.tid == 0) { bctr[0] = 0u; bctr[1] = 0u; }
        __syncthreads();
        const unsigned char* Kt = WSP(unsigned char, WS_KFT) + (size_t)bh * 64 * 12288;
        const unsigned char* Vt = WSP(unsigned char, WS_VFT) + (size_t)bh * 64 * 8192;
        if (F.wave < 4) {
            unsigned nbar = 0;
            const int nu = (s == 0) ? 2 : 3;
            for (int i = 0; i < nu; ++i) {
                const int qb = (s == 0) ? (i == 0 ? 15 : 13) : (s == 1) ? (i == 0 ? 14 : i == 1 ? 8 : 5) : (s == 2) ? (i == 0 ? 12 : i == 1 ? 9 : 6) : (i == 0 ? 11 : i == 1 ? 10 : 7);
                const unsigned char* Q = WSP(unsigned char, WS_QF) + ((size_t)bh * 4096 + qb * 256 + 32 * F.wave) * 192;
                unsigned char* O = WSP(unsigned char, WS_ABC) + ((size_t)(bh >> 4) * 4096 + qb * 256 + 32 * F.wave) * ABC_ROWB + ABC_BB + (bh & 15) * 128;
                attn8_unit2<true>(F.lds + RING_OFF, Q, Kt, Vt, 4 * (qb + 1), qb * 256 + 32 * F.wave, O, ABC_ROWB, F.wave, F.lane, bctr, nbar); }
        } else {
            moe_convert_share_w256<4>(F, in, F.wave - 4, (LAS unsigned*)cbase, F.lane);
            asm volatile("s_waitcnt vmcnt(0) lgkmcnt(0)" ::: "memory");
            unsigned nbar2 = 0; const int cw = F.wave - 4;
            att_bar4(bctr + 1, nbar2, F.lane);
            const int nu = (s == 3) ? 4 : 2;
            for (int i = 0; i < nu; ++i) {
                const int qh = (s == 0) ? (i == 0 ? 9 : 3) : (s == 1) ? (i == 0 ? 8 : 4) : (s == 2) ? (i == 0 ? 7 : 5) : (i == 0 ? 6 : i == 1 ? 2 : i == 2 ? 1 : 0);
                const unsigned char* Q = WSP(unsigned char, WS_QF) + ((size_t)bh * 4096 + qh * 128 + 32 * cw) * 192;
                unsigned char* O = WSP(unsigned char, WS_ABC) + ((size_t)(bh >> 4) * 4096 + qh * 128 + 32 * cw) * ABC_ROWB + ABC_BB + (bh & 15) * 128;
                attn8_unit<true, 4>(F.lds + RING_OFF + 61440, Q, Kt, Vt, 2 * (qh + 1), qh * 128 + 32 * cw, O, ABC_ROWB, cw, F.lane, bctr + 1, &nbar2); }
        }
#else
        LAS unsigned* bctr = (LAS unsigned*)(F.lds + MISC_OFF + 64);
        if (F.tid == 0) *bctr = 0u;
        __syncthreads();
        if (F.wave < 4) {
            unsigned nbar = 0;
            for (int rep = 0; rep < REP_P5; ++rep)
            for (int i = 0; i < 4; ++i) { P5_UNIT(i);
                const unsigned char* Q = WSP(unsigned char, WS_QF) + ((size_t)bh * 4096 + qb * 256 + 32 * F.wave) * 192;
                const unsigned char* Kt = WSP(unsigned char, WS_KFT) + (size_t)bh * 64 * 12288;
                const unsigned char* Vt = WSP(unsigned char, WS_VFT) + (size_t)bh * 64 * 8192;
                unsigned char* O = WSP(unsigned char, WS_ABC) + ((size_t)(bh >> 4) * 4096 + qb * 256 + 32 * F.wave) * ABC_ROWB + ABC_BB + (bh & 15) * 128;
                attn8_unit2<true>(F.lds + RING_OFF, Q, Kt, Vt, nt, qb * 256 + 32 * F.wave, O, ABC_ROWB, F.wave, F.lane, bctr, nbar); }
        } else {
#if !SPLIT_FREE
            int it = 0;
            for (int i = 0; i < 4; ++i) { P5_UNIT(i);
                for (int j = 0; j < nt; ++j, ++it) { conv_steps<4>(F, in, cs, cbase, 3, F.lane); __builtin_amdgcn_s_barrier(); asm volatile("" ::: "memory"); }
                __builtin_amdgcn_s_barrier(); asm volatile("" ::: "memory"); }
#endif
#if SPLIT_FREE == 2
            for (int rep = 0; rep < REP_CONV; ++rep) { if (CONV_ROWS == 256) moe_convert_share_w256<4>(F, in, F.wave - 4, (LAS unsigned*)cbase, F.lane); else moe_convert_share_w<4>(F, in, F.wave - 4, (LAS unsigned*)cbase, F.lane); }
            asm volatile("s_waitcnt vmcnt(0)" ::: "memory");
#else
            for (int rep = 0; rep < REP_CONV; ++rep) { cs.c = -1; conv_steps<4>(F, in, cs, cbase, 1 << 20, F.lane); asm volatile("s_waitcnt vmcnt(0)" ::: "memory"); }
#endif
        }
#endif
#undef P5_UNIT
#else
#define P5_UNIT(i_) const int qb = (((i_) >> 1) == 0) ? s : (((i_) >> 1) == 1) ? 7 - s : (((i_) >> 1) == 2) ? 8 + s : 15 - s, qh = 2 * qb + ((i_) & 1), nt = 2 * (qh + 1)
        if (F.wave < 4) {
            __builtin_amdgcn_s_setprio(SPLIT_PRIO);
            for (int i = 0; i < 8; ++i) { P5_UNIT(i);
                const unsigned char* Q = WSP(unsigned char, WS_QF) + ((size_t)bh * 4096 + qh * 128 + 32 * F.wave) * 192;
                const unsigned char* Kt = WSP(unsigned char, WS_KFT) + (size_t)bh * 64 * 12288;
                const unsigned char* Vt = WSP(unsigned char, WS_VFT) + (size_t)bh * 64 * 8192;
                unsigned char* O = WSP(unsigned char, WS_ABC) + ((size_t)(bh >> 4) * 4096 + qh * 128 + 32 * F.wave) * ABC_ROWB + ABC_BB + (bh & 15) * 128;
                attn8_unit<true, 4>(F.lds + RING_OFF, Q, Kt, Vt, nt, qh * 128 + 32 * F.wave, O, ABC_ROWB, F.wave, F.lane); }
            __builtin_amdgcn_s_setprio(0);
        } else {
            int it = 0;
            for (int i = 0; i < 8; ++i) { P5_UNIT(i);
                for (int j = 0; j < nt; ++j, ++it) { conv_steps<4>(F, in, cs, cbase, CONV_QUOTA(it), F.lane); __builtin_amdgcn_s_barrier(); asm volatile("" ::: "memory"); }
                __builtin_amdgcn_s_barrier(); asm volatile("" ::: "memory"); }
            conv_steps<4>(F, in, cs, cbase, 1 << 20, F.lane); asm volatile("s_waitcnt vmcnt(0)" ::: "memory");
        }
#undef P5_UNIT
#endif
        __syncthreads();
    }
    PHASE_SEAM();

#else
    for (int rep = 0; rep < REP_P5; ++rep)
    {   const int bh = F.vcu >> 2, s = F.vcu & 3;
        for (int i = 0; i < 4; ++i) {
            if (!CONV_IN_P1 && rep == 0 && i == ((F.vcu >> 2) & 3)) { moe_convert_share<0>(F, in); if (REP_CONV > 1) moe_convert_share<1>(F, in); }
            const int qb = (i == 0) ? s : (i == 1) ? 7 - s : (i == 2) ? 8 + s : 15 - s;
#if ATTN_F8
            const unsigned char* Q = WSP(unsigned char, WS_QF) + ((size_t)bh * 4096 + qb * 256 + 32 * F.wave) * 192;
            const unsigned char* Kt = WSP(unsigned char, WS_KFT) + (size_t)bh * 64 * 12288;
            const unsigned char* Vt = WSP(unsigned char, WS_VFT) + (size_t)bh * 64 * 8192;
            unsigned char* O = WSP(unsigned char, WS_ABC) + ((size_t)(bh >> 4) * 4096 + qb * 256 + 32 * F.wave) * ABC_ROWB + ABC_BB + (bh & 15) * 128;
            attn8_unit<true>(F.lds + RING_OFF, Q, Kt, Vt, 4 * (qb + 1), qb * 256 + 32 * F.wave, O, ABC_ROWB, F.wave, F.lane);
#else
            const bf16* Q = WSP(bf16, WS_QF) + ((size_t)bh * 4096 + qb * 256 + 32 * F.wave) * 192;
            const bf16* Kt = WSP(bf16, WS_KFT) + (size_t)bh * 64 * (24 * 64 * 8);
            const bf16* Vt = WSP(bf16, WS_VFT) + (size_t)bh * 64 * (4 * 64 * 32);
            unsigned char* O = WSP(unsigned char, WS_ABC) + ((size_t)(bh >> 4) * 4096 + qb * 256 + 32 * F.wave) * ABC_ROWB + ABC_BB + (bh & 15) * 128;
            attn_unit<192, 3, true>(F.lds + RING_OFF, Q, 192, Kt, Vt, 4 * (qb + 1), qb * 256 + 32 * F.wave, O, ABC_ROWB, F.wave, F.lane);
#endif
        }
    }
    PHASE_SEAM();

#endif
    for (int rep = 0; rep < REP_P6; ++rep)
    {   pg8::Gemm g{WSP(pbf, WS_ABC), WSP(pbf, WS_WPT), T, 2048, ABC_LD, ABC_LD, ABC_LD, MOE_SW, ATT_OSB};
        pg8::StaticOrder S; S.init(T, 2048, F.G, (int)blockIdx.x);
        pg8::EpiMergedT<16, 32> E{WSP(pbf, WS_P1), WSP(pbf, WS_MERGED)};
        pg8::gemm_phase<pg8::EpiMergedT<16, 32>, pg8::StaticOrder, GEMM_ALIGN, true, false, 16>(F.lds + RING_OFF, g, S, E, F.wave);
    }
    PHASE_SEAM();

    for (int rep = 0; rep < REP_P7; ++rep)
    {   pg8::Gemm g{WSP(pbf, WS_MERGED), WSP(pbf, WS_WOT), T, 2048, 2048, 2048, 2048};
        pg8::StaticOrder S; S.init(T, 2048, F.G, (int)blockIdx.x);
        pg8::EpiX1 E{in[0], WSP(pbf, WS_X1)};
        pg8::gemm_phase<pg8::EpiX1, pg8::StaticOrder, P7_ALIGN, true>(F.lds + RING_OFF, g, S, E, F.wave);
    }
    PHASE_SEAM();

    p8_router(F, in);
    PHASE_SEAM();

    build_moe_tab(F);
    for (int rep = 0; rep < REP_P9; ++rep)
    {   P9Pre cur = p9_load(F, gw < T ? gw : 0);
        for (int t = gw; t < T; t += NGW) { const P9Pre nx = p9_load(F, t + NGW < T ? t + NGW : t); p9_scatter_token(F, in, cur); cur = nx; } }
    PHASE_SEAM();

    for (int rep = 0; rep < REP_P10; ++rep)
    {   pg8::Gemm g{WSP(pbf, WS_HS), WSP(pbf, WS_WGUT), MAXSLOT, NE * 4096, 1024, 1024, 1024, MOE_SW, MOE_SX};
        pg8::MoeOrder S{(const LAS int*)(F.lds + LTAB_OFF), 16, (int)(blockIdx.x & 7), (int)(blockIdx.x >> 3)};
        pg8::EpiSwiGLU E{in[30], WSP(unsigned char, WS_ACT)};
#if P10_PROBE
        if (rep > 0) { pg8::EpiSwiGLUProbe<P10_PROBE> EP; EP.bgu = E.bgu; EP.ACT = E.ACT;
            pg8::gemm_phase<pg8::EpiSwiGLUProbe<P10_PROBE>, pg8::MoeOrder, GEMM_ALIGN, true, true>(F.lds + RING_OFF, g, S, EP, F.wave); }
        else
#endif
        pg8::gemm_phase<pg8::EpiSwiGLU, pg8::MoeOrder, GEMM_ALIGN, true, true, 0, (KROT_MASK & 1) != 0, (PFETCH_MASK & 1) != 0>(F.lds + RING_OFF, g, S, E, F.wave);
    }
    PHASE_SEAM();

    for (int rep = 0; rep < REP_P11; ++rep)
    {   pg8::Gemm g{WSP(pbf, WS_ACT), WSP(pbf, WS_WDT), MAXSLOT, NE * 2048, 1024, 1024, 1024, MOE_SW, MOE_SX};
        pg8::MoeOrder S{(const LAS int*)(F.lds + LTAB_OFF), 8, (int)(blockIdx.x & 7), (int)(blockIdx.x >> 3)};
        pg8::EpiDown E{in[32], WSP(unsigned char, WS_Y)};
        pg8::gemm_phase<pg8::EpiDown, pg8::MoeOrder, GEMM_ALIGN, true, true, 0, (KROT_MASK & 2) != 0>(F.lds + RING_OFF, g, S, E, F.wave);
    }
    PHASE_SEAM();

    for (int rep = 0; rep < REP_P12; ++rep)
    {   P12Idx ix = p12_load_idx(F, gw < T ? gw : 0);
        for (int t = gw; t < T; t += NGW) { const P12Idx nx = p12_load_idx(F, t + NGW < T ? t + NGW : t); p12_combine_token(F, args.out, t, ix); ix = nx; } }
}

extern "C" void kernel_launch(void* const* d_in, const int* in_sizes, int n_in, void* d_out, int out_size, void* d_ws, size_t ws_size, hipStream_t stream) {
    static int grid = 0;
    if (grid == 0) {
        if (n_in != 33 || out_size != T * D || ws_size < WS_END) { fprintf(stderr, "kernel_launch: unexpected problem (n_in %d out %d ws %zu need %zu)\n", n_in, out_size, ws_size, (size_t)WS_END); grid = -1; return; }
        (void)in_sizes;
        if (hipFuncSetAttribute((const void*)mk_fwd, hipFuncAttributeMaxDynamicSharedMemorySize, LDS_BYTES) != hipSuccess) { fprintf(stderr, "kernel_launch: hipFuncSetAttribute failed\n"); grid = -1; return; }
        int per_cu = 0;
        if (hipOccupancyMaxActiveBlocksPerMultiprocessor(&per_cu, (const void*)mk_fwd, NWAVES * 64, LDS_BYTES) != hipSuccess || per_cu < 1) fprintf(stderr, "kernel_launch: occupancy query reports %d\n", per_cu);
        (void)hipGetLastError();
        grid = 256;
    }
    if (grid < 0) return;
    if (hipMemsetAsync((char*)d_ws + WS_CTL, 0, CTL_ZERO_BYTES, stream) != hipSuccess) { fprintf(stderr, "kernel_launch: memset failed\n"); return; }
    Args a{};
    for (int i = 0; i < 33; ++i) a.in[i] = (const float*)d_in[i];
    a.out = (float*)d_out; a.ws = (unsigned char*)d_ws;
    hipLaunchKernelGGL(mk_fwd, dim3(grid), dim3(NWAVES * 64), LDS_BYTES, stream, a);
}
```
